# Optimizing an MI355X kernel written in HIP

```python
import jax, jax.numpy as jnp
from jax import lax
import numpy as np

D_MODEL = 1024
BATCH = 8
SEQ = 4096
DEPTH = 1
DEC_BATCH = 8
DEC_SEQ = 16
PAST_LEN = 4096

CHUNK = 64
D_MIX = D_MODEL
RET_HEADS = 4
RET_DK = 128
RET_DV = 128
RET_WIDTH = RET_HEADS * RET_DV
CONV_WIDTH = D_MIX - RET_WIDTH
CONV_GROUPS = 8
CONV_K = 3
D_FF = 4 * D_MODEL
FFN_CONV_K = 3
ROPE_BASE = 10000.0
EPS = 1e-6
IN_COLS = 3 * RET_HEADS * RET_DK + RET_WIDTH + 3 * CONV_WIDTH

kernel_name = "hybrid_retention_shortconv_streaming_step"


def rms_norm(x, w):
    xf = x.astype(jnp.float32)
    var = jnp.mean(xf * xf, axis=-1, keepdims=True)
    return (xf * lax.rsqrt(var + EPS)).astype(x.dtype) * w


def rotary(x, pos):
    d = x.shape[-1]
    inv = ROPE_BASE ** (-jnp.arange(0, d, 2, dtype=jnp.float32) / d)
    ang = pos.astype(jnp.float32)[:, None] * inv[None, :]
    cos = jnp.cos(ang)[:, None, :]
    sin = jnp.sin(ang)[:, None, :]
    xf = x.astype(jnp.float32)
    x1, x2 = xf[..., : d // 2], xf[..., d // 2:]
    return jnp.concatenate([x1 * cos - x2 * sin, x2 * cos + x1 * sin], axis=-1).astype(x.dtype)


def causal_dwconv(x, buf, w):
    k = w.shape[0]
    L = x.shape[1]
    xp = jnp.concatenate([buf.astype(x.dtype), x], axis=1)
    y = sum(xp[:, i:i + L] * w[i] for i in range(k))
    return y, xp[:, L:]


def retention_chunkwise(q, k, v, s0):
    C = q.shape[2]
    dt = q.dtype
    lg = jnp.log(1.0 - 2.0 ** (-5.0 - jnp.arange(RET_HEADS, dtype=jnp.float32)))
    idx = jnp.arange(C, dtype=jnp.float32)
    dmat = jnp.exp(lg[:, None, None] * jnp.abs(idx[:, None] - idx[None, :])).astype(dt)
    to_end = jnp.exp(lg[None, :] * (C - 1 - idx)[:, None]).astype(dt)
    from_start = jnp.exp(lg[None, :] * (idx + 1)[:, None]).astype(dt)
    g_chunk = jnp.exp(lg * C).astype(dt)[:, None, None]

    scores = jnp.einsum('bnihd,bnjhd->bnhij', q, k) * dmat
    intra = jnp.einsum('bnhij,bnjhe->bnihe', scores, v)
    upd = jnp.einsum('bnjhd,bnjhe->bnhde', k * to_end[None, None, :, :, None], v)

    def step(s, u):
        return g_chunk * s + u, s

    s_final, s_prev = lax.scan(step, s0.astype(upd.dtype), jnp.moveaxis(upd, 1, 0))
    s_prev = jnp.moveaxis(s_prev, 0, 1)
    cross = jnp.einsum('bnihd,bnhde->bnihe', q, s_prev) * from_start[None, None, :, :, None]
    return intra + cross, s_final


def layer(x, pos, chunk, s_ret, c_conv, c_ffn,
          w_in, w_out, conv_w, ret_norm_w, pre_mix_w, post_mix_w,
          pre_ffn_w, post_ffn_w, w_up, w_gate, ffn_conv_w, w_down):
    b, L, _ = x.shape
    n_chunks = L // chunk
    h = rms_norm(x, pre_mix_w)
    p = h @ w_in
    qd = RET_HEADS * RET_DK
    q, k, v, g, bg, cg, hc = jnp.split(
        p, np.cumsum([qd, qd, RET_WIDTH, RET_WIDTH, CONV_WIDTH, CONV_WIDTH]).tolist(), axis=-1)

    q = rotary(q.reshape(b, L, RET_HEADS, RET_DK), pos)
    k = rotary(k.reshape(b, L, RET_HEADS, RET_DK), pos) * (RET_DK ** -0.5)
    v = v.reshape(b, L, RET_HEADS, RET_DV)
    o, s_new = retention_chunkwise(
        q.reshape(b, n_chunks, chunk, RET_HEADS, RET_DK),
        k.reshape(b, n_chunks, chunk, RET_HEADS, RET_DK),
        v.reshape(b, n_chunks, chunk, RET_HEADS, RET_DV), s_ret)
    o = rms_norm(o.reshape(b, L, RET_HEADS, RET_DV), ret_norm_w.reshape(RET_HEADS, RET_DV))
    o = o.reshape(b, L, RET_WIDTH) * jax.nn.silu(g)

    yc, c_conv_new = causal_dwconv(cg * hc, c_conv, conv_w)
    yc = bg * yc

    x = x + rms_norm(jnp.concatenate([o, yc], axis=-1) @ w_out, post_mix_w)

    h2 = rms_norm(x, pre_ffn_w)
    u, c_ffn_new = causal_dwconv(h2 @ w_up, c_ffn, ffn_conv_w)
    f = (jax.nn.gelu(u, approximate=True) * (h2 @ w_gate)) @ w_down
    x = x + rms_norm(f, post_ffn_w)
    return x, s_new.astype(x.dtype), c_conv_new, c_ffn_new


def setup_inputs(seed: int = 0) -> dict:
    key = jax.random.key(seed)
    ks = jax.random.split(key, 20)
    nrm = lambda k, s, sc: jax.random.normal(k, s, jnp.float32) * sc
    gain = lambda k, n: 1.0 + nrm(k, (DEPTH, n), 0.05)
    return {
        "x_prompt": nrm(ks[0], (BATCH, SEQ, D_MODEL), 1.0),
        "x_sample": nrm(ks[1], (DEC_BATCH, DEC_SEQ, D_MODEL), 1.0),
        "state_ret": nrm(ks[2], (DEPTH, DEC_BATCH, RET_HEADS, RET_DK, RET_DV), 0.05),
        "cache_conv": nrm(ks[3], (DEPTH, DEC_BATCH, CONV_K - 1, CONV_WIDTH), 1.0),
        "cache_ffn_conv": nrm(ks[4], (DEPTH, DEC_BATCH, FFN_CONV_K - 1, D_FF), 1.0),
        "w_in": nrm(ks[5], (DEPTH, D_MODEL, IN_COLS), D_MODEL ** -0.5),
        "w_out": nrm(ks[6], (DEPTH, D_MIX, D_MODEL), D_MIX ** -0.5),
        "conv_w": nrm(ks[7], (DEPTH, CONV_K, CONV_WIDTH), CONV_K ** -0.5),
        "ret_norm_w": gain(ks[8], RET_WIDTH),
        "pre_mix_w": gain(ks[9], D_MODEL),
        "post_mix_w": gain(ks[10], D_MODEL),
        "pre_ffn_w": gain(ks[11], D_MODEL),
        "post_ffn_w": gain(ks[12], D_MODEL),
        "w_up": nrm(ks[13], (DEPTH, D_MODEL, D_FF), D_MODEL ** -0.5),
        "w_gate": nrm(ks[14], (DEPTH, D_MODEL, D_FF), D_MODEL ** -0.5),
        "ffn_conv_w": nrm(ks[15], (DEPTH, FFN_CONV_K, D_FF), FFN_CONV_K ** -0.5),
        "w_down": nrm(ks[16], (DEPTH, D_FF, D_MODEL), D_FF ** -0.5),
    }


def reference(x_prompt, x_sample, state_ret, cache_conv, cache_ffn_conv,
              w_in, w_out, conv_w, ret_norm_w, pre_mix_w, post_mix_w,
              pre_ffn_w, post_ffn_w, w_up, w_gate, ffn_conv_w, w_down):
    bp, lp, _ = x_prompt.shape
    bs, ls, _ = x_sample.shape
    dt = x_prompt.dtype
    pos_p = jnp.arange(lp)
    pos_s = PAST_LEN + jnp.arange(ls)
    zs_ret = jnp.zeros((bp, RET_HEADS, RET_DK, RET_DV), dt)
    zs_conv = jnp.zeros((bp, CONV_K - 1, CONV_WIDTH), dt)
    zs_ffn = jnp.zeros((bp, FFN_CONV_K - 1, D_FF), dt)

    yp, ys = x_prompt, x_sample
    sr_p, cc_p, cf_p, sr_s, cc_s, cf_s = [], [], [], [], [], []
    for l in range(DEPTH):
        w = (w_in[l], w_out[l], conv_w[l], ret_norm_w[l], pre_mix_w[l], post_mix_w[l],
             pre_ffn_w[l], post_ffn_w[l], w_up[l], w_gate[l], ffn_conv_w[l], w_down[l])
        yp, a, b_, c = layer(yp, pos_p, CHUNK, zs_ret, zs_conv, zs_ffn, *w)
        sr_p.append(a); cc_p.append(b_); cf_p.append(c)
        ys, a, b_, c = layer(ys, pos_s, ls, state_ret[l], cache_conv[l], cache_ffn_conv[l], *w)
        sr_s.append(a); cc_s.append(b_); cf_s.append(c)

    return (yp, ys,
            jnp.stack(sr_p), jnp.stack(cc_p), jnp.stack(cf_p),
            jnp.stack(sr_s), jnp.stack(cc_s), jnp.stack(cf_s))
```

```cpp
#include <hip/hip_runtime.h>
#include <hip/hip_cooperative_groups.h>
#include <cstdio>
#include <cstdint>
namespace cg = cooperative_groups;
namespace pg8 {
#define PG8_LAS __attribute__((address_space(3)))
typedef unsigned short bf16_t;
typedef short bf16x8 __attribute__((ext_vector_type(8)));
typedef float f32x4 __attribute__((ext_vector_type(4)));
typedef unsigned u32x4 __attribute__((ext_vector_type(4)));
constexpr int BM = 256, BK = 64, HALF = 128, HTB = HALF * BK * 2  , STAGE_BYTES = 8 * HTB, NXCD = 8, WGM = 8;

__host__ __device__ __forceinline__ int lds_byte(int r, int c) { const int st = (r >> 4) * 2 + (c >> 5), rr = r & 15, cc = c & 31, ob = rr * 64 + cc * 2; return st * 1024 + (ob ^ (((ob >> 9) & 1) << 5)); }
__host__ __device__ __forceinline__ void stage_rc(int b, int& R, int& C) { const int st = b / 1024, sb = b % 1024, swz = sb ^ (((sb >> 9) & 1) << 5); R = (st >> 1) * 16 + swz / 64; C = (st & 1) * 32 + (swz % 64) / 2; }
__host__ __device__ __forceinline__ int perm32(int rho) { const int n = rho >> 4, i = rho & 15; return 8 * (i >> 2) + 4 * n + (i & 3); }

struct Unit { int pm, pn; };
struct Gemm { const bf16_t* A; const bf16_t* Bt; int M, N, K; };

struct StaticOrder {
    int nM, nN, nwg, G, c;
    __host__ __device__ void init(int M, int N, int G_, int c_) { nM = M / BM; nN = N / BM; nwg = nM * nN; G = G_; c = c_; }
    __host__ __device__ bool next(int i, Unit& u) const {
        const long L = (long)i * G + c; if (L >= nwg) return false;
        int wgid = (int)L; { const int q = nwg / NXCD, r = nwg % NXCD, xcd = wgid % NXCD, off = wgid / NXCD; wgid = (xcd < r ? xcd * (q + 1) : r * (q + 1) + (xcd - r) * q) + off; }
        const int nig = WGM * nN, gid = wgid / nig, fm = gid * WGM, gsz = (nM - fm) < WGM ? (nM - fm) : WGM;
        u.pm = fm + ((wgid % nig) % gsz); u.pn = (wgid % nig) / gsz; return true;
    }
    __device__ __forceinline__ void a_ready(const Unit&) const {}
    __device__ __forceinline__ void done(const Unit&) const {}
};
__device__ __forceinline__ unsigned cvt_pk_bf16(float lo, float hi) { unsigned r; asm volatile("v_cvt_pk_bf16_f32 %0, %1, %2" : "=v"(r) : "v"(lo), "v"(hi)); return r; }
__device__ __forceinline__ float dpp_shr1(float v) { return __builtin_bit_cast(float, __builtin_amdgcn_update_dpp(0, __builtin_bit_cast(int, v), 0x111, 0xf, 0xf, true)); }
__device__ __forceinline__ float dpp_shr2(float v) { return __builtin_bit_cast(float, __builtin_amdgcn_update_dpp(0, __builtin_bit_cast(int, v), 0x112, 0xf, 0xf, true)); }
__device__ __forceinline__ float dpp_shl15(float v) { return __builtin_bit_cast(float, __builtin_amdgcn_update_dpp(0, __builtin_bit_cast(int, v), 0x10F, 0xf, 0xf, true)); }
__device__ __forceinline__ float dpp_shl14(float v) { return __builtin_bit_cast(float, __builtin_amdgcn_update_dpp(0, __builtin_bit_cast(int, v), 0x10E, 0xf, 0xf, true)); }
__device__ __forceinline__ float gelu_tanh(float x) {
    const float z = 0.7978845608028654f * (x + 0.044715f * x * x * x);
    const float e = __builtin_amdgcn_exp2f(-2.8853900817779268f * z);
    return x * __builtin_amdgcn_rcpf(1.0f + e);
}
constexpr int TOKP = 32768;

struct EpiIn {
    static constexpr bool PERM = true, AFTER_DRAIN = false;
    bf16_t* P; const float* cosT; const float* sinT;
    __device__ __forceinline__ void operator()(const f32x4 (&acc)[2][2][4][2], const Unit& u, int wr, int wc, int fr, int fq) const {
        asm volatile("" : "+v"(fr), "+v"(fq));
        const int row0 = u.pm * BM + wr * 64 + fr, col0 = u.pn * BM + wc * 32 + 8 * fq;
        if (u.pn < 4) {
            const float sc = (u.pn >= 2) ? 0.08838834764831845f : 1.0f;
            const int f0 = 16 * wc + 4 * fq;
#pragma unroll
            for (int ai = 0; ai < 2; ++ai)
#pragma unroll
                for (int m = 0; m < 4; ++m) {
                    const int r = row0 + ai * HALF + m * 16;
                    const int pos = r < TOKP ? (r & 4095) : 4096 + ((r - TOKP) & 15);
                    const f32x4 c4 = *(const f32x4*)(cosT + pos * 64 + f0), s4 = *(const f32x4*)(sinT + pos * 64 + f0);
                    bf16_t* rowp = P + (size_t)r * 3584 + col0;
#pragma unroll
                    for (int bj = 0; bj < 2; ++bj) {
                        const f32x4 x1 = acc[ai][bj][m][0], x2 = acc[ai][bj][m][1];
                        const f32x4 o1 = (x1 * c4 - x2 * s4) * sc, o2 = (x2 * c4 + x1 * s4) * sc;
                        u32x4 w; w.x = cvt_pk_bf16(o1[0], o1[1]); w.y = cvt_pk_bf16(o1[2], o1[3]); w.z = cvt_pk_bf16(o2[0], o2[1]); w.w = cvt_pk_bf16(o2[2], o2[3]);
                        *(u32x4*)(rowp + bj * HALF) = w;
                    }
                }
        } else {
#pragma unroll
            for (int ai = 0; ai < 2; ++ai)
#pragma unroll
                for (int m = 0; m < 4; ++m) {
                    bf16_t* rowp = P + (size_t)(row0 + ai * HALF + m * 16) * 3584 + col0;
#pragma unroll
                    for (int bj = 0; bj < 2; ++bj) {
                        const f32x4 v0 = acc[ai][bj][m][0], v1 = acc[ai][bj][m][1];
                        u32x4 w; w.x = cvt_pk_bf16(v0[0], v0[1]); w.y = cvt_pk_bf16(v0[2], v0[3]); w.z = cvt_pk_bf16(v1[0], v1[1]); w.w = cvt_pk_bf16(v1[2], v1[3]);
                        *(u32x4*)(rowp + bj * HALF) = w;
                    }
                }
        }
    }
};

struct EpiY {
    static constexpr bool PERM = true, AFTER_DRAIN = false;
    bf16_t* Y; float* ssq;
    __device__ __forceinline__ void operator()(const f32x4 (&acc)[2][2][4][2], const Unit& u, int wr, int wc, int fr, int fq) const {
        asm volatile("" : "+v"(fr), "+v"(fq));
        const int row0 = u.pm * BM + wr * 64 + fr, col0 = u.pn * BM + wc * 32 + 8 * fq;
#pragma unroll
        for (int ai = 0; ai < 2; ++ai)
#pragma unroll
            for (int m = 0; m < 4; ++m) {
                const int r = row0 + ai * HALF + m * 16;
                bf16_t* rowp = Y + (size_t)r * 1024 + col0;
                float s = 0.f;
#pragma unroll
                for (int bj = 0; bj < 2; ++bj) {
                    const f32x4 v0 = acc[ai][bj][m][0], v1 = acc[ai][bj][m][1];
                    s += (v0[0] * v0[0] + v0[1] * v0[1]) + (v0[2] * v0[2] + v0[3] * v0[3]) + (v1[0] * v1[0] + v1[1] * v1[1]) + (v1[2] * v1[2] + v1[3] * v1[3]);
                    u32x4 w; w.x = cvt_pk_bf16(v0[0], v0[1]); w.y = cvt_pk_bf16(v0[2], v0[3]); w.z = cvt_pk_bf16(v1[0], v1[1]); w.w = cvt_pk_bf16(v1[2], v1[3]);
                    *(u32x4*)(rowp + bj * HALF) = w;
                }
                s += __shfl_xor(s, 16); s += __shfl_xor(s, 32);
                if (fq == 0) ssq[(size_t)r * 16 + u.pn * 4 + wc] = s;
            }
    }
};

struct EpiFfn {
    static constexpr bool PERM = true, AFTER_DRAIN = false;
    bf16_t* ACT; const float* cw; const float* cache; float* outp; float* outs; PG8_LAS float* halo;
    __device__ __forceinline__ void operator()(const f32x4 (&acc)[2][2][4][2], const Unit& u, int wr, int wc, int fr, int fq) const {
        asm volatile("" : "+v"(fr), "+v"(fq));
        const int lc0 = wc * 32 + 8 * fq, ch0 = u.pn * 128 + lc0;
        const bool sample = (u.pm == 128);
        const int par = u.pm & 1;
        f32x4 w0[2], w1[2], w2[2];
#pragma unroll
        for (int n = 0; n < 2; ++n) { w0[n] = *(const f32x4*)(cw + ch0 + 4 * n); w1[n] = *(const f32x4*)(cw + 4096 + ch0 + 4 * n); w2[n] = *(const f32x4*)(cw + 8192 + ch0 + 4 * n); }
        if (!sample && fr >= 14) {
#pragma unroll
            for (int ai = 0; ai < 2; ++ai) { PG8_LAS float* hp = halo + ((par * 4 + 2 * ai + wr) * 2 + (fr - 14)) * 128 + lc0;
                *(PG8_LAS f32x4*)hp = acc[ai][0][3][0]; *(PG8_LAS f32x4*)(hp + 4) = acc[ai][0][3][1]; }
        }
        asm volatile("s_waitcnt lgkmcnt(0)" ::: "memory"); __builtin_amdgcn_s_barrier(); asm volatile("" ::: "memory");
#pragma unroll
        for (int ai = 0; ai < 2; ++ai) {
            const int blk = 2 * ai + wr;
#pragma unroll
            for (int m = 0; m < 4; ++m) {
                f32x4 pv[2]; pv[0] = (f32x4){0.f, 0.f, 0.f, 0.f}; pv[1] = pv[0];
                const int sb = 8 * ai + 4 * wr + m;
                if (sample) {
                    if (fr >= 14 && sb < 8) { const float* cp = cache + (size_t)(sb * 2 + fr - 14) * 4096 + ch0; pv[0] = *(const f32x4*)cp; pv[1] = *(const f32x4*)(cp + 4); }
                } else if (m == 0) {
                    if (fr >= 14) {
                        const bool zero = (blk == 0) && ((u.pm & 15) == 0);
                        const int hb = (blk == 0) ? ((par ^ 1) * 4 + 3) : (par * 4 + blk - 1);
                        if (!zero) { const PG8_LAS float* hp = halo + (hb * 2 + fr - 14) * 128 + lc0; pv[0] = *(const PG8_LAS f32x4*)hp; pv[1] = *(const PG8_LAS f32x4*)(hp + 4); }
                    }
                } else { pv[0] = acc[ai][0][m - 1][0]; pv[1] = acc[ai][0][m - 1][1]; }
                const int r = u.pm * BM + ai * HALF + wr * 64 + m * 16 + fr;
                float a8[8];
#pragma unroll
                for (int n = 0; n < 2; ++n)
#pragma unroll
                    for (int e = 0; e < 4; ++e) {
                        const float cur = acc[ai][0][m][n][e], pr = pv[n][e];
                        const float p1 = dpp_shr1(cur) + dpp_shl15(pr), p2 = dpp_shr2(cur) + dpp_shl14(pr);
                        const float uc = w0[n][e] * p2 + w1[n][e] * p1 + w2[n][e] * cur;
                        a8[4 * n + e] = gelu_tanh(uc) * acc[ai][1][m][n][e];
                    }
                u32x4 w; w.x = cvt_pk_bf16(a8[0], a8[1]); w.y = cvt_pk_bf16(a8[2], a8[3]); w.z = cvt_pk_bf16(a8[4], a8[5]); w.w = cvt_pk_bf16(a8[6], a8[7]);
                *(u32x4*)(ACT + (size_t)r * 4096 + ch0) = w;
                if (sample) {
                    if (fr >= 14 && sb < 8) { float* op = outs + (size_t)(sb * 2 + fr - 14) * 4096 + ch0; *(f32x4*)op = acc[ai][0][m][0]; *(f32x4*)(op + 4) = acc[ai][0][m][1]; }
                } else if (m == 3 && blk == 3 && (u.pm & 15) == 15 && fr >= 14) {
                    float* op = outp + (size_t)((u.pm >> 4) * 2 + fr - 14) * 4096 + ch0; *(f32x4*)op = acc[ai][0][m][0]; *(f32x4*)(op + 4) = acc[ai][0][m][1];
                }
            }
        }
    }
};
struct WalkOrder {
    int G, c;
    __device__ __forceinline__ bool next(int i, Unit& u) const {
        int w = c, rem = i;
        while (w < 288) { const int len = w < 256 ? 16 : 1;
            if (rem < len) { if (w < 256) { u.pm = (w >> 5) * 16 + rem; u.pn = w & 31; } else { u.pm = 128; u.pn = w - 256; } return true; }
            rem -= len; w += G; }
        return false;
    }
    __device__ __forceinline__ void a_ready(const Unit&) const {}
    __device__ __forceinline__ void done(const Unit&) const {}
};
template <class Epi, class Sched, bool ALIGN_EPI = false, bool SP2 = false>
__device__ __forceinline__ void gemm_phase(PG8_LAS unsigned char* lds, const Gemm g, const Sched& S, const Epi& E) {
    int tid_raw = threadIdx.x; asm volatile("" : "+v"(tid_raw));
    const int tid = tid_raw, wid = __builtin_amdgcn_readfirstlane(tid >> 6), lane = tid & 63, wr = wid >> 2, wc = wid & 3, fr = lane & 15, fq = lane >> 4;
    const int K = g.K, nt = K / BK;
    unsigned voffA[2], voffB[2];
#pragma unroll
    for (int i = 0; i < 2; ++i) { int R, C; stage_rc(tid * 16 + i * 8192, R, C); const int Rb = Epi::PERM ? ((R & ~31) + perm32(R & 31)) : R;
        voffA[i] = (unsigned)(R * K + C) * 2u; voffB[i] = (unsigned)(Rb * K + C) * 2u; }
    const size_t kstep = (size_t)(BK * 2);
    const size_t hstep = (size_t)HALF * K * 2;
    const size_t tstep = 2 * hstep;
    const unsigned ldsw = (unsigned)wid * 1024u;
    const int aoff = lds_byte(wr * 64 + fr, fq * 8), boff = lds_byte(wc * 32 + fr, fq * 8);
#define PG8_SA(b, h) (((b) * 2 + (h)) * HTB)
#define PG8_SB(b, h) ((4 + (b) * 2 + (h)) * HTB)
#define PG8_STAGE(bufoff, gbase, voff) do { _Pragma("unroll") for (int _i = 0; _i < 2; ++_i) \
        __builtin_amdgcn_global_load_lds((const unsigned*)((const char*)(gbase) + (voff)[_i]), (PG8_LAS unsigned*)(lds + (bufoff) + ldsw + _i * 8192), 16, 0, 0); } while (0)
#define PG8_LDA(dst, b, h) do { _Pragma("unroll") for (int m = 0; m < 4; ++m) _Pragma("unroll") for (int k = 0; k < 2; ++k) dst[m][k] = *(const PG8_LAS bf16x8*)(lds + PG8_SA(b, h) + aoff + m * 2048 + k * 1024); } while (0)
#define PG8_LDB(dst, b, h) do { _Pragma("unroll") for (int n = 0; n < 2; ++n) _Pragma("unroll") for (int k = 0; k < 2; ++k) dst[n][k] = *(const PG8_LAS bf16x8*)(lds + PG8_SB(b, h) + boff + n * 2048 + k * 1024); } while (0)
#define PG8_MMA(ai, bj, At, Bt) do { __builtin_amdgcn_s_setprio(1); _Pragma("unroll") for (int m = 0; m < 4; ++m) _Pragma("unroll") for (int n = 0; n < 2; ++n) _Pragma("unroll") for (int k = 0; k < 2; ++k) \
        acc[ai][bj][m][n] = __builtin_amdgcn_mfma_f32_16x16x32_bf16(Bt[n][k], At[m][k], acc[ai][bj][m][n], 0, 0, 0); __builtin_amdgcn_s_setprio(0); } while (0)
#define PG8_WAIT_V(n) asm volatile("s_waitcnt vmcnt(" #n ")" ::: "memory")
#define PG8_WAIT_L(n) asm volatile("s_waitcnt lgkmcnt(" #n ")" ::: "memory")
#define PG8_BAR __builtin_amdgcn_s_barrier()
#define PG8_SCHED __builtin_amdgcn_sched_barrier(0)
    Unit cur, nxt; int ui = 0;
    if (!S.next(0, cur)) return;
    f32x4 acc[2][2][4][2];
#pragma unroll
    for (int a = 0; a < 2; ++a)
#pragma unroll
        for (int b = 0; b < 2; ++b)
#pragma unroll
            for (int m = 0; m < 4; ++m)
#pragma unroll
                for (int n = 0; n < 2; ++n) acc[a][b][m][n] = (f32x4){0.f, 0.f, 0.f, 0.f};
    bf16x8 At[4][2], B0[2][2], B1[2][2];
    const char* cA = (const char*)g.A + (size_t)cur.pm * tstep; const char* cB = (const char*)g.Bt + (size_t)cur.pn * tstep;
    S.a_ready(cur);
    if constexpr (SP2) {
        PG8_STAGE(PG8_SB(0, 0), cB, voffB); PG8_STAGE(PG8_SB(0, 1), cB + hstep, voffB); PG8_STAGE(PG8_SA(0, 0), cA, voffA); PG8_STAGE(PG8_SA(0, 1), cA + hstep, voffA);
        if (wr == 1) PG8_BAR;
        PG8_WAIT_V(2); PG8_BAR;
        PG8_STAGE(PG8_SB(1, 0), cB + kstep, voffB); PG8_STAGE(PG8_SA(1, 0), cA + kstep, voffA); PG8_STAGE(PG8_SB(1, 1), cB + hstep + kstep, voffB);
        PG8_WAIT_V(6); PG8_BAR;
    } else {
        PG8_STAGE(PG8_SB(0, 0), cB, voffB); PG8_STAGE(PG8_SA(0, 0), cA, voffA); PG8_STAGE(PG8_SB(0, 1), cB + hstep, voffB); PG8_STAGE(PG8_SA(0, 1), cA + hstep, voffA);
        if (wr == 1) PG8_BAR;
        PG8_WAIT_V(4); PG8_BAR;
        PG8_STAGE(PG8_SB(1, 0), cB + kstep, voffB); PG8_STAGE(PG8_SA(1, 0), cA + kstep, voffA); PG8_STAGE(PG8_SB(1, 1), cB + hstep + kstep, voffB);
        PG8_WAIT_V(6); PG8_BAR;
    }
    for (;;) {
        const bool has_next = S.next(ui + 1, nxt);
        const char* nA = has_next ? (const char*)g.A + (size_t)nxt.pm * tstep : cA; const char* nB = has_next ? (const char*)g.Bt + (size_t)nxt.pn * tstep : cB;
        for (int t = 0; t < nt; t += 2) {
            const bool last = (t == nt - 2);
            const char* a1 = cA + (size_t)(t + 1) * kstep;
            const char* a2 = last ? nA : cA + (size_t)(t + 2) * kstep; const char* b2 = last ? nB : cB + (size_t)(t + 2) * kstep;
            const char* a3 = a2 + kstep; const char* b3 = b2 + kstep;
            if (last && has_next) S.a_ready(nxt);
            if constexpr (SP2) {
            PG8_LDB(B0, 0, 0); PG8_LDB(B1, 0, 1); PG8_SCHED; PG8_LDA(At, 0, 0); PG8_STAGE(PG8_SA(1, 1), a1 + hstep, voffA);
            PG8_WAIT_V(8); PG8_WAIT_L(0); PG8_BAR; PG8_MMA(0, 0, At, B0); PG8_MMA(0, 1, At, B1); PG8_BAR; PG8_SCHED;
            PG8_LDA(At, 0, 1); PG8_STAGE(PG8_SB(0, 0), b2, voffB); PG8_STAGE(PG8_SB(0, 1), b2 + hstep, voffB); PG8_STAGE(PG8_SA(0, 0), a2, voffA);
            PG8_WAIT_V(8); PG8_WAIT_L(0); PG8_BAR; PG8_MMA(1, 0, At, B0); PG8_MMA(1, 1, At, B1); PG8_BAR; PG8_SCHED;
            PG8_LDB(B0, 1, 0); PG8_LDB(B1, 1, 1); PG8_SCHED; PG8_LDA(At, 1, 0); PG8_STAGE(PG8_SA(0, 1), a2 + hstep, voffA);
            PG8_WAIT_V(8); PG8_WAIT_L(0); PG8_BAR; PG8_MMA(0, 0, At, B0); PG8_MMA(0, 1, At, B1); PG8_BAR; PG8_SCHED;
            PG8_LDA(At, 1, 1); PG8_STAGE(PG8_SB(1, 0), b3, voffB); PG8_STAGE(PG8_SB(1, 1), b3 + hstep, voffB); PG8_STAGE(PG8_SA(1, 0), a3, voffA);
            PG8_WAIT_V(8); PG8_WAIT_L(0); PG8_BAR; PG8_MMA(1, 0, At, B0); PG8_MMA(1, 1, At, B1); PG8_BAR; PG8_SCHED;
            } else {
            PG8_LDB(B0, 0, 0); PG8_SCHED; PG8_LDA(At, 0, 0); PG8_STAGE(PG8_SA(1, 1), a1 + hstep, voffA);
            PG8_WAIT_L(8); PG8_BAR; PG8_WAIT_L(0); PG8_MMA(0, 0, At, B0); PG8_BAR; PG8_SCHED;
            PG8_LDB(B1, 0, 1); PG8_STAGE(PG8_SB(0, 0), b2, voffB);
            PG8_BAR; PG8_WAIT_L(0); PG8_MMA(0, 1, At, B1); PG8_BAR;
            PG8_LDA(At, 0, 1); PG8_STAGE(PG8_SA(0, 0), a2, voffA);
            PG8_BAR; PG8_WAIT_L(0); PG8_MMA(1, 0, At, B0); PG8_BAR; PG8_SCHED;
            PG8_STAGE(PG8_SB(0, 1), b2 + hstep, voffB);
            PG8_WAIT_V(6); PG8_BAR; PG8_MMA(1, 1, At, B1); PG8_BAR;
            PG8_LDB(B0, 1, 0); PG8_SCHED; PG8_LDA(At, 1, 0); PG8_STAGE(PG8_SA(0, 1), a2 + hstep, voffA);
            PG8_WAIT_L(8); PG8_BAR; PG8_WAIT_L(0); PG8_MMA(0, 0, At, B0); PG8_BAR; PG8_SCHED;
            PG8_LDB(B1, 1, 1); PG8_STAGE(PG8_SB(1, 0), b3, voffB);
            PG8_BAR; PG8_WAIT_L(0); PG8_MMA(0, 1, At, B1); PG8_BAR;
            PG8_LDA(At, 1, 1); PG8_STAGE(PG8_SA(1, 0), a3, voffA);
            PG8_BAR; PG8_WAIT_L(0); PG8_MMA(1, 0, At, B0); PG8_BAR; PG8_SCHED;
            PG8_STAGE(PG8_SB(1, 1), b3 + hstep, voffB);
            PG8_WAIT_V(6); PG8_BAR; PG8_MMA(1, 1, At, B1); PG8_BAR;
            }
        }
        if constexpr (ALIGN_EPI) { if (wr == 0) PG8_BAR; }
        if constexpr (!Epi::AFTER_DRAIN) { E(acc, cur, wr, wc, fr, fq); S.done(cur); }
        if (!has_next) break;
#pragma unroll
        for (int a = 0; a < 2; ++a)
#pragma unroll
            for (int b = 0; b < 2; ++b)
#pragma unroll
                for (int m = 0; m < 4; ++m)
#pragma unroll
                    for (int n = 0; n < 2; ++n) acc[a][b][m][n] = (f32x4){0.f, 0.f, 0.f, 0.f};
        cur = nxt; cA = nA; cB = nB; ++ui;
        if constexpr (ALIGN_EPI) { if (wr == 1) PG8_BAR; }
    }
    PG8_WAIT_V(0);
    if constexpr (!ALIGN_EPI) { if (wr == 0) PG8_BAR; }
    PG8_BAR;
    if constexpr (Epi::AFTER_DRAIN) { E.fused(acc, cur, wr, wc, fr, fq, lds, wid, lane); S.done(cur); }
#undef PG8_SA
#undef PG8_SB
#undef PG8_STAGE
#undef PG8_LDA
#undef PG8_LDB
#undef PG8_MMA
#undef PG8_WAIT_V
#undef PG8_WAIT_L
#undef PG8_BAR
#undef PG8_SCHED
}
}

using pg8::bf16_t; using pg8::bf16x8; using pg8::f32x4; using pg8::u32x4;
#define LAS __attribute__((address_space(3)))
typedef unsigned u32x2 __attribute__((ext_vector_type(2)));
constexpr int DM = 1024, NIN = 3584, DFF = 4096;
constexpr int TOK_P = 32768, TOK = 32896, TOKPAD = 33024;
constexpr float EPS = 1e-6f;
constexpr size_t WS_WIN = 4096;
constexpr size_t WS_WOUT = WS_WIN + (size_t)NIN * DM * 2;
constexpr size_t WS_WFF1 = WS_WOUT + (size_t)DM * DM * 2;
constexpr size_t WS_WDN = WS_WFF1 + (size_t)2 * DFF * DM * 2;
constexpr size_t WS_COS = WS_WDN + (size_t)DM * DFF * 2;
constexpr size_t WS_SIN = WS_COS + (size_t)4112 * 64 * 4;
constexpr size_t WS_SSQ1 = WS_SIN + (size_t)4112 * 64 * 4;
constexpr size_t WS_SSQ2 = WS_SSQ1 + (size_t)TOKPAD * 16 * 4;
constexpr size_t WS_UG = WS_SSQ2 + (size_t)TOKPAD * 16 * 4;
constexpr size_t WS_RA = WS_UG + (size_t)256 * 65536;
constexpr size_t WS_RB = WS_RA + (size_t)TOKPAD * DM * 2;
constexpr size_t WS_END = WS_RB + (size_t)TOKPAD * DFF * 2;
constexpr size_t O_SRP = (size_t)TOK * DM, O_CCP = O_SRP + 524288, O_CFP = O_CCP + 8192, O_SRS = O_CFP + 65536, O_CCS = O_SRS + 524288, O_CFS = O_CCS + 8192;
constexpr int LDS_HALO = 131072, LDS_BYTES = 131072 + 8192;

struct Params { const float* in[17]; float* out; unsigned char* ws; };

__device__ __forceinline__ float wave_sum(float v) {
#pragma unroll
    for (int o = 1; o < 64; o <<= 1) v += __shfl_xor(v, o);
    return v;
}
__device__ __forceinline__ float bf2f(unsigned short b) { return __uint_as_float(((unsigned)b) << 16); }
__device__ __forceinline__ unsigned pk2(float a, float b) { return pg8::cvt_pk_bf16(a, b); }
__device__ __forceinline__ float silu_f(float g) { return g * __builtin_amdgcn_rcpf(1.0f + __builtin_amdgcn_exp2f(-1.4426950408889634f * g)); }
__device__ __forceinline__ int dmap(int P) { return ((P >> 2) & 1) * 64 + (P >> 3) * 4 + (P & 3); }
__device__ __forceinline__ int pmap(int d) { return ((d >> 4) & 3) * 32 + ((d >> 2) & 3) * 8 + ((d >> 6) & 1) * 4 + (d & 3); }

template <int MODE> __device__ __forceinline__ int rowmap(int c) {
    if (MODE == 0) { if (c < 1024) return (c & ~127) + pmap(c & 127); return c; }
    if (MODE == 1) return c;
    if (MODE == 2) return ((c >> 7) << 8) + (c & 127);
    return ((c >> 7) << 8) + 128 + (c & 127);
}
template <int MODE>
__device__ __forceinline__ void transpose_item(const float* W, int K, int N, bf16_t* WT, LAS float* scr, int item, int lane) {
    const int nblk = N / 32, kb = item / nblk, nb = item % nblk, k0 = 64 * kb, n0 = 32 * nb;
#pragma unroll 8
    for (int i = 0; i < 32; ++i) { const int kk = 2 * i + (lane >> 5); scr[kk * 33 + (lane & 31)] = W[(size_t)(k0 + kk) * N + n0 + (lane & 31)]; }
    asm volatile("s_waitcnt lgkmcnt(0)" ::: "memory");
    const int c = lane & 7;
#pragma unroll
    for (int j = 0; j < 4; ++j) { const int n = (lane >> 3) + 8 * j; const LAS float* s = scr + (8 * c) * 33 + n;
        u32x4 o; o.x = pk2(s[0 * 33], s[1 * 33]); o.y = pk2(s[2 * 33], s[3 * 33]); o.z = pk2(s[4 * 33], s[5 * 33]); o.w = pk2(s[6 * 33], s[7 * 33]);
        *(u32x4*)(WT + (size_t)rowmap<MODE>(n0 + n) * K + k0 + 8 * c) = o; }
    asm volatile("s_waitcnt lgkmcnt(0)" ::: "memory");
}
__device__ __forceinline__ void phase0(const Params& p, LAS unsigned char* lds, int tid, int wid, int lane) {
    LAS float* scr = (LAS float*)(lds + wid * 8448);
    const int gw = blockIdx.x * 8 + wid, NGW = gridDim.x * 8;
    bf16_t* win = (bf16_t*)(p.ws + WS_WIN); bf16_t* wout = (bf16_t*)(p.ws + WS_WOUT); bf16_t* wff1 = (bf16_t*)(p.ws + WS_WFF1); bf16_t* wdn = (bf16_t*)(p.ws + WS_WDN);
    constexpr int I_IN = 16 * 112, I_OUT = 16 * 32, I_UP = 16 * 128, I_DN = 64 * 32, NITEMS = I_IN + I_OUT + 2 * I_UP + I_DN;
    for (int it = gw; it < NITEMS; it += NGW) {
        int r = it;
        if (r < I_IN) { transpose_item<0>(p.in[5], DM, NIN, win, scr, r, lane); continue; } r -= I_IN;
        if (r < I_OUT) { transpose_item<1>(p.in[6], DM, DM, wout, scr, r, lane); continue; } r -= I_OUT;
        if (r < I_UP) { transpose_item<2>(p.in[13], DM, DFF, wff1, scr, r, lane); continue; } r -= I_UP;
        if (r < I_UP) { transpose_item<3>(p.in[14], DM, DFF, wff1, scr, r, lane); continue; } r -= I_UP;
        transpose_item<1>(p.in[16], DFF, DM, wdn, scr, r, lane);
    }
    float* cosT = (float*)(p.ws + WS_COS); float* sinT = (float*)(p.ws + WS_SIN);
    for (int idx = blockIdx.x * 512 + tid; idx < 4112 * 64; idx += gridDim.x * 512) {
        const int pos = idx >> 6, f = idx & 63;
        const float inv = exp2f(-(float)(2 * f) * (1.0f / 128.0f) * 13.287712379549449f);
        const float ang = (float)pos * inv;
        const double rev = (double)ang * 0.15915494309189535;
        const float fr = (float)(rev - floor(rev));
        cosT[idx] = __builtin_amdgcn_cosf(fr); sinT[idx] = __builtin_amdgcn_sinf(fr);
    }
    bf16_t* H = (bf16_t*)(p.ws + WS_RA);
    const float* wpre = p.in[9];
    for (int r = gw; r < TOKPAD; r += NGW) {
        u32x2* o8 = (u32x2*)(H + (size_t)r * DM) + lane;
        if (r >= TOK) {
#pragma unroll
            for (int j = 0; j < 4; ++j) o8[64 * j] = (u32x2){0u, 0u};
            continue; }
        const float* xrow = r < TOK_P ? p.in[0] + (size_t)r * DM : p.in[1] + (size_t)(r - TOK_P) * DM;
        f32x4 v[4]; float s = 0.f;
#pragma unroll
        for (int j = 0; j < 4; ++j) { v[j] = *((const f32x4*)xrow + lane + 64 * j); s += (v[j][0] * v[j][0] + v[j][1] * v[j][1]) + (v[j][2] * v[j][2] + v[j][3] * v[j][3]); }
        const float rstd = rsqrtf(wave_sum(s) * (1.0f / DM) + EPS);
#pragma unroll
        for (int j = 0; j < 4; ++j) { const f32x4 w = *((const f32x4*)wpre + lane + 64 * j); const f32x4 y = (v[j] * rstd) * w;
            o8[64 * j] = (u32x2){pk2(y[0], y[1]), pk2(y[2], y[3])}; }
    }
}

constexpr int QI_OFF = 0, KI_OFF = 17408, KT_OFF = 34816, VT_OFF = 53248, SI_OFF = 71680, ST_OFF = 80896;
#define MFMA16(a, b, c) __builtin_amdgcn_mfma_f32_16x16x32_bf16((a), (b), (c), 0, 0, 0)
template <bool FULL>
__device__ __forceinline__ void ret_unit(const Params& p, LAS unsigned char* lds, int unit, int tid, int wid, int lane) {
    asm volatile("" : "+v"(tid), "+v"(lane));
    const int G = unit & 7, h = (unit >> 3) & 3, b = unit >> 5;
    const bf16_t* P = (const bf16_t*)(p.ws + WS_RB);
    bf16_t* MIX = (bf16_t*)(p.ws + WS_RA);
    float* UG = (float*)(p.ws + WS_UG);
    const size_t tok0 = (size_t)b * 4096 + (size_t)G * 512;
    const float l2g = log2f(1.0f - exp2f(-5.0f - (float)h));
    const float g64 = __builtin_amdgcn_exp2f(l2g * 64.0f);
    const bool is_state = wid >= 4; const int w4 = wid & 3;
    const int l15 = lane & 15, l4 = lane >> 4;
    const int vtL = l4 ^ (l15 >> 3);
    const int vtb0 = VT_OFF + l15 * 144 + 16 * vtL, vtb1 = VT_OFF + l15 * 144 + 16 * (vtL ^ 2);
#define VT_ADDR(nt, ks) ((((nt) & 1) ? vtb1 : vtb0) + (nt) * 2304 + 16 * (((4 * (ks)) ^ (2 * ((nt) & 3))) & 4))
    f32x4 st[2][8];
#pragma unroll
    for (int mt = 0; mt < 2; ++mt)
#pragma unroll
        for (int nt = 0; nt < 8; ++nt) st[mt][nt] = (f32x4){0.f, 0.f, 0.f, 0.f};
    if (FULL && is_state) {
#pragma unroll 1
        for (int Gp = 0; Gp < G; ++Gp) {
            const float wgt = __builtin_amdgcn_exp2f(l2g * 512.0f * (float)(G - 1 - Gp));
            const float* src = UG + ((size_t)((b * 4 + h) * 8 + Gp) * 4 + w4) * 4096 + lane;
#pragma unroll
            for (int mt = 0; mt < 2; ++mt)
#pragma unroll
                for (int nt = 0; nt < 8; ++nt)
#pragma unroll
                    for (int r = 0; r < 4; ++r) st[mt][nt][r] += wgt * src[((mt * 8 + nt) * 4 + r) * 64];
        }
    }
    float rwv[8];
#pragma unroll
    for (int nt = 0; nt < 8; ++nt) rwv[nt] = p.in[8][128 * h + 16 * nt + l15];
    u32x4 rq[2], rk[2], rv[2];
#pragma unroll
    for (int i = 0; i < 2; ++i) { const int idx = tid + 512 * i, j = idx >> 4, ch = idx & 15; const bf16_t* rowp = P + (tok0 + j) * NIN + 128 * h + ch * 8;
        if (FULL) rq[i] = *(const u32x4*)rowp; rk[i] = *(const u32x4*)(rowp + 512); rv[i] = *(const u32x4*)(rowp + 1024); }
#pragma unroll 1
    for (int n = 0; n < 8; ++n) {
#pragma unroll
        for (int i = 0; i < 2; ++i) { const int idx = tid + 512 * i, j = idx >> 4, ch = idx & 15;
            if (FULL) { *(LAS u32x4*)(lds + QI_OFF + j * 272 + ch * 16) = rq[i]; *(LAS u32x4*)(lds + KI_OFF + j * 272 + ch * 16) = rk[i]; }
            const float te = __builtin_amdgcn_exp2f(l2g * (float)(63 - j));
            const unsigned kw[4] = {rk[i].x, rk[i].y, rk[i].z, rk[i].w}, vw[4] = {rv[i].x, rv[i].y, rv[i].z, rv[i].w};
            const int cofs = 16 * ((j >> 3) ^ (ch & 7)) + 2 * (j & 7);
#pragma unroll
            for (int e2 = 0; e2 < 4; ++e2) {
                const unsigned kk = pk2(__uint_as_float(kw[e2] << 16) * te, __uint_as_float(kw[e2] & 0xffff0000u) * te);
                const int row = 8 * ch + 2 * e2;
                *(LAS unsigned short*)(lds + KT_OFF + row * 144 + cofs) = (unsigned short)(kk & 0xffffu);
                *(LAS unsigned short*)(lds + KT_OFF + (row + 1) * 144 + cofs) = (unsigned short)(kk >> 16);
                *(LAS unsigned short*)(lds + VT_OFF + row * 144 + cofs) = (unsigned short)(vw[e2] & 0xffffu);
                *(LAS unsigned short*)(lds + VT_OFF + (row + 1) * 144 + cofs) = (unsigned short)(vw[e2] >> 16);
            }
        }
        if (FULL && is_state) {
#pragma unroll
            for (int mt = 0; mt < 2; ++mt)
#pragma unroll
                for (int nt = 0; nt < 8; ++nt) { const int e = 16 * nt + l15, dk0 = 32 * w4 + 16 * mt + 4 * l4;
                    *(LAS u32x2*)(lds + ST_OFF + e * 272 + dk0 * 2) = (u32x2){pk2(st[mt][nt][0], st[mt][nt][1]), pk2(st[mt][nt][2], st[mt][nt][3])}; }
        }
        __syncthreads();
        if (n + 1 < 8) {
#pragma unroll
            for (int i = 0; i < 2; ++i) { const int idx = tid + 512 * i, j = idx >> 4, ch = idx & 15; const bf16_t* rowp = P + (tok0 + (n + 1) * 64 + j) * NIN + 128 * h + ch * 8;
                if (FULL) rq[i] = *(const u32x4*)rowp; rk[i] = *(const u32x4*)(rowp + 512); rv[i] = *(const u32x4*)(rowp + 1024); }
        }
        f32x4 cr[8];
#pragma unroll
        for (int nt = 0; nt < 8; ++nt) cr[nt] = (f32x4){0.f, 0.f, 0.f, 0.f};
        if (FULL) {
            if (!is_state) {
                bf16x8 aq[4];
#pragma unroll
                for (int ks = 0; ks < 4; ++ks) aq[ks] = *(const LAS bf16x8*)(lds + QI_OFF + (16 * w4 + l15) * 272 + (32 * ks + 8 * l4) * 2);
#pragma unroll
                for (int nt = 0; nt < 8; ++nt)
#pragma unroll
                    for (int ks = 0; ks < 4; ++ks) { const bf16x8 bs = *(const LAS bf16x8*)(lds + ST_OFF + (16 * nt + l15) * 272 + (32 * ks + 8 * l4) * 2); cr[nt] = MFMA16(aq[ks], bs, cr[nt]); }
            } else {
                bf16x8 ak[4];
#pragma unroll
                for (int ks = 0; ks < 4; ++ks) ak[ks] = *(const LAS bf16x8*)(lds + KI_OFF + (16 * w4 + l15) * 272 + (32 * ks + 8 * l4) * 2);
#pragma unroll
                for (int it = 0; it < 4; ++it) {
                    f32x4 sa = (f32x4){0.f, 0.f, 0.f, 0.f};
#pragma unroll
                    for (int ks = 0; ks < 4; ++ks) { const bf16x8 bq = *(const LAS bf16x8*)(lds + QI_OFF + (16 * it + l15) * 272 + (32 * ks + 8 * l4) * 2); sa = MFMA16(ak[ks], bq, sa); }
                    const int i = 16 * it + l15, j0 = 16 * w4 + 4 * l4;
#pragma unroll
                    for (int r = 0; r < 4; ++r) { const int d = i - (j0 + r); sa[r] *= __builtin_amdgcn_exp2f(l2g * (float)(d < 0 ? -d : d)); }
                    *(LAS u32x2*)(lds + SI_OFF + i * 144 + j0 * 2) = (u32x2){pk2(sa[0], sa[1]), pk2(sa[2], sa[3])};
                }
            }
        }
        __syncthreads();
        if (!is_state) {
            if (FULL) {
                f32x4 itr[8];
#pragma unroll
                for (int nt = 0; nt < 8; ++nt) itr[nt] = (f32x4){0.f, 0.f, 0.f, 0.f};
                bf16x8 as_[2];
#pragma unroll
                for (int ks = 0; ks < 2; ++ks) as_[ks] = *(const LAS bf16x8*)(lds + SI_OFF + (16 * w4 + l15) * 144 + 16 * (4 * ks + l4));
#pragma unroll
                for (int nt = 0; nt < 8; ++nt)
#pragma unroll
                    for (int ks = 0; ks < 2; ++ks) { const bf16x8 bv = *(const LAS bf16x8*)(lds + VT_ADDR(nt, ks)); itr[nt] = MFMA16(as_[ks], bv, itr[nt]); }
#pragma unroll
                for (int r = 0; r < 4; ++r) {
                    const int i = 16 * w4 + 4 * l4 + r;
                    const float fs = __builtin_amdgcn_exp2f(l2g * (float)(i + 1));
                    float ov[8]; float ss = 0.f;
#pragma unroll
                    for (int nt = 0; nt < 8; ++nt) { ov[nt] = itr[nt][r] + fs * cr[nt][r]; ss += ov[nt] * ov[nt]; }
                    ss += __shfl_xor(ss, 1); ss += __shfl_xor(ss, 2); ss += __shfl_xor(ss, 4); ss += __shfl_xor(ss, 8);
                    const float rstd = rsqrtf(ss * (1.0f / 128.0f) + EPS);
                    const size_t token = tok0 + (size_t)n * 64 + i;
                    const bf16_t* gp = P + token * NIN + 1536 + 128 * h + l15;
                    bf16_t* mp = MIX + token * DM + 128 * h + l15;
#pragma unroll
                    for (int nt = 0; nt < 8; ++nt) { const float gq = bf2f(gp[16 * nt]); mp[16 * nt] = (bf16_t)(pk2(ov[nt] * rstd * rwv[nt] * silu_f(gq), 0.f) & 0xffffu); }
                }
            }
        } else {
#pragma unroll
            for (int mt = 0; mt < 2; ++mt)
#pragma unroll
                for (int nt = 0; nt < 8; ++nt) st[mt][nt] = st[mt][nt] * g64;
#pragma unroll
            for (int ks = 0; ks < 2; ++ks) {
                bf16x8 akt[2];
#pragma unroll
                for (int mt = 0; mt < 2; ++mt) { const int row = 32 * w4 + 16 * mt + l15; akt[mt] = *(const LAS bf16x8*)(lds + KT_OFF + row * 144 + 16 * ((4 * ks + l4) ^ ((row >> 3) & 7))); }
#pragma unroll
                for (int nt = 0; nt < 8; ++nt) { const bf16x8 bv = *(const LAS bf16x8*)(lds + VT_ADDR(nt, ks));
#pragma unroll
                    for (int mt = 0; mt < 2; ++mt) st[mt][nt] = MFMA16(akt[mt], bv, st[mt][nt]); }
            }
        }
        __syncthreads();
    }
    if (is_state) {
        if (!FULL) {
            float* dst = UG + ((size_t)unit * 4 + w4) * 4096 + lane;
#pragma unroll
            for (int mt = 0; mt < 2; ++mt)
#pragma unroll
                for (int nt = 0; nt < 8; ++nt)
#pragma unroll
                    for (int r = 0; r < 4; ++r) dst[((mt * 8 + nt) * 4 + r) * 64] = st[mt][nt][r];
        } else if (G == 7) {
            float* o = p.out + O_SRP + (size_t)(b * 4 + h) * 16384 + (64 * (l4 & 1) + 16 * w4 + 4 * (l4 >> 1)) * 128 + l15;
#pragma unroll
            for (int mt = 0; mt < 2; ++mt)
#pragma unroll
                for (int nt = 0; nt < 8; ++nt)
#pragma unroll
                    for (int r = 0; r < 4; ++r) o[(8 * mt + r) * 128 + 16 * nt] = st[mt][nt][r];
        }
    }
    if (FULL) {
        const int c0 = 128 * h + 8 * (tid & 15), run = tid >> 4, t0 = G * 512 + run * 16;
        const float* cwp = p.in[7];
        float w0[8], w1[8], w2[8], p1[8], p2[8];
#pragma unroll
        for (int e = 0; e < 8; ++e) { w0[e] = cwp[c0 + e]; w1[e] = cwp[512 + c0 + e]; w2[e] = cwp[1024 + c0 + e]; p1[e] = 0.f; p2[e] = 0.f; }
        if (t0 > 0) {
            const bf16_t* r2 = P + ((size_t)b * 4096 + t0 - 2) * NIN; const bf16_t* r1 = r2 + NIN;
            const u32x4 c2 = *(const u32x4*)(r2 + 2560 + c0), h2 = *(const u32x4*)(r2 + 3072 + c0), c1 = *(const u32x4*)(r1 + 2560 + c0), h1 = *(const u32x4*)(r1 + 3072 + c0);
            const unsigned c2w[4] = {c2.x, c2.y, c2.z, c2.w}, h2w[4] = {h2.x, h2.y, h2.z, h2.w}, c1w[4] = {c1.x, c1.y, c1.z, c1.w}, h1w[4] = {h1.x, h1.y, h1.z, h1.w};
#pragma unroll
            for (int e = 0; e < 4; ++e) {
                p2[2 * e] = __uint_as_float(c2w[e] << 16) * __uint_as_float(h2w[e] << 16); p2[2 * e + 1] = __uint_as_float(c2w[e] & 0xffff0000u) * __uint_as_float(h2w[e] & 0xffff0000u);
                p1[2 * e] = __uint_as_float(c1w[e] << 16) * __uint_as_float(h1w[e] << 16); p1[2 * e + 1] = __uint_as_float(c1w[e] & 0xffff0000u) * __uint_as_float(h1w[e] & 0xffff0000u); }
        }
#pragma unroll 1
        for (int t = 0; t < 16; ++t) {
            const size_t row = (size_t)b * 4096 + t0 + t;
            const bf16_t* rp = P + row * NIN;
            const u32x4 bb = *(const u32x4*)(rp + 2048 + c0), cc = *(const u32x4*)(rp + 2560 + c0), hh = *(const u32x4*)(rp + 3072 + c0);
            const unsigned bw[4] = {bb.x, bb.y, bb.z, bb.w}, cw4[4] = {cc.x, cc.y, cc.z, cc.w}, hw[4] = {hh.x, hh.y, hh.z, hh.w};
            float y[8];
#pragma unroll
            for (int e = 0; e < 4; ++e) {
                const float ca = __uint_as_float(cw4[e] << 16) * __uint_as_float(hw[e] << 16), cb = __uint_as_float(cw4[e] & 0xffff0000u) * __uint_as_float(hw[e] & 0xffff0000u);
                y[2 * e] = __uint_as_float(bw[e] << 16) * (w0[2 * e] * p2[2 * e] + w1[2 * e] * p1[2 * e] + w2[2 * e] * ca);
                y[2 * e + 1] = __uint_as_float(bw[e] & 0xffff0000u) * (w0[2 * e + 1] * p2[2 * e + 1] + w1[2 * e + 1] * p1[2 * e + 1] + w2[2 * e + 1] * cb);
                p2[2 * e] = p1[2 * e]; p2[2 * e + 1] = p1[2 * e + 1]; p1[2 * e] = ca; p1[2 * e + 1] = cb;
            }
            *(u32x4*)(MIX + row * DM + 512 + c0) = (u32x4){pk2(y[0], y[1]), pk2(y[2], y[3]), pk2(y[4], y[5]), pk2(y[6], y[7])};
        }
        if (G == 7 && run == 31) {
            float* o = p.out + O_CCP + (size_t)b * 1024 + c0;
#pragma unroll
            for (int e = 0; e < 8; ++e) { o[e] = p2[e]; o[512 + e] = p1[e]; }
        }
    }
}

__device__ __forceinline__ float ch_at(const bf16_t* P, const float* cache, int b, int ts0, int t, int ch) {
    if (t < 0) return cache[(b * 2 + (t + 2)) * 512 + ch];
    const bf16_t* rp = P + (size_t)(ts0 + t) * NIN;
    return bf2f(rp[2560 + ch]) * bf2f(rp[3072 + ch]);
}
__device__ __forceinline__ void sample_unit(const Params& p, LAS unsigned char* lds, int su, int tid, int wid, int lane) {
    const int b = su >> 2, h = su & 3, ts0 = TOK_P + 16 * b;
    const bf16_t* P = (const bf16_t*)(p.ws + WS_RB);
    bf16_t* MIX = (bf16_t*)(p.ws + WS_RA);
    LAS float* qs = (LAS float*)lds; LAS float* ks = qs + 2048; LAS float* vs = qs + 4096; LAS float* Ssm = qs + 6144; LAS float* osm = qs + 6400;
    const float l2g = log2f(1.0f - exp2f(-5.0f - (float)h));
    for (int idx = tid; idx < 2048; idx += 512) { const int i = idx >> 7, c = idx & 127; const bf16_t* rp = P + (size_t)(ts0 + i) * NIN + 128 * h + c;
        qs[i * 128 + dmap(c)] = bf2f(rp[0]); ks[i * 128 + dmap(c)] = bf2f(rp[512]); vs[i * 128 + c] = bf2f(rp[1024]); }
    __syncthreads();
    if (tid < 256) { const int i = tid >> 4, j = tid & 15; float s = 0.f;
        for (int d = 0; d < 128; ++d) s += qs[i * 128 + d] * ks[j * 128 + d];
        const int dd = i - j; Ssm[i * 16 + j] = s * __builtin_amdgcn_exp2f(l2g * (float)(dd < 0 ? -dd : dd)); }
    const int e = tid & 127, ig = tid >> 7;
    const float* s0 = p.in[2] + (size_t)su * 16384;
    float cr[4] = {0.f, 0.f, 0.f, 0.f};
    for (int d = 0; d < 128; ++d) { const float sv = s0[d * 128 + e];
#pragma unroll
        for (int r = 0; r < 4; ++r) cr[r] += qs[(ig * 4 + r) * 128 + d] * sv; }
    __syncthreads();
#pragma unroll
    for (int r = 0; r < 4; ++r) { const int i = ig * 4 + r; float o = 0.f;
        for (int j = 0; j < 16; ++j) o += Ssm[i * 16 + j] * vs[j * 128 + e];
        osm[i * 128 + e] = o + __builtin_amdgcn_exp2f(l2g * (float)(i + 1)) * cr[r]; }
    __syncthreads();
    for (int rr = 0; rr < 2; ++rr) { const int i = 2 * wid + rr; const float v0 = osm[i * 128 + lane], v1 = osm[i * 128 + 64 + lane];
        const float rstd = rsqrtf(wave_sum(v0 * v0 + v1 * v1) * (1.0f / 128.0f) + EPS);
        const size_t token = (size_t)(ts0 + i);
        const float g0 = bf2f(P[token * NIN + 1536 + 128 * h + lane]), g1 = bf2f(P[token * NIN + 1536 + 128 * h + 64 + lane]);
        MIX[token * DM + 128 * h + lane] = (bf16_t)(pk2(v0 * rstd * p.in[8][128 * h + lane] * silu_f(g0), 0.f) & 0xffffu);
        MIX[token * DM + 128 * h + 64 + lane] = (bf16_t)(pk2(v1 * rstd * p.in[8][128 * h + 64 + lane] * silu_f(g1), 0.f) & 0xffffu); }
    const float g16 = __builtin_amdgcn_exp2f(l2g * 16.0f);
    float* outS = p.out + O_SRS + (size_t)su * 16384;
    for (int dd = 0; dd < 32; ++dd) { const int d = ig + 4 * dd; float a = g16 * s0[d * 128 + e];
        for (int j = 0; j < 16; ++j) a += __builtin_amdgcn_exp2f(l2g * (float)(15 - j)) * ks[j * 128 + d] * vs[j * 128 + e];
        outS[d * 128 + e] = a; }
    const int ch = 128 * h + e; const float* cache = p.in[3]; const float* cwp = p.in[7];
    const float w0 = cwp[ch], w1 = cwp[512 + ch], w2 = cwp[1024 + ch];
    for (int tt = 0; tt < 4; ++tt) { const int t = ig * 4 + tt;
        const float c0 = ch_at(P, cache, b, ts0, t - 2, ch), c1 = ch_at(P, cache, b, ts0, t - 1, ch), c2 = ch_at(P, cache, b, ts0, t, ch);
        const float y = bf2f(P[(size_t)(ts0 + t) * NIN + 2048 + ch]) * (w0 * c0 + w1 * c1 + w2 * c2);
        MIX[(size_t)(ts0 + t) * DM + 512 + ch] = (bf16_t)(pk2(y, 0.f) & 0xffffu);
        if (t >= 14) p.out[O_CCS + (size_t)(b * 2 + t - 14) * 512 + ch] = c2; }
    __syncthreads();
}

__device__ __forceinline__ void phase4(const Params& p, int wid, int lane) {
    const int gw = blockIdx.x * 8 + wid, NGW = gridDim.x * 8;
    const bf16_t* Y = (const bf16_t*)(p.ws + WS_RB); bf16_t* H2 = (bf16_t*)(p.ws + WS_RA); const float* ssq = (const float*)(p.ws + WS_SSQ1);
    const float* wpost = p.in[10]; const float* wpre = p.in[11];
    for (int r = gw; r < TOKPAD; r += NGW) {
        u32x2* o8 = (u32x2*)(H2 + (size_t)r * DM) + lane;
        if (r >= TOK) {
#pragma unroll
            for (int j = 0; j < 4; ++j) o8[64 * j] = (u32x2){0u, 0u};
            continue; }
        const float* xrow = r < TOK_P ? p.in[0] + (size_t)r * DM : p.in[1] + (size_t)(r - TOK_P) * DM;
        const float tot = wave_sum(lane < 16 ? ssq[(size_t)r * 16 + lane] : 0.f);
        const float rstd1 = rsqrtf(tot * (1.0f / DM) + EPS);
        f32x4 v[4]; float s2 = 0.f;
#pragma unroll
        for (int j = 0; j < 4; ++j) {
            const f32x4 xv = *((const f32x4*)xrow + lane + 64 * j); const u32x2 yw = *((const u32x2*)(Y + (size_t)r * DM) + lane + 64 * j); const f32x4 w = *((const f32x4*)wpost + lane + 64 * j);
            f32x4 yv; yv[0] = __uint_as_float(yw.x << 16); yv[1] = __uint_as_float(yw.x & 0xffff0000u); yv[2] = __uint_as_float(yw.y << 16); yv[3] = __uint_as_float(yw.y & 0xffff0000u);
            v[j] = xv + (yv * rstd1) * w;
            s2 += (v[j][0] * v[j][0] + v[j][1] * v[j][1]) + (v[j][2] * v[j][2] + v[j][3] * v[j][3]);
            *((f32x4*)(p.out + (size_t)r * DM) + lane + 64 * j) = v[j];
        }
        const float rstd2 = rsqrtf(wave_sum(s2) * (1.0f / DM) + EPS);
#pragma unroll
        for (int j = 0; j < 4; ++j) { const f32x4 w = *((const f32x4*)wpre + lane + 64 * j); const f32x4 y = (v[j] * rstd2) * w; o8[64 * j] = (u32x2){pk2(y[0], y[1]), pk2(y[2], y[3])}; }
    }
}
__device__ __forceinline__ void phase7(const Params& p, int wid, int lane) {
    const int gw = blockIdx.x * 8 + wid, NGW = gridDim.x * 8;
    const bf16_t* F = (const bf16_t*)(p.ws + WS_RA); const float* ssq = (const float*)(p.ws + WS_SSQ2); const float* wpost = p.in[12];
    for (int r = gw; r < TOK; r += NGW) {
        const float tot = wave_sum(lane < 16 ? ssq[(size_t)r * 16 + lane] : 0.f);
        const float rstd = rsqrtf(tot * (1.0f / DM) + EPS);
#pragma unroll
        for (int j = 0; j < 4; ++j) {
            f32x4* op = (f32x4*)(p.out + (size_t)r * DM) + lane + 64 * j;
            const f32x4 xv = *op; const u32x2 yw = *((const u32x2*)(F + (size_t)r * DM) + lane + 64 * j); const f32x4 w = *((const f32x4*)wpost + lane + 64 * j);
            f32x4 yv; yv[0] = __uint_as_float(yw.x << 16); yv[1] = __uint_as_float(yw.x & 0xffff0000u); yv[2] = __uint_as_float(yw.y << 16); yv[3] = __uint_as_float(yw.y & 0xffff0000u);
            *op = xv + (yv * rstd) * w;
        }
    }
}

#ifndef MK_LAUNCHES
#define MK_LAUNCHES 1
#endif
template <int PH_LO, int PH_HI>
__device__ __forceinline__ void run_phases(const Params& p, LAS unsigned char* lds) {
    int tid = threadIdx.x, lane = tid & 63; const int wid = __builtin_amdgcn_readfirstlane(tid >> 6);
    const int G = gridDim.x, c = blockIdx.x;
#define LAUNDER() asm volatile("" : "+v"(tid), "+v"(lane))
#define SEAM(ph) do { if (PH_LO <= (ph) && (ph) + 1 < PH_HI) { cg::this_grid().sync(); } } while (0)
    if (PH_LO <= 0 && 0 < PH_HI) { LAUNDER(); phase0(p, lds, tid, wid, lane); }
    SEAM(0);
    if (PH_LO <= 1 && 1 < PH_HI) {
        pg8::Gemm g{(const bf16_t*)(p.ws + WS_RA), (const bf16_t*)(p.ws + WS_WIN), TOKPAD, NIN, DM};
        pg8::StaticOrder S; S.init(TOKPAD, NIN, G, c);
        pg8::EpiIn E{(bf16_t*)(p.ws + WS_RB), (const float*)(p.ws + WS_COS), (const float*)(p.ws + WS_SIN)};
        pg8::gemm_phase<pg8::EpiIn, pg8::StaticOrder, true, true>(lds, g, S, E);
    }
    SEAM(1);
    if (PH_LO <= 2 && 2 < PH_HI) {
        for (int u = c; u < 256; u += G) ret_unit<false>(p, lds, u, tid, wid, lane);
        LAUNDER();
        for (int su = c; su < 32; su += G) sample_unit(p, lds, su, tid, wid, lane);
    }
    SEAM(2);
    if (PH_LO <= 3 && 3 < PH_HI) {
        for (int u = c; u < 256; u += G) ret_unit<true>(p, lds, u, tid, wid, lane);
    }
    SEAM(3);
    if (PH_LO <= 4 && 4 < PH_HI) {
        pg8::Gemm g{(const bf16_t*)(p.ws + WS_RA), (const bf16_t*)(p.ws + WS_WOUT), TOKPAD, DM, DM};
        pg8::StaticOrder S; S.init(TOKPAD, DM, G, c);
        pg8::EpiY E{(bf16_t*)(p.ws + WS_RB), (float*)(p.ws + WS_SSQ1)};
        pg8::gemm_phase<pg8::EpiY, pg8::StaticOrder, true, true>(lds, g, S, E);
    }
    SEAM(4);
    if (PH_LO <= 5 && 5 < PH_HI) { LAUNDER(); phase4(p, wid, lane); }
    SEAM(5);
    if (PH_LO <= 6 && 6 < PH_HI) {
        pg8::Gemm g{(const bf16_t*)(p.ws + WS_RA), (const bf16_t*)(p.ws + WS_WFF1), TOKPAD, 2 * DFF, DM};
        pg8::WalkOrder S{G, c};
        pg8::EpiFfn E{(bf16_t*)(p.ws + WS_RB), p.in[15], p.in[4], p.out + O_CFP, p.out + O_CFS, (LAS float*)(lds + LDS_HALO)};
        pg8::gemm_phase<pg8::EpiFfn, pg8::WalkOrder, true, true>(lds, g, S, E);
    }
    SEAM(6);
    if (PH_LO <= 7 && 7 < PH_HI) {
        pg8::Gemm g{(const bf16_t*)(p.ws + WS_RB), (const bf16_t*)(p.ws + WS_WDN), TOKPAD, DM, DFF};
        pg8::StaticOrder S; S.init(TOKPAD, DM, G, c);
        pg8::EpiY E{(bf16_t*)(p.ws + WS_RA), (float*)(p.ws + WS_SSQ2)};
        pg8::gemm_phase<pg8::EpiY, pg8::StaticOrder, true, true>(lds, g, S, E);
    }
    SEAM(7);
    if (PH_LO <= 8 && 8 < PH_HI) { LAUNDER(); phase7(p, wid, lane); }
#undef SEAM
}
constexpr int NPH = 9;
#if MK_LAUNCHES == 1
__global__ void __launch_bounds__(512, 2) fwd_kernel(Params p) {
    extern __shared__ __attribute__((aligned(16))) unsigned char smem[];
    run_phases<0, NPH>(p, (LAS unsigned char*)smem);
}
#else
template <int PH>
__global__ void __launch_bounds__(512, 2) fwd_phase(Params p) {
    extern __shared__ __attribute__((aligned(16))) unsigned char smem[];
    run_phases<PH, PH + 1>(p, (LAS unsigned char*)smem);
}
template <int PH> static void launch_phase(const Params& p, int grid, hipStream_t stream) {
    static bool attr = false;
    if (!attr) { (void)hipFuncSetAttribute((const void*)fwd_phase<PH>, hipFuncAttributeMaxDynamicSharedMemorySize, LDS_BYTES); attr = true; }
    hipLaunchKernelGGL(fwd_phase<PH>, dim3(grid), dim3(512), LDS_BYTES, stream, p);
}
#endif

extern "C" void kernel_launch(void* const* d_in, const int* in_sizes, int n_in, void* d_out, int out_size, void* d_ws, size_t ws_size, hipStream_t stream) {
    static int grid = 0;
    if (grid == 0) {
        if (n_in != 17 || ws_size < WS_END) { fprintf(stderr, "kernel_launch: expected 17 inputs and >= %zu bytes of workspace (got %d, %zu)\n", (size_t)WS_END, n_in, ws_size); grid = -1; return; }
        int dev = 0, cus = 0, per_cu = 0;
        (void)hipGetDevice(&dev); (void)hipDeviceGetAttribute(&cus, hipDeviceAttributeMultiprocessorCount, dev);
#if MK_LAUNCHES == 1
        if (hipFuncSetAttribute((const void*)fwd_kernel, hipFuncAttributeMaxDynamicSharedMemorySize, LDS_BYTES) != hipSuccess) { fprintf(stderr, "kernel_launch: hipFuncSetAttribute failed\n"); grid = -1; return; }
        if (hipOccupancyMaxActiveBlocksPerMultiprocessor(&per_cu, (const void*)fwd_kernel, 512, LDS_BYTES) != hipSuccess || per_cu < 1) { fprintf(stderr, "kernel_launch: occupancy query says %d\n", per_cu); per_cu = 1; }
        (void)hipGetLastError();
#endif
        grid = cus > 0 ? cus : 256;
    }
    if (grid < 0) return;
    Params p{};
    for (int i = 0; i < 17; ++i) p.in[i] = (const float*)d_in[i];
    p.out = (float*)d_out; p.ws = (unsigned char*)d_ws;
#if MK_LAUNCHES == 1
    void* args[] = {&p};
    const hipError_t e = hipLaunchCooperativeKernel((const void*)fwd_kernel, dim3(grid), dim3(512), args, LDS_BYTES, stream);
    if (e != hipSuccess) fprintf(stderr, "kernel_launch: cooperative launch failed: %s (grid %d)\n", hipGetErrorString(e), grid);
#else
    launch_phase<0>(p, grid, stream); launch_phase<1>(p, grid, stream); launch_phase<2>(p, grid, stream); launch_phase<3>(p, grid, stream); launch_phase<4>(p, grid, stream);
    launch_phase<5>(p, grid, stream); launch_phase<6>(p, grid, stream); launch_phase<7>(p, grid, stream); launch_phase<8>(p, grid, stream);
#endif
}
```

```cpp
#include <hip/hip_runtime.h>
#include <hip/hip_cooperative_groups.h>
#include <cstdio>
#include <cstdint>
namespace cg = cooperative_groups;
namespace pg8 {
#define PG8_LAS __attribute__((address_space(3)))
typedef unsigned short bf16_t;
typedef short bf16x8 __attribute__((ext_vector_type(8)));
typedef float f32x4 __attribute__((ext_vector_type(4)));
typedef unsigned u32x4 __attribute__((ext_vector_type(4)));
constexpr int BM = 256, BK = 64, HALF = 128, HTB = HALF * BK * 2  , STAGE_BYTES = 8 * HTB, NXCD = 8, WGM = 8;

__host__ __device__ __forceinline__ int lds_byte(int r, int c) { const int st = (r >> 4) * 2 + (c >> 5), rr = r & 15, cc = c & 31, ob = rr * 64 + cc * 2; return st * 1024 + (ob ^ (((ob >> 9) & 1) << 5)); }
__host__ __device__ __forceinline__ void stage_rc(int b, int& R, int& C) { const int st = b / 1024, sb = b % 1024, swz = sb ^ (((sb >> 9) & 1) << 5); R = (st >> 1) * 16 + swz / 64; C = (st & 1) * 32 + (swz % 64) / 2; }
__host__ __device__ __forceinline__ int perm32(int rho) { const int n = rho >> 4, i = rho & 15; return 8 * (i >> 2) + 4 * n + (i & 3); }

struct Unit { int pm, pn; };
struct Gemm { const bf16_t* A; const bf16_t* Bt; int M, N, K; };

struct StaticOrder {
    int nM, nN, nwg, G, c;
    __host__ __device__ void init(int M, int N, int G_, int c_) { nM = M / BM; nN = N / BM; nwg = nM * nN; G = G_; c = c_; }
    __host__ __device__ bool next(int i, Unit& u) const {
        const long L = (long)i * G + c; if (L >= nwg) return false;
        int wgid = (int)L; { const int q = nwg / NXCD, r = nwg % NXCD, xcd = wgid % NXCD, off = wgid / NXCD; wgid = (xcd < r ? xcd * (q + 1) : r * (q + 1) + (xcd - r) * q) + off; }
        const int nig = WGM * nN, gid = wgid / nig, fm = gid * WGM, gsz = (nM - fm) < WGM ? (nM - fm) : WGM;
        u.pm = fm + ((wgid % nig) % gsz); u.pn = (wgid % nig) / gsz; return true;
    }
    __device__ __forceinline__ void a_ready(const Unit&) const {}
    __device__ __forceinline__ void done(const Unit&) const {}
};
__device__ __forceinline__ unsigned cvt_pk_bf16(float lo, float hi) { unsigned r; asm volatile("v_cvt_pk_bf16_f32 %0, %1, %2" : "=v"(r) : "v"(lo), "v"(hi)); return r; }
__device__ __forceinline__ float dpp_shr1(float v) { return __builtin_bit_cast(float, __builtin_amdgcn_update_dpp(0, __builtin_bit_cast(int, v), 0x111, 0xf, 0xf, true)); }
__device__ __forceinline__ float dpp_shr2(float v) { return __builtin_bit_cast(float, __builtin_amdgcn_update_dpp(0, __builtin_bit_cast(int, v), 0x112, 0xf, 0xf, true)); }
__device__ __forceinline__ float dpp_shl15(float v) { return __builtin_bit_cast(float, __builtin_amdgcn_update_dpp(0, __builtin_bit_cast(int, v), 0x10F, 0xf, 0xf, true)); }
__device__ __forceinline__ float dpp_shl14(float v) { return __builtin_bit_cast(float, __builtin_amdgcn_update_dpp(0, __builtin_bit_cast(int, v), 0x10E, 0xf, 0xf, true)); }
__device__ __forceinline__ float gelu_tanh(float x) {
    const float z = 0.7978845608028654f * (x + 0.044715f * x * x * x);
    const float e = __builtin_amdgcn_exp2f(-2.8853900817779268f * z);
    return x * __builtin_amdgcn_rcpf(1.0f + e);
}
constexpr int TOKP = 32768;

struct EpiIn {
    static constexpr bool PERM = true, AFTER_DRAIN = false;
    bf16_t* P; const float* cosT; const float* sinT;
    __device__ __forceinline__ void operator()(const f32x4 (&acc)[2][2][4][2], const Unit& u, int wr, int wc, int fr, int fq) const {
        asm volatile("" : "+v"(fr), "+v"(fq));
        const int row0 = u.pm * BM + wr * 64 + fr, col0 = u.pn * BM + wc * 32 + 8 * fq;
        if (u.pn < 4) {
            const float sc = (u.pn >= 2) ? 0.08838834764831845f : 1.0f;
            const int f0 = 16 * wc + 4 * fq;
#pragma unroll
            for (int ai = 0; ai < 2; ++ai)
#pragma unroll
                for (int m = 0; m < 4; ++m) {
                    const int r = row0 + ai * HALF + m * 16;
                    const int pos = r < TOKP ? (r & 4095) : 4096 + ((r - TOKP) & 15);
                    const f32x4 c4 = *(const f32x4*)(cosT + pos * 64 + f0), s4 = *(const f32x4*)(sinT + pos * 64 + f0);
                    bf16_t* rowp = P + (size_t)r * 3584 + col0;
#pragma unroll
                    for (int bj = 0; bj < 2; ++bj) {
                        const f32x4 x1 = acc[ai][bj][m][0], x2 = acc[ai][bj][m][1];
                        const f32x4 o1 = (x1 * c4 - x2 * s4) * sc, o2 = (x2 * c4 + x1 * s4) * sc;
                        u32x4 w; w.x = cvt_pk_bf16(o1[0], o1[1]); w.y = cvt_pk_bf16(o1[2], o1[3]); w.z = cvt_pk_bf16(o2[0], o2[1]); w.w = cvt_pk_bf16(o2[2], o2[3]);
                        *(u32x4*)(rowp + bj * HALF) = w;
                    }
                }
        } else {
#pragma unroll
            for (int ai = 0; ai < 2; ++ai)
#pragma unroll
                for (int m = 0; m < 4; ++m) {
                    bf16_t* rowp = P + (size_t)(row0 + ai * HALF + m * 16) * 3584 + col0;
#pragma unroll
                    for (int bj = 0; bj < 2; ++bj) {
                        const f32x4 v0 = acc[ai][bj][m][0], v1 = acc[ai][bj][m][1];
                        u32x4 w; w.x = cvt_pk_bf16(v0[0], v0[1]); w.y = cvt_pk_bf16(v0[2], v0[3]); w.z = cvt_pk_bf16(v1[0], v1[1]); w.w = cvt_pk_bf16(v1[2], v1[3]);
                        *(u32x4*)(rowp + bj * HALF) = w;
                    }
                }
        }
    }
};

struct EpiY {
    static constexpr bool PERM = true, AFTER_DRAIN = false;
    bf16_t* Y; float* ssq;
    __device__ __forceinline__ void operator()(const f32x4 (&acc)[2][2][4][2], const Unit& u, int wr, int wc, int fr, int fq) const {
        asm volatile("" : "+v"(fr), "+v"(fq));
        const int row0 = u.pm * BM + wr * 64 + fr, col0 = u.pn * BM + wc * 32 + 8 * fq;
#pragma unroll
        for (int ai = 0; ai < 2; ++ai)
#pragma unroll
            for (int m = 0; m < 4; ++m) {
                const int r = row0 + ai * HALF + m * 16;
                bf16_t* rowp = Y + (size_t)r * 1024 + col0;
                float s = 0.f;
#pragma unroll
                for (int bj = 0; bj < 2; ++bj) {
                    const f32x4 v0 = acc[ai][bj][m][0], v1 = acc[ai][bj][m][1];
                    s += (v0[0] * v0[0] + v0[1] * v0[1]) + (v0[2] * v0[2] + v0[3] * v0[3]) + (v1[0] * v1[0] + v1[1] * v1[1]) + (v1[2] * v1[2] + v1[3] * v1[3]);
                    u32x4 w; w.x = cvt_pk_bf16(v0[0], v0[1]); w.y = cvt_pk_bf16(v0[2], v0[3]); w.z = cvt_pk_bf16(v1[0], v1[1]); w.w = cvt_pk_bf16(v1[2], v1[3]);
                    *(u32x4*)(rowp + bj * HALF) = w;
                }
                s += __shfl_xor(s, 16); s += __shfl_xor(s, 32);
                if (fq == 0) ssq[(size_t)r * 16 + u.pn * 4 + wc] = s;
            }
    }
};

struct EpiFfn {
    static constexpr bool PERM = true, AFTER_DRAIN = false;
    bf16_t* ACT; const float* cw; const float* cache; float* outp; float* outs; PG8_LAS float* halo;
    __device__ __forceinline__ void operator()(const f32x4 (&acc)[2][2][4][2], const Unit& u, int wr, int wc, int fr, int fq) const {
        asm volatile("" : "+v"(fr), "+v"(fq));
        const int lc0 = wc * 32 + 8 * fq, ch0 = u.pn * 128 + lc0;
        const bool sample = (u.pm == 128);
        const int par = u.pm & 1;
        f32x4 w0[2], w1[2], w2[2];
#pragma unroll
        for (int n = 0; n < 2; ++n) { w0[n] = *(const f32x4*)(cw + ch0 + 4 * n); w1[n] = *(const f32x4*)(cw + 4096 + ch0 + 4 * n); w2[n] = *(const f32x4*)(cw + 8192 + ch0 + 4 * n); }
        if (!sample && fr >= 14) {
#pragma unroll
            for (int ai = 0; ai < 2; ++ai) { PG8_LAS float* hp = halo + ((par * 4 + 2 * ai + wr) * 2 + (fr - 14)) * 128 + lc0;
                *(PG8_LAS f32x4*)hp = acc[ai][0][3][0]; *(PG8_LAS f32x4*)(hp + 4) = acc[ai][0][3][1]; }
        }
        asm volatile("s_waitcnt lgkmcnt(0)" ::: "memory"); __builtin_amdgcn_s_barrier(); asm volatile("" ::: "memory");
#pragma unroll
        for (int ai = 0; ai < 2; ++ai) {
            const int blk = 2 * ai + wr;
#pragma unroll
            for (int m = 0; m < 4; ++m) {
                f32x4 pv[2]; pv[0] = (f32x4){0.f, 0.f, 0.f, 0.f}; pv[1] = pv[0];
                const int sb = 8 * ai + 4 * wr + m;
                if (sample) {
                    if (fr >= 14 && sb < 8) { const float* cp = cache + (size_t)(sb * 2 + fr - 14) * 4096 + ch0; pv[0] = *(const f32x4*)cp; pv[1] = *(const f32x4*)(cp + 4); }
                } else if (m == 0) {
                    if (fr >= 14) {
                        const bool zero = (blk == 0) && ((u.pm & 15) == 0);
                        const int hb = (blk == 0) ? ((par ^ 1) * 4 + 3) : (par * 4 + blk - 1);
                        if (!zero) { const PG8_LAS float* hp = halo + (hb * 2 + fr - 14) * 128 + lc0; pv[0] = *(const PG8_LAS f32x4*)hp; pv[1] = *(const PG8_LAS f32x4*)(hp + 4); }
                    }
                } else { pv[0] = acc[ai][0][m - 1][0]; pv[1] = acc[ai][0][m - 1][1]; }
                const int r = u.pm * BM + ai * HALF + wr * 64 + m * 16 + fr;
                float a8[8];
#pragma unroll
                for (int n = 0; n < 2; ++n)
#pragma unroll
                    for (int e = 0; e < 4; ++e) {
                        const float cur = acc[ai][0][m][n][e], pr = pv[n][e];
                        const float p1 = dpp_shr1(cur) + dpp_shl15(pr), p2 = dpp_shr2(cur) + dpp_shl14(pr);
                        const float uc = w0[n][e] * p2 + w1[n][e] * p1 + w2[n][e] * cur;
                        a8[4 * n + e] = gelu_tanh(uc) * acc[ai][1][m][n][e];
                    }
                u32x4 w; w.x = cvt_pk_bf16(a8[0], a8[1]); w.y = cvt_pk_bf16(a8[2], a8[3]); w.z = cvt_pk_bf16(a8[4], a8[5]); w.w = cvt_pk_bf16(a8[6], a8[7]);
                *(u32x4*)(ACT + (size_t)r * 4096 + ch0) = w;
                if (sample) {
                    if (fr >= 14 && sb < 8) { float* op = outs + (size_t)(sb * 2 + fr - 14) * 4096 + ch0; *(f32x4*)op = acc[ai][0][m][0]; *(f32x4*)(op + 4) = acc[ai][0][m][1]; }
                } else if (m == 3 && blk == 3 && (u.pm & 15) == 15 && fr >= 14) {
                    float* op = outp + (size_t)((u.pm >> 4) * 2 + fr - 14) * 4096 + ch0; *(f32x4*)op = acc[ai][0][m][0]; *(f32x4*)(op + 4) = acc[ai][0][m][1];
                }
            }
        }
    }
};
struct WalkOrder {
    int G, c;
    __device__ __forceinline__ bool next(int i, Unit& u) const {
        int w = c, rem = i;
        while (w < 288) { const int len = w < 256 ? 16 : 1;
            if (rem < len) { if (w < 256) { u.pm = (w >> 5) * 16 + rem; u.pn = w & 31; } else { u.pm = 128; u.pn = w - 256; } return true; }
            rem -= len; w += G; }
        return false;
    }
    __device__ __forceinline__ void a_ready(const Unit&) const {}
    __device__ __forceinline__ void done(const Unit&) const {}
};
template <class Epi, class Sched, bool ALIGN_EPI = false, bool SP2 = false>
__device__ __forceinline__ void gemm_phase(PG8_LAS unsigned char* lds, const Gemm g, const Sched& S, const Epi& E) {
    int tid_raw = threadIdx.x; asm volatile("" : "+v"(tid_raw));
    const int tid = tid_raw, wid = __builtin_amdgcn_readfirstlane(tid >> 6), lane = tid & 63, wr = wid >> 2, wc = wid & 3, fr = lane & 15, fq = lane >> 4;
    const int K = g.K, nt = K / BK;
    unsigned voffA[2], voffB[2];
#pragma unroll
    for (int i = 0; i < 2; ++i) { int R, C; stage_rc(tid * 16 + i * 8192, R, C); const int Rb = Epi::PERM ? ((R & ~31) + perm32(R & 31)) : R;
        voffA[i] = (unsigned)(R * K + C) * 2u; voffB[i] = (unsigned)(Rb * K + C) * 2u; }
    const size_t kstep = (size_t)(BK * 2);
    const size_t hstep = (size_t)HALF * K * 2;
    const size_t tstep = 2 * hstep;
    const unsigned ldsw = (unsigned)wid * 1024u;
    const int aoff = lds_byte(wr * 64 + fr, fq * 8), boff = lds_byte(wc * 32 + fr, fq * 8);
#define PG8_SA(b, h) (((b) * 2 + (h)) * HTB)
#define PG8_SB(b, h) ((4 + (b) * 2 + (h)) * HTB)
#define PG8_STAGE(bufoff, gbase, voff) do { _Pragma("unroll") for (int _i = 0; _i < 2; ++_i) \
        __builtin_amdgcn_global_load_lds((const unsigned*)((const char*)(gbase) + (voff)[_i]), (PG8_LAS unsigned*)(lds + (bufoff) + ldsw + _i * 8192), 16, 0, 0); } while (0)
#define PG8_LDA(dst, b, h) do { _Pragma("unroll") for (int m = 0; m < 4; ++m) _Pragma("unroll") for (int k = 0; k < 2; ++k) dst[m][k] = *(const PG8_LAS bf16x8*)(lds + PG8_SA(b, h) + aoff + m * 2048 + k * 1024); } while (0)
#define PG8_LDB(dst, b, h) do { _Pragma("unroll") for (int n = 0; n < 2; ++n) _Pragma("unroll") for (int k = 0; k < 2; ++k) dst[n][k] = *(const PG8_LAS bf16x8*)(lds + PG8_SB(b, h) + boff + n * 2048 + k * 1024); } while (0)
#define PG8_MMA(ai, bj, At, Bt) do { __builtin_amdgcn_s_setprio(1); _Pragma("unroll") for (int m = 0; m < 4; ++m) _Pragma("unroll") for (int n = 0; n < 2; ++n) _Pragma("unroll") for (int k = 0; k < 2; ++k) \
        acc[ai][bj][m][n] = __builtin_amdgcn_mfma_f32_16x16x32_bf16(Bt[n][k], At[m][k], acc[ai][bj][m][n], 0, 0, 0); __builtin_amdgcn_s_setprio(0); } while (0)
#define PG8_WAIT_V(n) asm volatile("s_waitcnt vmcnt(" #n ")" ::: "memory")
#define PG8_WAIT_L(n) asm volatile("s_waitcnt lgkmcnt(" #n ")" ::: "memory")
#define PG8_BAR __builtin_amdgcn_s_barrier()
#define PG8_SCHED __builtin_amdgcn_sched_barrier(0)
    Unit cur, nxt; int ui = 0;
    if (!S.next(0, cur)) return;
    f32x4 acc[2][2][4][2];
#pragma unroll
    for (int a = 0; a < 2; ++a)
#pragma unroll
        for (int b = 0; b < 2; ++b)
#pragma unroll
            for (int m = 0; m < 4; ++m)
#pragma unroll
                for (int n = 0; n < 2; ++n) acc[a][b][m][n] = (f32x4){0.f, 0.f, 0.f, 0.f};
    bf16x8 At[4][2], B0[2][2], B1[2][2];
    const char* cA = (const char*)g.A + (size_t)cur.pm * tstep; const char* cB = (const char*)g.Bt + (size_t)cur.pn * tstep;
    S.a_ready(cur);
    if constexpr (SP2) {
        PG8_STAGE(PG8_SB(0, 0), cB, voffB); PG8_STAGE(PG8_SB(0, 1), cB + hstep, voffB); PG8_STAGE(PG8_SA(0, 0), cA, voffA); PG8_STAGE(PG8_SA(0, 1), cA + hstep, voffA);
        if (wr == 1) PG8_BAR;
        PG8_WAIT_V(2); PG8_BAR;
        PG8_STAGE(PG8_SB(1, 0), cB + kstep, voffB); PG8_STAGE(PG8_SA(1, 0), cA + kstep, voffA); PG8_STAGE(PG8_SB(1, 1), cB + hstep + kstep, voffB);
        PG8_WAIT_V(6); PG8_BAR;
    } else {
        PG8_STAGE(PG8_SB(0, 0), cB, voffB); PG8_STAGE(PG8_SA(0, 0), cA, voffA); PG8_STAGE(PG8_SB(0, 1), cB + hstep, voffB); PG8_STAGE(PG8_SA(0, 1), cA + hstep, voffA);
        if (wr == 1) PG8_BAR;
        PG8_WAIT_V(4); PG8_BAR;
        PG8_STAGE(PG8_SB(1, 0), cB + kstep, voffB); PG8_STAGE(PG8_SA(1, 0), cA + kstep, voffA); PG8_STAGE(PG8_SB(1, 1), cB + hstep + kstep, voffB);
        PG8_WAIT_V(6); PG8_BAR;
    }
    for (;;) {
        const bool has_next = S.next(ui + 1, nxt);
        const char* nA = has_next ? (const char*)g.A + (size_t)nxt.pm * tstep : cA; const char* nB = has_next ? (const char*)g.Bt + (size_t)nxt.pn * tstep : cB;
        for (int t = 0; t < nt; t += 2) {
            const bool last = (t == nt - 2);
            const char* a1 = cA + (size_t)(t + 1) * kstep;
            const char* a2 = last ? nA : cA + (size_t)(t + 2) * kstep; const char* b2 = last ? nB : cB + (size_t)(t + 2) * kstep;
            const char* a3 = a2 + kstep; const char* b3 = b2 + kstep;
            if (last && has_next) S.a_ready(nxt);
            if constexpr (SP2) {
            PG8_LDB(B0, 0, 0); PG8_LDB(B1, 0, 1); PG8_SCHED; PG8_LDA(At, 0, 0); PG8_STAGE(PG8_SA(1, 1), a1 + hstep, voffA);
            PG8_WAIT_V(8); PG8_WAIT_L(0); PG8_BAR; PG8_MMA(0, 0, At, B0); PG8_MMA(0, 1, At, B1); PG8_BAR; PG8_SCHED;
            PG8_LDA(At, 0, 1); PG8_STAGE(PG8_SB(0, 0), b2, voffB); PG8_STAGE(PG8_SB(0, 1), b2 + hstep, voffB); PG8_STAGE(PG8_SA(0, 0), a2, voffA);
            PG8_WAIT_V(8); PG8_WAIT_L(0); PG8_BAR; PG8_MMA(1, 0, At, B0); PG8_MMA(1, 1, At, B1); PG8_BAR; PG8_SCHED;
            PG8_LDB(B0, 1, 0); PG8_LDB(B1, 1, 1); PG8_SCHED; PG8_LDA(At, 1, 0); PG8_STAGE(PG8_SA(0, 1), a2 + hstep, voffA);
            PG8_WAIT_V(8); PG8_WAIT_L(0); PG8_BAR; PG8_MMA(0, 0, At, B0); PG8_MMA(0, 1, At, B1); PG8_BAR; PG8_SCHED;
            PG8_LDA(At, 1, 1); PG8_STAGE(PG8_SB(1, 0), b3, voffB); PG8_STAGE(PG8_SB(1, 1), b3 + hstep, voffB); PG8_STAGE(PG8_SA(1, 0), a3, voffA);
            PG8_WAIT_V(8); PG8_WAIT_L(0); PG8_BAR; PG8_MMA(1, 0, At, B0); PG8_MMA(1, 1, At, B1); PG8_BAR; PG8_SCHED;
            } else {
            PG8_LDB(B0, 0, 0); PG8_SCHED; PG8_LDA(At, 0, 0); PG8_STAGE(PG8_SA(1, 1), a1 + hstep, voffA);
            PG8_WAIT_L(8); PG8_BAR; PG8_WAIT_L(0); PG8_MMA(0, 0, At, B0); PG8_BAR; PG8_SCHED;
            PG8_LDB(B1, 0, 1); PG8_STAGE(PG8_SB(0, 0), b2, voffB);
            PG8_BAR; PG8_WAIT_L(0); PG8_MMA(0, 1, At, B1); PG8_BAR;
            PG8_LDA(At, 0, 1); PG8_STAGE(PG8_SA(0, 0), a2, voffA);
            PG8_BAR; PG8_WAIT_L(0); PG8_MMA(1, 0, At, B0); PG8_BAR; PG8_SCHED;
            PG8_STAGE(PG8_SB(0, 1), b2 + hstep, voffB);
            PG8_WAIT_V(6); PG8_BAR; PG8_MMA(1, 1, At, B1); PG8_BAR;
            PG8_LDB(B0, 1, 0); PG8_SCHED; PG8_LDA(At, 1, 0); PG8_STAGE(PG8_SA(0, 1), a2 + hstep, voffA);
            PG8_WAIT_L(8); PG8_BAR; PG8_WAIT_L(0); PG8_MMA(0, 0, At, B0); PG8_BAR; PG8_SCHED;
            PG8_LDB(B1, 1, 1); PG8_STAGE(PG8_SB(1, 0), b3, voffB);
            PG8_BAR; PG8_WAIT_L(0); PG8_MMA(0, 1, At, B1); PG8_BAR;
            PG8_LDA(At, 1, 1); PG8_STAGE(PG8_SA(1, 0), a3, voffA);
            PG8_BAR; PG8_WAIT_L(0); PG8_MMA(1, 0, At, B0); PG8_BAR; PG8_SCHED;
            PG8_STAGE(PG8_SB(1, 1), b3 + hstep, voffB);
            PG8_WAIT_V(6); PG8_BAR; PG8_MMA(1, 1, At, B1); PG8_BAR;
            }
        }
        if constexpr (ALIGN_EPI) { if (wr == 0) PG8_BAR; }
        if constexpr (!Epi::AFTER_DRAIN) { E(acc, cur, wr, wc, fr, fq); S.done(cur); }
        if (!has_next) break;
#pragma unroll
        for (int a = 0; a < 2; ++a)
#pragma unroll
            for (int b = 0; b < 2; ++b)
#pragma unroll
                for (int m = 0; m < 4; ++m)
#pragma unroll
                    for (int n = 0; n < 2; ++n) acc[a][b][m][n] = (f32x4){0.f, 0.f, 0.f, 0.f};
        cur = nxt; cA = nA; cB = nB; ++ui;
        if constexpr (ALIGN_EPI) { if (wr == 1) PG8_BAR; }
    }
    PG8_WAIT_V(0);
    if constexpr (!ALIGN_EPI) { if (wr == 0) PG8_BAR; }
    PG8_BAR;
    if constexpr (Epi::AFTER_DRAIN) { E.fused(acc, cur, wr, wc, fr, fq, lds, wid, lane); S.done(cur); }
#undef PG8_SA
#undef PG8_SB
#undef PG8_STAGE
#undef PG8_LDA
#undef PG8_LDB
#undef PG8_MMA
#undef PG8_WAIT_V
#undef PG8_WAIT_L
#undef PG8_BAR
#undef PG8_SCHED
}
}

using pg8::bf16_t; using pg8::bf16x8; using pg8::f32x4; using pg8::u32x4;
#define LAS __attribute__((address_space(3)))
typedef unsigned u32x2 __attribute__((ext_vector_type(2)));
constexpr int DM = 1024, NIN = 3584, DFF = 4096;
constexpr int TOK_P = 32768, TOK = 32896, TOKPAD = 33024;
constexpr float EPS = 1e-6f;
constexpr size_t WS_WIN = 16384;
constexpr size_t WS_WOUT = WS_WIN + (size_t)NIN * DM * 2;
constexpr size_t WS_WFF1 = WS_WOUT + (size_t)DM * DM * 2;
constexpr size_t WS_WDN = WS_WFF1 + (size_t)2 * DFF * DM * 2;
constexpr size_t WS_COS = WS_WDN + (size_t)DM * DFF * 2;
constexpr size_t WS_SIN = WS_COS + (size_t)4112 * 64 * 4;
constexpr size_t WS_SSQ1 = WS_SIN + (size_t)4112 * 64 * 4;
constexpr size_t WS_SSQ2 = WS_SSQ1 + (size_t)TOKPAD * 16 * 4;
constexpr size_t WS_UG = WS_SSQ2 + (size_t)TOKPAD * 16 * 4;
constexpr size_t WS_RA = WS_UG + (size_t)256 * 65536;
constexpr size_t WS_RB = WS_RA + (size_t)TOKPAD * DM * 2;
constexpr size_t WS_END = WS_RB + (size_t)TOKPAD * DFF * 2;
constexpr size_t O_SRP = (size_t)TOK * DM, O_CCP = O_SRP + 524288, O_CFP = O_CCP + 8192, O_SRS = O_CFP + 65536, O_CCS = O_SRS + 524288, O_CFS = O_CCS + 8192;
constexpr int LDS_HALO = 131072, LDS_BARW = 131072 + 8192, LDS_BYTES = LDS_BARW + 16;

struct Params { const float* in[17]; float* out; unsigned char* ws; };

__device__ __forceinline__ float wave_sum(float v) {
#pragma unroll
    for (int o = 1; o < 64; o <<= 1) v += __shfl_xor(v, o);
    return v;
}
__device__ __forceinline__ float bf2f(unsigned short b) { return __uint_as_float(((unsigned)b) << 16); }
__device__ __forceinline__ unsigned pk2(float a, float b) { return pg8::cvt_pk_bf16(a, b); }
__device__ __forceinline__ float silu_f(float g) { return g * __builtin_amdgcn_rcpf(1.0f + __builtin_amdgcn_exp2f(-1.4426950408889634f * g)); }
__device__ __forceinline__ int dmap(int P) { return ((P >> 2) & 1) * 64 + (P >> 3) * 4 + (P & 3); }
__device__ __forceinline__ int pmap(int d) { return ((d >> 4) & 3) * 32 + ((d >> 2) & 3) * 8 + ((d >> 6) & 1) * 4 + (d & 3); }

template <int MODE> __device__ __forceinline__ int rowmap(int c) {
    if (MODE == 0) { if (c < 1024) return (c & ~127) + pmap(c & 127); return c; }
    if (MODE == 1) return c;
    if (MODE == 2) return ((c >> 7) << 8) + (c & 127);
    return ((c >> 7) << 8) + 128 + (c & 127);
}
template <int MODE>
__device__ __forceinline__ void transpose_item(const float* W, int K, int N, bf16_t* WT, LAS float* scr, int item, int lane) {
    const int nblk = N / 32, kb = item / nblk, nb = item % nblk, k0 = 64 * kb, n0 = 32 * nb;
#pragma unroll 8
    for (int i = 0; i < 32; ++i) { const int kk = 2 * i + (lane >> 5); scr[kk * 33 + (lane & 31)] = W[(size_t)(k0 + kk) * N + n0 + (lane & 31)]; }
    asm volatile("s_waitcnt lgkmcnt(0)" ::: "memory");
    const int c = lane & 7;
#pragma unroll
    for (int j = 0; j < 4; ++j) { const int n = (lane >> 3) + 8 * j; const LAS float* s = scr + (8 * c) * 33 + n;
        u32x4 o; o.x = pk2(s[0 * 33], s[1 * 33]); o.y = pk2(s[2 * 33], s[3 * 33]); o.z = pk2(s[4 * 33], s[5 * 33]); o.w = pk2(s[6 * 33], s[7 * 33]);
        *(u32x4*)(WT + (size_t)rowmap<MODE>(n0 + n) * K + k0 + 8 * c) = o; }
    asm volatile("s_waitcnt lgkmcnt(0)" ::: "memory");
}
__device__ __forceinline__ void phase0(const Params& p, LAS unsigned char* lds, int tid, int wid, int lane) {
    LAS float* scr = (LAS float*)(lds + wid * 8448);
    const int gw = blockIdx.x * 8 + wid, NGW = gridDim.x * 8;
    bf16_t* win = (bf16_t*)(p.ws + WS_WIN); bf16_t* wout = (bf16_t*)(p.ws + WS_WOUT); bf16_t* wff1 = (bf16_t*)(p.ws + WS_WFF1); bf16_t* wdn = (bf16_t*)(p.ws + WS_WDN);
    constexpr int I_IN = 16 * 112, I_OUT = 16 * 32, I_UP = 16 * 128, I_DN = 64 * 32, NITEMS = I_IN + I_OUT + 2 * I_UP + I_DN;
    for (int it = gw; it < NITEMS; it += NGW) {
        int r = it;
        if (r < I_IN) { transpose_item<0>(p.in[5], DM, NIN, win, scr, r, lane); continue; } r -= I_IN;
        if (r < I_OUT) { transpose_item<1>(p.in[6], DM, DM, wout, scr, r, lane); continue; } r -= I_OUT;
        if (r < I_UP) { transpose_item<2>(p.in[13], DM, DFF, wff1, scr, r, lane); continue; } r -= I_UP;
        if (r < I_UP) { transpose_item<3>(p.in[14], DM, DFF, wff1, scr, r, lane); continue; } r -= I_UP;
        transpose_item<1>(p.in[16], DFF, DM, wdn, scr, r, lane);
    }
    float* cosT = (float*)(p.ws + WS_COS); float* sinT = (float*)(p.ws + WS_SIN);
    for (int idx = blockIdx.x * 512 + tid; idx < 4112 * 64; idx += gridDim.x * 512) {
        const int pos = idx >> 6, f = idx & 63;
        const float inv = exp2f(-(float)(2 * f) * (1.0f / 128.0f) * 13.287712379549449f);
        const float ang = (float)pos * inv;
        const double rev = (double)ang * 0.15915494309189535;
        const float fr = (float)(rev - floor(rev));
        cosT[idx] = __builtin_amdgcn_cosf(fr); sinT[idx] = __builtin_amdgcn_sinf(fr);
    }
    bf16_t* H = (bf16_t*)(p.ws + WS_RA);
    const float* wpre = p.in[9];
    for (int r = gw; r < TOKPAD; r += NGW) {
        u32x2* o8 = (u32x2*)(H + (size_t)r * DM) + lane;
        if (r >= TOK) {
#pragma unroll
            for (int j = 0; j < 4; ++j) o8[64 * j] = (u32x2){0u, 0u};
            continue; }
        const float* xrow = r < TOK_P ? p.in[0] + (size_t)r * DM : p.in[1] + (size_t)(r - TOK_P) * DM;
        f32x4 v[4]; float s = 0.f;
#pragma unroll
        for (int j = 0; j < 4; ++j) { v[j] = *((const f32x4*)xrow + lane + 64 * j); s += (v[j][0] * v[j][0] + v[j][1] * v[j][1]) + (v[j][2] * v[j][2] + v[j][3] * v[j][3]); }
        const float rstd = rsqrtf(wave_sum(s) * (1.0f / DM) + EPS);
#pragma unroll
        for (int j = 0; j < 4; ++j) { const f32x4 w = *((const f32x4*)wpre + lane + 64 * j); const f32x4 y = (v[j] * rstd) * w;
            o8[64 * j] = (u32x2){pk2(y[0], y[1]), pk2(y[2], y[3])}; }
    }
}

constexpr int QI_OFF = 0, KI_OFF = 17408, KT_OFF = 34816, VT_OFF = 53248, SI_OFF = 71680, ST_OFF = 80896, GI_OFF = 115712;
#define MFMA16(a, b, c) __builtin_amdgcn_mfma_f32_16x16x32_bf16((a), (b), (c), 0, 0, 0)
template <bool FULL>
__device__ __forceinline__ void ret_unit(const Params& p, LAS unsigned char* lds, int unit, int tid, int wid, int lane) {
    asm volatile("" : "+v"(tid), "+v"(lane));
    const int G = unit & 7, h = (unit >> 3) & 3, b = unit >> 5;
    const bf16_t* P = (const bf16_t*)(p.ws + WS_RB);
    bf16_t* MIX = (bf16_t*)(p.ws + WS_RA);
    float* UG = (float*)(p.ws + WS_UG);
    const size_t tok0 = (size_t)b * 4096 + (size_t)G * 512;
    const float l2g = log2f(1.0f - exp2f(-5.0f - (float)h));
    const float g64 = __builtin_amdgcn_exp2f(l2g * 64.0f);
    const bool is_state = wid >= 4; const int w4 = wid & 3;
    const int l15 = lane & 15, l4 = lane >> 4;
    const int vtL = l4 ^ (l15 >> 3);
    const int vtb0 = VT_OFF + l15 * 144 + 16 * vtL, vtb1 = VT_OFF + l15 * 144 + 16 * (vtL ^ 2);
#define VT_ADDR(nt, ks) ((((nt) & 1) ? vtb1 : vtb0) + (nt) * 2304 + 16 * (((4 * (ks)) ^ (2 * ((nt) & 3))) & 4))
    f32x4 st[2][8];
#pragma unroll
    for (int mt = 0; mt < 2; ++mt)
#pragma unroll
        for (int nt = 0; nt < 8; ++nt) st[mt][nt] = (f32x4){0.f, 0.f, 0.f, 0.f};
    if (FULL && is_state) {
#pragma unroll 1
        for (int Gp = 0; Gp < G; Gp += 2) {
            const float wa = __builtin_amdgcn_exp2f(l2g * 512.0f * (float)(G - 1 - Gp));
            const bool two = Gp + 1 < G;
            const float wb = two ? __builtin_amdgcn_exp2f(l2g * 512.0f * (float)(G - 2 - Gp)) : 0.f;
            const float* sa = UG + ((size_t)((b * 4 + h) * 8 + Gp) * 4 + w4) * 4096 + lane;
            const float* sb = two ? sa + 4 * 4096 : sa;
#pragma unroll
            for (int mt = 0; mt < 2; ++mt)
#pragma unroll
                for (int nt = 0; nt < 8; ++nt)
#pragma unroll
                    for (int r = 0; r < 4; ++r) st[mt][nt][r] += wa * sa[((mt * 8 + nt) * 4 + r) * 64] + wb * sb[((mt * 8 + nt) * 4 + r) * 64];
        }
    }
    float rwv[8];
#pragma unroll
    for (int nt = 0; nt < 8; ++nt) rwv[nt] = p.in[8][128 * h + 16 * nt + l15];
    u32x4 rq[2], rk[2], rv[2], rg[2];
#pragma unroll
    for (int i = 0; i < 2; ++i) { const int idx = tid + 512 * i, j = idx >> 4, ch = idx & 15; const bf16_t* rowp = P + (tok0 + j) * NIN + 128 * h + ch * 8;
        if (FULL) { rq[i] = *(const u32x4*)rowp; rg[i] = *(const u32x4*)(rowp + 1536); } rk[i] = *(const u32x4*)(rowp + 512); rv[i] = *(const u32x4*)(rowp + 1024); }
#pragma unroll 1
    for (int n = 0; n < 8; ++n) {
#pragma unroll
        for (int i = 0; i < 2; ++i) { const int idx = tid + 512 * i, j = idx >> 4, ch = idx & 15;
            if (FULL) { *(LAS u32x4*)(lds + QI_OFF + j * 272 + ch * 16) = rq[i]; *(LAS u32x4*)(lds + KI_OFF + j * 272 + ch * 16) = rk[i]; *(LAS u32x4*)(lds + GI_OFF + j * 272 + ch * 16) = rg[i]; }
            const float te = __builtin_amdgcn_exp2f(l2g * (float)(63 - j));
            const unsigned kw[4] = {rk[i].x, rk[i].y, rk[i].z, rk[i].w}, vw[4] = {rv[i].x, rv[i].y, rv[i].z, rv[i].w};
            const int cofs = 16 * ((j >> 3) ^ (ch & 7)) + 2 * (j & 7);
#pragma unroll
            for (int e2 = 0; e2 < 4; ++e2) {
                const unsigned kk = pk2(__uint_as_float(kw[e2] << 16) * te, __uint_as_float(kw[e2] & 0xffff0000u) * te);
                const int row = 8 * ch + 2 * e2;
                *(LAS unsigned short*)(lds + KT_OFF + row * 144 + cofs) = (unsigned short)(kk & 0xffffu);
                *(LAS unsigned short*)(lds + KT_OFF + (row + 1) * 144 + cofs) = (unsigned short)(kk >> 16);
                *(LAS unsigned short*)(lds + VT_OFF + row * 144 + cofs) = (unsigned short)(vw[e2] & 0xffffu);
                *(LAS unsigned short*)(lds + VT_OFF + (row + 1) * 144 + cofs) = (unsigned short)(vw[e2] >> 16);
            }
        }
        if (FULL && is_state) {
#pragma unroll
            for (int mt = 0; mt < 2; ++mt)
#pragma unroll
                for (int nt = 0; nt < 8; ++nt) { const int e = 16 * nt + l15, dk0 = 32 * w4 + 16 * mt + 4 * l4;
                    *(LAS u32x2*)(lds + ST_OFF + e * 272 + dk0 * 2) = (u32x2){pk2(st[mt][nt][0], st[mt][nt][1]), pk2(st[mt][nt][2], st[mt][nt][3])}; }
        }
        __syncthreads();
        if (n + 1 < 8) {
#pragma unroll
            for (int i = 0; i < 2; ++i) { const int idx = tid + 512 * i, j = idx >> 4, ch = idx & 15; const bf16_t* rowp = P + (tok0 + (n + 1) * 64 + j) * NIN + 128 * h + ch * 8;
                if (FULL) { rq[i] = *(const u32x4*)rowp; rg[i] = *(const u32x4*)(rowp + 1536); } rk[i] = *(const u32x4*)(rowp + 512); rv[i] = *(const u32x4*)(rowp + 1024); }
        }
        f32x4 cr[8];
#pragma unroll
        for (int nt = 0; nt < 8; ++nt) cr[nt] = (f32x4){0.f, 0.f, 0.f, 0.f};
        if (FULL) {
            if (!is_state) {
                bf16x8 aq[4];
#pragma unroll
                for (int ks = 0; ks < 4; ++ks) aq[ks] = *(const LAS bf16x8*)(lds + QI_OFF + (16 * w4 + l15) * 272 + (32 * ks + 8 * l4) * 2);
#pragma unroll
                for (int nt = 0; nt < 8; ++nt)
#pragma unroll
                    for (int ks = 0; ks < 4; ++ks) { const bf16x8 bs = *(const LAS bf16x8*)(lds + ST_OFF + (16 * nt + l15) * 272 + (32 * ks + 8 * l4) * 2); cr[nt] = MFMA16(aq[ks], bs, cr[nt]); }
            } else {
                bf16x8 ak[4];
#pragma unroll
                for (int ks = 0; ks < 4; ++ks) ak[ks] = *(const LAS bf16x8*)(lds + KI_OFF + (16 * w4 + l15) * 272 + (32 * ks + 8 * l4) * 2);
#pragma unroll
                for (int it = 0; it < 4; ++it) {
                    f32x4 sa = (f32x4){0.f, 0.f, 0.f, 0.f};
#pragma unroll
                    for (int ks = 0; ks < 4; ++ks) { const bf16x8 bq = *(const LAS bf16x8*)(lds + QI_OFF + (16 * it + l15) * 272 + (32 * ks + 8 * l4) * 2); sa = MFMA16(ak[ks], bq, sa); }
                    const int i = 16 * it + l15, j0 = 16 * w4 + 4 * l4;
#pragma unroll
                    for (int r = 0; r < 4; ++r) { const int d = i - (j0 + r); sa[r] *= __builtin_amdgcn_exp2f(l2g * (float)(d < 0 ? -d : d)); }
                    *(LAS u32x2*)(lds + SI_OFF + i * 144 + j0 * 2) = (u32x2){pk2(sa[0], sa[1]), pk2(sa[2], sa[3])};
                }
            }
        }
        __syncthreads();
        if (!is_state) {
            if (FULL) {
                f32x4 itr[8];
                { f32x4 fsv;
#pragma unroll
                  for (int r = 0; r < 4; ++r) fsv[r] = __builtin_amdgcn_exp2f(l2g * (float)(16 * w4 + 4 * l4 + r + 1));
#pragma unroll
                  for (int nt = 0; nt < 8; ++nt) itr[nt] = cr[nt] * fsv; }
                bf16x8 as_[2];
#pragma unroll
                for (int ks = 0; ks < 2; ++ks) as_[ks] = *(const LAS bf16x8*)(lds + SI_OFF + (16 * w4 + l15) * 144 + 16 * (4 * ks + l4));
#pragma unroll
                for (int nt = 0; nt < 8; ++nt)
#pragma unroll
                    for (int ks = 0; ks < 2; ++ks) { const bf16x8 bv = *(const LAS bf16x8*)(lds + VT_ADDR(nt, ks)); itr[nt] = MFMA16(as_[ks], bv, itr[nt]); }
#pragma unroll
                for (int r = 0; r < 4; ++r) {
                    const int i = 16 * w4 + 4 * l4 + r;
                    float ov[8]; float ss = 0.f;
#pragma unroll
                    for (int nt = 0; nt < 8; ++nt) { ov[nt] = itr[nt][r]; ss += ov[nt] * ov[nt]; }
                    ss += __shfl_xor(ss, 1); ss += __shfl_xor(ss, 2); ss += __shfl_xor(ss, 4); ss += __shfl_xor(ss, 8);
                    const float rstd = rsqrtf(ss * (1.0f / 128.0f) + EPS);
#pragma unroll
                    for (int nt = 0; nt < 8; ++nt) { const float gq = bf2f(*(const LAS unsigned short*)(lds + GI_OFF + i * 272 + (16 * nt + l15) * 2));
                        *(LAS unsigned short*)(lds + QI_OFF + i * 272 + (16 * nt + l15) * 2) = (unsigned short)(pk2(ov[nt] * rstd * rwv[nt] * silu_f(gq), 0.f) & 0xffffu); }
                }
#pragma unroll
                for (int q = 0; q < 4; ++q) { const int cidx = lane + 64 * q, row = 16 * w4 + (cidx >> 4), ch = cidx & 15;
                    const u32x4 v = *(const LAS u32x4*)(lds + QI_OFF + row * 272 + ch * 16);
                    *(u32x4*)(MIX + (tok0 + (size_t)n * 64 + row) * DM + 128 * h + ch * 8) = v; }
            }
        } else {
#pragma unroll
            for (int mt = 0; mt < 2; ++mt)
#pragma unroll
                for (int nt = 0; nt < 8; ++nt) st[mt][nt] = st[mt][nt] * g64;
#pragma unroll
            for (int ks = 0; ks < 2; ++ks) {
                bf16x8 akt[2];
#pragma unroll
                for (int mt = 0; mt < 2; ++mt) { const int row = 32 * w4 + 16 * mt + l15; akt[mt] = *(const LAS bf16x8*)(lds + KT_OFF + row * 144 + 16 * ((4 * ks + l4) ^ ((row >> 3) & 7))); }
#pragma unroll
                for (int nt = 0; nt < 8; ++nt) { const bf16x8 bv = *(const LAS bf16x8*)(lds + VT_ADDR(nt, ks));
#pragma unroll
                    for (int mt = 0; mt < 2; ++mt) st[mt][nt] = MFMA16(akt[mt], bv, st[mt][nt]); }
            }
        }
        __syncthreads();
    }
    if (is_state) {
        if (!FULL) {
            float* dst = UG + ((size_t)unit * 4 + w4) * 4096 + lane;
#pragma unroll
            for (int mt = 0; mt < 2; ++mt)
#pragma unroll
                for (int nt = 0; nt < 8; ++nt)
#pragma unroll
                    for (int r = 0; r < 4; ++r) dst[((mt * 8 + nt) * 4 + r) * 64] = st[mt][nt][r];
        } else if (G == 7) {
            float* o = p.out + O_SRP + (size_t)(b * 4 + h) * 16384 + (64 * (l4 & 1) + 16 * w4 + 4 * (l4 >> 1)) * 128 + l15;
#pragma unroll
            for (int mt = 0; mt < 2; ++mt)
#pragma unroll
                for (int nt = 0; nt < 8; ++nt)
#pragma unroll
                    for (int r = 0; r < 4; ++r) o[(8 * mt + r) * 128 + 16 * nt] = st[mt][nt][r];
        }
    }
    if (FULL) {
        const int c0 = 128 * h + 8 * (tid & 15), run = tid >> 4, t0 = G * 512 + run * 16;
        const float* cwp = p.in[7];
        float w0[8], w1[8], w2[8], p1[8], p2[8];
#pragma unroll
        for (int e = 0; e < 8; ++e) { w0[e] = cwp[c0 + e]; w1[e] = cwp[512 + c0 + e]; w2[e] = cwp[1024 + c0 + e]; p1[e] = 0.f; p2[e] = 0.f; }
        if (t0 > 0) {
            const bf16_t* r2 = P + ((size_t)b * 4096 + t0 - 2) * NIN; const bf16_t* r1 = r2 + NIN;
            const u32x4 c2 = *(const u32x4*)(r2 + 2560 + c0), h2 = *(const u32x4*)(r2 + 3072 + c0), c1 = *(const u32x4*)(r1 + 2560 + c0), h1 = *(const u32x4*)(r1 + 3072 + c0);
            const unsigned c2w[4] = {c2.x, c2.y, c2.z, c2.w}, h2w[4] = {h2.x, h2.y, h2.z, h2.w}, c1w[4] = {c1.x, c1.y, c1.z, c1.w}, h1w[4] = {h1.x, h1.y, h1.z, h1.w};
#pragma unroll
            for (int e = 0; e < 4; ++e) {
                p2[2 * e] = __uint_as_float(c2w[e] << 16) * __uint_as_float(h2w[e] << 16); p2[2 * e + 1] = __uint_as_float(c2w[e] & 0xffff0000u) * __uint_as_float(h2w[e] & 0xffff0000u);
                p1[2 * e] = __uint_as_float(c1w[e] << 16) * __uint_as_float(h1w[e] << 16); p1[2 * e + 1] = __uint_as_float(c1w[e] & 0xffff0000u) * __uint_as_float(h1w[e] & 0xffff0000u); }
        }
#pragma unroll 4
        for (int t = 0; t < 16; ++t) {
            const size_t row = (size_t)b * 4096 + t0 + t;
            const bf16_t* rp = P + row * NIN;
            const u32x4 bb = *(const u32x4*)(rp + 2048 + c0), cc = *(const u32x4*)(rp + 2560 + c0), hh = *(const u32x4*)(rp + 3072 + c0);
            const unsigned bw[4] = {bb.x, bb.y, bb.z, bb.w}, cw4[4] = {cc.x, cc.y, cc.z, cc.w}, hw[4] = {hh.x, hh.y, hh.z, hh.w};
            float y[8];
#pragma unroll
            for (int e = 0; e < 4; ++e) {
                const float ca = __uint_as_float(cw4[e] << 16) * __uint_as_float(hw[e] << 16), cb = __uint_as_float(cw4[e] & 0xffff0000u) * __uint_as_float(hw[e] & 0xffff0000u);
                y[2 * e] = __uint_as_float(bw[e] << 16) * (w0[2 * e] * p2[2 * e] + w1[2 * e] * p1[2 * e] + w2[2 * e] * ca);
                y[2 * e + 1] = __uint_as_float(bw[e] & 0xffff0000u) * (w0[2 * e + 1] * p2[2 * e + 1] + w1[2 * e + 1] * p1[2 * e + 1] + w2[2 * e + 1] * cb);
                p2[2 * e] = p1[2 * e]; p2[2 * e + 1] = p1[2 * e + 1]; p1[2 * e] = ca; p1[2 * e + 1] = cb;
            }
            *(u32x4*)(MIX + row * DM + 512 + c0) = (u32x4){pk2(y[0], y[1]), pk2(y[2], y[3]), pk2(y[4], y[5]), pk2(y[6], y[7])};
        }
        if (G == 7 && run == 31) {
            float* o = p.out + O_CCP + (size_t)b * 1024 + c0;
#pragma unroll
            for (int e = 0; e < 8; ++e) { o[e] = p2[e]; o[512 + e] = p1[e]; }
        }
    }
}

__device__ __forceinline__ float ch_at(const bf16_t* P, const float* cache, int b, int ts0, int t, int ch) {
    if (t < 0) return cache[(b * 2 + (t + 2)) * 512 + ch];
    const bf16_t* rp = P + (size_t)(ts0 + t) * NIN;
    return bf2f(rp[2560 + ch]) * bf2f(rp[3072 + ch]);
}
__device__ __forceinline__ void sample_unit(const Params& p, LAS unsigned char* lds, int su, int tid, int wid, int lane) {
    const int b = su >> 2, h = su & 3, ts0 = TOK_P + 16 * b;
    const bf16_t* P = (const bf16_t*)(p.ws + WS_RB);
    bf16_t* MIX = (bf16_t*)(p.ws + WS_RA);
    LAS float* qs = (LAS float*)lds; LAS float* ks = qs + 2048; LAS float* vs = qs + 4096; LAS float* Ssm = qs + 6144; LAS float* osm = qs + 6400;
    const float l2g = log2f(1.0f - exp2f(-5.0f - (float)h));
    for (int idx = tid; idx < 2048; idx += 512) { const int i = idx >> 7, c = idx & 127; const bf16_t* rp = P + (size_t)(ts0 + i) * NIN + 128 * h + c;
        qs[i * 128 + dmap(c)] = bf2f(rp[0]); ks[i * 128 + dmap(c)] = bf2f(rp[512]); vs[i * 128 + c] = bf2f(rp[1024]); }
    __syncthreads();
    if (tid < 256) { const int i = tid >> 4, j = tid & 15; float s = 0.f;
        for (int d = 0; d < 128; ++d) s += qs[i * 128 + d] * ks[j * 128 + d];
        const int dd = i - j; Ssm[i * 16 + j] = s * __builtin_amdgcn_exp2f(l2g * (float)(dd < 0 ? -dd : dd)); }
    const int e = tid & 127, ig = tid >> 7;
    const float* s0 = p.in[2] + (size_t)su * 16384;
    float cr[4] = {0.f, 0.f, 0.f, 0.f};
#pragma unroll 16
    for (int d = 0; d < 128; ++d) { const float sv = s0[d * 128 + e];
#pragma unroll
        for (int r = 0; r < 4; ++r) cr[r] += qs[(ig * 4 + r) * 128 + d] * sv; }
    __syncthreads();
#pragma unroll
    for (int r = 0; r < 4; ++r) { const int i = ig * 4 + r; float o = 0.f;
        for (int j = 0; j < 16; ++j) o += Ssm[i * 16 + j] * vs[j * 128 + e];
        osm[i * 128 + e] = o + __builtin_amdgcn_exp2f(l2g * (float)(i + 1)) * cr[r]; }
    __syncthreads();
    for (int rr = 0; rr < 2; ++rr) { const int i = 2 * wid + rr; const float v0 = osm[i * 128 + lane], v1 = osm[i * 128 + 64 + lane];
        const float rstd = rsqrtf(wave_sum(v0 * v0 + v1 * v1) * (1.0f / 128.0f) + EPS);
        const size_t token = (size_t)(ts0 + i);
        const float g0 = bf2f(P[token * NIN + 1536 + 128 * h + lane]), g1 = bf2f(P[token * NIN + 1536 + 128 * h + 64 + lane]);
        MIX[token * DM + 128 * h + lane] = (bf16_t)(pk2(v0 * rstd * p.in[8][128 * h + lane] * silu_f(g0), 0.f) & 0xffffu);
        MIX[token * DM + 128 * h + 64 + lane] = (bf16_t)(pk2(v1 * rstd * p.in[8][128 * h + 64 + lane] * silu_f(g1), 0.f) & 0xffffu); }
    const float g16 = __builtin_amdgcn_exp2f(l2g * 16.0f);
    float* outS = p.out + O_SRS + (size_t)su * 16384;
#pragma unroll 8
    for (int dd = 0; dd < 32; ++dd) { const int d = ig + 4 * dd; float a = g16 * s0[d * 128 + e];
        for (int j = 0; j < 16; ++j) a += __builtin_amdgcn_exp2f(l2g * (float)(15 - j)) * ks[j * 128 + d] * vs[j * 128 + e];
        outS[d * 128 + e] = a; }
    const int ch = 128 * h + e; const float* cache = p.in[3]; const float* cwp = p.in[7];
    const float w0 = cwp[ch], w1 = cwp[512 + ch], w2 = cwp[1024 + ch];
#pragma unroll
    for (int tt = 0; tt < 4; ++tt) { const int t = ig * 4 + tt;
        const float c0 = ch_at(P, cache, b, ts0, t - 2, ch), c1 = ch_at(P, cache, b, ts0, t - 1, ch), c2 = ch_at(P, cache, b, ts0, t, ch);
        const float y = bf2f(P[(size_t)(ts0 + t) * NIN + 2048 + ch]) * (w0 * c0 + w1 * c1 + w2 * c2);
        MIX[(size_t)(ts0 + t) * DM + 512 + ch] = (bf16_t)(pk2(y, 0.f) & 0xffffu);
        if (t >= 14) p.out[O_CCS + (size_t)(b * 2 + t - 14) * 512 + ch] = c2; }
    __syncthreads();
}

__device__ __forceinline__ void phase4(const Params& p, int wid, int lane) {
    const int gw = blockIdx.x * 8 + wid, NGW = gridDim.x * 8;
    const bf16_t* Y = (const bf16_t*)(p.ws + WS_RB); bf16_t* H2 = (bf16_t*)(p.ws + WS_RA); const float* ssq = (const float*)(p.ws + WS_SSQ1);
    const float* wpost = p.in[10]; const float* wpre = p.in[11];
    for (int r = gw; r < TOKPAD; r += NGW) {
        u32x2* o8 = (u32x2*)(H2 + (size_t)r * DM) + lane;
        if (r >= TOK) {
#pragma unroll
            for (int j = 0; j < 4; ++j) o8[64 * j] = (u32x2){0u, 0u};
            continue; }
        const float* xrow = r < TOK_P ? p.in[0] + (size_t)r * DM : p.in[1] + (size_t)(r - TOK_P) * DM;
        const float tot = wave_sum(lane < 16 ? ssq[(size_t)r * 16 + lane] : 0.f);
        const float rstd1 = rsqrtf(tot * (1.0f / DM) + EPS);
        f32x4 v[4]; float s2 = 0.f;
#pragma unroll
        for (int j = 0; j < 4; ++j) {
            const f32x4 xv = *((const f32x4*)xrow + lane + 64 * j); const u32x2 yw = *((const u32x2*)(Y + (size_t)r * DM) + lane + 64 * j); const f32x4 w = *((const f32x4*)wpost + lane + 64 * j);
            f32x4 yv; yv[0] = __uint_as_float(yw.x << 16); yv[1] = __uint_as_float(yw.x & 0xffff0000u); yv[2] = __uint_as_float(yw.y << 16); yv[3] = __uint_as_float(yw.y & 0xffff0000u);
            v[j] = xv + (yv * rstd1) * w;
            s2 += (v[j][0] * v[j][0] + v[j][1] * v[j][1]) + (v[j][2] * v[j][2] + v[j][3] * v[j][3]);
            *((f32x4*)(p.out + (size_t)r * DM) + lane + 64 * j) = v[j];
        }
        const float rstd2 = rsqrtf(wave_sum(s2) * (1.0f / DM) + EPS);
#pragma unroll
        for (int j = 0; j < 4; ++j) { const f32x4 w = *((const f32x4*)wpre + lane + 64 * j); const f32x4 y = (v[j] * rstd2) * w; o8[64 * j] = (u32x2){pk2(y[0], y[1]), pk2(y[2], y[3])}; }
    }
}
__device__ __forceinline__ void phase7(const Params& p, int wid, int lane) {
    const int gw = blockIdx.x * 8 + wid, NGW = gridDim.x * 8;
    const bf16_t* F = (const bf16_t*)(p.ws + WS_RA); const float* ssq = (const float*)(p.ws + WS_SSQ2); const float* wpost = p.in[12];
    for (int r = gw; r < TOK; r += NGW) {
        const float tot = wave_sum(lane < 16 ? ssq[(size_t)r * 16 + lane] : 0.f);
        const float rstd = rsqrtf(tot * (1.0f / DM) + EPS);
#pragma unroll
        for (int j = 0; j < 4; ++j) {
            f32x4* op = (f32x4*)(p.out + (size_t)r * DM) + lane + 64 * j;
            const f32x4 xv = *op; const u32x2 yw = *((const u32x2*)(F + (size_t)r * DM) + lane + 64 * j); const f32x4 w = *((const f32x4*)wpost + lane + 64 * j);
            f32x4 yv; yv[0] = __uint_as_float(yw.x << 16); yv[1] = __uint_as_float(yw.x & 0xffff0000u); yv[2] = __uint_as_float(yw.y << 16); yv[3] = __uint_as_float(yw.y & 0xffff0000u);
            *op = xv + (yv * rstd) * w;
        }
    }
}


#define XB_TMO      128
#define XB_XCNT(j)  (256  + 64 * (j))
#define XB_XSUB(j)  (1280 + 64 * (j))
#define XB_XGEN(j)  (2304 + 64 * (j))
#define XB_TOP      3328
#define XB_TOPGEN   3392
#define XCD_BAR_WORDS 3456
#define XB_SPIN_CAP (1u << 18)

__device__ __forceinline__ unsigned xb_ld(unsigned* p)              { return __hip_atomic_load(p, __ATOMIC_RELAXED, __HIP_MEMORY_SCOPE_AGENT); }
__device__ __forceinline__ unsigned xb_add(unsigned* p, unsigned v) { return __hip_atomic_fetch_add(p, v, __ATOMIC_RELAXED, __HIP_MEMORY_SCOPE_AGENT); }
__device__ __forceinline__ unsigned xb_xcc_id() { return (unsigned)__builtin_amdgcn_s_getreg((3 << 11) | 20) & 0xFu; }
#define XB_SPIN(cond, bar) do { unsigned _sp = 0; while (cond) { __builtin_amdgcn_s_sleep(1); \
    if ((++_sp & 255u) == 0u) { if (xb_ld(&(bar)[XB_TMO])) break; if (_sp > XB_SPIN_CAP) { atomicAdd(&(bar)[XB_TMO], 1u); break; } } } } while (0)

struct XcdBarrier {
    unsigned* bar; unsigned x;
    volatile LAS unsigned* st;
};

__device__ __forceinline__ XcdBarrier xcd_barrier_post(unsigned* bar, volatile LAS unsigned* st) {
    XcdBarrier b; b.bar = bar; b.x = xb_xcc_id(); b.st = st;
    if (threadIdx.x == 0) (void)xb_add(&bar[XB_XCNT(b.x)], 1u);
    return b;
}
__device__ __forceinline__ void xcd_barrier_complete(unsigned* bar, unsigned x, unsigned& nloc, unsigned& nx) {
    const unsigned G = gridDim.x * gridDim.y * gridDim.z;
    unsigned sum, cnt, mine, sp = 0u;
    for (;;) {
        sum = 0u; cnt = 0u; mine = 0u;
#pragma unroll
        for (unsigned j = 0; j < 16; ++j) { const unsigned c = xb_ld(&bar[XB_XCNT(j)]); sum += c; cnt += (c > 0u) ? 1u : 0u; mine = (j == x) ? c : mine; }
        if (sum == G) break;
        __builtin_amdgcn_s_sleep(1);
        if ((++sp & 255u) == 0u) { if (xb_ld(&bar[XB_TMO])) break; if (sp > XB_SPIN_CAP) { atomicAdd(&bar[XB_TMO], 1u); break; } }
    }
    nloc = mine > 0u ? mine : 1u; nx = cnt > 0u ? cnt : 1u;
}

__device__ __forceinline__ void xcd_barrier(const XcdBarrier& b) {
    asm volatile("s_waitcnt vmcnt(0)" ::: "memory");
    __syncthreads();
    if (threadIdx.x == 0) {
        unsigned* bar = b.bar;
        __builtin_amdgcn_s_waitcnt(0);
        unsigned nloc = b.st[0], nx = b.st[1];
        if (nloc == 0u) { xcd_barrier_complete(bar, b.x, nloc, nx); b.st[0] = nloc; b.st[1] = nx; }
        const unsigned old = xb_add(&bar[XB_XSUB(b.x)], 1u);
        const unsigned gen = old / nloc;
        if (old + 1u == (gen + 1u) * nloc) {
            __builtin_amdgcn_fence(__ATOMIC_RELEASE, "agent");
            asm volatile("s_waitcnt vmcnt(0)" ::: "memory");
            const unsigned og = xb_add(&bar[XB_TOP], 1u);
            const unsigned tg = og / nx;
            if (og + 1u == (tg + 1u) * nx) xb_add(&bar[XB_TOPGEN], 1u);
            else XB_SPIN(xb_ld(&bar[XB_TOPGEN]) == tg, bar);
            __builtin_amdgcn_fence(__ATOMIC_ACQUIRE, "agent");
            xb_add(&bar[XB_XGEN(b.x)], 1u);
            asm volatile("s_waitcnt vmcnt(0)" ::: "memory");
        } else {
            XB_SPIN(xb_ld(&bar[XB_XGEN(b.x)]) == gen, bar);
            __builtin_amdgcn_fence(__ATOMIC_ACQUIRE, "agent");
            asm volatile("s_waitcnt vmcnt(0)" ::: "memory");
        }
    }
    __syncthreads();
}

#ifndef MK_LAUNCHES
#define MK_LAUNCHES 1
#endif
#ifndef REP0
#define REP0 1
#endif
#ifndef REP1
#define REP1 1
#endif
#ifndef REP2
#define REP2 1
#endif
#ifndef REP3
#define REP3 1
#endif
#ifndef REP4
#define REP4 1
#endif
#ifndef REP5
#define REP5 1
#endif
#ifndef REP6
#define REP6 1
#endif
#ifndef REP7
#define REP7 1
#endif
#define REPEAT(n) for (int rep_ = 0; rep_ < (n); ++rep_, ((rep_ < (n)) ? GRIDSYNC() : (void)0))
template <int PH_LO, int PH_HI>
__device__ __forceinline__ void run_phases(const Params& p, LAS unsigned char* lds) {
    int tid = threadIdx.x, lane = tid & 63; const int wid = __builtin_amdgcn_readfirstlane(tid >> 6);
    const int G = gridDim.x, c = blockIdx.x;
#define LAUNDER() asm volatile("" : "+v"(tid), "+v"(lane))
    XcdBarrier bar_;
    if (PH_HI - PH_LO > 1) {
        volatile LAS unsigned* stw = (volatile LAS unsigned*)(lds + LDS_BARW);
        if (threadIdx.x == 0) { stw[0] = 0u; stw[1] = 0u; }
        __syncthreads();
        bar_ = xcd_barrier_post((unsigned*)p.ws, stw);
        if (p.ws == nullptr) cg::this_grid().sync();
    }
#define GRIDSYNC() xcd_barrier(bar_)
#define SEAM(ph) do { if (PH_LO <= (ph) && (ph) + 1 < PH_HI) { GRIDSYNC(); } } while (0)
#ifdef XSYNC
    for (int xs_ = 0; xs_ < XSYNC; ++xs_) GRIDSYNC();
#endif
    if (PH_LO <= 0 && 0 < PH_HI) REPEAT(REP0) { LAUNDER(); phase0(p, lds, tid, wid, lane); }
    SEAM(0);
    if (PH_LO <= 1 && 1 < PH_HI) REPEAT(REP1) {
        pg8::Gemm g{(const bf16_t*)(p.ws + WS_RA), (const bf16_t*)(p.ws + WS_WIN), TOKPAD, NIN, DM};
        pg8::StaticOrder S; S.init(TOKPAD, NIN, G, c);
        pg8::EpiIn E{(bf16_t*)(p.ws + WS_RB), (const float*)(p.ws + WS_COS), (const float*)(p.ws + WS_SIN)};
        pg8::gemm_phase<pg8::EpiIn, pg8::StaticOrder, true, true>(lds, g, S, E);
    }
    SEAM(1);
    if (PH_LO <= 2 && 2 < PH_HI) REPEAT(REP2) {
        for (int u = c; u < 256; u += G) ret_unit<false>(p, lds, u, tid, wid, lane);
        LAUNDER();
        for (int su = c; su < 32; su += G) sample_unit(p, lds, su, tid, wid, lane);
    }
    SEAM(2);
    if (PH_LO <= 3 && 3 < PH_HI) REPEAT(REP3) {
        for (int u = c; u < 256; u += G) ret_unit<true>(p, lds, u, tid, wid, lane);
    }
    SEAM(3);
    if (PH_LO <= 4 && 4 < PH_HI) REPEAT(REP4) {
        pg8::Gemm g{(const bf16_t*)(p.ws + WS_RA), (const bf16_t*)(p.ws + WS_WOUT), TOKPAD, DM, DM};
        pg8::StaticOrder S; S.init(TOKPAD, DM, G, c);
        pg8::EpiY E{(bf16_t*)(p.ws + WS_RB), (float*)(p.ws + WS_SSQ1)};
        pg8::gemm_phase<pg8::EpiY, pg8::StaticOrder, true, true>(lds, g, S, E);
    }
    SEAM(4);
    if (PH_LO <= 5 && 5 < PH_HI) REPEAT(REP5) { LAUNDER(); phase4(p, wid, lane); }
    SEAM(5);
    if (PH_LO <= 6 && 6 < PH_HI) REPEAT(REP6) {
        pg8::Gemm g{(const bf16_t*)(p.ws + WS_RA), (const bf16_t*)(p.ws + WS_WFF1), TOKPAD, 2 * DFF, DM};
        pg8::WalkOrder S{G, c};
        pg8::EpiFfn E{(bf16_t*)(p.ws + WS_RB), p.in[15], p.in[4], p.out + O_CFP, p.out + O_CFS, (LAS float*)(lds + LDS_HALO)};
        pg8::gemm_phase<pg8::EpiFfn, pg8::WalkOrder, true, true>(lds, g, S, E);
    }
    SEAM(6);
    if (PH_LO <= 7 && 7 < PH_HI) REPEAT(REP7) {
        pg8::Gemm g{(const bf16_t*)(p.ws + WS_RB), (const bf16_t*)(p.ws + WS_WDN), TOKPAD, DM, DFF};
        pg8::StaticOrder S; S.init(TOKPAD, DM, G, c);
        pg8::EpiY E{(bf16_t*)(p.ws + WS_RA), (float*)(p.ws + WS_SSQ2)};
        pg8::gemm_phase<pg8::EpiY, pg8::StaticOrder, true, true>(lds, g, S, E);
    }
    SEAM(7);
    if (PH_LO <= 8 && 8 < PH_HI) { LAUNDER(); phase7(p, wid, lane); }
#undef SEAM
}
constexpr int NPH = 9;
#if MK_LAUNCHES == 1
__global__ void __launch_bounds__(512, 2) fwd_kernel(Params p) {
    extern __shared__ __attribute__((aligned(16))) unsigned char smem[];
    run_phases<0, NPH>(p, (LAS unsigned char*)smem);
}
#else
template <int PH>
__global__ void __launch_bounds__(512, 2) fwd_phase(Params p) {
    extern __shared__ __attribute__((aligned(16))) unsigned char smem[];
    run_phases<PH, PH + 1>(p, (LAS unsigned char*)smem);
}
template <int PH> static void launch_phase(const Params& p, int grid, hipStream_t stream) {
    static bool attr = false;
    if (!attr) { (void)hipFuncSetAttribute((const void*)fwd_phase<PH>, hipFuncAttributeMaxDynamicSharedMemorySize, LDS_BYTES); attr = true; }
    hipLaunchKernelGGL(fwd_phase<PH>, dim3(grid), dim3(512), LDS_BYTES, stream, p);
}
#endif

extern "C" void kernel_launch(void* const* d_in, const int* in_sizes, int n_in, void* d_out, int out_size, void* d_ws, size_t ws_size, hipStream_t stream) {
    static int grid = 0;
    if (grid == 0) {
        if (n_in != 17 || ws_size < WS_END) { fprintf(stderr, "kernel_launch: expected 17 inputs and >= %zu bytes of workspace (got %d, %zu)\n", (size_t)WS_END, n_in, ws_size); grid = -1; return; }
        int dev = 0, cus = 0, per_cu = 0;
        (void)hipGetDevice(&dev); (void)hipDeviceGetAttribute(&cus, hipDeviceAttributeMultiprocessorCount, dev);
#if MK_LAUNCHES == 1
        if (hipFuncSetAttribute((const void*)fwd_kernel, hipFuncAttributeMaxDynamicSharedMemorySize, LDS_BYTES) != hipSuccess) { fprintf(stderr, "kernel_launch: hipFuncSetAttribute failed\n"); grid = -1; return; }
        if (hipOccupancyMaxActiveBlocksPerMultiprocessor(&per_cu, (const void*)fwd_kernel, 512, LDS_BYTES) != hipSuccess || per_cu < 1) { fprintf(stderr, "kernel_launch: occupancy query says %d\n", per_cu); per_cu = 1; }
        (void)hipGetLastError();
#endif
        grid = cus > 0 ? cus : 256;
    }
    if (grid < 0) return;
    Params p{};
    for (int i = 0; i < 17; ++i) p.in[i] = (const float*)d_in[i];
    p.out = (float*)d_out; p.ws = (unsigned char*)d_ws;
#if MK_LAUNCHES == 1
    if (hipMemsetAsync(d_ws, 0, 16384, stream) != hipSuccess) { fprintf(stderr, "kernel_launch: hipMemsetAsync failed\n"); return; }
    void* args[] = {&p};
    const hipError_t e = hipLaunchCooperativeKernel((const void*)fwd_kernel, dim3(grid), dim3(512), args, LDS_BYTES, stream);
    if (e != hipSuccess) fprintf(stderr, "kernel_launch: cooperative launch failed: %s (grid %d)\n", hipGetErrorString(e), grid);
#else
    launch_phase<0>(p, grid, stream); launch_phase<1>(p, grid, stream); launch_phase<2>(p, grid, stream); launch_phase<3>(p, grid, stream); launch_phase<4>(p, grid, stream);
    launch_phase<5>(p, grid, stream); launch_phase<6>(p, grid, stream); launch_phase<7>(p, grid, stream); launch_phase<8>(p, grid, stream);
#endif
}
```

```cpp
#include <hip/hip_runtime.h>
#include <hip/hip_cooperative_groups.h>
#include <cstdio>
#include <cstdint>
namespace cg = cooperative_groups;
namespace pg8 {
#define PG8_LAS __attribute__((address_space(3)))
typedef unsigned short bf16_t;
typedef short bf16x8 __attribute__((ext_vector_type(8)));
typedef float f32x4 __attribute__((ext_vector_type(4)));
typedef unsigned u32x4 __attribute__((ext_vector_type(4)));
constexpr int BM = 256, BK = 64, HALF = 128, HTB = HALF * BK * 2  , STAGE_BYTES = 8 * HTB, NXCD = 8, WGM = 8;

__host__ __device__ __forceinline__ int lds_byte(int r, int c) { const int st = (r >> 4) * 2 + (c >> 5), rr = r & 15, cc = c & 31, ob = rr * 64 + cc * 2; return st * 1024 + (ob ^ (((ob >> 9) & 1) << 5)); }
__host__ __device__ __forceinline__ void stage_rc(int b, int& R, int& C) { const int st = b / 1024, sb = b % 1024, swz = sb ^ (((sb >> 9) & 1) << 5); R = (st >> 1) * 16 + swz / 64; C = (st & 1) * 32 + (swz % 64) / 2; }
__host__ __device__ __forceinline__ int perm32(int rho) { const int n = rho >> 4, i = rho & 15; return 8 * (i >> 2) + 4 * n + (i & 3); }

struct Unit { int pm, pn; };
struct Gemm { const bf16_t* A; const bf16_t* Bt; int M, N, K; };

struct StaticOrder {
    int nM, nN, nwg, G, c;
    __host__ __device__ void init(int M, int N, int G_, int c_) { nM = M / BM; nN = N / BM; nwg = nM * nN; G = G_; c = c_; }
    __host__ __device__ bool next(int i, Unit& u) const {
        const long L = (long)i * G + c; if (L >= nwg) return false;
        int wgid = (int)L; { const int q = nwg / NXCD, r = nwg % NXCD, xcd = wgid % NXCD, off = wgid / NXCD; wgid = (xcd < r ? xcd * (q + 1) : r * (q + 1) + (xcd - r) * q) + off; }
        const int nig = WGM * nN, gid = wgid / nig, fm = gid * WGM, gsz = (nM - fm) < WGM ? (nM - fm) : WGM;
        u.pm = fm + ((wgid % nig) % gsz); u.pn = (wgid % nig) / gsz; return true;
    }
    __device__ __forceinline__ void a_ready(const Unit&) const {}
    __device__ __forceinline__ void done(const Unit&) const {}
};
__device__ __forceinline__ unsigned cvt_pk_bf16(float lo, float hi) { unsigned r; asm volatile("v_cvt_pk_bf16_f32 %0, %1, %2" : "=v"(r) : "v"(lo), "v"(hi)); return r; }
__device__ __forceinline__ float dpp_shr1(float v) { return __builtin_bit_cast(float, __builtin_amdgcn_update_dpp(0, __builtin_bit_cast(int, v), 0x111, 0xf, 0xf, true)); }
__device__ __forceinline__ float dpp_shr2(float v) { return __builtin_bit_cast(float, __builtin_amdgcn_update_dpp(0, __builtin_bit_cast(int, v), 0x112, 0xf, 0xf, true)); }
__device__ __forceinline__ float dpp_shl15(float v) { return __builtin_bit_cast(float, __builtin_amdgcn_update_dpp(0, __builtin_bit_cast(int, v), 0x10F, 0xf, 0xf, true)); }
__device__ __forceinline__ float dpp_shl14(float v) { return __builtin_bit_cast(float, __builtin_amdgcn_update_dpp(0, __builtin_bit_cast(int, v), 0x10E, 0xf, 0xf, true)); }
__device__ __forceinline__ float gelu_tanh(float x) {
    const float z = 0.7978845608028654f * (x + 0.044715f * x * x * x);
    const float e = __builtin_amdgcn_exp2f(-2.8853900817779268f * z);
    return x * __builtin_amdgcn_rcpf(1.0f + e);
}
constexpr int TOKP = 32768;

struct EpiIn {
    static constexpr bool PERM = true, AFTER_DRAIN = false;
    bf16_t* P; const float* cosT; const float* sinT;
    __device__ __forceinline__ void operator()(const f32x4 (&acc)[2][2][4][2], const Unit& u, int wr, int wc, int fr, int fq) const {
        asm volatile("" : "+v"(fr), "+v"(fq));
        const int row0 = u.pm * BM + wr * 64 + fr, col0 = u.pn * BM + wc * 32 + 8 * fq;
        if (u.pn < 4) {
            const float sc = (u.pn >= 2) ? 0.08838834764831845f : 1.0f;
            const int f0 = 16 * wc + 4 * fq;
#pragma unroll
            for (int ai = 0; ai < 2; ++ai)
#pragma unroll
                for (int m = 0; m < 4; ++m) {
                    const int r = row0 + ai * HALF + m * 16;
                    const int pos = r < TOKP ? (r & 4095) : 4096 + ((r - TOKP) & 15);
                    const f32x4 c4 = *(const f32x4*)(cosT + pos * 64 + f0), s4 = *(const f32x4*)(sinT + pos * 64 + f0);
                    bf16_t* rowp = P + (size_t)r * 3584 + col0;
#pragma unroll
                    for (int bj = 0; bj < 2; ++bj) {
                        const f32x4 x1 = acc[ai][bj][m][0], x2 = acc[ai][bj][m][1];
                        const f32x4 o1 = (x1 * c4 - x2 * s4) * sc, o2 = (x2 * c4 + x1 * s4) * sc;
                        u32x4 w; w.x = cvt_pk_bf16(o1[0], o1[1]); w.y = cvt_pk_bf16(o1[2], o1[3]); w.z = cvt_pk_bf16(o2[0], o2[1]); w.w = cvt_pk_bf16(o2[2], o2[3]);
                        *(u32x4*)(rowp + bj * HALF) = w;
                    }
                }
        } else {
#pragma unroll
            for (int ai = 0; ai < 2; ++ai)
#pragma unroll
                for (int m = 0; m < 4; ++m) {
                    bf16_t* rowp = P + (size_t)(row0 + ai * HALF + m * 16) * 3584 + col0;
#pragma unroll
                    for (int bj = 0; bj < 2; ++bj) {
                        const f32x4 v0 = acc[ai][bj][m][0], v1 = acc[ai][bj][m][1];
                        u32x4 w; w.x = cvt_pk_bf16(v0[0], v0[1]); w.y = cvt_pk_bf16(v0[2], v0[3]); w.z = cvt_pk_bf16(v1[0], v1[1]); w.w = cvt_pk_bf16(v1[2], v1[3]);
                        *(u32x4*)(rowp + bj * HALF) = w;
                    }
                }
        }
    }
};

struct EpiY {
    static constexpr bool PERM = true, AFTER_DRAIN = false;
    bf16_t* Y; float* ssq;
    __device__ __forceinline__ void operator()(const f32x4 (&acc)[2][2][4][2], const Unit& u, int wr, int wc, int fr, int fq) const {
        asm volatile("" : "+v"(fr), "+v"(fq));
        const int row0 = u.pm * BM + wr * 64 + fr, col0 = u.pn * BM + wc * 32 + 8 * fq;
#pragma unroll
        for (int ai = 0; ai < 2; ++ai)
#pragma unroll
            for (int m = 0; m < 4; ++m) {
                const int r = row0 + ai * HALF + m * 16;
                bf16_t* rowp = Y + (size_t)r * 1024 + col0;
                float s = 0.f;
#pragma unroll
                for (int bj = 0; bj < 2; ++bj) {
                    const f32x4 v0 = acc[ai][bj][m][0], v1 = acc[ai][bj][m][1];
                    s += (v0[0] * v0[0] + v0[1] * v0[1]) + (v0[2] * v0[2] + v0[3] * v0[3]) + (v1[0] * v1[0] + v1[1] * v1[1]) + (v1[2] * v1[2] + v1[3] * v1[3]);
                    u32x4 w; w.x = cvt_pk_bf16(v0[0], v0[1]); w.y = cvt_pk_bf16(v0[2], v0[3]); w.z = cvt_pk_bf16(v1[0], v1[1]); w.w = cvt_pk_bf16(v1[2], v1[3]);
                    *(u32x4*)(rowp + bj * HALF) = w;
                }
                s += __shfl_xor(s, 16); s += __shfl_xor(s, 32);
                if (fq == 0) ssq[(size_t)r * 16 + u.pn * 4 + wc] = s;
            }
    }
};

struct EpiFfn {
    static constexpr bool PERM = true, AFTER_DRAIN = false;
    bf16_t* ACT; const float* cw; const float* cache; float* outp; float* outs; PG8_LAS float* halo;
    __device__ __forceinline__ void operator()(const f32x4 (&acc)[2][2][4][2], const Unit& u, int wr, int wc, int fr, int fq) const {
        asm volatile("" : "+v"(fr), "+v"(fq));
        const int lc0 = wc * 32 + 8 * fq, ch0 = u.pn * 128 + lc0;
        const bool sample = false;
        const int par = u.pm & 1;
        f32x4 w0[2], w1[2], w2[2];
#pragma unroll
        for (int n = 0; n < 2; ++n) { w0[n] = *(const f32x4*)(cw + ch0 + 4 * n); w1[n] = *(const f32x4*)(cw + 4096 + ch0 + 4 * n); w2[n] = *(const f32x4*)(cw + 8192 + ch0 + 4 * n); }
        if (!sample && fr >= 14) {
#pragma unroll
            for (int ai = 0; ai < 2; ++ai) { PG8_LAS float* hp = halo + ((par * 4 + 2 * ai + wr) * 2 + (fr - 14)) * 128 + lc0;
                *(PG8_LAS f32x4*)hp = acc[ai][0][3][0]; *(PG8_LAS f32x4*)(hp + 4) = acc[ai][0][3][1]; }
        }
        asm volatile("s_waitcnt lgkmcnt(0)" ::: "memory"); __builtin_amdgcn_s_barrier(); asm volatile("" ::: "memory");
#pragma unroll
        for (int ai = 0; ai < 2; ++ai) {
            const int blk = 2 * ai + wr;
#pragma unroll
            for (int m = 0; m < 4; ++m) {
                f32x4 pv[2]; pv[0] = (f32x4){0.f, 0.f, 0.f, 0.f}; pv[1] = pv[0];
                const int sb = 8 * ai + 4 * wr + m;
                if (sample) {
                    if (fr >= 14 && sb < 8) { const float* cp = cache + (size_t)(sb * 2 + fr - 14) * 4096 + ch0; pv[0] = *(const f32x4*)cp; pv[1] = *(const f32x4*)(cp + 4); }
                } else if (m == 0) {
                    if (fr >= 14) {
                        const bool zero = (blk == 0) && ((u.pm & 15) == 0);
                        const int hb = (blk == 0) ? ((par ^ 1) * 4 + 3) : (par * 4 + blk - 1);
                        if (!zero) { const PG8_LAS float* hp = halo + (hb * 2 + fr - 14) * 128 + lc0; pv[0] = *(const PG8_LAS f32x4*)hp; pv[1] = *(const PG8_LAS f32x4*)(hp + 4); }
                    }
                } else { pv[0] = acc[ai][0][m - 1][0]; pv[1] = acc[ai][0][m - 1][1]; }
                const int r = u.pm * BM + ai * HALF + wr * 64 + m * 16 + fr;
                float a8[8];
#pragma unroll
                for (int n = 0; n < 2; ++n)
#pragma unroll
                    for (int e = 0; e < 4; ++e) {
                        const float cur = acc[ai][0][m][n][e], pr = pv[n][e];
                        const float p1 = dpp_shr1(cur) + dpp_shl15(pr), p2 = dpp_shr2(cur) + dpp_shl14(pr);
                        const float uc = w0[n][e] * p2 + w1[n][e] * p1 + w2[n][e] * cur;
                        a8[4 * n + e] = gelu_tanh(uc) * acc[ai][1][m][n][e];
                    }
                u32x4 w; w.x = cvt_pk_bf16(a8[0], a8[1]); w.y = cvt_pk_bf16(a8[2], a8[3]); w.z = cvt_pk_bf16(a8[4], a8[5]); w.w = cvt_pk_bf16(a8[6], a8[7]);
                *(u32x4*)(ACT + (size_t)r * 4096 + ch0) = w;
                if (sample) {
                    if (fr >= 14 && sb < 8) { float* op = outs + (size_t)(sb * 2 + fr - 14) * 4096 + ch0; *(f32x4*)op = acc[ai][0][m][0]; *(f32x4*)(op + 4) = acc[ai][0][m][1]; }
                } else if (m == 3 && blk == 3 && (u.pm & 15) == 15 && fr >= 14) {
                    float* op = outp + (size_t)((u.pm >> 4) * 2 + fr - 14) * 4096 + ch0; *(f32x4*)op = acc[ai][0][m][0]; *(f32x4*)(op + 4) = acc[ai][0][m][1];
                }
            }
        }
    }
};
struct WalkOrder {
    int G, c;
    __device__ __forceinline__ bool next(int i, Unit& u) const {
        int w = c, rem = i;
        while (w < 256) { const int len = 16;
            if (rem < len) { if (w < 256) { u.pm = (w >> 5) * 16 + rem; u.pn = w & 31; } else { u.pm = 128; u.pn = w - 256; } return true; }
            rem -= len; w += G; }
        return false;
    }
    __device__ __forceinline__ void a_ready(const Unit&) const {}
    __device__ __forceinline__ void done(const Unit&) const {}
};
template <class Epi, class Sched, bool ALIGN_EPI = false, bool SP2 = false>
__device__ __forceinline__ void gemm_phase(PG8_LAS unsigned char* lds, const Gemm g, const Sched& S, const Epi& E) {
    int tid_raw = threadIdx.x; asm volatile("" : "+v"(tid_raw));
    const int tid = tid_raw, wid = __builtin_amdgcn_readfirstlane(tid >> 6), lane = tid & 63, wr = wid >> 2, wc = wid & 3, fr = lane & 15, fq = lane >> 4;
    const int K = g.K, nt = K / BK;
    unsigned voffA[2], voffB[2];
#pragma unroll
    for (int i = 0; i < 2; ++i) { int R, C; stage_rc(tid * 16 + i * 8192, R, C); const int Rb = Epi::PERM ? ((R & ~31) + perm32(R & 31)) : R;
        voffA[i] = (unsigned)(R * K + C) * 2u; voffB[i] = (unsigned)(Rb * K + C) * 2u; }
    const size_t kstep = (size_t)(BK * 2);
    const size_t hstep = (size_t)HALF * K * 2;
    const size_t tstep = 2 * hstep;
    const unsigned ldsw = (unsigned)wid * 1024u;
    const int aoff = lds_byte(wr * 64 + fr, fq * 8), boff = lds_byte(wc * 32 + fr, fq * 8);
#define PG8_SA(b, h) (((b) * 2 + (h)) * HTB)
#define PG8_SB(b, h) ((4 + (b) * 2 + (h)) * HTB)
#define PG8_STAGE(bufoff, gbase, voff) do { _Pragma("unroll") for (int _i = 0; _i < 2; ++_i) \
        __builtin_amdgcn_global_load_lds((const unsigned*)((const char*)(gbase) + (voff)[_i]), (PG8_LAS unsigned*)(lds + (bufoff) + ldsw + _i * 8192), 16, 0, 0); } while (0)
#define PG8_LDA(dst, b, h) do { _Pragma("unroll") for (int m = 0; m < 4; ++m) _Pragma("unroll") for (int k = 0; k < 2; ++k) dst[m][k] = *(const PG8_LAS bf16x8*)(lds + PG8_SA(b, h) + aoff + m * 2048 + k * 1024); } while (0)
#define PG8_LDB(dst, b, h) do { _Pragma("unroll") for (int n = 0; n < 2; ++n) _Pragma("unroll") for (int k = 0; k < 2; ++k) dst[n][k] = *(const PG8_LAS bf16x8*)(lds + PG8_SB(b, h) + boff + n * 2048 + k * 1024); } while (0)
#define PG8_MMA(ai, bj, At, Bt) do { __builtin_amdgcn_s_setprio(1); _Pragma("unroll") for (int m = 0; m < 4; ++m) _Pragma("unroll") for (int n = 0; n < 2; ++n) _Pragma("unroll") for (int k = 0; k < 2; ++k) \
        acc[ai][bj][m][n] = __builtin_amdgcn_mfma_f32_16x16x32_bf16(Bt[n][k], At[m][k], acc[ai][bj][m][n], 0, 0, 0); __builtin_amdgcn_s_setprio(0); } while (0)
#define PG8_WAIT_V(n) asm volatile("s_waitcnt vmcnt(" #n ")" ::: "memory")
#define PG8_WAIT_L(n) asm volatile("s_waitcnt lgkmcnt(" #n ")" ::: "memory")
#define PG8_BAR __builtin_amdgcn_s_barrier()
#define PG8_SCHED __builtin_amdgcn_sched_barrier(0)
    Unit cur, nxt; int ui = 0;
    if (!S.next(0, cur)) return;
    f32x4 acc[2][2][4][2];
#pragma unroll
    for (int a = 0; a < 2; ++a)
#pragma unroll
        for (int b = 0; b < 2; ++b)
#pragma unroll
            for (int m = 0; m < 4; ++m)
#pragma unroll
                for (int n = 0; n < 2; ++n) acc[a][b][m][n] = (f32x4){0.f, 0.f, 0.f, 0.f};
    bf16x8 At[4][2], B0[2][2], B1[2][2];
    const char* cA = (const char*)g.A + (size_t)cur.pm * tstep; const char* cB = (const char*)g.Bt + (size_t)cur.pn * tstep;
    S.a_ready(cur);
    if constexpr (SP2) {
        PG8_STAGE(PG8_SB(0, 0), cB, voffB); PG8_STAGE(PG8_SB(0, 1), cB + hstep, voffB); PG8_STAGE(PG8_SA(0, 0), cA, voffA); PG8_STAGE(PG8_SA(0, 1), cA + hstep, voffA);
        if (wr == 1) PG8_BAR;
        PG8_WAIT_V(2); PG8_BAR;
        PG8_STAGE(PG8_SB(1, 0), cB + kstep, voffB); PG8_STAGE(PG8_SA(1, 0), cA + kstep, voffA); PG8_STAGE(PG8_SB(1, 1), cB + hstep + kstep, voffB);
        PG8_WAIT_V(6); PG8_BAR;
    } else {
        PG8_STAGE(PG8_SB(0, 0), cB, voffB); PG8_STAGE(PG8_SA(0, 0), cA, voffA); PG8_STAGE(PG8_SB(0, 1), cB + hstep, voffB); PG8_STAGE(PG8_SA(0, 1), cA + hstep, voffA);
        if (wr == 1) PG8_BAR;
        PG8_WAIT_V(4); PG8_BAR;
        PG8_STAGE(PG8_SB(1, 0), cB + kstep, voffB); PG8_STAGE(PG8_SA(1, 0), cA + kstep, voffA); PG8_STAGE(PG8_SB(1, 1), cB + hstep + kstep, voffB);
        PG8_WAIT_V(6); PG8_BAR;
    }
    for (;;) {
        const bool has_next = S.next(ui + 1, nxt);
        const char* nA = has_next ? (const char*)g.A + (size_t)nxt.pm * tstep : cA; const char* nB = has_next ? (const char*)g.Bt + (size_t)nxt.pn * tstep : cB;
        for (int t = 0; t < nt; t += 2) {
            const bool last = (t == nt - 2);
            const char* a1 = cA + (size_t)(t + 1) * kstep;
            const char* a2 = last ? nA : cA + (size_t)(t + 2) * kstep; const char* b2 = last ? nB : cB + (size_t)(t + 2) * kstep;
            const char* a3 = a2 + kstep; const char* b3 = b2 + kstep;
            if (last && has_next) S.a_ready(nxt);
            if constexpr (SP2) {
            PG8_LDB(B0, 0, 0); PG8_LDB(B1, 0, 1); PG8_SCHED; PG8_LDA(At, 0, 0); PG8_STAGE(PG8_SA(1, 1), a1 + hstep, voffA);
            PG8_WAIT_V(8); PG8_WAIT_L(0); PG8_BAR; PG8_MMA(0, 0, At, B0); PG8_MMA(0, 1, At, B1); PG8_BAR; PG8_SCHED;
            PG8_LDA(At, 0, 1); PG8_STAGE(PG8_SB(0, 0), b2, voffB); PG8_STAGE(PG8_SB(0, 1), b2 + hstep, voffB); PG8_STAGE(PG8_SA(0, 0), a2, voffA);
            PG8_WAIT_V(8); PG8_WAIT_L(0); PG8_BAR; PG8_MMA(1, 0, At, B0); PG8_MMA(1, 1, At, B1); PG8_BAR; PG8_SCHED;
            PG8_LDB(B0, 1, 0); PG8_LDB(B1, 1, 1); PG8_SCHED; PG8_LDA(At, 1, 0); PG8_STAGE(PG8_SA(0, 1), a2 + hstep, voffA);
            PG8_WAIT_V(8); PG8_WAIT_L(0); PG8_BAR; PG8_MMA(0, 0, At, B0); PG8_MMA(0, 1, At, B1); PG8_BAR; PG8_SCHED;
            PG8_LDA(At, 1, 1); PG8_STAGE(PG8_SB(1, 0), b3, voffB); PG8_STAGE(PG8_SB(1, 1), b3 + hstep, voffB); PG8_STAGE(PG8_SA(1, 0), a3, voffA);
            PG8_WAIT_V(8); PG8_WAIT_L(0); PG8_BAR; PG8_MMA(1, 0, At, B0); PG8_MMA(1, 1, At, B1); PG8_BAR; PG8_SCHED;
            } else {
            PG8_LDB(B0, 0, 0); PG8_SCHED; PG8_LDA(At, 0, 0); PG8_STAGE(PG8_SA(1, 1), a1 + hstep, voffA);
            PG8_WAIT_L(8); PG8_BAR; PG8_WAIT_L(0); PG8_MMA(0, 0, At, B0); PG8_BAR; PG8_SCHED;
            PG8_LDB(B1, 0, 1); PG8_STAGE(PG8_SB(0, 0), b2, voffB);
            PG8_BAR; PG8_WAIT_L(0); PG8_MMA(0, 1, At, B1); PG8_BAR;
            PG8_LDA(At, 0, 1); PG8_STAGE(PG8_SA(0, 0), a2, voffA);
            PG8_BAR; PG8_WAIT_L(0); PG8_MMA(1, 0, At, B0); PG8_BAR; PG8_SCHED;
            PG8_STAGE(PG8_SB(0, 1), b2 + hstep, voffB);
            PG8_WAIT_V(6); PG8_BAR; PG8_MMA(1, 1, At, B1); PG8_BAR;
            PG8_LDB(B0, 1, 0); PG8_SCHED; PG8_LDA(At, 1, 0); PG8_STAGE(PG8_SA(0, 1), a2 + hstep, voffA);
            PG8_WAIT_L(8); PG8_BAR; PG8_WAIT_L(0); PG8_MMA(0, 0, At, B0); PG8_BAR; PG8_SCHED;
            PG8_LDB(B1, 1, 1); PG8_STAGE(PG8_SB(1, 0), b3, voffB);
            PG8_BAR; PG8_WAIT_L(0); PG8_MMA(0, 1, At, B1); PG8_BAR;
            PG8_LDA(At, 1, 1); PG8_STAGE(PG8_SA(1, 0), a3, voffA);
            PG8_BAR; PG8_WAIT_L(0); PG8_MMA(1, 0, At, B0); PG8_BAR; PG8_SCHED;
            PG8_STAGE(PG8_SB(1, 1), b3 + hstep, voffB);
            PG8_WAIT_V(6); PG8_BAR; PG8_MMA(1, 1, At, B1); PG8_BAR;
            }
        }
        if constexpr (ALIGN_EPI) { if (wr == 0) PG8_BAR; }
        if constexpr (!Epi::AFTER_DRAIN) { E(acc, cur, wr, wc, fr, fq); S.done(cur); }
        if (!has_next) break;
#pragma unroll
        for (int a = 0; a < 2; ++a)
#pragma unroll
            for (int b = 0; b < 2; ++b)
#pragma unroll
                for (int m = 0; m < 4; ++m)
#pragma unroll
                    for (int n = 0; n < 2; ++n) acc[a][b][m][n] = (f32x4){0.f, 0.f, 0.f, 0.f};
        cur = nxt; cA = nA; cB = nB; ++ui;
        if constexpr (ALIGN_EPI) { if (wr == 1) PG8_BAR; }
    }
    PG8_WAIT_V(0);
    if constexpr (!ALIGN_EPI) { if (wr == 0) PG8_BAR; }
    PG8_BAR;
    if constexpr (Epi::AFTER_DRAIN) { E.fused(acc, cur, wr, wc, fr, fq, lds, wid, lane); S.done(cur); }
#undef PG8_SA
#undef PG8_SB
#undef PG8_STAGE
#undef PG8_LDA
#undef PG8_LDB
#undef PG8_MMA
#undef PG8_WAIT_V
#undef PG8_WAIT_L
#undef PG8_BAR
#undef PG8_SCHED
}
}

using pg8::bf16_t; using pg8::bf16x8; using pg8::f32x4; using pg8::u32x4;
#define LAS __attribute__((address_space(3)))
typedef unsigned u32x2 __attribute__((ext_vector_type(2)));
constexpr int DM = 1024, NIN = 3584, DFF = 4096;
constexpr int TOK_P = 32768, TOK = 32896, TOKPAD = 33024;
constexpr float EPS = 1e-6f;
constexpr size_t WS_WIN = 16384;
constexpr size_t WS_WOUT = WS_WIN + (size_t)NIN * DM * 2;
constexpr size_t WS_WFF1 = WS_WOUT + (size_t)DM * DM * 2;
constexpr size_t WS_WDN = WS_WFF1 + (size_t)2 * DFF * DM * 2;
constexpr size_t WS_COS = WS_WDN + (size_t)DM * DFF * 2;
constexpr size_t WS_SIN = WS_COS + (size_t)4112 * 64 * 4;
constexpr size_t WS_SSQ1 = WS_SIN + (size_t)4112 * 64 * 4;
constexpr size_t WS_SSQ2 = WS_SSQ1 + (size_t)TOKPAD * 16 * 4;
constexpr size_t WS_UG = WS_SSQ2 + (size_t)TOKPAD * 16 * 4;
constexpr size_t WS_PS = WS_UG + (size_t)256 * 65536;
constexpr size_t WS_YS = WS_PS + (size_t)128 * NIN * 4;
constexpr size_t WS_FS = WS_YS + (size_t)4 * 128 * DM * 4;
constexpr size_t WS_RA = WS_FS + (size_t)4 * 128 * DM * 4;
constexpr size_t WS_RB = WS_RA + (size_t)TOKPAD * DM * 2;
constexpr size_t WS_END = WS_RB + (size_t)TOKPAD * DFF * 2;
constexpr size_t O_SRP = (size_t)TOK * DM, O_CCP = O_SRP + 524288, O_CFP = O_CCP + 8192, O_SRS = O_CFP + 65536, O_CCS = O_SRS + 524288, O_CFS = O_CCS + 8192;
constexpr int LDS_HALO = 131072, LDS_BARW = 131072 + 8192, LDS_BYTES = LDS_BARW + 16;

struct Params { const float* in[17]; float* out; unsigned char* ws; };

__device__ __forceinline__ float wave_sum(float v) {
#pragma unroll
    for (int o = 1; o < 64; o <<= 1) v += __shfl_xor(v, o);
    return v;
}
__device__ __forceinline__ float bf2f(unsigned short b) { return __uint_as_float(((unsigned)b) << 16); }
__device__ __forceinline__ unsigned pk2(float a, float b) { return pg8::cvt_pk_bf16(a, b); }
__device__ __forceinline__ float silu_f(float g) { return g * __builtin_amdgcn_rcpf(1.0f + __builtin_amdgcn_exp2f(-1.4426950408889634f * g)); }
__device__ __forceinline__ int dmap(int P) { return ((P >> 2) & 1) * 64 + (P >> 3) * 4 + (P & 3); }
__device__ __forceinline__ int pmap(int d) { return ((d >> 4) & 3) * 32 + ((d >> 2) & 3) * 8 + ((d >> 6) & 1) * 4 + (d & 3); }

template <int MODE> __device__ __forceinline__ int rowmap(int c) {
    if (MODE == 0) { if (c < 1024) return (c & ~127) + pmap(c & 127); return c; }
    if (MODE == 1) return c;
    if (MODE == 2) return ((c >> 7) << 8) + (c & 127);
    return ((c >> 7) << 8) + 128 + (c & 127);
}
template <int MODE>
__device__ __forceinline__ void transpose_item(const float* W, int K, int N, bf16_t* WT, LAS float* scr, int item, int lane) {
    const int nblk = N / 32, kb = item / nblk, nb = item % nblk, k0 = 64 * kb, n0 = 32 * nb;
#pragma unroll 8
    for (int i = 0; i < 32; ++i) { const int kk = 2 * i + (lane >> 5); scr[kk * 33 + (lane & 31)] = W[(size_t)(k0 + kk) * N + n0 + (lane & 31)]; }
    asm volatile("s_waitcnt lgkmcnt(0)" ::: "memory");
    const int c = lane & 7;
#pragma unroll
    for (int j = 0; j < 4; ++j) { const int n = (lane >> 3) + 8 * j; const LAS float* s = scr + (8 * c) * 33 + n;
        u32x4 o; o.x = pk2(s[0 * 33], s[1 * 33]); o.y = pk2(s[2 * 33], s[3 * 33]); o.z = pk2(s[4 * 33], s[5 * 33]); o.w = pk2(s[6 * 33], s[7 * 33]);
        *(u32x4*)(WT + (size_t)rowmap<MODE>(n0 + n) * K + k0 + 8 * c) = o; }
    asm volatile("s_waitcnt lgkmcnt(0)" ::: "memory");
}
__device__ __forceinline__ void phase0(const Params& p, LAS unsigned char* lds, int tid, int wid, int lane) {
    LAS float* scr = (LAS float*)(lds + wid * 8448);
    const int gw = blockIdx.x * 8 + wid, NGW = gridDim.x * 8;
    bf16_t* win = (bf16_t*)(p.ws + WS_WIN); bf16_t* wout = (bf16_t*)(p.ws + WS_WOUT); bf16_t* wff1 = (bf16_t*)(p.ws + WS_WFF1); bf16_t* wdn = (bf16_t*)(p.ws + WS_WDN);
    constexpr int I_IN = 16 * 112, I_OUT = 16 * 32, I_UP = 16 * 128, I_DN = 64 * 32, NITEMS = I_IN + I_OUT + 2 * I_UP + I_DN;
    for (int it = gw; it < NITEMS; it += NGW) {
        int r = it;
        if (r < I_IN) { transpose_item<0>(p.in[5], DM, NIN, win, scr, r, lane); continue; } r -= I_IN;
        if (r < I_OUT) { transpose_item<1>(p.in[6], DM, DM, wout, scr, r, lane); continue; } r -= I_OUT;
        if (r < I_UP) { transpose_item<2>(p.in[13], DM, DFF, wff1, scr, r, lane); continue; } r -= I_UP;
        if (r < I_UP) { transpose_item<3>(p.in[14], DM, DFF, wff1, scr, r, lane); continue; } r -= I_UP;
        transpose_item<1>(p.in[16], DFF, DM, wdn, scr, r, lane);
    }
    float* cosT = (float*)(p.ws + WS_COS); float* sinT = (float*)(p.ws + WS_SIN);
    for (int idx = blockIdx.x * 512 + tid; idx < 4112 * 64; idx += gridDim.x * 512) {
        const int pos = idx >> 6, f = idx & 63;
        const float inv = exp2f(-(float)(2 * f) * (1.0f / 128.0f) * 13.287712379549449f);
        const float ang = (float)pos * inv;
        const double rev = (double)ang * 0.15915494309189535;
        const float fr = (float)(rev - floor(rev));
        cosT[idx] = __builtin_amdgcn_cosf(fr); sinT[idx] = __builtin_amdgcn_sinf(fr);
    }
    bf16_t* H = (bf16_t*)(p.ws + WS_RA);
    const float* wpre = p.in[9];
    for (int r = gw; r < TOKPAD; r += NGW) {
        u32x2* o8 = (u32x2*)(H + (size_t)r * DM) + lane;
        if (r >= TOK) {
#pragma unroll
            for (int j = 0; j < 4; ++j) o8[64 * j] = (u32x2){0u, 0u};
            continue; }
        const float* xrow = r < TOK_P ? p.in[0] + (size_t)r * DM : p.in[1] + (size_t)(r - TOK_P) * DM;
        f32x4 v[4]; float s = 0.f;
#pragma unroll
        for (int j = 0; j < 4; ++j) { v[j] = *((const f32x4*)xrow + lane + 64 * j); s += (v[j][0] * v[j][0] + v[j][1] * v[j][1]) + (v[j][2] * v[j][2] + v[j][3] * v[j][3]); }
        const float rstd = rsqrtf(wave_sum(s) * (1.0f / DM) + EPS);
#pragma unroll
        for (int j = 0; j < 4; ++j) { const f32x4 w = *((const f32x4*)wpre + lane + 64 * j); const f32x4 y = (v[j] * rstd) * w;
            o8[64 * j] = (u32x2){pk2(y[0], y[1]), pk2(y[2], y[3])}; }
    }
}

constexpr int QI_OFF = 0, KI_OFF = 17408, KT_OFF = 34816, VT_OFF = 53248, SI_OFF = 71680, ST_OFF = 80896, GI_OFF = 115712;
#define MFMA16(a, b, c) __builtin_amdgcn_mfma_f32_16x16x32_bf16((a), (b), (c), 0, 0, 0)
template <bool FULL>
__device__ __forceinline__ void ret_unit(const Params& p, LAS unsigned char* lds, int unit, int tid, int wid, int lane) {
    asm volatile("" : "+v"(tid), "+v"(lane));
    const int G = unit & 7, h = (unit >> 3) & 3, b = unit >> 5;
    const bf16_t* P = (const bf16_t*)(p.ws + WS_RB);
    bf16_t* MIX = (bf16_t*)(p.ws + WS_RA);
    float* UG = (float*)(p.ws + WS_UG);
    const size_t tok0 = (size_t)b * 4096 + (size_t)G * 512;
    const float l2g = log2f(1.0f - exp2f(-5.0f - (float)h));
    const float g64 = __builtin_amdgcn_exp2f(l2g * 64.0f);
    const bool is_state = wid >= 4; const int w4 = wid & 3;
    const int l15 = lane & 15, l4 = lane >> 4;
    const int vtL = l4 ^ (l15 >> 3);
    const int vtb0 = VT_OFF + l15 * 144 + 16 * vtL, vtb1 = VT_OFF + l15 * 144 + 16 * (vtL ^ 2);
#define VT_ADDR(nt, ks) ((((nt) & 1) ? vtb1 : vtb0) + (nt) * 2304 + 16 * (((4 * (ks)) ^ (2 * ((nt) & 3))) & 4))
    f32x4 st[2][8];
#pragma unroll
    for (int mt = 0; mt < 2; ++mt)
#pragma unroll
        for (int nt = 0; nt < 8; ++nt) st[mt][nt] = (f32x4){0.f, 0.f, 0.f, 0.f};
    if (FULL && is_state) {
#pragma unroll 1
        for (int Gp = 0; Gp < G; Gp += 2) {
            const float wa = __builtin_amdgcn_exp2f(l2g * 512.0f * (float)(G - 1 - Gp));
            const bool two = Gp + 1 < G;
            const float wb = two ? __builtin_amdgcn_exp2f(l2g * 512.0f * (float)(G - 2 - Gp)) : 0.f;
            const float* sa = UG + ((size_t)((b * 4 + h) * 8 + Gp) * 4 + w4) * 4096 + lane;
            const float* sb = two ? sa + 4 * 4096 : sa;
#pragma unroll
            for (int mt = 0; mt < 2; ++mt)
#pragma unroll
                for (int nt = 0; nt < 8; ++nt)
#pragma unroll
                    for (int r = 0; r < 4; ++r) st[mt][nt][r] += wa * sa[((mt * 8 + nt) * 4 + r) * 64] + wb * sb[((mt * 8 + nt) * 4 + r) * 64];
        }
    }
    float rwv[8];
#pragma unroll
    for (int nt = 0; nt < 8; ++nt) rwv[nt] = p.in[8][128 * h + 16 * nt + l15];
    u32x4 rq[2], rk[2], rv[2], rg[2];
#pragma unroll
    for (int i = 0; i < 2; ++i) { const int idx = tid + 512 * i, j = idx >> 4, ch = idx & 15; const bf16_t* rowp = P + (tok0 + j) * NIN + 128 * h + ch * 8;
        if (FULL) { rq[i] = *(const u32x4*)rowp; rg[i] = *(const u32x4*)(rowp + 1536); } rk[i] = *(const u32x4*)(rowp + 512); rv[i] = *(const u32x4*)(rowp + 1024); }
#pragma unroll 1
    for (int n = 0; n < 8; ++n) {
#pragma unroll
        for (int i = 0; i < 2; ++i) { const int idx = tid + 512 * i, j = idx >> 4, ch = idx & 15;
            if (FULL) { *(LAS u32x4*)(lds + QI_OFF + j * 272 + ch * 16) = rq[i]; *(LAS u32x4*)(lds + KI_OFF + j * 272 + ch * 16) = rk[i]; *(LAS u32x4*)(lds + GI_OFF + j * 272 + ch * 16) = rg[i]; }
            const float te = __builtin_amdgcn_exp2f(l2g * (float)(63 - j));
            const unsigned kw[4] = {rk[i].x, rk[i].y, rk[i].z, rk[i].w}, vw[4] = {rv[i].x, rv[i].y, rv[i].z, rv[i].w};
            const int cofs = 16 * ((j >> 3) ^ (ch & 7)) + 2 * (j & 7);
#pragma unroll
            for (int e2 = 0; e2 < 4; ++e2) {
                const unsigned kk = pk2(__uint_as_float(kw[e2] << 16) * te, __uint_as_float(kw[e2] & 0xffff0000u) * te);
                const int row = 8 * ch + 2 * e2;
                *(LAS unsigned short*)(lds + KT_OFF + row * 144 + cofs) = (unsigned short)(kk & 0xffffu);
                *(LAS unsigned short*)(lds + KT_OFF + (row + 1) * 144 + cofs) = (unsigned short)(kk >> 16);
                *(LAS unsigned short*)(lds + VT_OFF + row * 144 + cofs) = (unsigned short)(vw[e2] & 0xffffu);
                *(LAS unsigned short*)(lds + VT_OFF + (row + 1) * 144 + cofs) = (unsigned short)(vw[e2] >> 16);
            }
        }
        if (FULL && is_state) {
#pragma unroll
            for (int mt = 0; mt < 2; ++mt)
#pragma unroll
                for (int nt = 0; nt < 8; ++nt) { const int e = 16 * nt + l15, dk0 = 32 * w4 + 16 * mt + 4 * l4;
                    *(LAS u32x2*)(lds + ST_OFF + e * 272 + dk0 * 2) = (u32x2){pk2(st[mt][nt][0], st[mt][nt][1]), pk2(st[mt][nt][2], st[mt][nt][3])}; }
        }
        __syncthreads();
        if (n + 1 < 8) {
#pragma unroll
            for (int i = 0; i < 2; ++i) { const int idx = tid + 512 * i, j = idx >> 4, ch = idx & 15; const bf16_t* rowp = P + (tok0 + (n + 1) * 64 + j) * NIN + 128 * h + ch * 8;
                if (FULL) { rq[i] = *(const u32x4*)rowp; rg[i] = *(const u32x4*)(rowp + 1536); } rk[i] = *(const u32x4*)(rowp + 512); rv[i] = *(const u32x4*)(rowp + 1024); }
        }
        f32x4 cr[8];
#pragma unroll
        for (int nt = 0; nt < 8; ++nt) cr[nt] = (f32x4){0.f, 0.f, 0.f, 0.f};
        if (FULL) {
            if (!is_state) {
                bf16x8 aq[4];
#pragma unroll
                for (int ks = 0; ks < 4; ++ks) aq[ks] = *(const LAS bf16x8*)(lds + QI_OFF + (16 * w4 + l15) * 272 + (32 * ks + 8 * l4) * 2);
#pragma unroll
                for (int nt = 0; nt < 8; ++nt)
#pragma unroll
                    for (int ks = 0; ks < 4; ++ks) { const bf16x8 bs = *(const LAS bf16x8*)(lds + ST_OFF + (16 * nt + l15) * 272 + (32 * ks + 8 * l4) * 2); cr[nt] = MFMA16(aq[ks], bs, cr[nt]); }
            } else {
                bf16x8 ak[4];
#pragma unroll
                for (int ks = 0; ks < 4; ++ks) ak[ks] = *(const LAS bf16x8*)(lds + KI_OFF + (16 * w4 + l15) * 272 + (32 * ks + 8 * l4) * 2);
#pragma unroll
                for (int it = 0; it < 4; ++it) {
                    f32x4 sa = (f32x4){0.f, 0.f, 0.f, 0.f};
#pragma unroll
                    for (int ks = 0; ks < 4; ++ks) { const bf16x8 bq = *(const LAS bf16x8*)(lds + QI_OFF + (16 * it + l15) * 272 + (32 * ks + 8 * l4) * 2); sa = MFMA16(ak[ks], bq, sa); }
                    const int i = 16 * it + l15, j0 = 16 * w4 + 4 * l4;
#pragma unroll
                    for (int r = 0; r < 4; ++r) { const int d = i - (j0 + r); sa[r] *= __builtin_amdgcn_exp2f(l2g * (float)(d < 0 ? -d : d)); }
                    *(LAS u32x2*)(lds + SI_OFF + i * 144 + j0 * 2) = (u32x2){pk2(sa[0], sa[1]), pk2(sa[2], sa[3])};
                }
            }
        }
        __syncthreads();
        if (!is_state) {
            if (FULL) {
                f32x4 itr[8];
                { f32x4 fsv;
#pragma unroll
                  for (int r = 0; r < 4; ++r) fsv[r] = __builtin_amdgcn_exp2f(l2g * (float)(16 * w4 + 4 * l4 + r + 1));
#pragma unroll
                  for (int nt = 0; nt < 8; ++nt) itr[nt] = cr[nt] * fsv; }
                bf16x8 as_[2];
#pragma unroll
                for (int ks = 0; ks < 2; ++ks) as_[ks] = *(const LAS bf16x8*)(lds + SI_OFF + (16 * w4 + l15) * 144 + 16 * (4 * ks + l4));
#pragma unroll
                for (int nt = 0; nt < 8; ++nt)
#pragma unroll
                    for (int ks = 0; ks < 2; ++ks) { const bf16x8 bv = *(const LAS bf16x8*)(lds + VT_ADDR(nt, ks)); itr[nt] = MFMA16(as_[ks], bv, itr[nt]); }
#pragma unroll
                for (int r = 0; r < 4; ++r) {
                    const int i = 16 * w4 + 4 * l4 + r;
                    float ov[8]; float ss = 0.f;
#pragma unroll
                    for (int nt = 0; nt < 8; ++nt) { ov[nt] = itr[nt][r]; ss += ov[nt] * ov[nt]; }
                    ss += __shfl_xor(ss, 1); ss += __shfl_xor(ss, 2); ss += __shfl_xor(ss, 4); ss += __shfl_xor(ss, 8);
                    const float rstd = rsqrtf(ss * (1.0f / 128.0f) + EPS);
#pragma unroll
                    for (int nt = 0; nt < 8; ++nt) { const float gq = bf2f(*(const LAS unsigned short*)(lds + GI_OFF + i * 272 + (16 * nt + l15) * 2));
                        *(LAS unsigned short*)(lds + QI_OFF + i * 272 + (16 * nt + l15) * 2) = (unsigned short)(pk2(ov[nt] * rstd * rwv[nt] * silu_f(gq), 0.f) & 0xffffu); }
                }
#pragma unroll
                for (int q = 0; q < 4; ++q) { const int cidx = lane + 64 * q, row = 16 * w4 + (cidx >> 4), ch = cidx & 15;
                    const u32x4 v = *(const LAS u32x4*)(lds + QI_OFF + row * 272 + ch * 16);
                    *(u32x4*)(MIX + (tok0 + (size_t)n * 64 + row) * DM + 128 * h + ch * 8) = v; }
            }
        } else {
#pragma unroll
            for (int mt = 0; mt < 2; ++mt)
#pragma unroll
                for (int nt = 0; nt < 8; ++nt) st[mt][nt] = st[mt][nt] * g64;
#pragma unroll
            for (int ks = 0; ks < 2; ++ks) {
                bf16x8 akt[2];
#pragma unroll
                for (int mt = 0; mt < 2; ++mt) { const int row = 32 * w4 + 16 * mt + l15; akt[mt] = *(const LAS bf16x8*)(lds + KT_OFF + row * 144 + 16 * ((4 * ks + l4) ^ ((row >> 3) & 7))); }
#pragma unroll
                for (int nt = 0; nt < 8; ++nt) { const bf16x8 bv = *(const LAS bf16x8*)(lds + VT_ADDR(nt, ks));
#pragma unroll
                    for (int mt = 0; mt < 2; ++mt) st[mt][nt] = MFMA16(akt[mt], bv, st[mt][nt]); }
            }
        }
        __syncthreads();
    }
    if (is_state) {
        if (!FULL) {
            float* dst = UG + ((size_t)unit * 4 + w4) * 4096 + lane;
#pragma unroll
            for (int mt = 0; mt < 2; ++mt)
#pragma unroll
                for (int nt = 0; nt < 8; ++nt)
#pragma unroll
                    for (int r = 0; r < 4; ++r) dst[((mt * 8 + nt) * 4 + r) * 64] = st[mt][nt][r];
        } else if (G == 7) {
            float* o = p.out + O_SRP + (size_t)(b * 4 + h) * 16384 + (64 * (l4 & 1) + 16 * w4 + 4 * (l4 >> 1)) * 128 + l15;
#pragma unroll
            for (int mt = 0; mt < 2; ++mt)
#pragma unroll
                for (int nt = 0; nt < 8; ++nt)
#pragma unroll
                    for (int r = 0; r < 4; ++r) o[(8 * mt + r) * 128 + 16 * nt] = st[mt][nt][r];
        }
    }
    if (FULL) {
        const int c0 = 128 * h + 8 * (tid & 15), run = tid >> 4, t0 = G * 512 + run * 16;
        const float* cwp = p.in[7];
        float w0[8], w1[8], w2[8], p1[8], p2[8];
#pragma unroll
        for (int e = 0; e < 8; ++e) { w0[e] = cwp[c0 + e]; w1[e] = cwp[512 + c0 + e]; w2[e] = cwp[1024 + c0 + e]; p1[e] = 0.f; p2[e] = 0.f; }
        if (t0 > 0) {
            const bf16_t* r2 = P + ((size_t)b * 4096 + t0 - 2) * NIN; const bf16_t* r1 = r2 + NIN;
            const u32x4 c2 = *(const u32x4*)(r2 + 2560 + c0), h2 = *(const u32x4*)(r2 + 3072 + c0), c1 = *(const u32x4*)(r1 + 2560 + c0), h1 = *(const u32x4*)(r1 + 3072 + c0);
            const unsigned c2w[4] = {c2.x, c2.y, c2.z, c2.w}, h2w[4] = {h2.x, h2.y, h2.z, h2.w}, c1w[4] = {c1.x, c1.y, c1.z, c1.w}, h1w[4] = {h1.x, h1.y, h1.z, h1.w};
#pragma unroll
            for (int e = 0; e < 4; ++e) {
                p2[2 * e] = __uint_as_float(c2w[e] << 16) * __uint_as_float(h2w[e] << 16); p2[2 * e + 1] = __uint_as_float(c2w[e] & 0xffff0000u) * __uint_as_float(h2w[e] & 0xffff0000u);
                p1[2 * e] = __uint_as_float(c1w[e] << 16) * __uint_as_float(h1w[e] << 16); p1[2 * e + 1] = __uint_as_float(c1w[e] & 0xffff0000u) * __uint_as_float(h1w[e] & 0xffff0000u); }
        }
#pragma unroll 4
        for (int t = 0; t < 16; ++t) {
            const size_t row = (size_t)b * 4096 + t0 + t;
            const bf16_t* rp = P + row * NIN;
            const u32x4 bb = *(const u32x4*)(rp + 2048 + c0), cc = *(const u32x4*)(rp + 2560 + c0), hh = *(const u32x4*)(rp + 3072 + c0);
            const unsigned bw[4] = {bb.x, bb.y, bb.z, bb.w}, cw4[4] = {cc.x, cc.y, cc.z, cc.w}, hw[4] = {hh.x, hh.y, hh.z, hh.w};
            float y[8];
#pragma unroll
            for (int e = 0; e < 4; ++e) {
                const float ca = __uint_as_float(cw4[e] << 16) * __uint_as_float(hw[e] << 16), cb = __uint_as_float(cw4[e] & 0xffff0000u) * __uint_as_float(hw[e] & 0xffff0000u);
                y[2 * e] = __uint_as_float(bw[e] << 16) * (w0[2 * e] * p2[2 * e] + w1[2 * e] * p1[2 * e] + w2[2 * e] * ca);
                y[2 * e + 1] = __uint_as_float(bw[e] & 0xffff0000u) * (w0[2 * e + 1] * p2[2 * e + 1] + w1[2 * e + 1] * p1[2 * e + 1] + w2[2 * e + 1] * cb);
                p2[2 * e] = p1[2 * e]; p2[2 * e + 1] = p1[2 * e + 1]; p1[2 * e] = ca; p1[2 * e + 1] = cb;
            }
            *(u32x4*)(MIX + row * DM + 512 + c0) = (u32x4){pk2(y[0], y[1]), pk2(y[2], y[3]), pk2(y[4], y[5]), pk2(y[6], y[7])};
        }
        if (G == 7 && run == 31) {
            float* o = p.out + O_CCP + (size_t)b * 1024 + c0;
#pragma unroll
            for (int e = 0; e < 8; ++e) { o[e] = p2[e]; o[512 + e] = p1[e]; }
        }
    }
}

__device__ __forceinline__ float ch_at(const float* PS, const float* cache, int b, int t, int ch) {
    if (t < 0) return cache[(b * 2 + (t + 2)) * 512 + ch];
    const float* rp = PS + (size_t)(16 * b + t) * NIN;
    return rp[2560 + ch] * rp[3072 + ch];
}
__device__ __forceinline__ void sample_unit(const Params& p, LAS unsigned char* lds, int su, int tid, int wid, int lane) {
    const int b = su >> 2, h = su & 3, ts0 = TOK_P + 16 * b;
    const float* PS = (const float*)(p.ws + WS_PS);
    bf16_t* MIX = (bf16_t*)(p.ws + WS_RA);
    LAS float* qs = (LAS float*)lds; LAS float* ks = qs + 2048; LAS float* vs = qs + 4096; LAS float* Ssm = qs + 6144; LAS float* osm = qs + 6400;
    const float l2g = log2f(1.0f - exp2f(-5.0f - (float)h));
    const float* cosT = (const float*)(p.ws + WS_COS); const float* sinT = (const float*)(p.ws + WS_SIN);
    for (int idx = tid; idx < 2048; idx += 512) { const int i = idx >> 7, c = idx & 127, d = dmap(c);
        const float* rp = PS + (size_t)(16 * b + i) * NIN + 128 * h;
        const float cs = cosT[(4096 + i) * 64 + (d & 63)], sn = sinT[(4096 + i) * 64 + (d & 63)];
        const float xq = rp[c], xqp = rp[c ^ 4], xk = rp[512 + c], xkp = rp[512 + (c ^ 4)];
        qs[i * 128 + d] = d < 64 ? xq * cs - xqp * sn : xq * cs + xqp * sn;
        ks[i * 128 + d] = (d < 64 ? xk * cs - xkp * sn : xk * cs + xkp * sn) * 0.08838834764831845f;
        vs[i * 128 + c] = rp[1024 + c]; }
    __syncthreads();
    if (tid < 256) { const int i = tid >> 4, j = tid & 15; float s = 0.f;
        for (int d = 0; d < 128; ++d) s += qs[i * 128 + d] * ks[j * 128 + d];
        const int dd = i - j; Ssm[i * 16 + j] = s * __builtin_amdgcn_exp2f(l2g * (float)(dd < 0 ? -dd : dd)); }
    const int e = tid & 127, ig = tid >> 7;
    const float* s0 = p.in[2] + (size_t)su * 16384;
    float cr[4] = {0.f, 0.f, 0.f, 0.f};
#pragma unroll 16
    for (int d = 0; d < 128; ++d) { const float sv = s0[d * 128 + e];
#pragma unroll
        for (int r = 0; r < 4; ++r) cr[r] += qs[(ig * 4 + r) * 128 + d] * sv; }
    __syncthreads();
#pragma unroll
    for (int r = 0; r < 4; ++r) { const int i = ig * 4 + r; float o = 0.f;
        for (int j = 0; j < 16; ++j) o += Ssm[i * 16 + j] * vs[j * 128 + e];
        osm[i * 128 + e] = o + __builtin_amdgcn_exp2f(l2g * (float)(i + 1)) * cr[r]; }
    __syncthreads();
    for (int rr = 0; rr < 2; ++rr) { const int i = 2 * wid + rr; const float v0 = osm[i * 128 + lane], v1 = osm[i * 128 + 64 + lane];
        const float rstd = rsqrtf(wave_sum(v0 * v0 + v1 * v1) * (1.0f / 128.0f) + EPS);
        const size_t token = (size_t)(ts0 + i);
        const float g0 = PS[(size_t)(16 * b + i) * NIN + 1536 + 128 * h + lane], g1 = PS[(size_t)(16 * b + i) * NIN + 1536 + 128 * h + 64 + lane];
        MIX[token * DM + 128 * h + lane] = (bf16_t)(pk2(v0 * rstd * p.in[8][128 * h + lane] * silu_f(g0), 0.f) & 0xffffu);
        MIX[token * DM + 128 * h + 64 + lane] = (bf16_t)(pk2(v1 * rstd * p.in[8][128 * h + 64 + lane] * silu_f(g1), 0.f) & 0xffffu); }
    const float g16 = __builtin_amdgcn_exp2f(l2g * 16.0f);
    float* outS = p.out + O_SRS + (size_t)su * 16384;
#pragma unroll 8
    for (int dd = 0; dd < 32; ++dd) { const int d = ig + 4 * dd; float a = g16 * s0[d * 128 + e];
        for (int j = 0; j < 16; ++j) a += __builtin_amdgcn_exp2f(l2g * (float)(15 - j)) * ks[j * 128 + d] * vs[j * 128 + e];
        outS[d * 128 + e] = a; }
    const int ch = 128 * h + e; const float* cache = p.in[3]; const float* cwp = p.in[7];
    const float w0 = cwp[ch], w1 = cwp[512 + ch], w2 = cwp[1024 + ch];
#pragma unroll
    for (int tt = 0; tt < 4; ++tt) { const int t = ig * 4 + tt;
        const float c0 = ch_at(PS, cache, b, t - 2, ch), c1 = ch_at(PS, cache, b, t - 1, ch), c2 = ch_at(PS, cache, b, t, ch);
        const float y = PS[(size_t)(16 * b + t) * NIN + 2048 + ch] * (w0 * c0 + w1 * c1 + w2 * c2);
        MIX[(size_t)(ts0 + t) * DM + 512 + ch] = (bf16_t)(pk2(y, 0.f) & 0xffffu);
        if (t >= 14) p.out[O_CCS + (size_t)(b * 2 + t - 14) * 512 + ch] = c2; }
    __syncthreads();
}

template <int NB>
__device__ __forceinline__ void thin_gemm(const bf16_t* A, int lda, const bf16_t* Bt, int ldb, int n0, int nbstride, int kbeg, int klen, f32x4 (&acc)[NB], int wid, int lane) {
    const int l15 = lane & 15, l4 = lane >> 4;
    const bf16_t* ap = A + (size_t)(16 * wid + l15) * lda + kbeg + 8 * l4;
    const bf16_t* bp = Bt + (size_t)(n0 + l15) * ldb + kbeg + 8 * l4;
#pragma unroll
    for (int nb = 0; nb < NB; ++nb) acc[nb] = (f32x4){0.f, 0.f, 0.f, 0.f};
#pragma unroll 1
    for (int s0 = 0; s0 < klen; s0 += 256) {
        bf16x8 a[8], b[NB][8];
#pragma unroll
        for (int s = 0; s < 8; ++s) { a[s] = *(const bf16x8*)(ap + s0 + 32 * s);
#pragma unroll
            for (int nb = 0; nb < NB; ++nb) b[nb][s] = *(const bf16x8*)(bp + (size_t)nb * nbstride * ldb + s0 + 32 * s); }
#pragma unroll
        for (int s = 0; s < 8; ++s)
#pragma unroll
            for (int nb = 0; nb < NB; ++nb) acc[nb] = MFMA16(a[s], b[nb][s], acc[nb]);
    }
}
__device__ __forceinline__ void thin_store(const f32x4& acc, float* out, int ldo, int col, int wid, int lane) {
#pragma unroll
    for (int r = 0; r < 4; ++r) out[(size_t)(16 * wid + 4 * (lane >> 4) + r) * ldo + col + (lane & 15)] = acc[r];
}
__device__ __forceinline__ void thin_ffn1(const Params& p, int c, int wid, int lane) {
    const int pn = c >> 3, j16 = c & 7, l15 = lane & 15, l4 = lane >> 4;
    f32x4 acc[2];
    thin_gemm<2>((const bf16_t*)(p.ws + WS_RA) + (size_t)TOK_P * DM, DM, (const bf16_t*)(p.ws + WS_WFF1), DM, 256 * pn + 16 * j16, 128, 0, DM, acc, wid, lane);
    const int ch = 128 * pn + 16 * j16 + l15, b = wid;
    const float* cw = p.in[15]; const float* cache = p.in[4] + (size_t)b * 2 * DFF + ch;
    const float w0 = cw[ch], w1 = cw[DFF + ch], w2 = cw[2 * DFF + ch];
    const f32x4 up = acc[0], gt = acc[1];
    float pm1 = __shfl_up(up[3], 16), pm2 = __shfl_up(up[2], 16);
    if (l4 == 0) { pm1 = cache[DFF]; pm2 = cache[0]; }
    float uc[4];
    uc[0] = w0 * pm2 + w1 * pm1 + w2 * up[0];
    uc[1] = w0 * pm1 + w1 * up[0] + w2 * up[1];
    uc[2] = w0 * up[0] + w1 * up[1] + w2 * up[2];
    uc[3] = w0 * up[1] + w1 * up[2] + w2 * up[3];
    bf16_t* ACT = (bf16_t*)(p.ws + WS_RB);
#pragma unroll
    for (int r = 0; r < 4; ++r) ACT[(size_t)(TOK_P + 16 * wid + 4 * l4 + r) * DFF + ch] = (bf16_t)(pk2(pg8::gelu_tanh(uc[r]) * gt[r], 0.f) & 0xffffu);
    if (l4 == 3) { float* o = p.out + O_CFS + (size_t)b * 2 * DFF + ch; o[0] = up[2]; o[DFF] = up[3]; }
}

__device__ __forceinline__ void phase4(const Params& p, int wid, int lane) {
    const int gw = blockIdx.x * 8 + wid, NGW = gridDim.x * 8;
    const bf16_t* Y = (const bf16_t*)(p.ws + WS_RB); bf16_t* H2 = (bf16_t*)(p.ws + WS_RA); const float* ssq = (const float*)(p.ws + WS_SSQ1);
    const float* wpost = p.in[10]; const float* wpre = p.in[11];
    for (int r = gw; r < TOKPAD; r += NGW) {
        u32x2* o8 = (u32x2*)(H2 + (size_t)r * DM) + lane;
        if (r >= TOK) {
#pragma unroll
            for (int j = 0; j < 4; ++j) o8[64 * j] = (u32x2){0u, 0u};
            continue; }
        const float* xrow = r < TOK_P ? p.in[0] + (size_t)r * DM : p.in[1] + (size_t)(r - TOK_P) * DM;
        f32x4 yv4[4]; float tot;
        if (r < TOK_P) {
            tot = wave_sum(lane < 16 ? ssq[(size_t)r * 16 + lane] : 0.f);
#pragma unroll
            for (int j = 0; j < 4; ++j) { const u32x2 yw = *((const u32x2*)(Y + (size_t)r * DM) + lane + 64 * j);
                yv4[j][0] = __uint_as_float(yw.x << 16); yv4[j][1] = __uint_as_float(yw.x & 0xffff0000u); yv4[j][2] = __uint_as_float(yw.y << 16); yv4[j][3] = __uint_as_float(yw.y & 0xffff0000u); }
        } else {
            const float* ys = (const float*)(p.ws + WS_YS) + (size_t)(r - TOK_P) * DM; float s = 0.f;
#pragma unroll
            for (int j = 0; j < 4; ++j) { f32x4 a = *((const f32x4*)ys + lane + 64 * j);
#pragma unroll
                for (int q = 1; q < 4; ++q) a += *((const f32x4*)(ys + (size_t)q * 128 * DM) + lane + 64 * j);
                yv4[j] = a; s += (a[0] * a[0] + a[1] * a[1]) + (a[2] * a[2] + a[3] * a[3]); }
            tot = wave_sum(s);
        }
        const float rstd1 = rsqrtf(tot * (1.0f / DM) + EPS);
        f32x4 v[4]; float s2 = 0.f;
#pragma unroll
        for (int j = 0; j < 4; ++j) {
            const f32x4 xv = *((const f32x4*)xrow + lane + 64 * j); const f32x4 w = *((const f32x4*)wpost + lane + 64 * j);
            const f32x4 yv = yv4[j];
            v[j] = xv + (yv * rstd1) * w;
            s2 += (v[j][0] * v[j][0] + v[j][1] * v[j][1]) + (v[j][2] * v[j][2] + v[j][3] * v[j][3]);
            *((f32x4*)(p.out + (size_t)r * DM) + lane + 64 * j) = v[j];
        }
        const float rstd2 = rsqrtf(wave_sum(s2) * (1.0f / DM) + EPS);
#pragma unroll
        for (int j = 0; j < 4; ++j) { const f32x4 w = *((const f32x4*)wpre + lane + 64 * j); const f32x4 y = (v[j] * rstd2) * w; o8[64 * j] = (u32x2){pk2(y[0], y[1]), pk2(y[2], y[3])}; }
    }
}
__device__ __forceinline__ void phase7(const Params& p, int wid, int lane) {
    const int gw = blockIdx.x * 8 + wid, NGW = gridDim.x * 8;
    const bf16_t* F = (const bf16_t*)(p.ws + WS_RA); const float* ssq = (const float*)(p.ws + WS_SSQ2); const float* wpost = p.in[12];
    for (int r = gw; r < TOK; r += NGW) {
        f32x4 yv4[4]; float tot;
        if (r < TOK_P) {
            tot = wave_sum(lane < 16 ? ssq[(size_t)r * 16 + lane] : 0.f);
#pragma unroll
            for (int j = 0; j < 4; ++j) { const u32x2 yw = *((const u32x2*)(F + (size_t)r * DM) + lane + 64 * j);
                yv4[j][0] = __uint_as_float(yw.x << 16); yv4[j][1] = __uint_as_float(yw.x & 0xffff0000u); yv4[j][2] = __uint_as_float(yw.y << 16); yv4[j][3] = __uint_as_float(yw.y & 0xffff0000u); }
        } else {
            const float* fs = (const float*)(p.ws + WS_FS) + (size_t)(r - TOK_P) * DM; float s = 0.f;
#pragma unroll
            for (int j = 0; j < 4; ++j) { f32x4 a = *((const f32x4*)fs + lane + 64 * j);
#pragma unroll
                for (int q = 1; q < 4; ++q) a += *((const f32x4*)(fs + (size_t)q * 128 * DM) + lane + 64 * j);
                yv4[j] = a; s += (a[0] * a[0] + a[1] * a[1]) + (a[2] * a[2] + a[3] * a[3]); }
            tot = wave_sum(s);
        }
        const float rstd = rsqrtf(tot * (1.0f / DM) + EPS);
#pragma unroll
        for (int j = 0; j < 4; ++j) {
            f32x4* op = (f32x4*)(p.out + (size_t)r * DM) + lane + 64 * j;
            const f32x4 xv = *op; const f32x4 w = *((const f32x4*)wpost + lane + 64 * j);
            *op = xv + (yv4[j] * rstd) * w;
        }
    }
}


#define XB_TMO      128
#define XB_XCNT(j)  (256  + 64 * (j))
#define XB_XSUB(j)  (1280 + 64 * (j))
#define XB_XGEN(j)  (2304 + 64 * (j))
#define XB_TOP      3328
#define XB_TOPGEN   3392
#define XCD_BAR_WORDS 3456
#define XB_SPIN_CAP (1u << 18)

__device__ __forceinline__ unsigned xb_ld(unsigned* p)              { return __hip_atomic_load(p, __ATOMIC_RELAXED, __HIP_MEMORY_SCOPE_AGENT); }
__device__ __forceinline__ unsigned xb_add(unsigned* p, unsigned v) { return __hip_atomic_fetch_add(p, v, __ATOMIC_RELAXED, __HIP_MEMORY_SCOPE_AGENT); }
__device__ __forceinline__ unsigned xb_xcc_id() { return (unsigned)__builtin_amdgcn_s_getreg((3 << 11) | 20) & 0xFu; }
#define XB_SPIN(cond, bar) do { unsigned _sp = 0; while (cond) { __builtin_amdgcn_s_sleep(1); \
    if ((++_sp & 255u) == 0u) { if (xb_ld(&(bar)[XB_TMO])) break; if (_sp > XB_SPIN_CAP) { atomicAdd(&(bar)[XB_TMO], 1u); break; } } } } while (0)

struct XcdBarrier {
    unsigned* bar; unsigned x;
    volatile LAS unsigned* st;
};

__device__ __forceinline__ XcdBarrier xcd_barrier_post(unsigned* bar, volatile LAS unsigned* st) {
    XcdBarrier b; b.bar = bar; b.x = xb_xcc_id(); b.st = st;
    if (threadIdx.x == 0) (void)xb_add(&bar[XB_XCNT(b.x)], 1u);
    return b;
}
__device__ __forceinline__ void xcd_barrier_complete(unsigned* bar, unsigned x, unsigned& nloc, unsigned& nx) {
    const unsigned G = gridDim.x * gridDim.y * gridDim.z;
    unsigned sum, cnt, mine, sp = 0u;
    for (;;) {
        sum = 0u; cnt = 0u; mine = 0u;
#pragma unroll
        for (unsigned j = 0; j < 16; ++j) { const unsigned c = xb_ld(&bar[XB_XCNT(j)]); sum += c; cnt += (c > 0u) ? 1u : 0u; mine = (j == x) ? c : mine; }
        if (sum == G) break;
        __builtin_amdgcn_s_sleep(1);
        if ((++sp & 255u) == 0u) { if (xb_ld(&bar[XB_TMO])) break; if (sp > XB_SPIN_CAP) { atomicAdd(&bar[XB_TMO], 1u); break; } }
    }
    nloc = mine > 0u ? mine : 1u; nx = cnt > 0u ? cnt : 1u;
}

__device__ __forceinline__ void xcd_barrier(const XcdBarrier& b) {
    asm volatile("s_waitcnt vmcnt(0)" ::: "memory");
    __syncthreads();
    if (threadIdx.x == 0) {
        unsigned* bar = b.bar;
        __builtin_amdgcn_s_waitcnt(0);
        unsigned nloc = b.st[0], nx = b.st[1];
        if (nloc == 0u) { xcd_barrier_complete(bar, b.x, nloc, nx); b.st[0] = nloc; b.st[1] = nx; }
        const unsigned old = xb_add(&bar[XB_XSUB(b.x)], 1u);
        const unsigned gen = old / nloc;
        if (old + 1u == (gen + 1u) * nloc) {
            __builtin_amdgcn_fence(__ATOMIC_RELEASE, "agent");
            asm volatile("s_waitcnt vmcnt(0)" ::: "memory");
            const unsigned og = xb_add(&bar[XB_TOP], 1u);
            const unsigned tg = og / nx;
            if (og + 1u == (tg + 1u) * nx) xb_add(&bar[XB_TOPGEN], 1u);
            else XB_SPIN(xb_ld(&bar[XB_TOPGEN]) == tg, bar);
            __builtin_amdgcn_fence(__ATOMIC_ACQUIRE, "agent");
            xb_add(&bar[XB_XGEN(b.x)], 1u);
            asm volatile("s_waitcnt vmcnt(0)" ::: "memory");
        } else {
            XB_SPIN(xb_ld(&bar[XB_XGEN(b.x)]) == gen, bar);
            __builtin_amdgcn_fence(__ATOMIC_ACQUIRE, "agent");
            asm volatile("s_waitcnt vmcnt(0)" ::: "memory");
        }
    }
    __syncthreads();
}

#ifndef MK_LAUNCHES
#define MK_LAUNCHES 1
#endif
#ifndef REP0
#define REP0 1
#endif
#ifndef REP1
#define REP1 1
#endif
#ifndef REP2
#define REP2 1
#endif
#ifndef REP3
#define REP3 1
#endif
#ifndef REP4
#define REP4 1
#endif
#ifndef REP5
#define REP5 1
#endif
#ifndef REP6
#define REP6 1
#endif
#ifndef REP7
#define REP7 1
#endif
#define REPEAT(n) for (int rep_ = 0; rep_ < (n); ++rep_, ((rep_ < (n)) ? GRIDSYNC() : (void)0))
template <int PH_LO, int PH_HI>
__device__ __forceinline__ void run_phases(const Params& p, LAS unsigned char* lds) {
    int tid = threadIdx.x, lane = tid & 63; const int wid = __builtin_amdgcn_readfirstlane(tid >> 6);
    const int G = gridDim.x, c = blockIdx.x;
#define LAUNDER() asm volatile("" : "+v"(tid), "+v"(lane))
    XcdBarrier bar_;
    if (PH_HI - PH_LO > 1) {
        volatile LAS unsigned* stw = (volatile LAS unsigned*)(lds + LDS_BARW);
        if (threadIdx.x == 0) { stw[0] = 0u; stw[1] = 0u; }
        __syncthreads();
        bar_ = xcd_barrier_post((unsigned*)p.ws, stw);
        if (p.ws == nullptr) cg::this_grid().sync();
    }
#define GRIDSYNC() xcd_barrier(bar_)
#define SEAM(ph) do { if (PH_LO <= (ph) && (ph) + 1 < PH_HI) { GRIDSYNC(); } } while (0)
#ifdef XSYNC
    for (int xs_ = 0; xs_ < XSYNC; ++xs_) GRIDSYNC();
#endif
    if (PH_LO <= 0 && 0 < PH_HI) REPEAT(REP0) { LAUNDER(); phase0(p, lds, tid, wid, lane); }
    SEAM(0);
    if (PH_LO <= 1 && 1 < PH_HI) REPEAT(REP1) {
        for (int t = c; t < 224; t += G) { f32x4 acc[1]; thin_gemm<1>((const bf16_t*)(p.ws + WS_RA) + (size_t)TOK_P * DM, DM, (const bf16_t*)(p.ws + WS_WIN), DM, 16 * t, 0, 0, DM, acc, wid, lane);
            thin_store(acc[0], (float*)(p.ws + WS_PS), NIN, 16 * t, wid, lane); }
        pg8::Gemm g{(const bf16_t*)(p.ws + WS_RA), (const bf16_t*)(p.ws + WS_WIN), TOK_P, NIN, DM};
        pg8::StaticOrder S; S.init(TOK_P, NIN, G, c);
        pg8::EpiIn E{(bf16_t*)(p.ws + WS_RB), (const float*)(p.ws + WS_COS), (const float*)(p.ws + WS_SIN)};
        pg8::gemm_phase<pg8::EpiIn, pg8::StaticOrder, true, true>(lds, g, S, E);
    }
    SEAM(1);
    if (PH_LO <= 2 && 2 < PH_HI) REPEAT(REP2) {
        for (int u = c; u < 256; u += G) ret_unit<false>(p, lds, u, tid, wid, lane);
        LAUNDER();
        for (int su = c; su < 32; su += G) sample_unit(p, lds, su, tid, wid, lane);
    }
    SEAM(2);
    if (PH_LO <= 3 && 3 < PH_HI) REPEAT(REP3) {
        for (int u = c; u < 256; u += G) ret_unit<true>(p, lds, u, tid, wid, lane);
    }
    SEAM(3);
    if (PH_LO <= 4 && 4 < PH_HI) REPEAT(REP4) {
        for (int t = c; t < 256; t += G) { f32x4 acc[1]; const int kq = t >> 6, nt = t & 63;
            thin_gemm<1>((const bf16_t*)(p.ws + WS_RA) + (size_t)TOK_P * DM, DM, (const bf16_t*)(p.ws + WS_WOUT), DM, 16 * nt, 0, 256 * kq, 256, acc, wid, lane);
            thin_store(acc[0], (float*)(p.ws + WS_YS) + (size_t)kq * 128 * DM, DM, 16 * nt, wid, lane); }
        pg8::Gemm g{(const bf16_t*)(p.ws + WS_RA), (const bf16_t*)(p.ws + WS_WOUT), TOK_P, DM, DM};
        pg8::StaticOrder S; S.init(TOK_P, DM, G, c);
        pg8::EpiY E{(bf16_t*)(p.ws + WS_RB), (float*)(p.ws + WS_SSQ1)};
        pg8::gemm_phase<pg8::EpiY, pg8::StaticOrder, true, true>(lds, g, S, E);
    }
    SEAM(4);
    if (PH_LO <= 5 && 5 < PH_HI) REPEAT(REP5) { LAUNDER(); phase4(p, wid, lane); }
    SEAM(5);
    if (PH_LO <= 6 && 6 < PH_HI) REPEAT(REP6) {
        for (int t = c; t < 256; t += G) thin_ffn1(p, t, wid, lane);
        pg8::Gemm g{(const bf16_t*)(p.ws + WS_RA), (const bf16_t*)(p.ws + WS_WFF1), TOK_P, 2 * DFF, DM};
        pg8::WalkOrder S{G, c};
        pg8::EpiFfn E{(bf16_t*)(p.ws + WS_RB), p.in[15], p.in[4], p.out + O_CFP, p.out + O_CFS, (LAS float*)(lds + LDS_HALO)};
        pg8::gemm_phase<pg8::EpiFfn, pg8::WalkOrder, true, true>(lds, g, S, E);
    }
    SEAM(6);
    if (PH_LO <= 7 && 7 < PH_HI) REPEAT(REP7) {
        for (int t = c; t < 256; t += G) { f32x4 acc[1]; const int kq = t >> 6, nt = t & 63;
            thin_gemm<1>((const bf16_t*)(p.ws + WS_RB) + (size_t)TOK_P * DFF, DFF, (const bf16_t*)(p.ws + WS_WDN), DFF, 16 * nt, 0, 1024 * kq, 1024, acc, wid, lane);
            thin_store(acc[0], (float*)(p.ws + WS_FS) + (size_t)kq * 128 * DM, DM, 16 * nt, wid, lane); }
        pg8::Gemm g{(const bf16_t*)(p.ws + WS_RB), (const bf16_t*)(p.ws + WS_WDN), TOK_P, DM, DFF};
        pg8::StaticOrder S; S.init(TOK_P, DM, G, c);
        pg8::EpiY E{(bf16_t*)(p.ws + WS_RA), (float*)(p.ws + WS_SSQ2)};
        pg8::gemm_phase<pg8::EpiY, pg8::StaticOrder, true, true>(lds, g, S, E);
    }
    SEAM(7);
    if (PH_LO <= 8 && 8 < PH_HI) { LAUNDER(); phase7(p, wid, lane); }
#undef SEAM
}
constexpr int NPH = 9;
#if MK_LAUNCHES == 1
__global__ void __launch_bounds__(512, 2) fwd_kernel(Params p) {
    extern __shared__ __attribute__((aligned(16))) unsigned char smem[];
    run_phases<0, NPH>(p, (LAS unsigned char*)smem);
}
#else
template <int PH>
__global__ void __launch_bounds__(512, 2) fwd_phase(Params p) {
    extern __shared__ __attribute__((aligned(16))) unsigned char smem[];
    run_phases<PH, PH + 1>(p, (LAS unsigned char*)smem);
}
template <int PH> static void launch_phase(const Params& p, int grid, hipStream_t stream) {
    static bool attr = false;
    if (!attr) { (void)hipFuncSetAttribute((const void*)fwd_phase<PH>, hipFuncAttributeMaxDynamicSharedMemorySize, LDS_BYTES); attr = true; }
    hipLaunchKernelGGL(fwd_phase<PH>, dim3(grid), dim3(512), LDS_BYTES, stream, p);
}
#endif

extern "C" void kernel_launch(void* const* d_in, const int* in_sizes, int n_in, void* d_out, int out_size, void* d_ws, size_t ws_size, hipStream_t stream) {
    static int grid = 0;
    if (grid == 0) {
        if (n_in != 17 || ws_size < WS_END) { fprintf(stderr, "kernel_launch: expected 17 inputs and >= %zu bytes of workspace (got %d, %zu)\n", (size_t)WS_END, n_in, ws_size); grid = -1; return; }
        int dev = 0, cus = 0, per_cu = 0;
        (void)hipGetDevice(&dev); (void)hipDeviceGetAttribute(&cus, hipDeviceAttributeMultiprocessorCount, dev);
#if MK_LAUNCHES == 1
        if (hipFuncSetAttribute((const void*)fwd_kernel, hipFuncAttributeMaxDynamicSharedMemorySize, LDS_BYTES) != hipSuccess) { fprintf(stderr, "kernel_launch: hipFuncSetAttribute failed\n"); grid = -1; return; }
        if (hipOccupancyMaxActiveBlocksPerMultiprocessor(&per_cu, (const void*)fwd_kernel, 512, LDS_BYTES) != hipSuccess || per_cu < 1) { fprintf(stderr, "kernel_launch: occupancy query says %d\n", per_cu); per_cu = 1; }
        (void)hipGetLastError();
#endif
        grid = cus > 0 ? cus : 256;
    }
    if (grid < 0) return;
    Params p{};
    for (int i = 0; i < 17; ++i) p.in[i] = (const float*)d_in[i];
    p.out = (float*)d_out; p.ws = (unsigned char*)d_ws;
#if MK_LAUNCHES == 1
    if (hipMemsetAsync(d_ws, 0, 16384, stream) != hipSuccess) { fprintf(stderr, "kernel_launch: hipMemsetAsync failed\n"); return; }
    void* args[] = {&p};
    const hipError_t e = hipLaunchCooperativeKernel((const void*)fwd_kernel, dim3(grid), dim3(512), args, LDS_BYTES, stream);
    if (e != hipSuccess) fprintf(stderr, "kernel_launch: cooperative launch failed: %s (grid %d)\n", hipGetErrorString(e), grid);
#else
    launch_phase<0>(p, grid, stream); launch_phase<1>(p, grid, stream); launch_phase<2>(p, grid, stream); launch_phase<3>(p, grid, stream); launch_phase<4>(p, grid, stream);
    launch_phase<5>(p, grid, stream); launch_phase<6>(p, grid, stream); launch_phase<7>(p, grid, stream); launch_phase<8>(p, grid, stream);
#endif
}
```

```cpp
#include <hip/hip_runtime.h>
#include <hip/hip_cooperative_groups.h>
#include <cstdio>
#include <cstdint>
namespace cg = cooperative_groups;
namespace pg8 {
#define PG8_LAS __attribute__((address_space(3)))
typedef unsigned short bf16_t;
typedef short bf16x8 __attribute__((ext_vector_type(8)));
typedef float f32x4 __attribute__((ext_vector_type(4)));
typedef unsigned u32x4 __attribute__((ext_vector_type(4)));
constexpr int BM = 256, BK = 64, HALF = 128, HTB = HALF * BK * 2  , STAGE_BYTES = 8 * HTB, NXCD = 8, WGM = 8;

__host__ __device__ __forceinline__ int lds_byte(int r, int c) { const int st = (r >> 4) * 2 + (c >> 5), rr = r & 15, cc = c & 31, ob = rr * 64 + cc * 2; return st * 1024 + (ob ^ (((ob >> 9) & 1) << 5)); }
__host__ __device__ __forceinline__ void stage_rc(int b, int& R, int& C) { const int st = b / 1024, sb = b % 1024, swz = sb ^ (((sb >> 9) & 1) << 5); R = (st >> 1) * 16 + swz / 64; C = (st & 1) * 32 + (swz % 64) / 2; }
__host__ __device__ __forceinline__ int perm32(int rho) { const int n = rho >> 4, i = rho & 15; return 8 * (i >> 2) + 4 * n + (i & 3); }

struct Unit { int pm, pn; };
struct Gemm { const bf16_t* A; const bf16_t* Bt; int M, N, K; };

struct StaticOrder {
    int nM, nN, nwg, G, c;
    __host__ __device__ void init(int M, int N, int G_, int c_) { nM = M / BM; nN = N / BM; nwg = nM * nN; G = G_; c = c_; }
    __host__ __device__ bool next(int i, Unit& u) const {
        const long L = (long)i * G + c; if (L >= nwg) return false;
        int wgid = (int)L; { const int q = nwg / NXCD, r = nwg % NXCD, xcd = wgid % NXCD, off = wgid / NXCD; wgid = (xcd < r ? xcd * (q + 1) : r * (q + 1) + (xcd - r) * q) + off; }
        const int nig = WGM * nN, gid = wgid / nig, fm = gid * WGM, gsz = (nM - fm) < WGM ? (nM - fm) : WGM;
        u.pm = fm + ((wgid % nig) % gsz); u.pn = (wgid % nig) / gsz; return true;
    }
    __device__ __forceinline__ void a_ready(const Unit&) const {}
    __device__ __forceinline__ void done(const Unit&) const {}
};
__device__ __forceinline__ unsigned cvt_pk_bf16(float lo, float hi) { unsigned r; asm volatile("v_cvt_pk_bf16_f32 %0, %1, %2" : "=v"(r) : "v"(lo), "v"(hi)); return r; }
__device__ __forceinline__ float dpp_shr1(float v) { return __builtin_bit_cast(float, __builtin_amdgcn_update_dpp(0, __builtin_bit_cast(int, v), 0x111, 0xf, 0xf, true)); }
__device__ __forceinline__ float dpp_shr2(float v) { return __builtin_bit_cast(float, __builtin_amdgcn_update_dpp(0, __builtin_bit_cast(int, v), 0x112, 0xf, 0xf, true)); }
__device__ __forceinline__ float dpp_shl15(float v) { return __builtin_bit_cast(float, __builtin_amdgcn_update_dpp(0, __builtin_bit_cast(int, v), 0x10F, 0xf, 0xf, true)); }
__device__ __forceinline__ float dpp_shl14(float v) { return __builtin_bit_cast(float, __builtin_amdgcn_update_dpp(0, __builtin_bit_cast(int, v), 0x10E, 0xf, 0xf, true)); }
__device__ __forceinline__ float gelu_tanh(float x) {
    const float z = 0.7978845608028654f * (x + 0.044715f * x * x * x);
    const float e = __builtin_amdgcn_exp2f(-2.8853900817779268f * z);
    return x * __builtin_amdgcn_rcpf(1.0f + e);
}
constexpr int TOKP = 32768;

struct EpiIn {
    static constexpr bool PERM = true, AFTER_DRAIN = false;
    bf16_t* P; const float* cosT; const float* sinT;
    __device__ __forceinline__ void operator()(const f32x4 (&acc)[2][2][4][2], const Unit& u, int wr, int wc, int fr, int fq) const {
        asm volatile("" : "+v"(fr), "+v"(fq));
        const int row0 = u.pm * BM + wr * 64 + fr, col0 = u.pn * BM + wc * 32 + 8 * fq;
        if (u.pn < 4) {
            const float sc = (u.pn >= 2) ? 0.08838834764831845f : 1.0f;
            const int f0 = 16 * wc + 4 * fq;
#pragma unroll
            for (int ai = 0; ai < 2; ++ai)
#pragma unroll
                for (int m = 0; m < 4; ++m) {
                    const int r = row0 + ai * HALF + m * 16;
                    const int pos = r < TOKP ? (r & 4095) : 4096 + ((r - TOKP) & 15);
                    const f32x4 c4 = *(const f32x4*)(cosT + pos * 64 + f0), s4 = *(const f32x4*)(sinT + pos * 64 + f0);
                    bf16_t* rowp = P + (size_t)r * 3584 + col0;
#pragma unroll
                    for (int bj = 0; bj < 2; ++bj) {
                        const f32x4 x1 = acc[ai][bj][m][0], x2 = acc[ai][bj][m][1];
                        const f32x4 o1 = (x1 * c4 - x2 * s4) * sc, o2 = (x2 * c4 + x1 * s4) * sc;
                        u32x4 w; w.x = cvt_pk_bf16(o1[0], o1[1]); w.y = cvt_pk_bf16(o1[2], o1[3]); w.z = cvt_pk_bf16(o2[0], o2[1]); w.w = cvt_pk_bf16(o2[2], o2[3]);
                        *(u32x4*)(rowp + bj * HALF) = w;
                    }
                }
        } else {
#pragma unroll
            for (int ai = 0; ai < 2; ++ai)
#pragma unroll
                for (int m = 0; m < 4; ++m) {
                    bf16_t* rowp = P + (size_t)(row0 + ai * HALF + m * 16) * 3584 + col0;
#pragma unroll
                    for (int bj = 0; bj < 2; ++bj) {
                        const f32x4 v0 = acc[ai][bj][m][0], v1 = acc[ai][bj][m][1];
                        u32x4 w; w.x = cvt_pk_bf16(v0[0], v0[1]); w.y = cvt_pk_bf16(v0[2], v0[3]); w.z = cvt_pk_bf16(v1[0], v1[1]); w.w = cvt_pk_bf16(v1[2], v1[3]);
                        *(u32x4*)(rowp + bj * HALF) = w;
                    }
                }
        }
    }
};

struct EpiY {
    static constexpr bool PERM = true, AFTER_DRAIN = false;
    bf16_t* Y; float* ssq;
    __device__ __forceinline__ void operator()(const f32x4 (&acc)[2][2][4][2], const Unit& u, int wr, int wc, int fr, int fq) const {
        asm volatile("" : "+v"(fr), "+v"(fq));
        const int row0 = u.pm * BM + wr * 64 + fr, col0 = u.pn * BM + wc * 32 + 8 * fq;
#pragma unroll
        for (int ai = 0; ai < 2; ++ai)
#pragma unroll
            for (int m = 0; m < 4; ++m) {
                const int r = row0 + ai * HALF + m * 16;
                bf16_t* rowp = Y + (size_t)r * 1024 + col0;
                float s = 0.f;
#pragma unroll
                for (int bj = 0; bj < 2; ++bj) {
                    const f32x4 v0 = acc[ai][bj][m][0], v1 = acc[ai][bj][m][1];
                    s += (v0[0] * v0[0] + v0[1] * v0[1]) + (v0[2] * v0[2] + v0[3] * v0[3]) + (v1[0] * v1[0] + v1[1] * v1[1]) + (v1[2] * v1[2] + v1[3] * v1[3]);
                    u32x4 w; w.x = cvt_pk_bf16(v0[0], v0[1]); w.y = cvt_pk_bf16(v0[2], v0[3]); w.z = cvt_pk_bf16(v1[0], v1[1]); w.w = cvt_pk_bf16(v1[2], v1[3]);
                    *(u32x4*)(rowp + bj * HALF) = w;
                }
                s += __shfl_xor(s, 16); s += __shfl_xor(s, 32);
                if (fq == 0) ssq[(size_t)r * 16 + u.pn * 4 + wc] = s;
            }
    }
};

struct EpiFfn {
    static constexpr bool PERM = true, AFTER_DRAIN = false;
    bf16_t* ACT; const float* cw; const float* cache; float* outp; float* outs; PG8_LAS float* halo;
    __device__ __forceinline__ void operator()(const f32x4 (&acc)[2][2][4][2], const Unit& u, int wr, int wc, int fr, int fq) const {
        asm volatile("" : "+v"(fr), "+v"(fq));
        const int lc0 = wc * 32 + 8 * fq, ch0 = u.pn * 128 + lc0;
        const bool sample = false;
        const int par = u.pm & 1;
        f32x4 w0[2], w1[2], w2[2];
#pragma unroll
        for (int n = 0; n < 2; ++n) { w0[n] = *(const f32x4*)(cw + ch0 + 4 * n); w1[n] = *(const f32x4*)(cw + 4096 + ch0 + 4 * n); w2[n] = *(const f32x4*)(cw + 8192 + ch0 + 4 * n); }
        if (!sample && fr >= 14) {
#pragma unroll
            for (int ai = 0; ai < 2; ++ai) { PG8_LAS float* hp = halo + ((par * 4 + 2 * ai + wr) * 2 + (fr - 14)) * 128 + lc0;
                *(PG8_LAS f32x4*)hp = acc[ai][0][3][0]; *(PG8_LAS f32x4*)(hp + 4) = acc[ai][0][3][1]; }
        }
        asm volatile("s_waitcnt lgkmcnt(0)" ::: "memory"); __builtin_amdgcn_s_barrier(); asm volatile("" ::: "memory");
#pragma unroll
        for (int ai = 0; ai < 2; ++ai) {
            const int blk = 2 * ai + wr;
#pragma unroll
            for (int m = 0; m < 4; ++m) {
                f32x4 pv[2]; pv[0] = (f32x4){0.f, 0.f, 0.f, 0.f}; pv[1] = pv[0];
                const int sb = 8 * ai + 4 * wr + m;
                if (sample) {
                    if (fr >= 14 && sb < 8) { const float* cp = cache + (size_t)(sb * 2 + fr - 14) * 4096 + ch0; pv[0] = *(const f32x4*)cp; pv[1] = *(const f32x4*)(cp + 4); }
                } else if (m == 0) {
                    if (fr >= 14) {
                        const bool zero = (blk == 0) && ((u.pm & 15) == 0);
                        const int hb = (blk == 0) ? ((par ^ 1) * 4 + 3) : (par * 4 + blk - 1);
                        if (!zero) { const PG8_LAS float* hp = halo + (hb * 2 + fr - 14) * 128 + lc0; pv[0] = *(const PG8_LAS f32x4*)hp; pv[1] = *(const PG8_LAS f32x4*)(hp + 4); }
                    }
                } else { pv[0] = acc[ai][0][m - 1][0]; pv[1] = acc[ai][0][m - 1][1]; }
                const int r = u.pm * BM + ai * HALF + wr * 64 + m * 16 + fr;
                float a8[8];
#pragma unroll
                for (int n = 0; n < 2; ++n)
#pragma unroll
                    for (int e = 0; e < 4; ++e) {
                        const float cur = acc[ai][0][m][n][e], pr = pv[n][e];
                        const float p1 = dpp_shr1(cur) + dpp_shl15(pr), p2 = dpp_shr2(cur) + dpp_shl14(pr);
                        const float uc = w0[n][e] * p2 + w1[n][e] * p1 + w2[n][e] * cur;
                        a8[4 * n + e] = gelu_tanh(uc) * acc[ai][1][m][n][e];
                    }
                u32x4 w; w.x = cvt_pk_bf16(a8[0], a8[1]); w.y = cvt_pk_bf16(a8[2], a8[3]); w.z = cvt_pk_bf16(a8[4], a8[5]); w.w = cvt_pk_bf16(a8[6], a8[7]);
                *(u32x4*)(ACT + (size_t)r * 4096 + ch0) = w;
                if (sample) {
                    if (fr >= 14 && sb < 8) { float* op = outs + (size_t)(sb * 2 + fr - 14) * 4096 + ch0; *(f32x4*)op = acc[ai][0][m][0]; *(f32x4*)(op + 4) = acc[ai][0][m][1]; }
                } else if (m == 3 && blk == 3 && (u.pm & 15) == 15 && fr >= 14) {
                    float* op = outp + (size_t)((u.pm >> 4) * 2 + fr - 14) * 4096 + ch0; *(f32x4*)op = acc[ai][0][m][0]; *(f32x4*)(op + 4) = acc[ai][0][m][1];
                }
            }
        }
    }
};
struct WalkOrder {
    int G, c;
    __device__ __forceinline__ bool next(int i, Unit& u) const {
        int w = c, rem = i;
        while (w < 256) { const int len = 16;
            if (rem < len) { if (w < 256) { u.pm = (w >> 5) * 16 + rem; u.pn = w & 31; } else { u.pm = 128; u.pn = w - 256; } return true; }
            rem -= len; w += G; }
        return false;
    }
    __device__ __forceinline__ void a_ready(const Unit&) const {}
    __device__ __forceinline__ void done(const Unit&) const {}
};
template <class Epi, class Sched, bool ALIGN_EPI = false, bool SP2 = false>
__device__ __forceinline__ void gemm_phase(PG8_LAS unsigned char* lds, const Gemm g, const Sched& S, const Epi& E) {
    int tid_raw = threadIdx.x; asm volatile("" : "+v"(tid_raw));
    const int tid = tid_raw, wid = __builtin_amdgcn_readfirstlane(tid >> 6), lane = tid & 63, wr = wid >> 2, wc = wid & 3, fr = lane & 15, fq = lane >> 4;
    const int K = g.K, nt = K / BK;
    unsigned voffA[2], voffB[2];
#pragma unroll
    for (int i = 0; i < 2; ++i) { int R, C; stage_rc(tid * 16 + i * 8192, R, C); const int Rb = Epi::PERM ? ((R & ~31) + perm32(R & 31)) : R;
        voffA[i] = (unsigned)(R * K + C) * 2u; voffB[i] = (unsigned)(Rb * K + C) * 2u; }
    const size_t kstep = (size_t)(BK * 2);
    const size_t hstep = (size_t)HALF * K * 2;
    const size_t tstep = 2 * hstep;
    const unsigned ldsw = (unsigned)wid * 1024u;
    const int aoff = lds_byte(wr * 64 + fr, fq * 8), boff = lds_byte(wc * 32 + fr, fq * 8);
#define PG8_SA(b, h) (((b) * 2 + (h)) * HTB)
#define PG8_SB(b, h) ((4 + (b) * 2 + (h)) * HTB)
#define PG8_STAGE(bufoff, gbase, voff) do { _Pragma("unroll") for (int _i = 0; _i < 2; ++_i) \
        __builtin_amdgcn_global_load_lds((const unsigned*)((const char*)(gbase) + (voff)[_i]), (PG8_LAS unsigned*)(lds + (bufoff) + ldsw + _i * 8192), 16, 0, 0); } while (0)
#define PG8_LDA(dst, b, h) do { _Pragma("unroll") for (int m = 0; m < 4; ++m) _Pragma("unroll") for (int k = 0; k < 2; ++k) dst[m][k] = *(const PG8_LAS bf16x8*)(lds + PG8_SA(b, h) + aoff + m * 2048 + k * 1024); } while (0)
#define PG8_LDB(dst, b, h) do { _Pragma("unroll") for (int n = 0; n < 2; ++n) _Pragma("unroll") for (int k = 0; k < 2; ++k) dst[n][k] = *(const PG8_LAS bf16x8*)(lds + PG8_SB(b, h) + boff + n * 2048 + k * 1024); } while (0)
#define PG8_MMA(ai, bj, At, Bt) do { __builtin_amdgcn_s_setprio(1); _Pragma("unroll") for (int m = 0; m < 4; ++m) _Pragma("unroll") for (int n = 0; n < 2; ++n) _Pragma("unroll") for (int k = 0; k < 2; ++k) \
        acc[ai][bj][m][n] = __builtin_amdgcn_mfma_f32_16x16x32_bf16(Bt[n][k], At[m][k], acc[ai][bj][m][n], 0, 0, 0); __builtin_amdgcn_s_setprio(0); } while (0)
#define PG8_WAIT_V(n) asm volatile("s_waitcnt vmcnt(" #n ")" ::: "memory")
#define PG8_WAIT_L(n) asm volatile("s_waitcnt lgkmcnt(" #n ")" ::: "memory")
#define PG8_BAR __builtin_amdgcn_s_barrier()
#define PG8_SCHED __builtin_amdgcn_sched_barrier(0)
    Unit cur, nxt; int ui = 0;
    if (!S.next(0, cur)) return;
    f32x4 acc[2][2][4][2];
#pragma unroll
    for (int a = 0; a < 2; ++a)
#pragma unroll
        for (int b = 0; b < 2; ++b)
#pragma unroll
            for (int m = 0; m < 4; ++m)
#pragma unroll
                for (int n = 0; n < 2; ++n) acc[a][b][m][n] = (f32x4){0.f, 0.f, 0.f, 0.f};
    bf16x8 At[4][2], B0[2][2], B1[2][2];
    const char* cA = (const char*)g.A + (size_t)cur.pm * tstep; const char* cB = (const char*)g.Bt + (size_t)cur.pn * tstep;
    S.a_ready(cur);
    if constexpr (SP2) {
        PG8_STAGE(PG8_SB(0, 0), cB, voffB); PG8_STAGE(PG8_SB(0, 1), cB + hstep, voffB); PG8_STAGE(PG8_SA(0, 0), cA, voffA); PG8_STAGE(PG8_SA(0, 1), cA + hstep, voffA);
        if (wr == 1) PG8_BAR;
        PG8_WAIT_V(2); PG8_BAR;
        PG8_STAGE(PG8_SB(1, 0), cB + kstep, voffB); PG8_STAGE(PG8_SA(1, 0), cA + kstep, voffA); PG8_STAGE(PG8_SB(1, 1), cB + hstep + kstep, voffB);
        PG8_WAIT_V(6); PG8_BAR;
    } else {
        PG8_STAGE(PG8_SB(0, 0), cB, voffB); PG8_STAGE(PG8_SA(0, 0), cA, voffA); PG8_STAGE(PG8_SB(0, 1), cB + hstep, voffB); PG8_STAGE(PG8_SA(0, 1), cA + hstep, voffA);
        if (wr == 1) PG8_BAR;
        PG8_WAIT_V(4); PG8_BAR;
        PG8_STAGE(PG8_SB(1, 0), cB + kstep, voffB); PG8_STAGE(PG8_SA(1, 0), cA + kstep, voffA); PG8_STAGE(PG8_SB(1, 1), cB + hstep + kstep, voffB);
        PG8_WAIT_V(6); PG8_BAR;
    }
    for (;;) {
        const bool has_next = S.next(ui + 1, nxt);
        const char* nA = has_next ? (const char*)g.A + (size_t)nxt.pm * tstep : cA; const char* nB = has_next ? (const char*)g.Bt + (size_t)nxt.pn * tstep : cB;
        for (int t = 0; t < nt; t += 2) {
            const bool last = (t == nt - 2);
            const char* a1 = cA + (size_t)(t + 1) * kstep;
            const char* a2 = last ? nA : cA + (size_t)(t + 2) * kstep; const char* b2 = last ? nB : cB + (size_t)(t + 2) * kstep;
            const char* a3 = a2 + kstep; const char* b3 = b2 + kstep;
            if (last && has_next) S.a_ready(nxt);
            if constexpr (SP2) {
            PG8_LDB(B0, 0, 0); PG8_LDB(B1, 0, 1); PG8_SCHED; PG8_LDA(At, 0, 0); PG8_STAGE(PG8_SA(1, 1), a1 + hstep, voffA);
            PG8_WAIT_V(8); PG8_WAIT_L(0); PG8_BAR; PG8_MMA(0, 0, At, B0); PG8_MMA(0, 1, At, B1); PG8_BAR; PG8_SCHED;
            PG8_LDA(At, 0, 1); PG8_STAGE(PG8_SB(0, 0), b2, voffB); PG8_STAGE(PG8_SB(0, 1), b2 + hstep, voffB); PG8_STAGE(PG8_SA(0, 0), a2, voffA);
            PG8_WAIT_V(8); PG8_WAIT_L(0); PG8_BAR; PG8_MMA(1, 0, At, B0); PG8_MMA(1, 1, At, B1); PG8_BAR; PG8_SCHED;
            PG8_LDB(B0, 1, 0); PG8_LDB(B1, 1, 1); PG8_SCHED; PG8_LDA(At, 1, 0); PG8_STAGE(PG8_SA(0, 1), a2 + hstep, voffA);
            PG8_WAIT_V(8); PG8_WAIT_L(0); PG8_BAR; PG8_MMA(0, 0, At, B0); PG8_MMA(0, 1, At, B1); PG8_BAR; PG8_SCHED;
            PG8_LDA(At, 1, 1); PG8_STAGE(PG8_SB(1, 0), b3, voffB); PG8_STAGE(PG8_SB(1, 1), b3 + hstep, voffB); PG8_STAGE(PG8_SA(1, 0), a3, voffA);
            PG8_WAIT_V(8); PG8_WAIT_L(0); PG8_BAR; PG8_MMA(1, 0, At, B0); PG8_MMA(1, 1, At, B1); PG8_BAR; PG8_SCHED;
            } else {
            PG8_LDB(B0, 0, 0); PG8_SCHED; PG8_LDA(At, 0, 0); PG8_STAGE(PG8_SA(1, 1), a1 + hstep, voffA);
            PG8_WAIT_L(8); PG8_BAR; PG8_WAIT_L(0); PG8_MMA(0, 0, At, B0); PG8_BAR; PG8_SCHED;
            PG8_LDB(B1, 0, 1); PG8_STAGE(PG8_SB(0, 0), b2, voffB);
            PG8_BAR; PG8_WAIT_L(0); PG8_MMA(0, 1, At, B1); PG8_BAR;
            PG8_LDA(At, 0, 1); PG8_STAGE(PG8_SA(0, 0), a2, voffA);
            PG8_BAR; PG8_WAIT_L(0); PG8_MMA(1, 0, At, B0); PG8_BAR; PG8_SCHED;
            PG8_STAGE(PG8_SB(0, 1), b2 + hstep, voffB);
            PG8_WAIT_V(6); PG8_BAR; PG8_MMA(1, 1, At, B1); PG8_BAR;
            PG8_LDB(B0, 1, 0); PG8_SCHED; PG8_LDA(At, 1, 0); PG8_STAGE(PG8_SA(0, 1), a2 + hstep, voffA);
            PG8_WAIT_L(8); PG8_BAR; PG8_WAIT_L(0); PG8_MMA(0, 0, At, B0); PG8_BAR; PG8_SCHED;
            PG8_LDB(B1, 1, 1); PG8_STAGE(PG8_SB(1, 0), b3, voffB);
            PG8_BAR; PG8_WAIT_L(0); PG8_MMA(0, 1, At, B1); PG8_BAR;
            PG8_LDA(At, 1, 1); PG8_STAGE(PG8_SA(1, 0), a3, voffA);
            PG8_BAR; PG8_WAIT_L(0); PG8_MMA(1, 0, At, B0); PG8_BAR; PG8_SCHED;
            PG8_STAGE(PG8_SB(1, 1), b3 + hstep, voffB);
            PG8_WAIT_V(6); PG8_BAR; PG8_MMA(1, 1, At, B1); PG8_BAR;
            }
        }
        if constexpr (ALIGN_EPI) { if (wr == 0) PG8_BAR; }
        if constexpr (!Epi::AFTER_DRAIN) { E(acc, cur, wr, wc, fr, fq); S.done(cur); }
        if (!has_next) break;
#pragma unroll
        for (int a = 0; a < 2; ++a)
#pragma unroll
            for (int b = 0; b < 2; ++b)
#pragma unroll
                for (int m = 0; m < 4; ++m)
#pragma unroll
                    for (int n = 0; n < 2; ++n) acc[a][b][m][n] = (f32x4){0.f, 0.f, 0.f, 0.f};
        cur = nxt; cA = nA; cB = nB; ++ui;
        if constexpr (ALIGN_EPI) { if (wr == 1) PG8_BAR; }
    }
    PG8_WAIT_V(0);
    if constexpr (!ALIGN_EPI) { if (wr == 0) PG8_BAR; }
    PG8_BAR;
    if constexpr (Epi::AFTER_DRAIN) { E.fused(acc, cur, wr, wc, fr, fq, lds, wid, lane); S.done(cur); }
#undef PG8_SA
#undef PG8_SB
#undef PG8_STAGE
#undef PG8_LDA
#undef PG8_LDB
#undef PG8_MMA
#undef PG8_WAIT_V
#undef PG8_WAIT_L
#undef PG8_BAR
#undef PG8_SCHED
}
}

using pg8::bf16_t; using pg8::bf16x8; using pg8::f32x4; using pg8::u32x4;
#define LAS __attribute__((address_space(3)))
typedef unsigned u32x2 __attribute__((ext_vector_type(2)));
constexpr int DM = 1024, NIN = 3584, DFF = 4096;
constexpr int TOK_P = 32768, TOK = 32896, TOKPAD = 33024;
constexpr float EPS = 1e-6f;
constexpr size_t WS_WIN = 16384;
constexpr size_t WS_WOUT = WS_WIN + (size_t)NIN * DM * 2;
constexpr size_t WS_WFF1 = WS_WOUT + (size_t)DM * DM * 2;
constexpr size_t WS_WDN = WS_WFF1 + (size_t)2 * DFF * DM * 2;
constexpr size_t WS_COS = WS_WDN + (size_t)DM * DFF * 2;
constexpr size_t WS_SIN = WS_COS + (size_t)4112 * 64 * 4;
constexpr size_t WS_SSQ1 = WS_SIN + (size_t)4112 * 64 * 4;
constexpr size_t WS_SSQ2 = WS_SSQ1 + (size_t)TOKPAD * 16 * 4;
constexpr size_t WS_UG = WS_SSQ2 + (size_t)TOKPAD * 16 * 4;
constexpr size_t WS_PS = WS_UG + (size_t)256 * 65536;
constexpr size_t WS_YS = WS_PS + (size_t)128 * NIN * 4;
constexpr size_t WS_FS = WS_YS + (size_t)4 * 128 * DM * 4;
constexpr size_t WS_RA = WS_FS + (size_t)4 * 128 * DM * 4;
constexpr size_t WS_RB = WS_RA + (size_t)TOKPAD * DM * 2;
constexpr size_t WS_END = WS_RB + (size_t)TOKPAD * DFF * 2;
constexpr size_t O_SRP = (size_t)TOK * DM, O_CCP = O_SRP + 524288, O_CFP = O_CCP + 8192, O_SRS = O_CFP + 65536, O_CCS = O_SRS + 524288, O_CFS = O_CCS + 8192;
constexpr int LDS_HALO = 131072, LDS_BARW = 131072 + 8192, LDS_BYTES = LDS_BARW + 16;

struct Params { const float* in[17]; float* out; unsigned char* ws; };

__device__ __forceinline__ float dppf(float v, const int ctrl_sel) {
    const int iv = __builtin_bit_cast(int, v); int r;
    switch (ctrl_sel) { case 1: r = __builtin_amdgcn_update_dpp(0, iv, 0x111, 0xf, 0xf, true); break; case 2: r = __builtin_amdgcn_update_dpp(0, iv, 0x112, 0xf, 0xf, true); break;
        case 4: r = __builtin_amdgcn_update_dpp(0, iv, 0x114, 0xf, 0xf, true); break; case 8: r = __builtin_amdgcn_update_dpp(0, iv, 0x118, 0xf, 0xf, true); break;
        case 15: r = __builtin_amdgcn_update_dpp(0, iv, 0x142, 0xa, 0xf, false); break; default: r = __builtin_amdgcn_update_dpp(0, iv, 0x143, 0xc, 0xf, false); break; }
    return __builtin_bit_cast(float, r);
}
__device__ __forceinline__ float wave_sum(float v) {
    v += dppf(v, 1); v += dppf(v, 2); v += dppf(v, 4); v += dppf(v, 8); v += dppf(v, 15); v += dppf(v, 31);
    return __builtin_bit_cast(float, __builtin_amdgcn_readlane(__builtin_bit_cast(int, v), 63));
}
__device__ __forceinline__ float bf2f(unsigned short b) { return __uint_as_float(((unsigned)b) << 16); }
__device__ __forceinline__ unsigned pk2(float a, float b) { return pg8::cvt_pk_bf16(a, b); }
__device__ __forceinline__ float silu_f(float g) { return g * __builtin_amdgcn_rcpf(1.0f + __builtin_amdgcn_exp2f(-1.4426950408889634f * g)); }
__device__ __forceinline__ int dmap(int P) { return ((P >> 2) & 1) * 64 + (P >> 3) * 4 + (P & 3); }
__device__ __forceinline__ int pmap(int d) { return ((d >> 4) & 3) * 32 + ((d >> 2) & 3) * 8 + ((d >> 6) & 1) * 4 + (d & 3); }

constexpr int RB = 4;
__device__ __forceinline__ f32x4 unpack_bf4(const u32x2 w) { f32x4 v; v[0] = __uint_as_float(w.x << 16); v[1] = __uint_as_float(w.x & 0xffff0000u); v[2] = __uint_as_float(w.y << 16); v[3] = __uint_as_float(w.y & 0xffff0000u); return v; }
__device__ __forceinline__ float sumsq4(const f32x4 a) { return (a[0] * a[0] + a[1] * a[1]) + (a[2] * a[2] + a[3] * a[3]); }
template <int MODE> __device__ __forceinline__ int rowmap(int c) {
    if (MODE == 0) { if (c < 1024) return (c & ~127) + pmap(c & 127); return c; }
    if (MODE == 1) return c;
    if (MODE == 2) return ((c >> 7) << 8) + (c & 127);
    return ((c >> 7) << 8) + 128 + (c & 127);
}
template <int MODE>
__device__ __forceinline__ void transpose_item(const float* W, int K, int N, bf16_t* WT, LAS float* scr, int item, int lane) {
    const int nblk = N / 32, kb = item / nblk, nb = item % nblk, k0 = 64 * kb, n0 = 32 * nb;
#pragma unroll
    for (int i = 0; i < 32; ++i) { const int kk = 2 * i + (lane >> 5); scr[kk * 33 + (lane & 31)] = W[(size_t)(k0 + kk) * N + n0 + (lane & 31)]; }
    asm volatile("s_waitcnt lgkmcnt(0)" ::: "memory");
    const int c = lane & 7;
#pragma unroll
    for (int j = 0; j < 4; ++j) { const int n = (lane >> 3) + 8 * j; const LAS float* s = scr + (8 * c) * 33 + n;
        u32x4 o; o.x = pk2(s[0 * 33], s[1 * 33]); o.y = pk2(s[2 * 33], s[3 * 33]); o.z = pk2(s[4 * 33], s[5 * 33]); o.w = pk2(s[6 * 33], s[7 * 33]);
        *(u32x4*)(WT + (size_t)rowmap<MODE>(n0 + n) * K + k0 + 8 * c) = o; }
    asm volatile("s_waitcnt lgkmcnt(0)" ::: "memory");
}
__device__ __forceinline__ void phase0(const Params& p, LAS unsigned char* lds, int tid, int wid, int lane) {
    LAS float* scr = (LAS float*)(lds + wid * 8448);
    const int gw = blockIdx.x * 8 + wid, NGW = gridDim.x * 8;
    bf16_t* win = (bf16_t*)(p.ws + WS_WIN); bf16_t* wout = (bf16_t*)(p.ws + WS_WOUT); bf16_t* wff1 = (bf16_t*)(p.ws + WS_WFF1); bf16_t* wdn = (bf16_t*)(p.ws + WS_WDN);
    constexpr int I_IN = 16 * 112, I_OUT = 16 * 32, I_UP = 16 * 128, I_DN = 64 * 32, NITEMS = I_IN + I_OUT + 2 * I_UP + I_DN;
    for (int it = gw; it < NITEMS; it += NGW) {
        int r = it;
        if (r < I_IN) { transpose_item<0>(p.in[5], DM, NIN, win, scr, r, lane); continue; } r -= I_IN;
        if (r < I_OUT) { transpose_item<1>(p.in[6], DM, DM, wout, scr, r, lane); continue; } r -= I_OUT;
        if (r < I_UP) { transpose_item<2>(p.in[13], DM, DFF, wff1, scr, r, lane); continue; } r -= I_UP;
        if (r < I_UP) { transpose_item<3>(p.in[14], DM, DFF, wff1, scr, r, lane); continue; } r -= I_UP;
        transpose_item<1>(p.in[16], DFF, DM, wdn, scr, r, lane);
    }
    float* cosT = (float*)(p.ws + WS_COS); float* sinT = (float*)(p.ws + WS_SIN);
    for (int idx = blockIdx.x * 512 + tid; idx < 4112 * 64; idx += gridDim.x * 512) {
        const int pos = idx >> 6, f = idx & 63;
        const float inv = exp2f(-(float)(2 * f) * (1.0f / 128.0f) * 13.287712379549449f);
        const float ang = (float)pos * inv;
        const double rev = (double)ang * 0.15915494309189535;
        const float fr = (float)(rev - floor(rev));
        cosT[idx] = __builtin_amdgcn_cosf(fr); sinT[idx] = __builtin_amdgcn_sinf(fr);
    }
    bf16_t* H = (bf16_t*)(p.ws + WS_RA);
    const float* wpre = p.in[9];
    f32x4 wpr[4];
#pragma unroll
    for (int j = 0; j < 4; ++j) wpr[j] = *((const f32x4*)wpre + lane + 64 * j);
#pragma unroll 1
    for (int base = gw; base < TOK; base += RB * NGW) {
        f32x4 v[RB][4]; float s[RB];
#pragma unroll
        for (int k = 0; k < RB; ++k) { const int rr = min(base + k * NGW, TOK - 1);
            const float* xrow = rr < TOK_P ? p.in[0] + (size_t)rr * DM : p.in[1] + (size_t)(rr - TOK_P) * DM; s[k] = 0.f;
#pragma unroll
            for (int j = 0; j < 4; ++j) { v[k][j] = __builtin_nontemporal_load((const f32x4*)xrow + lane + 64 * j); s[k] += sumsq4(v[k][j]); } }
#pragma unroll
        for (int k = 0; k < RB; ++k) { const int r = base + k * NGW; const float rstd = rsqrtf(wave_sum(s[k]) * (1.0f / DM) + EPS);
            if (r < TOK) {
#pragma unroll
                for (int j = 0; j < 4; ++j) { const f32x4 y = (v[k][j] * rstd) * wpr[j];
                    __builtin_nontemporal_store((u32x2){pk2(y[0], y[1]), pk2(y[2], y[3])}, (u32x2*)(H + (size_t)r * DM) + lane + 64 * j); } } }
    }
}

constexpr int QI_OFF = 0, KI_OFF = 17408, KT_OFF = 34816, VT_OFF = 53248, SI_OFF = 71680, ST_OFF = 80896, GI_OFF = 115712;
#define MFMA16(a, b, c) __builtin_amdgcn_mfma_f32_16x16x32_bf16((a), (b), (c), 0, 0, 0)
#define RET_ISSUE(nn) do { _Pragma("unroll") for (int i_ = 0; i_ < 2; ++i_) { const int idx_ = tid + 512 * i_; \
        const bf16_t* rowp_ = P + (tok0 + (size_t)(nn) * 64 + (idx_ >> 4)) * NIN + 128 * h + (idx_ & 15) * 8; \
        if (FULL) { rq[i_] = *(const u32x4*)rowp_; rg[i_] = *(const u32x4*)(rowp_ + 1536); } rk[i_] = *(const u32x4*)(rowp_ + 512); rv[i_] = *(const u32x4*)(rowp_ + 1024); } } while (0)
#define RET_STAGE_A() do { _Pragma("unroll") for (int i_ = 0; i_ < 2; ++i_) { const int idx_ = tid + 512 * i_, j_ = idx_ >> 4, ch_ = idx_ & 15; \
        if (FULL) { *(LAS u32x4*)(lds + QI_OFF + j_ * 272 + ch_ * 16) = rq[i_]; *(LAS u32x4*)(lds + KI_OFF + j_ * 272 + ch_ * 16) = rk[i_]; *(LAS u32x4*)(lds + GI_OFF + j_ * 272 + ch_ * 16) = rg[i_]; } \
        const float te_ = __builtin_amdgcn_exp2f(l2g * (float)(63 - j_)); \
        const unsigned kw_[4] = {rk[i_].x, rk[i_].y, rk[i_].z, rk[i_].w}, vw_[4] = {rv[i_].x, rv[i_].y, rv[i_].z, rv[i_].w}; \
        const int cofs_ = 16 * ((j_ >> 3) ^ (ch_ & 7)) + 2 * (j_ & 7); \
        _Pragma("unroll") for (int e2 = 0; e2 < 4; ++e2) { \
            const unsigned kk_ = pk2(__uint_as_float(kw_[e2] << 16) * te_, __uint_as_float(kw_[e2] & 0xffff0000u) * te_); \
            const int row_ = 8 * ch_ + 2 * e2; \
            *(LAS unsigned short*)(lds + KT_OFF + row_ * 144 + cofs_) = (unsigned short)(kk_ & 0xffffu); \
            *(LAS unsigned short*)(lds + KT_OFF + (row_ + 1) * 144 + cofs_) = (unsigned short)(kk_ >> 16); \
            *(LAS unsigned short*)(lds + VT_OFF + row_ * 144 + cofs_) = (unsigned short)(vw_[e2] & 0xffffu); \
            *(LAS unsigned short*)(lds + VT_OFF + (row_ + 1) * 144 + cofs_) = (unsigned short)(vw_[e2] >> 16); } } } while (0)
template <bool FULL>
__device__ __forceinline__ void ret_unit(const Params& p, LAS unsigned char* lds, int unit, int tid, int wid, int lane) {
    asm volatile("" : "+v"(tid), "+v"(lane));
    const int G = unit & 7, h = (unit >> 3) & 3, b = unit >> 5;
    const bf16_t* P = (const bf16_t*)(p.ws + WS_RB);
    bf16_t* MIX = (bf16_t*)(p.ws + WS_RA);
    float* UG = (float*)(p.ws + WS_UG);
    const size_t tok0 = (size_t)b * 4096 + (size_t)G * 512;
    const float l2g = log2f(1.0f - exp2f(-5.0f - (float)h));
    const float g64 = __builtin_amdgcn_exp2f(l2g * 64.0f);
    const bool is_state = wid >= 4; const int w4 = wid & 3;
    const int l15 = lane & 15, l4 = lane >> 4;
    const int vtL = l4 ^ (l15 >> 3);
    const int vtb0 = VT_OFF + l15 * 144 + 16 * vtL, vtb1 = VT_OFF + l15 * 144 + 16 * (vtL ^ 2);
#define VT_ADDR(nt, ks) ((((nt) & 1) ? vtb1 : vtb0) + (nt) * 2304 + 16 * (((4 * (ks)) ^ (2 * ((nt) & 3))) & 4))
    u32x4 rq[2], rk[2], rv[2], rg[2];
    if (is_state) {
        f32x4 st[2][8];
#pragma unroll
        for (int mt = 0; mt < 2; ++mt)
#pragma unroll
            for (int nt = 0; nt < 8; ++nt) st[mt][nt] = (f32x4){0.f, 0.f, 0.f, 0.f};
        if (FULL) {
#pragma unroll 1
            for (int Gp = 0; Gp < G; Gp += 2) {
                const float wa = __builtin_amdgcn_exp2f(l2g * 512.0f * (float)(G - 1 - Gp));
                const bool two = Gp + 1 < G;
                const float wb = two ? __builtin_amdgcn_exp2f(l2g * 512.0f * (float)(G - 2 - Gp)) : 0.f;
                const float* sa = UG + ((size_t)((b * 4 + h) * 8 + Gp) * 4 + w4) * 4096 + lane;
                const float* sb = two ? sa + 4 * 4096 : sa;
#pragma unroll
                for (int mt = 0; mt < 2; ++mt)
#pragma unroll
                    for (int nt = 0; nt < 8; ++nt)
#pragma unroll
                        for (int r = 0; r < 4; ++r) st[mt][nt][r] += wa * sa[((mt * 8 + nt) * 4 + r) * 64] + wb * sb[((mt * 8 + nt) * 4 + r) * 64];
            }
        }
        RET_ISSUE(0);
#pragma unroll 1
        for (int n = 0; n < 8; ++n) {
            RET_STAGE_A();
            if (FULL) {
#pragma unroll
                for (int mt = 0; mt < 2; ++mt)
#pragma unroll
                    for (int nt = 0; nt < 8; ++nt) { const int e = 16 * nt + l15, dk0 = 32 * w4 + 16 * mt + 4 * l4;
                        *(LAS u32x2*)(lds + ST_OFF + e * 272 + dk0 * 2) = (u32x2){pk2(st[mt][nt][0], st[mt][nt][1]), pk2(st[mt][nt][2], st[mt][nt][3])}; }
            }
            __syncthreads();
            if (n + 1 < 8) RET_ISSUE(n + 1);
            if (FULL) {
                bf16x8 ak[4], bq[4][4];
#pragma unroll
                for (int ks = 0; ks < 4; ++ks) ak[ks] = *(const LAS bf16x8*)(lds + KI_OFF + (16 * w4 + l15) * 272 + (32 * ks + 8 * l4) * 2);
#pragma unroll
                for (int it = 0; it < 4; ++it)
#pragma unroll
                    for (int ks = 0; ks < 4; ++ks) bq[it][ks] = *(const LAS bf16x8*)(lds + QI_OFF + (16 * it + l15) * 272 + (32 * ks + 8 * l4) * 2);
#pragma unroll
                for (int it = 0; it < 4; ++it) {
                    f32x4 sa = (f32x4){0.f, 0.f, 0.f, 0.f};
#pragma unroll
                    for (int ks = 0; ks < 4; ++ks) sa = MFMA16(ak[ks], bq[it][ks], sa);
                    const int i = 16 * it + l15, j0 = 16 * w4 + 4 * l4;
#pragma unroll
                    for (int r = 0; r < 4; ++r) { const int d = i - (j0 + r); sa[r] *= __builtin_amdgcn_exp2f(l2g * (float)(d < 0 ? -d : d)); }
                    *(LAS u32x2*)(lds + SI_OFF + i * 144 + j0 * 2) = (u32x2){pk2(sa[0], sa[1]), pk2(sa[2], sa[3])};
                }
            }
            __syncthreads();
#pragma unroll
            for (int mt = 0; mt < 2; ++mt)
#pragma unroll
                for (int nt = 0; nt < 8; ++nt) st[mt][nt] = st[mt][nt] * g64;
#pragma unroll
            for (int ks = 0; ks < 2; ++ks) {
                bf16x8 akt[2], bv[8];
#pragma unroll
                for (int mt = 0; mt < 2; ++mt) { const int row = 32 * w4 + 16 * mt + l15; akt[mt] = *(const LAS bf16x8*)(lds + KT_OFF + row * 144 + 16 * ((4 * ks + l4) ^ ((row >> 3) & 7))); }
#pragma unroll
                for (int nt = 0; nt < 8; ++nt) bv[nt] = *(const LAS bf16x8*)(lds + VT_ADDR(nt, ks));
#pragma unroll
                for (int nt = 0; nt < 8; ++nt)
#pragma unroll
                    for (int mt = 0; mt < 2; ++mt) st[mt][nt] = MFMA16(akt[mt], bv[nt], st[mt][nt]);
            }
            __syncthreads();
        }
        if (!FULL) {
            float* dst = UG + ((size_t)unit * 4 + w4) * 4096 + lane;
#pragma unroll
            for (int mt = 0; mt < 2; ++mt)
#pragma unroll
                for (int nt = 0; nt < 8; ++nt)
#pragma unroll
                    for (int r = 0; r < 4; ++r) dst[((mt * 8 + nt) * 4 + r) * 64] = st[mt][nt][r];
        } else if (G == 7) {
            float* o = p.out + O_SRP + (size_t)(b * 4 + h) * 16384 + (64 * (l4 & 1) + 16 * w4 + 4 * (l4 >> 1)) * 128 + l15;
#pragma unroll
            for (int mt = 0; mt < 2; ++mt)
#pragma unroll
                for (int nt = 0; nt < 8; ++nt)
#pragma unroll
                    for (int r = 0; r < 4; ++r) o[(8 * mt + r) * 128 + 16 * nt] = st[mt][nt][r];
        }
    } else {
        float rwv[8];
#pragma unroll
        for (int nt = 0; nt < 8; ++nt) rwv[nt] = p.in[8][128 * h + 16 * nt + l15];
        RET_ISSUE(0);
#pragma unroll 1
        for (int n = 0; n < 8; ++n) {
            RET_STAGE_A();
            __syncthreads();
            if (n + 1 < 8) RET_ISSUE(n + 1);
            f32x4 acc[8];
            if (FULL) {
                f32x4 fsv;
#pragma unroll
                for (int r = 0; r < 4; ++r) fsv[r] = __builtin_amdgcn_exp2f(l2g * (float)(16 * w4 + 4 * l4 + r + 1));
#pragma unroll
                for (int nt = 0; nt < 8; ++nt) acc[nt] = (f32x4){0.f, 0.f, 0.f, 0.f};
                bf16x8 aq[4];
#pragma unroll
                for (int ks = 0; ks < 4; ++ks) aq[ks] = *(const LAS bf16x8*)(lds + QI_OFF + (16 * w4 + l15) * 272 + (32 * ks + 8 * l4) * 2);
#pragma unroll
                for (int ks = 0; ks < 4; ++ks) {
                    bf16x8 bs[8];
#pragma unroll
                    for (int nt = 0; nt < 8; ++nt) bs[nt] = *(const LAS bf16x8*)(lds + ST_OFF + (16 * nt + l15) * 272 + (32 * ks + 8 * l4) * 2);
#pragma unroll
                    for (int nt = 0; nt < 8; ++nt) acc[nt] = MFMA16(aq[ks], bs[nt], acc[nt]);
                }
#pragma unroll
                for (int nt = 0; nt < 8; ++nt) acc[nt] = acc[nt] * fsv;
            }
            __syncthreads();
            if (FULL) {
                bf16x8 as_[2];
#pragma unroll
                for (int ks = 0; ks < 2; ++ks) as_[ks] = *(const LAS bf16x8*)(lds + SI_OFF + (16 * w4 + l15) * 144 + 16 * (4 * ks + l4));
#pragma unroll
                for (int ks = 0; ks < 2; ++ks) {
                    bf16x8 bv[8];
#pragma unroll
                    for (int nt = 0; nt < 8; ++nt) bv[nt] = *(const LAS bf16x8*)(lds + VT_ADDR(nt, ks));
#pragma unroll
                    for (int nt = 0; nt < 8; ++nt) acc[nt] = MFMA16(as_[ks], bv[nt], acc[nt]);
                }
#pragma unroll
                for (int r = 0; r < 4; ++r) {
                    const int i = 16 * w4 + 4 * l4 + r;
                    float ss = 0.f;
#pragma unroll
                    for (int nt = 0; nt < 8; ++nt) ss += acc[nt][r] * acc[nt][r];
                    ss += dppf(ss, 1); ss += dppf(ss, 2); ss += dppf(ss, 4); ss += dppf(ss, 8);
                    ss = __shfl(ss, (lane & 48) | 15);
                    const float rstd = rsqrtf(ss * (1.0f / 128.0f) + EPS);
#pragma unroll
                    for (int nt = 0; nt < 8; ++nt) { const float gq = bf2f(*(const LAS unsigned short*)(lds + GI_OFF + i * 272 + (16 * nt + l15) * 2));
                        *(LAS unsigned short*)(lds + QI_OFF + i * 272 + (16 * nt + l15) * 2) = (unsigned short)(pk2(acc[nt][r] * rstd * rwv[nt] * silu_f(gq), 0.f) & 0xffffu); }
                }
#pragma unroll
                for (int q = 0; q < 4; ++q) { const int cidx = lane + 64 * q, row = 16 * w4 + (cidx >> 4), ch = cidx & 15;
                    const u32x4 v = *(const LAS u32x4*)(lds + QI_OFF + row * 272 + ch * 16);
                    *(u32x4*)(MIX + (tok0 + (size_t)n * 64 + row) * DM + 128 * h + ch * 8) = v; }
            }
            __syncthreads();
        }
    }
    if (FULL) {
        const int c0 = 128 * h + 8 * (tid & 15), run = tid >> 4, t0 = G * 512 + run * 16;
        const float* cwp = p.in[7];
        float w0[8], w1[8], w2[8], p1[8], p2[8];
#pragma unroll
        for (int e = 0; e < 8; ++e) { w0[e] = cwp[c0 + e]; w1[e] = cwp[512 + c0 + e]; w2[e] = cwp[1024 + c0 + e]; p1[e] = 0.f; p2[e] = 0.f; }
        if (t0 > 0) {
            const bf16_t* r2 = P + ((size_t)b * 4096 + t0 - 2) * NIN; const bf16_t* r1 = r2 + NIN;
            const u32x4 c2 = *(const u32x4*)(r2 + 2560 + c0), h2 = *(const u32x4*)(r2 + 3072 + c0), c1 = *(const u32x4*)(r1 + 2560 + c0), h1 = *(const u32x4*)(r1 + 3072 + c0);
            const unsigned c2w[4] = {c2.x, c2.y, c2.z, c2.w}, h2w[4] = {h2.x, h2.y, h2.z, h2.w}, c1w[4] = {c1.x, c1.y, c1.z, c1.w}, h1w[4] = {h1.x, h1.y, h1.z, h1.w};
#pragma unroll
            for (int e = 0; e < 4; ++e) {
                p2[2 * e] = __uint_as_float(c2w[e] << 16) * __uint_as_float(h2w[e] << 16); p2[2 * e + 1] = __uint_as_float(c2w[e] & 0xffff0000u) * __uint_as_float(h2w[e] & 0xffff0000u);
                p1[2 * e] = __uint_as_float(c1w[e] << 16) * __uint_as_float(h1w[e] << 16); p1[2 * e + 1] = __uint_as_float(c1w[e] & 0xffff0000u) * __uint_as_float(h1w[e] & 0xffff0000u); }
        }
#pragma unroll 8
        for (int t = 0; t < 16; ++t) {
            const size_t row = (size_t)b * 4096 + t0 + t;
            const bf16_t* rp = P + row * NIN;
            const u32x4 bb = *(const u32x4*)(rp + 2048 + c0), cc = *(const u32x4*)(rp + 2560 + c0), hh = *(const u32x4*)(rp + 3072 + c0);
            const unsigned bw[4] = {bb.x, bb.y, bb.z, bb.w}, cw4[4] = {cc.x, cc.y, cc.z, cc.w}, hw[4] = {hh.x, hh.y, hh.z, hh.w};
            float y[8];
#pragma unroll
            for (int e = 0; e < 4; ++e) {
                const float ca = __uint_as_float(cw4[e] << 16) * __uint_as_float(hw[e] << 16), cb = __uint_as_float(cw4[e] & 0xffff0000u) * __uint_as_float(hw[e] & 0xffff0000u);
                y[2 * e] = __uint_as_float(bw[e] << 16) * (w0[2 * e] * p2[2 * e] + w1[2 * e] * p1[2 * e] + w2[2 * e] * ca);
                y[2 * e + 1] = __uint_as_float(bw[e] & 0xffff0000u) * (w0[2 * e + 1] * p2[2 * e + 1] + w1[2 * e + 1] * p1[2 * e + 1] + w2[2 * e + 1] * cb);
                p2[2 * e] = p1[2 * e]; p2[2 * e + 1] = p1[2 * e + 1]; p1[2 * e] = ca; p1[2 * e + 1] = cb;
            }
            *(u32x4*)(MIX + row * DM + 512 + c0) = (u32x4){pk2(y[0], y[1]), pk2(y[2], y[3]), pk2(y[4], y[5]), pk2(y[6], y[7])};
        }
        if (G == 7 && run == 31) {
            float* o = p.out + O_CCP + (size_t)b * 1024 + c0;
#pragma unroll
            for (int e = 0; e < 8; ++e) { o[e] = p2[e]; o[512 + e] = p1[e]; }
        }
    }
#undef VT_ADDR
}

__device__ __forceinline__ float ch_at(const float* PS, const float* cache, int b, int t, int ch) {
    if (t < 0) return cache[(b * 2 + (t + 2)) * 512 + ch];
    const float* rp = PS + (size_t)(16 * b + t) * NIN;
    return rp[2560 + ch] * rp[3072 + ch];
}
__device__ __forceinline__ void sample_unit(const Params& p, LAS unsigned char* lds, int su, int tid, int wid, int lane) {
    const int b = su >> 2, h = su & 3, ts0 = TOK_P + 16 * b;
    const float* PS = (const float*)(p.ws + WS_PS);
    bf16_t* MIX = (bf16_t*)(p.ws + WS_RA);
    LAS float* qs = (LAS float*)lds; LAS float* ks = qs + 2048; LAS float* vs = qs + 4096; LAS float* Ssm = qs + 6144; LAS float* osm = qs + 6400;
    const float l2g = log2f(1.0f - exp2f(-5.0f - (float)h));
    const float* cosT = (const float*)(p.ws + WS_COS); const float* sinT = (const float*)(p.ws + WS_SIN);
    for (int idx = tid; idx < 2048; idx += 512) { const int i = idx >> 7, c = idx & 127, d = dmap(c);
        const float* rp = PS + (size_t)(16 * b + i) * NIN + 128 * h;
        const float cs = cosT[(4096 + i) * 64 + (d & 63)], sn = sinT[(4096 + i) * 64 + (d & 63)];
        const float xq = rp[c], xqp = rp[c ^ 4], xk = rp[512 + c], xkp = rp[512 + (c ^ 4)];
        qs[i * 128 + d] = d < 64 ? xq * cs - xqp * sn : xq * cs + xqp * sn;
        ks[i * 128 + d] = (d < 64 ? xk * cs - xkp * sn : xk * cs + xkp * sn) * 0.08838834764831845f;
        vs[i * 128 + c] = rp[1024 + c]; }
    __syncthreads();
    if (tid < 256) { const int i = tid >> 4, j = tid & 15; float s = 0.f;
        for (int d = 0; d < 128; ++d) s += qs[i * 128 + d] * ks[j * 128 + d];
        const int dd = i - j; Ssm[i * 16 + j] = s * __builtin_amdgcn_exp2f(l2g * (float)(dd < 0 ? -dd : dd)); }
    const int e = tid & 127, ig = tid >> 7;
    const float* s0 = p.in[2] + (size_t)su * 16384;
    float cr[4] = {0.f, 0.f, 0.f, 0.f};
#pragma unroll 16
    for (int d = 0; d < 128; ++d) { const float sv = s0[d * 128 + e];
#pragma unroll
        for (int r = 0; r < 4; ++r) cr[r] += qs[(ig * 4 + r) * 128 + d] * sv; }
    __syncthreads();
#pragma unroll
    for (int r = 0; r < 4; ++r) { const int i = ig * 4 + r; float o = 0.f;
        for (int j = 0; j < 16; ++j) o += Ssm[i * 16 + j] * vs[j * 128 + e];
        osm[i * 128 + e] = o + __builtin_amdgcn_exp2f(l2g * (float)(i + 1)) * cr[r]; }
    __syncthreads();
    for (int rr = 0; rr < 2; ++rr) { const int i = 2 * wid + rr; const float v0 = osm[i * 128 + lane], v1 = osm[i * 128 + 64 + lane];
        const float rstd = rsqrtf(wave_sum(v0 * v0 + v1 * v1) * (1.0f / 128.0f) + EPS);
        const size_t token = (size_t)(ts0 + i);
        const float g0 = PS[(size_t)(16 * b + i) * NIN + 1536 + 128 * h + lane], g1 = PS[(size_t)(16 * b + i) * NIN + 1536 + 128 * h + 64 + lane];
        MIX[token * DM + 128 * h + lane] = (bf16_t)(pk2(v0 * rstd * p.in[8][128 * h + lane] * silu_f(g0), 0.f) & 0xffffu);
        MIX[token * DM + 128 * h + 64 + lane] = (bf16_t)(pk2(v1 * rstd * p.in[8][128 * h + 64 + lane] * silu_f(g1), 0.f) & 0xffffu); }
    const float g16 = __builtin_amdgcn_exp2f(l2g * 16.0f);
    float* outS = p.out + O_SRS + (size_t)su * 16384;
#pragma unroll 8
    for (int dd = 0; dd < 32; ++dd) { const int d = ig + 4 * dd; float a = g16 * s0[d * 128 + e];
        for (int j = 0; j < 16; ++j) a += __builtin_amdgcn_exp2f(l2g * (float)(15 - j)) * ks[j * 128 + d] * vs[j * 128 + e];
        outS[d * 128 + e] = a; }
    const int ch = 128 * h + e; const float* cache = p.in[3]; const float* cwp = p.in[7];
    const float w0 = cwp[ch], w1 = cwp[512 + ch], w2 = cwp[1024 + ch];
#pragma unroll
    for (int tt = 0; tt < 4; ++tt) { const int t = ig * 4 + tt;
        const float c0 = ch_at(PS, cache, b, t - 2, ch), c1 = ch_at(PS, cache, b, t - 1, ch), c2 = ch_at(PS, cache, b, t, ch);
        const float y = PS[(size_t)(16 * b + t) * NIN + 2048 + ch] * (w0 * c0 + w1 * c1 + w2 * c2);
        MIX[(size_t)(ts0 + t) * DM + 512 + ch] = (bf16_t)(pk2(y, 0.f) & 0xffffu);
        if (t >= 14) p.out[O_CCS + (size_t)(b * 2 + t - 14) * 512 + ch] = c2; }
    __syncthreads();
}

template <int NB>
__device__ __forceinline__ void thin_gemm(const bf16_t* A, int lda, const bf16_t* Bt, int ldb, int n0, int nbstride, int kbeg, int klen, f32x4 (&acc)[NB], int wid, int lane) {
    const int l15 = lane & 15, l4 = lane >> 4;
    const bf16_t* ap = A + (size_t)(16 * wid + l15) * lda + kbeg + 8 * l4;
    const bf16_t* bp = Bt + (size_t)(n0 + l15) * ldb + kbeg + 8 * l4;
#pragma unroll
    for (int nb = 0; nb < NB; ++nb) acc[nb] = (f32x4){0.f, 0.f, 0.f, 0.f};
#pragma unroll 1
    for (int s0 = 0; s0 < klen; s0 += 256) {
        bf16x8 a[8], b[NB][8];
#pragma unroll
        for (int s = 0; s < 8; ++s) { a[s] = *(const bf16x8*)(ap + s0 + 32 * s);
#pragma unroll
            for (int nb = 0; nb < NB; ++nb) b[nb][s] = *(const bf16x8*)(bp + (size_t)nb * nbstride * ldb + s0 + 32 * s); }
#pragma unroll
        for (int s = 0; s < 8; ++s)
#pragma unroll
            for (int nb = 0; nb < NB; ++nb) acc[nb] = MFMA16(a[s], b[nb][s], acc[nb]);
    }
}
__device__ __forceinline__ void thin_store(const f32x4& acc, float* out, int ldo, int col, int wid, int lane) {
#pragma unroll
    for (int r = 0; r < 4; ++r) out[(size_t)(16 * wid + 4 * (lane >> 4) + r) * ldo + col + (lane & 15)] = acc[r];
}
__device__ __forceinline__ void thin_ffn1(const Params& p, int c, int wid, int lane) {
    const int pn = c >> 3, j16 = c & 7, l15 = lane & 15, l4 = lane >> 4;
    f32x4 acc[2];
    thin_gemm<2>((const bf16_t*)(p.ws + WS_RA) + (size_t)TOK_P * DM, DM, (const bf16_t*)(p.ws + WS_WFF1), DM, 256 * pn + 16 * j16, 128, 0, DM, acc, wid, lane);
    const int ch = 128 * pn + 16 * j16 + l15, b = wid;
    const float* cw = p.in[15]; const float* cache = p.in[4] + (size_t)b * 2 * DFF + ch;
    const float w0 = cw[ch], w1 = cw[DFF + ch], w2 = cw[2 * DFF + ch];
    const f32x4 up = acc[0], gt = acc[1];
    float pm1 = __shfl_up(up[3], 16), pm2 = __shfl_up(up[2], 16);
    if (l4 == 0) { pm1 = cache[DFF]; pm2 = cache[0]; }
    float uc[4];
    uc[0] = w0 * pm2 + w1 * pm1 + w2 * up[0];
    uc[1] = w0 * pm1 + w1 * up[0] + w2 * up[1];
    uc[2] = w0 * up[0] + w1 * up[1] + w2 * up[2];
    uc[3] = w0 * up[1] + w1 * up[2] + w2 * up[3];
    bf16_t* ACT = (bf16_t*)(p.ws + WS_RB);
#pragma unroll
    for (int r = 0; r < 4; ++r) ACT[(size_t)(TOK_P + 16 * wid + 4 * l4 + r) * DFF + ch] = (bf16_t)(pk2(pg8::gelu_tanh(uc[r]) * gt[r], 0.f) & 0xffffu);
    if (l4 == 3) { float* o = p.out + O_CFS + (size_t)b * 2 * DFF + ch; o[0] = up[2]; o[DFF] = up[3]; }
}

__device__ __forceinline__ void phase4(const Params& p, int wid, int lane) {
    const int gw = blockIdx.x * 8 + wid, NGW = gridDim.x * 8;
    const bf16_t* Y = (const bf16_t*)(p.ws + WS_RB); bf16_t* H2 = (bf16_t*)(p.ws + WS_RA); const float* ssq = (const float*)(p.ws + WS_SSQ1);
    const float* wpost = p.in[10]; const float* wpre = p.in[11];
    f32x4 wpo[4], wpr[4];
#pragma unroll
    for (int j = 0; j < 4; ++j) { wpo[j] = *((const f32x4*)wpost + lane + 64 * j); wpr[j] = *((const f32x4*)wpre + lane + 64 * j); }
#pragma unroll 1
    for (int base = gw; base < TOK_P; base += RB * NGW) {
        f32x4 v[RB][4]; u32x2 yw[RB][4]; float sq[RB];
#pragma unroll
        for (int k = 0; k < RB; ++k) { const int rr = min(base + k * NGW, TOK_P - 1);
            sq[k] = lane < 16 ? ssq[(size_t)rr * 16 + lane] : 0.f;
#pragma unroll
            for (int j = 0; j < 4; ++j) { v[k][j] = __builtin_nontemporal_load((const f32x4*)(p.in[0] + (size_t)rr * DM) + lane + 64 * j); yw[k][j] = __builtin_nontemporal_load((const u32x2*)(Y + (size_t)rr * DM) + lane + 64 * j); } }
        float s2[RB];
#pragma unroll
        for (int k = 0; k < RB; ++k) { const float rstd1 = rsqrtf(wave_sum(sq[k]) * (1.0f / DM) + EPS); s2[k] = 0.f;
#pragma unroll
            for (int j = 0; j < 4; ++j) { v[k][j] = v[k][j] + (unpack_bf4(yw[k][j]) * rstd1) * wpo[j]; s2[k] += sumsq4(v[k][j]); } }
#pragma unroll
        for (int k = 0; k < RB; ++k) { const int r = base + k * NGW; const float rstd2 = rsqrtf(wave_sum(s2[k]) * (1.0f / DM) + EPS);
            if (r < TOK_P) {
#pragma unroll
                for (int j = 0; j < 4; ++j) { const f32x4 y = (v[k][j] * rstd2) * wpr[j];
                    __builtin_nontemporal_store(v[k][j], (f32x4*)(p.out + (size_t)r * DM) + lane + 64 * j);
                    __builtin_nontemporal_store((u32x2){pk2(y[0], y[1]), pk2(y[2], y[3])}, (u32x2*)(H2 + (size_t)r * DM) + lane + 64 * j); } } }
    }
    for (int r = TOK_P + gw; r < TOK; r += NGW) {
        const float* xrow = p.in[1] + (size_t)(r - TOK_P) * DM; const float* ys = (const float*)(p.ws + WS_YS) + (size_t)(r - TOK_P) * DM;
        f32x4 yv[4], v[4]; float s = 0.f, s2 = 0.f;
#pragma unroll
        for (int j = 0; j < 4; ++j) { f32x4 a = *((const f32x4*)ys + lane + 64 * j);
#pragma unroll
            for (int q = 1; q < 4; ++q) a += *((const f32x4*)(ys + (size_t)q * 128 * DM) + lane + 64 * j);
            yv[j] = a; s += sumsq4(a); }
        const float rstd1 = rsqrtf(wave_sum(s) * (1.0f / DM) + EPS);
#pragma unroll
        for (int j = 0; j < 4; ++j) { v[j] = *((const f32x4*)xrow + lane + 64 * j) + (yv[j] * rstd1) * wpo[j]; s2 += sumsq4(v[j]);
            *((f32x4*)(p.out + (size_t)r * DM) + lane + 64 * j) = v[j]; }
        const float rstd2 = rsqrtf(wave_sum(s2) * (1.0f / DM) + EPS);
#pragma unroll
        for (int j = 0; j < 4; ++j) { const f32x4 y = (v[j] * rstd2) * wpr[j]; *((u32x2*)(H2 + (size_t)r * DM) + lane + 64 * j) = (u32x2){pk2(y[0], y[1]), pk2(y[2], y[3])}; }
    }
}
__device__ __forceinline__ void phase7(const Params& p, int wid, int lane) {
    const int gw = blockIdx.x * 8 + wid, NGW = gridDim.x * 8;
    const bf16_t* F = (const bf16_t*)(p.ws + WS_RA); const float* ssq = (const float*)(p.ws + WS_SSQ2); const float* wpost = p.in[12];
    f32x4 wpo[4];
#pragma unroll
    for (int j = 0; j < 4; ++j) wpo[j] = *((const f32x4*)wpost + lane + 64 * j);
#pragma unroll 1
    for (int base = gw; base < TOK_P; base += RB * NGW) {
        f32x4 v[RB][4]; u32x2 yw[RB][4]; float sq[RB];
#pragma unroll
        for (int k = 0; k < RB; ++k) { const int rr = min(base + k * NGW, TOK_P - 1);
            sq[k] = lane < 16 ? ssq[(size_t)rr * 16 + lane] : 0.f;
#pragma unroll
            for (int j = 0; j < 4; ++j) { v[k][j] = __builtin_nontemporal_load((const f32x4*)(p.out + (size_t)rr * DM) + lane + 64 * j); yw[k][j] = __builtin_nontemporal_load((const u32x2*)(F + (size_t)rr * DM) + lane + 64 * j); } }
#pragma unroll
        for (int k = 0; k < RB; ++k) { const int r = base + k * NGW; const float rstd = rsqrtf(wave_sum(sq[k]) * (1.0f / DM) + EPS);
            if (r < TOK_P) {
#pragma unroll
                for (int j = 0; j < 4; ++j) __builtin_nontemporal_store(v[k][j] + (unpack_bf4(yw[k][j]) * rstd) * wpo[j], (f32x4*)(p.out + (size_t)r * DM) + lane + 64 * j); } }
    }
    for (int r = TOK_P + gw; r < TOK; r += NGW) {
        const float* fs = (const float*)(p.ws + WS_FS) + (size_t)(r - TOK_P) * DM;
        f32x4 yv[4]; float s = 0.f;
#pragma unroll
        for (int j = 0; j < 4; ++j) { f32x4 a = *((const f32x4*)fs + lane + 64 * j);
#pragma unroll
            for (int q = 1; q < 4; ++q) a += *((const f32x4*)(fs + (size_t)q * 128 * DM) + lane + 64 * j);
            yv[j] = a; s += sumsq4(a); }
        const float rstd = rsqrtf(wave_sum(s) * (1.0f / DM) + EPS);
#pragma unroll
        for (int j = 0; j < 4; ++j) { f32x4* op = (f32x4*)(p.out + (size_t)r * DM) + lane + 64 * j; *op = *op + (yv[j] * rstd) * wpo[j]; }
    }
}


#define XB_TMO      128
#define XB_XCNT(j)  (256  + 64 * (j))
#define XB_XSUB(j)  (1280 + 64 * (j))
#define XB_XGEN(j)  (2304 + 64 * (j))
#define XB_TOP      3328
#define XB_TOPGEN   3392
#define XCD_BAR_WORDS 3456
#define XB_SPIN_CAP (1u << 18)

__device__ __forceinline__ unsigned xb_ld(unsigned* p)              { return __hip_atomic_load(p, __ATOMIC_RELAXED, __HIP_MEMORY_SCOPE_AGENT); }
__device__ __forceinline__ unsigned xb_add(unsigned* p, unsigned v) { return __hip_atomic_fetch_add(p, v, __ATOMIC_RELAXED, __HIP_MEMORY_SCOPE_AGENT); }
__device__ __forceinline__ unsigned xb_xcc_id() { return (unsigned)__builtin_amdgcn_s_getreg((3 << 11) | 20) & 0xFu; }
#define XB_SPIN(cond, bar) do { unsigned _sp = 0; while (cond) { __builtin_amdgcn_s_sleep(1); \
    if ((++_sp & 255u) == 0u) { if (xb_ld(&(bar)[XB_TMO])) break; if (_sp > XB_SPIN_CAP) { atomicAdd(&(bar)[XB_TMO], 1u); break; } } } } while (0)

struct XcdBarrier {
    unsigned* bar; unsigned x;
    volatile LAS unsigned* st;
};

__device__ __forceinline__ XcdBarrier xcd_barrier_post(unsigned* bar, volatile LAS unsigned* st) {
    XcdBarrier b; b.bar = bar; b.x = xb_xcc_id(); b.st = st;
    if (threadIdx.x == 0) (void)xb_add(&bar[XB_XCNT(b.x)], 1u);
    return b;
}
__device__ __forceinline__ void xcd_barrier_complete(unsigned* bar, unsigned x, unsigned& nloc, unsigned& nx) {
    const unsigned G = gridDim.x * gridDim.y * gridDim.z;
    unsigned sum, cnt, mine, sp = 0u;
    for (;;) {
        sum = 0u; cnt = 0u; mine = 0u;
#pragma unroll
        for (unsigned j = 0; j < 16; ++j) { const unsigned c = xb_ld(&bar[XB_XCNT(j)]); sum += c; cnt += (c > 0u) ? 1u : 0u; mine = (j == x) ? c : mine; }
        if (sum == G) break;
        __builtin_amdgcn_s_sleep(1);
        if ((++sp & 255u) == 0u) { if (xb_ld(&bar[XB_TMO])) break; if (sp > XB_SPIN_CAP) { atomicAdd(&bar[XB_TMO], 1u); break; } }
    }
    nloc = mine > 0u ? mine : 1u; nx = cnt > 0u ? cnt : 1u;
}

__device__ __forceinline__ void xcd_barrier(const XcdBarrier& b) {
    asm volatile("s_waitcnt vmcnt(0)" ::: "memory");
    __syncthreads();
    if (threadIdx.x == 0) {
        unsigned* bar = b.bar;
        __builtin_amdgcn_s_waitcnt(0);
        unsigned nloc = b.st[0], nx = b.st[1];
        if (nloc == 0u) { xcd_barrier_complete(bar, b.x, nloc, nx); b.st[0] = nloc; b.st[1] = nx; }
        const unsigned old = xb_add(&bar[XB_XSUB(b.x)], 1u);
        const unsigned gen = old / nloc;
        if (old + 1u == (gen + 1u) * nloc) {
            __builtin_amdgcn_fence(__ATOMIC_RELEASE, "agent");
            asm volatile("s_waitcnt vmcnt(0)" ::: "memory");
            const unsigned og = xb_add(&bar[XB_TOP], 1u);
            const unsigned tg = og / nx;
            if (og + 1u == (tg + 1u) * nx) xb_add(&bar[XB_TOPGEN], 1u);
            else XB_SPIN(xb_ld(&bar[XB_TOPGEN]) == tg, bar);
            __builtin_amdgcn_fence(__ATOMIC_ACQUIRE, "agent");
            xb_add(&bar[XB_XGEN(b.x)], 1u);
            asm volatile("s_waitcnt vmcnt(0)" ::: "memory");
        } else {
            XB_SPIN(xb_ld(&bar[XB_XGEN(b.x)]) == gen, bar);
            __builtin_amdgcn_fence(__ATOMIC_ACQUIRE, "agent");
            asm volatile("s_waitcnt vmcnt(0)" ::: "memory");
        }
    }
    __syncthreads();
}

#ifndef MK_LAUNCHES
#define MK_LAUNCHES 1
#endif
#ifndef REP0
#define REP0 1
#endif
#ifndef REP1
#define REP1 1
#endif
#ifndef REP2
#define REP2 1
#endif
#ifndef REP3
#define REP3 1
#endif
#ifndef REP4
#define REP4 1
#endif
#ifndef REP5
#define REP5 1
#endif
#ifndef REP6
#define REP6 1
#endif
#ifndef REP7
#define REP7 1
#endif
#define REPEAT(n) for (int rep_ = 0; rep_ < (n); ++rep_, ((rep_ < (n)) ? GRIDSYNC() : (void)0))
template <int PH_LO, int PH_HI>
__device__ __forceinline__ void run_phases(const Params& p, LAS unsigned char* lds) {
    int tid = threadIdx.x, lane = tid & 63; const int wid = __builtin_amdgcn_readfirstlane(tid >> 6);
    const int G = gridDim.x, c = blockIdx.x;
#define LAUNDER() asm volatile("" : "+v"(tid), "+v"(lane))
    XcdBarrier bar_;
    if (PH_HI - PH_LO > 1) {
        volatile LAS unsigned* stw = (volatile LAS unsigned*)(lds + LDS_BARW);
        if (threadIdx.x == 0) { stw[0] = 0u; stw[1] = 0u; }
        __syncthreads();
        bar_ = xcd_barrier_post((unsigned*)p.ws, stw);
        if (p.ws == nullptr) cg::this_grid().sync();
    }
#define GRIDSYNC() xcd_barrier(bar_)
#define SEAM(ph) do { if (PH_LO <= (ph) && (ph) + 1 < PH_HI) { GRIDSYNC(); } } while (0)
#ifdef XSYNC
    for (int xs_ = 0; xs_ < XSYNC; ++xs_) GRIDSYNC();
#endif
    if (PH_LO <= 0 && 0 < PH_HI) REPEAT(REP0) { LAUNDER(); phase0(p, lds, tid, wid, lane); }
    SEAM(0);
    if (PH_LO <= 1 && 1 < PH_HI) REPEAT(REP1) {
        for (int t = c; t < 224; t += G) { f32x4 acc[1]; thin_gemm<1>((const bf16_t*)(p.ws + WS_RA) + (size_t)TOK_P * DM, DM, (const bf16_t*)(p.ws + WS_WIN), DM, 16 * t, 0, 0, DM, acc, wid, lane);
            thin_store(acc[0], (float*)(p.ws + WS_PS), NIN, 16 * t, wid, lane); }
        pg8::Gemm g{(const bf16_t*)(p.ws + WS_RA), (const bf16_t*)(p.ws + WS_WIN), TOK_P, NIN, DM};
        pg8::StaticOrder S; S.init(TOK_P, NIN, G, c);
        pg8::EpiIn E{(bf16_t*)(p.ws + WS_RB), (const float*)(p.ws + WS_COS), (const float*)(p.ws + WS_SIN)};
        pg8::gemm_phase<pg8::EpiIn, pg8::StaticOrder, true, true>(lds, g, S, E);
    }
    SEAM(1);
    if (PH_LO <= 2 && 2 < PH_HI) REPEAT(REP2) {
        for (int u = c; u < 256; u += G) ret_unit<false>(p, lds, u, tid, wid, lane);
        LAUNDER();
        for (int su = c; su < 32; su += G) sample_unit(p, lds, su, tid, wid, lane);
    }
    SEAM(2);
    if (PH_LO <= 3 && 3 < PH_HI) REPEAT(REP3) {
        for (int u = c; u < 256; u += G) ret_unit<true>(p, lds, u, tid, wid, lane);
    }
    SEAM(3);
    if (PH_LO <= 4 && 4 < PH_HI) REPEAT(REP4) {
        for (int t = c; t < 256; t += G) { f32x4 acc[1]; const int kq = t >> 6, nt = t & 63;
            thin_gemm<1>((const bf16_t*)(p.ws + WS_RA) + (size_t)TOK_P * DM, DM, (const bf16_t*)(p.ws + WS_WOUT), DM, 16 * nt, 0, 256 * kq, 256, acc, wid, lane);
            thin_store(acc[0], (float*)(p.ws + WS_YS) + (size_t)kq * 128 * DM, DM, 16 * nt, wid, lane); }
        pg8::Gemm g{(const bf16_t*)(p.ws + WS_RA), (const bf16_t*)(p.ws + WS_WOUT), TOK_P, DM, DM};
        pg8::StaticOrder S; S.init(TOK_P, DM, G, c);
        pg8::EpiY E{(bf16_t*)(p.ws + WS_RB), (float*)(p.ws + WS_SSQ1)};
        pg8::gemm_phase<pg8::EpiY, pg8::StaticOrder, true, true>(lds, g, S, E);
    }
    SEAM(4);
    if (PH_LO <= 5 && 5 < PH_HI) REPEAT(REP5) { LAUNDER(); phase4(p, wid, lane); }
    SEAM(5);
    if (PH_LO <= 6 && 6 < PH_HI) REPEAT(REP6) {
        for (int t = c; t < 256; t += G) thin_ffn1(p, t, wid, lane);
        pg8::Gemm g{(const bf16_t*)(p.ws + WS_RA), (const bf16_t*)(p.ws + WS_WFF1), TOK_P, 2 * DFF, DM};
        pg8::WalkOrder S{G, c};
        pg8::EpiFfn E{(bf16_t*)(p.ws + WS_RB), p.in[15], p.in[4], p.out + O_CFP, p.out + O_CFS, (LAS float*)(lds + LDS_HALO)};
        pg8::gemm_phase<pg8::EpiFfn, pg8::WalkOrder, true, true>(lds, g, S, E);
    }
    SEAM(6);
    if (PH_LO <= 7 && 7 < PH_HI) REPEAT(REP7) {
        for (int t = c; t < 256; t += G) { f32x4 acc[1]; const int kq = t >> 6, nt = t & 63;
            thin_gemm<1>((const bf16_t*)(p.ws + WS_RB) + (size_t)TOK_P * DFF, DFF, (const bf16_t*)(p.ws + WS_WDN), DFF, 16 * nt, 0, 1024 * kq, 1024, acc, wid, lane);
            thin_store(acc[0], (float*)(p.ws + WS_FS) + (size_t)kq * 128 * DM, DM, 16 * nt, wid, lane); }
        pg8::Gemm g{(const bf16_t*)(p.ws + WS_RB), (const bf16_t*)(p.ws + WS_WDN), TOK_P, DM, DFF};
        pg8::StaticOrder S; S.init(TOK_P, DM, G, c);
        pg8::EpiY E{(bf16_t*)(p.ws + WS_RA), (float*)(p.ws + WS_SSQ2)};
        pg8::gemm_phase<pg8::EpiY, pg8::StaticOrder, true, true>(lds, g, S, E);
    }
    SEAM(7);
    if (PH_LO <= 8 && 8 < PH_HI) { LAUNDER(); phase7(p, wid, lane); }
#undef SEAM
}
constexpr int NPH = 9;
#if MK_LAUNCHES == 1
__global__ void __launch_bounds__(512, 2) fwd_kernel(Params p) {
    extern __shared__ __attribute__((aligned(16))) unsigned char smem[];
    run_phases<0, NPH>(p, (LAS unsigned char*)smem);
}
#else
template <int PH>
__global__ void __launch_bounds__(512, 2) fwd_phase(Params p) {
    extern __shared__ __attribute__((aligned(16))) unsigned char smem[];
    run_phases<PH, PH + 1>(p, (LAS unsigned char*)smem);
}
template <int PH> static void launch_phase(const Params& p, int grid, hipStream_t stream) {
    static bool attr = false;
    if (!attr) { (void)hipFuncSetAttribute((const void*)fwd_phase<PH>, hipFuncAttributeMaxDynamicSharedMemorySize, LDS_BYTES); attr = true; }
    hipLaunchKernelGGL(fwd_phase<PH>, dim3(grid), dim3(512), LDS_BYTES, stream, p);
}
#endif

extern "C" void kernel_launch(void* const* d_in, const int* in_sizes, int n_in, void* d_out, int out_size, void* d_ws, size_t ws_size, hipStream_t stream) {
    static int grid = 0;
    if (grid == 0) {
        if (n_in != 17 || ws_size < WS_END) { fprintf(stderr, "kernel_launch: expected 17 inputs and >= %zu bytes of workspace (got %d, %zu)\n", (size_t)WS_END, n_in, ws_size); grid = -1; return; }
        int dev = 0, cus = 0, per_cu = 0;
        (void)hipGetDevice(&dev); (void)hipDeviceGetAttribute(&cus, hipDeviceAttributeMultiprocessorCount, dev);
#if MK_LAUNCHES == 1
        if (hipFuncSetAttribute((const void*)fwd_kernel, hipFuncAttributeMaxDynamicSharedMemorySize, LDS_BYTES) != hipSuccess) { fprintf(stderr, "kernel_launch: hipFuncSetAttribute failed\n"); grid = -1; return; }
        if (hipOccupancyMaxActiveBlocksPerMultiprocessor(&per_cu, (const void*)fwd_kernel, 512, LDS_BYTES) != hipSuccess || per_cu < 1) { fprintf(stderr, "kernel_launch: occupancy query says %d\n", per_cu); per_cu = 1; }
        (void)hipGetLastError();
#endif
        grid = cus > 0 ? cus : 256;
    }
    if (grid < 0) return;
    Params p{};
    for (int i = 0; i < 17; ++i) p.in[i] = (const float*)d_in[i];
    p.out = (float*)d_out; p.ws = (unsigned char*)d_ws;
#if MK_LAUNCHES == 1
    if (hipMemsetAsync(d_ws, 0, 16384, stream) != hipSuccess) { fprintf(stderr, "kernel_launch: hipMemsetAsync failed\n"); return; }
    void* args[] = {&p};
    const hipError_t e = hipLaunchCooperativeKernel((const void*)fwd_kernel, dim3(grid), dim3(512), args, LDS_BYTES, stream);
    if (e != hipSuccess) fprintf(stderr, "kernel_launch: cooperative launch failed: %s (grid %d)\n", hipGetErrorString(e), grid);
#else
    launch_phase<0>(p, grid, stream); launch_phase<1>(p, grid, stream); launch_phase<2>(p, grid, stream); launch_phase<3>(p, grid, stream); launch_phase<4>(p, grid, stream);
    launch_phase<5>(p, grid, stream); launch_phase<6>(p, grid, stream); launch_phase<7>(p, grid, stream); launch_phase<8>(p, grid, stream);
#endif
}
```

```cpp
#include <hip/hip_runtime.h>
#include <hip/hip_cooperative_groups.h>
#include <cstdio>
#include <cstdint>
namespace cg = cooperative_groups;
namespace pg8 {
#define PG8_LAS __attribute__((address_space(3)))
typedef unsigned short bf16_t;
typedef short bf16x8 __attribute__((ext_vector_type(8)));
typedef float f32x4 __attribute__((ext_vector_type(4)));
typedef unsigned u32x4 __attribute__((ext_vector_type(4)));
constexpr int BM = 256, BK = 64, HALF = 128, HTB = HALF * BK * 2  , STAGE_BYTES = 8 * HTB, NXCD = 8, WGM = 8;

__host__ __device__ __forceinline__ int lds_byte(int r, int c) { const int st = (r >> 4) * 2 + (c >> 5), rr = r & 15, cc = c & 31, ob = rr * 64 + cc * 2; return st * 1024 + (ob ^ (((ob >> 9) & 1) << 5)); }
__host__ __device__ __forceinline__ void stage_rc(int b, int& R, int& C) { const int st = b / 1024, sb = b % 1024, swz = sb ^ (((sb >> 9) & 1) << 5); R = (st >> 1) * 16 + swz / 64; C = (st & 1) * 32 + (swz % 64) / 2; }
__host__ __device__ __forceinline__ int perm32(int rho) { const int n = rho >> 4, i = rho & 15; return 8 * (i >> 2) + 4 * n + (i & 3); }

struct Unit { int pm, pn; };
struct Gemm { const bf16_t* A; const bf16_t* Bt; int M, N, K; };

struct StaticOrder {
    int nM, nN, nwg, G, c;
    __host__ __device__ void init(int M, int N, int G_, int c_) { nM = M / BM; nN = N / BM; nwg = nM * nN; G = G_; c = c_; }
    __host__ __device__ bool next(int i, Unit& u) const {
        const long L = (long)i * G + c; if (L >= nwg) return false;
        int wgid = (int)L; { const int q = nwg / NXCD, r = nwg % NXCD, xcd = wgid % NXCD, off = wgid / NXCD; wgid = (xcd < r ? xcd * (q + 1) : r * (q + 1) + (xcd - r) * q) + off; }
        const int nig = WGM * nN, gid = wgid / nig, fm = gid * WGM, gsz = (nM - fm) < WGM ? (nM - fm) : WGM;
        u.pm = fm + ((wgid % nig) % gsz); u.pn = (wgid % nig) / gsz; return true;
    }
    __device__ __forceinline__ void a_ready(const Unit&) const {}
    __device__ __forceinline__ void done(const Unit&) const {}
};
__device__ __forceinline__ unsigned cvt_pk_bf16(float lo, float hi) { unsigned r; asm volatile("v_cvt_pk_bf16_f32 %0, %1, %2" : "=v"(r) : "v"(lo), "v"(hi)); return r; }
__device__ __forceinline__ float dpp_shr1(float v) { return __builtin_bit_cast(float, __builtin_amdgcn_update_dpp(0, __builtin_bit_cast(int, v), 0x111, 0xf, 0xf, true)); }
__device__ __forceinline__ float dpp_shr2(float v) { return __builtin_bit_cast(float, __builtin_amdgcn_update_dpp(0, __builtin_bit_cast(int, v), 0x112, 0xf, 0xf, true)); }
__device__ __forceinline__ float dpp_shl15(float v) { return __builtin_bit_cast(float, __builtin_amdgcn_update_dpp(0, __builtin_bit_cast(int, v), 0x10F, 0xf, 0xf, true)); }
__device__ __forceinline__ float dpp_shl14(float v) { return __builtin_bit_cast(float, __builtin_amdgcn_update_dpp(0, __builtin_bit_cast(int, v), 0x10E, 0xf, 0xf, true)); }
__device__ __forceinline__ float gelu_tanh(float x) {
    const float z = 0.7978845608028654f * (x + 0.044715f * x * x * x);
    const float e = __builtin_amdgcn_exp2f(-2.8853900817779268f * z);
    return x * __builtin_amdgcn_rcpf(1.0f + e);
}
constexpr int TOKP = 32768;

struct EpiIn {
    static constexpr bool PERM = true, AFTER_DRAIN = false;
    bf16_t* P; const float* cosT; const float* sinT;
    __device__ __forceinline__ void operator()(const f32x4 (&acc)[2][2][4][2], const Unit& u, int wr, int wc, int fr, int fq) const {
        asm volatile("" : "+v"(fr), "+v"(fq));
        const int row0 = u.pm * BM + wr * 64 + fr, col0 = u.pn * BM + wc * 32 + 8 * fq;
        if (u.pn < 4) {
            const float sc = (u.pn >= 2) ? 0.08838834764831845f : 1.0f;
            const int f0 = 16 * wc + 4 * fq;
#pragma unroll
            for (int ai = 0; ai < 2; ++ai)
#pragma unroll
                for (int m = 0; m < 4; ++m) {
                    const int r = row0 + ai * HALF + m * 16;
                    const int pos = r < TOKP ? (r & 4095) : 4096 + ((r - TOKP) & 15);
                    const f32x4 c4 = *(const f32x4*)(cosT + pos * 64 + f0), s4 = *(const f32x4*)(sinT + pos * 64 + f0);
                    bf16_t* rowp = P + (size_t)r * 3584 + col0;
#pragma unroll
                    for (int bj = 0; bj < 2; ++bj) {
                        const f32x4 x1 = acc[ai][bj][m][0], x2 = acc[ai][bj][m][1];
                        const f32x4 o1 = (x1 * c4 - x2 * s4) * sc, o2 = (x2 * c4 + x1 * s4) * sc;
                        u32x4 w; w.x = cvt_pk_bf16(o1[0], o1[1]); w.y = cvt_pk_bf16(o1[2], o1[3]); w.z = cvt_pk_bf16(o2[0], o2[1]); w.w = cvt_pk_bf16(o2[2], o2[3]);
                        *(u32x4*)(rowp + bj * HALF) = w;
                    }
                }
        } else {
#pragma unroll
            for (int ai = 0; ai < 2; ++ai)
#pragma unroll
                for (int m = 0; m < 4; ++m) {
                    bf16_t* rowp = P + (size_t)(row0 + ai * HALF + m * 16) * 3584 + col0;
#pragma unroll
                    for (int bj = 0; bj < 2; ++bj) {
                        const f32x4 v0 = acc[ai][bj][m][0], v1 = acc[ai][bj][m][1];
                        u32x4 w; w.x = cvt_pk_bf16(v0[0], v0[1]); w.y = cvt_pk_bf16(v0[2], v0[3]); w.z = cvt_pk_bf16(v1[0], v1[1]); w.w = cvt_pk_bf16(v1[2], v1[3]);
                        *(u32x4*)(rowp + bj * HALF) = w;
                    }
                }
        }
    }
};

struct EpiY {
    static constexpr bool PERM = true, AFTER_DRAIN = false;
    bf16_t* Y; float* ssq;
    __device__ __forceinline__ void operator()(const f32x4 (&acc)[2][2][4][2], const Unit& u, int wr, int wc, int fr, int fq) const {
        asm volatile("" : "+v"(fr), "+v"(fq));
        const int row0 = u.pm * BM + wr * 64 + fr, col0 = u.pn * BM + wc * 32 + 8 * fq;
#pragma unroll
        for (int ai = 0; ai < 2; ++ai)
#pragma unroll
            for (int m = 0; m < 4; ++m) {
                const int r = row0 + ai * HALF + m * 16;
                bf16_t* rowp = Y + (size_t)r * 1024 + col0;
                float s = 0.f;
#pragma unroll
                for (int bj = 0; bj < 2; ++bj) {
                    const f32x4 v0 = acc[ai][bj][m][0], v1 = acc[ai][bj][m][1];
                    s += (v0[0] * v0[0] + v0[1] * v0[1]) + (v0[2] * v0[2] + v0[3] * v0[3]) + (v1[0] * v1[0] + v1[1] * v1[1]) + (v1[2] * v1[2] + v1[3] * v1[3]);
                    u32x4 w; w.x = cvt_pk_bf16(v0[0], v0[1]); w.y = cvt_pk_bf16(v0[2], v0[3]); w.z = cvt_pk_bf16(v1[0], v1[1]); w.w = cvt_pk_bf16(v1[2], v1[3]);
                    *(u32x4*)(rowp + bj * HALF) = w;
                }
                s += __shfl_xor(s, 16); s += __shfl_xor(s, 32);
                if (fq == 0) ssq[(size_t)r * 16 + u.pn * 4 + wc] = s;
            }
    }
};

struct EpiFfn {
    static constexpr bool PERM = true, AFTER_DRAIN = false;
    bf16_t* ACT; const float* cw; const float* cache; float* outp; float* outs; PG8_LAS float* halo;
    __device__ __forceinline__ void operator()(const f32x4 (&acc)[2][2][4][2], const Unit& u, int wr, int wc, int fr, int fq) const {
        asm volatile("" : "+v"(fr), "+v"(fq));
        const int lc0 = wc * 32 + 8 * fq, ch0 = u.pn * 128 + lc0;
        const bool sample = false;
        const int par = u.pm & 1;
        f32x4 w0[2], w1[2], w2[2];
#pragma unroll
        for (int n = 0; n < 2; ++n) { w0[n] = *(const f32x4*)(cw + ch0 + 4 * n); w1[n] = *(const f32x4*)(cw + 4096 + ch0 + 4 * n); w2[n] = *(const f32x4*)(cw + 8192 + ch0 + 4 * n); }
        if (!sample && fr >= 14) {
#pragma unroll
            for (int ai = 0; ai < 2; ++ai) { PG8_LAS float* hp = halo + ((par * 4 + 2 * ai + wr) * 2 + (fr - 14)) * 128 + lc0;
                *(PG8_LAS f32x4*)hp = acc[ai][0][3][0]; *(PG8_LAS f32x4*)(hp + 4) = acc[ai][0][3][1]; }
        }
        asm volatile("s_waitcnt lgkmcnt(0)" ::: "memory"); __builtin_amdgcn_s_barrier(); asm volatile("" ::: "memory");
#pragma unroll
        for (int ai = 0; ai < 2; ++ai) {
            const int blk = 2 * ai + wr;
#pragma unroll
            for (int m = 0; m < 4; ++m) {
                f32x4 pv[2]; pv[0] = (f32x4){0.f, 0.f, 0.f, 0.f}; pv[1] = pv[0];
                const int sb = 8 * ai + 4 * wr + m;
                if (sample) {
                    if (fr >= 14 && sb < 8) { const float* cp = cache + (size_t)(sb * 2 + fr - 14) * 4096 + ch0; pv[0] = *(const f32x4*)cp; pv[1] = *(const f32x4*)(cp + 4); }
                } else if (m == 0) {
                    if (fr >= 14) {
                        const bool zero = (blk == 0) && ((u.pm & 15) == 0);
                        const int hb = (blk == 0) ? ((par ^ 1) * 4 + 3) : (par * 4 + blk - 1);
                        if (!zero) { const PG8_LAS float* hp = halo + (hb * 2 + fr - 14) * 128 + lc0; pv[0] = *(const PG8_LAS f32x4*)hp; pv[1] = *(const PG8_LAS f32x4*)(hp + 4); }
                    }
                } else { pv[0] = acc[ai][0][m - 1][0]; pv[1] = acc[ai][0][m - 1][1]; }
                const int r = u.pm * BM + ai * HALF + wr * 64 + m * 16 + fr;
                float a8[8];
#pragma unroll
                for (int n = 0; n < 2; ++n)
#pragma unroll
                    for (int e = 0; e < 4; ++e) {
                        const float cur = acc[ai][0][m][n][e], pr = pv[n][e];
                        const float p1 = dpp_shr1(cur) + dpp_shl15(pr), p2 = dpp_shr2(cur) + dpp_shl14(pr);
                        const float uc = w0[n][e] * p2 + w1[n][e] * p1 + w2[n][e] * cur;
                        a8[4 * n + e] = gelu_tanh(uc) * acc[ai][1][m][n][e];
                    }
                u32x4 w; w.x = cvt_pk_bf16(a8[0], a8[1]); w.y = cvt_pk_bf16(a8[2], a8[3]); w.z = cvt_pk_bf16(a8[4], a8[5]); w.w = cvt_pk_bf16(a8[6], a8[7]);
                *(u32x4*)(ACT + (size_t)r * 4096 + ch0) = w;
                if (sample) {
                    if (fr >= 14 && sb < 8) { float* op = outs + (size_t)(sb * 2 + fr - 14) * 4096 + ch0; *(f32x4*)op = acc[ai][0][m][0]; *(f32x4*)(op + 4) = acc[ai][0][m][1]; }
                } else if (m == 3 && blk == 3 && (u.pm & 15) == 15 && fr >= 14) {
                    float* op = outp + (size_t)((u.pm >> 4) * 2 + fr - 14) * 4096 + ch0; *(f32x4*)op = acc[ai][0][m][0]; *(f32x4*)(op + 4) = acc[ai][0][m][1];
                }
            }
        }
    }
};
struct WalkOrder {
    int G, c;
    __device__ __forceinline__ bool next(int i, Unit& u) const {
        int w = c, rem = i;
        while (w < 256) { const int len = 16;
            if (rem < len) { if (w < 256) { u.pm = (w >> 5) * 16 + rem; u.pn = w & 31; } else { u.pm = 128; u.pn = w - 256; } return true; }
            rem -= len; w += G; }
        return false;
    }
    __device__ __forceinline__ void a_ready(const Unit&) const {}
    __device__ __forceinline__ void done(const Unit&) const {}
};
template <class Epi, class Sched, bool ALIGN_EPI = false, bool SP2 = false>
__device__ __forceinline__ void gemm_phase(PG8_LAS unsigned char* lds, const Gemm g, const Sched& S, const Epi& E) {
    int tid_raw = threadIdx.x; asm volatile("" : "+v"(tid_raw));
    const int tid = tid_raw, wid = __builtin_amdgcn_readfirstlane(tid >> 6), lane = tid & 63, wr = wid >> 2, wc = wid & 3, fr = lane & 15, fq = lane >> 4;
    const int K = g.K, nt = K / BK;
    unsigned voffA[2], voffB[2];
#pragma unroll
    for (int i = 0; i < 2; ++i) { int R, C; stage_rc(tid * 16 + i * 8192, R, C); const int Rb = Epi::PERM ? ((R & ~31) + perm32(R & 31)) : R;
        voffA[i] = (unsigned)(R * K + C) * 2u; voffB[i] = (unsigned)(Rb * K + C) * 2u; }
    const size_t kstep = (size_t)(BK * 2);
    const size_t hstep = (size_t)HALF * K * 2;
    const size_t tstep = 2 * hstep;
    const unsigned ldsw = (unsigned)wid * 1024u;
    const int aoff = lds_byte(wr * 64 + fr, fq * 8), boff = lds_byte(wc * 32 + fr, fq * 8);
#define PG8_SA(b, h) (((b) * 2 + (h)) * HTB)
#define PG8_SB(b, h) ((4 + (b) * 2 + (h)) * HTB)
#define PG8_STAGE(bufoff, gbase, voff) do { _Pragma("unroll") for (int _i = 0; _i < 2; ++_i) \
        __builtin_amdgcn_global_load_lds((const unsigned*)((const char*)(gbase) + (voff)[_i]), (PG8_LAS unsigned*)(lds + (bufoff) + ldsw + _i * 8192), 16, 0, 0); } while (0)
#define PG8_LDA(dst, b, h) do { _Pragma("unroll") for (int m = 0; m < 4; ++m) _Pragma("unroll") for (int k = 0; k < 2; ++k) dst[m][k] = *(const PG8_LAS bf16x8*)(lds + PG8_SA(b, h) + aoff + m * 2048 + k * 1024); } while (0)
#define PG8_LDB(dst, b, h) do { _Pragma("unroll") for (int n = 0; n < 2; ++n) _Pragma("unroll") for (int k = 0; k < 2; ++k) dst[n][k] = *(const PG8_LAS bf16x8*)(lds + PG8_SB(b, h) + boff + n * 2048 + k * 1024); } while (0)
#define PG8_MMA(ai, bj, At, Bt) do { __builtin_amdgcn_s_setprio(1); _Pragma("unroll") for (int m = 0; m < 4; ++m) _Pragma("unroll") for (int n = 0; n < 2; ++n) _Pragma("unroll") for (int k = 0; k < 2; ++k) \
        acc[ai][bj][m][n] = __builtin_amdgcn_mfma_f32_16x16x32_bf16(Bt[n][k], At[m][k], acc[ai][bj][m][n], 0, 0, 0); __builtin_amdgcn_s_setprio(0); } while (0)
#define PG8_WAIT_V(n) asm volatile("s_waitcnt vmcnt(" #n ")" ::: "memory")
#define PG8_WAIT_L(n) asm volatile("s_waitcnt lgkmcnt(" #n ")" ::: "memory")
#define PG8_BAR __builtin_amdgcn_s_barrier()
#define PG8_SCHED __builtin_amdgcn_sched_barrier(0)
    Unit cur, nxt; int ui = 0;
    if (!S.next(0, cur)) return;
    f32x4 acc[2][2][4][2];
#pragma unroll
    for (int a = 0; a < 2; ++a)
#pragma unroll
        for (int b = 0; b < 2; ++b)
#pragma unroll
            for (int m = 0; m < 4; ++m)
#pragma unroll
                for (int n = 0; n < 2; ++n) acc[a][b][m][n] = (f32x4){0.f, 0.f, 0.f, 0.f};
    bf16x8 At[4][2], B0[2][2], B1[2][2];
    const char* cA = (const char*)g.A + (size_t)cur.pm * tstep; const char* cB = (const char*)g.Bt + (size_t)cur.pn * tstep;
    S.a_ready(cur);
    if constexpr (SP2) {
        PG8_STAGE(PG8_SB(0, 0), cB, voffB); PG8_STAGE(PG8_SB(0, 1), cB + hstep, voffB); PG8_STAGE(PG8_SA(0, 0), cA, voffA); PG8_STAGE(PG8_SA(0, 1), cA + hstep, voffA);
        if (wr == 1) PG8_BAR;
        PG8_WAIT_V(2); PG8_BAR;
        PG8_STAGE(PG8_SB(1, 0), cB + kstep, voffB); PG8_STAGE(PG8_SA(1, 0), cA + kstep, voffA); PG8_STAGE(PG8_SB(1, 1), cB + hstep + kstep, voffB);
        PG8_WAIT_V(6); PG8_BAR;
    } else {
        PG8_STAGE(PG8_SB(0, 0), cB, voffB); PG8_STAGE(PG8_SA(0, 0), cA, voffA); PG8_STAGE(PG8_SB(0, 1), cB + hstep, voffB); PG8_STAGE(PG8_SA(0, 1), cA + hstep, voffA);
        if (wr == 1) PG8_BAR;
        PG8_WAIT_V(4); PG8_BAR;
        PG8_STAGE(PG8_SB(1, 0), cB + kstep, voffB); PG8_STAGE(PG8_SA(1, 0), cA + kstep, voffA); PG8_STAGE(PG8_SB(1, 1), cB + hstep + kstep, voffB);
        PG8_WAIT_V(6); PG8_BAR;
    }
    for (;;) {
        const bool has_next = S.next(ui + 1, nxt);
        const char* nA = has_next ? (const char*)g.A + (size_t)nxt.pm * tstep : cA; const char* nB = has_next ? (const char*)g.Bt + (size_t)nxt.pn * tstep : cB;
        for (int t = 0; t < nt; t += 2) {
            const bool last = (t == nt - 2);
            const char* a1 = cA + (size_t)(t + 1) * kstep;
            const char* a2 = last ? nA : cA + (size_t)(t + 2) * kstep; const char* b2 = last ? nB : cB + (size_t)(t + 2) * kstep;
            const char* a3 = a2 + kstep; const char* b3 = b2 + kstep;
            if (last && has_next) S.a_ready(nxt);
            if constexpr (SP2) {
            PG8_LDB(B0, 0, 0); PG8_LDB(B1, 0, 1); PG8_SCHED; PG8_LDA(At, 0, 0); PG8_STAGE(PG8_SA(1, 1), a1 + hstep, voffA);
            PG8_WAIT_V(8); PG8_WAIT_L(0); PG8_BAR; PG8_MMA(0, 0, At, B0); PG8_MMA(0, 1, At, B1); PG8_BAR; PG8_SCHED;
            PG8_LDA(At, 0, 1); PG8_STAGE(PG8_SB(0, 0), b2, voffB); PG8_STAGE(PG8_SB(0, 1), b2 + hstep, voffB); PG8_STAGE(PG8_SA(0, 0), a2, voffA);
            PG8_WAIT_V(8); PG8_WAIT_L(0); PG8_BAR; PG8_MMA(1, 0, At, B0); PG8_MMA(1, 1, At, B1); PG8_BAR; PG8_SCHED;
            PG8_LDB(B0, 1, 0); PG8_LDB(B1, 1, 1); PG8_SCHED; PG8_LDA(At, 1, 0); PG8_STAGE(PG8_SA(0, 1), a2 + hstep, voffA);
            PG8_WAIT_V(8); PG8_WAIT_L(0); PG8_BAR; PG8_MMA(0, 0, At, B0); PG8_MMA(0, 1, At, B1); PG8_BAR; PG8_SCHED;
            PG8_LDA(At, 1, 1); PG8_STAGE(PG8_SB(1, 0), b3, voffB); PG8_STAGE(PG8_SB(1, 1), b3 + hstep, voffB); PG8_STAGE(PG8_SA(1, 0), a3, voffA);
            PG8_WAIT_V(8); PG8_WAIT_L(0); PG8_BAR; PG8_MMA(1, 0, At, B0); PG8_MMA(1, 1, At, B1); PG8_BAR; PG8_SCHED;
            } else {
            PG8_LDB(B0, 0, 0); PG8_SCHED; PG8_LDA(At, 0, 0); PG8_STAGE(PG8_SA(1, 1), a1 + hstep, voffA);
            PG8_WAIT_L(8); PG8_BAR; PG8_WAIT_L(0); PG8_MMA(0, 0, At, B0); PG8_BAR; PG8_SCHED;
            PG8_LDB(B1, 0, 1); PG8_STAGE(PG8_SB(0, 0), b2, voffB);
            PG8_BAR; PG8_WAIT_L(0); PG8_MMA(0, 1, At, B1); PG8_BAR;
            PG8_LDA(At, 0, 1); PG8_STAGE(PG8_SA(0, 0), a2, voffA);
            PG8_BAR; PG8_WAIT_L(0); PG8_MMA(1, 0, At, B0); PG8_BAR; PG8_SCHED;
            PG8_STAGE(PG8_SB(0, 1), b2 + hstep, voffB);
            PG8_WAIT_V(6); PG8_BAR; PG8_MMA(1, 1, At, B1); PG8_BAR;
            PG8_LDB(B0, 1, 0); PG8_SCHED; PG8_LDA(At, 1, 0); PG8_STAGE(PG8_SA(0, 1), a2 + hstep, voffA);
            PG8_WAIT_L(8); PG8_BAR; PG8_WAIT_L(0); PG8_MMA(0, 0, At, B0); PG8_BAR; PG8_SCHED;
            PG8_LDB(B1, 1, 1); PG8_STAGE(PG8_SB(1, 0), b3, voffB);
            PG8_BAR; PG8_WAIT_L(0); PG8_MMA(0, 1, At, B1); PG8_BAR;
            PG8_LDA(At, 1, 1); PG8_STAGE(PG8_SA(1, 0), a3, voffA);
            PG8_BAR; PG8_WAIT_L(0); PG8_MMA(1, 0, At, B0); PG8_BAR; PG8_SCHED;
            PG8_STAGE(PG8_SB(1, 1), b3 + hstep, voffB);
            PG8_WAIT_V(6); PG8_BAR; PG8_MMA(1, 1, At, B1); PG8_BAR;
            }
        }
        if constexpr (ALIGN_EPI) { if (wr == 0) PG8_BAR; }
        if constexpr (!Epi::AFTER_DRAIN) { E(acc, cur, wr, wc, fr, fq); S.done(cur); }
        if (!has_next) break;
#pragma unroll
        for (int a = 0; a < 2; ++a)
#pragma unroll
            for (int b = 0; b < 2; ++b)
#pragma unroll
                for (int m = 0; m < 4; ++m)
#pragma unroll
                    for (int n = 0; n < 2; ++n) acc[a][b][m][n] = (f32x4){0.f, 0.f, 0.f, 0.f};
        cur = nxt; cA = nA; cB = nB; ++ui;
        if constexpr (ALIGN_EPI) { if (wr == 1) PG8_BAR; }
    }
    PG8_WAIT_V(0);
    if constexpr (!ALIGN_EPI) { if (wr == 0) PG8_BAR; }
    PG8_BAR;
    if constexpr (Epi::AFTER_DRAIN) { E.fused(acc, cur, wr, wc, fr, fq, lds, wid, lane); S.done(cur); }
#undef PG8_SA
#undef PG8_SB
#undef PG8_STAGE
#undef PG8_LDA
#undef PG8_LDB
#undef PG8_MMA
#undef PG8_WAIT_V
#undef PG8_WAIT_L
#undef PG8_BAR
#undef PG8_SCHED
}
}

using pg8::bf16_t; using pg8::bf16x8; using pg8::f32x4; using pg8::u32x4;
#define LAS __attribute__((address_space(3)))
typedef unsigned u32x2 __attribute__((ext_vector_type(2)));
constexpr int DM = 1024, NIN = 3584, DFF = 4096;
constexpr int TOK_P = 32768, TOK = 32896, TOKPAD = 33024;
constexpr float EPS = 1e-6f;
constexpr size_t WS_WIN = 16384;
constexpr size_t WS_WOUT = WS_WIN + (size_t)NIN * DM * 2;
constexpr size_t WS_WFF1 = WS_WOUT + (size_t)DM * DM * 2;
constexpr size_t WS_WDN = WS_WFF1 + (size_t)2 * DFF * DM * 2;
constexpr size_t WS_COS = WS_WDN + (size_t)DM * DFF * 2;
constexpr size_t WS_SIN = WS_COS + (size_t)4112 * 64 * 4;
constexpr size_t WS_SSQ1 = WS_SIN + (size_t)4112 * 64 * 4;
constexpr size_t WS_SSQ2 = WS_SSQ1 + (size_t)TOKPAD * 16 * 4;
constexpr size_t WS_UG = WS_SSQ2 + (size_t)TOKPAD * 16 * 4;
constexpr size_t WS_PS = WS_UG + (size_t)256 * 65536;
constexpr size_t WS_YS = WS_PS + (size_t)128 * NIN * 4;
constexpr size_t WS_FS = WS_YS + (size_t)4 * 128 * DM * 4;
constexpr size_t WS_RA = WS_FS + (size_t)4 * 128 * DM * 4;
constexpr size_t WS_RB = WS_RA + (size_t)TOKPAD * DM * 2;
constexpr size_t WS_Y = WS_RB + (size_t)TOKPAD * DFF * 2;
constexpr size_t WS_END = WS_Y + (size_t)TOK_P * DM * 2;
constexpr size_t O_SRP = (size_t)TOK * DM, O_CCP = O_SRP + 524288, O_CFP = O_CCP + 8192, O_SRS = O_CFP + 65536, O_CCS = O_SRS + 524288, O_CFS = O_CCS + 8192;
constexpr int LDS_HALO = 131072, LDS_BARW = 131072 + 8192, LDS_BYTES = LDS_BARW + 16;

struct Params { const float* in[17]; float* out; unsigned char* ws; };

__device__ __forceinline__ float dppf(float v, const int ctrl_sel) {
    const int iv = __builtin_bit_cast(int, v); int r;
    switch (ctrl_sel) { case 1: r = __builtin_amdgcn_update_dpp(0, iv, 0x111, 0xf, 0xf, true); break; case 2: r = __builtin_amdgcn_update_dpp(0, iv, 0x112, 0xf, 0xf, true); break;
        case 4: r = __builtin_amdgcn_update_dpp(0, iv, 0x114, 0xf, 0xf, true); break; case 8: r = __builtin_amdgcn_update_dpp(0, iv, 0x118, 0xf, 0xf, true); break;
        case 15: r = __builtin_amdgcn_update_dpp(0, iv, 0x142, 0xa, 0xf, false); break; default: r = __builtin_amdgcn_update_dpp(0, iv, 0x143, 0xc, 0xf, false); break; }
    return __builtin_bit_cast(float, r);
}
__device__ __forceinline__ float wave_sum(float v) {
    v += dppf(v, 1); v += dppf(v, 2); v += dppf(v, 4); v += dppf(v, 8); v += dppf(v, 15); v += dppf(v, 31);
    return __builtin_bit_cast(float, __builtin_amdgcn_readlane(__builtin_bit_cast(int, v), 63));
}
__device__ __forceinline__ float bf2f(unsigned short b) { return __uint_as_float(((unsigned)b) << 16); }
__device__ __forceinline__ unsigned pk2(float a, float b) { return pg8::cvt_pk_bf16(a, b); }
__device__ __forceinline__ unsigned pk2s(float a, float b) { unsigned r; asm("v_cvt_pk_bf16_f32 %0, %1, %2" : "=v"(r) : "v"(a), "v"(b)); return r; }
__device__ __forceinline__ float silu_f(float g) { return g * __builtin_amdgcn_rcpf(1.0f + __builtin_amdgcn_exp2f(-1.4426950408889634f * g)); }
__device__ __forceinline__ int dmap(int P) { return ((P >> 2) & 1) * 64 + (P >> 3) * 4 + (P & 3); }
__device__ __forceinline__ int pmap(int d) { return ((d >> 4) & 3) * 32 + ((d >> 2) & 3) * 8 + ((d >> 6) & 1) * 4 + (d & 3); }

constexpr int RB = 4;
__device__ __forceinline__ f32x4 unpack_bf4(const u32x2 w) { f32x4 v; v[0] = __uint_as_float(w.x << 16); v[1] = __uint_as_float(w.x & 0xffff0000u); v[2] = __uint_as_float(w.y << 16); v[3] = __uint_as_float(w.y & 0xffff0000u); return v; }
__device__ __forceinline__ float sumsq4(const f32x4 a) { return (a[0] * a[0] + a[1] * a[1]) + (a[2] * a[2] + a[3] * a[3]); }
template <int MODE> __device__ __forceinline__ int rowmap(int c) {
    if (MODE == 0) { if (c < 1024) return (c & ~127) + pmap(c & 127); return c; }
    if (MODE == 1) return c;
    if (MODE == 2) return ((c >> 7) << 8) + (c & 127);
    return ((c >> 7) << 8) + 128 + (c & 127);
}
template <int MODE>
__device__ __forceinline__ void transpose_item(const float* W, int K, int N, bf16_t* WT, LAS float* scr, int item, int lane) {
    const int nblk = N / 32, kb = item / nblk, nb = item % nblk, k0 = 64 * kb, n0 = 32 * nb;
#pragma unroll
    for (int i = 0; i < 32; ++i) { const int kk = 2 * i + (lane >> 5); scr[kk * 33 + (lane & 31)] = W[(size_t)(k0 + kk) * N + n0 + (lane & 31)]; }
    asm volatile("s_waitcnt lgkmcnt(0)" ::: "memory");
    const int c = lane & 7;
#pragma unroll
    for (int j = 0; j < 4; ++j) { const int n = (lane >> 3) + 8 * j; const LAS float* s = scr + (8 * c) * 33 + n;
        u32x4 o; o.x = pk2(s[0 * 33], s[1 * 33]); o.y = pk2(s[2 * 33], s[3 * 33]); o.z = pk2(s[4 * 33], s[5 * 33]); o.w = pk2(s[6 * 33], s[7 * 33]);
        *(u32x4*)(WT + (size_t)rowmap<MODE>(n0 + n) * K + k0 + 8 * c) = o; }
    asm volatile("s_waitcnt lgkmcnt(0)" ::: "memory");
}
__device__ __forceinline__ void phase0(const Params& p, LAS unsigned char* lds, int tid, int wid, int lane) {
    LAS float* scr = (LAS float*)(lds + wid * 8448);
    const int gw = blockIdx.x * 8 + wid, NGW = gridDim.x * 8;
    bf16_t* win = (bf16_t*)(p.ws + WS_WIN); bf16_t* wout = (bf16_t*)(p.ws + WS_WOUT); bf16_t* wff1 = (bf16_t*)(p.ws + WS_WFF1); bf16_t* wdn = (bf16_t*)(p.ws + WS_WDN);
    constexpr int I_IN = 16 * 112, I_OUT = 16 * 32, I_UP = 16 * 128, I_DN = 64 * 32, NITEMS = I_IN + I_OUT + 2 * I_UP + I_DN;
    for (int it = gw; it < NITEMS; it += NGW) {
        int r = it;
        if (r < I_IN) { transpose_item<0>(p.in[5], DM, NIN, win, scr, r, lane); continue; } r -= I_IN;
        if (r < I_OUT) { transpose_item<1>(p.in[6], DM, DM, wout, scr, r, lane); continue; } r -= I_OUT;
        if (r < I_UP) { transpose_item<2>(p.in[13], DM, DFF, wff1, scr, r, lane); continue; } r -= I_UP;
        if (r < I_UP) { transpose_item<3>(p.in[14], DM, DFF, wff1, scr, r, lane); continue; } r -= I_UP;
        transpose_item<1>(p.in[16], DFF, DM, wdn, scr, r, lane);
    }
    float* cosT = (float*)(p.ws + WS_COS); float* sinT = (float*)(p.ws + WS_SIN);
    for (int idx = blockIdx.x * 512 + tid; idx < 4112 * 64; idx += gridDim.x * 512) {
        const int pos = idx >> 6, f = idx & 63;
        const float inv = exp2f(-(float)(2 * f) * (1.0f / 128.0f) * 13.287712379549449f);
        const float ang = (float)pos * inv;
        const double rev = (double)ang * 0.15915494309189535;
        const float fr = (float)(rev - floor(rev));
        cosT[idx] = __builtin_amdgcn_cosf(fr); sinT[idx] = __builtin_amdgcn_sinf(fr);
    }
    bf16_t* H = (bf16_t*)(p.ws + WS_RA);
    const float* wpre = p.in[9];
    f32x4 wpr[4];
#pragma unroll
    for (int j = 0; j < 4; ++j) wpr[j] = *((const f32x4*)wpre + lane + 64 * j);
#pragma unroll 1
    for (int base = gw; base < TOK; base += RB * NGW) {
        f32x4 v[RB][4]; float s[RB];
#pragma unroll
        for (int k = 0; k < RB; ++k) { const int rr = min(base + k * NGW, TOK - 1);
            const float* xrow = rr < TOK_P ? p.in[0] + (size_t)rr * DM : p.in[1] + (size_t)(rr - TOK_P) * DM; s[k] = 0.f;
#pragma unroll
            for (int j = 0; j < 4; ++j) { v[k][j] = __builtin_nontemporal_load((const f32x4*)xrow + lane + 64 * j); s[k] += sumsq4(v[k][j]); } }
#pragma unroll
        for (int k = 0; k < RB; ++k) { const int r = base + k * NGW; const float rstd = rsqrtf(wave_sum(s[k]) * (1.0f / DM) + EPS);
            if (r < TOK) {
#pragma unroll
                for (int j = 0; j < 4; ++j) { const f32x4 y = (v[k][j] * rstd) * wpr[j];
                    __builtin_nontemporal_store((u32x2){pk2(y[0], y[1]), pk2(y[2], y[3])}, (u32x2*)(H + (size_t)r * DM) + lane + 64 * j); } } }
    }
}

constexpr int QI_OFF = 0, KI_OFF = 17408, KT_OFF = 34816, VT_OFF = 53248, SI_OFF = 71680, ST_OFF = 80896, GI_OFF = 115712;
#define MFMA16(a, b, c) __builtin_amdgcn_mfma_f32_16x16x32_bf16((a), (b), (c), 0, 0, 0)
#define RET_ISSUE(S, nn) do { _Pragma("unroll") for (int i_ = 0; i_ < 2; ++i_) { \
        const bf16_t* rowp_ = P + (tok0 + (size_t)(nn) * 64 + 2 * (tid >> 4) + i_) * NIN + 128 * h + (tid & 15) * 8; \
        if (FULL) { rq[S][i_] = *(const u32x4*)rowp_; rg[S][i_] = *(const u32x4*)(rowp_ + 1536); } rk[S][i_] = *(const u32x4*)(rowp_ + 512); rv[S][i_] = *(const u32x4*)(rowp_ + 1024); } } while (0)
#define RET_STAGE_A(S) do { const int j_ = 2 * (tid >> 4), ch_ = tid & 15; \
        if (FULL) { _Pragma("unroll") for (int i_ = 0; i_ < 2; ++i_) { *(LAS u32x4*)(lds + QI_OFF + (j_ + i_) * 272 + ch_ * 16) = rq[S][i_]; *(LAS u32x4*)(lds + KI_OFF + (j_ + i_) * 272 + ch_ * 16) = rk[S][i_]; *(LAS u32x4*)(lds + GI_OFF + (j_ + i_) * 272 + ch_ * 16) = rg[S][i_]; } } \
        const float te0_ = __builtin_amdgcn_exp2f(l2g * (float)(63 - j_)), te1_ = __builtin_amdgcn_exp2f(l2g * (float)(62 - j_)); \
        const unsigned ka_[4] = {rk[S][0].x, rk[S][0].y, rk[S][0].z, rk[S][0].w}, kb_[4] = {rk[S][1].x, rk[S][1].y, rk[S][1].z, rk[S][1].w}; \
        const unsigned va_[4] = {rv[S][0].x, rv[S][0].y, rv[S][0].z, rv[S][0].w}, vb_[4] = {rv[S][1].x, rv[S][1].y, rv[S][1].z, rv[S][1].w}; \
        const int cofs_ = 16 * ((j_ >> 3) ^ (ch_ & 7)) + 2 * (j_ & 7); \
        _Pragma("unroll") for (int e2 = 0; e2 < 4; ++e2) { const int row_ = 8 * ch_ + 2 * e2; \
            *(LAS unsigned*)(lds + KT_OFF + row_ * 144 + cofs_) = pk2(__uint_as_float(ka_[e2] << 16) * te0_, __uint_as_float(kb_[e2] << 16) * te1_); \
            *(LAS unsigned*)(lds + KT_OFF + (row_ + 1) * 144 + cofs_) = pk2(__uint_as_float(ka_[e2] & 0xffff0000u) * te0_, __uint_as_float(kb_[e2] & 0xffff0000u) * te1_); \
            *(LAS unsigned*)(lds + VT_OFF + row_ * 144 + cofs_) = (va_[e2] & 0xffffu) | (vb_[e2] << 16); \
            *(LAS unsigned*)(lds + VT_OFF + (row_ + 1) * 144 + cofs_) = (va_[e2] >> 16) | (vb_[e2] & 0xffff0000u); } } while (0)
#define WG_BAR() do { asm volatile("s_waitcnt lgkmcnt(0)" ::: "memory"); __builtin_amdgcn_s_barrier(); asm volatile("" ::: "memory"); } while (0)
template <bool FULL>
__device__ __forceinline__ void ret_unit(const Params& p, LAS unsigned char* lds, int unit, int tid, int wid, int lane) {
    asm volatile("" : "+v"(tid), "+v"(lane));
    const int G = unit & 7, h = (unit >> 3) & 3, b = unit >> 5;
    const bf16_t* P = (const bf16_t*)(p.ws + WS_RB);
    bf16_t* MIX = (bf16_t*)(p.ws + WS_RA);
    float* UG = (float*)(p.ws + WS_UG);
    const size_t tok0 = (size_t)b * 4096 + (size_t)G * 512;
    const float l2g = log2f(1.0f - exp2f(-5.0f - (float)h));
    const float g64 = __builtin_amdgcn_exp2f(l2g * 64.0f);
    const bool is_state = wid >= 4; const int w4 = wid & 3;
    const int l15 = lane & 15, l4 = lane >> 4;
    const int vtL = l4 ^ (l15 >> 3);
    const int vtb0 = VT_OFF + l15 * 144 + 16 * vtL, vtb1 = VT_OFF + l15 * 144 + 16 * (vtL ^ 2);
#define VT_ADDR(nt, ks) ((((nt) & 1) ? vtb1 : vtb0) + (nt) * 2304 + 16 * (((4 * (ks)) ^ (2 * ((nt) & 3))) & 4))
    constexpr int PD = FULL ? 1 : 4;
    u32x4 rq[PD][2], rk[PD][2], rv[PD][2], rg[PD][2];
    if (is_state) {
        f32x4 st[2][8];
#pragma unroll
        for (int mt = 0; mt < 2; ++mt)
#pragma unroll
            for (int nt = 0; nt < 8; ++nt) st[mt][nt] = (f32x4){0.f, 0.f, 0.f, 0.f};
        if (FULL) {
#pragma unroll 1
            for (int Gp = 0; Gp < G; Gp += 2) {
                const float wa = __builtin_amdgcn_exp2f(l2g * 512.0f * (float)(G - 1 - Gp));
                const bool two = Gp + 1 < G;
                const float wb = two ? __builtin_amdgcn_exp2f(l2g * 512.0f * (float)(G - 2 - Gp)) : 0.f;
                const float* sa = UG + ((size_t)((b * 4 + h) * 8 + Gp) * 4 + w4) * 4096 + lane;
                const float* sb = two ? sa + 4 * 4096 : sa;
#pragma unroll
                for (int mt = 0; mt < 2; ++mt)
#pragma unroll
                    for (int nt = 0; nt < 8; ++nt)
#pragma unroll
                        for (int r = 0; r < 4; ++r) st[mt][nt][r] += wa * sa[((mt * 8 + nt) * 4 + r) * 64] + wb * sb[((mt * 8 + nt) * 4 + r) * 64];
            }
        }
#pragma unroll
        for (int s = 0; s < PD; ++s) RET_ISSUE(s, s);
#pragma unroll 1
        for (int n0 = 0; n0 < 8; n0 += PD) {
#pragma unroll
          for (int s = 0; s < PD; ++s) { const int n = n0 + s;
            RET_STAGE_A(s);
            if (n + PD < 8) RET_ISSUE(s, n + PD);
            if (FULL) {
#pragma unroll
                for (int mt = 0; mt < 2; ++mt)
#pragma unroll
                    for (int nt = 0; nt < 8; ++nt) { const int e = 16 * nt + l15, dk0 = 32 * w4 + 16 * mt + 4 * l4;
                        *(LAS u32x2*)(lds + ST_OFF + e * 272 + dk0 * 2) = (u32x2){pk2(st[mt][nt][0], st[mt][nt][1]), pk2(st[mt][nt][2], st[mt][nt][3])}; }
            }
            WG_BAR();
            if (FULL) {
                bf16x8 ak[4];
#pragma unroll
                for (int ks = 0; ks < 4; ++ks) ak[ks] = *(const LAS bf16x8*)(lds + KI_OFF + (16 * w4 + l15) * 272 + (32 * ks + 8 * l4) * 2);
#pragma unroll
                for (int it = 0; it < 4; ++it) {
                    bf16x8 bq[4];
#pragma unroll
                    for (int ks = 0; ks < 4; ++ks) bq[ks] = *(const LAS bf16x8*)(lds + QI_OFF + (16 * it + l15) * 272 + (32 * ks + 8 * l4) * 2);
                    f32x4 sa = (f32x4){0.f, 0.f, 0.f, 0.f};
#pragma unroll
                    for (int ks = 0; ks < 4; ++ks) sa = MFMA16(ak[ks], bq[ks], sa);
                    const int i = 16 * it + l15, j0 = 16 * w4 + 4 * l4;
#pragma unroll
                    for (int r = 0; r < 4; ++r) { const int d = i - (j0 + r); sa[r] *= __builtin_amdgcn_exp2f(l2g * (float)(d < 0 ? -d : d)); }
                    *(LAS u32x2*)(lds + SI_OFF + i * 144 + j0 * 2) = (u32x2){pk2(sa[0], sa[1]), pk2(sa[2], sa[3])};
                }
            }
            WG_BAR();
#pragma unroll
            for (int mt = 0; mt < 2; ++mt)
#pragma unroll
                for (int nt = 0; nt < 8; ++nt) st[mt][nt] = st[mt][nt] * g64;
#pragma unroll
            for (int ks = 0; ks < 2; ++ks) {
                bf16x8 akt[2];
#pragma unroll
                for (int mt = 0; mt < 2; ++mt) { const int row = 32 * w4 + 16 * mt + l15; akt[mt] = *(const LAS bf16x8*)(lds + KT_OFF + row * 144 + 16 * ((4 * ks + l4) ^ ((row >> 3) & 7))); }
#pragma unroll
                for (int nh = 0; nh < 2; ++nh) {
                    bf16x8 bv[4];
#pragma unroll
                    for (int nt = 0; nt < 4; ++nt) bv[nt] = *(const LAS bf16x8*)(lds + VT_ADDR(4 * nh + nt, ks));
#pragma unroll
                    for (int nt = 0; nt < 4; ++nt)
#pragma unroll
                        for (int mt = 0; mt < 2; ++mt) st[mt][4 * nh + nt] = MFMA16(akt[mt], bv[nt], st[mt][4 * nh + nt]);
                }
            }
            WG_BAR();
          }
        }
        if (!FULL) {
            float* dst = UG + ((size_t)unit * 4 + w4) * 4096 + lane;
#pragma unroll
            for (int mt = 0; mt < 2; ++mt)
#pragma unroll
                for (int nt = 0; nt < 8; ++nt)
#pragma unroll
                    for (int r = 0; r < 4; ++r) dst[((mt * 8 + nt) * 4 + r) * 64] = st[mt][nt][r];
        } else if (G == 7) {
            float* o = p.out + O_SRP + (size_t)(b * 4 + h) * 16384 + (64 * (l4 & 1) + 16 * w4 + 4 * (l4 >> 1)) * 128 + l15;
#pragma unroll
            for (int mt = 0; mt < 2; ++mt)
#pragma unroll
                for (int nt = 0; nt < 8; ++nt)
#pragma unroll
                    for (int r = 0; r < 4; ++r) o[(8 * mt + r) * 128 + 16 * nt] = st[mt][nt][r];
        }
    } else {
        float rwv[8];
#pragma unroll
        for (int nt = 0; nt < 8; ++nt) rwv[nt] = p.in[8][128 * h + 16 * nt + l15];
#pragma unroll
        for (int s = 0; s < PD; ++s) RET_ISSUE(s, s);
#pragma unroll 1
        for (int n0 = 0; n0 < 8; n0 += PD) {
#pragma unroll
          for (int s = 0; s < PD; ++s) { const int n = n0 + s;
            RET_STAGE_A(s);
            if (n + PD < 8) RET_ISSUE(s, n + PD);
            WG_BAR();
            f32x4 acc[8];
            if (FULL) {
                f32x4 fsv;
#pragma unroll
                for (int r = 0; r < 4; ++r) fsv[r] = __builtin_amdgcn_exp2f(l2g * (float)(16 * w4 + 4 * l4 + r + 1));
#pragma unroll
                for (int nt = 0; nt < 8; ++nt) acc[nt] = (f32x4){0.f, 0.f, 0.f, 0.f};
                bf16x8 aq[4];
#pragma unroll
                for (int ks = 0; ks < 4; ++ks) aq[ks] = *(const LAS bf16x8*)(lds + QI_OFF + (16 * w4 + l15) * 272 + (32 * ks + 8 * l4) * 2);
#pragma unroll
                for (int ks = 0; ks < 4; ++ks)
#pragma unroll
                    for (int nh = 0; nh < 2; ++nh) {
                        bf16x8 bs[4];
#pragma unroll
                        for (int nt = 0; nt < 4; ++nt) bs[nt] = *(const LAS bf16x8*)(lds + ST_OFF + (16 * (4 * nh + nt) + l15) * 272 + (32 * ks + 8 * l4) * 2);
#pragma unroll
                        for (int nt = 0; nt < 4; ++nt) acc[4 * nh + nt] = MFMA16(aq[ks], bs[nt], acc[4 * nh + nt]);
                    }
#pragma unroll
                for (int nt = 0; nt < 8; ++nt) acc[nt] = acc[nt] * fsv;
            }
            WG_BAR();
            if (FULL) {
                bf16x8 as_[2];
#pragma unroll
                for (int ks = 0; ks < 2; ++ks) as_[ks] = *(const LAS bf16x8*)(lds + SI_OFF + (16 * w4 + l15) * 144 + 16 * (4 * ks + l4));
#pragma unroll
                for (int ks = 0; ks < 2; ++ks)
#pragma unroll
                    for (int nh = 0; nh < 2; ++nh) {
                        bf16x8 bv[4];
#pragma unroll
                        for (int nt = 0; nt < 4; ++nt) bv[nt] = *(const LAS bf16x8*)(lds + VT_ADDR(4 * nh + nt, ks));
#pragma unroll
                        for (int nt = 0; nt < 4; ++nt) acc[4 * nh + nt] = MFMA16(as_[ks], bv[nt], acc[4 * nh + nt]);
                    }
                unsigned short gq[4][8];
#pragma unroll
                for (int r = 0; r < 4; ++r)
#pragma unroll
                    for (int nt = 0; nt < 8; ++nt) gq[r][nt] = *(const LAS unsigned short*)(lds + GI_OFF + (16 * w4 + 4 * l4 + r) * 272 + (16 * nt + l15) * 2);
                float rstd[4];
#pragma unroll
                for (int r = 0; r < 4; ++r) { float ss = 0.f;
#pragma unroll
                    for (int nt = 0; nt < 8; ++nt) ss += acc[nt][r] * acc[nt][r];
                    ss += dppf(ss, 1); ss += dppf(ss, 2); ss += dppf(ss, 4); ss += dppf(ss, 8);
                    ss = __shfl(ss, (lane & 48) | 15);
                    rstd[r] = rsqrtf(ss * (1.0f / 128.0f) + EPS); }
#pragma unroll
                for (int r = 0; r < 4; ++r)
#pragma unroll
                    for (int nt = 0; nt < 8; ++nt)
                        *(LAS unsigned short*)(lds + QI_OFF + (16 * w4 + 4 * l4 + r) * 272 + (16 * nt + l15) * 2) = (unsigned short)(pk2s(acc[nt][r] * rstd[r] * rwv[nt] * silu_f(bf2f(gq[r][nt])), 0.f) & 0xffffu);
#pragma unroll
                for (int q = 0; q < 4; ++q) { const int cidx = lane + 64 * q, row = 16 * w4 + (cidx >> 4), ch = cidx & 15;
                    const u32x4 v = *(const LAS u32x4*)(lds + QI_OFF + row * 272 + ch * 16);
                    *(u32x4*)(MIX + (tok0 + (size_t)n * 64 + row) * DM + 128 * h + ch * 8) = v; }
            }
            WG_BAR();
          }
        }
    }
#ifndef CONVREP
#define CONVREP 1
#endif
    if (FULL) for (int crep_ = 0; crep_ < CONVREP; ++crep_) {
        const int c0 = 128 * h + 8 * (tid & 15), run = tid >> 4, t0 = G * 512 + run * 16;
        const float* cwp = p.in[7];
        float w0[8], w1[8], w2[8], p1[8], p2[8];
#pragma unroll
        for (int e = 0; e < 8; ++e) { w0[e] = cwp[c0 + e]; w1[e] = cwp[512 + c0 + e]; w2[e] = cwp[1024 + c0 + e]; p1[e] = 0.f; p2[e] = 0.f; }
        if (t0 > 0) {
            const bf16_t* r2 = P + ((size_t)b * 4096 + t0 - 2) * NIN; const bf16_t* r1 = r2 + NIN;
            const u32x4 c2 = *(const u32x4*)(r2 + 2560 + c0), h2 = *(const u32x4*)(r2 + 3072 + c0), c1 = *(const u32x4*)(r1 + 2560 + c0), h1 = *(const u32x4*)(r1 + 3072 + c0);
            const unsigned c2w[4] = {c2.x, c2.y, c2.z, c2.w}, h2w[4] = {h2.x, h2.y, h2.z, h2.w}, c1w[4] = {c1.x, c1.y, c1.z, c1.w}, h1w[4] = {h1.x, h1.y, h1.z, h1.w};
#pragma unroll
            for (int e = 0; e < 4; ++e) {
                p2[2 * e] = __uint_as_float(c2w[e] << 16) * __uint_as_float(h2w[e] << 16); p2[2 * e + 1] = __uint_as_float(c2w[e] & 0xffff0000u) * __uint_as_float(h2w[e] & 0xffff0000u);
                p1[2 * e] = __uint_as_float(c1w[e] << 16) * __uint_as_float(h1w[e] << 16); p1[2 * e + 1] = __uint_as_float(c1w[e] & 0xffff0000u) * __uint_as_float(h1w[e] & 0xffff0000u); }
        }
#pragma unroll 8
        for (int t = 0; t < 16; ++t) {
            const size_t row = (size_t)b * 4096 + t0 + t;
            const bf16_t* rp = P + row * NIN;
            const u32x4 bb = *(const u32x4*)(rp + 2048 + c0), cc = *(const u32x4*)(rp + 2560 + c0), hh = *(const u32x4*)(rp + 3072 + c0);
            const unsigned bw[4] = {bb.x, bb.y, bb.z, bb.w}, cw4[4] = {cc.x, cc.y, cc.z, cc.w}, hw[4] = {hh.x, hh.y, hh.z, hh.w};
            float y[8];
#pragma unroll
            for (int e = 0; e < 4; ++e) {
                const float ca = __uint_as_float(cw4[e] << 16) * __uint_as_float(hw[e] << 16), cb = __uint_as_float(cw4[e] & 0xffff0000u) * __uint_as_float(hw[e] & 0xffff0000u);
                y[2 * e] = __uint_as_float(bw[e] << 16) * (w0[2 * e] * p2[2 * e] + w1[2 * e] * p1[2 * e] + w2[2 * e] * ca);
                y[2 * e + 1] = __uint_as_float(bw[e] & 0xffff0000u) * (w0[2 * e + 1] * p2[2 * e + 1] + w1[2 * e + 1] * p1[2 * e + 1] + w2[2 * e + 1] * cb);
                p2[2 * e] = p1[2 * e]; p2[2 * e + 1] = p1[2 * e + 1]; p1[2 * e] = ca; p1[2 * e + 1] = cb;
            }
            *(u32x4*)(MIX + row * DM + 512 + c0) = (u32x4){pk2(y[0], y[1]), pk2(y[2], y[3]), pk2(y[4], y[5]), pk2(y[6], y[7])};
        }
        if (G == 7 && run == 31) {
            float* o = p.out + O_CCP + (size_t)b * 1024 + c0;
#pragma unroll
            for (int e = 0; e < 8; ++e) { o[e] = p2[e]; o[512 + e] = p1[e]; }
        }
    }
#undef VT_ADDR
}

__device__ __forceinline__ float ch_at(const float* PS, const float* cache, int b, int t, int ch) {
    if (t < 0) return cache[(b * 2 + (t + 2)) * 512 + ch];
    const float* rp = PS + (size_t)(16 * b + t) * NIN;
    return rp[2560 + ch] * rp[3072 + ch];
}
__device__ __forceinline__ void sample_unit(const Params& p, LAS unsigned char* lds, int su, int tid, int wid, int lane) {
    const int b = su >> 2, h = su & 3, ts0 = TOK_P + 16 * b;
    const float* PS = (const float*)(p.ws + WS_PS);
    bf16_t* MIX = (bf16_t*)(p.ws + WS_RA);
    LAS float* qs = (LAS float*)lds; LAS float* ks = qs + 2048; LAS float* vs = qs + 4096; LAS float* Ssm = qs + 6144; LAS float* osm = qs + 6400;
    const float l2g = log2f(1.0f - exp2f(-5.0f - (float)h));
    const float* cosT = (const float*)(p.ws + WS_COS); const float* sinT = (const float*)(p.ws + WS_SIN);
    for (int idx = tid; idx < 2048; idx += 512) { const int i = idx >> 7, c = idx & 127, d = dmap(c);
        const float* rp = PS + (size_t)(16 * b + i) * NIN + 128 * h;
        const float cs = cosT[(4096 + i) * 64 + (d & 63)], sn = sinT[(4096 + i) * 64 + (d & 63)];
        const float xq = rp[c], xqp = rp[c ^ 4], xk = rp[512 + c], xkp = rp[512 + (c ^ 4)];
        qs[i * 128 + d] = d < 64 ? xq * cs - xqp * sn : xq * cs + xqp * sn;
        ks[i * 128 + d] = (d < 64 ? xk * cs - xkp * sn : xk * cs + xkp * sn) * 0.08838834764831845f;
        vs[i * 128 + c] = rp[1024 + c]; }
    __syncthreads();
    if (tid < 256) { const int i = tid >> 4, j = tid & 15; float s = 0.f;
        for (int d = 0; d < 128; ++d) s += qs[i * 128 + d] * ks[j * 128 + d];
        const int dd = i - j; Ssm[i * 16 + j] = s * __builtin_amdgcn_exp2f(l2g * (float)(dd < 0 ? -dd : dd)); }
    const int e = tid & 127, ig = tid >> 7;
    LAS float* s0 = qs + 8704;
    { const float* s0g = p.in[2] + (size_t)su * 16384; f32x4 t8[8];
#pragma unroll
      for (int q = 0; q < 8; ++q) t8[q] = *((const f32x4*)s0g + tid + 512 * q);
#pragma unroll
      for (int q = 0; q < 8; ++q) *((LAS f32x4*)s0 + tid + 512 * q) = t8[q]; }
    __syncthreads();
    float cr[4] = {0.f, 0.f, 0.f, 0.f};
#pragma unroll 4
    for (int d = 0; d < 128; ++d) { const float sv = s0[d * 128 + e];
#pragma unroll
        for (int r = 0; r < 4; ++r) cr[r] += qs[(ig * 4 + r) * 128 + d] * sv; }
    __syncthreads();
#pragma unroll
    for (int r = 0; r < 4; ++r) { const int i = ig * 4 + r; float o = 0.f;
        for (int j = 0; j < 16; ++j) o += Ssm[i * 16 + j] * vs[j * 128 + e];
        osm[i * 128 + e] = o + __builtin_amdgcn_exp2f(l2g * (float)(i + 1)) * cr[r]; }
    __syncthreads();
    for (int rr = 0; rr < 2; ++rr) { const int i = 2 * wid + rr; const float v0 = osm[i * 128 + lane], v1 = osm[i * 128 + 64 + lane];
        const float rstd = rsqrtf(wave_sum(v0 * v0 + v1 * v1) * (1.0f / 128.0f) + EPS);
        const size_t token = (size_t)(ts0 + i);
        const float g0 = PS[(size_t)(16 * b + i) * NIN + 1536 + 128 * h + lane], g1 = PS[(size_t)(16 * b + i) * NIN + 1536 + 128 * h + 64 + lane];
        MIX[token * DM + 128 * h + lane] = (bf16_t)(pk2(v0 * rstd * p.in[8][128 * h + lane] * silu_f(g0), 0.f) & 0xffffu);
        MIX[token * DM + 128 * h + 64 + lane] = (bf16_t)(pk2(v1 * rstd * p.in[8][128 * h + 64 + lane] * silu_f(g1), 0.f) & 0xffffu); }
    const float g16 = __builtin_amdgcn_exp2f(l2g * 16.0f);
    float* outS = p.out + O_SRS + (size_t)su * 16384;
#pragma unroll 2
    for (int dd = 0; dd < 32; ++dd) { const int d = ig + 4 * dd; float a = g16 * s0[d * 128 + e];
        for (int j = 0; j < 16; ++j) a += __builtin_amdgcn_exp2f(l2g * (float)(15 - j)) * ks[j * 128 + d] * vs[j * 128 + e];
        outS[d * 128 + e] = a; }
    const int ch = 128 * h + e; const float* cache = p.in[3]; const float* cwp = p.in[7];
    const float w0 = cwp[ch], w1 = cwp[512 + ch], w2 = cwp[1024 + ch];
#pragma unroll
    for (int tt = 0; tt < 4; ++tt) { const int t = ig * 4 + tt;
        const float c0 = ch_at(PS, cache, b, t - 2, ch), c1 = ch_at(PS, cache, b, t - 1, ch), c2 = ch_at(PS, cache, b, t, ch);
        const float y = PS[(size_t)(16 * b + t) * NIN + 2048 + ch] * (w0 * c0 + w1 * c1 + w2 * c2);
        MIX[(size_t)(ts0 + t) * DM + 512 + ch] = (bf16_t)(pk2(y, 0.f) & 0xffffu);
        if (t >= 14) p.out[O_CCS + (size_t)(b * 2 + t - 14) * 512 + ch] = c2; }
    __syncthreads();
}

template <int NB>
__device__ __forceinline__ void thin_gemm(const bf16_t* A, int lda, const bf16_t* Bt, int ldb, int n0, int nbstride, int kbeg, int klen, f32x4 (&acc)[NB], int wid, int lane) {
    const int l15 = lane & 15, l4 = lane >> 4;
    const bf16_t* ap = A + (size_t)(16 * wid + l15) * lda + kbeg + 8 * l4;
    const bf16_t* bp = Bt + (size_t)(n0 + l15) * ldb + kbeg + 8 * l4;
#pragma unroll
    for (int nb = 0; nb < NB; ++nb) acc[nb] = (f32x4){0.f, 0.f, 0.f, 0.f};
#pragma unroll 1
    for (int s0 = 0; s0 < klen; s0 += 256) {
        bf16x8 a[8], b[NB][8];
#pragma unroll
        for (int s = 0; s < 8; ++s) { a[s] = *(const bf16x8*)(ap + s0 + 32 * s);
#pragma unroll
            for (int nb = 0; nb < NB; ++nb) b[nb][s] = *(const bf16x8*)(bp + (size_t)nb * nbstride * ldb + s0 + 32 * s); }
#pragma unroll
        for (int s = 0; s < 8; ++s)
#pragma unroll
            for (int nb = 0; nb < NB; ++nb) acc[nb] = MFMA16(a[s], b[nb][s], acc[nb]);
    }
}
__device__ __forceinline__ void thin_store(const f32x4& acc, float* out, int ldo, int col, int wid, int lane) {
#pragma unroll
    for (int r = 0; r < 4; ++r) out[(size_t)(16 * wid + 4 * (lane >> 4) + r) * ldo + col + (lane & 15)] = acc[r];
}
__device__ __forceinline__ void thin_ffn1(const Params& p, int c, int wid, int lane) {
    const int pn = c >> 3, j16 = c & 7, l15 = lane & 15, l4 = lane >> 4;
    f32x4 acc[2];
    thin_gemm<2>((const bf16_t*)(p.ws + WS_RA) + (size_t)TOK_P * DM, DM, (const bf16_t*)(p.ws + WS_WFF1), DM, 256 * pn + 16 * j16, 128, 0, DM, acc, wid, lane);
    const int ch = 128 * pn + 16 * j16 + l15, b = wid;
    const float* cw = p.in[15]; const float* cache = p.in[4] + (size_t)b * 2 * DFF + ch;
    const float w0 = cw[ch], w1 = cw[DFF + ch], w2 = cw[2 * DFF + ch];
    const f32x4 up = acc[0], gt = acc[1];
    float pm1 = __shfl_up(up[3], 16), pm2 = __shfl_up(up[2], 16);
    if (l4 == 0) { pm1 = cache[DFF]; pm2 = cache[0]; }
    float uc[4];
    uc[0] = w0 * pm2 + w1 * pm1 + w2 * up[0];
    uc[1] = w0 * pm1 + w1 * up[0] + w2 * up[1];
    uc[2] = w0 * up[0] + w1 * up[1] + w2 * up[2];
    uc[3] = w0 * up[1] + w1 * up[2] + w2 * up[3];
    bf16_t* ACT = (bf16_t*)(p.ws + WS_RB);
#pragma unroll
    for (int r = 0; r < 4; ++r) ACT[(size_t)(TOK_P + 16 * wid + 4 * l4 + r) * DFF + ch] = (bf16_t)(pk2(pg8::gelu_tanh(uc[r]) * gt[r], 0.f) & 0xffffu);
    if (l4 == 3) { float* o = p.out + O_CFS + (size_t)b * 2 * DFF + ch; o[0] = up[2]; o[DFF] = up[3]; }
}

__device__ __forceinline__ void phase4(const Params& p, int wid, int lane) {
    const int gw = blockIdx.x * 8 + wid, NGW = gridDim.x * 8;
    const bf16_t* Y = (const bf16_t*)(p.ws + WS_Y); bf16_t* H2 = (bf16_t*)(p.ws + WS_RA); const float* ssq = (const float*)(p.ws + WS_SSQ1);
    const float* wpost = p.in[10]; const float* wpre = p.in[11];
    f32x4 wpo[4], wpr[4];
#pragma unroll
    for (int j = 0; j < 4; ++j) { wpo[j] = *((const f32x4*)wpost + lane + 64 * j); wpr[j] = *((const f32x4*)wpre + lane + 64 * j); }
#pragma unroll 1
    for (int base = gw; base < TOK_P; base += RB * NGW) {
        f32x4 v[RB][4]; u32x2 yw[RB][4]; float sq[RB];
#pragma unroll
        for (int k = 0; k < RB; ++k) { const int rr = min(base + k * NGW, TOK_P - 1);
            sq[k] = lane < 16 ? ssq[(size_t)rr * 16 + lane] : 0.f;
#pragma unroll
            for (int j = 0; j < 4; ++j) { v[k][j] = __builtin_nontemporal_load((const f32x4*)(p.in[0] + (size_t)rr * DM) + lane + 64 * j); yw[k][j] = __builtin_nontemporal_load((const u32x2*)(Y + (size_t)rr * DM) + lane + 64 * j); } }
        float s2[RB];
#pragma unroll
        for (int k = 0; k < RB; ++k) { const float rstd1 = rsqrtf(wave_sum(sq[k]) * (1.0f / DM) + EPS); s2[k] = 0.f;
#pragma unroll
            for (int j = 0; j < 4; ++j) { v[k][j] = v[k][j] + (unpack_bf4(yw[k][j]) * rstd1) * wpo[j]; s2[k] += sumsq4(v[k][j]); } }
#pragma unroll
        for (int k = 0; k < RB; ++k) { const int r = base + k * NGW; const float rstd2 = rsqrtf(wave_sum(s2[k]) * (1.0f / DM) + EPS);
            if (r < TOK_P) {
#pragma unroll
                for (int j = 0; j < 4; ++j) { const f32x4 y = (v[k][j] * rstd2) * wpr[j];
                    __builtin_nontemporal_store((u32x2){pk2(y[0], y[1]), pk2(y[2], y[3])}, (u32x2*)(H2 + (size_t)r * DM) + lane + 64 * j); } } }
    }
    for (int r = TOK_P + gw; r < TOK; r += NGW) {
        const float* xrow = p.in[1] + (size_t)(r - TOK_P) * DM; const float* ys = (const float*)(p.ws + WS_YS) + (size_t)(r - TOK_P) * DM;
        f32x4 yv[4], v[4]; float s = 0.f, s2 = 0.f;
#pragma unroll
        for (int j = 0; j < 4; ++j) { f32x4 a = *((const f32x4*)ys + lane + 64 * j);
#pragma unroll
            for (int q = 1; q < 4; ++q) a += *((const f32x4*)(ys + (size_t)q * 128 * DM) + lane + 64 * j);
            yv[j] = a; s += sumsq4(a); }
        const float rstd1 = rsqrtf(wave_sum(s) * (1.0f / DM) + EPS);
#pragma unroll
        for (int j = 0; j < 4; ++j) { v[j] = *((const f32x4*)xrow + lane + 64 * j) + (yv[j] * rstd1) * wpo[j]; s2 += sumsq4(v[j]);
 }
        const float rstd2 = rsqrtf(wave_sum(s2) * (1.0f / DM) + EPS);
#pragma unroll
        for (int j = 0; j < 4; ++j) { const f32x4 y = (v[j] * rstd2) * wpr[j]; *((u32x2*)(H2 + (size_t)r * DM) + lane + 64 * j) = (u32x2){pk2(y[0], y[1]), pk2(y[2], y[3])}; }
    }
}
__device__ __forceinline__ void phase7(const Params& p, int wid, int lane) {
    const int gw = blockIdx.x * 8 + wid, NGW = gridDim.x * 8;
    const bf16_t* F = (const bf16_t*)(p.ws + WS_RA); const bf16_t* Y = (const bf16_t*)(p.ws + WS_Y);
    const float* ssq1 = (const float*)(p.ws + WS_SSQ1); const float* ssq2 = (const float*)(p.ws + WS_SSQ2);
    f32x4 wm[4], wf[4];
#pragma unroll
    for (int j = 0; j < 4; ++j) { wm[j] = *((const f32x4*)p.in[10] + lane + 64 * j); wf[j] = *((const f32x4*)p.in[12] + lane + 64 * j); }
    constexpr int RB7 = 3;
#pragma unroll 1
    for (int base = gw; base < TOK_P; base += RB7 * NGW) {
        f32x4 v[RB7][4]; u32x2 yw[RB7][4], fw[RB7][4]; float sq1[RB7], sq2[RB7];
#pragma unroll
        for (int k = 0; k < RB7; ++k) { const int rr = min(base + k * NGW, TOK_P - 1);
            sq1[k] = lane < 16 ? ssq1[(size_t)rr * 16 + lane] : 0.f; sq2[k] = lane < 16 ? ssq2[(size_t)rr * 16 + lane] : 0.f;
#pragma unroll
            for (int j = 0; j < 4; ++j) { v[k][j] = __builtin_nontemporal_load((const f32x4*)(p.in[0] + (size_t)rr * DM) + lane + 64 * j);
                yw[k][j] = __builtin_nontemporal_load((const u32x2*)(Y + (size_t)rr * DM) + lane + 64 * j); fw[k][j] = __builtin_nontemporal_load((const u32x2*)(F + (size_t)rr * DM) + lane + 64 * j); } }
#pragma unroll
        for (int k = 0; k < RB7; ++k) { const int r = base + k * NGW;
            const float rstd1 = rsqrtf(wave_sum(sq1[k]) * (1.0f / DM) + EPS), rstd2 = rsqrtf(wave_sum(sq2[k]) * (1.0f / DM) + EPS);
            if (r < TOK_P) {
#pragma unroll
                for (int j = 0; j < 4; ++j) __builtin_nontemporal_store(v[k][j] + (unpack_bf4(yw[k][j]) * rstd1) * wm[j] + (unpack_bf4(fw[k][j]) * rstd2) * wf[j], (f32x4*)(p.out + (size_t)r * DM) + lane + 64 * j); } }
    }
    for (int r = TOK_P + gw; r < TOK; r += NGW) {
        const float* xrow = p.in[1] + (size_t)(r - TOK_P) * DM;
        const float* ys = (const float*)(p.ws + WS_YS) + (size_t)(r - TOK_P) * DM; const float* fs = (const float*)(p.ws + WS_FS) + (size_t)(r - TOK_P) * DM;
        f32x4 yv[4], fv[4]; float s1 = 0.f, s2 = 0.f;
#pragma unroll
        for (int j = 0; j < 4; ++j) { f32x4 a = *((const f32x4*)ys + lane + 64 * j), c = *((const f32x4*)fs + lane + 64 * j);
#pragma unroll
            for (int q = 1; q < 4; ++q) { a += *((const f32x4*)(ys + (size_t)q * 128 * DM) + lane + 64 * j); c += *((const f32x4*)(fs + (size_t)q * 128 * DM) + lane + 64 * j); }
            yv[j] = a; fv[j] = c; s1 += sumsq4(a); s2 += sumsq4(c); }
        const float rstd1 = rsqrtf(wave_sum(s1) * (1.0f / DM) + EPS), rstd2 = rsqrtf(wave_sum(s2) * (1.0f / DM) + EPS);
#pragma unroll
        for (int j = 0; j < 4; ++j) *((f32x4*)(p.out + (size_t)r * DM) + lane + 64 * j) = *((const f32x4*)xrow + lane + 64 * j) + (yv[j] * rstd1) * wm[j] + (fv[j] * rstd2) * wf[j];
    }
}


#define XB_TMO      128
#define XB_XCNT(j)  (256  + 64 * (j))
#define XB_XSUB(j)  (1280 + 64 * (j))
#define XB_XGEN(j)  (2304 + 64 * (j))
#define XB_TOP      3328
#define XB_TOPGEN   3392
#define XCD_BAR_WORDS 3456
#define XB_SPIN_CAP (1u << 18)

__device__ __forceinline__ unsigned xb_ld(unsigned* p)              { return __hip_atomic_load(p, __ATOMIC_RELAXED, __HIP_MEMORY_SCOPE_AGENT); }
__device__ __forceinline__ unsigned xb_add(unsigned* p, unsigned v) { return __hip_atomic_fetch_add(p, v, __ATOMIC_RELAXED, __HIP_MEMORY_SCOPE_AGENT); }
__device__ __forceinline__ unsigned xb_xcc_id() { return (unsigned)__builtin_amdgcn_s_getreg((3 << 11) | 20) & 0xFu; }
#define XB_SPIN(cond, bar) do { unsigned _sp = 0; while (cond) { __builtin_amdgcn_s_sleep(1); \
    if ((++_sp & 255u) == 0u) { if (xb_ld(&(bar)[XB_TMO])) break; if (_sp > XB_SPIN_CAP) { atomicAdd(&(bar)[XB_TMO], 1u); break; } } } } while (0)

struct XcdBarrier {
    unsigned* bar; unsigned x;
    volatile LAS unsigned* st;
};

__device__ __forceinline__ XcdBarrier xcd_barrier_post(unsigned* bar, volatile LAS unsigned* st) {
    XcdBarrier b; b.bar = bar; b.x = xb_xcc_id(); b.st = st;
    if (threadIdx.x == 0) (void)xb_add(&bar[XB_XCNT(b.x)], 1u);
    return b;
}
__device__ __forceinline__ void xcd_barrier_complete(unsigned* bar, unsigned x, unsigned& nloc, unsigned& nx) {
    const unsigned G = gridDim.x * gridDim.y * gridDim.z;
    unsigned sum, cnt, mine, sp = 0u;
    for (;;) {
        sum = 0u; cnt = 0u; mine = 0u;
#pragma unroll
        for (unsigned j = 0; j < 16; ++j) { const unsigned c = xb_ld(&bar[XB_XCNT(j)]); sum += c; cnt += (c > 0u) ? 1u : 0u; mine = (j == x) ? c : mine; }
        if (sum == G) break;
        __builtin_amdgcn_s_sleep(1);
        if ((++sp & 255u) == 0u) { if (xb_ld(&bar[XB_TMO])) break; if (sp > XB_SPIN_CAP) { atomicAdd(&bar[XB_TMO], 1u); break; } }
    }
    nloc = mine > 0u ? mine : 1u; nx = cnt > 0u ? cnt : 1u;
}

__device__ __forceinline__ void xcd_barrier(const XcdBarrier& b) {
    asm volatile("s_waitcnt vmcnt(0)" ::: "memory");
    __syncthreads();
    if (threadIdx.x == 0) {
        unsigned* bar = b.bar;
        __builtin_amdgcn_s_waitcnt(0);
        unsigned nloc = b.st[0], nx = b.st[1];
        if (nloc == 0u) { xcd_barrier_complete(bar, b.x, nloc, nx); b.st[0] = nloc; b.st[1] = nx; }
        const unsigned old = xb_add(&bar[XB_XSUB(b.x)], 1u);
        const unsigned gen = old / nloc;
        if (old + 1u == (gen + 1u) * nloc) {
            __builtin_amdgcn_fence(__ATOMIC_RELEASE, "agent");
            asm volatile("s_waitcnt vmcnt(0)" ::: "memory");
            const unsigned og = xb_add(&bar[XB_TOP], 1u);
            const unsigned tg = og / nx;
            if (og + 1u == (tg + 1u) * nx) xb_add(&bar[XB_TOPGEN], 1u);
            else XB_SPIN(xb_ld(&bar[XB_TOPGEN]) == tg, bar);
            __builtin_amdgcn_fence(__ATOMIC_ACQUIRE, "agent");
            xb_add(&bar[XB_XGEN(b.x)], 1u);
            asm volatile("s_waitcnt vmcnt(0)" ::: "memory");
        } else {
            XB_SPIN(xb_ld(&bar[XB_XGEN(b.x)]) == gen, bar);
            __builtin_amdgcn_fence(__ATOMIC_ACQUIRE, "agent");
            asm volatile("s_waitcnt vmcnt(0)" ::: "memory");
        }
    }
    __syncthreads();
}

#ifndef MK_LAUNCHES
#define MK_LAUNCHES 1
#endif
#ifndef REP0
#define REP0 1
#endif
#ifndef REP1
#define REP1 1
#endif
#ifndef REP2
#define REP2 1
#endif
#ifndef REP3
#define REP3 1
#endif
#ifndef REP4
#define REP4 1
#endif
#ifndef REP5
#define REP5 1
#endif
#ifndef REP6
#define REP6 1
#endif
#ifndef REP7
#define REP7 1
#endif
#define REPEAT(n) for (int rep_ = 0; rep_ < (n); ++rep_, ((rep_ < (n)) ? GRIDSYNC() : (void)0))
template <int PH_LO, int PH_HI>
__device__ __forceinline__ void run_phases(const Params& p, LAS unsigned char* lds) {
    int tid = threadIdx.x, lane = tid & 63; const int wid = __builtin_amdgcn_readfirstlane(tid >> 6);
    const int G = gridDim.x, c = blockIdx.x;
#define LAUNDER() asm volatile("" : "+v"(tid), "+v"(lane))
    XcdBarrier bar_;
    if (PH_HI - PH_LO > 1) {
        volatile LAS unsigned* stw = (volatile LAS unsigned*)(lds + LDS_BARW);
        if (threadIdx.x == 0) { stw[0] = 0u; stw[1] = 0u; }
        __syncthreads();
        bar_ = xcd_barrier_post((unsigned*)p.ws, stw);
        if (p.ws == nullptr) cg::this_grid().sync();
    }
#define GRIDSYNC() xcd_barrier(bar_)
#define SEAM(ph) do { if (PH_LO <= (ph) && (ph) + 1 < PH_HI) { GRIDSYNC(); } } while (0)
#ifdef XSYNC
    for (int xs_ = 0; xs_ < XSYNC; ++xs_) GRIDSYNC();
#endif
    if (PH_LO <= 0 && 0 < PH_HI) REPEAT(REP0) { LAUNDER(); phase0(p, lds, tid, wid, lane); }
    SEAM(0);
    if (PH_LO <= 1 && 1 < PH_HI) REPEAT(REP1) {
        for (int t = c; t < 224; t += G) { f32x4 acc[1]; thin_gemm<1>((const bf16_t*)(p.ws + WS_RA) + (size_t)TOK_P * DM, DM, (const bf16_t*)(p.ws + WS_WIN), DM, 16 * t, 0, 0, DM, acc, wid, lane);
            thin_store(acc[0], (float*)(p.ws + WS_PS), NIN, 16 * t, wid, lane); }
        pg8::Gemm g{(const bf16_t*)(p.ws + WS_RA), (const bf16_t*)(p.ws + WS_WIN), TOK_P, NIN, DM};
        pg8::StaticOrder S; S.init(TOK_P, NIN, G, c);
        pg8::EpiIn E{(bf16_t*)(p.ws + WS_RB), (const float*)(p.ws + WS_COS), (const float*)(p.ws + WS_SIN)};
        pg8::gemm_phase<pg8::EpiIn, pg8::StaticOrder, true, true>(lds, g, S, E);
    }
    SEAM(1);
    if (PH_LO <= 2 && 2 < PH_HI) REPEAT(REP2) {
#ifndef RUREP
#define RUREP 1
#endif
        for (int rrep_ = 0; rrep_ < RUREP; ++rrep_) for (int u = c; u < 256; u += G) ret_unit<false>(p, lds, u, tid, wid, lane);
        LAUNDER();
#ifndef SUREP
#define SUREP 1
#endif
        for (int srep_ = 0; srep_ < SUREP; ++srep_) for (int su = c; su < 32; su += G) sample_unit(p, lds, su, tid, wid, lane);
    }
    SEAM(2);
    if (PH_LO <= 3 && 3 < PH_HI) REPEAT(REP3) {
        for (int u = c; u < 256; u += G) ret_unit<true>(p, lds, u, tid, wid, lane);
    }
    SEAM(3);
    if (PH_LO <= 4 && 4 < PH_HI) REPEAT(REP4) {
        for (int t = c; t < 256; t += G) { f32x4 acc[1]; const int kq = t >> 6, nt = t & 63;
            thin_gemm<1>((const bf16_t*)(p.ws + WS_RA) + (size_t)TOK_P * DM, DM, (const bf16_t*)(p.ws + WS_WOUT), DM, 16 * nt, 0, 256 * kq, 256, acc, wid, lane);
            thin_store(acc[0], (float*)(p.ws + WS_YS) + (size_t)kq * 128 * DM, DM, 16 * nt, wid, lane); }
        pg8::Gemm g{(const bf16_t*)(p.ws + WS_RA), (const bf16_t*)(p.ws + WS_WOUT), TOK_P, DM, DM};
        pg8::StaticOrder S; S.init(TOK_P, DM, G, c);
        pg8::EpiY E{(bf16_t*)(p.ws + WS_Y), (float*)(p.ws + WS_SSQ1)};
        pg8::gemm_phase<pg8::EpiY, pg8::StaticOrder, true, true>(lds, g, S, E);
    }
    SEAM(4);
    if (PH_LO <= 5 && 5 < PH_HI) REPEAT(REP5) { LAUNDER(); phase4(p, wid, lane); }
    SEAM(5);
    if (PH_LO <= 6 && 6 < PH_HI) REPEAT(REP6) {
        for (int t = c; t < 256; t += G) thin_ffn1(p, t, wid, lane);
        pg8::Gemm g{(const bf16_t*)(p.ws + WS_RA), (const bf16_t*)(p.ws + WS_WFF1), TOK_P, 2 * DFF, DM};
        pg8::WalkOrder S{G, c};
        pg8::EpiFfn E{(bf16_t*)(p.ws + WS_RB), p.in[15], p.in[4], p.out + O_CFP, p.out + O_CFS, (LAS float*)(lds + LDS_HALO)};
        pg8::gemm_phase<pg8::EpiFfn, pg8::WalkOrder, true, true>(lds, g, S, E);
    }
    SEAM(6);
    if (PH_LO <= 7 && 7 < PH_HI) REPEAT(REP7) {
        for (int t = c; t < 256; t += G) { f32x4 acc[1]; const int kq = t >> 6, nt = t & 63;
            thin_gemm<1>((const bf16_t*)(p.ws + WS_RB) + (size_t)TOK_P * DFF, DFF, (const bf16_t*)(p.ws + WS_WDN), DFF, 16 * nt, 0, 1024 * kq, 1024, acc, wid, lane);
            thin_store(acc[0], (float*)(p.ws + WS_FS) + (size_t)kq * 128 * DM, DM, 16 * nt, wid, lane); }
        pg8::Gemm g{(const bf16_t*)(p.ws + WS_RB), (const bf16_t*)(p.ws + WS_WDN), TOK_P, DM, DFF};
        pg8::StaticOrder S; S.init(TOK_P, DM, G, c);
        pg8::EpiY E{(bf16_t*)(p.ws + WS_RA), (float*)(p.ws + WS_SSQ2)};
        pg8::gemm_phase<pg8::EpiY, pg8::StaticOrder, true, true>(lds, g, S, E);
    }
    SEAM(7);
#ifndef REP8
#define REP8 1
#endif
    if (PH_LO <= 8 && 8 < PH_HI) REPEAT(REP8) { LAUNDER(); phase7(p, wid, lane); }
#undef SEAM
}
constexpr int NPH = 9;
#if MK_LAUNCHES == 1
__global__ void __launch_bounds__(512, 2) fwd_kernel(Params p) {
    extern __shared__ __attribute__((aligned(16))) unsigned char smem[];
    run_phases<0, NPH>(p, (LAS unsigned char*)smem);
}
#else
template <int PH>
__global__ void __launch_bounds__(512, 2) fwd_phase(Params p) {
    extern __shared__ __attribute__((aligned(16))) unsigned char smem[];
    run_phases<PH, PH + 1>(p, (LAS unsigned char*)smem);
}
template <int PH> static void launch_phase(const Params& p, int grid, hipStream_t stream) {
    static bool attr = false;
    if (!attr) { (void)hipFuncSetAttribute((const void*)fwd_phase<PH>, hipFuncAttributeMaxDynamicSharedMemorySize, LDS_BYTES); attr = true; }
    hipLaunchKernelGGL(fwd_phase<PH>, dim3(grid), dim3(512), LDS_BYTES, stream, p);
}
#endif

extern "C" void kernel_launch(void* const* d_in, const int* in_sizes, int n_in, void* d_out, int out_size, void* d_ws, size_t ws_size, hipStream_t stream) {
    static int grid = 0;
    if (grid == 0) {
        if (n_in != 17 || ws_size < WS_END) { fprintf(stderr, "kernel_launch: expected 17 inputs and >= %zu bytes of workspace (got %d, %zu)\n", (size_t)WS_END, n_in, ws_size); grid = -1; return; }
        int dev = 0, cus = 0, per_cu = 0;
        (void)hipGetDevice(&dev); (void)hipDeviceGetAttribute(&cus, hipDeviceAttributeMultiprocessorCount, dev);
#if MK_LAUNCHES == 1
        if (hipFuncSetAttribute((const void*)fwd_kernel, hipFuncAttributeMaxDynamicSharedMemorySize, LDS_BYTES) != hipSuccess) { fprintf(stderr, "kernel_launch: hipFuncSetAttribute failed\n"); grid = -1; return; }
        if (hipOccupancyMaxActiveBlocksPerMultiprocessor(&per_cu, (const void*)fwd_kernel, 512, LDS_BYTES) != hipSuccess || per_cu < 1) { fprintf(stderr, "kernel_launch: occupancy query says %d\n", per_cu); per_cu = 1; }
        (void)hipGetLastError();
#endif
        grid = cus > 0 ? cus : 256;
    }
    if (grid < 0) return;
    Params p{};
    for (int i = 0; i < 17; ++i) p.in[i] = (const float*)d_in[i];
    p.out = (float*)d_out; p.ws = (unsigned char*)d_ws;
#if MK_LAUNCHES == 1
    if (hipMemsetAsync(d_ws, 0, 16384, stream) != hipSuccess) { fprintf(stderr, "kernel_launch: hipMemsetAsync failed\n"); return; }
    void* args[] = {&p};
    const hipError_t e = hipLaunchCooperativeKernel((const void*)fwd_kernel, dim3(grid), dim3(512), args, LDS_BYTES, stream);
    if (e != hipSuccess) fprintf(stderr, "kernel_launch: cooperative launch failed: %s (grid %d)\n", hipGetErrorString(e), grid);
#else
    launch_phase<0>(p, grid, stream); launch_phase<1>(p, grid, stream); launch_phase<2>(p, grid, stream); launch_phase<3>(p, grid, stream); launch_phase<4>(p, grid, stream);
    launch_phase<5>(p, grid, stream); launch_phase<6>(p, grid, stream); launch_phase<7>(p, grid, stream); launch_phase<8>(p, grid, stream);
#endif
}
```

```cpp
#include <hip/hip_runtime.h>
#include <hip/hip_cooperative_groups.h>
#include <cstdio>
#include <cstdint>
namespace cg = cooperative_groups;
namespace pg8 {
#define PG8_LAS __attribute__((address_space(3)))
typedef unsigned short bf16_t;
typedef short bf16x8 __attribute__((ext_vector_type(8)));
typedef float f32x4 __attribute__((ext_vector_type(4)));
typedef unsigned u32x4 __attribute__((ext_vector_type(4)));
constexpr int BM = 256, BK = 64, HALF = 128, HTB = HALF * BK * 2  , STAGE_BYTES = 8 * HTB, NXCD = 8, WGM = 8;

__host__ __device__ __forceinline__ int lds_byte(int r, int c) { const int st = (r >> 4) * 2 + (c >> 5), rr = r & 15, cc = c & 31, ob = rr * 64 + cc * 2; return st * 1024 + (ob ^ (((ob >> 9) & 1) << 5)); }
__host__ __device__ __forceinline__ void stage_rc(int b, int& R, int& C) { const int st = b / 1024, sb = b % 1024, swz = sb ^ (((sb >> 9) & 1) << 5); R = (st >> 1) * 16 + swz / 64; C = (st & 1) * 32 + (swz % 64) / 2; }
__host__ __device__ __forceinline__ int perm32(int rho) { const int n = rho >> 4, i = rho & 15; return 8 * (i >> 2) + 4 * n + (i & 3); }

struct Unit { int pm, pn; };
struct Gemm { const bf16_t* A; const bf16_t* Bt; int M, N, K; };

struct StaticOrder {
    int nM, nN, nwg, G, c;
    __host__ __device__ void init(int M, int N, int G_, int c_) { nM = M / BM; nN = N / BM; nwg = nM * nN; G = G_; c = c_; }
    __host__ __device__ bool next(int i, Unit& u) const {
        const long L = (long)i * G + c; if (L >= nwg) return false;
        int wgid = (int)L; { const int q = nwg / NXCD, r = nwg % NXCD, xcd = wgid % NXCD, off = wgid / NXCD; wgid = (xcd < r ? xcd * (q + 1) : r * (q + 1) + (xcd - r) * q) + off; }
        const int nig = WGM * nN, gid = wgid / nig, fm = gid * WGM, gsz = (nM - fm) < WGM ? (nM - fm) : WGM;
        u.pm = fm + ((wgid % nig) % gsz); u.pn = (wgid % nig) / gsz; return true;
    }
    __device__ __forceinline__ void a_ready(const Unit&) const {}
    __device__ __forceinline__ void done(const Unit&) const {}
};
__device__ __forceinline__ unsigned cvt_pk_bf16(float lo, float hi) { unsigned r; asm volatile("v_cvt_pk_bf16_f32 %0, %1, %2" : "=v"(r) : "v"(lo), "v"(hi)); return r; }
__device__ __forceinline__ float dpp_shr1(float v) { return __builtin_bit_cast(float, __builtin_amdgcn_update_dpp(0, __builtin_bit_cast(int, v), 0x111, 0xf, 0xf, true)); }
__device__ __forceinline__ float dpp_shr2(float v) { return __builtin_bit_cast(float, __builtin_amdgcn_update_dpp(0, __builtin_bit_cast(int, v), 0x112, 0xf, 0xf, true)); }
__device__ __forceinline__ float dpp_shl15(float v) { return __builtin_bit_cast(float, __builtin_amdgcn_update_dpp(0, __builtin_bit_cast(int, v), 0x10F, 0xf, 0xf, true)); }
__device__ __forceinline__ float dpp_shl14(float v) { return __builtin_bit_cast(float, __builtin_amdgcn_update_dpp(0, __builtin_bit_cast(int, v), 0x10E, 0xf, 0xf, true)); }
__device__ __forceinline__ float gelu_tanh(float x) {
    const float z = 0.7978845608028654f * (x + 0.044715f * x * x * x);
    const float e = __builtin_amdgcn_exp2f(-2.8853900817779268f * z);
    return x * __builtin_amdgcn_rcpf(1.0f + e);
}
constexpr int TOKP = 32768;

struct EpiIn {
    static constexpr bool PERM = true, AFTER_DRAIN = false;
    bf16_t* P; const float* cosT; const float* sinT;
    __device__ __forceinline__ void operator()(const f32x4 (&acc)[2][2][4][2], const Unit& u, int wr, int wc, int fr, int fq) const {
        asm volatile("" : "+v"(fr), "+v"(fq));
        const int row0 = u.pm * BM + wr * 64 + fr, col0 = u.pn * BM + wc * 32 + 8 * fq;
        if (u.pn < 4) {
            const float sc = (u.pn >= 2) ? 0.08838834764831845f : 1.0f;
            const int f0 = 16 * wc + 4 * fq;
#pragma unroll
            for (int ai = 0; ai < 2; ++ai)
#pragma unroll
                for (int m = 0; m < 4; ++m) {
                    const int r = row0 + ai * HALF + m * 16;
                    const int pos = r < TOKP ? (r & 4095) : 4096 + ((r - TOKP) & 15);
                    const f32x4 c4 = *(const f32x4*)(cosT + pos * 64 + f0), s4 = *(const f32x4*)(sinT + pos * 64 + f0);
                    bf16_t* rowp = P + (size_t)r * 3584 + col0;
#pragma unroll
                    for (int bj = 0; bj < 2; ++bj) {
                        const f32x4 x1 = acc[ai][bj][m][0], x2 = acc[ai][bj][m][1];
                        const f32x4 o1 = (x1 * c4 - x2 * s4) * sc, o2 = (x2 * c4 + x1 * s4) * sc;
                        u32x4 w; w.x = cvt_pk_bf16(o1[0], o1[1]); w.y = cvt_pk_bf16(o1[2], o1[3]); w.z = cvt_pk_bf16(o2[0], o2[1]); w.w = cvt_pk_bf16(o2[2], o2[3]);
                        *(u32x4*)(rowp + bj * HALF) = w;
                    }
                }
        } else {
#pragma unroll
            for (int ai = 0; ai < 2; ++ai)
#pragma unroll
                for (int m = 0; m < 4; ++m) {
                    bf16_t* rowp = P + (size_t)(row0 + ai * HALF + m * 16) * 3584 + col0;
#pragma unroll
                    for (int bj = 0; bj < 2; ++bj) {
                        const f32x4 v0 = acc[ai][bj][m][0], v1 = acc[ai][bj][m][1];
                        u32x4 w; w.x = cvt_pk_bf16(v0[0], v0[1]); w.y = cvt_pk_bf16(v0[2], v0[3]); w.z = cvt_pk_bf16(v1[0], v1[1]); w.w = cvt_pk_bf16(v1[2], v1[3]);
                        *(u32x4*)(rowp + bj * HALF) = w;
                    }
                }
        }
    }
};

struct EpiY {
    static constexpr bool PERM = true, AFTER_DRAIN = false;
    bf16_t* Y; float* ssq;
    __device__ __forceinline__ void operator()(const f32x4 (&acc)[2][2][4][2], const Unit& u, int wr, int wc, int fr, int fq) const {
        asm volatile("" : "+v"(fr), "+v"(fq));
        const int row0 = u.pm * BM + wr * 64 + fr, col0 = u.pn * BM + wc * 32 + 8 * fq;
#pragma unroll
        for (int ai = 0; ai < 2; ++ai)
#pragma unroll
            for (int m = 0; m < 4; ++m) {
                const int r = row0 + ai * HALF + m * 16;
                bf16_t* rowp = Y + (size_t)r * 1024 + col0;
                float s = 0.f;
#pragma unroll
                for (int bj = 0; bj < 2; ++bj) {
                    const f32x4 v0 = acc[ai][bj][m][0], v1 = acc[ai][bj][m][1];
                    s += (v0[0] * v0[0] + v0[1] * v0[1]) + (v0[2] * v0[2] + v0[3] * v0[3]) + (v1[0] * v1[0] + v1[1] * v1[1]) + (v1[2] * v1[2] + v1[3] * v1[3]);
                    u32x4 w; w.x = cvt_pk_bf16(v0[0], v0[1]); w.y = cvt_pk_bf16(v0[2], v0[3]); w.z = cvt_pk_bf16(v1[0], v1[1]); w.w = cvt_pk_bf16(v1[2], v1[3]);
                    *(u32x4*)(rowp + bj * HALF) = w;
                }
                s += __shfl_xor(s, 16); s += __shfl_xor(s, 32);
                if (fq == 0) ssq[(size_t)r * 16 + u.pn * 4 + wc] = s;
            }
    }
};

struct EpiFfn {
    static constexpr bool PERM = true, AFTER_DRAIN = false;
    bf16_t* ACT; const float* cw; const float* cache; float* outp; float* outs; PG8_LAS float* halo;
    __device__ __forceinline__ void operator()(const f32x4 (&acc)[2][2][4][2], const Unit& u, int wr, int wc, int fr, int fq) const {
        asm volatile("" : "+v"(fr), "+v"(fq));
        const int lc0 = wc * 32 + 8 * fq, ch0 = u.pn * 128 + lc0;
        const bool sample = false;
        const int par = u.pm & 1;
        f32x4 w0[2], w1[2], w2[2];
#pragma unroll
        for (int n = 0; n < 2; ++n) { w0[n] = *(const f32x4*)(cw + ch0 + 4 * n); w1[n] = *(const f32x4*)(cw + 4096 + ch0 + 4 * n); w2[n] = *(const f32x4*)(cw + 8192 + ch0 + 4 * n); }
        if (!sample && fr >= 14) {
#pragma unroll
            for (int ai = 0; ai < 2; ++ai) { PG8_LAS float* hp = halo + ((par * 4 + 2 * ai + wr) * 2 + (fr - 14)) * 128 + lc0;
                *(PG8_LAS f32x4*)hp = acc[ai][0][3][0]; *(PG8_LAS f32x4*)(hp + 4) = acc[ai][0][3][1]; }
        }
        asm volatile("s_waitcnt lgkmcnt(0)" ::: "memory"); __builtin_amdgcn_s_barrier(); asm volatile("" ::: "memory");
#pragma unroll
        for (int ai = 0; ai < 2; ++ai) {
            const int blk = 2 * ai + wr;
#pragma unroll
            for (int m = 0; m < 4; ++m) {
                f32x4 pv[2]; pv[0] = (f32x4){0.f, 0.f, 0.f, 0.f}; pv[1] = pv[0];
                const int sb = 8 * ai + 4 * wr + m;
                if (sample) {
                    if (fr >= 14 && sb < 8) { const float* cp = cache + (size_t)(sb * 2 + fr - 14) * 4096 + ch0; pv[0] = *(const f32x4*)cp; pv[1] = *(const f32x4*)(cp + 4); }
                } else if (m == 0) {
                    if (fr >= 14) {
                        const bool zero = (blk == 0) && ((u.pm & 15) == 0);
                        const int hb = (blk == 0) ? ((par ^ 1) * 4 + 3) : (par * 4 + blk - 1);
                        if (!zero) { const PG8_LAS float* hp = halo + (hb * 2 + fr - 14) * 128 + lc0; pv[0] = *(const PG8_LAS f32x4*)hp; pv[1] = *(const PG8_LAS f32x4*)(hp + 4); }
                    }
                } else { pv[0] = acc[ai][0][m - 1][0]; pv[1] = acc[ai][0][m - 1][1]; }
                const int r = u.pm * BM + ai * HALF + wr * 64 + m * 16 + fr;
                float a8[8];
#pragma unroll
                for (int n = 0; n < 2; ++n)
#pragma unroll
                    for (int e = 0; e < 4; ++e) {
                        const float cur = acc[ai][0][m][n][e], pr = pv[n][e];
                        const float p1 = dpp_shr1(cur) + dpp_shl15(pr), p2 = dpp_shr2(cur) + dpp_shl14(pr);
                        const float uc = w0[n][e] * p2 + w1[n][e] * p1 + w2[n][e] * cur;
                        a8[4 * n + e] = gelu_tanh(uc) * acc[ai][1][m][n][e];
                    }
                u32x4 w; w.x = cvt_pk_bf16(a8[0], a8[1]); w.y = cvt_pk_bf16(a8[2], a8[3]); w.z = cvt_pk_bf16(a8[4], a8[5]); w.w = cvt_pk_bf16(a8[6], a8[7]);
                *(u32x4*)(ACT + (size_t)r * 4096 + ch0) = w;
                if (sample) {
                    if (fr >= 14 && sb < 8) { float* op = outs + (size_t)(sb * 2 + fr - 14) * 4096 + ch0; *(f32x4*)op = acc[ai][0][m][0]; *(f32x4*)(op + 4) = acc[ai][0][m][1]; }
                } else if (m == 3 && blk == 3 && (u.pm & 15) == 15 && fr >= 14) {
                    float* op = outp + (size_t)((u.pm >> 4) * 2 + fr - 14) * 4096 + ch0; *(f32x4*)op = acc[ai][0][m][0]; *(f32x4*)(op + 4) = acc[ai][0][m][1];
                }
            }
        }
    }
};
struct WalkOrder {
    int G, c;
    __device__ __forceinline__ bool next(int i, Unit& u) const {
        int w = c, rem = i;
        while (w < 256) { const int len = 16;
            if (rem < len) { if (w < 256) { u.pm = (w >> 5) * 16 + rem; u.pn = w & 31; } else { u.pm = 128; u.pn = w - 256; } return true; }
            rem -= len; w += G; }
        return false;
    }
    __device__ __forceinline__ void a_ready(const Unit&) const {}
    __device__ __forceinline__ void done(const Unit&) const {}
};
template <class Epi, class Sched, bool ALIGN_EPI = false, bool SP2 = false>
__device__ __forceinline__ void gemm_phase(PG8_LAS unsigned char* lds, const Gemm g, const Sched& S, const Epi& E) {
    int tid_raw = threadIdx.x; asm volatile("" : "+v"(tid_raw));
    const int tid = tid_raw, wid = __builtin_amdgcn_readfirstlane(tid >> 6), lane = tid & 63, wr = wid >> 2, wc = wid & 3, fr = lane & 15, fq = lane >> 4;
    const int K = g.K, nt = K / BK;
    unsigned voffA[2], voffB[2];
#pragma unroll
    for (int i = 0; i < 2; ++i) { int R, C; stage_rc(tid * 16 + i * 8192, R, C); const int Rb = Epi::PERM ? ((R & ~31) + perm32(R & 31)) : R;
        voffA[i] = (unsigned)(R * K + C) * 2u; voffB[i] = (unsigned)(Rb * K + C) * 2u; }
    const size_t kstep = (size_t)(BK * 2);
    const size_t hstep = (size_t)HALF * K * 2;
    const size_t tstep = 2 * hstep;
    const unsigned ldsw = (unsigned)wid * 1024u;
    const int aoff = lds_byte(wr * 64 + fr, fq * 8), boff = lds_byte(wc * 32 + fr, fq * 8);
#define PG8_SA(b, h) (((b) * 2 + (h)) * HTB)
#define PG8_SB(b, h) ((4 + (b) * 2 + (h)) * HTB)
#define PG8_STAGE(bufoff, gbase, voff) do { _Pragma("unroll") for (int _i = 0; _i < 2; ++_i) \
        __builtin_amdgcn_global_load_lds((const unsigned*)((const char*)(gbase) + (voff)[_i]), (PG8_LAS unsigned*)(lds + (bufoff) + ldsw + _i * 8192), 16, 0, 0); } while (0)
#define PG8_LDA(dst, b, h) do { _Pragma("unroll") for (int m = 0; m < 4; ++m) _Pragma("unroll") for (int k = 0; k < 2; ++k) dst[m][k] = *(const PG8_LAS bf16x8*)(lds + PG8_SA(b, h) + aoff + m * 2048 + k * 1024); } while (0)
#define PG8_LDB(dst, b, h) do { _Pragma("unroll") for (int n = 0; n < 2; ++n) _Pragma("unroll") for (int k = 0; k < 2; ++k) dst[n][k] = *(const PG8_LAS bf16x8*)(lds + PG8_SB(b, h) + boff + n * 2048 + k * 1024); } while (0)
#define PG8_MMA(ai, bj, At, Bt) do { __builtin_amdgcn_s_setprio(1); _Pragma("unroll") for (int m = 0; m < 4; ++m) _Pragma("unroll") for (int n = 0; n < 2; ++n) _Pragma("unroll") for (int k = 0; k < 2; ++k) \
        acc[ai][bj][m][n] = __builtin_amdgcn_mfma_f32_16x16x32_bf16(Bt[n][k], At[m][k], acc[ai][bj][m][n], 0, 0, 0); __builtin_amdgcn_s_setprio(0); } while (0)
#define PG8_WAIT_V(n) asm volatile("s_waitcnt vmcnt(" #n ")" ::: "memory")
#define PG8_WAIT_L(n) asm volatile("s_waitcnt lgkmcnt(" #n ")" ::: "memory")
#define PG8_BAR __builtin_amdgcn_s_barrier()
#define PG8_SCHED __builtin_amdgcn_sched_barrier(0)
    Unit cur, nxt; int ui = 0;
    if (!S.next(0, cur)) return;
    f32x4 acc[2][2][4][2];
#pragma unroll
    for (int a = 0; a < 2; ++a)
#pragma unroll
        for (int b = 0; b < 2; ++b)
#pragma unroll
            for (int m = 0; m < 4; ++m)
#pragma unroll
                for (int n = 0; n < 2; ++n) acc[a][b][m][n] = (f32x4){0.f, 0.f, 0.f, 0.f};
    bf16x8 At[4][2], B0[2][2], B1[2][2];
    const char* cA = (const char*)g.A + (size_t)cur.pm * tstep; const char* cB = (const char*)g.Bt + (size_t)cur.pn * tstep;
    S.a_ready(cur);
    if constexpr (SP2) {
        PG8_STAGE(PG8_SB(0, 0), cB, voffB); PG8_STAGE(PG8_SB(0, 1), cB + hstep, voffB); PG8_STAGE(PG8_SA(0, 0), cA, voffA); PG8_STAGE(PG8_SA(0, 1), cA + hstep, voffA);
        if (wr == 1) PG8_BAR;
        PG8_WAIT_V(2); PG8_BAR;
        PG8_STAGE(PG8_SB(1, 0), cB + kstep, voffB); PG8_STAGE(PG8_SA(1, 0), cA + kstep, voffA); PG8_STAGE(PG8_SB(1, 1), cB + hstep + kstep, voffB);
        PG8_WAIT_V(6); PG8_BAR;
    } else {
        PG8_STAGE(PG8_SB(0, 0), cB, voffB); PG8_STAGE(PG8_SA(0, 0), cA, voffA); PG8_STAGE(PG8_SB(0, 1), cB + hstep, voffB); PG8_STAGE(PG8_SA(0, 1), cA + hstep, voffA);
        if (wr == 1) PG8_BAR;
        PG8_WAIT_V(4); PG8_BAR;
        PG8_STAGE(PG8_SB(1, 0), cB + kstep, voffB); PG8_STAGE(PG8_SA(1, 0), cA + kstep, voffA); PG8_STAGE(PG8_SB(1, 1), cB + hstep + kstep, voffB);
        PG8_WAIT_V(6); PG8_BAR;
    }
    for (;;) {
        const bool has_next = S.next(ui + 1, nxt);
        const char* nA = has_next ? (const char*)g.A + (size_t)nxt.pm * tstep : cA; const char* nB = has_next ? (const char*)g.Bt + (size_t)nxt.pn * tstep : cB;
        for (int t = 0; t < nt; t += 2) {
            const bool last = (t == nt - 2);
            const char* a1 = cA + (size_t)(t + 1) * kstep;
            const char* a2 = last ? nA : cA + (size_t)(t + 2) * kstep; const char* b2 = last ? nB : cB + (size_t)(t + 2) * kstep;
            const char* a3 = a2 + kstep; const char* b3 = b2 + kstep;
            if (last && has_next) S.a_ready(nxt);
            if constexpr (SP2) {
            PG8_LDB(B0, 0, 0); PG8_LDB(B1, 0, 1); PG8_SCHED; PG8_LDA(At, 0, 0); PG8_STAGE(PG8_SA(1, 1), a1 + hstep, voffA);
            PG8_WAIT_V(8); PG8_WAIT_L(0); PG8_BAR; PG8_MMA(0, 0, At, B0); PG8_MMA(0, 1, At, B1); PG8_BAR; PG8_SCHED;
            PG8_LDA(At, 0, 1); PG8_STAGE(PG8_SB(0, 0), b2, voffB); PG8_STAGE(PG8_SB(0, 1), b2 + hstep, voffB); PG8_STAGE(PG8_SA(0, 0), a2, voffA);
            PG8_WAIT_V(8); PG8_WAIT_L(0); PG8_BAR; PG8_MMA(1, 0, At, B0); PG8_MMA(1, 1, At, B1); PG8_BAR; PG8_SCHED;
            PG8_LDB(B0, 1, 0); PG8_LDB(B1, 1, 1); PG8_SCHED; PG8_LDA(At, 1, 0); PG8_STAGE(PG8_SA(0, 1), a2 + hstep, voffA);
            PG8_WAIT_V(8); PG8_WAIT_L(0); PG8_BAR; PG8_MMA(0, 0, At, B0); PG8_MMA(0, 1, At, B1); PG8_BAR; PG8_SCHED;
            PG8_LDA(At, 1, 1); PG8_STAGE(PG8_SB(1, 0), b3, voffB); PG8_STAGE(PG8_SB(1, 1), b3 + hstep, voffB); PG8_STAGE(PG8_SA(1, 0), a3, voffA);
            PG8_WAIT_V(8); PG8_WAIT_L(0); PG8_BAR; PG8_MMA(1, 0, At, B0); PG8_MMA(1, 1, At, B1); PG8_BAR; PG8_SCHED;
            } else {
            PG8_LDB(B0, 0, 0); PG8_SCHED; PG8_LDA(At, 0, 0); PG8_STAGE(PG8_SA(1, 1), a1 + hstep, voffA);
            PG8_WAIT_L(8); PG8_BAR; PG8_WAIT_L(0); PG8_MMA(0, 0, At, B0); PG8_BAR; PG8_SCHED;
            PG8_LDB(B1, 0, 1); PG8_STAGE(PG8_SB(0, 0), b2, voffB);
            PG8_BAR; PG8_WAIT_L(0); PG8_MMA(0, 1, At, B1); PG8_BAR;
            PG8_LDA(At, 0, 1); PG8_STAGE(PG8_SA(0, 0), a2, voffA);
            PG8_BAR; PG8_WAIT_L(0); PG8_MMA(1, 0, At, B0); PG8_BAR; PG8_SCHED;
            PG8_STAGE(PG8_SB(0, 1), b2 + hstep, voffB);
            PG8_WAIT_V(6); PG8_BAR; PG8_MMA(1, 1, At, B1); PG8_BAR;
            PG8_LDB(B0, 1, 0); PG8_SCHED; PG8_LDA(At, 1, 0); PG8_STAGE(PG8_SA(0, 1), a2 + hstep, voffA);
            PG8_WAIT_L(8); PG8_BAR; PG8_WAIT_L(0); PG8_MMA(0, 0, At, B0); PG8_BAR; PG8_SCHED;
            PG8_LDB(B1, 1, 1); PG8_STAGE(PG8_SB(1, 0), b3, voffB);
            PG8_BAR; PG8_WAIT_L(0); PG8_MMA(0, 1, At, B1); PG8_BAR;
            PG8_LDA(At, 1, 1); PG8_STAGE(PG8_SA(1, 0), a3, voffA);
            PG8_BAR; PG8_WAIT_L(0); PG8_MMA(1, 0, At, B0); PG8_BAR; PG8_SCHED;
            PG8_STAGE(PG8_SB(1, 1), b3 + hstep, voffB);
            PG8_WAIT_V(6); PG8_BAR; PG8_MMA(1, 1, At, B1); PG8_BAR;
            }
        }
        if constexpr (ALIGN_EPI) { if (wr == 0) PG8_BAR; }
        if constexpr (!Epi::AFTER_DRAIN) { E(acc, cur, wr, wc, fr, fq); S.done(cur); }
        if (!has_next) break;
#pragma unroll
        for (int a = 0; a < 2; ++a)
#pragma unroll
            for (int b = 0; b < 2; ++b)
#pragma unroll
                for (int m = 0; m < 4; ++m)
#pragma unroll
                    for (int n = 0; n < 2; ++n) acc[a][b][m][n] = (f32x4){0.f, 0.f, 0.f, 0.f};
        cur = nxt; cA = nA; cB = nB; ++ui;
        if constexpr (ALIGN_EPI) { if (wr == 1) PG8_BAR; }
    }
    PG8_WAIT_V(0);
    if constexpr (!ALIGN_EPI) { if (wr == 0) PG8_BAR; }
    PG8_BAR;
    if constexpr (Epi::AFTER_DRAIN) { E.fused(acc, cur, wr, wc, fr, fq, lds, wid, lane); S.done(cur); }
#undef PG8_SA
#undef PG8_SB
#undef PG8_STAGE
#undef PG8_LDA
#undef PG8_LDB
#undef PG8_MMA
#undef PG8_WAIT_V
#undef PG8_WAIT_L
#undef PG8_BAR
#undef PG8_SCHED
}
}

using pg8::bf16_t; using pg8::bf16x8; using pg8::f32x4; using pg8::u32x4;
#define LAS __attribute__((address_space(3)))
typedef unsigned u32x2 __attribute__((ext_vector_type(2)));
constexpr int DM = 1024, NIN = 3584, DFF = 4096;
constexpr int TOK_P = 32768, TOK = 32896, TOKPAD = 33024;
constexpr float EPS = 1e-6f;
constexpr size_t WS_WIN = 16384;
constexpr size_t WS_WOUT = WS_WIN + (size_t)NIN * DM * 2;
constexpr size_t WS_WFF1 = WS_WOUT + (size_t)DM * DM * 2;
constexpr size_t WS_WDN = WS_WFF1 + (size_t)2 * DFF * DM * 2;
constexpr size_t WS_COS = WS_WDN + (size_t)DM * DFF * 2;
constexpr size_t WS_SIN = WS_COS + (size_t)4112 * 64 * 4;
constexpr size_t WS_SSQ1 = WS_SIN + (size_t)4112 * 64 * 4;
constexpr size_t WS_SSQ2 = WS_SSQ1 + (size_t)TOKPAD * 16 * 4;
constexpr size_t WS_UG = WS_SSQ2 + (size_t)TOKPAD * 16 * 4;
constexpr size_t WS_PS = WS_UG + (size_t)256 * 65536;
constexpr size_t WS_YS = WS_PS + (size_t)128 * NIN * 4;
constexpr size_t WS_FS = WS_YS + (size_t)4 * 128 * DM * 4;
constexpr size_t WS_RA = WS_FS + (size_t)4 * 128 * DM * 4;
constexpr size_t WS_RB = WS_RA + (size_t)TOKPAD * DM * 2;
constexpr size_t WS_Y = WS_RB + (size_t)TOKPAD * DFF * 2;
constexpr size_t WS_END = WS_Y + (size_t)TOK_P * DM * 2;
constexpr size_t O_SRP = (size_t)TOK * DM, O_CCP = O_SRP + 524288, O_CFP = O_CCP + 8192, O_SRS = O_CFP + 65536, O_CCS = O_SRS + 524288, O_CFS = O_CCS + 8192;
constexpr int LDS_HALO = 131072, LDS_BARW = 131072 + 8192, LDS_BYTES = LDS_BARW + 16;

struct Params { const float* in[17]; float* out; unsigned char* ws; };

__device__ __forceinline__ float dppf(float v, const int ctrl_sel) {
    const int iv = __builtin_bit_cast(int, v); int r;
    switch (ctrl_sel) { case 1: r = __builtin_amdgcn_update_dpp(0, iv, 0x111, 0xf, 0xf, true); break; case 2: r = __builtin_amdgcn_update_dpp(0, iv, 0x112, 0xf, 0xf, true); break;
        case 4: r = __builtin_amdgcn_update_dpp(0, iv, 0x114, 0xf, 0xf, true); break; case 8: r = __builtin_amdgcn_update_dpp(0, iv, 0x118, 0xf, 0xf, true); break;
        case 15: r = __builtin_amdgcn_update_dpp(0, iv, 0x142, 0xa, 0xf, false); break; default: r = __builtin_amdgcn_update_dpp(0, iv, 0x143, 0xc, 0xf, false); break; }
    return __builtin_bit_cast(float, r);
}
__device__ __forceinline__ float wave_sum(float v) {
    v += dppf(v, 1); v += dppf(v, 2); v += dppf(v, 4); v += dppf(v, 8); v += dppf(v, 15); v += dppf(v, 31);
    return __builtin_bit_cast(float, __builtin_amdgcn_readlane(__builtin_bit_cast(int, v), 63));
}
__device__ __forceinline__ float bf2f(unsigned short b) { return __uint_as_float(((unsigned)b) << 16); }
__device__ __forceinline__ unsigned pk2(float a, float b) { return pg8::cvt_pk_bf16(a, b); }
__device__ __forceinline__ unsigned pk2s(float a, float b) { unsigned r; asm("v_cvt_pk_bf16_f32 %0, %1, %2" : "=v"(r) : "v"(a), "v"(b)); return r; }
__device__ __forceinline__ float silu_f(float g) { return g * __builtin_amdgcn_rcpf(1.0f + __builtin_amdgcn_exp2f(-1.4426950408889634f * g)); }
__device__ __forceinline__ int dmap(int P) { return ((P >> 2) & 1) * 64 + (P >> 3) * 4 + (P & 3); }
__device__ __forceinline__ int pmap(int d) { return ((d >> 4) & 3) * 32 + ((d >> 2) & 3) * 8 + ((d >> 6) & 1) * 4 + (d & 3); }

constexpr int RB = 6;
__device__ __forceinline__ f32x4 unpack_bf4(const u32x2 w) { f32x4 v; v[0] = __uint_as_float(w.x << 16); v[1] = __uint_as_float(w.x & 0xffff0000u); v[2] = __uint_as_float(w.y << 16); v[3] = __uint_as_float(w.y & 0xffff0000u); return v; }
__device__ __forceinline__ float sumsq4(const f32x4 a) { return (a[0] * a[0] + a[1] * a[1]) + (a[2] * a[2] + a[3] * a[3]); }
template <int MODE> __device__ __forceinline__ int rowmap(int c) {
    if (MODE == 0) { if (c < 1024) return (c & ~127) + pmap(c & 127); return c; }
    if (MODE == 1) return c;
    if (MODE == 2) return ((c >> 7) << 8) + (c & 127);
    return ((c >> 7) << 8) + 128 + (c & 127);
}
template <int MODE>
__device__ __forceinline__ void transpose_item(const float* W, int K, int N, bf16_t* WT, LAS float* scr, int item, int lane) {
    const int nblk = N / 32, kb = item / nblk, nb = item % nblk, k0 = 64 * kb, n0 = 32 * nb;
#pragma unroll
    for (int i = 0; i < 32; ++i) { const int kk = 2 * i + (lane >> 5); scr[kk * 33 + (lane & 31)] = W[(size_t)(k0 + kk) * N + n0 + (lane & 31)]; }
    asm volatile("s_waitcnt lgkmcnt(0)" ::: "memory");
    const int c = lane & 7;
#pragma unroll
    for (int j = 0; j < 4; ++j) { const int n = (lane >> 3) + 8 * j; const LAS float* s = scr + (8 * c) * 33 + n;
        u32x4 o; o.x = pk2(s[0 * 33], s[1 * 33]); o.y = pk2(s[2 * 33], s[3 * 33]); o.z = pk2(s[4 * 33], s[5 * 33]); o.w = pk2(s[6 * 33], s[7 * 33]);
        *(u32x4*)(WT + (size_t)rowmap<MODE>(n0 + n) * K + k0 + 8 * c) = o; }
    asm volatile("s_waitcnt lgkmcnt(0)" ::: "memory");
}
__device__ __forceinline__ void phase0(const Params& p, LAS unsigned char* lds, int tid, int wid, int lane) {
    LAS float* scr = (LAS float*)(lds + wid * 8448);
    const int gw = blockIdx.x * 8 + wid, NGW = gridDim.x * 8;
    bf16_t* win = (bf16_t*)(p.ws + WS_WIN); bf16_t* wout = (bf16_t*)(p.ws + WS_WOUT); bf16_t* wff1 = (bf16_t*)(p.ws + WS_WFF1); bf16_t* wdn = (bf16_t*)(p.ws + WS_WDN);
    constexpr int I_IN = 16 * 112, I_OUT = 16 * 32, I_UP = 16 * 128, I_DN = 64 * 32, NITEMS = I_IN + I_OUT + 2 * I_UP + I_DN;
    for (int it = gw; it < NITEMS; it += NGW) {
        int r = it;
        if (r < I_IN) { transpose_item<0>(p.in[5], DM, NIN, win, scr, r, lane); continue; } r -= I_IN;
        if (r < I_OUT) { transpose_item<1>(p.in[6], DM, DM, wout, scr, r, lane); continue; } r -= I_OUT;
        if (r < I_UP) { transpose_item<2>(p.in[13], DM, DFF, wff1, scr, r, lane); continue; } r -= I_UP;
        if (r < I_UP) { transpose_item<3>(p.in[14], DM, DFF, wff1, scr, r, lane); continue; } r -= I_UP;
        transpose_item<1>(p.in[16], DFF, DM, wdn, scr, r, lane);
    }
    float* cosT = (float*)(p.ws + WS_COS); float* sinT = (float*)(p.ws + WS_SIN);
    for (int idx = blockIdx.x * 512 + tid; idx < 4112 * 64; idx += gridDim.x * 512) {
        const int pos = idx >> 6, f = idx & 63;
        const float inv = exp2f(-(float)(2 * f) * (1.0f / 128.0f) * 13.287712379549449f);
        const float ang = (float)pos * inv;
        const double rev = (double)ang * 0.15915494309189535;
        const float fr = (float)(rev - floor(rev));
        cosT[idx] = __builtin_amdgcn_cosf(fr); sinT[idx] = __builtin_amdgcn_sinf(fr);
    }
    bf16_t* H = (bf16_t*)(p.ws + WS_RA);
    const float* wpre = p.in[9];
    f32x4 wpr[4];
#pragma unroll
    for (int j = 0; j < 4; ++j) wpr[j] = *((const f32x4*)wpre + lane + 64 * j);
#pragma unroll 1
    for (int base = gw; base < TOK; base += RB * NGW) {
        f32x4 v[RB][4]; float s[RB];
#pragma unroll
        for (int k = 0; k < RB; ++k) { const int rr = min(base + k * NGW, TOK - 1);
            const float* xrow = rr < TOK_P ? p.in[0] + (size_t)rr * DM : p.in[1] + (size_t)(rr - TOK_P) * DM; s[k] = 0.f;
#pragma unroll
            for (int j = 0; j < 4; ++j) { v[k][j] = __builtin_nontemporal_load((const f32x4*)xrow + lane + 64 * j); s[k] += sumsq4(v[k][j]); } }
#pragma unroll
        for (int k = 0; k < RB; ++k) { const int r = base + k * NGW; const float rstd = rsqrtf(wave_sum(s[k]) * (1.0f / DM) + EPS);
            if (r < TOK) {
#pragma unroll
                for (int j = 0; j < 4; ++j) { const f32x4 y = (v[k][j] * rstd) * wpr[j];
                    __builtin_nontemporal_store((u32x2){pk2(y[0], y[1]), pk2(y[2], y[3])}, (u32x2*)(H + (size_t)r * DM) + lane + 64 * j); } } }
    }
}

constexpr int QI_OFF = 0, KI_OFF = 17408, KT_OFF = 34816, VT_OFF = 53248, SI_OFF = 71680, ST_OFF = 80896, GI_OFF = 115712;
#define MFMA16(a, b, c) __builtin_amdgcn_mfma_f32_16x16x32_bf16((a), (b), (c), 0, 0, 0)
#define RET_ISSUE(S, nn) do { _Pragma("unroll") for (int i_ = 0; i_ < 2; ++i_) { \
        const bf16_t* rowp_ = P + (tok0 + (size_t)(nn) * 64 + 2 * (tid >> 4) + i_) * NIN + 128 * h + (tid & 15) * 8; \
        if (FULL) { rq[S][i_] = *(const u32x4*)rowp_; rg[S][i_] = *(const u32x4*)(rowp_ + 1536); } rk[S][i_] = *(const u32x4*)(rowp_ + 512); rv[S][i_] = *(const u32x4*)(rowp_ + 1024); } } while (0)
#define RET_STAGE_A(S) do { const int j_ = 2 * (tid >> 4), ch_ = tid & 15; \
        if (FULL) { _Pragma("unroll") for (int i_ = 0; i_ < 2; ++i_) { *(LAS u32x4*)(lds + QI_OFF + (j_ + i_) * 272 + ch_ * 16) = rq[S][i_]; *(LAS u32x4*)(lds + KI_OFF + (j_ + i_) * 272 + ch_ * 16) = rk[S][i_]; *(LAS u32x4*)(lds + GI_OFF + (j_ + i_) * 272 + ch_ * 16) = rg[S][i_]; } } \
        const float te0_ = __builtin_amdgcn_exp2f(l2g * (float)(63 - j_)), te1_ = __builtin_amdgcn_exp2f(l2g * (float)(62 - j_)); \
        const unsigned ka_[4] = {rk[S][0].x, rk[S][0].y, rk[S][0].z, rk[S][0].w}, kb_[4] = {rk[S][1].x, rk[S][1].y, rk[S][1].z, rk[S][1].w}; \
        const unsigned va_[4] = {rv[S][0].x, rv[S][0].y, rv[S][0].z, rv[S][0].w}, vb_[4] = {rv[S][1].x, rv[S][1].y, rv[S][1].z, rv[S][1].w}; \
        const int cofs_ = 16 * ((j_ >> 3) ^ (ch_ & 7)) + 2 * (j_ & 7); \
        _Pragma("unroll") for (int e2 = 0; e2 < 4; ++e2) { const int row_ = 8 * ch_ + 2 * e2; \
            *(LAS unsigned*)(lds + KT_OFF + row_ * 144 + cofs_) = pk2(__uint_as_float(ka_[e2] << 16) * te0_, __uint_as_float(kb_[e2] << 16) * te1_); \
            *(LAS unsigned*)(lds + KT_OFF + (row_ + 1) * 144 + cofs_) = pk2(__uint_as_float(ka_[e2] & 0xffff0000u) * te0_, __uint_as_float(kb_[e2] & 0xffff0000u) * te1_); \
            *(LAS unsigned*)(lds + VT_OFF + row_ * 144 + cofs_) = (va_[e2] & 0xffffu) | (vb_[e2] << 16); \
            *(LAS unsigned*)(lds + VT_OFF + (row_ + 1) * 144 + cofs_) = (va_[e2] >> 16) | (vb_[e2] & 0xffff0000u); } } while (0)
#define WG_BAR() do { asm volatile("s_waitcnt lgkmcnt(0)" ::: "memory"); __builtin_amdgcn_s_barrier(); asm volatile("" ::: "memory"); } while (0)
template <bool FULL>
__device__ __forceinline__ void ret_unit(const Params& p, LAS unsigned char* lds, int unit, int tid, int wid, int lane) {
    asm volatile("" : "+v"(tid), "+v"(lane));
    const int G = unit & 7, h = (unit >> 3) & 3, b = unit >> 5;
    const bf16_t* P = (const bf16_t*)(p.ws + WS_RB);
    bf16_t* MIX = (bf16_t*)(p.ws + WS_RA);
    float* UG = (float*)(p.ws + WS_UG);
    const size_t tok0 = (size_t)b * 4096 + (size_t)G * 512;
    const float l2g = log2f(1.0f - exp2f(-5.0f - (float)h));
    const float g64 = __builtin_amdgcn_exp2f(l2g * 64.0f);
    const bool is_state = wid >= 4; const int w4 = wid & 3;
    const int l15 = lane & 15, l4 = lane >> 4;
    const int vtL = l4 ^ (l15 >> 3);
    const int vtb0 = VT_OFF + l15 * 144 + 16 * vtL, vtb1 = VT_OFF + l15 * 144 + 16 * (vtL ^ 2);
#define VT_ADDR(nt, ks) ((((nt) & 1) ? vtb1 : vtb0) + (nt) * 2304 + 16 * (((4 * (ks)) ^ (2 * ((nt) & 3))) & 4))
    constexpr int PD = FULL ? 1 : 4;
    u32x4 rq[PD][2], rk[PD][2], rv[PD][2], rg[PD][2];
    if (is_state) {
        f32x4 st[2][8];
#pragma unroll
        for (int mt = 0; mt < 2; ++mt)
#pragma unroll
            for (int nt = 0; nt < 8; ++nt) st[mt][nt] = (f32x4){0.f, 0.f, 0.f, 0.f};
        if (FULL) {
#pragma unroll 1
            for (int Gp = 0; Gp < G; Gp += 2) {
                const float wa = __builtin_amdgcn_exp2f(l2g * 512.0f * (float)(G - 1 - Gp));
                const bool two = Gp + 1 < G;
                const float wb = two ? __builtin_amdgcn_exp2f(l2g * 512.0f * (float)(G - 2 - Gp)) : 0.f;
                const float* sa = UG + ((size_t)((b * 4 + h) * 8 + Gp) * 4 + w4) * 4096 + lane;
                const float* sb = two ? sa + 4 * 4096 : sa;
#pragma unroll
                for (int mt = 0; mt < 2; ++mt)
#pragma unroll
                    for (int nt = 0; nt < 8; ++nt)
#pragma unroll
                        for (int r = 0; r < 4; ++r) st[mt][nt][r] += wa * sa[((mt * 8 + nt) * 4 + r) * 64] + wb * sb[((mt * 8 + nt) * 4 + r) * 64];
            }
        }
#pragma unroll
        for (int s = 0; s < PD; ++s) RET_ISSUE(s, s);
#pragma unroll 1
        for (int n0 = 0; n0 < 8; n0 += PD) {
#pragma unroll
          for (int s = 0; s < PD; ++s) { const int n = n0 + s;
            RET_STAGE_A(s);
            if (n + PD < 8) RET_ISSUE(s, n + PD);
            if (FULL) {
#pragma unroll
                for (int mt = 0; mt < 2; ++mt)
#pragma unroll
                    for (int nt = 0; nt < 8; ++nt) { const int e = 16 * nt + l15, dk0 = 32 * w4 + 16 * mt + 4 * l4;
                        *(LAS u32x2*)(lds + ST_OFF + e * 272 + dk0 * 2) = (u32x2){pk2(st[mt][nt][0], st[mt][nt][1]), pk2(st[mt][nt][2], st[mt][nt][3])}; }
            }
            WG_BAR();
            if (FULL) {
                bf16x8 ak[4];
#pragma unroll
                for (int ks = 0; ks < 4; ++ks) ak[ks] = *(const LAS bf16x8*)(lds + KI_OFF + (16 * w4 + l15) * 272 + (32 * ks + 8 * l4) * 2);
#pragma unroll
                for (int it = 0; it < 4; ++it) {
                    bf16x8 bq[4];
#pragma unroll
                    for (int ks = 0; ks < 4; ++ks) bq[ks] = *(const LAS bf16x8*)(lds + QI_OFF + (16 * it + l15) * 272 + (32 * ks + 8 * l4) * 2);
                    f32x4 sa = (f32x4){0.f, 0.f, 0.f, 0.f};
#pragma unroll
                    for (int ks = 0; ks < 4; ++ks) sa = MFMA16(ak[ks], bq[ks], sa);
                    const int i = 16 * it + l15, j0 = 16 * w4 + 4 * l4;
#pragma unroll
                    for (int r = 0; r < 4; ++r) { const int d = i - (j0 + r); sa[r] *= __builtin_amdgcn_exp2f(l2g * (float)(d < 0 ? -d : d)); }
                    *(LAS u32x2*)(lds + SI_OFF + i * 144 + j0 * 2) = (u32x2){pk2(sa[0], sa[1]), pk2(sa[2], sa[3])};
                }
            }
            WG_BAR();
#pragma unroll
            for (int mt = 0; mt < 2; ++mt)
#pragma unroll
                for (int nt = 0; nt < 8; ++nt) st[mt][nt] = st[mt][nt] * g64;
#pragma unroll
            for (int ks = 0; ks < 2; ++ks) {
                bf16x8 akt[2];
#pragma unroll
                for (int mt = 0; mt < 2; ++mt) { const int row = 32 * w4 + 16 * mt + l15; akt[mt] = *(const LAS bf16x8*)(lds + KT_OFF + row * 144 + 16 * ((4 * ks + l4) ^ ((row >> 3) & 7))); }
#pragma unroll
                for (int nh = 0; nh < 2; ++nh) {
                    bf16x8 bv[4];
#pragma unroll
                    for (int nt = 0; nt < 4; ++nt) bv[nt] = *(const LAS bf16x8*)(lds + VT_ADDR(4 * nh + nt, ks));
#pragma unroll
                    for (int nt = 0; nt < 4; ++nt)
#pragma unroll
                        for (int mt = 0; mt < 2; ++mt) st[mt][4 * nh + nt] = MFMA16(akt[mt], bv[nt], st[mt][4 * nh + nt]);
                }
            }
            WG_BAR();
          }
        }
        if (!FULL) {
            float* dst = UG + ((size_t)unit * 4 + w4) * 4096 + lane;
#pragma unroll
            for (int mt = 0; mt < 2; ++mt)
#pragma unroll
                for (int nt = 0; nt < 8; ++nt)
#pragma unroll
                    for (int r = 0; r < 4; ++r) dst[((mt * 8 + nt) * 4 + r) * 64] = st[mt][nt][r];
        } else if (G == 7) {
            float* o = p.out + O_SRP + (size_t)(b * 4 + h) * 16384 + (64 * (l4 & 1) + 16 * w4 + 4 * (l4 >> 1)) * 128 + l15;
#pragma unroll
            for (int mt = 0; mt < 2; ++mt)
#pragma unroll
                for (int nt = 0; nt < 8; ++nt)
#pragma unroll
                    for (int r = 0; r < 4; ++r) o[(8 * mt + r) * 128 + 16 * nt] = st[mt][nt][r];
        }
    } else {
        float rwv[8];
#pragma unroll
        for (int nt = 0; nt < 8; ++nt) rwv[nt] = p.in[8][128 * h + 16 * nt + l15];
#pragma unroll
        for (int s = 0; s < PD; ++s) RET_ISSUE(s, s);
#pragma unroll 1
        for (int n0 = 0; n0 < 8; n0 += PD) {
#pragma unroll
          for (int s = 0; s < PD; ++s) { const int n = n0 + s;
            RET_STAGE_A(s);
            if (n + PD < 8) RET_ISSUE(s, n + PD);
            WG_BAR();
            f32x4 acc[8];
            if (FULL) {
                f32x4 fsv;
#pragma unroll
                for (int r = 0; r < 4; ++r) fsv[r] = __builtin_amdgcn_exp2f(l2g * (float)(16 * w4 + 4 * l4 + r + 1));
#pragma unroll
                for (int nt = 0; nt < 8; ++nt) acc[nt] = (f32x4){0.f, 0.f, 0.f, 0.f};
                bf16x8 aq[4];
#pragma unroll
                for (int ks = 0; ks < 4; ++ks) aq[ks] = *(const LAS bf16x8*)(lds + QI_OFF + (16 * w4 + l15) * 272 + (32 * ks + 8 * l4) * 2);
#pragma unroll
                for (int ks = 0; ks < 4; ++ks)
#pragma unroll
                    for (int nh = 0; nh < 2; ++nh) {
                        bf16x8 bs[4];
#pragma unroll
                        for (int nt = 0; nt < 4; ++nt) bs[nt] = *(const LAS bf16x8*)(lds + ST_OFF + (16 * (4 * nh + nt) + l15) * 272 + (32 * ks + 8 * l4) * 2);
#pragma unroll
                        for (int nt = 0; nt < 4; ++nt) acc[4 * nh + nt] = MFMA16(aq[ks], bs[nt], acc[4 * nh + nt]);
                    }
#pragma unroll
                for (int nt = 0; nt < 8; ++nt) acc[nt] = acc[nt] * fsv;
            }
            WG_BAR();
            if (FULL) {
                bf16x8 as_[2];
#pragma unroll
                for (int ks = 0; ks < 2; ++ks) as_[ks] = *(const LAS bf16x8*)(lds + SI_OFF + (16 * w4 + l15) * 144 + 16 * (4 * ks + l4));
#pragma unroll
                for (int ks = 0; ks < 2; ++ks)
#pragma unroll
                    for (int nh = 0; nh < 2; ++nh) {
                        bf16x8 bv[4];
#pragma unroll
                        for (int nt = 0; nt < 4; ++nt) bv[nt] = *(const LAS bf16x8*)(lds + VT_ADDR(4 * nh + nt, ks));
#pragma unroll
                        for (int nt = 0; nt < 4; ++nt) acc[4 * nh + nt] = MFMA16(as_[ks], bv[nt], acc[4 * nh + nt]);
                    }
                unsigned short gq[4][8];
#pragma unroll
                for (int r = 0; r < 4; ++r)
#pragma unroll
                    for (int nt = 0; nt < 8; ++nt) gq[r][nt] = *(const LAS unsigned short*)(lds + GI_OFF + (16 * w4 + 4 * l4 + r) * 272 + (16 * nt + l15) * 2);
                float rstd[4];
#pragma unroll
                for (int r = 0; r < 4; ++r) { float ss = 0.f;
#pragma unroll
                    for (int nt = 0; nt < 8; ++nt) ss += acc[nt][r] * acc[nt][r];
                    ss += dppf(ss, 1); ss += dppf(ss, 2); ss += dppf(ss, 4); ss += dppf(ss, 8);
                    ss = __shfl(ss, (lane & 48) | 15);
                    rstd[r] = rsqrtf(ss * (1.0f / 128.0f) + EPS); }
#pragma unroll
                for (int r = 0; r < 4; ++r)
#pragma unroll
                    for (int nt = 0; nt < 8; ++nt)
                        *(LAS unsigned short*)(lds + QI_OFF + (16 * w4 + 4 * l4 + r) * 272 + (16 * nt + l15) * 2) = (unsigned short)(pk2s(acc[nt][r] * rstd[r] * rwv[nt] * silu_f(bf2f(gq[r][nt])), 0.f) & 0xffffu);
#pragma unroll
                for (int q = 0; q < 4; ++q) { const int cidx = lane + 64 * q, row = 16 * w4 + (cidx >> 4), ch = cidx & 15;
                    const u32x4 v = *(const LAS u32x4*)(lds + QI_OFF + row * 272 + ch * 16);
                    *(u32x4*)(MIX + (tok0 + (size_t)n * 64 + row) * DM + 128 * h + ch * 8) = v; }
            }
            WG_BAR();
          }
        }
    }
#ifndef CONVREP
#define CONVREP 1
#endif
    if (FULL) for (int crep_ = 0; crep_ < CONVREP; ++crep_) {
        const int c0 = 128 * h + 8 * (tid & 15), run = tid >> 4, t0 = G * 512 + run * 16;
        const float* cwp = p.in[7];
        float w0[8], w1[8], w2[8], p1[8], p2[8];
#pragma unroll
        for (int e = 0; e < 8; ++e) { w0[e] = cwp[c0 + e]; w1[e] = cwp[512 + c0 + e]; w2[e] = cwp[1024 + c0 + e]; p1[e] = 0.f; p2[e] = 0.f; }
        if (t0 > 0) {
            const bf16_t* r2 = P + ((size_t)b * 4096 + t0 - 2) * NIN; const bf16_t* r1 = r2 + NIN;
            const u32x4 c2 = *(const u32x4*)(r2 + 2560 + c0), h2 = *(const u32x4*)(r2 + 3072 + c0), c1 = *(const u32x4*)(r1 + 2560 + c0), h1 = *(const u32x4*)(r1 + 3072 + c0);
            const unsigned c2w[4] = {c2.x, c2.y, c2.z, c2.w}, h2w[4] = {h2.x, h2.y, h2.z, h2.w}, c1w[4] = {c1.x, c1.y, c1.z, c1.w}, h1w[4] = {h1.x, h1.y, h1.z, h1.w};
#pragma unroll
            for (int e = 0; e < 4; ++e) {
                p2[2 * e] = __uint_as_float(c2w[e] << 16) * __uint_as_float(h2w[e] << 16); p2[2 * e + 1] = __uint_as_float(c2w[e] & 0xffff0000u) * __uint_as_float(h2w[e] & 0xffff0000u);
                p1[2 * e] = __uint_as_float(c1w[e] << 16) * __uint_as_float(h1w[e] << 16); p1[2 * e + 1] = __uint_as_float(c1w[e] & 0xffff0000u) * __uint_as_float(h1w[e] & 0xffff0000u); }
        }
#pragma unroll 8
        for (int t = 0; t < 16; ++t) {
            const size_t row = (size_t)b * 4096 + t0 + t;
            const bf16_t* rp = P + row * NIN;
            const u32x4 bb = *(const u32x4*)(rp + 2048 + c0), cc = *(const u32x4*)(rp + 2560 + c0), hh = *(const u32x4*)(rp + 3072 + c0);
            const unsigned bw[4] = {bb.x, bb.y, bb.z, bb.w}, cw4[4] = {cc.x, cc.y, cc.z, cc.w}, hw[4] = {hh.x, hh.y, hh.z, hh.w};
            float y[8];
#pragma unroll
            for (int e = 0; e < 4; ++e) {
                const float ca = __uint_as_float(cw4[e] << 16) * __uint_as_float(hw[e] << 16), cb = __uint_as_float(cw4[e] & 0xffff0000u) * __uint_as_float(hw[e] & 0xffff0000u);
                y[2 * e] = __uint_as_float(bw[e] << 16) * (w0[2 * e] * p2[2 * e] + w1[2 * e] * p1[2 * e] + w2[2 * e] * ca);
                y[2 * e + 1] = __uint_as_float(bw[e] & 0xffff0000u) * (w0[2 * e + 1] * p2[2 * e + 1] + w1[2 * e + 1] * p1[2 * e + 1] + w2[2 * e + 1] * cb);
                p2[2 * e] = p1[2 * e]; p2[2 * e + 1] = p1[2 * e + 1]; p1[2 * e] = ca; p1[2 * e + 1] = cb;
            }
            *(u32x4*)(MIX + row * DM + 512 + c0) = (u32x4){pk2(y[0], y[1]), pk2(y[2], y[3]), pk2(y[4], y[5]), pk2(y[6], y[7])};
        }
        if (G == 7 && run == 31) {
            float* o = p.out + O_CCP + (size_t)b * 1024 + c0;
#pragma unroll
            for (int e = 0; e < 8; ++e) { o[e] = p2[e]; o[512 + e] = p1[e]; }
        }
    }
#undef VT_ADDR
}

__device__ __forceinline__ float ch_at(const float* PS, const float* cache, int b, int t, int ch) {
    if (t < 0) return cache[(b * 2 + (t + 2)) * 512 + ch];
    const float* rp = PS + (size_t)(16 * b + t) * NIN;
    return rp[2560 + ch] * rp[3072 + ch];
}
__device__ __forceinline__ void sample_unit(const Params& p, LAS unsigned char* lds, int su, int tid, int wid, int lane) {
    const int b = su >> 2, h = su & 3, ts0 = TOK_P + 16 * b;
    const float* PS = (const float*)(p.ws + WS_PS);
    bf16_t* MIX = (bf16_t*)(p.ws + WS_RA);
    LAS float* qs = (LAS float*)lds; LAS float* ks = qs + 2048; LAS float* vs = qs + 4096; LAS float* Ssm = qs + 6144; LAS float* osm = qs + 6400;
    const float l2g = log2f(1.0f - exp2f(-5.0f - (float)h));
    const float* cosT = (const float*)(p.ws + WS_COS); const float* sinT = (const float*)(p.ws + WS_SIN);
    for (int idx = tid; idx < 2048; idx += 512) { const int i = idx >> 7, c = idx & 127, d = dmap(c);
        const float* rp = PS + (size_t)(16 * b + i) * NIN + 128 * h;
        const float cs = cosT[(4096 + i) * 64 + (d & 63)], sn = sinT[(4096 + i) * 64 + (d & 63)];
        const float xq = rp[c], xqp = rp[c ^ 4], xk = rp[512 + c], xkp = rp[512 + (c ^ 4)];
        qs[i * 128 + d] = d < 64 ? xq * cs - xqp * sn : xq * cs + xqp * sn;
        ks[i * 128 + d] = (d < 64 ? xk * cs - xkp * sn : xk * cs + xkp * sn) * 0.08838834764831845f;
        vs[i * 128 + c] = rp[1024 + c]; }
    __syncthreads();
    if (tid < 256) { const int i = tid >> 4, j = tid & 15; float s = 0.f;
        for (int d = 0; d < 128; ++d) s += qs[i * 128 + d] * ks[j * 128 + d];
        const int dd = i - j; Ssm[i * 16 + j] = s * __builtin_amdgcn_exp2f(l2g * (float)(dd < 0 ? -dd : dd)); }
    const int e = tid & 127, ig = tid >> 7;
    LAS float* s0 = qs + 8704;
    { const float* s0g = p.in[2] + (size_t)su * 16384; f32x4 t8[8];
#pragma unroll
      for (int q = 0; q < 8; ++q) t8[q] = *((const f32x4*)s0g + tid + 512 * q);
#pragma unroll
      for (int q = 0; q < 8; ++q) *((LAS f32x4*)s0 + tid + 512 * q) = t8[q]; }
    __syncthreads();
    float cr[4] = {0.f, 0.f, 0.f, 0.f};
#pragma unroll 4
    for (int d = 0; d < 128; ++d) { const float sv = s0[d * 128 + e];
#pragma unroll
        for (int r = 0; r < 4; ++r) cr[r] += qs[(ig * 4 + r) * 128 + d] * sv; }
    __syncthreads();
#pragma unroll
    for (int r = 0; r < 4; ++r) { const int i = ig * 4 + r; float o = 0.f;
        for (int j = 0; j < 16; ++j) o += Ssm[i * 16 + j] * vs[j * 128 + e];
        osm[i * 128 + e] = o + __builtin_amdgcn_exp2f(l2g * (float)(i + 1)) * cr[r]; }
    __syncthreads();
    for (int rr = 0; rr < 2; ++rr) { const int i = 2 * wid + rr; const float v0 = osm[i * 128 + lane], v1 = osm[i * 128 + 64 + lane];
        const float rstd = rsqrtf(wave_sum(v0 * v0 + v1 * v1) * (1.0f / 128.0f) + EPS);
        const size_t token = (size_t)(ts0 + i);
        const float g0 = PS[(size_t)(16 * b + i) * NIN + 1536 + 128 * h + lane], g1 = PS[(size_t)(16 * b + i) * NIN + 1536 + 128 * h + 64 + lane];
        MIX[token * DM + 128 * h + lane] = (bf16_t)(pk2(v0 * rstd * p.in[8][128 * h + lane] * silu_f(g0), 0.f) & 0xffffu);
        MIX[token * DM + 128 * h + 64 + lane] = (bf16_t)(pk2(v1 * rstd * p.in[8][128 * h + 64 + lane] * silu_f(g1), 0.f) & 0xffffu); }
    const float g16 = __builtin_amdgcn_exp2f(l2g * 16.0f);
    float* outS = p.out + O_SRS + (size_t)su * 16384;
#pragma unroll 2
    for (int dd = 0; dd < 32; ++dd) { const int d = ig + 4 * dd; float a = g16 * s0[d * 128 + e];
        for (int j = 0; j < 16; ++j) a += __builtin_amdgcn_exp2f(l2g * (float)(15 - j)) * ks[j * 128 + d] * vs[j * 128 + e];
        outS[d * 128 + e] = a; }
    const int ch = 128 * h + e; const float* cache = p.in[3]; const float* cwp = p.in[7];
    const float w0 = cwp[ch], w1 = cwp[512 + ch], w2 = cwp[1024 + ch];
#pragma unroll
    for (int tt = 0; tt < 4; ++tt) { const int t = ig * 4 + tt;
        const float c0 = ch_at(PS, cache, b, t - 2, ch), c1 = ch_at(PS, cache, b, t - 1, ch), c2 = ch_at(PS, cache, b, t, ch);
        const float y = PS[(size_t)(16 * b + t) * NIN + 2048 + ch] * (w0 * c0 + w1 * c1 + w2 * c2);
        MIX[(size_t)(ts0 + t) * DM + 512 + ch] = (bf16_t)(pk2(y, 0.f) & 0xffffu);
        if (t >= 14) p.out[O_CCS + (size_t)(b * 2 + t - 14) * 512 + ch] = c2; }
    __syncthreads();
}

template <int NB>
__device__ __forceinline__ void thin_gemm(const bf16_t* A, int lda, const bf16_t* Bt, int ldb, int n0, int nbstride, int kbeg, int klen, f32x4 (&acc)[NB], int wid, int lane) {
    const int l15 = lane & 15, l4 = lane >> 4;
    const bf16_t* ap = A + (size_t)(16 * wid + l15) * lda + kbeg + 8 * l4;
    const bf16_t* bp = Bt + (size_t)(n0 + l15) * ldb + kbeg + 8 * l4;
#pragma unroll
    for (int nb = 0; nb < NB; ++nb) acc[nb] = (f32x4){0.f, 0.f, 0.f, 0.f};
#pragma unroll 1
    for (int s0 = 0; s0 < klen; s0 += 256) {
        bf16x8 a[8], b[NB][8];
#pragma unroll
        for (int s = 0; s < 8; ++s) { a[s] = *(const bf16x8*)(ap + s0 + 32 * s);
#pragma unroll
            for (int nb = 0; nb < NB; ++nb) b[nb][s] = *(const bf16x8*)(bp + (size_t)nb * nbstride * ldb + s0 + 32 * s); }
#pragma unroll
        for (int s = 0; s < 8; ++s)
#pragma unroll
            for (int nb = 0; nb < NB; ++nb) acc[nb] = MFMA16(a[s], b[nb][s], acc[nb]);
    }
}
__device__ __forceinline__ void thin_store(const f32x4& acc, float* out, int ldo, int col, int wid, int lane) {
#pragma unroll
    for (int r = 0; r < 4; ++r) out[(size_t)(16 * wid + 4 * (lane >> 4) + r) * ldo + col + (lane & 15)] = acc[r];
}
__device__ __forceinline__ void thin_ffn1(const Params& p, int c, int wid, int lane) {
    const int pn = c >> 3, j16 = c & 7, l15 = lane & 15, l4 = lane >> 4;
    f32x4 acc[2];
    thin_gemm<2>((const bf16_t*)(p.ws + WS_RA) + (size_t)TOK_P * DM, DM, (const bf16_t*)(p.ws + WS_WFF1), DM, 256 * pn + 16 * j16, 128, 0, DM, acc, wid, lane);
    const int ch = 128 * pn + 16 * j16 + l15, b = wid;
    const float* cw = p.in[15]; const float* cache = p.in[4] + (size_t)b * 2 * DFF + ch;
    const float w0 = cw[ch], w1 = cw[DFF + ch], w2 = cw[2 * DFF + ch];
    const f32x4 up = acc[0], gt = acc[1];
    float pm1 = __shfl_up(up[3], 16), pm2 = __shfl_up(up[2], 16);
    if (l4 == 0) { pm1 = cache[DFF]; pm2 = cache[0]; }
    float uc[4];
    uc[0] = w0 * pm2 + w1 * pm1 + w2 * up[0];
    uc[1] = w0 * pm1 + w1 * up[0] + w2 * up[1];
    uc[2] = w0 * up[0] + w1 * up[1] + w2 * up[2];
    uc[3] = w0 * up[1] + w1 * up[2] + w2 * up[3];
    bf16_t* ACT = (bf16_t*)(p.ws + WS_RB);
#pragma unroll
    for (int r = 0; r < 4; ++r) ACT[(size_t)(TOK_P + 16 * wid + 4 * l4 + r) * DFF + ch] = (bf16_t)(pk2(pg8::gelu_tanh(uc[r]) * gt[r], 0.f) & 0xffffu);
    if (l4 == 3) { float* o = p.out + O_CFS + (size_t)b * 2 * DFF + ch; o[0] = up[2]; o[DFF] = up[3]; }
}

__device__ __forceinline__ void phase4(const Params& p, int wid, int lane) {
    const int gw = blockIdx.x * 8 + wid, NGW = gridDim.x * 8;
    const bf16_t* Y = (const bf16_t*)(p.ws + WS_Y); bf16_t* H2 = (bf16_t*)(p.ws + WS_RA); const float* ssq = (const float*)(p.ws + WS_SSQ1);
    const float* wpost = p.in[10]; const float* wpre = p.in[11];
    f32x4 wpo[4], wpr[4];
#pragma unroll
    for (int j = 0; j < 4; ++j) { wpo[j] = *((const f32x4*)wpost + lane + 64 * j); wpr[j] = *((const f32x4*)wpre + lane + 64 * j); }
#pragma unroll 1
    for (int base = gw; base < TOK_P; base += RB * NGW) {
        f32x4 v[RB][4]; u32x2 yw[RB][4]; float sq[RB];
#pragma unroll
        for (int k = 0; k < RB; ++k) { const int rr = min(base + k * NGW, TOK_P - 1);
            sq[k] = lane < 16 ? ssq[(size_t)rr * 16 + lane] : 0.f;
#pragma unroll
            for (int j = 0; j < 4; ++j) { v[k][j] = __builtin_nontemporal_load((const f32x4*)(p.in[0] + (size_t)rr * DM) + lane + 64 * j); yw[k][j] = __builtin_nontemporal_load((const u32x2*)(Y + (size_t)rr * DM) + lane + 64 * j); } }
        float s2[RB];
#pragma unroll
        for (int k = 0; k < RB; ++k) { const float rstd1 = rsqrtf(wave_sum(sq[k]) * (1.0f / DM) + EPS); s2[k] = 0.f;
#pragma unroll
            for (int j = 0; j < 4; ++j) { v[k][j] = v[k][j] + (unpack_bf4(yw[k][j]) * rstd1) * wpo[j]; s2[k] += sumsq4(v[k][j]); } }
#pragma unroll
        for (int k = 0; k < RB; ++k) { const int r = base + k * NGW; const float rstd2 = rsqrtf(wave_sum(s2[k]) * (1.0f / DM) + EPS);
            if (r < TOK_P) {
#pragma unroll
                for (int j = 0; j < 4; ++j) { const f32x4 y = (v[k][j] * rstd2) * wpr[j];
                    __builtin_nontemporal_store((u32x2){pk2(y[0], y[1]), pk2(y[2], y[3])}, (u32x2*)(H2 + (size_t)r * DM) + lane + 64 * j); } } }
    }
    for (int r = TOK_P + gw; r < TOK; r += NGW) {
        const float* xrow = p.in[1] + (size_t)(r - TOK_P) * DM; const float* ys = (const float*)(p.ws + WS_YS) + (size_t)(r - TOK_P) * DM;
        f32x4 yv[4], v[4]; float s = 0.f, s2 = 0.f;
#pragma unroll
        for (int j = 0; j < 4; ++j) { f32x4 a = *((const f32x4*)ys + lane + 64 * j);
#pragma unroll
            for (int q = 1; q < 4; ++q) a += *((const f32x4*)(ys + (size_t)q * 128 * DM) + lane + 64 * j);
            yv[j] = a; s += sumsq4(a); }
        const float rstd1 = rsqrtf(wave_sum(s) * (1.0f / DM) + EPS);
#pragma unroll
        for (int j = 0; j < 4; ++j) { v[j] = *((const f32x4*)xrow + lane + 64 * j) + (yv[j] * rstd1) * wpo[j]; s2 += sumsq4(v[j]);
 }
        const float rstd2 = rsqrtf(wave_sum(s2) * (1.0f / DM) + EPS);
#pragma unroll
        for (int j = 0; j < 4; ++j) { const f32x4 y = (v[j] * rstd2) * wpr[j]; *((u32x2*)(H2 + (size_t)r * DM) + lane + 64 * j) = (u32x2){pk2(y[0], y[1]), pk2(y[2], y[3])}; }
    }
}
__device__ __forceinline__ void phase7(const Params& p, int wid, int lane) {
    const int gw = blockIdx.x * 8 + wid, NGW = gridDim.x * 8;
    const bf16_t* F = (const bf16_t*)(p.ws + WS_RA); const bf16_t* Y = (const bf16_t*)(p.ws + WS_Y);
    const float* ssq1 = (const float*)(p.ws + WS_SSQ1); const float* ssq2 = (const float*)(p.ws + WS_SSQ2);
    f32x4 wm[4], wf[4];
#pragma unroll
    for (int j = 0; j < 4; ++j) { wm[j] = *((const f32x4*)p.in[10] + lane + 64 * j); wf[j] = *((const f32x4*)p.in[12] + lane + 64 * j); }
    constexpr int RB7 = 4;
#pragma unroll 1
    for (int base = gw; base < TOK_P; base += RB7 * NGW) {
        f32x4 v[RB7][4]; u32x2 yw[RB7][4], fw[RB7][4]; float sq1[RB7], sq2[RB7];
#pragma unroll
        for (int k = 0; k < RB7; ++k) { const int rr = min(base + k * NGW, TOK_P - 1);
            sq1[k] = lane < 16 ? ssq1[(size_t)rr * 16 + lane] : 0.f; sq2[k] = lane < 16 ? ssq2[(size_t)rr * 16 + lane] : 0.f;
#pragma unroll
            for (int j = 0; j < 4; ++j) { v[k][j] = __builtin_nontemporal_load((const f32x4*)(p.in[0] + (size_t)rr * DM) + lane + 64 * j);
                yw[k][j] = __builtin_nontemporal_load((const u32x2*)(Y + (size_t)rr * DM) + lane + 64 * j); fw[k][j] = __builtin_nontemporal_load((const u32x2*)(F + (size_t)rr * DM) + lane + 64 * j); } }
#pragma unroll
        for (int k = 0; k < RB7; ++k) { const int r = base + k * NGW;
            const float rstd1 = rsqrtf(wave_sum(sq1[k]) * (1.0f / DM) + EPS), rstd2 = rsqrtf(wave_sum(sq2[k]) * (1.0f / DM) + EPS);
            if (r < TOK_P) {
#pragma unroll
                for (int j = 0; j < 4; ++j) __builtin_nontemporal_store(v[k][j] + (unpack_bf4(yw[k][j]) * rstd1) * wm[j] + (unpack_bf4(fw[k][j]) * rstd2) * wf[j], (f32x4*)(p.out + (size_t)r * DM) + lane + 64 * j); } }
    }
    for (int r = TOK_P + gw; r < TOK; r += NGW) {
        const float* xrow = p.in[1] + (size_t)(r - TOK_P) * DM;
        const float* ys = (const float*)(p.ws + WS_YS) + (size_t)(r - TOK_P) * DM; const float* fs = (const float*)(p.ws + WS_FS) + (size_t)(r - TOK_P) * DM;
        f32x4 yv[4], fv[4]; float s1 = 0.f, s2 = 0.f;
#pragma unroll
        for (int j = 0; j < 4; ++j) { f32x4 a = *((const f32x4*)ys + lane + 64 * j), c = *((const f32x4*)fs + lane + 64 * j);
#pragma unroll
            for (int q = 1; q < 4; ++q) { a += *((const f32x4*)(ys + (size_t)q * 128 * DM) + lane + 64 * j); c += *((const f32x4*)(fs + (size_t)q * 128 * DM) + lane + 64 * j); }
            yv[j] = a; fv[j] = c; s1 += sumsq4(a); s2 += sumsq4(c); }
        const float rstd1 = rsqrtf(wave_sum(s1) * (1.0f / DM) + EPS), rstd2 = rsqrtf(wave_sum(s2) * (1.0f / DM) + EPS);
#pragma unroll
        for (int j = 0; j < 4; ++j) *((f32x4*)(p.out + (size_t)r * DM) + lane + 64 * j) = *((const f32x4*)xrow + lane + 64 * j) + (yv[j] * rstd1) * wm[j] + (fv[j] * rstd2) * wf[j];
    }
}


#define XB_TMO      128
#define XB_XCNT(j)  (256  + 64 * (j))
#define XB_XSUB(j)  (1280 + 64 * (j))
#define XB_XGEN(j)  (2304 + 64 * (j))
#define XB_TOP      3328
#define XB_TOPGEN   3392
#define XCD_BAR_WORDS 3456
#define XB_SPIN_CAP (1u << 18)

__device__ __forceinline__ unsigned xb_ld(unsigned* p)              { return __hip_atomic_load(p, __ATOMIC_RELAXED, __HIP_MEMORY_SCOPE_AGENT); }
__device__ __forceinline__ unsigned xb_add(unsigned* p, unsigned v) { return __hip_atomic_fetch_add(p, v, __ATOMIC_RELAXED, __HIP_MEMORY_SCOPE_AGENT); }
__device__ __forceinline__ unsigned xb_xcc_id() { return (unsigned)__builtin_amdgcn_s_getreg((3 << 11) | 20) & 0xFu; }
#define XB_SPIN(cond, bar) do { unsigned _sp = 0; while (cond) { __builtin_amdgcn_s_sleep(1); \
    if ((++_sp & 255u) == 0u) { if (xb_ld(&(bar)[XB_TMO])) break; if (_sp > XB_SPIN_CAP) { atomicAdd(&(bar)[XB_TMO], 1u); break; } } } } while (0)

struct XcdBarrier {
    unsigned* bar; unsigned x;
    volatile LAS unsigned* st;
};

__device__ __forceinline__ XcdBarrier xcd_barrier_post(unsigned* bar, volatile LAS unsigned* st) {
    XcdBarrier b; b.bar = bar; b.x = xb_xcc_id(); b.st = st;
    if (threadIdx.x == 0) (void)xb_add(&bar[XB_XCNT(b.x)], 1u);
    return b;
}
__device__ __forceinline__ void xcd_barrier_complete(unsigned* bar, unsigned x, unsigned& nloc, unsigned& nx) {
    const unsigned G = gridDim.x * gridDim.y * gridDim.z;
    unsigned sum, cnt, mine, sp = 0u;
    for (;;) {
        sum = 0u; cnt = 0u; mine = 0u;
#pragma unroll
        for (unsigned j = 0; j < 16; ++j) { const unsigned c = xb_ld(&bar[XB_XCNT(j)]); sum += c; cnt += (c > 0u) ? 1u : 0u; mine = (j == x) ? c : mine; }
        if (sum == G) break;
        __builtin_amdgcn_s_sleep(1);
        if ((++sp & 255u) == 0u) { if (xb_ld(&bar[XB_TMO])) break; if (sp > XB_SPIN_CAP) { atomicAdd(&bar[XB_TMO], 1u); break; } }
    }
    nloc = mine > 0u ? mine : 1u; nx = cnt > 0u ? cnt : 1u;
}

__device__ __forceinline__ void xcd_barrier(const XcdBarrier& b) {
    asm volatile("s_waitcnt vmcnt(0)" ::: "memory");
    __syncthreads();
    if (threadIdx.x == 0) {
        unsigned* bar = b.bar;
        __builtin_amdgcn_s_waitcnt(0);
        unsigned nloc = b.st[0], nx = b.st[1];
        if (nloc == 0u) { xcd_barrier_complete(bar, b.x, nloc, nx); b.st[0] = nloc; b.st[1] = nx; }
        const unsigned old = xb_add(&bar[XB_XSUB(b.x)], 1u);
        const unsigned gen = old / nloc;
        if (old + 1u == (gen + 1u) * nloc) {
            __builtin_amdgcn_fence(__ATOMIC_RELEASE, "agent");
            asm volatile("s_waitcnt vmcnt(0)" ::: "memory");
            const unsigned og = xb_add(&bar[XB_TOP], 1u);
            const unsigned tg = og / nx;
            if (og + 1u == (tg + 1u) * nx) xb_add(&bar[XB_TOPGEN], 1u);
            else XB_SPIN(xb_ld(&bar[XB_TOPGEN]) == tg, bar);
            __builtin_amdgcn_fence(__ATOMIC_ACQUIRE, "agent");
            xb_add(&bar[XB_XGEN(b.x)], 1u);
            asm volatile("s_waitcnt vmcnt(0)" ::: "memory");
        } else {
            XB_SPIN(xb_ld(&bar[XB_XGEN(b.x)]) == gen, bar);
            __builtin_amdgcn_fence(__ATOMIC_ACQUIRE, "agent");
            asm volatile("s_waitcnt vmcnt(0)" ::: "memory");
        }
    }
    __syncthreads();
}

#ifndef MK_LAUNCHES
#define MK_LAUNCHES 1
#endif
#ifndef REP0
#define REP0 1
#endif
#ifndef REP1
#define REP1 1
#endif
#ifndef REP2
#define REP2 1
#endif
#ifndef REP3
#define REP3 1
#endif
#ifndef REP4
#define REP4 1
#endif
#ifndef REP5
#define REP5 1
#endif
#ifndef REP6
#define REP6 1
#endif
#ifndef REP7
#define REP7 1
#endif
#define REPEAT(n) for (int rep_ = 0; rep_ < (n); ++rep_, ((rep_ < (n)) ? GRIDSYNC() : (void)0))
template <int PH_LO, int PH_HI>
__device__ __forceinline__ void run_phases(const Params& p, LAS unsigned char* lds) {
    int tid = threadIdx.x, lane = tid & 63; const int wid = __builtin_amdgcn_readfirstlane(tid >> 6);
    const int G = gridDim.x, c = blockIdx.x;
#define LAUNDER() asm volatile("" : "+v"(tid), "+v"(lane))
    XcdBarrier bar_;
    if (PH_HI - PH_LO > 1) {
        volatile LAS unsigned* stw = (volatile LAS unsigned*)(lds + LDS_BARW);
        if (threadIdx.x == 0) { stw[0] = 0u; stw[1] = 0u; }
        __syncthreads();
        bar_ = xcd_barrier_post((unsigned*)p.ws, stw);
        if (p.ws == nullptr) cg::this_grid().sync();
    }
#define GRIDSYNC() xcd_barrier(bar_)
#define SEAM(ph) do { if (PH_LO <= (ph) && (ph) + 1 < PH_HI) { GRIDSYNC(); } } while (0)
#ifdef XSYNC
    for (int xs_ = 0; xs_ < XSYNC; ++xs_) GRIDSYNC();
#endif
    if (PH_LO <= 0 && 0 < PH_HI) REPEAT(REP0) { LAUNDER(); phase0(p, lds, tid, wid, lane); }
    SEAM(0);
    if (PH_LO <= 1 && 1 < PH_HI) REPEAT(REP1) {
        for (int t = c; t < 224; t += G) { f32x4 acc[1]; thin_gemm<1>((const bf16_t*)(p.ws + WS_RA) + (size_t)TOK_P * DM, DM, (const bf16_t*)(p.ws + WS_WIN), DM, 16 * t, 0, 0, DM, acc, wid, lane);
            thin_store(acc[0], (float*)(p.ws + WS_PS), NIN, 16 * t, wid, lane); }
        pg8::Gemm g{(const bf16_t*)(p.ws + WS_RA), (const bf16_t*)(p.ws + WS_WIN), TOK_P, NIN, DM};
        pg8::StaticOrder S; S.init(TOK_P, NIN, G, c);
        pg8::EpiIn E{(bf16_t*)(p.ws + WS_RB), (const float*)(p.ws + WS_COS), (const float*)(p.ws + WS_SIN)};
        pg8::gemm_phase<pg8::EpiIn, pg8::StaticOrder, true, true>(lds, g, S, E);
    }
    SEAM(1);
    if (PH_LO <= 2 && 2 < PH_HI) REPEAT(REP2) {
#ifndef RUREP
#define RUREP 1
#endif
        for (int rrep_ = 0; rrep_ < RUREP; ++rrep_) for (int u = c; u < 256; u += G) ret_unit<false>(p, lds, u, tid, wid, lane);
        LAUNDER();
#ifndef SUREP
#define SUREP 1
#endif
        for (int srep_ = 0; srep_ < SUREP; ++srep_) for (int su = c; su < 32; su += G) sample_unit(p, lds, su, tid, wid, lane);
    }
    SEAM(2);
    if (PH_LO <= 3 && 3 < PH_HI) REPEAT(REP3) {
        for (int u = c; u < 256; u += G) ret_unit<true>(p, lds, u, tid, wid, lane);
    }
    SEAM(3);
    if (PH_LO <= 4 && 4 < PH_HI) REPEAT(REP4) {
        for (int t = c; t < 256; t += G) { f32x4 acc[1]; const int kq = t >> 6, nt = t & 63;
            thin_gemm<1>((const bf16_t*)(p.ws + WS_RA) + (size_t)TOK_P * DM, DM, (const bf16_t*)(p.ws + WS_WOUT), DM, 16 * nt, 0, 256 * kq, 256, acc, wid, lane);
            thin_store(acc[0], (float*)(p.ws + WS_YS) + (size_t)kq * 128 * DM, DM, 16 * nt, wid, lane); }
        pg8::Gemm g{(const bf16_t*)(p.ws + WS_RA), (const bf16_t*)(p.ws + WS_WOUT), TOK_P, DM, DM};
        pg8::StaticOrder S; S.init(TOK_P, DM, G, c);
        pg8::EpiY E{(bf16_t*)(p.ws + WS_Y), (float*)(p.ws + WS_SSQ1)};
        pg8::gemm_phase<pg8::EpiY, pg8::StaticOrder, true, true>(lds, g, S, E);
    }
    SEAM(4);
    if (PH_LO <= 5 && 5 < PH_HI) REPEAT(REP5) { LAUNDER(); phase4(p, wid, lane); }
    SEAM(5);
    if (PH_LO <= 6 && 6 < PH_HI) REPEAT(REP6) {
        for (int t = c; t < 256; t += G) thin_ffn1(p, t, wid, lane);
        pg8::Gemm g{(const bf16_t*)(p.ws + WS_RA), (const bf16_t*)(p.ws + WS_WFF1), TOK_P, 2 * DFF, DM};
        pg8::WalkOrder S{G, c};
        pg8::EpiFfn E{(bf16_t*)(p.ws + WS_RB), p.in[15], p.in[4], p.out + O_CFP, p.out + O_CFS, (LAS float*)(lds + LDS_HALO)};
        pg8::gemm_phase<pg8::EpiFfn, pg8::WalkOrder, true, true>(lds, g, S, E);
    }
    SEAM(6);
    if (PH_LO <= 7 && 7 < PH_HI) REPEAT(REP7) {
        for (int t = c; t < 256; t += G) { f32x4 acc[1]; const int kq = t >> 6, nt = t & 63;
            thin_gemm<1>((const bf16_t*)(p.ws + WS_RB) + (size_t)TOK_P * DFF, DFF, (const bf16_t*)(p.ws + WS_WDN), DFF, 16 * nt, 0, 1024 * kq, 1024, acc, wid, lane);
            thin_store(acc[0], (float*)(p.ws + WS_FS) + (size_t)kq * 128 * DM, DM, 16 * nt, wid, lane); }
        pg8::Gemm g{(const bf16_t*)(p.ws + WS_RB), (const bf16_t*)(p.ws + WS_WDN), TOK_P, DM, DFF};
        pg8::StaticOrder S; S.init(TOK_P, DM, G, c);
        pg8::EpiY E{(bf16_t*)(p.ws + WS_RA), (float*)(p.ws + WS_SSQ2)};
        pg8::gemm_phase<pg8::EpiY, pg8::StaticOrder, true, true>(lds, g, S, E);
    }
    SEAM(7);
#ifndef REP8
#define REP8 1
#endif
    if (PH_LO <= 8 && 8 < PH_HI) REPEAT(REP8) { LAUNDER(); phase7(p, wid, lane); }
#undef SEAM
}
constexpr int NPH = 9;
#if MK_LAUNCHES == 1
__global__ void __launch_bounds__(512, 2) fwd_kernel(Params p) {
    extern __shared__ __attribute__((aligned(16))) unsigned char smem[];
    run_phases<0, NPH>(p, (LAS unsigned char*)smem);
}
#else
template <int PH>
__global__ void __launch_bounds__(512, 2) fwd_phase(Params p) {
    extern __shared__ __attribute__((aligned(16))) unsigned char smem[];
    run_phases<PH, PH + 1>(p, (LAS unsigned char*)smem);
}
template <int PH> static void launch_phase(const Params& p, int grid, hipStream_t stream) {
    static bool attr = false;
    if (!attr) { (void)hipFuncSetAttribute((const void*)fwd_phase<PH>, hipFuncAttributeMaxDynamicSharedMemorySize, LDS_BYTES); attr = true; }
    hipLaunchKernelGGL(fwd_phase<PH>, dim3(grid), dim3(512), LDS_BYTES, stream, p);
}
#endif

extern "C" void kernel_launch(void* const* d_in, const int* in_sizes, int n_in, void* d_out, int out_size, void* d_ws, size_t ws_size, hipStream_t stream) {
    static int grid = 0;
    if (grid == 0) {
        if (n_in != 17 || ws_size < WS_END) { fprintf(stderr, "kernel_launch: expected 17 inputs and >= %zu bytes of workspace (got %d, %zu)\n", (size_t)WS_END, n_in, ws_size); grid = -1; return; }
        int dev = 0, cus = 0, per_cu = 0;
        (void)hipGetDevice(&dev); (void)hipDeviceGetAttribute(&cus, hipDeviceAttributeMultiprocessorCount, dev);
#if MK_LAUNCHES == 1
        if (hipFuncSetAttribute((const void*)fwd_kernel, hipFuncAttributeMaxDynamicSharedMemorySize, LDS_BYTES) != hipSuccess) { fprintf(stderr, "kernel_launch: hipFuncSetAttribute failed\n"); grid = -1; return; }
        if (hipOccupancyMaxActiveBlocksPerMultiprocessor(&per_cu, (const void*)fwd_kernel, 512, LDS_BYTES) != hipSuccess || per_cu < 1) { fprintf(stderr, "kernel_launch: occupancy query says %d\n", per_cu); per_cu = 1; }
        (void)hipGetLastError();
#endif
        grid = cus > 0 ? cus : 256;
    }
    if (grid < 0) return;
    Params p{};
    for (int i = 0; i < 17; ++i) p.in[i] = (const float*)d_in[i];
    p.out = (float*)d_out; p.ws = (unsigned char*)d_ws;
#if MK_LAUNCHES == 1
    if (hipMemsetAsync(d_ws, 0, 16384, stream) != hipSuccess) { fprintf(stderr, "kernel_launch: hipMemsetAsync failed\n"); return; }
    void* args[] = {&p};
    const hipError_t e = hipLaunchCooperativeKernel((const void*)fwd_kernel, dim3(grid), dim3(512), args, LDS_BYTES, stream);
    if (e != hipSuccess) fprintf(stderr, "kernel_launch: cooperative launch failed: %s (grid %d)\n", hipGetErrorString(e), grid);
#else
    launch_phase<0>(p, grid, stream); launch_phase<1>(p, grid, stream); launch_phase<2>(p, grid, stream); launch_phase<3>(p, grid, stream); launch_phase<4>(p, grid, stream);
    launch_phase<5>(p, grid, stream); launch_phase<6>(p, grid, stream); launch_phase<7>(p, grid, stream); launch_phase<8>(p, grid, stream);
#endif
}
```

```cpp
#include <hip/hip_runtime.h>
#include <hip/hip_cooperative_groups.h>
#include <cstdio>
#include <cstdint>
namespace cg = cooperative_groups;
namespace pg8 {
#define PG8_LAS __attribute__((address_space(3)))
typedef unsigned short bf16_t;
typedef short bf16x8 __attribute__((ext_vector_type(8)));
typedef float f32x4 __attribute__((ext_vector_type(4)));
typedef unsigned u32x4 __attribute__((ext_vector_type(4)));
constexpr int BM = 256, BK = 64, HALF = 128, HTB = HALF * BK * 2  , STAGE_BYTES = 8 * HTB, NXCD = 8, WGM = 8;

__host__ __device__ __forceinline__ int lds_byte(int r, int c) { const int st = (r >> 4) * 2 + (c >> 5), rr = r & 15, cc = c & 31, ob = rr * 64 + cc * 2; return st * 1024 + (ob ^ (((ob >> 9) & 1) << 5)); }
__host__ __device__ __forceinline__ void stage_rc(int b, int& R, int& C) { const int st = b / 1024, sb = b % 1024, swz = sb ^ (((sb >> 9) & 1) << 5); R = (st >> 1) * 16 + swz / 64; C = (st & 1) * 32 + (swz % 64) / 2; }
__host__ __device__ __forceinline__ int perm32(int rho) { const int n = rho >> 4, i = rho & 15; return 8 * (i >> 2) + 4 * n + (i & 3); }

struct Unit { int pm, pn; };
struct Gemm { const bf16_t* A; const bf16_t* Bt; int M, N, K; };

struct StaticOrder {
    int nM, nN, nwg, G, c;
    __host__ __device__ void init(int M, int N, int G_, int c_) { nM = M / BM; nN = N / BM; nwg = nM * nN; G = G_; c = c_; }
    __host__ __device__ bool next(int i, Unit& u) const {
        const long L = (long)i * G + c; if (L >= nwg) return false;
        int wgid = (int)L; { const int q = nwg / NXCD, r = nwg % NXCD, xcd = wgid % NXCD, off = wgid / NXCD; wgid = (xcd < r ? xcd * (q + 1) : r * (q + 1) + (xcd - r) * q) + off; }
        const int nig = WGM * nN, gid = wgid / nig, fm = gid * WGM, gsz = (nM - fm) < WGM ? (nM - fm) : WGM;
        u.pm = fm + ((wgid % nig) % gsz); u.pn = (wgid % nig) / gsz; return true;
    }
    __device__ __forceinline__ void a_ready(const Unit&) const {}
    __device__ __forceinline__ void done(const Unit&) const {}
};
__device__ __forceinline__ unsigned cvt_pk_bf16(float lo, float hi) { unsigned r; asm volatile("v_cvt_pk_bf16_f32 %0, %1, %2" : "=v"(r) : "v"(lo), "v"(hi)); return r; }
__device__ __forceinline__ float dpp_shr1(float v) { return __builtin_bit_cast(float, __builtin_amdgcn_update_dpp(0, __builtin_bit_cast(int, v), 0x111, 0xf, 0xf, true)); }
__device__ __forceinline__ float dpp_shr2(float v) { return __builtin_bit_cast(float, __builtin_amdgcn_update_dpp(0, __builtin_bit_cast(int, v), 0x112, 0xf, 0xf, true)); }
__device__ __forceinline__ float dpp_shl15(float v) { return __builtin_bit_cast(float, __builtin_amdgcn_update_dpp(0, __builtin_bit_cast(int, v), 0x10F, 0xf, 0xf, true)); }
__device__ __forceinline__ float dpp_shl14(float v) { return __builtin_bit_cast(float, __builtin_amdgcn_update_dpp(0, __builtin_bit_cast(int, v), 0x10E, 0xf, 0xf, true)); }
__device__ __forceinline__ float gelu_tanh(float x) {
    const float z = 0.7978845608028654f * (x + 0.044715f * x * x * x);
    const float e = __builtin_amdgcn_exp2f(-2.8853900817779268f * z);
    return x * __builtin_amdgcn_rcpf(1.0f + e);
}
constexpr int TOKP = 32768;

struct EpiIn {
    static constexpr bool PERM = true, AFTER_DRAIN = false;
    bf16_t* P; const float* cosT; const float* sinT;
    __device__ __forceinline__ void operator()(const f32x4 (&acc)[2][2][4][2], const Unit& u, int wr, int wc, int fr, int fq) const {
        asm volatile("" : "+v"(fr), "+v"(fq));
        const int row0 = u.pm * BM + wr * 64 + fr, col0 = u.pn * BM + wc * 32 + 8 * fq;
        if (u.pn < 4) {
            const float sc = (u.pn >= 2) ? 0.08838834764831845f : 1.0f;
            const int f0 = 16 * wc + 4 * fq;
#pragma unroll
            for (int ai = 0; ai < 2; ++ai)
#pragma unroll
                for (int m = 0; m < 4; ++m) {
                    const int r = row0 + ai * HALF + m * 16;
                    const int pos = r < TOKP ? (r & 4095) : 4096 + ((r - TOKP) & 15);
                    const f32x4 c4 = *(const f32x4*)(cosT + pos * 64 + f0), s4 = *(const f32x4*)(sinT + pos * 64 + f0);
                    bf16_t* rowp = P + (size_t)r * 3584 + col0;
#pragma unroll
                    for (int bj = 0; bj < 2; ++bj) {
                        const f32x4 x1 = acc[ai][bj][m][0], x2 = acc[ai][bj][m][1];
                        const f32x4 o1 = (x1 * c4 - x2 * s4) * sc, o2 = (x2 * c4 + x1 * s4) * sc;
                        u32x4 w; w.x = cvt_pk_bf16(o1[0], o1[1]); w.y = cvt_pk_bf16(o1[2], o1[3]); w.z = cvt_pk_bf16(o2[0], o2[1]); w.w = cvt_pk_bf16(o2[2], o2[3]);
                        *(u32x4*)(rowp + bj * HALF) = w;
                    }
                }
        } else {
#pragma unroll
            for (int ai = 0; ai < 2; ++ai)
#pragma unroll
                for (int m = 0; m < 4; ++m) {
                    bf16_t* rowp = P + (size_t)(row0 + ai * HALF + m * 16) * 3584 + col0;
#pragma unroll
                    for (int bj = 0; bj < 2; ++bj) {
                        const f32x4 v0 = acc[ai][bj][m][0], v1 = acc[ai][bj][m][1];
                        u32x4 w; w.x = cvt_pk_bf16(v0[0], v0[1]); w.y = cvt_pk_bf16(v0[2], v0[3]); w.z = cvt_pk_bf16(v1[0], v1[1]); w.w = cvt_pk_bf16(v1[2], v1[3]);
                        *(u32x4*)(rowp + bj * HALF) = w;
                    }
                }
        }
    }
};

struct EpiY {
    static constexpr bool PERM = true, AFTER_DRAIN = false;
    bf16_t* Y; float* ssq;
    __device__ __forceinline__ void operator()(const f32x4 (&acc)[2][2][4][2], const Unit& u, int wr, int wc, int fr, int fq) const {
        asm volatile("" : "+v"(fr), "+v"(fq));
        const int row0 = u.pm * BM + wr * 64 + fr, col0 = u.pn * BM + wc * 32 + 8 * fq;
#pragma unroll
        for (int ai = 0; ai < 2; ++ai)
#pragma unroll
            for (int m = 0; m < 4; ++m) {
                const int r = row0 + ai * HALF + m * 16;
                bf16_t* rowp = Y + (size_t)r * 1024 + col0;
                float s = 0.f;
#pragma unroll
                for (int bj = 0; bj < 2; ++bj) {
                    const f32x4 v0 = acc[ai][bj][m][0], v1 = acc[ai][bj][m][1];
                    s += (v0[0] * v0[0] + v0[1] * v0[1]) + (v0[2] * v0[2] + v0[3] * v0[3]) + (v1[0] * v1[0] + v1[1] * v1[1]) + (v1[2] * v1[2] + v1[3] * v1[3]);
                    u32x4 w; w.x = cvt_pk_bf16(v0[0], v0[1]); w.y = cvt_pk_bf16(v0[2], v0[3]); w.z = cvt_pk_bf16(v1[0], v1[1]); w.w = cvt_pk_bf16(v1[2], v1[3]);
                    *(u32x4*)(rowp + bj * HALF) = w;
                }
                s += __shfl_xor(s, 16); s += __shfl_xor(s, 32);
                if (fq == 0) ssq[(size_t)r * 16 + u.pn * 4 + wc] = s;
            }
    }
};

struct EpiFfn {
    static constexpr bool PERM = true, AFTER_DRAIN = false;
    bf16_t* ACT; const float* cw; const float* cache; float* outp; float* outs; PG8_LAS float* halo;
    __device__ __forceinline__ void operator()(const f32x4 (&acc)[2][2][4][2], const Unit& u, int wr, int wc, int fr, int fq) const {
        asm volatile("" : "+v"(fr), "+v"(fq));
        const int lc0 = wc * 32 + 8 * fq, ch0 = u.pn * 128 + lc0;
        const bool sample = false;
        const int par = u.pm & 1;
        f32x4 w0[2], w1[2], w2[2];
#pragma unroll
        for (int n = 0; n < 2; ++n) { w0[n] = *(const f32x4*)(cw + ch0 + 4 * n); w1[n] = *(const f32x4*)(cw + 4096 + ch0 + 4 * n); w2[n] = *(const f32x4*)(cw + 8192 + ch0 + 4 * n); }
        if (!sample && fr >= 14) {
#pragma unroll
            for (int ai = 0; ai < 2; ++ai) { PG8_LAS float* hp = halo + ((par * 4 + 2 * ai + wr) * 2 + (fr - 14)) * 128 + lc0;
                *(PG8_LAS f32x4*)hp = acc[ai][0][3][0]; *(PG8_LAS f32x4*)(hp + 4) = acc[ai][0][3][1]; }
        }
        asm volatile("s_waitcnt lgkmcnt(0)" ::: "memory"); __builtin_amdgcn_s_barrier(); asm volatile("" ::: "memory");
#pragma unroll
        for (int ai = 0; ai < 2; ++ai) {
            const int blk = 2 * ai + wr;
#pragma unroll
            for (int m = 0; m < 4; ++m) {
                f32x4 pv[2]; pv[0] = (f32x4){0.f, 0.f, 0.f, 0.f}; pv[1] = pv[0];
                const int sb = 8 * ai + 4 * wr + m;
                if (sample) {
                    if (fr >= 14 && sb < 8) { const float* cp = cache + (size_t)(sb * 2 + fr - 14) * 4096 + ch0; pv[0] = *(const f32x4*)cp; pv[1] = *(const f32x4*)(cp + 4); }
                } else if (m == 0) {
                    if (fr >= 14) {
                        const bool zero = (blk == 0) && ((u.pm & 15) == 0);
                        const int hb = (blk == 0) ? ((par ^ 1) * 4 + 3) : (par * 4 + blk - 1);
                        if (!zero) { const PG8_LAS float* hp = halo + (hb * 2 + fr - 14) * 128 + lc0; pv[0] = *(const PG8_LAS f32x4*)hp; pv[1] = *(const PG8_LAS f32x4*)(hp + 4); }
                    }
                } else { pv[0] = acc[ai][0][m - 1][0]; pv[1] = acc[ai][0][m - 1][1]; }
                const int r = u.pm * BM + ai * HALF + wr * 64 + m * 16 + fr;
                float a8[8];
#pragma unroll
                for (int n = 0; n < 2; ++n)
#pragma unroll
                    for (int e = 0; e < 4; ++e) {
                        const float cur = acc[ai][0][m][n][e], pr = pv[n][e];
                        const float p1 = dpp_shr1(cur) + dpp_shl15(pr), p2 = dpp_shr2(cur) + dpp_shl14(pr);
                        const float uc = w0[n][e] * p2 + w1[n][e] * p1 + w2[n][e] * cur;
                        a8[4 * n + e] = gelu_tanh(uc) * acc[ai][1][m][n][e];
                    }
                u32x4 w; w.x = cvt_pk_bf16(a8[0], a8[1]); w.y = cvt_pk_bf16(a8[2], a8[3]); w.z = cvt_pk_bf16(a8[4], a8[5]); w.w = cvt_pk_bf16(a8[6], a8[7]);
                *(u32x4*)(ACT + (size_t)r * 4096 + ch0) = w;
                if (sample) {
                    if (fr >= 14 && sb < 8) { float* op = outs + (size_t)(sb * 2 + fr - 14) * 4096 + ch0; *(f32x4*)op = acc[ai][0][m][0]; *(f32x4*)(op + 4) = acc[ai][0][m][1]; }
                } else if (m == 3 && blk == 3 && (u.pm & 15) == 15 && fr >= 14) {
                    float* op = outp + (size_t)((u.pm >> 4) * 2 + fr - 14) * 4096 + ch0; *(f32x4*)op = acc[ai][0][m][0]; *(f32x4*)(op + 4) = acc[ai][0][m][1];
                }
            }
        }
    }
};
struct WalkOrder {
    int G, c;
    __device__ __forceinline__ bool next(int i, Unit& u) const {
        int w = c, rem = i;
        while (w < 256) { const int len = 16;
            if (rem < len) { if (w < 256) { u.pm = (w >> 5) * 16 + rem; u.pn = w & 31; } else { u.pm = 128; u.pn = w - 256; } return true; }
            rem -= len; w += G; }
        return false;
    }
    __device__ __forceinline__ void a_ready(const Unit&) const {}
    __device__ __forceinline__ void done(const Unit&) const {}
};
template <class Epi, class Sched, bool ALIGN_EPI = false, bool SP2 = false>
__device__ __forceinline__ void gemm_phase(PG8_LAS unsigned char* lds, const Gemm g, const Sched& S, const Epi& E) {
    int tid_raw = threadIdx.x; asm volatile("" : "+v"(tid_raw));
    const int tid = tid_raw, wid = __builtin_amdgcn_readfirstlane(tid >> 6), lane = tid & 63, wr = wid >> 2, wc = wid & 3, fr = lane & 15, fq = lane >> 4;
    const int K = g.K, nt = K / BK;
    unsigned voffA[2], voffB[2];
#pragma unroll
    for (int i = 0; i < 2; ++i) { int R, C; stage_rc(tid * 16 + i * 8192, R, C); const int Rb = Epi::PERM ? ((R & ~31) + perm32(R & 31)) : R;
        voffA[i] = (unsigned)(R * K + C) * 2u; voffB[i] = (unsigned)(Rb * K + C) * 2u; }
    const size_t kstep = (size_t)(BK * 2);
    const size_t hstep = (size_t)HALF * K * 2;
    const size_t tstep = 2 * hstep;
    const unsigned ldsw = (unsigned)wid * 1024u;
    const int aoff = lds_byte(wr * 64 + fr, fq * 8), boff = lds_byte(wc * 32 + fr, fq * 8);
#define PG8_SA(b, h) (((b) * 2 + (h)) * HTB)
#define PG8_SB(b, h) ((4 + (b) * 2 + (h)) * HTB)
#define PG8_STAGE(bufoff, gbase, voff) do { _Pragma("unroll") for (int _i = 0; _i < 2; ++_i) \
        __builtin_amdgcn_global_load_lds((const unsigned*)((const char*)(gbase) + (voff)[_i]), (PG8_LAS unsigned*)(lds + (bufoff) + ldsw + _i * 8192), 16, 0, 0); } while (0)
#define PG8_LDA(dst, b, h) do { _Pragma("unroll") for (int m = 0; m < 4; ++m) _Pragma("unroll") for (int k = 0; k < 2; ++k) dst[m][k] = *(const PG8_LAS bf16x8*)(lds + PG8_SA(b, h) + aoff + m * 2048 + k * 1024); } while (0)
#define PG8_LDB(dst, b, h) do { _Pragma("unroll") for (int n = 0; n < 2; ++n) _Pragma("unroll") for (int k = 0; k < 2; ++k) dst[n][k] = *(const PG8_LAS bf16x8*)(lds + PG8_SB(b, h) + boff + n * 2048 + k * 1024); } while (0)
#define PG8_MMA(ai, bj, At, Bt) do { __builtin_amdgcn_s_setprio(1); _Pragma("unroll") for (int m = 0; m < 4; ++m) _Pragma("unroll") for (int n = 0; n < 2; ++n) _Pragma("unroll") for (int k = 0; k < 2; ++k) \
        acc[ai][bj][m][n] = __builtin_amdgcn_mfma_f32_16x16x32_bf16(Bt[n][k], At[m][k], acc[ai][bj][m][n], 0, 0, 0); __builtin_amdgcn_s_setprio(0); } while (0)
#define PG8_WAIT_V(n) asm volatile("s_waitcnt vmcnt(" #n ")" ::: "memory")
#define PG8_WAIT_L(n) asm volatile("s_waitcnt lgkmcnt(" #n ")" ::: "memory")
#define PG8_BAR __builtin_amdgcn_s_barrier()
#define PG8_SCHED __builtin_amdgcn_sched_barrier(0)
    Unit cur, nxt; int ui = 0;
    if (!S.next(0, cur)) return;
    f32x4 acc[2][2][4][2];
#pragma unroll
    for (int a = 0; a < 2; ++a)
#pragma unroll
        for (int b = 0; b < 2; ++b)
#pragma unroll
            for (int m = 0; m < 4; ++m)
#pragma unroll
                for (int n = 0; n < 2; ++n) acc[a][b][m][n] = (f32x4){0.f, 0.f, 0.f, 0.f};
    bf16x8 At[4][2], B0[2][2], B1[2][2];
    const char* cA = (const char*)g.A + (size_t)cur.pm * tstep; const char* cB = (const char*)g.Bt + (size_t)cur.pn * tstep;
    S.a_ready(cur);
    if constexpr (SP2) {
        PG8_STAGE(PG8_SB(0, 0), cB, voffB); PG8_STAGE(PG8_SB(0, 1), cB + hstep, voffB); PG8_STAGE(PG8_SA(0, 0), cA, voffA); PG8_STAGE(PG8_SA(0, 1), cA + hstep, voffA);
        if (wr == 1) PG8_BAR;
        PG8_WAIT_V(2); PG8_BAR;
        PG8_STAGE(PG8_SB(1, 0), cB + kstep, voffB); PG8_STAGE(PG8_SA(1, 0), cA + kstep, voffA); PG8_STAGE(PG8_SB(1, 1), cB + hstep + kstep, voffB);
        PG8_WAIT_V(6); PG8_BAR;
    } else {
        PG8_STAGE(PG8_SB(0, 0), cB, voffB); PG8_STAGE(PG8_SA(0, 0), cA, voffA); PG8_STAGE(PG8_SB(0, 1), cB + hstep, voffB); PG8_STAGE(PG8_SA(0, 1), cA + hstep, voffA);
        if (wr == 1) PG8_BAR;
        PG8_WAIT_V(4); PG8_BAR;
        PG8_STAGE(PG8_SB(1, 0), cB + kstep, voffB); PG8_STAGE(PG8_SA(1, 0), cA + kstep, voffA); PG8_STAGE(PG8_SB(1, 1), cB + hstep + kstep, voffB);
        PG8_WAIT_V(6); PG8_BAR;
    }
    for (;;) {
        const bool has_next = S.next(ui + 1, nxt);
        const char* nA = has_next ? (const char*)g.A + (size_t)nxt.pm * tstep : cA; const char* nB = has_next ? (const char*)g.Bt + (size_t)nxt.pn * tstep : cB;
        for (int t = 0; t < nt; t += 2) {
            const bool last = (t == nt - 2);
            const char* a1 = cA + (size_t)(t + 1) * kstep;
            const char* a2 = last ? nA : cA + (size_t)(t + 2) * kstep; const char* b2 = last ? nB : cB + (size_t)(t + 2) * kstep;
            const char* a3 = a2 + kstep; const char* b3 = b2 + kstep;
            if (last && has_next) S.a_ready(nxt);
            if constexpr (SP2) {
            PG8_LDB(B0, 0, 0); PG8_LDB(B1, 0, 1); PG8_SCHED; PG8_LDA(At, 0, 0); PG8_STAGE(PG8_SA(1, 1), a1 + hstep, voffA);
            PG8_WAIT_V(8); PG8_WAIT_L(0); PG8_BAR; PG8_MMA(0, 0, At, B0); PG8_MMA(0, 1, At, B1); PG8_BAR; PG8_SCHED;
            PG8_LDA(At, 0, 1); PG8_STAGE(PG8_SB(0, 0), b2, voffB); PG8_STAGE(PG8_SB(0, 1), b2 + hstep, voffB); PG8_STAGE(PG8_SA(0, 0), a2, voffA);
            PG8_WAIT_V(8); PG8_WAIT_L(0); PG8_BAR; PG8_MMA(1, 0, At, B0); PG8_MMA(1, 1, At, B1); PG8_BAR; PG8_SCHED;
            PG8_LDB(B0, 1, 0); PG8_LDB(B1, 1, 1); PG8_SCHED; PG8_LDA(At, 1, 0); PG8_STAGE(PG8_SA(0, 1), a2 + hstep, voffA);
            PG8_WAIT_V(8); PG8_WAIT_L(0); PG8_BAR; PG8_MMA(0, 0, At, B0); PG8_MMA(0, 1, At, B1); PG8_BAR; PG8_SCHED;
            PG8_LDA(At, 1, 1); PG8_STAGE(PG8_SB(1, 0), b3, voffB); PG8_STAGE(PG8_SB(1, 1), b3 + hstep, voffB); PG8_STAGE(PG8_SA(1, 0), a3, voffA);
            PG8_WAIT_V(8); PG8_WAIT_L(0); PG8_BAR; PG8_MMA(1, 0, At, B0); PG8_MMA(1, 1, At, B1); PG8_BAR; PG8_SCHED;
            } else {
            PG8_LDB(B0, 0, 0); PG8_SCHED; PG8_LDA(At, 0, 0); PG8_STAGE(PG8_SA(1, 1), a1 + hstep, voffA);
            PG8_WAIT_L(8); PG8_BAR; PG8_WAIT_L(0); PG8_MMA(0, 0, At, B0); PG8_BAR; PG8_SCHED;
            PG8_LDB(B1, 0, 1); PG8_STAGE(PG8_SB(0, 0), b2, voffB);
            PG8_BAR; PG8_WAIT_L(0); PG8_MMA(0, 1, At, B1); PG8_BAR;
            PG8_LDA(At, 0, 1); PG8_STAGE(PG8_SA(0, 0), a2, voffA);
            PG8_BAR; PG8_WAIT_L(0); PG8_MMA(1, 0, At, B0); PG8_BAR; PG8_SCHED;
            PG8_STAGE(PG8_SB(0, 1), b2 + hstep, voffB);
            PG8_WAIT_V(6); PG8_BAR; PG8_MMA(1, 1, At, B1); PG8_BAR;
            PG8_LDB(B0, 1, 0); PG8_SCHED; PG8_LDA(At, 1, 0); PG8_STAGE(PG8_SA(0, 1), a2 + hstep, voffA);
            PG8_WAIT_L(8); PG8_BAR; PG8_WAIT_L(0); PG8_MMA(0, 0, At, B0); PG8_BAR; PG8_SCHED;
            PG8_LDB(B1, 1, 1); PG8_STAGE(PG8_SB(1, 0), b3, voffB);
            PG8_BAR; PG8_WAIT_L(0); PG8_MMA(0, 1, At, B1); PG8_BAR;
            PG8_LDA(At, 1, 1); PG8_STAGE(PG8_SA(1, 0), a3, voffA);
            PG8_BAR; PG8_WAIT_L(0); PG8_MMA(1, 0, At, B0); PG8_BAR; PG8_SCHED;
            PG8_STAGE(PG8_SB(1, 1), b3 + hstep, voffB);
            PG8_WAIT_V(6); PG8_BAR; PG8_MMA(1, 1, At, B1); PG8_BAR;
            }
        }
        if constexpr (ALIGN_EPI) { if (wr == 0) PG8_BAR; }
        if constexpr (!Epi::AFTER_DRAIN) { E(acc, cur, wr, wc, fr, fq); S.done(cur); }
        if (!has_next) break;
#pragma unroll
        for (int a = 0; a < 2; ++a)
#pragma unroll
            for (int b = 0; b < 2; ++b)
#pragma unroll
                for (int m = 0; m < 4; ++m)
#pragma unroll
                    for (int n = 0; n < 2; ++n) acc[a][b][m][n] = (f32x4){0.f, 0.f, 0.f, 0.f};
        cur = nxt; cA = nA; cB = nB; ++ui;
        if constexpr (ALIGN_EPI) { if (wr == 1) PG8_BAR; }
    }
    PG8_WAIT_V(0);
    if constexpr (!ALIGN_EPI) { if (wr == 0) PG8_BAR; }
    PG8_BAR;
    if constexpr (Epi::AFTER_DRAIN) { E.fused(acc, cur, wr, wc, fr, fq, lds, wid, lane); S.done(cur); }
#undef PG8_SA
#undef PG8_SB
#undef PG8_STAGE
#undef PG8_LDA
#undef PG8_LDB
#undef PG8_MMA
#undef PG8_WAIT_V
#undef PG8_WAIT_L
#undef PG8_BAR
#undef PG8_SCHED
}
}

using pg8::bf16_t; using pg8::bf16x8; using pg8::f32x4; using pg8::u32x4;
#define LAS __attribute__((address_space(3)))
typedef unsigned u32x2 __attribute__((ext_vector_type(2)));
constexpr int DM = 1024, NIN = 3584, DFF = 4096;
constexpr int TOK_P = 32768, TOK = 32896, TOKPAD = 33024;
constexpr float EPS = 1e-6f;
constexpr size_t WS_WIN = 16384;
constexpr size_t WS_WOUT = WS_WIN + (size_t)NIN * DM * 2;
constexpr size_t WS_WFF1 = WS_WOUT + (size_t)DM * DM * 2;
constexpr size_t WS_WDN = WS_WFF1 + (size_t)2 * DFF * DM * 2;
constexpr size_t WS_COS = WS_WDN + (size_t)DM * DFF * 2;
constexpr size_t WS_SIN = WS_COS + (size_t)4112 * 64 * 4;
constexpr size_t WS_SSQ1 = WS_SIN + (size_t)4112 * 64 * 4;
constexpr size_t WS_SSQ2 = WS_SSQ1 + (size_t)TOKPAD * 16 * 4;
constexpr size_t WS_UG = WS_SSQ2 + (size_t)TOKPAD * 16 * 4;
constexpr size_t WS_PS = WS_UG + (size_t)256 * 65536;
constexpr size_t WS_YS = WS_PS + (size_t)128 * NIN * 4;
constexpr size_t WS_FS = WS_YS + (size_t)4 * 128 * DM * 4;
constexpr size_t WS_RA = WS_FS + (size_t)4 * 128 * DM * 4;
constexpr size_t WS_RB = WS_RA + (size_t)TOKPAD * DM * 2;
constexpr size_t WS_Y = WS_RB + (size_t)TOKPAD * DFF * 2;
constexpr size_t WS_END = WS_Y + (size_t)TOK_P * DM * 2;
constexpr size_t O_SRP = (size_t)TOK * DM, O_CCP = O_SRP + 524288, O_CFP = O_CCP + 8192, O_SRS = O_CFP + 65536, O_CCS = O_SRS + 524288, O_CFS = O_CCS + 8192;
constexpr int LDS_HALO = 131072, LDS_BARW = 131072 + 8192, LDS_BYTES = LDS_BARW + 16;

struct Params { const float* in[17]; float* out; unsigned char* ws; };

__device__ __forceinline__ float dppf(float v, const int ctrl_sel) {
    const int iv = __builtin_bit_cast(int, v); int r;
    switch (ctrl_sel) { case 1: r = __builtin_amdgcn_update_dpp(0, iv, 0x111, 0xf, 0xf, true); break; case 2: r = __builtin_amdgcn_update_dpp(0, iv, 0x112, 0xf, 0xf, true); break;
        case 4: r = __builtin_amdgcn_update_dpp(0, iv, 0x114, 0xf, 0xf, true); break; case 8: r = __builtin_amdgcn_update_dpp(0, iv, 0x118, 0xf, 0xf, true); break;
        case 15: r = __builtin_amdgcn_update_dpp(0, iv, 0x142, 0xa, 0xf, false); break; default: r = __builtin_amdgcn_update_dpp(0, iv, 0x143, 0xc, 0xf, false); break; }
    return __builtin_bit_cast(float, r);
}
__device__ __forceinline__ float wave_sum(float v) {
    v += dppf(v, 1); v += dppf(v, 2); v += dppf(v, 4); v += dppf(v, 8); v += dppf(v, 15); v += dppf(v, 31);
    return __builtin_bit_cast(float, __builtin_amdgcn_readlane(__builtin_bit_cast(int, v), 63));
}
__device__ __forceinline__ float bf2f(unsigned short b) { return __uint_as_float(((unsigned)b) << 16); }
__device__ __forceinline__ unsigned pk2(float a, float b) { return pg8::cvt_pk_bf16(a, b); }
__device__ __forceinline__ unsigned pk2s(float a, float b) { unsigned r; asm("v_cvt_pk_bf16_f32 %0, %1, %2" : "=v"(r) : "v"(a), "v"(b)); return r; }
__device__ __forceinline__ float silu_f(float g) { return g * __builtin_amdgcn_rcpf(1.0f + __builtin_amdgcn_exp2f(-1.4426950408889634f * g)); }
__device__ __forceinline__ int dmap(int P) { return ((P >> 2) & 1) * 64 + (P >> 3) * 4 + (P & 3); }
__device__ __forceinline__ int pmap(int d) { return ((d >> 4) & 3) * 32 + ((d >> 2) & 3) * 8 + ((d >> 6) & 1) * 4 + (d & 3); }

constexpr int RB = 6;
__device__ __forceinline__ f32x4 unpack_bf4(const u32x2 w) { f32x4 v; v[0] = __uint_as_float(w.x << 16); v[1] = __uint_as_float(w.x & 0xffff0000u); v[2] = __uint_as_float(w.y << 16); v[3] = __uint_as_float(w.y & 0xffff0000u); return v; }
__device__ __forceinline__ float sumsq4(const f32x4 a) { return (a[0] * a[0] + a[1] * a[1]) + (a[2] * a[2] + a[3] * a[3]); }
template <int MODE> __device__ __forceinline__ int rowmap(int c) {
    if (MODE == 0) { if (c < 1024) return (c & ~127) + pmap(c & 127); return c; }
    if (MODE == 1) return c;
    if (MODE == 2) return ((c >> 7) << 8) + (c & 127);
    return ((c >> 7) << 8) + 128 + (c & 127);
}
template <int MODE>
__device__ __forceinline__ void transpose_item(const float* W, int K, int N, bf16_t* WT, LAS float* scr, int item, int lane) {
    const int nblk = N / 32, kb = item / nblk, nb = item % nblk, k0 = 64 * kb, n0 = 32 * nb;
#pragma unroll
    for (int i = 0; i < 32; ++i) { const int kk = 2 * i + (lane >> 5); scr[kk * 33 + (lane & 31)] = W[(size_t)(k0 + kk) * N + n0 + (lane & 31)]; }
    asm volatile("s_waitcnt lgkmcnt(0)" ::: "memory");
    const int c = lane & 7;
#pragma unroll
    for (int j = 0; j < 4; ++j) { const int n = (lane >> 3) + 8 * j; const LAS float* s = scr + (8 * c) * 33 + n;
        u32x4 o; o.x = pk2(s[0 * 33], s[1 * 33]); o.y = pk2(s[2 * 33], s[3 * 33]); o.z = pk2(s[4 * 33], s[5 * 33]); o.w = pk2(s[6 * 33], s[7 * 33]);
        *(u32x4*)(WT + (size_t)rowmap<MODE>(n0 + n) * K + k0 + 8 * c) = o; }
    asm volatile("s_waitcnt lgkmcnt(0)" ::: "memory");
}
__device__ __forceinline__ void phase0(const Params& p, LAS unsigned char* lds, int tid, int wid, int lane) {
    LAS float* scr = (LAS float*)(lds + wid * 8448);
    const int gw = blockIdx.x * 8 + wid, NGW = gridDim.x * 8;
    bf16_t* win = (bf16_t*)(p.ws + WS_WIN); bf16_t* wout = (bf16_t*)(p.ws + WS_WOUT); bf16_t* wff1 = (bf16_t*)(p.ws + WS_WFF1); bf16_t* wdn = (bf16_t*)(p.ws + WS_WDN);
    constexpr int I_IN = 16 * 112, I_OUT = 16 * 32, I_UP = 16 * 128, I_DN = 64 * 32, NITEMS = I_IN + I_OUT + 2 * I_UP + I_DN;
    for (int it = gw; it < NITEMS; it += NGW) {
        int r = it;
        if (r < I_IN) { transpose_item<0>(p.in[5], DM, NIN, win, scr, r, lane); continue; } r -= I_IN;
        if (r < I_OUT) { transpose_item<1>(p.in[6], DM, DM, wout, scr, r, lane); continue; } r -= I_OUT;
        if (r < I_UP) { transpose_item<2>(p.in[13], DM, DFF, wff1, scr, r, lane); continue; } r -= I_UP;
        if (r < I_UP) { transpose_item<3>(p.in[14], DM, DFF, wff1, scr, r, lane); continue; } r -= I_UP;
        transpose_item<1>(p.in[16], DFF, DM, wdn, scr, r, lane);
    }
    float* cosT = (float*)(p.ws + WS_COS); float* sinT = (float*)(p.ws + WS_SIN);
    for (int idx = blockIdx.x * 512 + tid; idx < 4112 * 64; idx += gridDim.x * 512) {
        const int pos = idx >> 6, f = idx & 63;
        const float inv = exp2f(-(float)(2 * f) * (1.0f / 128.0f) * 13.287712379549449f);
        const float ang = (float)pos * inv;
        const double rev = (double)ang * 0.15915494309189535;
        const float fr = (float)(rev - floor(rev));
        cosT[idx] = __builtin_amdgcn_cosf(fr); sinT[idx] = __builtin_amdgcn_sinf(fr);
    }
    bf16_t* H = (bf16_t*)(p.ws + WS_RA);
    const float* wpre = p.in[9];
    f32x4 wpr[4];
#pragma unroll
    for (int j = 0; j < 4; ++j) wpr[j] = *((const f32x4*)wpre + lane + 64 * j);
#pragma unroll 1
    for (int base = gw; base < TOK; base += RB * NGW) {
        f32x4 v[RB][4]; float s[RB];
#pragma unroll
        for (int k = 0; k < RB; ++k) { const int rr = min(base + k * NGW, TOK - 1);
            const float* xrow = rr < TOK_P ? p.in[0] + (size_t)rr * DM : p.in[1] + (size_t)(rr - TOK_P) * DM; s[k] = 0.f;
#pragma unroll
            for (int j = 0; j < 4; ++j) { v[k][j] = __builtin_nontemporal_load((const f32x4*)xrow + lane + 64 * j); s[k] += sumsq4(v[k][j]); } }
#pragma unroll
        for (int k = 0; k < RB; ++k) { const int r = base + k * NGW; const float rstd = rsqrtf(wave_sum(s[k]) * (1.0f / DM) + EPS);
            if (r < TOK) {
#pragma unroll
                for (int j = 0; j < 4; ++j) { const f32x4 y = (v[k][j] * rstd) * wpr[j];
                    __builtin_nontemporal_store((u32x2){pk2(y[0], y[1]), pk2(y[2], y[3])}, (u32x2*)(H + (size_t)r * DM) + lane + 64 * j); } } }
    }
}

constexpr int QI_OFF = 0, KI_OFF = 17408, KT_OFF = 34816, VT_OFF = 53248, SI_OFF = 71680, ST_OFF = 80896, GI_OFF = 115712;
#define MFMA16(a, b, c) __builtin_amdgcn_mfma_f32_16x16x32_bf16((a), (b), (c), 0, 0, 0)
#define RET_ISSUE(S, nn) do { _Pragma("unroll") for (int i_ = 0; i_ < 2; ++i_) { \
        const bf16_t* rowp_ = P + (tok0 + (size_t)(nn) * 64 + 2 * (tid >> 4) + i_) * NIN + 128 * h + (tid & 15) * 8; \
        if (FULL) { rq[S][i_] = *(const u32x4*)rowp_; rg[S][i_] = *(const u32x4*)(rowp_ + 1536); } rk[S][i_] = *(const u32x4*)(rowp_ + 512); rv[S][i_] = *(const u32x4*)(rowp_ + 1024); } } while (0)
#define RET_STAGE_A(S) do { const int j_ = 2 * (tid >> 4), ch_ = tid & 15; \
        if (FULL) { _Pragma("unroll") for (int i_ = 0; i_ < 2; ++i_) { *(LAS u32x4*)(lds + QI_OFF + (j_ + i_) * 272 + ch_ * 16) = rq[S][i_]; *(LAS u32x4*)(lds + KI_OFF + (j_ + i_) * 272 + ch_ * 16) = rk[S][i_]; *(LAS u32x4*)(lds + GI_OFF + (j_ + i_) * 272 + ch_ * 16) = rg[S][i_]; } } \
        const float te0_ = __builtin_amdgcn_exp2f(l2g * (float)(63 - j_)), te1_ = __builtin_amdgcn_exp2f(l2g * (float)(62 - j_)); \
        const unsigned ka_[4] = {rk[S][0].x, rk[S][0].y, rk[S][0].z, rk[S][0].w}, kb_[4] = {rk[S][1].x, rk[S][1].y, rk[S][1].z, rk[S][1].w}; \
        const unsigned va_[4] = {rv[S][0].x, rv[S][0].y, rv[S][0].z, rv[S][0].w}, vb_[4] = {rv[S][1].x, rv[S][1].y, rv[S][1].z, rv[S][1].w}; \
        const int cofs_ = 16 * ((j_ >> 3) ^ (ch_ & 7)) + 2 * (j_ & 7); \
        _Pragma("unroll") for (int e2 = 0; e2 < 4; ++e2) { const int row_ = 8 * ch_ + 2 * e2; \
            *(LAS unsigned*)(lds + KT_OFF + row_ * 144 + cofs_) = pk2(__uint_as_float(ka_[e2] << 16) * te0_, __uint_as_float(kb_[e2] << 16) * te1_); \
            *(LAS unsigned*)(lds + KT_OFF + (row_ + 1) * 144 + cofs_) = pk2(__uint_as_float(ka_[e2] & 0xffff0000u) * te0_, __uint_as_float(kb_[e2] & 0xffff0000u) * te1_); \
            *(LAS unsigned*)(lds + VT_OFF + row_ * 144 + cofs_) = (va_[e2] & 0xffffu) | (vb_[e2] << 16); \
            *(LAS unsigned*)(lds + VT_OFF + (row_ + 1) * 144 + cofs_) = (va_[e2] >> 16) | (vb_[e2] & 0xffff0000u); } } while (0)
#define WG_BAR() do { asm volatile("s_waitcnt lgkmcnt(0)" ::: "memory"); __builtin_amdgcn_s_barrier(); asm volatile("" ::: "memory"); } while (0)
template <bool FULL>
__device__ __forceinline__ void ret_unit(const Params& p, LAS unsigned char* lds, int unit, int tid, int wid, int lane) {
    asm volatile("" : "+v"(tid), "+v"(lane));
    const int G = unit & 7, h = (unit >> 3) & 3, b = unit >> 5;
    const bf16_t* P = (const bf16_t*)(p.ws + WS_RB);
    bf16_t* MIX = (bf16_t*)(p.ws + WS_RA);
    float* UG = (float*)(p.ws + WS_UG);
    const size_t tok0 = (size_t)b * 4096 + (size_t)G * 512;
    const float l2g = log2f(1.0f - exp2f(-5.0f - (float)h));
    const float g64 = __builtin_amdgcn_exp2f(l2g * 64.0f);
    const bool is_state = wid >= 4; const int w4 = wid & 3;
    const int l15 = lane & 15, l4 = lane >> 4;
    const int vtL = l4 ^ (l15 >> 3);
    const int vtb0 = VT_OFF + l15 * 144 + 16 * vtL, vtb1 = VT_OFF + l15 * 144 + 16 * (vtL ^ 2);
#define VT_ADDR(nt, ks) ((((nt) & 1) ? vtb1 : vtb0) + (nt) * 2304 + 16 * (((4 * (ks)) ^ (2 * ((nt) & 3))) & 4))
    constexpr int PD = FULL ? 1 : 4;
    u32x4 rq[PD][2], rk[PD][2], rv[PD][2], rg[PD][2];
    if (is_state) {
        f32x4 st[2][8];
#pragma unroll
        for (int mt = 0; mt < 2; ++mt)
#pragma unroll
            for (int nt = 0; nt < 8; ++nt) st[mt][nt] = (f32x4){0.f, 0.f, 0.f, 0.f};
        if (FULL) {
#pragma unroll 1
            for (int Gp = 0; Gp < G; Gp += 2) {
                const float wa = __builtin_amdgcn_exp2f(l2g * 512.0f * (float)(G - 1 - Gp));
                const bool two = Gp + 1 < G;
                const float wb = two ? __builtin_amdgcn_exp2f(l2g * 512.0f * (float)(G - 2 - Gp)) : 0.f;
                const float* sa = UG + ((size_t)((b * 4 + h) * 8 + Gp) * 4 + w4) * 4096 + lane;
                const float* sb = two ? sa + 4 * 4096 : sa;
#pragma unroll
                for (int mt = 0; mt < 2; ++mt)
#pragma unroll
                    for (int nt = 0; nt < 8; ++nt)
#pragma unroll
                        for (int r = 0; r < 4; ++r) st[mt][nt][r] += wa * sa[((mt * 8 + nt) * 4 + r) * 64] + wb * sb[((mt * 8 + nt) * 4 + r) * 64];
            }
        }
#pragma unroll
        for (int s = 0; s < PD; ++s) RET_ISSUE(s, s);
#pragma unroll 1
        for (int n0 = 0; n0 < 8; n0 += PD) {
#pragma unroll
          for (int s = 0; s < PD; ++s) { const int n = n0 + s;
            RET_STAGE_A(s);
            if (n + PD < 8) RET_ISSUE(s, n + PD);
            if (FULL) {
#pragma unroll
                for (int mt = 0; mt < 2; ++mt)
#pragma unroll
                    for (int nt = 0; nt < 8; ++nt) { const int e = 16 * nt + l15, dk0 = 32 * w4 + 16 * mt + 4 * l4;
                        *(LAS u32x2*)(lds + ST_OFF + e * 272 + dk0 * 2) = (u32x2){pk2(st[mt][nt][0], st[mt][nt][1]), pk2(st[mt][nt][2], st[mt][nt][3])}; }
            }
            WG_BAR();
            if (FULL) {
                bf16x8 ak[4];
#pragma unroll
                for (int ks = 0; ks < 4; ++ks) ak[ks] = *(const LAS bf16x8*)(lds + KI_OFF + (16 * w4 + l15) * 272 + (32 * ks + 8 * l4) * 2);
#pragma unroll
                for (int it = 0; it < 4; ++it) {
                    bf16x8 bq[4];
#pragma unroll
                    for (int ks = 0; ks < 4; ++ks) bq[ks] = *(const LAS bf16x8*)(lds + QI_OFF + (16 * it + l15) * 272 + (32 * ks + 8 * l4) * 2);
                    f32x4 sa = (f32x4){0.f, 0.f, 0.f, 0.f};
#pragma unroll
                    for (int ks = 0; ks < 4; ++ks) sa = MFMA16(ak[ks], bq[ks], sa);
                    const int i = 16 * it + l15, j0 = 16 * w4 + 4 * l4;
#pragma unroll
                    for (int r = 0; r < 4; ++r) { const int d = i - (j0 + r); sa[r] *= __builtin_amdgcn_exp2f(l2g * (float)(d < 0 ? -d : d)); }
                    *(LAS u32x2*)(lds + SI_OFF + i * 144 + j0 * 2) = (u32x2){pk2(sa[0], sa[1]), pk2(sa[2], sa[3])};
                }
            }
            WG_BAR();
#pragma unroll
            for (int mt = 0; mt < 2; ++mt)
#pragma unroll
                for (int nt = 0; nt < 8; ++nt) st[mt][nt] = st[mt][nt] * g64;
#pragma unroll
            for (int ks = 0; ks < 2; ++ks) {
                bf16x8 akt[2];
#pragma unroll
                for (int mt = 0; mt < 2; ++mt) { const int row = 32 * w4 + 16 * mt + l15; akt[mt] = *(const LAS bf16x8*)(lds + KT_OFF + row * 144 + 16 * ((4 * ks + l4) ^ ((row >> 3) & 7))); }
#pragma unroll
                for (int nh = 0; nh < 2; ++nh) {
                    bf16x8 bv[4];
#pragma unroll
                    for (int nt = 0; nt < 4; ++nt) bv[nt] = *(const LAS bf16x8*)(lds + VT_ADDR(4 * nh + nt, ks));
#pragma unroll
                    for (int nt = 0; nt < 4; ++nt)
#pragma unroll
                        for (int mt = 0; mt < 2; ++mt) st[mt][4 * nh + nt] = MFMA16(akt[mt], bv[nt], st[mt][4 * nh + nt]);
                }
            }
            WG_BAR();
          }
        }
        if (!FULL) {
            float* dst = UG + ((size_t)unit * 4 + w4) * 4096 + lane;
#pragma unroll
            for (int mt = 0; mt < 2; ++mt)
#pragma unroll
                for (int nt = 0; nt < 8; ++nt)
#pragma unroll
                    for (int r = 0; r < 4; ++r) dst[((mt * 8 + nt) * 4 + r) * 64] = st[mt][nt][r];
        } else if (G == 7) {
            float* o = p.out + O_SRP + (size_t)(b * 4 + h) * 16384 + (64 * (l4 & 1) + 16 * w4 + 4 * (l4 >> 1)) * 128 + l15;
#pragma unroll
            for (int mt = 0; mt < 2; ++mt)
#pragma unroll
                for (int nt = 0; nt < 8; ++nt)
#pragma unroll
                    for (int r = 0; r < 4; ++r) o[(8 * mt + r) * 128 + 16 * nt] = st[mt][nt][r];
        }
    } else {
        float rwv[8];
#pragma unroll
        for (int nt = 0; nt < 8; ++nt) rwv[nt] = p.in[8][128 * h + 16 * nt + l15];
#pragma unroll
        for (int s = 0; s < PD; ++s) RET_ISSUE(s, s);
#pragma unroll 1
        for (int n0 = 0; n0 < 8; n0 += PD) {
#pragma unroll
          for (int s = 0; s < PD; ++s) { const int n = n0 + s;
            RET_STAGE_A(s);
            if (n + PD < 8) RET_ISSUE(s, n + PD);
            WG_BAR();
            f32x4 acc[8];
            if (FULL) {
                f32x4 fsv;
#pragma unroll
                for (int r = 0; r < 4; ++r) fsv[r] = __builtin_amdgcn_exp2f(l2g * (float)(16 * w4 + 4 * l4 + r + 1));
#pragma unroll
                for (int nt = 0; nt < 8; ++nt) acc[nt] = (f32x4){0.f, 0.f, 0.f, 0.f};
                bf16x8 aq[4];
#pragma unroll
                for (int ks = 0; ks < 4; ++ks) aq[ks] = *(const LAS bf16x8*)(lds + QI_OFF + (16 * w4 + l15) * 272 + (32 * ks + 8 * l4) * 2);
#pragma unroll
                for (int ks = 0; ks < 4; ++ks)
#pragma unroll
                    for (int nh = 0; nh < 2; ++nh) {
                        bf16x8 bs[4];
#pragma unroll
                        for (int nt = 0; nt < 4; ++nt) bs[nt] = *(const LAS bf16x8*)(lds + ST_OFF + (16 * (4 * nh + nt) + l15) * 272 + (32 * ks + 8 * l4) * 2);
#pragma unroll
                        for (int nt = 0; nt < 4; ++nt) acc[4 * nh + nt] = MFMA16(aq[ks], bs[nt], acc[4 * nh + nt]);
                    }
#pragma unroll
                for (int nt = 0; nt < 8; ++nt) acc[nt] = acc[nt] * fsv;
            }
            WG_BAR();
            if (FULL) {
                bf16x8 as_[2];
#pragma unroll
                for (int ks = 0; ks < 2; ++ks) as_[ks] = *(const LAS bf16x8*)(lds + SI_OFF + (16 * w4 + l15) * 144 + 16 * (4 * ks + l4));
#pragma unroll
                for (int ks = 0; ks < 2; ++ks)
#pragma unroll
                    for (int nh = 0; nh < 2; ++nh) {
                        bf16x8 bv[4];
#pragma unroll
                        for (int nt = 0; nt < 4; ++nt) bv[nt] = *(const LAS bf16x8*)(lds + VT_ADDR(4 * nh + nt, ks));
#pragma unroll
                        for (int nt = 0; nt < 4; ++nt) acc[4 * nh + nt] = MFMA16(as_[ks], bv[nt], acc[4 * nh + nt]);
                    }
                unsigned short gq[4][8];
#pragma unroll
                for (int r = 0; r < 4; ++r)
#pragma unroll
                    for (int nt = 0; nt < 8; ++nt) gq[r][nt] = *(const LAS unsigned short*)(lds + GI_OFF + (16 * w4 + 4 * l4 + r) * 272 + (16 * nt + l15) * 2);
                float rstd[4];
#pragma unroll
                for (int r = 0; r < 4; ++r) { float ss = 0.f;
#pragma unroll
                    for (int nt = 0; nt < 8; ++nt) ss += acc[nt][r] * acc[nt][r];
                    ss += dppf(ss, 1); ss += dppf(ss, 2); ss += dppf(ss, 4); ss += dppf(ss, 8);
                    ss = __shfl(ss, (lane & 48) | 15);
                    rstd[r] = rsqrtf(ss * (1.0f / 128.0f) + EPS); }
#pragma unroll
                for (int r = 0; r < 4; ++r)
#pragma unroll
                    for (int nt = 0; nt < 8; ++nt)
                        *(LAS unsigned short*)(lds + QI_OFF + (16 * w4 + 4 * l4 + r) * 272 + (16 * nt + l15) * 2) = (unsigned short)(pk2s(acc[nt][r] * rstd[r] * rwv[nt] * silu_f(bf2f(gq[r][nt])), 0.f) & 0xffffu);
#pragma unroll
                for (int q = 0; q < 4; ++q) { const int cidx = lane + 64 * q, row = 16 * w4 + (cidx >> 4), ch = cidx & 15;
                    const u32x4 v = *(const LAS u32x4*)(lds + QI_OFF + row * 272 + ch * 16);
                    *(u32x4*)(MIX + (tok0 + (size_t)n * 64 + row) * DM + 128 * h + ch * 8) = v; }
            }
            WG_BAR();
          }
        }
    }
#ifndef CONVREP
#define CONVREP 1
#endif
    if (FULL) for (int crep_ = 0; crep_ < CONVREP; ++crep_) {
        const int c0 = 128 * h + 8 * (tid & 15), run = tid >> 4, t0 = G * 512 + run * 16;
        const float* cwp = p.in[7];
        float w0[8], w1[8], w2[8], p1[8], p2[8];
#pragma unroll
        for (int e = 0; e < 8; ++e) { w0[e] = cwp[c0 + e]; w1[e] = cwp[512 + c0 + e]; w2[e] = cwp[1024 + c0 + e]; p1[e] = 0.f; p2[e] = 0.f; }
        if (t0 > 0) {
            const bf16_t* r2 = P + ((size_t)b * 4096 + t0 - 2) * NIN; const bf16_t* r1 = r2 + NIN;
            const u32x4 c2 = *(const u32x4*)(r2 + 2560 + c0), h2 = *(const u32x4*)(r2 + 3072 + c0), c1 = *(const u32x4*)(r1 + 2560 + c0), h1 = *(const u32x4*)(r1 + 3072 + c0);
            const unsigned c2w[4] = {c2.x, c2.y, c2.z, c2.w}, h2w[4] = {h2.x, h2.y, h2.z, h2.w}, c1w[4] = {c1.x, c1.y, c1.z, c1.w}, h1w[4] = {h1.x, h1.y, h1.z, h1.w};
#pragma unroll
            for (int e = 0; e < 4; ++e) {
                p2[2 * e] = __uint_as_float(c2w[e] << 16) * __uint_as_float(h2w[e] << 16); p2[2 * e + 1] = __uint_as_float(c2w[e] & 0xffff0000u) * __uint_as_float(h2w[e] & 0xffff0000u);
                p1[2 * e] = __uint_as_float(c1w[e] << 16) * __uint_as_float(h1w[e] << 16); p1[2 * e + 1] = __uint_as_float(c1w[e] & 0xffff0000u) * __uint_as_float(h1w[e] & 0xffff0000u); }
        }
#pragma unroll 8
        for (int t = 0; t < 16; ++t) {
            const size_t row = (size_t)b * 4096 + t0 + t;
            const bf16_t* rp = P + row * NIN;
            const u32x4 bb = *(const u32x4*)(rp + 2048 + c0), cc = *(const u32x4*)(rp + 2560 + c0), hh = *(const u32x4*)(rp + 3072 + c0);
            const unsigned bw[4] = {bb.x, bb.y, bb.z, bb.w}, cw4[4] = {cc.x, cc.y, cc.z, cc.w}, hw[4] = {hh.x, hh.y, hh.z, hh.w};
            float y[8];
#pragma unroll
            for (int e = 0; e < 4; ++e) {
                const float ca = __uint_as_float(cw4[e] << 16) * __uint_as_float(hw[e] << 16), cb = __uint_as_float(cw4[e] & 0xffff0000u) * __uint_as_float(hw[e] & 0xffff0000u);
                y[2 * e] = __uint_as_float(bw[e] << 16) * (w0[2 * e] * p2[2 * e] + w1[2 * e] * p1[2 * e] + w2[2 * e] * ca);
                y[2 * e + 1] = __uint_as_float(bw[e] & 0xffff0000u) * (w0[2 * e + 1] * p2[2 * e + 1] + w1[2 * e + 1] * p1[2 * e + 1] + w2[2 * e + 1] * cb);
                p2[2 * e] = p1[2 * e]; p2[2 * e + 1] = p1[2 * e + 1]; p1[2 * e] = ca; p1[2 * e + 1] = cb;
            }
            *(u32x4*)(MIX + row * DM + 512 + c0) = (u32x4){pk2(y[0], y[1]), pk2(y[2], y[3]), pk2(y[4], y[5]), pk2(y[6], y[7])};
        }
        if (G == 7 && run == 31) {
            float* o = p.out + O_CCP + (size_t)b * 1024 + c0;
#pragma unroll
            for (int e = 0; e < 8; ++e) { o[e] = p2[e]; o[512 + e] = p1[e]; }
        }
    }
#undef VT_ADDR
}

__device__ __forceinline__ float ch_at(const float* PS, const float* cache, int b, int t, int ch) {
    if (t < 0) return cache[(b * 2 + (t + 2)) * 512 + ch];
    const float* rp = PS + (size_t)(16 * b + t) * NIN;
    return rp[2560 + ch] * rp[3072 + ch];
}
__device__ __forceinline__ void sample_unit(const Params& p, LAS unsigned char* lds, int su, int tid, int wid, int lane) {
    const int b = su >> 2, h = su & 3, ts0 = TOK_P + 16 * b;
    const float* PS = (const float*)(p.ws + WS_PS);
    bf16_t* MIX = (bf16_t*)(p.ws + WS_RA);
    LAS float* qs = (LAS float*)lds; LAS float* ks = qs + 2048; LAS float* vs = qs + 4096; LAS float* Ssm = qs + 6144; LAS float* osm = qs + 6400;
    const float l2g = log2f(1.0f - exp2f(-5.0f - (float)h));
    const float* cosT = (const float*)(p.ws + WS_COS); const float* sinT = (const float*)(p.ws + WS_SIN);
    for (int idx = tid; idx < 2048; idx += 512) { const int i = idx >> 7, c = idx & 127, d = dmap(c);
        const float* rp = PS + (size_t)(16 * b + i) * NIN + 128 * h;
        const float cs = cosT[(4096 + i) * 64 + (d & 63)], sn = sinT[(4096 + i) * 64 + (d & 63)];
        const float xq = rp[c], xqp = rp[c ^ 4], xk = rp[512 + c], xkp = rp[512 + (c ^ 4)];
        qs[i * 128 + d] = d < 64 ? xq * cs - xqp * sn : xq * cs + xqp * sn;
        ks[i * 128 + d] = (d < 64 ? xk * cs - xkp * sn : xk * cs + xkp * sn) * 0.08838834764831845f;
        vs[i * 128 + c] = rp[1024 + c]; }
    __syncthreads();
    if (tid < 256) { const int i = tid >> 4, j = tid & 15; float s = 0.f;
        for (int d = 0; d < 128; ++d) s += qs[i * 128 + d] * ks[j * 128 + d];
        const int dd = i - j; Ssm[i * 16 + j] = s * __builtin_amdgcn_exp2f(l2g * (float)(dd < 0 ? -dd : dd)); }
    const int e = tid & 127, ig = tid >> 7;
    LAS float* s0 = qs + 8704;
    { const float* s0g = p.in[2] + (size_t)su * 16384; f32x4 t8[8];
#pragma unroll
      for (int q = 0; q < 8; ++q) t8[q] = *((const f32x4*)s0g + tid + 512 * q);
#pragma unroll
      for (int q = 0; q < 8; ++q) *((LAS f32x4*)s0 + tid + 512 * q) = t8[q]; }
    __syncthreads();
    float cr[4] = {0.f, 0.f, 0.f, 0.f};
#pragma unroll 4
    for (int d = 0; d < 128; ++d) { const float sv = s0[d * 128 + e];
#pragma unroll
        for (int r = 0; r < 4; ++r) cr[r] += qs[(ig * 4 + r) * 128 + d] * sv; }
    __syncthreads();
#pragma unroll
    for (int r = 0; r < 4; ++r) { const int i = ig * 4 + r; float o = 0.f;
        for (int j = 0; j < 16; ++j) o += Ssm[i * 16 + j] * vs[j * 128 + e];
        osm[i * 128 + e] = o + __builtin_amdgcn_exp2f(l2g * (float)(i + 1)) * cr[r]; }
    __syncthreads();
    for (int rr = 0; rr < 2; ++rr) { const int i = 2 * wid + rr; const float v0 = osm[i * 128 + lane], v1 = osm[i * 128 + 64 + lane];
        const float rstd = rsqrtf(wave_sum(v0 * v0 + v1 * v1) * (1.0f / 128.0f) + EPS);
        const size_t token = (size_t)(ts0 + i);
        const float g0 = PS[(size_t)(16 * b + i) * NIN + 1536 + 128 * h + lane], g1 = PS[(size_t)(16 * b + i) * NIN + 1536 + 128 * h + 64 + lane];
        MIX[token * DM + 128 * h + lane] = (bf16_t)(pk2(v0 * rstd * p.in[8][128 * h + lane] * silu_f(g0), 0.f) & 0xffffu);
        MIX[token * DM + 128 * h + 64 + lane] = (bf16_t)(pk2(v1 * rstd * p.in[8][128 * h + 64 + lane] * silu_f(g1), 0.f) & 0xffffu); }
    const float g16 = __builtin_amdgcn_exp2f(l2g * 16.0f);
    float* outS = p.out + O_SRS + (size_t)su * 16384;
#pragma unroll 2
    for (int dd = 0; dd < 32; ++dd) { const int d = ig + 4 * dd; float a = g16 * s0[d * 128 + e];
        for (int j = 0; j < 16; ++j) a += __builtin_amdgcn_exp2f(l2g * (float)(15 - j)) * ks[j * 128 + d] * vs[j * 128 + e];
        outS[d * 128 + e] = a; }
    const int ch = 128 * h + e; const float* cache = p.in[3]; const float* cwp = p.in[7];
    const float w0 = cwp[ch], w1 = cwp[512 + ch], w2 = cwp[1024 + ch];
#pragma unroll
    for (int tt = 0; tt < 4; ++tt) { const int t = ig * 4 + tt;
        const float c0 = ch_at(PS, cache, b, t - 2, ch), c1 = ch_at(PS, cache, b, t - 1, ch), c2 = ch_at(PS, cache, b, t, ch);
        const float y = PS[(size_t)(16 * b + t) * NIN + 2048 + ch] * (w0 * c0 + w1 * c1 + w2 * c2);
        MIX[(size_t)(ts0 + t) * DM + 512 + ch] = (bf16_t)(pk2(y, 0.f) & 0xffffu);
        if (t >= 14) p.out[O_CCS + (size_t)(b * 2 + t - 14) * 512 + ch] = c2; }
    __syncthreads();
}

constexpr int TG_B = 34816, TG_BUF = 34816 + 32 * 272;
template <int NB>
__device__ __forceinline__ void thin_gemm2(LAS unsigned char* lds, const bf16_t* A, int lda, const bf16_t* Bt, int ldb, int n0, int nbstride, int kbeg, int klen, f32x4 (&acc)[NB], int tid, int wid, int lane) {
    const int l15 = lane & 15, l4 = lane >> 4, nkb = klen >> 7;
    const bool hasb = tid < NB * 256;
    const bf16_t* ag = A + (size_t)(tid >> 4) * lda + kbeg + (tid & 15) * 8;
    const bf16_t* bg = Bt + (size_t)(n0 + (tid >> 8) * nbstride + ((tid >> 4) & 15)) * ldb + kbeg + (tid & 15) * 8;
    const int sto = (tid >> 4) * 272 + (tid & 15) * 16;
    const int fro = l15 * 272 + (8 * l4) * 2;
    u32x4 Xa[4], Ya[4], Xb = (u32x4){0u, 0u, 0u, 0u}, Yb = Xb;
#define TG_LOAD(R, kb) do { _Pragma("unroll") for (int i_ = 0; i_ < 4; ++i_) R##a[i_] = *(const u32x4*)(ag + (size_t)(32 * i_) * lda + (kb) * 128); if (hasb) R##b = *(const u32x4*)(bg + (kb) * 128); } while (0)
#define TG_STORE(R, buf) do { _Pragma("unroll") for (int i_ = 0; i_ < 4; ++i_) *(LAS u32x4*)(lds + (buf) * TG_BUF + sto + i_ * 32 * 272) = R##a[i_]; if (hasb) *(LAS u32x4*)(lds + (buf) * TG_BUF + TG_B + sto) = R##b; } while (0)
#define TG_COMP(buf) do { _Pragma("unroll") for (int ks = 0; ks < 4; ++ks) { const bf16x8 a_ = *(const LAS bf16x8*)(lds + (buf) * TG_BUF + 16 * wid * 272 + fro + ks * 64); \
        _Pragma("unroll") for (int nb = 0; nb < NB; ++nb) { const bf16x8 b_ = *(const LAS bf16x8*)(lds + (buf) * TG_BUF + TG_B + 16 * nb * 272 + fro + ks * 64); acc[nb] = MFMA16(a_, b_, acc[nb]); } } } while (0)
#pragma unroll
    for (int nb = 0; nb < NB; ++nb) acc[nb] = (f32x4){0.f, 0.f, 0.f, 0.f};
    TG_LOAD(X, 0); TG_LOAD(Y, 1);
    TG_STORE(X, 0); WG_BAR();
#pragma unroll 1
    for (int kb = 0; kb < nkb; kb += 2) {
        if (kb + 2 < nkb) TG_LOAD(X, kb + 2);
        TG_COMP(0);
        TG_STORE(Y, 1); WG_BAR();
        if (kb + 3 < nkb) TG_LOAD(Y, kb + 3);
        TG_COMP(1);
        if (kb + 2 < nkb) TG_STORE(X, 0);
        WG_BAR();
    }
#undef TG_LOAD
#undef TG_STORE
#undef TG_COMP
}
template <int NB>
__device__ __forceinline__ void thin_gemm(const bf16_t* A, int lda, const bf16_t* Bt, int ldb, int n0, int nbstride, int kbeg, int klen, f32x4 (&acc)[NB], int wid, int lane) {
    const int l15 = lane & 15, l4 = lane >> 4;
    const bf16_t* ap = A + (size_t)(16 * wid + l15) * lda + kbeg + 8 * l4;
    const bf16_t* bp = Bt + (size_t)(n0 + l15) * ldb + kbeg + 8 * l4;
#pragma unroll
    for (int nb = 0; nb < NB; ++nb) acc[nb] = (f32x4){0.f, 0.f, 0.f, 0.f};
#pragma unroll 1
    for (int s0 = 0; s0 < klen; s0 += 256) {
        bf16x8 a[8], b[NB][8];
#pragma unroll
        for (int s = 0; s < 8; ++s) { a[s] = *(const bf16x8*)(ap + s0 + 32 * s);
#pragma unroll
            for (int nb = 0; nb < NB; ++nb) b[nb][s] = *(const bf16x8*)(bp + (size_t)nb * nbstride * ldb + s0 + 32 * s); }
#pragma unroll
        for (int s = 0; s < 8; ++s)
#pragma unroll
            for (int nb = 0; nb < NB; ++nb) acc[nb] = MFMA16(a[s], b[nb][s], acc[nb]);
    }
}
__device__ __forceinline__ void thin_store(const f32x4& acc, float* out, int ldo, int col, int wid, int lane) {
#pragma unroll
    for (int r = 0; r < 4; ++r) out[(size_t)(16 * wid + 4 * (lane >> 4) + r) * ldo + col + (lane & 15)] = acc[r];
}
__device__ __forceinline__ void thin_ffn1(const Params& p, LAS unsigned char* lds, int c, int tid, int wid, int lane) {
    const int pn = c >> 3, j16 = c & 7, l15 = lane & 15, l4 = lane >> 4;
    f32x4 acc[2];
    thin_gemm2<2>(lds, (const bf16_t*)(p.ws + WS_RA) + (size_t)TOK_P * DM, DM, (const bf16_t*)(p.ws + WS_WFF1), DM, 256 * pn + 16 * j16, 128, 0, DM, acc, tid, wid, lane);
    const int ch = 128 * pn + 16 * j16 + l15, b = wid;
    const float* cw = p.in[15]; const float* cache = p.in[4] + (size_t)b * 2 * DFF + ch;
    const float w0 = cw[ch], w1 = cw[DFF + ch], w2 = cw[2 * DFF + ch];
    const f32x4 up = acc[0], gt = acc[1];
    float pm1 = __shfl_up(up[3], 16), pm2 = __shfl_up(up[2], 16);
    if (l4 == 0) { pm1 = cache[DFF]; pm2 = cache[0]; }
    float uc[4];
    uc[0] = w0 * pm2 + w1 * pm1 + w2 * up[0];
    uc[1] = w0 * pm1 + w1 * up[0] + w2 * up[1];
    uc[2] = w0 * up[0] + w1 * up[1] + w2 * up[2];
    uc[3] = w0 * up[1] + w1 * up[2] + w2 * up[3];
    bf16_t* ACT = (bf16_t*)(p.ws + WS_RB);
#pragma unroll
    for (int r = 0; r < 4; ++r) ACT[(size_t)(TOK_P + 16 * wid + 4 * l4 + r) * DFF + ch] = (bf16_t)(pk2(pg8::gelu_tanh(uc[r]) * gt[r], 0.f) & 0xffffu);
    if (l4 == 3) { float* o = p.out + O_CFS + (size_t)b * 2 * DFF + ch; o[0] = up[2]; o[DFF] = up[3]; }
}

__device__ __forceinline__ void phase4(const Params& p, int wid, int lane) {
    const int gw = blockIdx.x * 8 + wid, NGW = gridDim.x * 8;
    const bf16_t* Y = (const bf16_t*)(p.ws + WS_Y); bf16_t* H2 = (bf16_t*)(p.ws + WS_RA); const float* ssq = (const float*)(p.ws + WS_SSQ1);
    const float* wpost = p.in[10]; const float* wpre = p.in[11];
    f32x4 wpo[4], wpr[4];
#pragma unroll
    for (int j = 0; j < 4; ++j) { wpo[j] = *((const f32x4*)wpost + lane + 64 * j); wpr[j] = *((const f32x4*)wpre + lane + 64 * j); }
#pragma unroll 1
    for (int base = gw; base < TOK_P; base += RB * NGW) {
        f32x4 v[RB][4]; u32x2 yw[RB][4]; float sq[RB];
#pragma unroll
        for (int k = 0; k < RB; ++k) { const int rr = min(base + k * NGW, TOK_P - 1);
            sq[k] = lane < 16 ? ssq[(size_t)rr * 16 + lane] : 0.f;
#pragma unroll
            for (int j = 0; j < 4; ++j) { v[k][j] = __builtin_nontemporal_load((const f32x4*)(p.in[0] + (size_t)rr * DM) + lane + 64 * j); yw[k][j] = __builtin_nontemporal_load((const u32x2*)(Y + (size_t)rr * DM) + lane + 64 * j); } }
        float s2[RB];
#pragma unroll
        for (int k = 0; k < RB; ++k) { const float rstd1 = rsqrtf(wave_sum(sq[k]) * (1.0f / DM) + EPS); s2[k] = 0.f;
#pragma unroll
            for (int j = 0; j < 4; ++j) { v[k][j] = v[k][j] + (unpack_bf4(yw[k][j]) * rstd1) * wpo[j]; s2[k] += sumsq4(v[k][j]); } }
#pragma unroll
        for (int k = 0; k < RB; ++k) { const int r = base + k * NGW; const float rstd2 = rsqrtf(wave_sum(s2[k]) * (1.0f / DM) + EPS);
            if (r < TOK_P) {
#pragma unroll
                for (int j = 0; j < 4; ++j) { const f32x4 y = (v[k][j] * rstd2) * wpr[j];
                    __builtin_nontemporal_store((u32x2){pk2(y[0], y[1]), pk2(y[2], y[3])}, (u32x2*)(H2 + (size_t)r * DM) + lane + 64 * j); } } }
    }
    for (int r = TOK_P + gw; r < TOK; r += NGW) {
        const float* xrow = p.in[1] + (size_t)(r - TOK_P) * DM; const float* ys = (const float*)(p.ws + WS_YS) + (size_t)(r - TOK_P) * DM;
        f32x4 yv[4], v[4]; float s = 0.f, s2 = 0.f;
#pragma unroll
        for (int j = 0; j < 4; ++j) { f32x4 a = *((const f32x4*)ys + lane + 64 * j);
#pragma unroll
            for (int q = 1; q < 4; ++q) a += *((const f32x4*)(ys + (size_t)q * 128 * DM) + lane + 64 * j);
            yv[j] = a; s += sumsq4(a); }
        const float rstd1 = rsqrtf(wave_sum(s) * (1.0f / DM) + EPS);
#pragma unroll
        for (int j = 0; j < 4; ++j) { v[j] = *((const f32x4*)xrow + lane + 64 * j) + (yv[j] * rstd1) * wpo[j]; s2 += sumsq4(v[j]);
 }
        const float rstd2 = rsqrtf(wave_sum(s2) * (1.0f / DM) + EPS);
#pragma unroll
        for (int j = 0; j < 4; ++j) { const f32x4 y = (v[j] * rstd2) * wpr[j]; *((u32x2*)(H2 + (size_t)r * DM) + lane + 64 * j) = (u32x2){pk2(y[0], y[1]), pk2(y[2], y[3])}; }
    }
}
__device__ __forceinline__ void phase7(const Params& p, int wid, int lane) {
    const int gw = blockIdx.x * 8 + wid, NGW = gridDim.x * 8;
    const bf16_t* F = (const bf16_t*)(p.ws + WS_RA); const bf16_t* Y = (const bf16_t*)(p.ws + WS_Y);
    const float* ssq1 = (const float*)(p.ws + WS_SSQ1); const float* ssq2 = (const float*)(p.ws + WS_SSQ2);
    f32x4 wm[4], wf[4];
#pragma unroll
    for (int j = 0; j < 4; ++j) { wm[j] = *((const f32x4*)p.in[10] + lane + 64 * j); wf[j] = *((const f32x4*)p.in[12] + lane + 64 * j); }
    constexpr int RB7 = 4;
#pragma unroll 1
    for (int base = gw; base < TOK_P; base += RB7 * NGW) {
        f32x4 v[RB7][4]; u32x2 yw[RB7][4], fw[RB7][4]; float sq1[RB7], sq2[RB7];
#pragma unroll
        for (int k = 0; k < RB7; ++k) { const int rr = min(base + k * NGW, TOK_P - 1);
            sq1[k] = lane < 16 ? ssq1[(size_t)rr * 16 + lane] : 0.f; sq2[k] = lane < 16 ? ssq2[(size_t)rr * 16 + lane] : 0.f;
#pragma unroll
            for (int j = 0; j < 4; ++j) { v[k][j] = __builtin_nontemporal_load((const f32x4*)(p.in[0] + (size_t)rr * DM) + lane + 64 * j);
                yw[k][j] = __builtin_nontemporal_load((const u32x2*)(Y + (size_t)rr * DM) + lane + 64 * j); fw[k][j] = __builtin_nontemporal_load((const u32x2*)(F + (size_t)rr * DM) + lane + 64 * j); } }
#pragma unroll
        for (int k = 0; k < RB7; ++k) { const int r = base + k * NGW;
            const float rstd1 = rsqrtf(wave_sum(sq1[k]) * (1.0f / DM) + EPS), rstd2 = rsqrtf(wave_sum(sq2[k]) * (1.0f / DM) + EPS);
            if (r < TOK_P) {
#pragma unroll
                for (int j = 0; j < 4; ++j) __builtin_nontemporal_store(v[k][j] + (unpack_bf4(yw[k][j]) * rstd1) * wm[j] + (unpack_bf4(fw[k][j]) * rstd2) * wf[j], (f32x4*)(p.out + (size_t)r * DM) + lane + 64 * j); } }
    }
    for (int r = TOK_P + gw; r < TOK; r += NGW) {
        const float* xrow = p.in[1] + (size_t)(r - TOK_P) * DM;
        const float* ys = (const float*)(p.ws + WS_YS) + (size_t)(r - TOK_P) * DM; const float* fs = (const float*)(p.ws + WS_FS) + (size_t)(r - TOK_P) * DM;
        f32x4 yv[4], fv[4]; float s1 = 0.f, s2 = 0.f;
#pragma unroll
        for (int j = 0; j < 4; ++j) { f32x4 a = *((const f32x4*)ys + lane + 64 * j), c = *((const f32x4*)fs + lane + 64 * j);
#pragma unroll
            for (int q = 1; q < 4; ++q) { a += *((const f32x4*)(ys + (size_t)q * 128 * DM) + lane + 64 * j); c += *((const f32x4*)(fs + (size_t)q * 128 * DM) + lane + 64 * j); }
            yv[j] = a; fv[j] = c; s1 += sumsq4(a); s2 += sumsq4(c); }
        const float rstd1 = rsqrtf(wave_sum(s1) * (1.0f / DM) + EPS), rstd2 = rsqrtf(wave_sum(s2) * (1.0f / DM) + EPS);
#pragma unroll
        for (int j = 0; j < 4; ++j) *((f32x4*)(p.out + (size_t)r * DM) + lane + 64 * j) = *((const f32x4*)xrow + lane + 64 * j) + (yv[j] * rstd1) * wm[j] + (fv[j] * rstd2) * wf[j];
    }
}


#define XB_TMO      128
#define XB_XCNT(j)  (256  + 64 * (j))
#define XB_XSUB(j)  (1280 + 64 * (j))
#define XB_XGEN(j)  (2304 + 64 * (j))
#define XB_TOP      3328
#define XB_TOPGEN   3392
#define XCD_BAR_WORDS 3456
#define XB_SPIN_CAP (1u << 18)

__device__ __forceinline__ unsigned xb_ld(unsigned* p)              { return __hip_atomic_load(p, __ATOMIC_RELAXED, __HIP_MEMORY_SCOPE_AGENT); }
__device__ __forceinline__ unsigned xb_add(unsigned* p, unsigned v) { return __hip_atomic_fetch_add(p, v, __ATOMIC_RELAXED, __HIP_MEMORY_SCOPE_AGENT); }
__device__ __forceinline__ unsigned xb_xcc_id() { return (unsigned)__builtin_amdgcn_s_getreg((3 << 11) | 20) & 0xFu; }
#define XB_SPIN(cond, bar) do { unsigned _sp = 0; while (cond) { __builtin_amdgcn_s_sleep(1); \
    if ((++_sp & 255u) == 0u) { if (xb_ld(&(bar)[XB_TMO])) break; if (_sp > XB_SPIN_CAP) { atomicAdd(&(bar)[XB_TMO], 1u); break; } } } } while (0)

struct XcdBarrier {
    unsigned* bar; unsigned x;
    volatile LAS unsigned* st;
};

__device__ __forceinline__ XcdBarrier xcd_barrier_post(unsigned* bar, volatile LAS unsigned* st) {
    XcdBarrier b; b.bar = bar; b.x = xb_xcc_id(); b.st = st;
    if (threadIdx.x == 0) (void)xb_add(&bar[XB_XCNT(b.x)], 1u);
    return b;
}
__device__ __forceinline__ void xcd_barrier_complete(unsigned* bar, unsigned x, unsigned& nloc, unsigned& nx) {
    const unsigned G = gridDim.x * gridDim.y * gridDim.z;
    unsigned sum, cnt, mine, sp = 0u;
    for (;;) {
        sum = 0u; cnt = 0u; mine = 0u;
#pragma unroll
        for (unsigned j = 0; j < 16; ++j) { const unsigned c = xb_ld(&bar[XB_XCNT(j)]); sum += c; cnt += (c > 0u) ? 1u : 0u; mine = (j == x) ? c : mine; }
        if (sum == G) break;
        __builtin_amdgcn_s_sleep(1);
        if ((++sp & 255u) == 0u) { if (xb_ld(&bar[XB_TMO])) break; if (sp > XB_SPIN_CAP) { atomicAdd(&bar[XB_TMO], 1u); break; } }
    }
    nloc = mine > 0u ? mine : 1u; nx = cnt > 0u ? cnt : 1u;
}

__device__ __forceinline__ void xcd_barrier(const XcdBarrier& b) {
    asm volatile("s_waitcnt vmcnt(0)" ::: "memory");
    __syncthreads();
    if (threadIdx.x == 0) {
        unsigned* bar = b.bar;
        __builtin_amdgcn_s_waitcnt(0);
        unsigned nloc = b.st[0], nx = b.st[1];
        if (nloc == 0u) { xcd_barrier_complete(bar, b.x, nloc, nx); b.st[0] = nloc; b.st[1] = nx; }
        const unsigned old = xb_add(&bar[XB_XSUB(b.x)], 1u);
        const unsigned gen = old / nloc;
        if (old + 1u == (gen + 1u) * nloc) {
            __builtin_amdgcn_fence(__ATOMIC_RELEASE, "agent");
            asm volatile("s_waitcnt vmcnt(0)" ::: "memory");
            const unsigned og = xb_add(&bar[XB_TOP], 1u);
            const unsigned tg = og / nx;
            if (og + 1u == (tg + 1u) * nx) xb_add(&bar[XB_TOPGEN], 1u);
            else XB_SPIN(xb_ld(&bar[XB_TOPGEN]) == tg, bar);
            __builtin_amdgcn_fence(__ATOMIC_ACQUIRE, "agent");
            xb_add(&bar[XB_XGEN(b.x)], 1u);
            asm volatile("s_waitcnt vmcnt(0)" ::: "memory");
        } else {
            XB_SPIN(xb_ld(&bar[XB_XGEN(b.x)]) == gen, bar);
            __builtin_amdgcn_fence(__ATOMIC_ACQUIRE, "agent");
            asm volatile("s_waitcnt vmcnt(0)" ::: "memory");
        }
    }
    __syncthreads();
}

#ifndef MK_LAUNCHES
#define MK_LAUNCHES 1
#endif
#ifndef REP0
#define REP0 1
#endif
#ifndef REP1
#define REP1 1
#endif
#ifndef REP2
#define REP2 1
#endif
#ifndef REP3
#define REP3 1
#endif
#ifndef REP4
#define REP4 1
#endif
#ifndef REP5
#define REP5 1
#endif
#ifndef REP6
#define REP6 1
#endif
#ifndef REP7
#define REP7 1
#endif
#define REPEAT(n) for (int rep_ = 0; rep_ < (n); ++rep_, ((rep_ < (n)) ? GRIDSYNC() : (void)0))
template <int PH_LO, int PH_HI>
__device__ __forceinline__ void run_phases(const Params& p, LAS unsigned char* lds) {
    int tid = threadIdx.x, lane = tid & 63; const int wid = __builtin_amdgcn_readfirstlane(tid >> 6);
    const int G = gridDim.x, c = blockIdx.x;
#define LAUNDER() asm volatile("" : "+v"(tid), "+v"(lane))
    XcdBarrier bar_;
    if (PH_HI - PH_LO > 1) {
        volatile LAS unsigned* stw = (volatile LAS unsigned*)(lds + LDS_BARW);
        if (threadIdx.x == 0) { stw[0] = 0u; stw[1] = 0u; }
        __syncthreads();
        bar_ = xcd_barrier_post((unsigned*)p.ws, stw);
        if (p.ws == nullptr) cg::this_grid().sync();
    }
#define GRIDSYNC() xcd_barrier(bar_)
#define SEAM(ph) do { if (PH_LO <= (ph) && (ph) + 1 < PH_HI) { GRIDSYNC(); } } while (0)
#ifdef XSYNC
    for (int xs_ = 0; xs_ < XSYNC; ++xs_) GRIDSYNC();
#endif
    if (PH_LO <= 0 && 0 < PH_HI) REPEAT(REP0) { LAUNDER(); phase0(p, lds, tid, wid, lane); }
    SEAM(0);
    if (PH_LO <= 1 && 1 < PH_HI) REPEAT(REP1) {
        for (int t = c; t < 224; t += G) { f32x4 acc[1]; thin_gemm2<1>(lds, (const bf16_t*)(p.ws + WS_RA) + (size_t)TOK_P * DM, DM, (const bf16_t*)(p.ws + WS_WIN), DM, 16 * t, 0, 0, DM, acc, tid, wid, lane);
            thin_store(acc[0], (float*)(p.ws + WS_PS), NIN, 16 * t, wid, lane); }
        pg8::Gemm g{(const bf16_t*)(p.ws + WS_RA), (const bf16_t*)(p.ws + WS_WIN), TOK_P, NIN, DM};
        pg8::StaticOrder S; S.init(TOK_P, NIN, G, c);
        pg8::EpiIn E{(bf16_t*)(p.ws + WS_RB), (const float*)(p.ws + WS_COS), (const float*)(p.ws + WS_SIN)};
        pg8::gemm_phase<pg8::EpiIn, pg8::StaticOrder, true, true>(lds, g, S, E);
    }
    SEAM(1);
    if (PH_LO <= 2 && 2 < PH_HI) REPEAT(REP2) {
#ifndef RUREP
#define RUREP 1
#endif
        for (int rrep_ = 0; rrep_ < RUREP; ++rrep_) for (int u = c; u < 256; u += G) ret_unit<false>(p, lds, u, tid, wid, lane);
        LAUNDER();
#ifndef SUREP
#define SUREP 1
#endif
        for (int srep_ = 0; srep_ < SUREP; ++srep_) for (int su = c; su < 32; su += G) sample_unit(p, lds, su, tid, wid, lane);
    }
    SEAM(2);
    if (PH_LO <= 3 && 3 < PH_HI) REPEAT(REP3) {
        for (int u = c; u < 256; u += G) ret_unit<true>(p, lds, u, tid, wid, lane);
    }
    SEAM(3);
    if (PH_LO <= 4 && 4 < PH_HI) REPEAT(REP4) {
        for (int t = c; t < 256; t += G) { f32x4 acc[1]; const int kq = t >> 6, nt = t & 63;
            thin_gemm2<1>(lds, (const bf16_t*)(p.ws + WS_RA) + (size_t)TOK_P * DM, DM, (const bf16_t*)(p.ws + WS_WOUT), DM, 16 * nt, 0, 256 * kq, 256, acc, tid, wid, lane);
            thin_store(acc[0], (float*)(p.ws + WS_YS) + (size_t)kq * 128 * DM, DM, 16 * nt, wid, lane); }
        pg8::Gemm g{(const bf16_t*)(p.ws + WS_RA), (const bf16_t*)(p.ws + WS_WOUT), TOK_P, DM, DM};
        pg8::StaticOrder S; S.init(TOK_P, DM, G, c);
        pg8::EpiY E{(bf16_t*)(p.ws + WS_Y), (float*)(p.ws + WS_SSQ1)};
        pg8::gemm_phase<pg8::EpiY, pg8::StaticOrder, true, true>(lds, g, S, E);
    }
    SEAM(4);
    if (PH_LO <= 5 && 5 < PH_HI) REPEAT(REP5) { LAUNDER(); phase4(p, wid, lane); }
    SEAM(5);
    if (PH_LO <= 6 && 6 < PH_HI) REPEAT(REP6) {
        for (int t = c; t < 256; t += G) thin_ffn1(p, lds, t, tid, wid, lane);
        pg8::Gemm g{(const bf16_t*)(p.ws + WS_RA), (const bf16_t*)(p.ws + WS_WFF1), TOK_P, 2 * DFF, DM};
        pg8::WalkOrder S{G, c};
        pg8::EpiFfn E{(bf16_t*)(p.ws + WS_RB), p.in[15], p.in[4], p.out + O_CFP, p.out + O_CFS, (LAS float*)(lds + LDS_HALO)};
        pg8::gemm_phase<pg8::EpiFfn, pg8::WalkOrder, true, true>(lds, g, S, E);
    }
    SEAM(6);
    if (PH_LO <= 7 && 7 < PH_HI) REPEAT(REP7) {
        for (int t = c; t < 256; t += G) { f32x4 acc[1]; const int kq = t >> 6, nt = t & 63;
            thin_gemm2<1>(lds, (const bf16_t*)(p.ws + WS_RB) + (size_t)TOK_P * DFF, DFF, (const bf16_t*)(p.ws + WS_WDN), DFF, 16 * nt, 0, 1024 * kq, 1024, acc, tid, wid, lane);
            thin_store(acc[0], (float*)(p.ws + WS_FS) + (size_t)kq * 128 * DM, DM, 16 * nt, wid, lane); }
        pg8::Gemm g{(const bf16_t*)(p.ws + WS_RB), (const bf16_t*)(p.ws + WS_WDN), TOK_P, DM, DFF};
        pg8::StaticOrder S; S.init(TOK_P, DM, G, c);
        pg8::EpiY E{(bf16_t*)(p.ws + WS_RA), (float*)(p.ws + WS_SSQ2)};
        pg8::gemm_phase<pg8::EpiY, pg8::StaticOrder, true, true>(lds, g, S, E);
    }
    SEAM(7);
#ifndef REP8
#define REP8 1
#endif
    if (PH_LO <= 8 && 8 < PH_HI) REPEAT(REP8) { LAUNDER(); phase7(p, wid, lane); }
#undef SEAM
}
constexpr int NPH = 9;
#if MK_LAUNCHES == 1
__global__ void __launch_bounds__(512, 2) fwd_kernel(Params p) {
    extern __shared__ __attribute__((aligned(16))) unsigned char smem[];
    run_phases<0, NPH>(p, (LAS unsigned char*)smem);
}
#else
template <int PH>
__global__ void __launch_bounds__(512, 2) fwd_phase(Params p) {
    extern __shared__ __attribute__((aligned(16))) unsigned char smem[];
    run_phases<PH, PH + 1>(p, (LAS unsigned char*)smem);
}
template <int PH> static void launch_phase(const Params& p, int grid, hipStream_t stream) {
    static bool attr = false;
    if (!attr) { (void)hipFuncSetAttribute((const void*)fwd_phase<PH>, hipFuncAttributeMaxDynamicSharedMemorySize, LDS_BYTES); attr = true; }
    hipLaunchKernelGGL(fwd_phase<PH>, dim3(grid), dim3(512), LDS_BYTES, stream, p);
}
#endif

extern "C" void kernel_launch(void* const* d_in, const int* in_sizes, int n_in, void* d_out, int out_size, void* d_ws, size_t ws_size, hipStream_t stream) {
    static int grid = 0;
    if (grid == 0) {
        if (n_in != 17 || ws_size < WS_END) { fprintf(stderr, "kernel_launch: expected 17 inputs and >= %zu bytes of workspace (got %d, %zu)\n", (size_t)WS_END, n_in, ws_size); grid = -1; return; }
        int dev = 0, cus = 0, per_cu = 0;
        (void)hipGetDevice(&dev); (void)hipDeviceGetAttribute(&cus, hipDeviceAttributeMultiprocessorCount, dev);
#if MK_LAUNCHES == 1
        if (hipFuncSetAttribute((const void*)fwd_kernel, hipFuncAttributeMaxDynamicSharedMemorySize, LDS_BYTES) != hipSuccess) { fprintf(stderr, "kernel_launch: hipFuncSetAttribute failed\n"); grid = -1; return; }
        if (hipOccupancyMaxActiveBlocksPerMultiprocessor(&per_cu, (const void*)fwd_kernel, 512, LDS_BYTES) != hipSuccess || per_cu < 1) { fprintf(stderr, "kernel_launch: occupancy query says %d\n", per_cu); per_cu = 1; }
        (void)hipGetLastError();
#endif
        grid = cus > 0 ? cus : 256;
    }
    if (grid < 0) return;
    Params p{};
    for (int i = 0; i < 17; ++i) p.in[i] = (const float*)d_in[i];
    p.out = (float*)d_out; p.ws = (unsigned char*)d_ws;
#if MK_LAUNCHES == 1
    if (hipMemsetAsync(d_ws, 0, 16384, stream) != hipSuccess) { fprintf(stderr, "kernel_launch: hipMemsetAsync failed\n"); return; }
    void* args[] = {&p};
    const hipError_t e = hipLaunchCooperativeKernel((const void*)fwd_kernel, dim3(grid), dim3(512), args, LDS_BYTES, stream);
    if (e != hipSuccess) fprintf(stderr, "kernel_launch: cooperative launch failed: %s (grid %d)\n", hipGetErrorString(e), grid);
#else
    launch_phase<0>(p, grid, stream); launch_phase<1>(p, grid, stream); launch_phase<2>(p, grid, stream); launch_phase<3>(p, grid, stream); launch_phase<4>(p, grid, stream);
    launch_phase<5>(p, grid, stream); launch_phase<6>(p, grid, stream); launch_phase<7>(p, grid, stream); launch_phase<8>(p, grid, stream);
#endif
}
```

```cpp
#include <hip/hip_runtime.h>
#include <hip/hip_cooperative_groups.h>
#include <cstdio>
#include <cstdint>
namespace cg = cooperative_groups;
namespace pg8 {
#define PG8_LAS __attribute__((address_space(3)))
typedef unsigned short bf16_t;
typedef short bf16x8 __attribute__((ext_vector_type(8)));
typedef float f32x4 __attribute__((ext_vector_type(4)));
typedef unsigned u32x4 __attribute__((ext_vector_type(4)));
constexpr int BM = 256, BK = 64, HALF = 128, HTB = HALF * BK * 2  , STAGE_BYTES = 8 * HTB, NXCD = 8, WGM = 8;

__host__ __device__ __forceinline__ int lds_byte(int r, int c) { const int st = (r >> 4) * 2 + (c >> 5), rr = r & 15, cc = c & 31, ob = rr * 64 + cc * 2; return st * 1024 + (ob ^ (((ob >> 9) & 1) << 5)); }
__host__ __device__ __forceinline__ void stage_rc(int b, int& R, int& C) { const int st = b / 1024, sb = b % 1024, swz = sb ^ (((sb >> 9) & 1) << 5); R = (st >> 1) * 16 + swz / 64; C = (st & 1) * 32 + (swz % 64) / 2; }
__host__ __device__ __forceinline__ int perm32(int rho) { const int n = rho >> 4, i = rho & 15; return 8 * (i >> 2) + 4 * n + (i & 3); }

struct Unit { int pm, pn; };
struct Gemm { const bf16_t* A; const bf16_t* Bt; int M, N, K; };

struct StaticOrder {
    int nM, nN, nwg, G, c;
    __host__ __device__ void init(int M, int N, int G_, int c_) { nM = M / BM; nN = N / BM; nwg = nM * nN; G = G_; c = c_; }
    __host__ __device__ bool next(int i, Unit& u) const {
        const long L = (long)i * G + c; if (L >= nwg) return false;
        int wgid = (int)L; { const int q = nwg / NXCD, r = nwg % NXCD, xcd = wgid % NXCD, off = wgid / NXCD; wgid = (xcd < r ? xcd * (q + 1) : r * (q + 1) + (xcd - r) * q) + off; }
        const int nig = WGM * nN, gid = wgid / nig, fm = gid * WGM, gsz = (nM - fm) < WGM ? (nM - fm) : WGM;
        u.pm = fm + ((wgid % nig) % gsz); u.pn = (wgid % nig) / gsz; return true;
    }
    __device__ __forceinline__ void a_ready(const Unit&) const {}
    __device__ __forceinline__ void done(const Unit&) const {}
};
__device__ __forceinline__ unsigned cvt_pk_bf16(float lo, float hi) { unsigned r; asm volatile("v_cvt_pk_bf16_f32 %0, %1, %2" : "=v"(r) : "v"(lo), "v"(hi)); return r; }
__device__ __forceinline__ float dpp_shr1(float v) { return __builtin_bit_cast(float, __builtin_amdgcn_update_dpp(0, __builtin_bit_cast(int, v), 0x111, 0xf, 0xf, true)); }
__device__ __forceinline__ float dpp_shr2(float v) { return __builtin_bit_cast(float, __builtin_amdgcn_update_dpp(0, __builtin_bit_cast(int, v), 0x112, 0xf, 0xf, true)); }
__device__ __forceinline__ float dpp_shl15(float v) { return __builtin_bit_cast(float, __builtin_amdgcn_update_dpp(0, __builtin_bit_cast(int, v), 0x10F, 0xf, 0xf, true)); }
__device__ __forceinline__ float dpp_shl14(float v) { return __builtin_bit_cast(float, __builtin_amdgcn_update_dpp(0, __builtin_bit_cast(int, v), 0x10E, 0xf, 0xf, true)); }
__device__ __forceinline__ float gelu_tanh(float x) {
    const float z = 0.7978845608028654f * (x + 0.044715f * x * x * x);
    const float e = __builtin_amdgcn_exp2f(-2.8853900817779268f * z);
    return x * __builtin_amdgcn_rcpf(1.0f + e);
}
constexpr int TOKP = 32768;

struct EpiIn {
    static constexpr bool PERM = true, AFTER_DRAIN = false;
    bf16_t* P; const float* cosT; const float* sinT;
    __device__ __forceinline__ void operator()(const f32x4 (&acc)[2][2][4][2], const Unit& u, int wr, int wc, int fr, int fq) const {
        asm volatile("" : "+v"(fr), "+v"(fq));
        const int row0 = u.pm * BM + wr * 64 + fr, col0 = u.pn * BM + wc * 32 + 8 * fq;
        if (u.pn < 4) {
            const float sc = (u.pn >= 2) ? 0.08838834764831845f : 1.0f;
            const int f0 = 16 * wc + 4 * fq;
#pragma unroll
            for (int ai = 0; ai < 2; ++ai)
#pragma unroll
                for (int m = 0; m < 4; ++m) {
                    const int r = row0 + ai * HALF + m * 16;
                    const int pos = r < TOKP ? (r & 4095) : 4096 + ((r - TOKP) & 15);
                    const f32x4 c4 = *(const f32x4*)(cosT + pos * 64 + f0), s4 = *(const f32x4*)(sinT + pos * 64 + f0);
                    bf16_t* rowp = P + (size_t)r * 3584 + col0;
#pragma unroll
                    for (int bj = 0; bj < 2; ++bj) {
                        const f32x4 x1 = acc[ai][bj][m][0], x2 = acc[ai][bj][m][1];
                        const f32x4 o1 = (x1 * c4 - x2 * s4) * sc, o2 = (x2 * c4 + x1 * s4) * sc;
                        u32x4 w; w.x = cvt_pk_bf16(o1[0], o1[1]); w.y = cvt_pk_bf16(o1[2], o1[3]); w.z = cvt_pk_bf16(o2[0], o2[1]); w.w = cvt_pk_bf16(o2[2], o2[3]);
                        *(u32x4*)(rowp + bj * HALF) = w;
                    }
                }
        } else {
#pragma unroll
            for (int ai = 0; ai < 2; ++ai)
#pragma unroll
                for (int m = 0; m < 4; ++m) {
                    bf16_t* rowp = P + (size_t)(row0 + ai * HALF + m * 16) * 3584 + col0;
#pragma unroll
                    for (int bj = 0; bj < 2; ++bj) {
                        const f32x4 v0 = acc[ai][bj][m][0], v1 = acc[ai][bj][m][1];
                        u32x4 w; w.x = cvt_pk_bf16(v0[0], v0[1]); w.y = cvt_pk_bf16(v0[2], v0[3]); w.z = cvt_pk_bf16(v1[0], v1[1]); w.w = cvt_pk_bf16(v1[2], v1[3]);
                        *(u32x4*)(rowp + bj * HALF) = w;
                    }
                }
        }
    }
};

struct EpiY {
    static constexpr bool PERM = true, AFTER_DRAIN = false;
    bf16_t* Y; float* ssq;
    __device__ __forceinline__ void operator()(const f32x4 (&acc)[2][2][4][2], const Unit& u, int wr, int wc, int fr, int fq) const {
        asm volatile("" : "+v"(fr), "+v"(fq));
        const int row0 = u.pm * BM + wr * 64 + fr, col0 = u.pn * BM + wc * 32 + 8 * fq;
#pragma unroll
        for (int ai = 0; ai < 2; ++ai)
#pragma unroll
            for (int m = 0; m < 4; ++m) {
                const int r = row0 + ai * HALF + m * 16;
                bf16_t* rowp = Y + (size_t)r * 1024 + col0;
                float s = 0.f;
#pragma unroll
                for (int bj = 0; bj < 2; ++bj) {
                    const f32x4 v0 = acc[ai][bj][m][0], v1 = acc[ai][bj][m][1];
                    s += (v0[0] * v0[0] + v0[1] * v0[1]) + (v0[2] * v0[2] + v0[3] * v0[3]) + (v1[0] * v1[0] + v1[1] * v1[1]) + (v1[2] * v1[2] + v1[3] * v1[3]);
                    u32x4 w; w.x = cvt_pk_bf16(v0[0], v0[1]); w.y = cvt_pk_bf16(v0[2], v0[3]); w.z = cvt_pk_bf16(v1[0], v1[1]); w.w = cvt_pk_bf16(v1[2], v1[3]);
                    *(u32x4*)(rowp + bj * HALF) = w;
                }
                s += __shfl_xor(s, 16); s += __shfl_xor(s, 32);
                if (fq == 0) ssq[(size_t)r * 16 + u.pn * 4 + wc] = s;
            }
    }
};

struct EpiFfn {
    static constexpr bool PERM = true, AFTER_DRAIN = false;
    bf16_t* ACT; const float* cw; const float* cache; float* outp; float* outs; PG8_LAS float* halo;
    __device__ __forceinline__ void operator()(const f32x4 (&acc)[2][2][4][2], const Unit& u, int wr, int wc, int fr, int fq) const {
        asm volatile("" : "+v"(fr), "+v"(fq));
        const int lc0 = wc * 32 + 8 * fq, ch0 = u.pn * 128 + lc0;
        const bool sample = false;
        const int par = u.pm & 1;
        f32x4 w0[2], w1[2], w2[2];
#pragma unroll
        for (int n = 0; n < 2; ++n) { w0[n] = *(const f32x4*)(cw + ch0 + 4 * n); w1[n] = *(const f32x4*)(cw + 4096 + ch0 + 4 * n); w2[n] = *(const f32x4*)(cw + 8192 + ch0 + 4 * n); }
        if (!sample && fr >= 14) {
#pragma unroll
            for (int ai = 0; ai < 2; ++ai) { PG8_LAS float* hp = halo + ((par * 4 + 2 * ai + wr) * 2 + (fr - 14)) * 128 + lc0;
                *(PG8_LAS f32x4*)hp = acc[ai][0][3][0]; *(PG8_LAS f32x4*)(hp + 4) = acc[ai][0][3][1]; }
        }
        asm volatile("s_waitcnt lgkmcnt(0)" ::: "memory"); __builtin_amdgcn_s_barrier(); asm volatile("" ::: "memory");
#pragma unroll
        for (int ai = 0; ai < 2; ++ai) {
            const int blk = 2 * ai + wr;
#pragma unroll
            for (int m = 0; m < 4; ++m) {
                f32x4 pv[2]; pv[0] = (f32x4){0.f, 0.f, 0.f, 0.f}; pv[1] = pv[0];
                const int sb = 8 * ai + 4 * wr + m;
                if (sample) {
                    if (fr >= 14 && sb < 8) { const float* cp = cache + (size_t)(sb * 2 + fr - 14) * 4096 + ch0; pv[0] = *(const f32x4*)cp; pv[1] = *(const f32x4*)(cp + 4); }
                } else if (m == 0) {
                    if (fr >= 14) {
                        const bool zero = (blk == 0) && ((u.pm & 15) == 0);
                        const int hb = (blk == 0) ? ((par ^ 1) * 4 + 3) : (par * 4 + blk - 1);
                        if (!zero) { const PG8_LAS float* hp = halo + (hb * 2 + fr - 14) * 128 + lc0; pv[0] = *(const PG8_LAS f32x4*)hp; pv[1] = *(const PG8_LAS f32x4*)(hp + 4); }
                    }
                } else { pv[0] = acc[ai][0][m - 1][0]; pv[1] = acc[ai][0][m - 1][1]; }
                const int r = u.pm * BM + ai * HALF + wr * 64 + m * 16 + fr;
                float a8[8];
#pragma unroll
                for (int n = 0; n < 2; ++n)
#pragma unroll
                    for (int e = 0; e < 4; ++e) {
                        const float cur = acc[ai][0][m][n][e], pr = pv[n][e];
                        const float p1 = dpp_shr1(cur) + dpp_shl15(pr), p2 = dpp_shr2(cur) + dpp_shl14(pr);
                        const float uc = w0[n][e] * p2 + w1[n][e] * p1 + w2[n][e] * cur;
                        a8[4 * n + e] = gelu_tanh(uc) * acc[ai][1][m][n][e];
                    }
                u32x4 w; w.x = cvt_pk_bf16(a8[0], a8[1]); w.y = cvt_pk_bf16(a8[2], a8[3]); w.z = cvt_pk_bf16(a8[4], a8[5]); w.w = cvt_pk_bf16(a8[6], a8[7]);
                *(u32x4*)(ACT + (size_t)r * 4096 + ch0) = w;
                if (sample) {
                    if (fr >= 14 && sb < 8) { float* op = outs + (size_t)(sb * 2 + fr - 14) * 4096 + ch0; *(f32x4*)op = acc[ai][0][m][0]; *(f32x4*)(op + 4) = acc[ai][0][m][1]; }
                } else if (m == 3 && blk == 3 && (u.pm & 15) == 15 && fr >= 14) {
                    float* op = outp + (size_t)((u.pm >> 4) * 2 + fr - 14) * 4096 + ch0; *(f32x4*)op = acc[ai][0][m][0]; *(f32x4*)(op + 4) = acc[ai][0][m][1];
                }
            }
        }
    }
};
struct WalkOrder {
    int G, c;
    __device__ __forceinline__ bool next(int i, Unit& u) const {
        int w = c, rem = i;
        while (w < 256) { const int len = 16;
            if (rem < len) { if (w < 256) { u.pm = (w >> 5) * 16 + rem; u.pn = w & 31; } else { u.pm = 128; u.pn = w - 256; } return true; }
            rem -= len; w += G; }
        return false;
    }
    __device__ __forceinline__ void a_ready(const Unit&) const {}
    __device__ __forceinline__ void done(const Unit&) const {}
};
template <class Epi, class Sched, bool ALIGN_EPI = false, bool SP2 = false>
__device__ __forceinline__ void gemm_phase(PG8_LAS unsigned char* lds, const Gemm g, const Sched& S, const Epi& E) {
    int tid_raw = threadIdx.x; asm volatile("" : "+v"(tid_raw));
    const int tid = tid_raw, wid = __builtin_amdgcn_readfirstlane(tid >> 6), lane = tid & 63, wr = wid >> 2, wc = wid & 3, fr = lane & 15, fq = lane >> 4;
    const int K = g.K, nt = K / BK;
    unsigned voffA[2], voffB[2];
#pragma unroll
    for (int i = 0; i < 2; ++i) { int R, C; stage_rc(tid * 16 + i * 8192, R, C); const int Rb = Epi::PERM ? ((R & ~31) + perm32(R & 31)) : R;
        voffA[i] = (unsigned)(R * K + C) * 2u; voffB[i] = (unsigned)(Rb * K + C) * 2u; }
    const size_t kstep = (size_t)(BK * 2);
    const size_t hstep = (size_t)HALF * K * 2;
    const size_t tstep = 2 * hstep;
    const unsigned ldsw = (unsigned)wid * 1024u;
    const int aoff = lds_byte(wr * 64 + fr, fq * 8), boff = lds_byte(wc * 32 + fr, fq * 8);
#define PG8_SA(b, h) (((b) * 2 + (h)) * HTB)
#define PG8_SB(b, h) ((4 + (b) * 2 + (h)) * HTB)
#define PG8_STAGE(bufoff, gbase, voff) do { _Pragma("unroll") for (int _i = 0; _i < 2; ++_i) \
        __builtin_amdgcn_global_load_lds((const unsigned*)((const char*)(gbase) + (voff)[_i]), (PG8_LAS unsigned*)(lds + (bufoff) + ldsw + _i * 8192), 16, 0, 0); } while (0)
#define PG8_LDA(dst, b, h) do { _Pragma("unroll") for (int m = 0; m < 4; ++m) _Pragma("unroll") for (int k = 0; k < 2; ++k) dst[m][k] = *(const PG8_LAS bf16x8*)(lds + PG8_SA(b, h) + aoff + m * 2048 + k * 1024); } while (0)
#define PG8_LDB(dst, b, h) do { _Pragma("unroll") for (int n = 0; n < 2; ++n) _Pragma("unroll") for (int k = 0; k < 2; ++k) dst[n][k] = *(const PG8_LAS bf16x8*)(lds + PG8_SB(b, h) + boff + n * 2048 + k * 1024); } while (0)
#define PG8_MMA(ai, bj, At, Bt) do { __builtin_amdgcn_s_setprio(1); _Pragma("unroll") for (int m = 0; m < 4; ++m) _Pragma("unroll") for (int n = 0; n < 2; ++n) _Pragma("unroll") for (int k = 0; k < 2; ++k) \
        acc[ai][bj][m][n] = __builtin_amdgcn_mfma_f32_16x16x32_bf16(Bt[n][k], At[m][k], acc[ai][bj][m][n], 0, 0, 0); __builtin_amdgcn_s_setprio(0); } while (0)
#define PG8_WAIT_V(n) asm volatile("s_waitcnt vmcnt(" #n ")" ::: "memory")
#define PG8_WAIT_L(n) asm volatile("s_waitcnt lgkmcnt(" #n ")" ::: "memory")
#define PG8_BAR __builtin_amdgcn_s_barrier()
#define PG8_SCHED __builtin_amdgcn_sched_barrier(0)
    Unit cur, nxt; int ui = 0;
    if (!S.next(0, cur)) return;
    f32x4 acc[2][2][4][2];
#pragma unroll
    for (int a = 0; a < 2; ++a)
#pragma unroll
        for (int b = 0; b < 2; ++b)
#pragma unroll
            for (int m = 0; m < 4; ++m)
#pragma unroll
                for (int n = 0; n < 2; ++n) acc[a][b][m][n] = (f32x4){0.f, 0.f, 0.f, 0.f};
    bf16x8 At[4][2], B0[2][2], B1[2][2];
    const char* cA = (const char*)g.A + (size_t)cur.pm * tstep; const char* cB = (const char*)g.Bt + (size_t)cur.pn * tstep;
    S.a_ready(cur);
    if constexpr (SP2) {
        PG8_STAGE(PG8_SB(0, 0), cB, voffB); PG8_STAGE(PG8_SB(0, 1), cB + hstep, voffB); PG8_STAGE(PG8_SA(0, 0), cA, voffA); PG8_STAGE(PG8_SA(0, 1), cA + hstep, voffA);
        if (wr == 1) PG8_BAR;
        PG8_WAIT_V(2); PG8_BAR;
        PG8_STAGE(PG8_SB(1, 0), cB + kstep, voffB); PG8_STAGE(PG8_SA(1, 0), cA + kstep, voffA); PG8_STAGE(PG8_SB(1, 1), cB + hstep + kstep, voffB);
        PG8_WAIT_V(6); PG8_BAR;
    } else {
        PG8_STAGE(PG8_SB(0, 0), cB, voffB); PG8_STAGE(PG8_SA(0, 0), cA, voffA); PG8_STAGE(PG8_SB(0, 1), cB + hstep, voffB); PG8_STAGE(PG8_SA(0, 1), cA + hstep, voffA);
        if (wr == 1) PG8_BAR;
        PG8_WAIT_V(4); PG8_BAR;
        PG8_STAGE(PG8_SB(1, 0), cB + kstep, voffB); PG8_STAGE(PG8_SA(1, 0), cA + kstep, voffA); PG8_STAGE(PG8_SB(1, 1), cB + hstep + kstep, voffB);
        PG8_WAIT_V(6); PG8_BAR;
    }
    for (;;) {
        const bool has_next = S.next(ui + 1, nxt);
        const char* nA = has_next ? (const char*)g.A + (size_t)nxt.pm * tstep : cA; const char* nB = has_next ? (const char*)g.Bt + (size_t)nxt.pn * tstep : cB;
        for (int t = 0; t < nt; t += 2) {
            const bool last = (t == nt - 2);
            const char* a1 = cA + (size_t)(t + 1) * kstep;
            const char* a2 = last ? nA : cA + (size_t)(t + 2) * kstep; const char* b2 = last ? nB : cB + (size_t)(t + 2) * kstep;
            const char* a3 = a2 + kstep; const char* b3 = b2 + kstep;
            if (last && has_next) S.a_ready(nxt);
            if constexpr (SP2) {
            PG8_LDB(B0, 0, 0); PG8_LDB(B1, 0, 1); PG8_SCHED; PG8_LDA(At, 0, 0); PG8_STAGE(PG8_SA(1, 1), a1 + hstep, voffA);
            PG8_WAIT_V(8); PG8_WAIT_L(0); PG8_BAR; PG8_MMA(0, 0, At, B0); PG8_MMA(0, 1, At, B1); PG8_BAR; PG8_SCHED;
            PG8_LDA(At, 0, 1); PG8_STAGE(PG8_SB(0, 0), b2, voffB); PG8_STAGE(PG8_SB(0, 1), b2 + hstep, voffB); PG8_STAGE(PG8_SA(0, 0), a2, voffA);
            PG8_WAIT_V(8); PG8_WAIT_L(0); PG8_BAR; PG8_MMA(1, 0, At, B0); PG8_MMA(1, 1, At, B1); PG8_BAR; PG8_SCHED;
            PG8_LDB(B0, 1, 0); PG8_LDB(B1, 1, 1); PG8_SCHED; PG8_LDA(At, 1, 0); PG8_STAGE(PG8_SA(0, 1), a2 + hstep, voffA);
            PG8_WAIT_V(8); PG8_WAIT_L(0); PG8_BAR; PG8_MMA(0, 0, At, B0); PG8_MMA(0, 1, At, B1); PG8_BAR; PG8_SCHED;
            PG8_LDA(At, 1, 1); PG8_STAGE(PG8_SB(1, 0), b3, voffB); PG8_STAGE(PG8_SB(1, 1), b3 + hstep, voffB); PG8_STAGE(PG8_SA(1, 0), a3, voffA);
            PG8_WAIT_V(8); PG8_WAIT_L(0); PG8_BAR; PG8_MMA(1, 0, At, B0); PG8_MMA(1, 1, At, B1); PG8_BAR; PG8_SCHED;
            } else {
            PG8_LDB(B0, 0, 0); PG8_SCHED; PG8_LDA(At, 0, 0); PG8_STAGE(PG8_SA(1, 1), a1 + hstep, voffA);
            PG8_WAIT_L(8); PG8_BAR; PG8_WAIT_L(0); PG8_MMA(0, 0, At, B0); PG8_BAR; PG8_SCHED;
            PG8_LDB(B1, 0, 1); PG8_STAGE(PG8_SB(0, 0), b2, voffB);
            PG8_BAR; PG8_WAIT_L(0); PG8_MMA(0, 1, At, B1); PG8_BAR;
            PG8_LDA(At, 0, 1); PG8_STAGE(PG8_SA(0, 0), a2, voffA);
            PG8_BAR; PG8_WAIT_L(0); PG8_MMA(1, 0, At, B0); PG8_BAR; PG8_SCHED;
            PG8_STAGE(PG8_SB(0, 1), b2 + hstep, voffB);
            PG8_WAIT_V(6); PG8_BAR; PG8_MMA(1, 1, At, B1); PG8_BAR;
            PG8_LDB(B0, 1, 0); PG8_SCHED; PG8_LDA(At, 1, 0); PG8_STAGE(PG8_SA(0, 1), a2 + hstep, voffA);
            PG8_WAIT_L(8); PG8_BAR; PG8_WAIT_L(0); PG8_MMA(0, 0, At, B0); PG8_BAR; PG8_SCHED;
            PG8_LDB(B1, 1, 1); PG8_STAGE(PG8_SB(1, 0), b3, voffB);
            PG8_BAR; PG8_WAIT_L(0); PG8_MMA(0, 1, At, B1); PG8_BAR;
            PG8_LDA(At, 1, 1); PG8_STAGE(PG8_SA(1, 0), a3, voffA);
            PG8_BAR; PG8_WAIT_L(0); PG8_MMA(1, 0, At, B0); PG8_BAR; PG8_SCHED;
            PG8_STAGE(PG8_SB(1, 1), b3 + hstep, voffB);
            PG8_WAIT_V(6); PG8_BAR; PG8_MMA(1, 1, At, B1); PG8_BAR;
            }
        }
        if constexpr (ALIGN_EPI) { if (wr == 0) PG8_BAR; }
        if constexpr (!Epi::AFTER_DRAIN) { E(acc, cur, wr, wc, fr, fq); S.done(cur); }
        if (!has_next) break;
#pragma unroll
        for (int a = 0; a < 2; ++a)
#pragma unroll
            for (int b = 0; b < 2; ++b)
#pragma unroll
                for (int m = 0; m < 4; ++m)
#pragma unroll
                    for (int n = 0; n < 2; ++n) acc[a][b][m][n] = (f32x4){0.f, 0.f, 0.f, 0.f};
        cur = nxt; cA = nA; cB = nB; ++ui;
        if constexpr (ALIGN_EPI) { if (wr == 1) PG8_BAR; }
    }
    PG8_WAIT_V(0);
    if constexpr (!ALIGN_EPI) { if (wr == 0) PG8_BAR; }
    PG8_BAR;
    if constexpr (Epi::AFTER_DRAIN) { E.fused(acc, cur, wr, wc, fr, fq, lds, wid, lane); S.done(cur); }
#undef PG8_SA
#undef PG8_SB
#undef PG8_STAGE
#undef PG8_LDA
#undef PG8_LDB
#undef PG8_MMA
#undef PG8_WAIT_V
#undef PG8_WAIT_L
#undef PG8_BAR
#undef PG8_SCHED
}
}

using pg8::bf16_t; using pg8::bf16x8; using pg8::f32x4; using pg8::u32x4;
#define LAS __attribute__((address_space(3)))
typedef unsigned u32x2 __attribute__((ext_vector_type(2)));
constexpr int DM = 1024, NIN = 3584, DFF = 4096;
constexpr int TOK_P = 32768, TOK = 32896, TOKPAD = 33024;
constexpr float EPS = 1e-6f;
constexpr size_t WS_WIN = 16384;
constexpr size_t WS_WOUT = WS_WIN + (size_t)NIN * DM * 2;
constexpr size_t WS_WFF1 = WS_WOUT + (size_t)DM * DM * 2;
constexpr size_t WS_WDN = WS_WFF1 + (size_t)2 * DFF * DM * 2;
constexpr size_t WS_COS = WS_WDN + (size_t)DM * DFF * 2;
constexpr size_t WS_SIN = WS_COS + (size_t)4112 * 64 * 4;
constexpr size_t WS_SSQ1 = WS_SIN + (size_t)4112 * 64 * 4;
constexpr size_t WS_SSQ2 = WS_SSQ1 + (size_t)TOKPAD * 16 * 4;
constexpr size_t WS_UG = WS_SSQ2 + (size_t)TOKPAD * 16 * 4;
constexpr size_t WS_PS = WS_UG + (size_t)256 * 65536;
constexpr size_t WS_YS = WS_PS + (size_t)128 * NIN * 4;
constexpr size_t WS_FS = WS_YS + (size_t)4 * 128 * DM * 4;
constexpr size_t WS_RA = WS_FS + (size_t)4 * 128 * DM * 4;
constexpr size_t WS_RB = WS_RA + (size_t)TOKPAD * DM * 2;
constexpr size_t WS_Y = WS_RB + (size_t)TOKPAD * DFF * 2;
constexpr size_t WS_END = WS_Y + (size_t)TOK_P * DM * 2;
constexpr size_t O_SRP = (size_t)TOK * DM, O_CCP = O_SRP + 524288, O_CFP = O_CCP + 8192, O_SRS = O_CFP + 65536, O_CCS = O_SRS + 524288, O_CFS = O_CCS + 8192;
constexpr int LDS_HALO = 131072, LDS_BARW = 131072 + 8192, LDS_BYTES = LDS_BARW + 16;

struct Params { const float* in[17]; float* out; unsigned char* ws; };

__device__ __forceinline__ float dppf(float v, const int ctrl_sel) {
    const int iv = __builtin_bit_cast(int, v); int r;
    switch (ctrl_sel) { case 1: r = __builtin_amdgcn_update_dpp(0, iv, 0x111, 0xf, 0xf, true); break; case 2: r = __builtin_amdgcn_update_dpp(0, iv, 0x112, 0xf, 0xf, true); break;
        case 4: r = __builtin_amdgcn_update_dpp(0, iv, 0x114, 0xf, 0xf, true); break; case 8: r = __builtin_amdgcn_update_dpp(0, iv, 0x118, 0xf, 0xf, true); break;
        case 15: r = __builtin_amdgcn_update_dpp(0, iv, 0x142, 0xa, 0xf, false); break; default: r = __builtin_amdgcn_update_dpp(0, iv, 0x143, 0xc, 0xf, false); break; }
    return __builtin_bit_cast(float, r);
}
__device__ __forceinline__ float wave_sum(float v) {
    v += dppf(v, 1); v += dppf(v, 2); v += dppf(v, 4); v += dppf(v, 8); v += dppf(v, 15); v += dppf(v, 31);
    return __builtin_bit_cast(float, __builtin_amdgcn_readlane(__builtin_bit_cast(int, v), 63));
}
__device__ __forceinline__ float bf2f(unsigned short b) { return __uint_as_float(((unsigned)b) << 16); }
__device__ __forceinline__ unsigned pk2(float a, float b) { return pg8::cvt_pk_bf16(a, b); }
__device__ __forceinline__ unsigned pk2s(float a, float b) { unsigned r; asm("v_cvt_pk_bf16_f32 %0, %1, %2" : "=v"(r) : "v"(a), "v"(b)); return r; }
__device__ __forceinline__ float silu_f(float g) { return g * __builtin_amdgcn_rcpf(1.0f + __builtin_amdgcn_exp2f(-1.4426950408889634f * g)); }
__device__ __forceinline__ int dmap(int P) { return ((P >> 2) & 1) * 64 + (P >> 3) * 4 + (P & 3); }
__device__ __forceinline__ int pmap(int d) { return ((d >> 4) & 3) * 32 + ((d >> 2) & 3) * 8 + ((d >> 6) & 1) * 4 + (d & 3); }

constexpr int RB = 6;
__device__ __forceinline__ f32x4 unpack_bf4(const u32x2 w) { f32x4 v; v[0] = __uint_as_float(w.x << 16); v[1] = __uint_as_float(w.x & 0xffff0000u); v[2] = __uint_as_float(w.y << 16); v[3] = __uint_as_float(w.y & 0xffff0000u); return v; }
__device__ __forceinline__ float sumsq4(const f32x4 a) { return (a[0] * a[0] + a[1] * a[1]) + (a[2] * a[2] + a[3] * a[3]); }
template <int MODE> __device__ __forceinline__ int rowmap(int c) {
    if (MODE == 0) { if (c < 1024) return (c & ~127) + pmap(c & 127); return c; }
    if (MODE == 1) return c;
    if (MODE == 2) return ((c >> 7) << 8) + (c & 127);
    return ((c >> 7) << 8) + 128 + (c & 127);
}
template <int MODE>
__device__ __forceinline__ void transpose_item(const float* W, int K, int N, bf16_t* WT, LAS float* scr, int item, int lane) {
    const int nblk = N / 32, kb = item / nblk, nb = item % nblk, k0 = 64 * kb, n0 = 32 * nb;
#pragma unroll
    for (int i = 0; i < 32; ++i) { const int kk = 2 * i + (lane >> 5); scr[kk * 33 + (lane & 31)] = W[(size_t)(k0 + kk) * N + n0 + (lane & 31)]; }
    asm volatile("s_waitcnt lgkmcnt(0)" ::: "memory");
    const int c = lane & 7;
#pragma unroll
    for (int j = 0; j < 4; ++j) { const int n = (lane >> 3) + 8 * j; const LAS float* s = scr + (8 * c) * 33 + n;
        u32x4 o; o.x = pk2(s[0 * 33], s[1 * 33]); o.y = pk2(s[2 * 33], s[3 * 33]); o.z = pk2(s[4 * 33], s[5 * 33]); o.w = pk2(s[6 * 33], s[7 * 33]);
        *(u32x4*)(WT + (size_t)rowmap<MODE>(n0 + n) * K + k0 + 8 * c) = o; }
    asm volatile("s_waitcnt lgkmcnt(0)" ::: "memory");
}
__device__ __forceinline__ void phase0(const Params& p, LAS unsigned char* lds, int tid, int wid, int lane) {
    LAS float* scr = (LAS float*)(lds + wid * 8448);
    const int gw = blockIdx.x * 8 + wid, NGW = gridDim.x * 8;
    bf16_t* win = (bf16_t*)(p.ws + WS_WIN); bf16_t* wout = (bf16_t*)(p.ws + WS_WOUT); bf16_t* wff1 = (bf16_t*)(p.ws + WS_WFF1); bf16_t* wdn = (bf16_t*)(p.ws + WS_WDN);
    constexpr int I_IN = 16 * 112, I_OUT = 16 * 32, I_UP = 16 * 128, I_DN = 64 * 32, NITEMS = I_IN + I_OUT + 2 * I_UP + I_DN;
    for (int it = gw; it < NITEMS; it += NGW) {
        int r = it;
        if (r < I_IN) { transpose_item<0>(p.in[5], DM, NIN, win, scr, r, lane); continue; } r -= I_IN;
        if (r < I_OUT) { transpose_item<1>(p.in[6], DM, DM, wout, scr, r, lane); continue; } r -= I_OUT;
        if (r < I_UP) { transpose_item<2>(p.in[13], DM, DFF, wff1, scr, r, lane); continue; } r -= I_UP;
        if (r < I_UP) { transpose_item<3>(p.in[14], DM, DFF, wff1, scr, r, lane); continue; } r -= I_UP;
        transpose_item<1>(p.in[16], DFF, DM, wdn, scr, r, lane);
    }
    float* cosT = (float*)(p.ws + WS_COS); float* sinT = (float*)(p.ws + WS_SIN);
    for (int idx = blockIdx.x * 512 + tid; idx < 4112 * 64; idx += gridDim.x * 512) {
        const int pos = idx >> 6, f = idx & 63;
        const float inv = exp2f(-(float)(2 * f) * (1.0f / 128.0f) * 13.287712379549449f);
        const float ang = (float)pos * inv;
        const double rev = (double)ang * 0.15915494309189535;
        const float fr = (float)(rev - floor(rev));
        cosT[idx] = __builtin_amdgcn_cosf(fr); sinT[idx] = __builtin_amdgcn_sinf(fr);
    }
    bf16_t* H = (bf16_t*)(p.ws + WS_RA);
    const float* wpre = p.in[9];
    f32x4 wpr[4];
#pragma unroll
    for (int j = 0; j < 4; ++j) wpr[j] = *((const f32x4*)wpre + lane + 64 * j);
#pragma unroll 1
    for (int base = gw; base < TOK; base += RB * NGW) {
        f32x4 v[RB][4]; float s[RB];
#pragma unroll
        for (int k = 0; k < RB; ++k) { const int rr = min(base + k * NGW, TOK - 1);
            const float* xrow = rr < TOK_P ? p.in[0] + (size_t)rr * DM : p.in[1] + (size_t)(rr - TOK_P) * DM; s[k] = 0.f;
#pragma unroll
            for (int j = 0; j < 4; ++j) { v[k][j] = __builtin_nontemporal_load((const f32x4*)xrow + lane + 64 * j); s[k] += sumsq4(v[k][j]); } }
#pragma unroll
        for (int k = 0; k < RB; ++k) { const int r = base + k * NGW; const float rstd = rsqrtf(wave_sum(s[k]) * (1.0f / DM) + EPS);
            if (r < TOK) {
#pragma unroll
                for (int j = 0; j < 4; ++j) { const f32x4 y = (v[k][j] * rstd) * wpr[j];
                    __builtin_nontemporal_store((u32x2){pk2(y[0], y[1]), pk2(y[2], y[3])}, (u32x2*)(H + (size_t)r * DM) + lane + 64 * j); } } }
    }
}

constexpr int QI_OFF = 0, KI_OFF = 17408, KT_OFF = 34816, VT_OFF = 53248, SI_OFF = 71680, ST_OFF = 80896, GI_OFF = 115712;
#define MFMA16(a, b, c) __builtin_amdgcn_mfma_f32_16x16x32_bf16((a), (b), (c), 0, 0, 0)
#define RET_ISSUE(S, nn) do { _Pragma("unroll") for (int i_ = 0; i_ < 2; ++i_) { \
        const bf16_t* rowp_ = P + (tok0 + (size_t)(nn) * 64 + 2 * (tid >> 4) + i_) * NIN + 128 * h + (tid & 15) * 8; \
        if (FULL) { rq[S][i_] = *(const u32x4*)rowp_; rg[S][i_] = *(const u32x4*)(rowp_ + 1536); } rk[S][i_] = *(const u32x4*)(rowp_ + 512); rv[S][i_] = *(const u32x4*)(rowp_ + 1024); } } while (0)
#define RET_STAGE_A(S) do { const int j_ = 2 * (tid >> 4), ch_ = tid & 15; \
        if (FULL) { _Pragma("unroll") for (int i_ = 0; i_ < 2; ++i_) { *(LAS u32x4*)(lds + QI_OFF + (j_ + i_) * 272 + ch_ * 16) = rq[S][i_]; *(LAS u32x4*)(lds + KI_OFF + (j_ + i_) * 272 + ch_ * 16) = rk[S][i_]; *(LAS u32x4*)(lds + GI_OFF + (j_ + i_) * 272 + ch_ * 16) = rg[S][i_]; } } \
        const float te0_ = __builtin_amdgcn_exp2f(l2g * (float)(63 - j_)), te1_ = __builtin_amdgcn_exp2f(l2g * (float)(62 - j_)); \
        const unsigned ka_[4] = {rk[S][0].x, rk[S][0].y, rk[S][0].z, rk[S][0].w}, kb_[4] = {rk[S][1].x, rk[S][1].y, rk[S][1].z, rk[S][1].w}; \
        const unsigned va_[4] = {rv[S][0].x, rv[S][0].y, rv[S][0].z, rv[S][0].w}, vb_[4] = {rv[S][1].x, rv[S][1].y, rv[S][1].z, rv[S][1].w}; \
        const int cofs_ = 16 * ((j_ >> 3) ^ (ch_ & 7)) + 2 * (j_ & 7); \
        _Pragma("unroll") for (int e2 = 0; e2 < 4; ++e2) { const int row_ = 8 * ch_ + 2 * e2; \
            *(LAS unsigned*)(lds + KT_OFF + row_ * 144 + cofs_) = pk2(__uint_as_float(ka_[e2] << 16) * te0_, __uint_as_float(kb_[e2] << 16) * te1_); \
            *(LAS unsigned*)(lds + KT_OFF + (row_ + 1) * 144 + cofs_) = pk2(__uint_as_float(ka_[e2] & 0xffff0000u) * te0_, __uint_as_float(kb_[e2] & 0xffff0000u) * te1_); \
            *(LAS unsigned*)(lds + VT_OFF + row_ * 144 + cofs_) = (va_[e2] & 0xffffu) | (vb_[e2] << 16); \
            *(LAS unsigned*)(lds + VT_OFF + (row_ + 1) * 144 + cofs_) = (va_[e2] >> 16) | (vb_[e2] & 0xffff0000u); } } while (0)
#define WG_BAR() do { asm volatile("s_waitcnt lgkmcnt(0)" ::: "memory"); __builtin_amdgcn_s_barrier(); asm volatile("" ::: "memory"); } while (0)
template <bool FULL>
__device__ __forceinline__ void ret_unit(const Params& p, LAS unsigned char* lds, int unit, int tid, int wid, int lane) {
    asm volatile("" : "+v"(tid), "+v"(lane));
    const int G = unit & 7, h = (unit >> 3) & 3, b = unit >> 5;
    const bf16_t* P = (const bf16_t*)(p.ws + WS_RB);
    bf16_t* MIX = (bf16_t*)(p.ws + WS_RA);
    float* UG = (float*)(p.ws + WS_UG);
    const size_t tok0 = (size_t)b * 4096 + (size_t)G * 512;
    const float l2g = log2f(1.0f - exp2f(-5.0f - (float)h));
    const float g64 = __builtin_amdgcn_exp2f(l2g * 64.0f);
    const bool is_state = wid >= 4; const int w4 = wid & 3;
    const int l15 = lane & 15, l4 = lane >> 4;
    const int vtL = l4 ^ (l15 >> 3);
    const int vtb0 = VT_OFF + l15 * 144 + 16 * vtL, vtb1 = VT_OFF + l15 * 144 + 16 * (vtL ^ 2);
#define VT_ADDR(nt, ks) ((((nt) & 1) ? vtb1 : vtb0) + (nt) * 2304 + 16 * (((4 * (ks)) ^ (2 * ((nt) & 3))) & 4))
    constexpr int PD = FULL ? 1 : 4;
    u32x4 rq[PD][2], rk[PD][2], rv[PD][2], rg[PD][2];
    if (is_state) {
        f32x4 st[2][8];
#pragma unroll
        for (int mt = 0; mt < 2; ++mt)
#pragma unroll
            for (int nt = 0; nt < 8; ++nt) st[mt][nt] = (f32x4){0.f, 0.f, 0.f, 0.f};
        if (FULL) {
#pragma unroll 1
            for (int Gp = 0; Gp < G; Gp += 2) {
                const float wa = __builtin_amdgcn_exp2f(l2g * 512.0f * (float)(G - 1 - Gp));
                const bool two = Gp + 1 < G;
                const float wb = two ? __builtin_amdgcn_exp2f(l2g * 512.0f * (float)(G - 2 - Gp)) : 0.f;
                const u32x2* sa = (const u32x2*)UG + ((size_t)((b * 4 + h) * 8 + Gp) * 4 + w4) * 1024 + lane;
                const u32x2* sb = two ? sa + 4 * 1024 : sa;
#pragma unroll
                for (int mt = 0; mt < 2; ++mt)
#pragma unroll
                    for (int nt = 0; nt < 8; ++nt) st[mt][nt] += unpack_bf4(sa[(mt * 8 + nt) * 64]) * wa + unpack_bf4(sb[(mt * 8 + nt) * 64]) * wb;
            }
        }
#pragma unroll
        for (int s = 0; s < PD; ++s) RET_ISSUE(s, s);
#pragma unroll 1
        for (int n0 = 0; n0 < 8; n0 += PD) {
#pragma unroll
          for (int s = 0; s < PD; ++s) { const int n = n0 + s;
            RET_STAGE_A(s);
            if (n + PD < 8) RET_ISSUE(s, n + PD);
            if (FULL) {
#pragma unroll
                for (int mt = 0; mt < 2; ++mt)
#pragma unroll
                    for (int nt = 0; nt < 8; ++nt) { const int e = 16 * nt + l15, dk0 = 32 * w4 + 16 * mt + 4 * l4;
                        *(LAS u32x2*)(lds + ST_OFF + e * 272 + dk0 * 2) = (u32x2){pk2(st[mt][nt][0], st[mt][nt][1]), pk2(st[mt][nt][2], st[mt][nt][3])}; }
            }
            WG_BAR();
            if (FULL) {
                bf16x8 ak[4];
#pragma unroll
                for (int ks = 0; ks < 4; ++ks) ak[ks] = *(const LAS bf16x8*)(lds + KI_OFF + (16 * w4 + l15) * 272 + (32 * ks + 8 * l4) * 2);
#pragma unroll
                for (int it = 0; it < 4; ++it) {
                    bf16x8 bq[4];
#pragma unroll
                    for (int ks = 0; ks < 4; ++ks) bq[ks] = *(const LAS bf16x8*)(lds + QI_OFF + (16 * it + l15) * 272 + (32 * ks + 8 * l4) * 2);
                    f32x4 sa = (f32x4){0.f, 0.f, 0.f, 0.f};
#pragma unroll
                    for (int ks = 0; ks < 4; ++ks) sa = MFMA16(ak[ks], bq[ks], sa);
                    const int i = 16 * it + l15, j0 = 16 * w4 + 4 * l4;
#pragma unroll
                    for (int r = 0; r < 4; ++r) { const int d = i - (j0 + r); sa[r] *= __builtin_amdgcn_exp2f(l2g * (float)(d < 0 ? -d : d)); }
                    *(LAS u32x2*)(lds + SI_OFF + i * 144 + j0 * 2) = (u32x2){pk2(sa[0], sa[1]), pk2(sa[2], sa[3])};
                }
            }
            WG_BAR();
#pragma unroll
            for (int mt = 0; mt < 2; ++mt)
#pragma unroll
                for (int nt = 0; nt < 8; ++nt) st[mt][nt] = st[mt][nt] * g64;
#pragma unroll
            for (int ks = 0; ks < 2; ++ks) {
                bf16x8 akt[2];
#pragma unroll
                for (int mt = 0; mt < 2; ++mt) { const int row = 32 * w4 + 16 * mt + l15; akt[mt] = *(const LAS bf16x8*)(lds + KT_OFF + row * 144 + 16 * ((4 * ks + l4) ^ ((row >> 3) & 7))); }
#pragma unroll
                for (int nh = 0; nh < 2; ++nh) {
                    bf16x8 bv[4];
#pragma unroll
                    for (int nt = 0; nt < 4; ++nt) bv[nt] = *(const LAS bf16x8*)(lds + VT_ADDR(4 * nh + nt, ks));
#pragma unroll
                    for (int nt = 0; nt < 4; ++nt)
#pragma unroll
                        for (int mt = 0; mt < 2; ++mt) st[mt][4 * nh + nt] = MFMA16(akt[mt], bv[nt], st[mt][4 * nh + nt]);
                }
            }
            WG_BAR();
          }
        }
        if (!FULL) {
            u32x2* dst = (u32x2*)UG + ((size_t)unit * 4 + w4) * 1024 + lane;
#pragma unroll
            for (int mt = 0; mt < 2; ++mt)
#pragma unroll
                for (int nt = 0; nt < 8; ++nt) dst[(mt * 8 + nt) * 64] = (u32x2){pk2(st[mt][nt][0], st[mt][nt][1]), pk2(st[mt][nt][2], st[mt][nt][3])};
        } else if (G == 7) {
            float* o = p.out + O_SRP + (size_t)(b * 4 + h) * 16384 + (64 * (l4 & 1) + 16 * w4 + 4 * (l4 >> 1)) * 128 + l15;
#pragma unroll
            for (int mt = 0; mt < 2; ++mt)
#pragma unroll
                for (int nt = 0; nt < 8; ++nt)
#pragma unroll
                    for (int r = 0; r < 4; ++r) o[(8 * mt + r) * 128 + 16 * nt] = st[mt][nt][r];
        }
    } else {
        float rwv[8];
#pragma unroll
        for (int nt = 0; nt < 8; ++nt) rwv[nt] = p.in[8][128 * h + 16 * nt + l15];
#pragma unroll
        for (int s = 0; s < PD; ++s) RET_ISSUE(s, s);
#pragma unroll 1
        for (int n0 = 0; n0 < 8; n0 += PD) {
#pragma unroll
          for (int s = 0; s < PD; ++s) { const int n = n0 + s;
            RET_STAGE_A(s);
            if (n + PD < 8) RET_ISSUE(s, n + PD);
            WG_BAR();
            f32x4 acc[8];
            if (FULL) {
                f32x4 fsv;
#pragma unroll
                for (int r = 0; r < 4; ++r) fsv[r] = __builtin_amdgcn_exp2f(l2g * (float)(16 * w4 + 4 * l4 + r + 1));
#pragma unroll
                for (int nt = 0; nt < 8; ++nt) acc[nt] = (f32x4){0.f, 0.f, 0.f, 0.f};
                bf16x8 aq[4];
#pragma unroll
                for (int ks = 0; ks < 4; ++ks) aq[ks] = *(const LAS bf16x8*)(lds + QI_OFF + (16 * w4 + l15) * 272 + (32 * ks + 8 * l4) * 2);
#pragma unroll
                for (int ks = 0; ks < 4; ++ks)
#pragma unroll
                    for (int nh = 0; nh < 2; ++nh) {
                        bf16x8 bs[4];
#pragma unroll
                        for (int nt = 0; nt < 4; ++nt) bs[nt] = *(const LAS bf16x8*)(lds + ST_OFF + (16 * (4 * nh + nt) + l15) * 272 + (32 * ks + 8 * l4) * 2);
#pragma unroll
                        for (int nt = 0; nt < 4; ++nt) acc[4 * nh + nt] = MFMA16(aq[ks], bs[nt], acc[4 * nh + nt]);
                    }
#pragma unroll
                for (int nt = 0; nt < 8; ++nt) acc[nt] = acc[nt] * fsv;
            }
            WG_BAR();
            if (FULL) {
                bf16x8 as_[2];
#pragma unroll
                for (int ks = 0; ks < 2; ++ks) as_[ks] = *(const LAS bf16x8*)(lds + SI_OFF + (16 * w4 + l15) * 144 + 16 * (4 * ks + l4));
#pragma unroll
                for (int ks = 0; ks < 2; ++ks)
#pragma unroll
                    for (int nh = 0; nh < 2; ++nh) {
                        bf16x8 bv[4];
#pragma unroll
                        for (int nt = 0; nt < 4; ++nt) bv[nt] = *(const LAS bf16x8*)(lds + VT_ADDR(4 * nh + nt, ks));
#pragma unroll
                        for (int nt = 0; nt < 4; ++nt) acc[4 * nh + nt] = MFMA16(as_[ks], bv[nt], acc[4 * nh + nt]);
                    }
                unsigned short gq[4][8];
#pragma unroll
                for (int r = 0; r < 4; ++r)
#pragma unroll
                    for (int nt = 0; nt < 8; ++nt) gq[r][nt] = *(const LAS unsigned short*)(lds + GI_OFF + (16 * w4 + 4 * l4 + r) * 272 + (16 * nt + l15) * 2);
                float rstd[4];
#pragma unroll
                for (int r = 0; r < 4; ++r) { float ss = 0.f;
#pragma unroll
                    for (int nt = 0; nt < 8; ++nt) ss += acc[nt][r] * acc[nt][r];
                    ss += dppf(ss, 1); ss += dppf(ss, 2); ss += dppf(ss, 4); ss += dppf(ss, 8);
                    ss = __shfl(ss, (lane & 48) | 15);
                    rstd[r] = rsqrtf(ss * (1.0f / 128.0f) + EPS); }
#pragma unroll
                for (int r = 0; r < 4; ++r)
#pragma unroll
                    for (int nt = 0; nt < 8; ++nt)
                        *(LAS unsigned short*)(lds + QI_OFF + (16 * w4 + 4 * l4 + r) * 272 + (16 * nt + l15) * 2) = (unsigned short)(pk2s(acc[nt][r] * rstd[r] * rwv[nt] * silu_f(bf2f(gq[r][nt])), 0.f) & 0xffffu);
#pragma unroll
                for (int q = 0; q < 4; ++q) { const int cidx = lane + 64 * q, row = 16 * w4 + (cidx >> 4), ch = cidx & 15;
                    const u32x4 v = *(const LAS u32x4*)(lds + QI_OFF + row * 272 + ch * 16);
                    *(u32x4*)(MIX + (tok0 + (size_t)n * 64 + row) * DM + 128 * h + ch * 8) = v; }
            }
            WG_BAR();
          }
        }
    }
#ifndef CONVREP
#define CONVREP 1
#endif
    if (FULL) for (int crep_ = 0; crep_ < CONVREP; ++crep_) {
        const int c0 = 128 * h + 8 * (tid & 15), run = tid >> 4, t0 = G * 512 + run * 16;
        const float* cwp = p.in[7];
        float w0[8], w1[8], w2[8], p1[8], p2[8];
#pragma unroll
        for (int e = 0; e < 8; ++e) { w0[e] = cwp[c0 + e]; w1[e] = cwp[512 + c0 + e]; w2[e] = cwp[1024 + c0 + e]; p1[e] = 0.f; p2[e] = 0.f; }
        if (t0 > 0) {
            const bf16_t* r2 = P + ((size_t)b * 4096 + t0 - 2) * NIN; const bf16_t* r1 = r2 + NIN;
            const u32x4 c2 = *(const u32x4*)(r2 + 2560 + c0), h2 = *(const u32x4*)(r2 + 3072 + c0), c1 = *(const u32x4*)(r1 + 2560 + c0), h1 = *(const u32x4*)(r1 + 3072 + c0);
            const unsigned c2w[4] = {c2.x, c2.y, c2.z, c2.w}, h2w[4] = {h2.x, h2.y, h2.z, h2.w}, c1w[4] = {c1.x, c1.y, c1.z, c1.w}, h1w[4] = {h1.x, h1.y, h1.z, h1.w};
#pragma unroll
            for (int e = 0; e < 4; ++e) {
                p2[2 * e] = __uint_as_float(c2w[e] << 16) * __uint_as_float(h2w[e] << 16); p2[2 * e + 1] = __uint_as_float(c2w[e] & 0xffff0000u) * __uint_as_float(h2w[e] & 0xffff0000u);
                p1[2 * e] = __uint_as_float(c1w[e] << 16) * __uint_as_float(h1w[e] << 16); p1[2 * e + 1] = __uint_as_float(c1w[e] & 0xffff0000u) * __uint_as_float(h1w[e] & 0xffff0000u); }
        }
#pragma unroll 8
        for (int t = 0; t < 16; ++t) {
            const size_t row = (size_t)b * 4096 + t0 + t;
            const bf16_t* rp = P + row * NIN;
            const u32x4 bb = *(const u32x4*)(rp + 2048 + c0), cc = *(const u32x4*)(rp + 2560 + c0), hh = *(const u32x4*)(rp + 3072 + c0);
            const unsigned bw[4] = {bb.x, bb.y, bb.z, bb.w}, cw4[4] = {cc.x, cc.y, cc.z, cc.w}, hw[4] = {hh.x, hh.y, hh.z, hh.w};
            float y[8];
#pragma unroll
            for (int e = 0; e < 4; ++e) {
                const float ca = __uint_as_float(cw4[e] << 16) * __uint_as_float(hw[e] << 16), cb = __uint_as_float(cw4[e] & 0xffff0000u) * __uint_as_float(hw[e] & 0xffff0000u);
                y[2 * e] = __uint_as_float(bw[e] << 16) * (w0[2 * e] * p2[2 * e] + w1[2 * e] * p1[2 * e] + w2[2 * e] * ca);
                y[2 * e + 1] = __uint_as_float(bw[e] & 0xffff0000u) * (w0[2 * e + 1] * p2[2 * e + 1] + w1[2 * e + 1] * p1[2 * e + 1] + w2[2 * e + 1] * cb);
                p2[2 * e] = p1[2 * e]; p2[2 * e + 1] = p1[2 * e + 1]; p1[2 * e] = ca; p1[2 * e + 1] = cb;
            }
            *(u32x4*)(MIX + row * DM + 512 + c0) = (u32x4){pk2(y[0], y[1]), pk2(y[2], y[3]), pk2(y[4], y[5]), pk2(y[6], y[7])};
        }
        if (G == 7 && run == 31) {
            float* o = p.out + O_CCP + (size_t)b * 1024 + c0;
#pragma unroll
            for (int e = 0; e < 8; ++e) { o[e] = p2[e]; o[512 + e] = p1[e]; }
        }
    }
#undef VT_ADDR
}

__device__ __forceinline__ float ch_at(const float* PS, const float* cache, int b, int t, int ch) {
    if (t < 0) return cache[(b * 2 + (t + 2)) * 512 + ch];
    const float* rp = PS + (size_t)(16 * b + t) * NIN;
    return rp[2560 + ch] * rp[3072 + ch];
}
__device__ __forceinline__ void sample_unit(const Params& p, LAS unsigned char* lds, int su, int tid, int wid, int lane) {
    const int b = su >> 2, h = su & 3, ts0 = TOK_P + 16 * b;
    const float* PS = (const float*)(p.ws + WS_PS);
    bf16_t* MIX = (bf16_t*)(p.ws + WS_RA);
    LAS float* qs = (LAS float*)lds; LAS float* ks = qs + 2048; LAS float* vs = qs + 4096; LAS float* Ssm = qs + 6144; LAS float* osm = qs + 6400;
    const float l2g = log2f(1.0f - exp2f(-5.0f - (float)h));
    const float* cosT = (const float*)(p.ws + WS_COS); const float* sinT = (const float*)(p.ws + WS_SIN);
    for (int idx = tid; idx < 2048; idx += 512) { const int i = idx >> 7, c = idx & 127, d = dmap(c);
        const float* rp = PS + (size_t)(16 * b + i) * NIN + 128 * h;
        const float cs = cosT[(4096 + i) * 64 + (d & 63)], sn = sinT[(4096 + i) * 64 + (d & 63)];
        const float xq = rp[c], xqp = rp[c ^ 4], xk = rp[512 + c], xkp = rp[512 + (c ^ 4)];
        qs[i * 128 + d] = d < 64 ? xq * cs - xqp * sn : xq * cs + xqp * sn;
        ks[i * 128 + d] = (d < 64 ? xk * cs - xkp * sn : xk * cs + xkp * sn) * 0.08838834764831845f;
        vs[i * 128 + c] = rp[1024 + c]; }
    __syncthreads();
    if (tid < 256) { const int i = tid >> 4, j = tid & 15; float s = 0.f;
        for (int d = 0; d < 128; ++d) s += qs[i * 128 + d] * ks[j * 128 + d];
        const int dd = i - j; Ssm[i * 16 + j] = s * __builtin_amdgcn_exp2f(l2g * (float)(dd < 0 ? -dd : dd)); }
    const int e = tid & 127, ig = tid >> 7;
    LAS float* s0 = qs + 8704;
    { const float* s0g = p.in[2] + (size_t)su * 16384; f32x4 t8[8];
#pragma unroll
      for (int q = 0; q < 8; ++q) t8[q] = *((const f32x4*)s0g + tid + 512 * q);
#pragma unroll
      for (int q = 0; q < 8; ++q) *((LAS f32x4*)s0 + tid + 512 * q) = t8[q]; }
    __syncthreads();
    float cr[4] = {0.f, 0.f, 0.f, 0.f};
#pragma unroll 4
    for (int d = 0; d < 128; ++d) { const float sv = s0[d * 128 + e];
#pragma unroll
        for (int r = 0; r < 4; ++r) cr[r] += qs[(ig * 4 + r) * 128 + d] * sv; }
    __syncthreads();
#pragma unroll
    for (int r = 0; r < 4; ++r) { const int i = ig * 4 + r; float o = 0.f;
        for (int j = 0; j < 16; ++j) o += Ssm[i * 16 + j] * vs[j * 128 + e];
        osm[i * 128 + e] = o + __builtin_amdgcn_exp2f(l2g * (float)(i + 1)) * cr[r]; }
    __syncthreads();
    for (int rr = 0; rr < 2; ++rr) { const int i = 2 * wid + rr; const float v0 = osm[i * 128 + lane], v1 = osm[i * 128 + 64 + lane];
        const float rstd = rsqrtf(wave_sum(v0 * v0 + v1 * v1) * (1.0f / 128.0f) + EPS);
        const size_t token = (size_t)(ts0 + i);
        const float g0 = PS[(size_t)(16 * b + i) * NIN + 1536 + 128 * h + lane], g1 = PS[(size_t)(16 * b + i) * NIN + 1536 + 128 * h + 64 + lane];
        MIX[token * DM + 128 * h + lane] = (bf16_t)(pk2(v0 * rstd * p.in[8][128 * h + lane] * silu_f(g0), 0.f) & 0xffffu);
        MIX[token * DM + 128 * h + 64 + lane] = (bf16_t)(pk2(v1 * rstd * p.in[8][128 * h + 64 + lane] * silu_f(g1), 0.f) & 0xffffu); }
    const float g16 = __builtin_amdgcn_exp2f(l2g * 16.0f);
    float* outS = p.out + O_SRS + (size_t)su * 16384;
#pragma unroll 2
    for (int dd = 0; dd < 32; ++dd) { const int d = ig + 4 * dd; float a = g16 * s0[d * 128 + e];
        for (int j = 0; j < 16; ++j) a += __builtin_amdgcn_exp2f(l2g * (float)(15 - j)) * ks[j * 128 + d] * vs[j * 128 + e];
        outS[d * 128 + e] = a; }
    const int ch = 128 * h + e; const float* cache = p.in[3]; const float* cwp = p.in[7];
    const float w0 = cwp[ch], w1 = cwp[512 + ch], w2 = cwp[1024 + ch];
#pragma unroll
    for (int tt = 0; tt < 4; ++tt) { const int t = ig * 4 + tt;
        const float c0 = ch_at(PS, cache, b, t - 2, ch), c1 = ch_at(PS, cache, b, t - 1, ch), c2 = ch_at(PS, cache, b, t, ch);
        const float y = PS[(size_t)(16 * b + t) * NIN + 2048 + ch] * (w0 * c0 + w1 * c1 + w2 * c2);
        MIX[(size_t)(ts0 + t) * DM + 512 + ch] = (bf16_t)(pk2(y, 0.f) & 0xffffu);
        if (t >= 14) p.out[O_CCS + (size_t)(b * 2 + t - 14) * 512 + ch] = c2; }
    __syncthreads();
}

constexpr int TG_B = 34816, TG_BUF = 34816 + 32 * 272;
template <int NB>
__device__ __forceinline__ void thin_gemm2(LAS unsigned char* lds, const bf16_t* A, int lda, const bf16_t* Bt, int ldb, int n0, int nbstride, int kbeg, int klen, f32x4 (&acc)[NB], int tid, int wid, int lane) {
    const int l15 = lane & 15, l4 = lane >> 4, nkb = klen >> 7;
    const bool hasb = tid < NB * 256;
    const bf16_t* ag = A + (size_t)(tid >> 4) * lda + kbeg + (tid & 15) * 8;
    const bf16_t* bg = Bt + (size_t)(n0 + (tid >> 8) * nbstride + ((tid >> 4) & 15)) * ldb + kbeg + (tid & 15) * 8;
    const int sto = (tid >> 4) * 272 + (tid & 15) * 16;
    const int fro = l15 * 272 + (8 * l4) * 2;
    u32x4 Xa[4], Ya[4], Xb = (u32x4){0u, 0u, 0u, 0u}, Yb = Xb;
#define TG_LOAD(R, kb) do { _Pragma("unroll") for (int i_ = 0; i_ < 4; ++i_) R##a[i_] = *(const u32x4*)(ag + (size_t)(32 * i_) * lda + (kb) * 128); if (hasb) R##b = *(const u32x4*)(bg + (kb) * 128); } while (0)
#define TG_STORE(R, buf) do { _Pragma("unroll") for (int i_ = 0; i_ < 4; ++i_) *(LAS u32x4*)(lds + (buf) * TG_BUF + sto + i_ * 32 * 272) = R##a[i_]; if (hasb) *(LAS u32x4*)(lds + (buf) * TG_BUF + TG_B + sto) = R##b; } while (0)
#define TG_COMP(buf) do { _Pragma("unroll") for (int ks = 0; ks < 4; ++ks) { const bf16x8 a_ = *(const LAS bf16x8*)(lds + (buf) * TG_BUF + 16 * wid * 272 + fro + ks * 64); \
        _Pragma("unroll") for (int nb = 0; nb < NB; ++nb) { const bf16x8 b_ = *(const LAS bf16x8*)(lds + (buf) * TG_BUF + TG_B + 16 * nb * 272 + fro + ks * 64); acc[nb] = MFMA16(a_, b_, acc[nb]); } } } while (0)
#pragma unroll
    for (int nb = 0; nb < NB; ++nb) acc[nb] = (f32x4){0.f, 0.f, 0.f, 0.f};
    TG_LOAD(X, 0); TG_LOAD(Y, 1);
    TG_STORE(X, 0); WG_BAR();
#pragma unroll 1
    for (int kb = 0; kb < nkb; kb += 2) {
        if (kb + 2 < nkb) TG_LOAD(X, kb + 2);
        TG_COMP(0);
        TG_STORE(Y, 1); WG_BAR();
        if (kb + 3 < nkb) TG_LOAD(Y, kb + 3);
        TG_COMP(1);
        if (kb + 2 < nkb) TG_STORE(X, 0);
        WG_BAR();
    }
#undef TG_LOAD
#undef TG_STORE
#undef TG_COMP
}
template <int NB>
__device__ __forceinline__ void thin_gemm(const bf16_t* A, int lda, const bf16_t* Bt, int ldb, int n0, int nbstride, int kbeg, int klen, f32x4 (&acc)[NB], int wid, int lane) {
    const int l15 = lane & 15, l4 = lane >> 4;
    const bf16_t* ap = A + (size_t)(16 * wid + l15) * lda + kbeg + 8 * l4;
    const bf16_t* bp = Bt + (size_t)(n0 + l15) * ldb + kbeg + 8 * l4;
#pragma unroll
    for (int nb = 0; nb < NB; ++nb) acc[nb] = (f32x4){0.f, 0.f, 0.f, 0.f};
#pragma unroll 1
    for (int s0 = 0; s0 < klen; s0 += 256) {
        bf16x8 a[8], b[NB][8];
#pragma unroll
        for (int s = 0; s < 8; ++s) { a[s] = *(const bf16x8*)(ap + s0 + 32 * s);
#pragma unroll
            for (int nb = 0; nb < NB; ++nb) b[nb][s] = *(const bf16x8*)(bp + (size_t)nb * nbstride * ldb + s0 + 32 * s); }
#pragma unroll
        for (int s = 0; s < 8; ++s)
#pragma unroll
            for (int nb = 0; nb < NB; ++nb) acc[nb] = MFMA16(a[s], b[nb][s], acc[nb]);
    }
}
__device__ __forceinline__ void thin_store(const f32x4& acc, float* out, int ldo, int col, int wid, int lane) {
#pragma unroll
    for (int r = 0; r < 4; ++r) out[(size_t)(16 * wid + 4 * (lane >> 4) + r) * ldo + col + (lane & 15)] = acc[r];
}
__device__ __forceinline__ void thin_ffn1(const Params& p, LAS unsigned char* lds, int c, int tid, int wid, int lane) {
    const int pn = c >> 3, j16 = c & 7, l15 = lane & 15, l4 = lane >> 4;
    f32x4 acc[2];
    thin_gemm2<2>(lds, (const bf16_t*)(p.ws + WS_RA) + (size_t)TOK_P * DM, DM, (const bf16_t*)(p.ws + WS_WFF1), DM, 256 * pn + 16 * j16, 128, 0, DM, acc, tid, wid, lane);
    const int ch = 128 * pn + 16 * j16 + l15, b = wid;
    const float* cw = p.in[15]; const float* cache = p.in[4] + (size_t)b * 2 * DFF + ch;
    const float w0 = cw[ch], w1 = cw[DFF + ch], w2 = cw[2 * DFF + ch];
    const f32x4 up = acc[0], gt = acc[1];
    float pm1 = __shfl_up(up[3], 16), pm2 = __shfl_up(up[2], 16);
    if (l4 == 0) { pm1 = cache[DFF]; pm2 = cache[0]; }
    float uc[4];
    uc[0] = w0 * pm2 + w1 * pm1 + w2 * up[0];
    uc[1] = w0 * pm1 + w1 * up[0] + w2 * up[1];
    uc[2] = w0 * up[0] + w1 * up[1] + w2 * up[2];
    uc[3] = w0 * up[1] + w1 * up[2] + w2 * up[3];
    bf16_t* ACT = (bf16_t*)(p.ws + WS_RB);
#pragma unroll
    for (int r = 0; r < 4; ++r) ACT[(size_t)(TOK_P + 16 * wid + 4 * l4 + r) * DFF + ch] = (bf16_t)(pk2(pg8::gelu_tanh(uc[r]) * gt[r], 0.f) & 0xffffu);
    if (l4 == 3) { float* o = p.out + O_CFS + (size_t)b * 2 * DFF + ch; o[0] = up[2]; o[DFF] = up[3]; }
}

__device__ __forceinline__ void phase4(const Params& p, int wid, int lane) {
    const int gw = blockIdx.x * 8 + wid, NGW = gridDim.x * 8;
    const bf16_t* Y = (const bf16_t*)(p.ws + WS_Y); bf16_t* H2 = (bf16_t*)(p.ws + WS_RA); const float* ssq = (const float*)(p.ws + WS_SSQ1);
    const float* wpost = p.in[10]; const float* wpre = p.in[11];
    f32x4 wpo[4], wpr[4];
#pragma unroll
    for (int j = 0; j < 4; ++j) { wpo[j] = *((const f32x4*)wpost + lane + 64 * j); wpr[j] = *((const f32x4*)wpre + lane + 64 * j); }
#pragma unroll 1
    for (int base = gw; base < TOK_P; base += RB * NGW) {
        f32x4 v[RB][4]; u32x2 yw[RB][4]; float sq[RB];
#pragma unroll
        for (int k = 0; k < RB; ++k) { const int rr = min(base + k * NGW, TOK_P - 1);
            sq[k] = lane < 16 ? ssq[(size_t)rr * 16 + lane] : 0.f;
#pragma unroll
            for (int j = 0; j < 4; ++j) { v[k][j] = __builtin_nontemporal_load((const f32x4*)(p.in[0] + (size_t)rr * DM) + lane + 64 * j); yw[k][j] = __builtin_nontemporal_load((const u32x2*)(Y + (size_t)rr * DM) + lane + 64 * j); } }
        float s2[RB];
#pragma unroll
        for (int k = 0; k < RB; ++k) { const float rstd1 = rsqrtf(wave_sum(sq[k]) * (1.0f / DM) + EPS); s2[k] = 0.f;
#pragma unroll
            for (int j = 0; j < 4; ++j) { v[k][j] = v[k][j] + (unpack_bf4(yw[k][j]) * rstd1) * wpo[j]; s2[k] += sumsq4(v[k][j]); } }
#pragma unroll
        for (int k = 0; k < RB; ++k) { const int r = base + k * NGW; const float rstd2 = rsqrtf(wave_sum(s2[k]) * (1.0f / DM) + EPS);
            if (r < TOK_P) {
#pragma unroll
                for (int j = 0; j < 4; ++j) { const f32x4 y = (v[k][j] * rstd2) * wpr[j];
                    __builtin_nontemporal_store((u32x2){pk2(y[0], y[1]), pk2(y[2], y[3])}, (u32x2*)(H2 + (size_t)r * DM) + lane + 64 * j); } } }
    }
    for (int r = TOK_P + gw; r < TOK; r += NGW) {
        const float* xrow = p.in[1] + (size_t)(r - TOK_P) * DM; const float* ys = (const float*)(p.ws + WS_YS) + (size_t)(r - TOK_P) * DM;
        f32x4 yv[4], v[4]; float s = 0.f, s2 = 0.f;
#pragma unroll
        for (int j = 0; j < 4; ++j) { f32x4 a = *((const f32x4*)ys + lane + 64 * j);
#pragma unroll
            for (int q = 1; q < 4; ++q) a += *((const f32x4*)(ys + (size_t)q * 128 * DM) + lane + 64 * j);
            yv[j] = a; s += sumsq4(a); }
        const float rstd1 = rsqrtf(wave_sum(s) * (1.0f / DM) + EPS);
#pragma unroll
        for (int j = 0; j < 4; ++j) { v[j] = *((const f32x4*)xrow + lane + 64 * j) + (yv[j] * rstd1) * wpo[j]; s2 += sumsq4(v[j]);
 }
        const float rstd2 = rsqrtf(wave_sum(s2) * (1.0f / DM) + EPS);
#pragma unroll
        for (int j = 0; j < 4; ++j) { const f32x4 y = (v[j] * rstd2) * wpr[j]; *((u32x2*)(H2 + (size_t)r * DM) + lane + 64 * j) = (u32x2){pk2(y[0], y[1]), pk2(y[2], y[3])}; }
    }
}
__device__ __forceinline__ void phase7(const Params& p, int wid, int lane) {
    const int gw = blockIdx.x * 8 + wid, NGW = gridDim.x * 8;
    const bf16_t* F = (const bf16_t*)(p.ws + WS_RA); const bf16_t* Y = (const bf16_t*)(p.ws + WS_Y);
    const float* ssq1 = (const float*)(p.ws + WS_SSQ1); const float* ssq2 = (const float*)(p.ws + WS_SSQ2);
    f32x4 wm[4], wf[4];
#pragma unroll
    for (int j = 0; j < 4; ++j) { wm[j] = *((const f32x4*)p.in[10] + lane + 64 * j); wf[j] = *((const f32x4*)p.in[12] + lane + 64 * j); }
    constexpr int RB7 = 4;
#pragma unroll 1
    for (int base = gw; base < TOK_P; base += RB7 * NGW) {
        f32x4 v[RB7][4]; u32x2 yw[RB7][4], fw[RB7][4]; float sq1[RB7], sq2[RB7];
#pragma unroll
        for (int k = 0; k < RB7; ++k) { const int rr = min(base + k * NGW, TOK_P - 1);
            sq1[k] = lane < 16 ? ssq1[(size_t)rr * 16 + lane] : 0.f; sq2[k] = lane < 16 ? ssq2[(size_t)rr * 16 + lane] : 0.f;
#pragma unroll
            for (int j = 0; j < 4; ++j) { v[k][j] = __builtin_nontemporal_load((const f32x4*)(p.in[0] + (size_t)rr * DM) + lane + 64 * j);
                yw[k][j] = __builtin_nontemporal_load((const u32x2*)(Y + (size_t)rr * DM) + lane + 64 * j); fw[k][j] = __builtin_nontemporal_load((const u32x2*)(F + (size_t)rr * DM) + lane + 64 * j); } }
#pragma unroll
        for (int k = 0; k < RB7; ++k) { const int r = base + k * NGW;
            const float rstd1 = rsqrtf(wave_sum(sq1[k]) * (1.0f / DM) + EPS), rstd2 = rsqrtf(wave_sum(sq2[k]) * (1.0f / DM) + EPS);
            if (r < TOK_P) {
#pragma unroll
                for (int j = 0; j < 4; ++j) __builtin_nontemporal_store(v[k][j] + (unpack_bf4(yw[k][j]) * rstd1) * wm[j] + (unpack_bf4(fw[k][j]) * rstd2) * wf[j], (f32x4*)(p.out + (size_t)r * DM) + lane + 64 * j); } }
    }
    for (int r = TOK_P + gw; r < TOK; r += NGW) {
        const float* xrow = p.in[1] + (size_t)(r - TOK_P) * DM;
        const float* ys = (const float*)(p.ws + WS_YS) + (size_t)(r - TOK_P) * DM; const float* fs = (const float*)(p.ws + WS_FS) + (size_t)(r - TOK_P) * DM;
        f32x4 yv[4], fv[4]; float s1 = 0.f, s2 = 0.f;
#pragma unroll
        for (int j = 0; j < 4; ++j) { f32x4 a = *((const f32x4*)ys + lane + 64 * j), c = *((const f32x4*)fs + lane + 64 * j);
#pragma unroll
            for (int q = 1; q < 4; ++q) { a += *((const f32x4*)(ys + (size_t)q * 128 * DM) + lane + 64 * j); c += *((const f32x4*)(fs + (size_t)q * 128 * DM) + lane + 64 * j); }
            yv[j] = a; fv[j] = c; s1 += sumsq4(a); s2 += sumsq4(c); }
        const float rstd1 = rsqrtf(wave_sum(s1) * (1.0f / DM) + EPS), rstd2 = rsqrtf(wave_sum(s2) * (1.0f / DM) + EPS);
#pragma unroll
        for (int j = 0; j < 4; ++j) *((f32x4*)(p.out + (size_t)r * DM) + lane + 64 * j) = *((const f32x4*)xrow + lane + 64 * j) + (yv[j] * rstd1) * wm[j] + (fv[j] * rstd2) * wf[j];
    }
}


#define XB_TMO      128
#define XB_XCNT(j)  (256  + 64 * (j))
#define XB_XSUB(j)  (1280 + 64 * (j))
#define XB_XGEN(j)  (2304 + 64 * (j))
#define XB_TOP      3328
#define XB_TOPGEN   3392
#define XCD_BAR_WORDS 3456
#define XB_SPIN_CAP (1u << 18)

__device__ __forceinline__ unsigned xb_ld(unsigned* p)              { return __hip_atomic_load(p, __ATOMIC_RELAXED, __HIP_MEMORY_SCOPE_AGENT); }
__device__ __forceinline__ unsigned xb_add(unsigned* p, unsigned v) { return __hip_atomic_fetch_add(p, v, __ATOMIC_RELAXED, __HIP_MEMORY_SCOPE_AGENT); }
__device__ __forceinline__ unsigned xb_xcc_id() { return (unsigned)__builtin_amdgcn_s_getreg((3 << 11) | 20) & 0xFu; }
#define XB_SPIN(cond, bar) do { unsigned _sp = 0; while (cond) { __builtin_amdgcn_s_sleep(1); \
    if ((++_sp & 255u) == 0u) { if (xb_ld(&(bar)[XB_TMO])) break; if (_sp > XB_SPIN_CAP) { atomicAdd(&(bar)[XB_TMO], 1u); break; } } } } while (0)

struct XcdBarrier {
    unsigned* bar; unsigned x;
    volatile LAS unsigned* st;
};

__device__ __forceinline__ XcdBarrier xcd_barrier_post(unsigned* bar, volatile LAS unsigned* st) {
    XcdBarrier b; b.bar = bar; b.x = xb_xcc_id(); b.st = st;
    if (threadIdx.x == 0) (void)xb_add(&bar[XB_XCNT(b.x)], 1u);
    return b;
}
__device__ __forceinline__ void xcd_barrier_complete(unsigned* bar, unsigned x, unsigned& nloc, unsigned& nx) {
    const unsigned G = gridDim.x * gridDim.y * gridDim.z;
    unsigned sum, cnt, mine, sp = 0u;
    for (;;) {
        sum = 0u; cnt = 0u; mine = 0u;
#pragma unroll
        for (unsigned j = 0; j < 16; ++j) { const unsigned c = xb_ld(&bar[XB_XCNT(j)]); sum += c; cnt += (c > 0u) ? 1u : 0u; mine = (j == x) ? c : mine; }
        if (sum == G) break;
        __builtin_amdgcn_s_sleep(1);
        if ((++sp & 255u) == 0u) { if (xb_ld(&bar[XB_TMO])) break; if (sp > XB_SPIN_CAP) { atomicAdd(&bar[XB_TMO], 1u); break; } }
    }
    nloc = mine > 0u ? mine : 1u; nx = cnt > 0u ? cnt : 1u;
}

__device__ __forceinline__ void xcd_barrier(const XcdBarrier& b) {
    asm volatile("s_waitcnt vmcnt(0)" ::: "memory");
    __syncthreads();
    if (threadIdx.x == 0) {
        unsigned* bar = b.bar;
        __builtin_amdgcn_s_waitcnt(0);
        unsigned nloc = b.st[0], nx = b.st[1];
        if (nloc == 0u) { xcd_barrier_complete(bar, b.x, nloc, nx); b.st[0] = nloc; b.st[1] = nx; }
        const unsigned old = xb_add(&bar[XB_XSUB(b.x)], 1u);
        const unsigned gen = old / nloc;
        if (old + 1u == (gen + 1u) * nloc) {
            __builtin_amdgcn_fence(__ATOMIC_RELEASE, "agent");
            asm volatile("s_waitcnt vmcnt(0)" ::: "memory");
            const unsigned og = xb_add(&bar[XB_TOP], 1u);
            const unsigned tg = og / nx;
            if (og + 1u == (tg + 1u) * nx) xb_add(&bar[XB_TOPGEN], 1u);
            else XB_SPIN(xb_ld(&bar[XB_TOPGEN]) == tg, bar);
            __builtin_amdgcn_fence(__ATOMIC_ACQUIRE, "agent");
            xb_add(&bar[XB_XGEN(b.x)], 1u);
            asm volatile("s_waitcnt vmcnt(0)" ::: "memory");
        } else {
            XB_SPIN(xb_ld(&bar[XB_XGEN(b.x)]) == gen, bar);
            __builtin_amdgcn_fence(__ATOMIC_ACQUIRE, "agent");
            asm volatile("s_waitcnt vmcnt(0)" ::: "memory");
        }
    }
    __syncthreads();
}

#ifndef MK_LAUNCHES
#define MK_LAUNCHES 1
#endif
#ifndef REP0
#define REP0 1
#endif
#ifndef REP1
#define REP1 1
#endif
#ifndef REP2
#define REP2 1
#endif
#ifndef REP3
#define REP3 1
#endif
#ifndef REP4
#define REP4 1
#endif
#ifndef REP5
#define REP5 1
#endif
#ifndef REP6
#define REP6 1
#endif
#ifndef REP7
#define REP7 1
#endif
#define REPEAT(n) for (int rep_ = 0; rep_ < (n); ++rep_, ((rep_ < (n)) ? GRIDSYNC() : (void)0))
template <int PH_LO, int PH_HI>
__device__ __forceinline__ void run_phases(const Params& p, LAS unsigned char* lds) {
    int tid = threadIdx.x, lane = tid & 63; const int wid = __builtin_amdgcn_readfirstlane(tid >> 6);
    const int G = gridDim.x, c = blockIdx.x;
#define LAUNDER() asm volatile("" : "+v"(tid), "+v"(lane))
    XcdBarrier bar_;
    if (PH_HI - PH_LO > 1) {
        volatile LAS unsigned* stw = (volatile LAS unsigned*)(lds + LDS_BARW);
        if (threadIdx.x == 0) { stw[0] = 0u; stw[1] = 0u; }
        __syncthreads();
        bar_ = xcd_barrier_post((unsigned*)p.ws, stw);
        if (p.ws == nullptr) cg::this_grid().sync();
    }
#define GRIDSYNC() xcd_barrier(bar_)
#define SEAM(ph) do { if (PH_LO <= (ph) && (ph) + 1 < PH_HI) { GRIDSYNC(); } } while (0)
#ifdef XSYNC
    for (int xs_ = 0; xs_ < XSYNC; ++xs_) GRIDSYNC();
#endif
    if (PH_LO <= 0 && 0 < PH_HI) REPEAT(REP0) { LAUNDER(); phase0(p, lds, tid, wid, lane); }
    SEAM(0);
    if (PH_LO <= 1 && 1 < PH_HI) REPEAT(REP1) {
        for (int t = c; t < 224; t += G) { f32x4 acc[1]; thin_gemm2<1>(lds, (const bf16_t*)(p.ws + WS_RA) + (size_t)TOK_P * DM, DM, (const bf16_t*)(p.ws + WS_WIN), DM, 16 * t, 0, 0, DM, acc, tid, wid, lane);
            thin_store(acc[0], (float*)(p.ws + WS_PS), NIN, 16 * t, wid, lane); }
        pg8::Gemm g{(const bf16_t*)(p.ws + WS_RA), (const bf16_t*)(p.ws + WS_WIN), TOK_P, NIN, DM};
        pg8::StaticOrder S; S.init(TOK_P, NIN, G, c);
        pg8::EpiIn E{(bf16_t*)(p.ws + WS_RB), (const float*)(p.ws + WS_COS), (const float*)(p.ws + WS_SIN)};
        pg8::gemm_phase<pg8::EpiIn, pg8::StaticOrder, true, true>(lds, g, S, E);
    }
    SEAM(1);
    if (PH_LO <= 2 && 2 < PH_HI) REPEAT(REP2) {
#ifndef RUREP
#define RUREP 1
#endif
        for (int rrep_ = 0; rrep_ < RUREP; ++rrep_) for (int u = c; u < 256; u += G) ret_unit<false>(p, lds, u, tid, wid, lane);
        LAUNDER();
#ifndef SUREP
#define SUREP 1
#endif
        for (int srep_ = 0; srep_ < SUREP; ++srep_) for (int su = c; su < 32; su += G) sample_unit(p, lds, su, tid, wid, lane);
    }
    SEAM(2);
    if (PH_LO <= 3 && 3 < PH_HI) REPEAT(REP3) {
        for (int u = c; u < 256; u += G) ret_unit<true>(p, lds, u, tid, wid, lane);
    }
    SEAM(3);
    if (PH_LO <= 4 && 4 < PH_HI) REPEAT(REP4) {
        for (int t = c; t < 256; t += G) { f32x4 acc[1]; const int kq = t >> 6, nt = t & 63;
            thin_gemm2<1>(lds, (const bf16_t*)(p.ws + WS_RA) + (size_t)TOK_P * DM, DM, (const bf16_t*)(p.ws + WS_WOUT), DM, 16 * nt, 0, 256 * kq, 256, acc, tid, wid, lane);
            thin_store(acc[0], (float*)(p.ws + WS_YS) + (size_t)kq * 128 * DM, DM, 16 * nt, wid, lane); }
        pg8::Gemm g{(const bf16_t*)(p.ws + WS_RA), (const bf16_t*)(p.ws + WS_WOUT), TOK_P, DM, DM};
        pg8::StaticOrder S; S.init(TOK_P, DM, G, c);
        pg8::EpiY E{(bf16_t*)(p.ws + WS_Y), (float*)(p.ws + WS_SSQ1)};
        pg8::gemm_phase<pg8::EpiY, pg8::StaticOrder, true, true>(lds, g, S, E);
    }
    SEAM(4);
    if (PH_LO <= 5 && 5 < PH_HI) REPEAT(REP5) { LAUNDER(); phase4(p, wid, lane); }
    SEAM(5);
    if (PH_LO <= 6 && 6 < PH_HI) REPEAT(REP6) {
        for (int t = c; t < 256; t += G) thin_ffn1(p, lds, t, tid, wid, lane);
        pg8::Gemm g{(const bf16_t*)(p.ws + WS_RA), (const bf16_t*)(p.ws + WS_WFF1), TOK_P, 2 * DFF, DM};
        pg8::WalkOrder S{G, c};
        pg8::EpiFfn E{(bf16_t*)(p.ws + WS_RB), p.in[15], p.in[4], p.out + O_CFP, p.out + O_CFS, (LAS float*)(lds + LDS_HALO)};
        pg8::gemm_phase<pg8::EpiFfn, pg8::WalkOrder, true, true>(lds, g, S, E);
    }
    SEAM(6);
    if (PH_LO <= 7 && 7 < PH_HI) REPEAT(REP7) {
        for (int t = c; t < 256; t += G) { f32x4 acc[1]; const int kq = t >> 6, nt = t & 63;
            thin_gemm2<1>(lds, (const bf16_t*)(p.ws + WS_RB) + (size_t)TOK_P * DFF, DFF, (const bf16_t*)(p.ws + WS_WDN), DFF, 16 * nt, 0, 1024 * kq, 1024, acc, tid, wid, lane);
            thin_store(acc[0], (float*)(p.ws + WS_FS) + (size_t)kq * 128 * DM, DM, 16 * nt, wid, lane); }
        pg8::Gemm g{(const bf16_t*)(p.ws + WS_RB), (const bf16_t*)(p.ws + WS_WDN), TOK_P, DM, DFF};
        pg8::StaticOrder S; S.init(TOK_P, DM, G, c);
        pg8::EpiY E{(bf16_t*)(p.ws + WS_RA), (float*)(p.ws + WS_SSQ2)};
        pg8::gemm_phase<pg8::EpiY, pg8::StaticOrder, true, true>(lds, g, S, E);
    }
    SEAM(7);
#ifndef REP8
#define REP8 1
#endif
    if (PH_LO <= 8 && 8 < PH_HI) REPEAT(REP8) { LAUNDER(); phase7(p, wid, lane); }
#undef SEAM
}
constexpr int NPH = 9;
#if MK_LAUNCHES == 1
__global__ void __launch_bounds__(512, 2) fwd_kernel(Params p) {
    extern __shared__ __attribute__((aligned(16))) unsigned char smem[];
    run_phases<0, NPH>(p, (LAS unsigned char*)smem);
}
#else
template <int PH>
__global__ void __launch_bounds__(512, 2) fwd_phase(Params p) {
    extern __shared__ __attribute__((aligned(16))) unsigned char smem[];
    run_phases<PH, PH + 1>(p, (LAS unsigned char*)smem);
}
template <int PH> static void launch_phase(const Params& p, int grid, hipStream_t stream) {
    static bool attr = false;
    if (!attr) { (void)hipFuncSetAttribute((const void*)fwd_phase<PH>, hipFuncAttributeMaxDynamicSharedMemorySize, LDS_BYTES); attr = true; }
    hipLaunchKernelGGL(fwd_phase<PH>, dim3(grid), dim3(512), LDS_BYTES, stream, p);
}
#endif

extern "C" void kernel_launch(void* const* d_in, const int* in_sizes, int n_in, void* d_out, int out_size, void* d_ws, size_t ws_size, hipStream_t stream) {
    static int grid = 0;
    if (grid == 0) {
        if (n_in != 17 || ws_size < WS_END) { fprintf(stderr, "kernel_launch: expected 17 inputs and >= %zu bytes of workspace (got %d, %zu)\n", (size_t)WS_END, n_in, ws_size); grid = -1; return; }
        int dev = 0, cus = 0, per_cu = 0;
        (void)hipGetDevice(&dev); (void)hipDeviceGetAttribute(&cus, hipDeviceAttributeMultiprocessorCount, dev);
#if MK_LAUNCHES == 1
        if (hipFuncSetAttribute((const void*)fwd_kernel, hipFuncAttributeMaxDynamicSharedMemorySize, LDS_BYTES) != hipSuccess) { fprintf(stderr, "kernel_launch: hipFuncSetAttribute failed\n"); grid = -1; return; }
        if (hipOccupancyMaxActiveBlocksPerMultiprocessor(&per_cu, (const void*)fwd_kernel, 512, LDS_BYTES) != hipSuccess || per_cu < 1) { fprintf(stderr, "kernel_launch: occupancy query says %d\n", per_cu); per_cu = 1; }
        (void)hipGetLastError();
#endif
        grid = cus > 0 ? cus : 256;
    }
    if (grid < 0) return;
    Params p{};
    for (int i = 0; i < 17; ++i) p.in[i] = (const float*)d_in[i];
    p.out = (float*)d_out; p.ws = (unsigned char*)d_ws;
#if MK_LAUNCHES == 1
    if (hipMemsetAsync(d_ws, 0, 16384, stream) != hipSuccess) { fprintf(stderr, "kernel_launch: hipMemsetAsync failed\n"); return; }
    void* args[] = {&p};
    const hipError_t e = hipLaunchCooperativeKernel((const void*)fwd_kernel, dim3(grid), dim3(512), args, LDS_BYTES, stream);
    if (e != hipSuccess) fprintf(stderr, "kernel_launch: cooperative launch failed: %s (grid %d)\n", hipGetErrorString(e), grid);
#else
    launch_phase<0>(p, grid, stream); launch_phase<1>(p, grid, stream); launch_phase<2>(p, grid, stream); launch_phase<3>(p, grid, stream); launch_phase<4>(p, grid, stream);
    launch_phase<5>(p, grid, stream); launch_phase<6>(p, grid, stream); launch_phase<7>(p, grid, stream); launch_phase<8>(p, grid, stream);
#endif
}
```

```cpp
#include <hip/hip_runtime.h>
#include <hip/hip_cooperative_groups.h>
#include <cstdio>
#include <cstdint>
namespace cg = cooperative_groups;
namespace pg8 {
#define PG8_LAS __attribute__((address_space(3)))
typedef unsigned short bf16_t;
typedef short bf16x8 __attribute__((ext_vector_type(8)));
typedef float f32x4 __attribute__((ext_vector_type(4)));
typedef unsigned u32x4 __attribute__((ext_vector_type(4)));
constexpr int BM = 256, BK = 64, HALF = 128, HTB = HALF * BK * 2  , STAGE_BYTES = 8 * HTB, NXCD = 8, WGM = 8;

__host__ __device__ __forceinline__ int lds_byte(int r, int c) { const int st = (r >> 4) * 2 + (c >> 5), rr = r & 15, cc = c & 31, ob = rr * 64 + cc * 2; return st * 1024 + (ob ^ (((ob >> 9) & 1) << 5)); }
__host__ __device__ __forceinline__ void stage_rc(int b, int& R, int& C) { const int st = b / 1024, sb = b % 1024, swz = sb ^ (((sb >> 9) & 1) << 5); R = (st >> 1) * 16 + swz / 64; C = (st & 1) * 32 + (swz % 64) / 2; }
__host__ __device__ __forceinline__ int perm32(int rho) { const int n = rho >> 4, i = rho & 15; return 8 * (i >> 2) + 4 * n + (i & 3); }

struct Unit { int pm, pn; };
struct Gemm { const bf16_t* A; const bf16_t* Bt; int M, N, K; };

struct StaticOrder {
    int nM, nN, nwg, G, c;
    __host__ __device__ void init(int M, int N, int G_, int c_) { nM = M / BM; nN = N / BM; nwg = nM * nN; G = G_; c = c_; }
    __host__ __device__ bool next(int i, Unit& u) const {
        const long L = (long)i * G + c; if (L >= nwg) return false;
        int wgid = (int)L; { const int q = nwg / NXCD, r = nwg % NXCD, xcd = wgid % NXCD, off = wgid / NXCD; wgid = (xcd < r ? xcd * (q + 1) : r * (q + 1) + (xcd - r) * q) + off; }
        const int nig = WGM * nN, gid = wgid / nig, fm = gid * WGM, gsz = (nM - fm) < WGM ? (nM - fm) : WGM;
        u.pm = fm + ((wgid % nig) % gsz); u.pn = (wgid % nig) / gsz; return true;
    }
    __device__ __forceinline__ void a_ready(const Unit&) const {}
    __device__ __forceinline__ void done(const Unit&) const {}
};
__device__ __forceinline__ unsigned cvt_pk_bf16(float lo, float hi) { unsigned r; asm volatile("v_cvt_pk_bf16_f32 %0, %1, %2" : "=v"(r) : "v"(lo), "v"(hi)); return r; }
__device__ __forceinline__ float dpp_shr1(float v) { return __builtin_bit_cast(float, __builtin_amdgcn_update_dpp(0, __builtin_bit_cast(int, v), 0x111, 0xf, 0xf, true)); }
__device__ __forceinline__ float dpp_shr2(float v) { return __builtin_bit_cast(float, __builtin_amdgcn_update_dpp(0, __builtin_bit_cast(int, v), 0x112, 0xf, 0xf, true)); }
__device__ __forceinline__ float dpp_shl15(float v) { return __builtin_bit_cast(float, __builtin_amdgcn_update_dpp(0, __builtin_bit_cast(int, v), 0x10F, 0xf, 0xf, true)); }
__device__ __forceinline__ float dpp_shl14(float v) { return __builtin_bit_cast(float, __builtin_amdgcn_update_dpp(0, __builtin_bit_cast(int, v), 0x10E, 0xf, 0xf, true)); }
__device__ __forceinline__ float gelu_tanh(float x) {
    const float z = 0.7978845608028654f * (x + 0.044715f * x * x * x);
    const float e = __builtin_amdgcn_exp2f(-2.8853900817779268f * z);
    return x * __builtin_amdgcn_rcpf(1.0f + e);
}
constexpr int TOKP = 32768;

struct EpiIn {
    static constexpr bool PERM = true, AFTER_DRAIN = false;
    bf16_t* P; const float* cosT; const float* sinT;
    __device__ __forceinline__ void operator()(const f32x4 (&acc)[2][2][4][2], const Unit& u, int wr, int wc, int fr, int fq) const {
        asm volatile("" : "+v"(fr), "+v"(fq));
        const int row0 = u.pm * BM + wr * 64 + fr, col0 = u.pn * BM + wc * 32 + 8 * fq;
        if (u.pn < 4) {
            const float sc = (u.pn >= 2) ? 0.08838834764831845f : 1.0f;
            const int f0 = 16 * wc + 4 * fq;
#pragma unroll
            for (int ai = 0; ai < 2; ++ai)
#pragma unroll
                for (int m = 0; m < 4; ++m) {
                    const int r = row0 + ai * HALF + m * 16;
                    const int pos = r < TOKP ? (r & 4095) : 4096 + ((r - TOKP) & 15);
                    const f32x4 c4 = *(const f32x4*)(cosT + pos * 64 + f0), s4 = *(const f32x4*)(sinT + pos * 64 + f0);
                    bf16_t* rowp = P + (size_t)r * 3584 + col0;
#pragma unroll
                    for (int bj = 0; bj < 2; ++bj) {
                        const f32x4 x1 = acc[ai][bj][m][0], x2 = acc[ai][bj][m][1];
                        const f32x4 o1 = (x1 * c4 - x2 * s4) * sc, o2 = (x2 * c4 + x1 * s4) * sc;
                        u32x4 w; w.x = cvt_pk_bf16(o1[0], o1[1]); w.y = cvt_pk_bf16(o1[2], o1[3]); w.z = cvt_pk_bf16(o2[0], o2[1]); w.w = cvt_pk_bf16(o2[2], o2[3]);
                        *(u32x4*)(rowp + bj * HALF) = w;
                    }
                }
        } else {
#pragma unroll
            for (int ai = 0; ai < 2; ++ai)
#pragma unroll
                for (int m = 0; m < 4; ++m) {
                    bf16_t* rowp = P + (size_t)(row0 + ai * HALF + m * 16) * 3584 + col0;
#pragma unroll
                    for (int bj = 0; bj < 2; ++bj) {
                        const f32x4 v0 = acc[ai][bj][m][0], v1 = acc[ai][bj][m][1];
                        u32x4 w; w.x = cvt_pk_bf16(v0[0], v0[1]); w.y = cvt_pk_bf16(v0[2], v0[3]); w.z = cvt_pk_bf16(v1[0], v1[1]); w.w = cvt_pk_bf16(v1[2], v1[3]);
                        *(u32x4*)(rowp + bj * HALF) = w;
                    }
                }
        }
    }
};

struct EpiY {
    static constexpr bool PERM = true, AFTER_DRAIN = false;
    bf16_t* Y; float* ssq;
    __device__ __forceinline__ void operator()(const f32x4 (&acc)[2][2][4][2], const Unit& u, int wr, int wc, int fr, int fq) const {
        asm volatile("" : "+v"(fr), "+v"(fq));
        const int row0 = u.pm * BM + wr * 64 + fr, col0 = u.pn * BM + wc * 32 + 8 * fq;
#pragma unroll
        for (int ai = 0; ai < 2; ++ai)
#pragma unroll
            for (int m = 0; m < 4; ++m) {
                const int r = row0 + ai * HALF + m * 16;
                bf16_t* rowp = Y + (size_t)r * 1024 + col0;
                float s = 0.f;
#pragma unroll
                for (int bj = 0; bj < 2; ++bj) {
                    const f32x4 v0 = acc[ai][bj][m][0], v1 = acc[ai][bj][m][1];
                    s += (v0[0] * v0[0] + v0[1] * v0[1]) + (v0[2] * v0[2] + v0[3] * v0[3]) + (v1[0] * v1[0] + v1[1] * v1[1]) + (v1[2] * v1[2] + v1[3] * v1[3]);
                    u32x4 w; w.x = cvt_pk_bf16(v0[0], v0[1]); w.y = cvt_pk_bf16(v0[2], v0[3]); w.z = cvt_pk_bf16(v1[0], v1[1]); w.w = cvt_pk_bf16(v1[2], v1[3]);
                    *(u32x4*)(rowp + bj * HALF) = w;
                }
                s += __shfl_xor(s, 16); s += __shfl_xor(s, 32);
                if (fq == 0) ssq[(size_t)r * 16 + u.pn * 4 + wc] = s;
            }
    }
};

struct EpiFfn {
    static constexpr bool PERM = true, AFTER_DRAIN = false;
    bf16_t* ACT; const float* cw; const float* cache; float* outp; float* outs; PG8_LAS float* halo;
    __device__ __forceinline__ void operator()(const f32x4 (&acc)[2][2][4][2], const Unit& u, int wr, int wc, int fr, int fq) const {
        asm volatile("" : "+v"(fr), "+v"(fq));
        const int lc0 = wc * 32 + 8 * fq, ch0 = u.pn * 128 + lc0;
        const bool sample = false;
        const int par = u.pm & 1;
        f32x4 w0[2], w1[2], w2[2];
#pragma unroll
        for (int n = 0; n < 2; ++n) { w0[n] = *(const f32x4*)(cw + ch0 + 4 * n); w1[n] = *(const f32x4*)(cw + 4096 + ch0 + 4 * n); w2[n] = *(const f32x4*)(cw + 8192 + ch0 + 4 * n); }
        if (!sample && fr >= 14) {
#pragma unroll
            for (int ai = 0; ai < 2; ++ai) { PG8_LAS float* hp = halo + ((par * 4 + 2 * ai + wr) * 2 + (fr - 14)) * 128 + lc0;
                *(PG8_LAS f32x4*)hp = acc[ai][0][3][0]; *(PG8_LAS f32x4*)(hp + 4) = acc[ai][0][3][1]; }
        }
        asm volatile("s_waitcnt lgkmcnt(0)" ::: "memory"); __builtin_amdgcn_s_barrier(); asm volatile("" ::: "memory");
#pragma unroll
        for (int ai = 0; ai < 2; ++ai) {
            const int blk = 2 * ai + wr;
#pragma unroll
            for (int m = 0; m < 4; ++m) {
                f32x4 pv[2]; pv[0] = (f32x4){0.f, 0.f, 0.f, 0.f}; pv[1] = pv[0];
                const int sb = 8 * ai + 4 * wr + m;
                if (sample) {
                    if (fr >= 14 && sb < 8) { const float* cp = cache + (size_t)(sb * 2 + fr - 14) * 4096 + ch0; pv[0] = *(const f32x4*)cp; pv[1] = *(const f32x4*)(cp + 4); }
                } else if (m == 0) {
                    if (fr >= 14) {
                        const bool zero = (blk == 0) && ((u.pm & 15) == 0);
                        const int hb = (blk == 0) ? ((par ^ 1) * 4 + 3) : (par * 4 + blk - 1);
                        if (!zero) { const PG8_LAS float* hp = halo + (hb * 2 + fr - 14) * 128 + lc0; pv[0] = *(const PG8_LAS f32x4*)hp; pv[1] = *(const PG8_LAS f32x4*)(hp + 4); }
                    }
                } else { pv[0] = acc[ai][0][m - 1][0]; pv[1] = acc[ai][0][m - 1][1]; }
                const int r = u.pm * BM + ai * HALF + wr * 64 + m * 16 + fr;
                float a8[8];
#pragma unroll
                for (int n = 0; n < 2; ++n)
#pragma unroll
                    for (int e = 0; e < 4; ++e) {
                        const float cur = acc[ai][0][m][n][e], pr = pv[n][e];
                        const float p1 = dpp_shr1(cur) + dpp_shl15(pr), p2 = dpp_shr2(cur) + dpp_shl14(pr);
                        const float uc = w0[n][e] * p2 + w1[n][e] * p1 + w2[n][e] * cur;
                        a8[4 * n + e] = gelu_tanh(uc) * acc[ai][1][m][n][e];
                    }
                u32x4 w; w.x = cvt_pk_bf16(a8[0], a8[1]); w.y = cvt_pk_bf16(a8[2], a8[3]); w.z = cvt_pk_bf16(a8[4], a8[5]); w.w = cvt_pk_bf16(a8[6], a8[7]);
                *(u32x4*)(ACT + (size_t)r * 4096 + ch0) = w;
                if (sample) {
                    if (fr >= 14 && sb < 8) { float* op = outs + (size_t)(sb * 2 + fr - 14) * 4096 + ch0; *(f32x4*)op = acc[ai][0][m][0]; *(f32x4*)(op + 4) = acc[ai][0][m][1]; }
                } else if (m == 3 && blk == 3 && (u.pm & 15) == 15 && fr >= 14) {
                    float* op = outp + (size_t)((u.pm >> 4) * 2 + fr - 14) * 4096 + ch0; *(f32x4*)op = acc[ai][0][m][0]; *(f32x4*)(op + 4) = acc[ai][0][m][1];
                }
            }
        }
    }
};
struct WalkOrder {
    int G, c;
    __device__ __forceinline__ bool next(int i, Unit& u) const {
        int w = c, rem = i;
        while (w < 256) { const int len = 16;
            if (rem < len) { if (w < 256) { u.pm = (w >> 5) * 16 + rem; u.pn = w & 31; } else { u.pm = 128; u.pn = w - 256; } return true; }
            rem -= len; w += G; }
        return false;
    }
    __device__ __forceinline__ void a_ready(const Unit&) const {}
    __device__ __forceinline__ void done(const Unit&) const {}
};
template <class Epi, class Sched, bool ALIGN_EPI = false, bool SP2 = false>
__device__ __forceinline__ void gemm_phase(PG8_LAS unsigned char* lds, const Gemm g, const Sched& S, const Epi& E) {
    int tid_raw = threadIdx.x; asm volatile("" : "+v"(tid_raw));
    const int tid = tid_raw, wid = __builtin_amdgcn_readfirstlane(tid >> 6), lane = tid & 63, wr = wid >> 2, wc = wid & 3, fr = lane & 15, fq = lane >> 4;
    const int K = g.K, nt = K / BK;
    unsigned voffA[2], voffB[2];
#pragma unroll
    for (int i = 0; i < 2; ++i) { int R, C; stage_rc(tid * 16 + i * 8192, R, C); const int Rb = Epi::PERM ? ((R & ~31) + perm32(R & 31)) : R;
        voffA[i] = (unsigned)(R * K + C) * 2u; voffB[i] = (unsigned)(Rb * K + C) * 2u; }
    const size_t kstep = (size_t)(BK * 2);
    const size_t hstep = (size_t)HALF * K * 2;
    const size_t tstep = 2 * hstep;
    const unsigned ldsw = (unsigned)wid * 1024u;
    const int aoff = lds_byte(wr * 64 + fr, fq * 8), boff = lds_byte(wc * 32 + fr, fq * 8);
#define PG8_SA(b, h) (((b) * 2 + (h)) * HTB)
#define PG8_SB(b, h) ((4 + (b) * 2 + (h)) * HTB)
#define PG8_STAGE(bufoff, gbase, voff) do { _Pragma("unroll") for (int _i = 0; _i < 2; ++_i) \
        __builtin_amdgcn_global_load_lds((const unsigned*)((const char*)(gbase) + (voff)[_i]), (PG8_LAS unsigned*)(lds + (bufoff) + ldsw + _i * 8192), 16, 0, 0); } while (0)
#define PG8_LDA(dst, b, h) do { _Pragma("unroll") for (int m = 0; m < 4; ++m) _Pragma("unroll") for (int k = 0; k < 2; ++k) dst[m][k] = *(const PG8_LAS bf16x8*)(lds + PG8_SA(b, h) + aoff + m * 2048 + k * 1024); } while (0)
#define PG8_LDB(dst, b, h) do { _Pragma("unroll") for (int n = 0; n < 2; ++n) _Pragma("unroll") for (int k = 0; k < 2; ++k) dst[n][k] = *(const PG8_LAS bf16x8*)(lds + PG8_SB(b, h) + boff + n * 2048 + k * 1024); } while (0)
#define PG8_MMA(ai, bj, At, Bt) do { __builtin_amdgcn_s_setprio(1); _Pragma("unroll") for (int m = 0; m < 4; ++m) _Pragma("unroll") for (int n = 0; n < 2; ++n) _Pragma("unroll") for (int k = 0; k < 2; ++k) \
        acc[ai][bj][m][n] = __builtin_amdgcn_mfma_f32_16x16x32_bf16(Bt[n][k], At[m][k], acc[ai][bj][m][n], 0, 0, 0); __builtin_amdgcn_s_setprio(0); } while (0)
#define PG8_WAIT_V(n) asm volatile("s_waitcnt vmcnt(" #n ")" ::: "memory")
#define PG8_WAIT_L(n) asm volatile("s_waitcnt lgkmcnt(" #n ")" ::: "memory")
#define PG8_BAR __builtin_amdgcn_s_barrier()
#define PG8_SCHED __builtin_amdgcn_sched_barrier(0)
    Unit cur, nxt; int ui = 0;
    if (!S.next(0, cur)) return;
    f32x4 acc[2][2][4][2];
#pragma unroll
    for (int a = 0; a < 2; ++a)
#pragma unroll
        for (int b = 0; b < 2; ++b)
#pragma unroll
            for (int m = 0; m < 4; ++m)
#pragma unroll
                for (int n = 0; n < 2; ++n) acc[a][b][m][n] = (f32x4){0.f, 0.f, 0.f, 0.f};
    bf16x8 At[4][2], B0[2][2], B1[2][2];
    const char* cA = (const char*)g.A + (size_t)cur.pm * tstep; const char* cB = (const char*)g.Bt + (size_t)cur.pn * tstep;
    S.a_ready(cur);
    if constexpr (SP2) {
        PG8_STAGE(PG8_SB(0, 0), cB, voffB); PG8_STAGE(PG8_SB(0, 1), cB + hstep, voffB); PG8_STAGE(PG8_SA(0, 0), cA, voffA); PG8_STAGE(PG8_SA(0, 1), cA + hstep, voffA);
        if (wr == 1) PG8_BAR;
        PG8_WAIT_V(2); PG8_BAR;
        PG8_STAGE(PG8_SB(1, 0), cB + kstep, voffB); PG8_STAGE(PG8_SA(1, 0), cA + kstep, voffA); PG8_STAGE(PG8_SB(1, 1), cB + hstep + kstep, voffB);
        PG8_WAIT_V(6); PG8_BAR;
    } else {
        PG8_STAGE(PG8_SB(0, 0), cB, voffB); PG8_STAGE(PG8_SA(0, 0), cA, voffA); PG8_STAGE(PG8_SB(0, 1), cB + hstep, voffB); PG8_STAGE(PG8_SA(0, 1), cA + hstep, voffA);
        if (wr == 1) PG8_BAR;
        PG8_WAIT_V(4); PG8_BAR;
        PG8_STAGE(PG8_SB(1, 0), cB + kstep, voffB); PG8_STAGE(PG8_SA(1, 0), cA + kstep, voffA); PG8_STAGE(PG8_SB(1, 1), cB + hstep + kstep, voffB);
        PG8_WAIT_V(6); PG8_BAR;
    }
    for (;;) {
        const bool has_next = S.next(ui + 1, nxt);
        const char* nA = has_next ? (const char*)g.A + (size_t)nxt.pm * tstep : cA; const char* nB = has_next ? (const char*)g.Bt + (size_t)nxt.pn * tstep : cB;
        for (int t = 0; t < nt; t += 2) {
            const bool last = (t == nt - 2);
            const char* a1 = cA + (size_t)(t + 1) * kstep;
            const char* a2 = last ? nA : cA + (size_t)(t + 2) * kstep; const char* b2 = last ? nB : cB + (size_t)(t + 2) * kstep;
            const char* a3 = a2 + kstep; const char* b3 = b2 + kstep;
            if (last && has_next) S.a_ready(nxt);
            if constexpr (SP2) {
            PG8_LDB(B0, 0, 0); PG8_LDB(B1, 0, 1); PG8_SCHED; PG8_LDA(At, 0, 0); PG8_STAGE(PG8_SA(1, 1), a1 + hstep, voffA);
            PG8_WAIT_V(8); PG8_WAIT_L(0); PG8_BAR; PG8_MMA(0, 0, At, B0); PG8_MMA(0, 1, At, B1); PG8_BAR; PG8_SCHED;
            PG8_LDA(At, 0, 1); PG8_STAGE(PG8_SB(0, 0), b2, voffB); PG8_STAGE(PG8_SB(0, 1), b2 + hstep, voffB); PG8_STAGE(PG8_SA(0, 0), a2, voffA);
            PG8_WAIT_V(8); PG8_WAIT_L(0); PG8_BAR; PG8_MMA(1, 0, At, B0); PG8_MMA(1, 1, At, B1); PG8_BAR; PG8_SCHED;
            PG8_LDB(B0, 1, 0); PG8_LDB(B1, 1, 1); PG8_SCHED; PG8_LDA(At, 1, 0); PG8_STAGE(PG8_SA(0, 1), a2 + hstep, voffA);
            PG8_WAIT_V(8); PG8_WAIT_L(0); PG8_BAR; PG8_MMA(0, 0, At, B0); PG8_MMA(0, 1, At, B1); PG8_BAR; PG8_SCHED;
            PG8_LDA(At, 1, 1); PG8_STAGE(PG8_SB(1, 0), b3, voffB); PG8_STAGE(PG8_SB(1, 1), b3 + hstep, voffB); PG8_STAGE(PG8_SA(1, 0), a3, voffA);
            PG8_WAIT_V(8); PG8_WAIT_L(0); PG8_BAR; PG8_MMA(1, 0, At, B0); PG8_MMA(1, 1, At, B1); PG8_BAR; PG8_SCHED;
            } else {
            PG8_LDB(B0, 0, 0); PG8_SCHED; PG8_LDA(At, 0, 0); PG8_STAGE(PG8_SA(1, 1), a1 + hstep, voffA);
            PG8_WAIT_L(8); PG8_BAR; PG8_WAIT_L(0); PG8_MMA(0, 0, At, B0); PG8_BAR; PG8_SCHED;
            PG8_LDB(B1, 0, 1); PG8_STAGE(PG8_SB(0, 0), b2, voffB);
            PG8_BAR; PG8_WAIT_L(0); PG8_MMA(0, 1, At, B1); PG8_BAR;
            PG8_LDA(At, 0, 1); PG8_STAGE(PG8_SA(0, 0), a2, voffA);
            PG8_BAR; PG8_WAIT_L(0); PG8_MMA(1, 0, At, B0); PG8_BAR; PG8_SCHED;
            PG8_STAGE(PG8_SB(0, 1), b2 + hstep, voffB);
            PG8_WAIT_V(6); PG8_BAR; PG8_MMA(1, 1, At, B1); PG8_BAR;
            PG8_LDB(B0, 1, 0); PG8_SCHED; PG8_LDA(At, 1, 0); PG8_STAGE(PG8_SA(0, 1), a2 + hstep, voffA);
            PG8_WAIT_L(8); PG8_BAR; PG8_WAIT_L(0); PG8_MMA(0, 0, At, B0); PG8_BAR; PG8_SCHED;
            PG8_LDB(B1, 1, 1); PG8_STAGE(PG8_SB(1, 0), b3, voffB);
            PG8_BAR; PG8_WAIT_L(0); PG8_MMA(0, 1, At, B1); PG8_BAR;
            PG8_LDA(At, 1, 1); PG8_STAGE(PG8_SA(1, 0), a3, voffA);
            PG8_BAR; PG8_WAIT_L(0); PG8_MMA(1, 0, At, B0); PG8_BAR; PG8_SCHED;
            PG8_STAGE(PG8_SB(1, 1), b3 + hstep, voffB);
            PG8_WAIT_V(6); PG8_BAR; PG8_MMA(1, 1, At, B1); PG8_BAR;
            }
        }
        if constexpr (ALIGN_EPI) { if (wr == 0) PG8_BAR; }
        if constexpr (!Epi::AFTER_DRAIN) { E(acc, cur, wr, wc, fr, fq); S.done(cur); }
        if (!has_next) break;
#pragma unroll
        for (int a = 0; a < 2; ++a)
#pragma unroll
            for (int b = 0; b < 2; ++b)
#pragma unroll
                for (int m = 0; m < 4; ++m)
#pragma unroll
                    for (int n = 0; n < 2; ++n) acc[a][b][m][n] = (f32x4){0.f, 0.f, 0.f, 0.f};
        cur = nxt; cA = nA; cB = nB; ++ui;
        if constexpr (ALIGN_EPI) { if (wr == 1) PG8_BAR; }
    }
    PG8_WAIT_V(0);
    if constexpr (!ALIGN_EPI) { if (wr == 0) PG8_BAR; }
    PG8_BAR;
    if constexpr (Epi::AFTER_DRAIN) { E.fused(acc, cur, wr, wc, fr, fq, lds, wid, lane); S.done(cur); }
#undef PG8_SA
#undef PG8_SB
#undef PG8_STAGE
#undef PG8_LDA
#undef PG8_LDB
#undef PG8_MMA
#undef PG8_WAIT_V
#undef PG8_WAIT_L
#undef PG8_BAR
#undef PG8_SCHED
}
}

using pg8::bf16_t; using pg8::bf16x8; using pg8::f32x4; using pg8::u32x4;
#define LAS __attribute__((address_space(3)))
typedef unsigned u32x2 __attribute__((ext_vector_type(2)));
constexpr int DM = 1024, NIN = 3584, DFF = 4096;
constexpr int TOK_P = 32768, TOK = 32896, TOKPAD = 33024;
constexpr float EPS = 1e-6f;
constexpr size_t WS_WIN = 16384;
constexpr size_t WS_WOUT = WS_WIN + (size_t)NIN * DM * 2;
constexpr size_t WS_WFF1 = WS_WOUT + (size_t)DM * DM * 2;
constexpr size_t WS_WDN = WS_WFF1 + (size_t)2 * DFF * DM * 2;
constexpr size_t WS_COS = WS_WDN + (size_t)DM * DFF * 2;
constexpr size_t WS_SIN = WS_COS + (size_t)4112 * 64 * 4;
constexpr size_t WS_SSQ1 = WS_SIN + (size_t)4112 * 64 * 4;
constexpr size_t WS_SSQ2 = WS_SSQ1 + (size_t)TOKPAD * 16 * 4;
constexpr size_t WS_UG = WS_SSQ2 + (size_t)TOKPAD * 16 * 4;
constexpr size_t WS_PS = WS_UG + (size_t)256 * 65536;
constexpr size_t WS_YS = WS_PS + (size_t)128 * NIN * 4;
constexpr size_t WS_FS = WS_YS + (size_t)4 * 128 * DM * 4;
constexpr size_t WS_RA = WS_FS + (size_t)4 * 128 * DM * 4;
constexpr size_t WS_RB = WS_RA + (size_t)TOKPAD * DM * 2;
constexpr size_t WS_Y = WS_RB + (size_t)TOKPAD * DFF * 2;
constexpr size_t WS_END = WS_Y + (size_t)TOK_P * DM * 2;
constexpr size_t O_SRP = (size_t)TOK * DM, O_CCP = O_SRP + 524288, O_CFP = O_CCP + 8192, O_SRS = O_CFP + 65536, O_CCS = O_SRS + 524288, O_CFS = O_CCS + 8192;
constexpr int LDS_HALO = 131072, LDS_BARW = 131072 + 8192, LDS_BYTES = LDS_BARW + 16;

struct Params { const float* in[17]; float* out; unsigned char* ws; };

__device__ __forceinline__ float dppf(float v, const int ctrl_sel) {
    const int iv = __builtin_bit_cast(int, v); int r;
    switch (ctrl_sel) { case 1: r = __builtin_amdgcn_update_dpp(0, iv, 0x111, 0xf, 0xf, true); break; case 2: r = __builtin_amdgcn_update_dpp(0, iv, 0x112, 0xf, 0xf, true); break;
        case 4: r = __builtin_amdgcn_update_dpp(0, iv, 0x114, 0xf, 0xf, true); break; case 8: r = __builtin_amdgcn_update_dpp(0, iv, 0x118, 0xf, 0xf, true); break;
        case 15: r = __builtin_amdgcn_update_dpp(0, iv, 0x142, 0xa, 0xf, false); break; default: r = __builtin_amdgcn_update_dpp(0, iv, 0x143, 0xc, 0xf, false); break; }
    return __builtin_bit_cast(float, r);
}
__device__ __forceinline__ float wave_sum(float v) {
    v += dppf(v, 1); v += dppf(v, 2); v += dppf(v, 4); v += dppf(v, 8); v += dppf(v, 15); v += dppf(v, 31);
    return __builtin_bit_cast(float, __builtin_amdgcn_readlane(__builtin_bit_cast(int, v), 63));
}
__device__ __forceinline__ float bf2f(unsigned short b) { return __uint_as_float(((unsigned)b) << 16); }
__device__ __forceinline__ unsigned pk2(float a, float b) { return pg8::cvt_pk_bf16(a, b); }
__device__ __forceinline__ unsigned pk2s(float a, float b) { unsigned r; asm("v_cvt_pk_bf16_f32 %0, %1, %2" : "=v"(r) : "v"(a), "v"(b)); return r; }
__device__ __forceinline__ float silu_f(float g) { return g * __builtin_amdgcn_rcpf(1.0f + __builtin_amdgcn_exp2f(-1.4426950408889634f * g)); }
__device__ __forceinline__ int dmap(int P) { return ((P >> 2) & 1) * 64 + (P >> 3) * 4 + (P & 3); }
__device__ __forceinline__ int pmap(int d) { return ((d >> 4) & 3) * 32 + ((d >> 2) & 3) * 8 + ((d >> 6) & 1) * 4 + (d & 3); }

constexpr int RB = 6;
__device__ __forceinline__ f32x4 unpack_bf4(const u32x2 w) { f32x4 v; v[0] = __uint_as_float(w.x << 16); v[1] = __uint_as_float(w.x & 0xffff0000u); v[2] = __uint_as_float(w.y << 16); v[3] = __uint_as_float(w.y & 0xffff0000u); return v; }
__device__ __forceinline__ float sumsq4(const f32x4 a) { return (a[0] * a[0] + a[1] * a[1]) + (a[2] * a[2] + a[3] * a[3]); }
template <int MODE> __device__ __forceinline__ int rowmap(int c) {
    if (MODE == 0) { if (c < 1024) return (c & ~127) + pmap(c & 127); return c; }
    if (MODE == 1) return c;
    if (MODE == 2) return ((c >> 7) << 8) + (c & 127);
    return ((c >> 7) << 8) + 128 + (c & 127);
}
template <int MODE>
__device__ __forceinline__ void transpose_item(const float* W, int K, int N, bf16_t* WT, LAS float* scr, int item, int lane) {
    const int nblk = N / 32, kb = item / nblk, nb = item % nblk, k0 = 64 * kb, n0 = 32 * nb;
#pragma unroll
    for (int i = 0; i < 32; ++i) { const int kk = 2 * i + (lane >> 5); scr[kk * 33 + (lane & 31)] = W[(size_t)(k0 + kk) * N + n0 + (lane & 31)]; }
    asm volatile("s_waitcnt lgkmcnt(0)" ::: "memory");
    const int c = lane & 7;
#pragma unroll
    for (int j = 0; j < 4; ++j) { const int n = (lane >> 3) + 8 * j; const LAS float* s = scr + (8 * c) * 33 + n;
        u32x4 o; o.x = pk2(s[0 * 33], s[1 * 33]); o.y = pk2(s[2 * 33], s[3 * 33]); o.z = pk2(s[4 * 33], s[5 * 33]); o.w = pk2(s[6 * 33], s[7 * 33]);
        *(u32x4*)(WT + (size_t)rowmap<MODE>(n0 + n) * K + k0 + 8 * c) = o; }
    asm volatile("s_waitcnt lgkmcnt(0)" ::: "memory");
}
__device__ __forceinline__ void phase0(const Params& p, LAS unsigned char* lds, int tid, int wid, int lane) {
    LAS float* scr = (LAS float*)(lds + wid * 8448);
    const int gw = blockIdx.x * 8 + wid, NGW = gridDim.x * 8;
    bf16_t* win = (bf16_t*)(p.ws + WS_WIN); bf16_t* wout = (bf16_t*)(p.ws + WS_WOUT); bf16_t* wff1 = (bf16_t*)(p.ws + WS_WFF1); bf16_t* wdn = (bf16_t*)(p.ws + WS_WDN);
    constexpr int I_IN = 16 * 112, I_OUT = 16 * 32, I_UP = 16 * 128, I_DN = 64 * 32, NITEMS = I_IN + I_OUT + 2 * I_UP + I_DN;
    for (int it = gw; it < NITEMS; it += NGW) {
        int r = it;
        if (r < I_IN) { transpose_item<0>(p.in[5], DM, NIN, win, scr, r, lane); continue; } r -= I_IN;
        if (r < I_OUT) { transpose_item<1>(p.in[6], DM, DM, wout, scr, r, lane); continue; } r -= I_OUT;
        if (r < I_UP) { transpose_item<2>(p.in[13], DM, DFF, wff1, scr, r, lane); continue; } r -= I_UP;
        if (r < I_UP) { transpose_item<3>(p.in[14], DM, DFF, wff1, scr, r, lane); continue; } r -= I_UP;
        transpose_item<1>(p.in[16], DFF, DM, wdn, scr, r, lane);
    }
    float* cosT = (float*)(p.ws + WS_COS); float* sinT = (float*)(p.ws + WS_SIN);
    for (int idx = blockIdx.x * 512 + tid; idx < 4112 * 64; idx += gridDim.x * 512) {
        const int pos = idx >> 6, f = idx & 63;
        const float inv = exp2f(-(float)(2 * f) * (1.0f / 128.0f) * 13.287712379549449f);
        const float ang = (float)pos * inv;
        const double rev = (double)ang * 0.15915494309189535;
        const float fr = (float)(rev - floor(rev));
        cosT[idx] = __builtin_amdgcn_cosf(fr); sinT[idx] = __builtin_amdgcn_sinf(fr);
    }
    bf16_t* H = (bf16_t*)(p.ws + WS_RA);
    const float* wpre = p.in[9];
    f32x4 wpr[4];
#pragma unroll
    for (int j = 0; j < 4; ++j) wpr[j] = *((const f32x4*)wpre + lane + 64 * j);
#pragma unroll 1
    for (int base = gw; base < TOK; base += RB * NGW) {
        f32x4 v[RB][4]; float s[RB];
#pragma unroll
        for (int k = 0; k < RB; ++k) { const int rr = min(base + k * NGW, TOK - 1);
            const float* xrow = rr < TOK_P ? p.in[0] + (size_t)rr * DM : p.in[1] + (size_t)(rr - TOK_P) * DM; s[k] = 0.f;
#pragma unroll
            for (int j = 0; j < 4; ++j) { v[k][j] = __builtin_nontemporal_load((const f32x4*)xrow + lane + 64 * j); s[k] += sumsq4(v[k][j]); } }
#pragma unroll
        for (int k = 0; k < RB; ++k) { const int r = base + k * NGW; const float rstd = rsqrtf(wave_sum(s[k]) * (1.0f / DM) + EPS);
            if (r < TOK) {
#pragma unroll
                for (int j = 0; j < 4; ++j) { const f32x4 y = (v[k][j] * rstd) * wpr[j];
                    __builtin_nontemporal_store((u32x2){pk2(y[0], y[1]), pk2(y[2], y[3])}, (u32x2*)(H + (size_t)r * DM) + lane + 64 * j); } } }
    }
}

constexpr int QI_OFF = 0, KI_OFF = 17408, KT_OFF = 34816, VT_OFF = 53248, SI_OFF = 71680, ST_OFF = 80896, GI_OFF = 115712;
#define MFMA16(a, b, c) __builtin_amdgcn_mfma_f32_16x16x32_bf16((a), (b), (c), 0, 0, 0)
#define RET_ISSUE(S, nn) do { _Pragma("unroll") for (int i_ = 0; i_ < 2; ++i_) { \
        const bf16_t* rowp_ = P + (tok0 + (size_t)(nn) * 64 + 2 * (tid >> 4) + i_) * NIN + 128 * h + (tid & 15) * 8; \
        if (FULL) { rq[S][i_] = *(const u32x4*)rowp_; rg[S][i_] = *(const u32x4*)(rowp_ + 1536); } rk[S][i_] = *(const u32x4*)(rowp_ + 512); rv[S][i_] = *(const u32x4*)(rowp_ + 1024); } } while (0)
#define RET_STAGE_A(S) do { const int j_ = 2 * (tid >> 4), ch_ = tid & 15; \
        if (FULL) { _Pragma("unroll") for (int i_ = 0; i_ < 2; ++i_) { *(LAS u32x4*)(lds + QI_OFF + (j_ + i_) * 272 + ch_ * 16) = rq[S][i_]; *(LAS u32x4*)(lds + KI_OFF + (j_ + i_) * 272 + ch_ * 16) = rk[S][i_]; *(LAS u32x4*)(lds + GI_OFF + (j_ + i_) * 272 + ch_ * 16) = rg[S][i_]; } } \
        const float te0_ = __builtin_amdgcn_exp2f(l2g * (float)(63 - j_)), te1_ = __builtin_amdgcn_exp2f(l2g * (float)(62 - j_)); \
        const unsigned ka_[4] = {rk[S][0].x, rk[S][0].y, rk[S][0].z, rk[S][0].w}, kb_[4] = {rk[S][1].x, rk[S][1].y, rk[S][1].z, rk[S][1].w}; \
        const unsigned va_[4] = {rv[S][0].x, rv[S][0].y, rv[S][0].z, rv[S][0].w}, vb_[4] = {rv[S][1].x, rv[S][1].y, rv[S][1].z, rv[S][1].w}; \
        const int cofs_ = 16 * ((j_ >> 3) ^ (ch_ & 7)) + 2 * (j_ & 7); \
        _Pragma("unroll") for (int e2 = 0; e2 < 4; ++e2) { const int row_ = 8 * ch_ + 2 * e2; \
            *(LAS unsigned*)(lds + KT_OFF + row_ * 144 + cofs_) = pk2(__uint_as_float(ka_[e2] << 16) * te0_, __uint_as_float(kb_[e2] << 16) * te1_); \
            *(LAS unsigned*)(lds + KT_OFF + (row_ + 1) * 144 + cofs_) = pk2(__uint_as_float(ka_[e2] & 0xffff0000u) * te0_, __uint_as_float(kb_[e2] & 0xffff0000u) * te1_); \
            *(LAS unsigned*)(lds + VT_OFF + row_ * 144 + cofs_) = (va_[e2] & 0xffffu) | (vb_[e2] << 16); \
            *(LAS unsigned*)(lds + VT_OFF + (row_ + 1) * 144 + cofs_) = (va_[e2] >> 16) | (vb_[e2] & 0xffff0000u); } } while (0)
#define WG_BAR() do { asm volatile("s_waitcnt lgkmcnt(0)" ::: "memory"); __builtin_amdgcn_s_barrier(); asm volatile("" ::: "memory"); } while (0)
template <bool FULL>
__device__ __forceinline__ void ret_unit(const Params& p, LAS unsigned char* lds, int unit, int tid, int wid, int lane) {
    asm volatile("" : "+v"(tid), "+v"(lane));
    const int G = unit & 7, h = (unit >> 3) & 3, b = unit >> 5;
    const bf16_t* P = (const bf16_t*)(p.ws + WS_RB);
    bf16_t* MIX = (bf16_t*)(p.ws + WS_RA);
    float* UG = (float*)(p.ws + WS_UG);
    const size_t tok0 = (size_t)b * 4096 + (size_t)G * 512;
    const float l2g = log2f(1.0f - exp2f(-5.0f - (float)h));
    const float g64 = __builtin_amdgcn_exp2f(l2g * 64.0f);
    const bool is_state = wid >= 4; const int w4 = wid & 3;
    const int l15 = lane & 15, l4 = lane >> 4;
    const int vtL = l4 ^ (l15 >> 3);
    const int vtb0 = VT_OFF + l15 * 144 + 16 * vtL, vtb1 = VT_OFF + l15 * 144 + 16 * (vtL ^ 2);
#define VT_ADDR(nt, ks) ((((nt) & 1) ? vtb1 : vtb0) + (nt) * 2304 + 16 * (((4 * (ks)) ^ (2 * ((nt) & 3))) & 4))
    constexpr int PD = FULL ? 1 : 4;
    u32x4 rq[PD][2], rk[PD][2], rv[PD][2], rg[PD][2];
    if (is_state) {
        f32x4 st[2][8];
#pragma unroll
        for (int mt = 0; mt < 2; ++mt)
#pragma unroll
            for (int nt = 0; nt < 8; ++nt) st[mt][nt] = (f32x4){0.f, 0.f, 0.f, 0.f};
        if (FULL) {
#pragma unroll 1
            for (int Gp = 0; Gp < G; Gp += 2) {
                const float wa = __builtin_amdgcn_exp2f(l2g * 512.0f * (float)(G - 1 - Gp));
                const bool two = Gp + 1 < G;
                const float wb = two ? __builtin_amdgcn_exp2f(l2g * 512.0f * (float)(G - 2 - Gp)) : 0.f;
                const u32x2* sa = (const u32x2*)UG + ((size_t)((b * 4 + h) * 8 + Gp) * 4 + w4) * 1024 + lane;
                const u32x2* sb = two ? sa + 4 * 1024 : sa;
#pragma unroll
                for (int mt = 0; mt < 2; ++mt)
#pragma unroll
                    for (int nt = 0; nt < 8; ++nt) st[mt][nt] += unpack_bf4(sa[(mt * 8 + nt) * 64]) * wa + unpack_bf4(sb[(mt * 8 + nt) * 64]) * wb;
            }
        }
#pragma unroll
        for (int s = 0; s < PD; ++s) RET_ISSUE(s, s);
#pragma unroll 1
        for (int n0 = 0; n0 < 8; n0 += PD) {
#pragma unroll
          for (int s = 0; s < PD; ++s) { const int n = n0 + s;
            RET_STAGE_A(s);
            if (n + PD < 8) RET_ISSUE(s, n + PD);
            if (FULL) {
#pragma unroll
                for (int mt = 0; mt < 2; ++mt)
#pragma unroll
                    for (int nt = 0; nt < 8; ++nt) { const int e = 16 * nt + l15, dk0 = 32 * w4 + 16 * mt + 4 * l4;
                        *(LAS u32x2*)(lds + ST_OFF + e * 272 + dk0 * 2) = (u32x2){pk2(st[mt][nt][0], st[mt][nt][1]), pk2(st[mt][nt][2], st[mt][nt][3])}; }
            }
            WG_BAR();
            if (FULL) {
                bf16x8 ak[4];
#pragma unroll
                for (int ks = 0; ks < 4; ++ks) ak[ks] = *(const LAS bf16x8*)(lds + KI_OFF + (16 * w4 + l15) * 272 + (32 * ks + 8 * l4) * 2);
#pragma unroll
                for (int it = 0; it < 4; ++it) {
                    bf16x8 bq[4];
#pragma unroll
                    for (int ks = 0; ks < 4; ++ks) bq[ks] = *(const LAS bf16x8*)(lds + QI_OFF + (16 * it + l15) * 272 + (32 * ks + 8 * l4) * 2);
                    f32x4 sa = (f32x4){0.f, 0.f, 0.f, 0.f};
#pragma unroll
                    for (int ks = 0; ks < 4; ++ks) sa = MFMA16(ak[ks], bq[ks], sa);
                    const int i = 16 * it + l15, j0 = 16 * w4 + 4 * l4;
#pragma unroll
                    for (int r = 0; r < 4; ++r) { const int d = i - (j0 + r); sa[r] *= __builtin_amdgcn_exp2f(l2g * (float)(d < 0 ? -d : d)); }
                    *(LAS u32x2*)(lds + SI_OFF + i * 144 + j0 * 2) = (u32x2){pk2(sa[0], sa[1]), pk2(sa[2], sa[3])};
                }
            }
            WG_BAR();
#pragma unroll
            for (int mt = 0; mt < 2; ++mt)
#pragma unroll
                for (int nt = 0; nt < 8; ++nt) st[mt][nt] = st[mt][nt] * g64;
#pragma unroll
            for (int ks = 0; ks < 2; ++ks) {
                bf16x8 akt[2];
#pragma unroll
                for (int mt = 0; mt < 2; ++mt) { const int row = 32 * w4 + 16 * mt + l15; akt[mt] = *(const LAS bf16x8*)(lds + KT_OFF + row * 144 + 16 * ((4 * ks + l4) ^ ((row >> 3) & 7))); }
#pragma unroll
                for (int nh = 0; nh < 2; ++nh) {
                    bf16x8 bv[4];
#pragma unroll
                    for (int nt = 0; nt < 4; ++nt) bv[nt] = *(const LAS bf16x8*)(lds + VT_ADDR(4 * nh + nt, ks));
#pragma unroll
                    for (int nt = 0; nt < 4; ++nt)
#pragma unroll
                        for (int mt = 0; mt < 2; ++mt) st[mt][4 * nh + nt] = MFMA16(akt[mt], bv[nt], st[mt][4 * nh + nt]);
                }
            }
            WG_BAR();
          }
        }
        if (!FULL) {
            u32x2* dst = (u32x2*)UG + ((size_t)unit * 4 + w4) * 1024 + lane;
#pragma unroll
            for (int mt = 0; mt < 2; ++mt)
#pragma unroll
                for (int nt = 0; nt < 8; ++nt) dst[(mt * 8 + nt) * 64] = (u32x2){pk2(st[mt][nt][0], st[mt][nt][1]), pk2(st[mt][nt][2], st[mt][nt][3])};
        } else if (G == 7) {
            float* o = p.out + O_SRP + (size_t)(b * 4 + h) * 16384 + (64 * (l4 & 1) + 16 * w4 + 4 * (l4 >> 1)) * 128 + l15;
#pragma unroll
            for (int mt = 0; mt < 2; ++mt)
#pragma unroll
                for (int nt = 0; nt < 8; ++nt)
#pragma unroll
                    for (int r = 0; r < 4; ++r) o[(8 * mt + r) * 128 + 16 * nt] = st[mt][nt][r];
        }
    } else {
        float rwv[8];
#pragma unroll
        for (int nt = 0; nt < 8; ++nt) rwv[nt] = p.in[8][128 * h + 16 * nt + l15];
#pragma unroll
        for (int s = 0; s < PD; ++s) RET_ISSUE(s, s);
#pragma unroll 1
        for (int n0 = 0; n0 < 8; n0 += PD) {
#pragma unroll
          for (int s = 0; s < PD; ++s) { const int n = n0 + s;
            RET_STAGE_A(s);
            if (n + PD < 8) RET_ISSUE(s, n + PD);
            WG_BAR();
            f32x4 acc[8];
            if (FULL) {
                f32x4 fsv;
#pragma unroll
                for (int r = 0; r < 4; ++r) fsv[r] = __builtin_amdgcn_exp2f(l2g * (float)(16 * w4 + 4 * l4 + r + 1));
#pragma unroll
                for (int nt = 0; nt < 8; ++nt) acc[nt] = (f32x4){0.f, 0.f, 0.f, 0.f};
                bf16x8 aq[4];
#pragma unroll
                for (int ks = 0; ks < 4; ++ks) aq[ks] = *(const LAS bf16x8*)(lds + QI_OFF + (16 * w4 + l15) * 272 + (32 * ks + 8 * l4) * 2);
#pragma unroll
                for (int ks = 0; ks < 4; ++ks)
#pragma unroll
                    for (int nh = 0; nh < 2; ++nh) {
                        bf16x8 bs[4];
#pragma unroll
                        for (int nt = 0; nt < 4; ++nt) bs[nt] = *(const LAS bf16x8*)(lds + ST_OFF + (16 * (4 * nh + nt) + l15) * 272 + (32 * ks + 8 * l4) * 2);
#pragma unroll
                        for (int nt = 0; nt < 4; ++nt) acc[4 * nh + nt] = MFMA16(aq[ks], bs[nt], acc[4 * nh + nt]);
                    }
#pragma unroll
                for (int nt = 0; nt < 8; ++nt) acc[nt] = acc[nt] * fsv;
            }
            WG_BAR();
            if (FULL) {
                bf16x8 as_[2];
#pragma unroll
                for (int ks = 0; ks < 2; ++ks) as_[ks] = *(const LAS bf16x8*)(lds + SI_OFF + (16 * w4 + l15) * 144 + 16 * (4 * ks + l4));
#pragma unroll
                for (int ks = 0; ks < 2; ++ks)
#pragma unroll
                    for (int nh = 0; nh < 2; ++nh) {
                        bf16x8 bv[4];
#pragma unroll
                        for (int nt = 0; nt < 4; ++nt) bv[nt] = *(const LAS bf16x8*)(lds + VT_ADDR(4 * nh + nt, ks));
#pragma unroll
                        for (int nt = 0; nt < 4; ++nt) acc[4 * nh + nt] = MFMA16(as_[ks], bv[nt], acc[4 * nh + nt]);
                    }
                unsigned short gq[4][8];
#pragma unroll
                for (int r = 0; r < 4; ++r)
#pragma unroll
                    for (int nt = 0; nt < 8; ++nt) gq[r][nt] = *(const LAS unsigned short*)(lds + GI_OFF + (16 * w4 + 4 * l4 + r) * 272 + (16 * nt + l15) * 2);
                float rstd[4];
#pragma unroll
                for (int r = 0; r < 4; ++r) { float ss = 0.f;
#pragma unroll
                    for (int nt = 0; nt < 8; ++nt) ss += acc[nt][r] * acc[nt][r];
                    ss += dppf(ss, 1); ss += dppf(ss, 2); ss += dppf(ss, 4); ss += dppf(ss, 8);
                    ss = __shfl(ss, (lane & 48) | 15);
                    rstd[r] = rsqrtf(ss * (1.0f / 128.0f) + EPS); }
#pragma unroll
                for (int r = 0; r < 4; ++r)
#pragma unroll
                    for (int nt = 0; nt < 8; ++nt)
                        *(LAS unsigned short*)(lds + QI_OFF + (16 * w4 + 4 * l4 + r) * 272 + (16 * nt + l15) * 2) = (unsigned short)(pk2s(acc[nt][r] * rstd[r] * rwv[nt] * silu_f(bf2f(gq[r][nt])), 0.f) & 0xffffu);
#pragma unroll
                for (int q = 0; q < 4; ++q) { const int cidx = lane + 64 * q, row = 16 * w4 + (cidx >> 4), ch = cidx & 15;
                    const u32x4 v = *(const LAS u32x4*)(lds + QI_OFF + row * 272 + ch * 16);
                    *(u32x4*)(MIX + (tok0 + (size_t)n * 64 + row) * DM + 128 * h + ch * 8) = v; }
            }
            WG_BAR();
          }
        }
    }
#ifndef CONVREP
#define CONVREP 1
#endif
    if (FULL) for (int crep_ = 0; crep_ < CONVREP; ++crep_) {
        const int c0 = 128 * h + 8 * (tid & 15), run = tid >> 4, t0 = G * 512 + run * 16;
        const float* cwp = p.in[7];
        float w0[8], w1[8], w2[8], p1[8], p2[8];
#pragma unroll
        for (int e = 0; e < 8; ++e) { w0[e] = cwp[c0 + e]; w1[e] = cwp[512 + c0 + e]; w2[e] = cwp[1024 + c0 + e]; p1[e] = 0.f; p2[e] = 0.f; }
        if (t0 > 0) {
            const bf16_t* r2 = P + ((size_t)b * 4096 + t0 - 2) * NIN; const bf16_t* r1 = r2 + NIN;
            const u32x4 c2 = *(const u32x4*)(r2 + 2560 + c0), h2 = *(const u32x4*)(r2 + 3072 + c0), c1 = *(const u32x4*)(r1 + 2560 + c0), h1 = *(const u32x4*)(r1 + 3072 + c0);
            const unsigned c2w[4] = {c2.x, c2.y, c2.z, c2.w}, h2w[4] = {h2.x, h2.y, h2.z, h2.w}, c1w[4] = {c1.x, c1.y, c1.z, c1.w}, h1w[4] = {h1.x, h1.y, h1.z, h1.w};
#pragma unroll
            for (int e = 0; e < 4; ++e) {
                p2[2 * e] = __uint_as_float(c2w[e] << 16) * __uint_as_float(h2w[e] << 16); p2[2 * e + 1] = __uint_as_float(c2w[e] & 0xffff0000u) * __uint_as_float(h2w[e] & 0xffff0000u);
                p1[2 * e] = __uint_as_float(c1w[e] << 16) * __uint_as_float(h1w[e] << 16); p1[2 * e + 1] = __uint_as_float(c1w[e] & 0xffff0000u) * __uint_as_float(h1w[e] & 0xffff0000u); }
        }
#pragma unroll 8
        for (int t = 0; t < 16; ++t) {
            const size_t row = (size_t)b * 4096 + t0 + t;
            const bf16_t* rp = P + row * NIN;
            const u32x4 bb = *(const u32x4*)(rp + 2048 + c0), cc = *(const u32x4*)(rp + 2560 + c0), hh = *(const u32x4*)(rp + 3072 + c0);
            const unsigned bw[4] = {bb.x, bb.y, bb.z, bb.w}, cw4[4] = {cc.x, cc.y, cc.z, cc.w}, hw[4] = {hh.x, hh.y, hh.z, hh.w};
            float y[8];
#pragma unroll
            for (int e = 0; e < 4; ++e) {
                const float ca = __uint_as_float(cw4[e] << 16) * __uint_as_float(hw[e] << 16), cb = __uint_as_float(cw4[e] & 0xffff0000u) * __uint_as_float(hw[e] & 0xffff0000u);
                y[2 * e] = __uint_as_float(bw[e] << 16) * (w0[2 * e] * p2[2 * e] + w1[2 * e] * p1[2 * e] + w2[2 * e] * ca);
                y[2 * e + 1] = __uint_as_float(bw[e] & 0xffff0000u) * (w0[2 * e + 1] * p2[2 * e + 1] + w1[2 * e + 1] * p1[2 * e + 1] + w2[2 * e + 1] * cb);
                p2[2 * e] = p1[2 * e]; p2[2 * e + 1] = p1[2 * e + 1]; p1[2 * e] = ca; p1[2 * e + 1] = cb;
            }
            *(u32x4*)(MIX + row * DM + 512 + c0) = (u32x4){pk2(y[0], y[1]), pk2(y[2], y[3]), pk2(y[4], y[5]), pk2(y[6], y[7])};
        }
        if (G == 7 && run == 31) {
            float* o = p.out + O_CCP + (size_t)b * 1024 + c0;
#pragma unroll
            for (int e = 0; e < 8; ++e) { o[e] = p2[e]; o[512 + e] = p1[e]; }
        }
    }
#undef VT_ADDR
}

__device__ __forceinline__ float ch_at(const float* PS, const float* cache, int b, int t, int ch) {
    if (t < 0) return cache[(b * 2 + (t + 2)) * 512 + ch];
    const float* rp = PS + (size_t)(16 * b + t) * NIN;
    return rp[2560 + ch] * rp[3072 + ch];
}
__device__ __forceinline__ void sample_unit(const Params& p, LAS unsigned char* lds, int sup, int tid, int wid, int lane) {
    const int su = sup >> 2, part = sup & 3;
    const int b = su >> 2, h = su & 3, ts0 = TOK_P + 16 * b;
    const float* PS = (const float*)(p.ws + WS_PS);
    bf16_t* MIX = (bf16_t*)(p.ws + WS_RA);
    LAS float* qs = (LAS float*)lds; LAS float* ks = qs + 2048; LAS float* vs = qs + 4096; LAS float* Ssm = qs + 6144; LAS float* osm = qs + 6400;
    const float l2g = log2f(1.0f - exp2f(-5.0f - (float)h));
    const float* cosT = (const float*)(p.ws + WS_COS); const float* sinT = (const float*)(p.ws + WS_SIN);
    for (int idx = tid; idx < 2048; idx += 512) { const int i = idx >> 7, c = idx & 127, d = dmap(c);
        const float* rp = PS + (size_t)(16 * b + i) * NIN + 128 * h;
        const float cs = cosT[(4096 + i) * 64 + (d & 63)], sn = sinT[(4096 + i) * 64 + (d & 63)];
        const float xq = rp[c], xqp = rp[c ^ 4], xk = rp[512 + c], xkp = rp[512 + (c ^ 4)];
        qs[i * 128 + d] = d < 64 ? xq * cs - xqp * sn : xq * cs + xqp * sn;
        ks[i * 128 + d] = (d < 64 ? xk * cs - xkp * sn : xk * cs + xkp * sn) * 0.08838834764831845f;
        vs[i * 128 + c] = rp[1024 + c]; }
    const int e = tid & 127, sub = tid >> 7, irow = 4 * part + sub;
    LAS float* s0 = qs + 8704;
    { const float* s0g = p.in[2] + (size_t)su * 16384; f32x4 t8[8];
#pragma unroll
      for (int q = 0; q < 8; ++q) t8[q] = *((const f32x4*)s0g + tid + 512 * q);
#pragma unroll
      for (int q = 0; q < 8; ++q) *((LAS f32x4*)s0 + tid + 512 * q) = t8[q]; }
    __syncthreads();
    if (tid < 64) { const int i = 4 * part + (tid >> 4), j = tid & 15; float s = 0.f;
        for (int d = 0; d < 128; ++d) s += qs[i * 128 + d] * ks[j * 128 + d];
        const int dd = i - j; Ssm[i * 16 + j] = s * __builtin_amdgcn_exp2f(l2g * (float)(dd < 0 ? -dd : dd)); }
    float cr = 0.f;
#pragma unroll 8
    for (int d = 0; d < 128; ++d) cr += qs[irow * 128 + d] * s0[d * 128 + e];
    __syncthreads();
    { float o = 0.f;
      for (int j = 0; j < 16; ++j) o += Ssm[irow * 16 + j] * vs[j * 128 + e];
      osm[irow * 128 + e] = o + __builtin_amdgcn_exp2f(l2g * (float)(irow + 1)) * cr; }
    __syncthreads();
    if (wid < 4) { const int i = 4 * part + wid; const float v0 = osm[i * 128 + lane], v1 = osm[i * 128 + 64 + lane];
        const float rstd = rsqrtf(wave_sum(v0 * v0 + v1 * v1) * (1.0f / 128.0f) + EPS);
        const size_t token = (size_t)(ts0 + i);
        const float g0 = PS[(size_t)(16 * b + i) * NIN + 1536 + 128 * h + lane], g1 = PS[(size_t)(16 * b + i) * NIN + 1536 + 128 * h + 64 + lane];
        MIX[token * DM + 128 * h + lane] = (bf16_t)(pk2(v0 * rstd * p.in[8][128 * h + lane] * silu_f(g0), 0.f) & 0xffffu);
        MIX[token * DM + 128 * h + 64 + lane] = (bf16_t)(pk2(v1 * rstd * p.in[8][128 * h + 64 + lane] * silu_f(g1), 0.f) & 0xffffu); }
    const float g16 = __builtin_amdgcn_exp2f(l2g * 16.0f);
    float* outS = p.out + O_SRS + (size_t)su * 16384;
#pragma unroll 2
    for (int dd = 0; dd < 8; ++dd) { const int d = 32 * part + sub + 4 * dd; float a = g16 * s0[d * 128 + e];
        for (int j = 0; j < 16; ++j) a += __builtin_amdgcn_exp2f(l2g * (float)(15 - j)) * ks[j * 128 + d] * vs[j * 128 + e];
        outS[d * 128 + e] = a; }
    { const int ch = 128 * h + e; const float* cache = p.in[3]; const float* cwp = p.in[7];
      const float w0 = cwp[ch], w1 = cwp[512 + ch], w2 = cwp[1024 + ch];
      const int t = irow;
      const float c0 = ch_at(PS, cache, b, t - 2, ch), c1 = ch_at(PS, cache, b, t - 1, ch), c2 = ch_at(PS, cache, b, t, ch);
      const float y = PS[(size_t)(16 * b + t) * NIN + 2048 + ch] * (w0 * c0 + w1 * c1 + w2 * c2);
      MIX[(size_t)(ts0 + t) * DM + 512 + ch] = (bf16_t)(pk2(y, 0.f) & 0xffffu);
      if (t >= 14) p.out[O_CCS + (size_t)(b * 2 + t - 14) * 512 + ch] = c2; }
    __syncthreads();
}

constexpr int TG_B = 34816, TG_BUF = 34816 + 32 * 272;
template <int NB>
__device__ __forceinline__ void thin_gemm2(LAS unsigned char* lds, const bf16_t* A, int lda, const bf16_t* Bt, int ldb, int n0, int nbstride, int kbeg, int klen, f32x4 (&acc)[NB], int tid, int wid, int lane) {
    const int l15 = lane & 15, l4 = lane >> 4, nkb = klen >> 7;
    const bool hasb = tid < NB * 256;
    const bf16_t* ag = A + (size_t)(tid >> 4) * lda + kbeg + (tid & 15) * 8;
    const bf16_t* bg = Bt + (size_t)(n0 + (tid >> 8) * nbstride + ((tid >> 4) & 15)) * ldb + kbeg + (tid & 15) * 8;
    const int sto = (tid >> 4) * 272 + (tid & 15) * 16;
    const int fro = l15 * 272 + (8 * l4) * 2;
    u32x4 Xa[4], Ya[4], Xb = (u32x4){0u, 0u, 0u, 0u}, Yb = Xb;
#define TG_LOAD(R, kb) do { _Pragma("unroll") for (int i_ = 0; i_ < 4; ++i_) R##a[i_] = *(const u32x4*)(ag + (size_t)(32 * i_) * lda + (kb) * 128); if (hasb) R##b = *(const u32x4*)(bg + (kb) * 128); } while (0)
#define TG_STORE(R, buf) do { _Pragma("unroll") for (int i_ = 0; i_ < 4; ++i_) *(LAS u32x4*)(lds + (buf) * TG_BUF + sto + i_ * 32 * 272) = R##a[i_]; if (hasb) *(LAS u32x4*)(lds + (buf) * TG_BUF + TG_B + sto) = R##b; } while (0)
#define TG_COMP(buf) do { _Pragma("unroll") for (int ks = 0; ks < 4; ++ks) { const bf16x8 a_ = *(const LAS bf16x8*)(lds + (buf) * TG_BUF + 16 * wid * 272 + fro + ks * 64); \
        _Pragma("unroll") for (int nb = 0; nb < NB; ++nb) { const bf16x8 b_ = *(const LAS bf16x8*)(lds + (buf) * TG_BUF + TG_B + 16 * nb * 272 + fro + ks * 64); acc[nb] = MFMA16(a_, b_, acc[nb]); } } } while (0)
#pragma unroll
    for (int nb = 0; nb < NB; ++nb) acc[nb] = (f32x4){0.f, 0.f, 0.f, 0.f};
    TG_LOAD(X, 0); TG_LOAD(Y, 1);
    TG_STORE(X, 0); WG_BAR();
#pragma unroll 1
    for (int kb = 0; kb < nkb; kb += 2) {
        if (kb + 2 < nkb) TG_LOAD(X, kb + 2);
        TG_COMP(0);
        TG_STORE(Y, 1); WG_BAR();
        if (kb + 3 < nkb) TG_LOAD(Y, kb + 3);
        TG_COMP(1);
        if (kb + 2 < nkb) TG_STORE(X, 0);
        WG_BAR();
    }
#undef TG_LOAD
#undef TG_STORE
#undef TG_COMP
}
template <int NB>
__device__ __forceinline__ void thin_gemm(const bf16_t* A, int lda, const bf16_t* Bt, int ldb, int n0, int nbstride, int kbeg, int klen, f32x4 (&acc)[NB], int wid, int lane) {
    const int l15 = lane & 15, l4 = lane >> 4;
    const bf16_t* ap = A + (size_t)(16 * wid + l15) * lda + kbeg + 8 * l4;
    const bf16_t* bp = Bt + (size_t)(n0 + l15) * ldb + kbeg + 8 * l4;
#pragma unroll
    for (int nb = 0; nb < NB; ++nb) acc[nb] = (f32x4){0.f, 0.f, 0.f, 0.f};
#pragma unroll 1
    for (int s0 = 0; s0 < klen; s0 += 256) {
        bf16x8 a[8], b[NB][8];
#pragma unroll
        for (int s = 0; s < 8; ++s) { a[s] = *(const bf16x8*)(ap + s0 + 32 * s);
#pragma unroll
            for (int nb = 0; nb < NB; ++nb) b[nb][s] = *(const bf16x8*)(bp + (size_t)nb * nbstride * ldb + s0 + 32 * s); }
#pragma unroll
        for (int s = 0; s < 8; ++s)
#pragma unroll
            for (int nb = 0; nb < NB; ++nb) acc[nb] = MFMA16(a[s], b[nb][s], acc[nb]);
    }
}
__device__ __forceinline__ void thin_store(const f32x4& acc, float* out, int ldo, int col, int wid, int lane) {
#pragma unroll
    for (int r = 0; r < 4; ++r) out[(size_t)(16 * wid + 4 * (lane >> 4) + r) * ldo + col + (lane & 15)] = acc[r];
}
__device__ __forceinline__ void thin_ffn1(const Params& p, LAS unsigned char* lds, int c, int tid, int wid, int lane) {
    const int pn = c >> 3, j16 = c & 7, l15 = lane & 15, l4 = lane >> 4;
    f32x4 acc[2];
    thin_gemm2<2>(lds, (const bf16_t*)(p.ws + WS_RA) + (size_t)TOK_P * DM, DM, (const bf16_t*)(p.ws + WS_WFF1), DM, 256 * pn + 16 * j16, 128, 0, DM, acc, tid, wid, lane);
    const int ch = 128 * pn + 16 * j16 + l15, b = wid;
    const float* cw = p.in[15]; const float* cache = p.in[4] + (size_t)b * 2 * DFF + ch;
    const float w0 = cw[ch], w1 = cw[DFF + ch], w2 = cw[2 * DFF + ch];
    const f32x4 up = acc[0], gt = acc[1];
    float pm1 = __shfl_up(up[3], 16), pm2 = __shfl_up(up[2], 16);
    if (l4 == 0) { pm1 = cache[DFF]; pm2 = cache[0]; }
    float uc[4];
    uc[0] = w0 * pm2 + w1 * pm1 + w2 * up[0];
    uc[1] = w0 * pm1 + w1 * up[0] + w2 * up[1];
    uc[2] = w0 * up[0] + w1 * up[1] + w2 * up[2];
    uc[3] = w0 * up[1] + w1 * up[2] + w2 * up[3];
    bf16_t* ACT = (bf16_t*)(p.ws + WS_RB);
#pragma unroll
    for (int r = 0; r < 4; ++r) ACT[(size_t)(TOK_P + 16 * wid + 4 * l4 + r) * DFF + ch] = (bf16_t)(pk2(pg8::gelu_tanh(uc[r]) * gt[r], 0.f) & 0xffffu);
    if (l4 == 3) { float* o = p.out + O_CFS + (size_t)b * 2 * DFF + ch; o[0] = up[2]; o[DFF] = up[3]; }
}

__device__ __forceinline__ void phase4(const Params& p, int wid, int lane) {
    const int gw = blockIdx.x * 8 + wid, NGW = gridDim.x * 8;
    const bf16_t* Y = (const bf16_t*)(p.ws + WS_Y); bf16_t* H2 = (bf16_t*)(p.ws + WS_RA); const float* ssq = (const float*)(p.ws + WS_SSQ1);
    const float* wpost = p.in[10]; const float* wpre = p.in[11];
    f32x4 wpo[4], wpr[4];
#pragma unroll
    for (int j = 0; j < 4; ++j) { wpo[j] = *((const f32x4*)wpost + lane + 64 * j); wpr[j] = *((const f32x4*)wpre + lane + 64 * j); }
#pragma unroll 1
    for (int base = gw; base < TOK_P; base += RB * NGW) {
        f32x4 v[RB][4]; u32x2 yw[RB][4]; float sq[RB];
#pragma unroll
        for (int k = 0; k < RB; ++k) { const int rr = min(base + k * NGW, TOK_P - 1);
            sq[k] = lane < 16 ? ssq[(size_t)rr * 16 + lane] : 0.f;
#pragma unroll
            for (int j = 0; j < 4; ++j) { v[k][j] = __builtin_nontemporal_load((const f32x4*)(p.in[0] + (size_t)rr * DM) + lane + 64 * j); yw[k][j] = __builtin_nontemporal_load((const u32x2*)(Y + (size_t)rr * DM) + lane + 64 * j); } }
        float s2[RB];
#pragma unroll
        for (int k = 0; k < RB; ++k) { const float rstd1 = rsqrtf(wave_sum(sq[k]) * (1.0f / DM) + EPS); s2[k] = 0.f;
#pragma unroll
            for (int j = 0; j < 4; ++j) { v[k][j] = v[k][j] + (unpack_bf4(yw[k][j]) * rstd1) * wpo[j]; s2[k] += sumsq4(v[k][j]); } }
#pragma unroll
        for (int k = 0; k < RB; ++k) { const int r = base + k * NGW; const float rstd2 = rsqrtf(wave_sum(s2[k]) * (1.0f / DM) + EPS);
            if (r < TOK_P) {
#pragma unroll
                for (int j = 0; j < 4; ++j) { const f32x4 y = (v[k][j] * rstd2) * wpr[j];
                    __builtin_nontemporal_store((u32x2){pk2(y[0], y[1]), pk2(y[2], y[3])}, (u32x2*)(H2 + (size_t)r * DM) + lane + 64 * j); } } }
    }
    for (int r = TOK_P + gw; r < TOK; r += NGW) {
        const float* xrow = p.in[1] + (size_t)(r - TOK_P) * DM; const float* ys = (const float*)(p.ws + WS_YS) + (size_t)(r - TOK_P) * DM;
        f32x4 yv[4], v[4]; float s = 0.f, s2 = 0.f;
#pragma unroll
        for (int j = 0; j < 4; ++j) { f32x4 a = *((const f32x4*)ys + lane + 64 * j);
#pragma unroll
            for (int q = 1; q < 4; ++q) a += *((const f32x4*)(ys + (size_t)q * 128 * DM) + lane + 64 * j);
            yv[j] = a; s += sumsq4(a); }
        const float rstd1 = rsqrtf(wave_sum(s) * (1.0f / DM) + EPS);
#pragma unroll
        for (int j = 0; j < 4; ++j) { v[j] = *((const f32x4*)xrow + lane + 64 * j) + (yv[j] * rstd1) * wpo[j]; s2 += sumsq4(v[j]);
 }
        const float rstd2 = rsqrtf(wave_sum(s2) * (1.0f / DM) + EPS);
#pragma unroll
        for (int j = 0; j < 4; ++j) { const f32x4 y = (v[j] * rstd2) * wpr[j]; *((u32x2*)(H2 + (size_t)r * DM) + lane + 64 * j) = (u32x2){pk2(y[0], y[1]), pk2(y[2], y[3])}; }
    }
}
__device__ __forceinline__ void phase7(const Params& p, int wid, int lane) {
    const int gw = blockIdx.x * 8 + wid, NGW = gridDim.x * 8;
    const bf16_t* F = (const bf16_t*)(p.ws + WS_RA); const bf16_t* Y = (const bf16_t*)(p.ws + WS_Y);
    const float* ssq1 = (const float*)(p.ws + WS_SSQ1); const float* ssq2 = (const float*)(p.ws + WS_SSQ2);
    f32x4 wm[4], wf[4];
#pragma unroll
    for (int j = 0; j < 4; ++j) { wm[j] = *((const f32x4*)p.in[10] + lane + 64 * j); wf[j] = *((const f32x4*)p.in[12] + lane + 64 * j); }
    constexpr int RB7 = 4;
#pragma unroll 1
    for (int base = gw; base < TOK_P; base += RB7 * NGW) {
        f32x4 v[RB7][4]; u32x2 yw[RB7][4], fw[RB7][4]; float sq1[RB7], sq2[RB7];
#pragma unroll
        for (int k = 0; k < RB7; ++k) { const int rr = min(base + k * NGW, TOK_P - 1);
            sq1[k] = lane < 16 ? ssq1[(size_t)rr * 16 + lane] : 0.f; sq2[k] = lane < 16 ? ssq2[(size_t)rr * 16 + lane] : 0.f;
#pragma unroll
            for (int j = 0; j < 4; ++j) { v[k][j] = __builtin_nontemporal_load((const f32x4*)(p.in[0] + (size_t)rr * DM) + lane + 64 * j);
                yw[k][j] = __builtin_nontemporal_load((const u32x2*)(Y + (size_t)rr * DM) + lane + 64 * j); fw[k][j] = __builtin_nontemporal_load((const u32x2*)(F + (size_t)rr * DM) + lane + 64 * j); } }
#pragma unroll
        for (int k = 0; k < RB7; ++k) { const int r = base + k * NGW;
            const float rstd1 = rsqrtf(wave_sum(sq1[k]) * (1.0f / DM) + EPS), rstd2 = rsqrtf(wave_sum(sq2[k]) * (1.0f / DM) + EPS);
            if (r < TOK_P) {
#pragma unroll
                for (int j = 0; j < 4; ++j) __builtin_nontemporal_store(v[k][j] + (unpack_bf4(yw[k][j]) * rstd1) * wm[j] + (unpack_bf4(fw[k][j]) * rstd2) * wf[j], (f32x4*)(p.out + (size_t)r * DM) + lane + 64 * j); } }
    }
    for (int r = TOK_P + gw; r < TOK; r += NGW) {
        const float* xrow = p.in[1] + (size_t)(r - TOK_P) * DM;
        const float* ys = (const float*)(p.ws + WS_YS) + (size_t)(r - TOK_P) * DM; const float* fs = (const float*)(p.ws + WS_FS) + (size_t)(r - TOK_P) * DM;
        f32x4 yv[4], fv[4]; float s1 = 0.f, s2 = 0.f;
#pragma unroll
        for (int j = 0; j < 4; ++j) { f32x4 a = *((const f32x4*)ys + lane + 64 * j), c = *((const f32x4*)fs + lane + 64 * j);
#pragma unroll
            for (int q = 1; q < 4; ++q) { a += *((const f32x4*)(ys + (size_t)q * 128 * DM) + lane + 64 * j); c += *((const f32x4*)(fs + (size_t)q * 128 * DM) + lane + 64 * j); }
            yv[j] = a; fv[j] = c; s1 += sumsq4(a); s2 += sumsq4(c); }
        const float rstd1 = rsqrtf(wave_sum(s1) * (1.0f / DM) + EPS), rstd2 = rsqrtf(wave_sum(s2) * (1.0f / DM) + EPS);
#pragma unroll
        for (int j = 0; j < 4; ++j) *((f32x4*)(p.out + (size_t)r * DM) + lane + 64 * j) = *((const f32x4*)xrow + lane + 64 * j) + (yv[j] * rstd1) * wm[j] + (fv[j] * rstd2) * wf[j];
    }
}


#define XB_TMO      128
#define XB_XCNT(j)  (256  + 64 * (j))
#define XB_XSUB(j)  (1280 + 64 * (j))
#define XB_XGEN(j)  (2304 + 64 * (j))
#define XB_TOP      3328
#define XB_TOPGEN   3392
#define XCD_BAR_WORDS 3456
#define XB_SPIN_CAP (1u << 18)

__device__ __forceinline__ unsigned xb_ld(unsigned* p)              { return __hip_atomic_load(p, __ATOMIC_RELAXED, __HIP_MEMORY_SCOPE_AGENT); }
__device__ __forceinline__ unsigned xb_add(unsigned* p, unsigned v) { return __hip_atomic_fetch_add(p, v, __ATOMIC_RELAXED, __HIP_MEMORY_SCOPE_AGENT); }
__device__ __forceinline__ unsigned xb_xcc_id() { return (unsigned)__builtin_amdgcn_s_getreg((3 << 11) | 20) & 0xFu; }
#define XB_SPIN(cond, bar) do { unsigned _sp = 0; while (cond) { __builtin_amdgcn_s_sleep(1); \
    if ((++_sp & 255u) == 0u) { if (xb_ld(&(bar)[XB_TMO])) break; if (_sp > XB_SPIN_CAP) { atomicAdd(&(bar)[XB_TMO], 1u); break; } } } } while (0)

struct XcdBarrier {
    unsigned* bar; unsigned x;
    volatile LAS unsigned* st;
};

__device__ __forceinline__ XcdBarrier xcd_barrier_post(unsigned* bar, volatile LAS unsigned* st) {
    XcdBarrier b; b.bar = bar; b.x = xb_xcc_id(); b.st = st;
    if (threadIdx.x == 0) (void)xb_add(&bar[XB_XCNT(b.x)], 1u);
    return b;
}
__device__ __forceinline__ void xcd_barrier_complete(unsigned* bar, unsigned x, unsigned& nloc, unsigned& nx) {
    const unsigned G = gridDim.x * gridDim.y * gridDim.z;
    unsigned sum, cnt, mine, sp = 0u;
    for (;;) {
        sum = 0u; cnt = 0u; mine = 0u;
#pragma unroll
        for (unsigned j = 0; j < 16; ++j) { const unsigned c = xb_ld(&bar[XB_XCNT(j)]); sum += c; cnt += (c > 0u) ? 1u : 0u; mine = (j == x) ? c : mine; }
        if (sum == G) break;
        __builtin_amdgcn_s_sleep(1);
        if ((++sp & 255u) == 0u) { if (xb_ld(&bar[XB_TMO])) break; if (sp > XB_SPIN_CAP) { atomicAdd(&bar[XB_TMO], 1u); break; } }
    }
    nloc = mine > 0u ? mine : 1u; nx = cnt > 0u ? cnt : 1u;
}

__device__ __forceinline__ void xcd_barrier(const XcdBarrier& b) {
    asm volatile("s_waitcnt vmcnt(0)" ::: "memory");
    __syncthreads();
    if (threadIdx.x == 0) {
        unsigned* bar = b.bar;
        __builtin_amdgcn_s_waitcnt(0);
        unsigned nloc = b.st[0], nx = b.st[1];
        if (nloc == 0u) { xcd_barrier_complete(bar, b.x, nloc, nx); b.st[0] = nloc; b.st[1] = nx; }
        const unsigned old = xb_add(&bar[XB_XSUB(b.x)], 1u);
        const unsigned gen = old / nloc;
        if (old + 1u == (gen + 1u) * nloc) {
            __builtin_amdgcn_fence(__ATOMIC_RELEASE, "agent");
            asm volatile("s_waitcnt vmcnt(0)" ::: "memory");
            const unsigned og = xb_add(&bar[XB_TOP], 1u);
            const unsigned tg = og / nx;
            if (og + 1u == (tg + 1u) * nx) xb_add(&bar[XB_TOPGEN], 1u);
            else XB_SPIN(xb_ld(&bar[XB_TOPGEN]) == tg, bar);
            __builtin_amdgcn_fence(__ATOMIC_ACQUIRE, "agent");
            xb_add(&bar[XB_XGEN(b.x)], 1u);
            asm volatile("s_waitcnt vmcnt(0)" ::: "memory");
        } else {
            XB_SPIN(xb_ld(&bar[XB_XGEN(b.x)]) == gen, bar);
            __builtin_amdgcn_fence(__ATOMIC_ACQUIRE, "agent");
            asm volatile("s_waitcnt vmcnt(0)" ::: "memory");
        }
    }
    __syncthreads();
}

#ifndef MK_LAUNCHES
#define MK_LAUNCHES 1
#endif
#ifndef REP0
#define REP0 1
#endif
#ifndef REP1
#define REP1 1
#endif
#ifndef REP2
#define REP2 1
#endif
#ifndef REP3
#define REP3 1
#endif
#ifndef REP4
#define REP4 1
#endif
#ifndef REP5
#define REP5 1
#endif
#ifndef REP6
#define REP6 1
#endif
#ifndef REP7
#define REP7 1
#endif
#define REPEAT(n) for (int rep_ = 0; rep_ < (n); ++rep_, ((rep_ < (n)) ? GRIDSYNC() : (void)0))
template <int PH_LO, int PH_HI>
__device__ __forceinline__ void run_phases(const Params& p, LAS unsigned char* lds) {
    int tid = threadIdx.x, lane = tid & 63; const int wid = __builtin_amdgcn_readfirstlane(tid >> 6);
    const int G = gridDim.x, c = blockIdx.x;
#define LAUNDER() asm volatile("" : "+v"(tid), "+v"(lane))
    XcdBarrier bar_;
    if (PH_HI - PH_LO > 1) {
        volatile LAS unsigned* stw = (volatile LAS unsigned*)(lds + LDS_BARW);
        if (threadIdx.x == 0) { stw[0] = 0u; stw[1] = 0u; }
        __syncthreads();
        bar_ = xcd_barrier_post((unsigned*)p.ws, stw);
        if (p.ws == nullptr) cg::this_grid().sync();
    }
#define GRIDSYNC() xcd_barrier(bar_)
#define SEAM(ph) do { if (PH_LO <= (ph) && (ph) + 1 < PH_HI) { GRIDSYNC(); } } while (0)
#ifdef XSYNC
    for (int xs_ = 0; xs_ < XSYNC; ++xs_) GRIDSYNC();
#endif
    if (PH_LO <= 0 && 0 < PH_HI) REPEAT(REP0) { LAUNDER(); phase0(p, lds, tid, wid, lane); }
    SEAM(0);
    if (PH_LO <= 1 && 1 < PH_HI) REPEAT(REP1) {
        for (int t = c; t < 224; t += G) { f32x4 acc[1]; thin_gemm2<1>(lds, (const bf16_t*)(p.ws + WS_RA) + (size_t)TOK_P * DM, DM, (const bf16_t*)(p.ws + WS_WIN), DM, 16 * t, 0, 0, DM, acc, tid, wid, lane);
            thin_store(acc[0], (float*)(p.ws + WS_PS), NIN, 16 * t, wid, lane); }
        pg8::Gemm g{(const bf16_t*)(p.ws + WS_RA), (const bf16_t*)(p.ws + WS_WIN), TOK_P, NIN, DM};
        pg8::StaticOrder S; S.init(TOK_P, NIN, G, c);
        pg8::EpiIn E{(bf16_t*)(p.ws + WS_RB), (const float*)(p.ws + WS_COS), (const float*)(p.ws + WS_SIN)};
        pg8::gemm_phase<pg8::EpiIn, pg8::StaticOrder, true, true>(lds, g, S, E);
    }
    SEAM(1);
    if (PH_LO <= 2 && 2 < PH_HI) REPEAT(REP2) {
#ifndef RUREP
#define RUREP 1
#endif
        for (int rrep_ = 0; rrep_ < RUREP; ++rrep_) for (int u = c; u < 256; u += G) ret_unit<false>(p, lds, u, tid, wid, lane);
        LAUNDER();
#ifndef SUREP
#define SUREP 1
#endif
        for (int srep_ = 0; srep_ < SUREP; ++srep_) for (int su = c; su < 128; su += G) sample_unit(p, lds, su, tid, wid, lane);
    }
    SEAM(2);
    if (PH_LO <= 3 && 3 < PH_HI) REPEAT(REP3) {
        for (int u = c; u < 256; u += G) ret_unit<true>(p, lds, u, tid, wid, lane);
    }
    SEAM(3);
    if (PH_LO <= 4 && 4 < PH_HI) REPEAT(REP4) {
        for (int t = c; t < 256; t += G) { f32x4 acc[1]; const int kq = t >> 6, nt = t & 63;
            thin_gemm2<1>(lds, (const bf16_t*)(p.ws + WS_RA) + (size_t)TOK_P * DM, DM, (const bf16_t*)(p.ws + WS_WOUT), DM, 16 * nt, 0, 256 * kq, 256, acc, tid, wid, lane);
            thin_store(acc[0], (float*)(p.ws + WS_YS) + (size_t)kq * 128 * DM, DM, 16 * nt, wid, lane); }
        pg8::Gemm g{(const bf16_t*)(p.ws + WS_RA), (const bf16_t*)(p.ws + WS_WOUT), TOK_P, DM, DM};
        pg8::StaticOrder S; S.init(TOK_P, DM, G, c);
        pg8::EpiY E{(bf16_t*)(p.ws + WS_Y), (float*)(p.ws + WS_SSQ1)};
        pg8::gemm_phase<pg8::EpiY, pg8::StaticOrder, true, true>(lds, g, S, E);
    }
    SEAM(4);
    if (PH_LO <= 5 && 5 < PH_HI) REPEAT(REP5) { LAUNDER(); phase4(p, wid, lane); }
    SEAM(5);
    if (PH_LO <= 6 && 6 < PH_HI) REPEAT(REP6) {
        for (int t = c; t < 256; t += G) thin_ffn1(p, lds, t, tid, wid, lane);
        pg8::Gemm g{(const bf16_t*)(p.ws + WS_RA), (const bf16_t*)(p.ws + WS_WFF1), TOK_P, 2 * DFF, DM};
        pg8::WalkOrder S{G, c};
        pg8::EpiFfn E{(bf16_t*)(p.ws + WS_RB), p.in[15], p.in[4], p.out + O_CFP, p.out + O_CFS, (LAS float*)(lds + LDS_HALO)};
        pg8::gemm_phase<pg8::EpiFfn, pg8::WalkOrder, true, true>(lds, g, S, E);
    }
    SEAM(6);
    if (PH_LO <= 7 && 7 < PH_HI) REPEAT(REP7) {
        for (int t = c; t < 256; t += G) { f32x4 acc[1]; const int kq = t >> 6, nt = t & 63;
            thin_gemm2<1>(lds, (const bf16_t*)(p.ws + WS_RB) + (size_t)TOK_P * DFF, DFF, (const bf16_t*)(p.ws + WS_WDN), DFF, 16 * nt, 0, 1024 * kq, 1024, acc, tid, wid, lane);
            thin_store(acc[0], (float*)(p.ws + WS_FS) + (size_t)kq * 128 * DM, DM, 16 * nt, wid, lane); }
        pg8::Gemm g{(const bf16_t*)(p.ws + WS_RB), (const bf16_t*)(p.ws + WS_WDN), TOK_P, DM, DFF};
        pg8::StaticOrder S; S.init(TOK_P, DM, G, c);
        pg8::EpiY E{(bf16_t*)(p.ws + WS_RA), (float*)(p.ws + WS_SSQ2)};
        pg8::gemm_phase<pg8::EpiY, pg8::StaticOrder, true, true>(lds, g, S, E);
    }
    SEAM(7);
#ifndef REP8
#define REP8 1
#endif
    if (PH_LO <= 8 && 8 < PH_HI) REPEAT(REP8) { LAUNDER(); phase7(p, wid, lane); }
#undef SEAM
}
constexpr int NPH = 9;
#if MK_LAUNCHES == 1
__global__ void __launch_bounds__(512, 2) fwd_kernel(Params p) {
    extern __shared__ __attribute__((aligned(16))) unsigned char smem[];
    run_phases<0, NPH>(p, (LAS unsigned char*)smem);
}
#else
template <int PH>
__global__ void __launch_bounds__(512, 2) fwd_phase(Params p) {
    extern __shared__ __attribute__((aligned(16))) unsigned char smem[];
    run_phases<PH, PH + 1>(p, (LAS unsigned char*)smem);
}
template <int PH> static void launch_phase(const Params& p, int grid, hipStream_t stream) {
    static bool attr = false;
    if (!attr) { (void)hipFuncSetAttribute((const void*)fwd_phase<PH>, hipFuncAttributeMaxDynamicSharedMemorySize, LDS_BYTES); attr = true; }
    hipLaunchKernelGGL(fwd_phase<PH>, dim3(grid), dim3(512), LDS_BYTES, stream, p);
}
#endif

extern "C" void kernel_launch(void* const* d_in, const int* in_sizes, int n_in, void* d_out, int out_size, void* d_ws, size_t ws_size, hipStream_t stream) {
    static int grid = 0;
    if (grid == 0) {
        if (n_in != 17 || ws_size < WS_END) { fprintf(stderr, "kernel_launch: expected 17 inputs and >= %zu bytes of workspace (got %d, %zu)\n", (size_t)WS_END, n_in, ws_size); grid = -1; return; }
        int dev = 0, cus = 0, per_cu = 0;
        (void)hipGetDevice(&dev); (void)hipDeviceGetAttribute(&cus, hipDeviceAttributeMultiprocessorCount, dev);
#if MK_LAUNCHES == 1
        if (hipFuncSetAttribute((const void*)fwd_kernel, hipFuncAttributeMaxDynamicSharedMemorySize, LDS_BYTES) != hipSuccess) { fprintf(stderr, "kernel_launch: hipFuncSetAttribute failed\n"); grid = -1; return; }
        if (hipOccupancyMaxActiveBlocksPerMultiprocessor(&per_cu, (const void*)fwd_kernel, 512, LDS_BYTES) != hipSuccess || per_cu < 1) { fprintf(stderr, "kernel_launch: occupancy query says %d\n", per_cu); per_cu = 1; }
        (void)hipGetLastError();
#endif
        grid = cus > 0 ? cus : 256;
    }
    if (grid < 0) return;
    Params p{};
    for (int i = 0; i < 17; ++i) p.in[i] = (const float*)d_in[i];
    p.out = (float*)d_out; p.ws = (unsigned char*)d_ws;
#if MK_LAUNCHES == 1
    if (hipMemsetAsync(d_ws, 0, 16384, stream) != hipSuccess) { fprintf(stderr, "kernel_launch: hipMemsetAsync failed\n"); return; }
    void* args[] = {&p};
    const hipError_t e = hipLaunchCooperativeKernel((const void*)fwd_kernel, dim3(grid), dim3(512), args, LDS_BYTES, stream);
    if (e != hipSuccess) fprintf(stderr, "kernel_launch: cooperative launch failed: %s (grid %d)\n", hipGetErrorString(e), grid);
#else
    launch_phase<0>(p, grid, stream); launch_phase<1>(p, grid, stream); launch_phase<2>(p, grid, stream); launch_phase<3>(p, grid, stream); launch_phase<4>(p, grid, stream);
    launch_phase<5>(p, grid, stream); launch_phase<6>(p, grid, stream); launch_phase<7>(p, grid, stream); launch_phase<8>(p, grid, stream);
#endif
}
```

```cpp
#include <hip/hip_runtime.h>
#include <hip/hip_cooperative_groups.h>
#include <cstdio>
#include <cstdint>
namespace cg = cooperative_groups;
namespace pg8 {
#define PG8_LAS __attribute__((address_space(3)))
typedef unsigned short bf16_t;
typedef short bf16x8 __attribute__((ext_vector_type(8)));
typedef float f32x4 __attribute__((ext_vector_type(4)));
typedef unsigned u32x4 __attribute__((ext_vector_type(4)));
constexpr int BM = 256, BK = 64, HALF = 128, HTB = HALF * BK * 2  , STAGE_BYTES = 8 * HTB, NXCD = 8, WGM = 8;

__host__ __device__ __forceinline__ int lds_byte(int r, int c) { const int st = (r >> 4) * 2 + (c >> 5), rr = r & 15, cc = c & 31, ob = rr * 64 + cc * 2; return st * 1024 + (ob ^ (((ob >> 9) & 1) << 5)); }
__host__ __device__ __forceinline__ void stage_rc(int b, int& R, int& C) { const int st = b / 1024, sb = b % 1024, swz = sb ^ (((sb >> 9) & 1) << 5); R = (st >> 1) * 16 + swz / 64; C = (st & 1) * 32 + (swz % 64) / 2; }
__host__ __device__ __forceinline__ int perm32(int rho) { const int n = rho >> 4, i = rho & 15; return 8 * (i >> 2) + 4 * n + (i & 3); }

struct Unit { int pm, pn; };
struct Gemm { const bf16_t* A; const bf16_t* Bt; int M, N, K; };

struct StaticOrder {
    int nM, nN, nwg, G, c;
    __host__ __device__ void init(int M, int N, int G_, int c_) { nM = M / BM; nN = N / BM; nwg = nM * nN; G = G_; c = c_; }
    __host__ __device__ bool next(int i, Unit& u) const {
        const long L = (long)i * G + c; if (L >= nwg) return false;
        int wgid = (int)L; { const int q = nwg / NXCD, r = nwg % NXCD, xcd = wgid % NXCD, off = wgid / NXCD; wgid = (xcd < r ? xcd * (q + 1) : r * (q + 1) + (xcd - r) * q) + off; }
        const int nig = WGM * nN, gid = wgid / nig, fm = gid * WGM, gsz = (nM - fm) < WGM ? (nM - fm) : WGM;
        u.pm = fm + ((wgid % nig) % gsz); u.pn = (wgid % nig) / gsz; return true;
    }
    __device__ __forceinline__ void a_ready(const Unit&) const {}
    __device__ __forceinline__ void done(const Unit&) const {}
};
__device__ __forceinline__ unsigned cvt_pk_bf16(float lo, float hi) { unsigned r; asm volatile("v_cvt_pk_bf16_f32 %0, %1, %2" : "=v"(r) : "v"(lo), "v"(hi)); return r; }
__device__ __forceinline__ float dpp_shr1(float v) { return __builtin_bit_cast(float, __builtin_amdgcn_update_dpp(0, __builtin_bit_cast(int, v), 0x111, 0xf, 0xf, true)); }
__device__ __forceinline__ float dpp_shr2(float v) { return __builtin_bit_cast(float, __builtin_amdgcn_update_dpp(0, __builtin_bit_cast(int, v), 0x112, 0xf, 0xf, true)); }
__device__ __forceinline__ float dpp_shl15(float v) { return __builtin_bit_cast(float, __builtin_amdgcn_update_dpp(0, __builtin_bit_cast(int, v), 0x10F, 0xf, 0xf, true)); }
__device__ __forceinline__ float dpp_shl14(float v) { return __builtin_bit_cast(float, __builtin_amdgcn_update_dpp(0, __builtin_bit_cast(int, v), 0x10E, 0xf, 0xf, true)); }
__device__ __forceinline__ float gelu_tanh(float x) {
    const float z = 0.7978845608028654f * (x + 0.044715f * x * x * x);
    const float e = __builtin_amdgcn_exp2f(-2.8853900817779268f * z);
    return x * __builtin_amdgcn_rcpf(1.0f + e);
}
constexpr int TOKP = 32768;

struct EpiIn {
    static constexpr bool PERM = true, AFTER_DRAIN = false;
    bf16_t* P; const float* cosT; const float* sinT;
    __device__ __forceinline__ void operator()(const f32x4 (&acc)[2][2][4][2], const Unit& u, int wr, int wc, int fr, int fq) const {
        asm volatile("" : "+v"(fr), "+v"(fq));
        const int row0 = u.pm * BM + wr * 64 + fr, col0 = u.pn * BM + wc * 32 + 8 * fq;
        if (u.pn < 4) {
            const float sc = (u.pn >= 2) ? 0.08838834764831845f : 1.0f;
            const int f0 = 16 * wc + 4 * fq;
#pragma unroll
            for (int ai = 0; ai < 2; ++ai)
#pragma unroll
                for (int m = 0; m < 4; ++m) {
                    const int r = row0 + ai * HALF + m * 16;
                    const int pos = r < TOKP ? (r & 4095) : 4096 + ((r - TOKP) & 15);
                    const f32x4 c4 = *(const f32x4*)(cosT + pos * 64 + f0), s4 = *(const f32x4*)(sinT + pos * 64 + f0);
                    bf16_t* rowp = P + (size_t)r * 3584 + col0;
#pragma unroll
                    for (int bj = 0; bj < 2; ++bj) {
                        const f32x4 x1 = acc[ai][bj][m][0], x2 = acc[ai][bj][m][1];
                        const f32x4 o1 = (x1 * c4 - x2 * s4) * sc, o2 = (x2 * c4 + x1 * s4) * sc;
                        u32x4 w; w.x = cvt_pk_bf16(o1[0], o1[1]); w.y = cvt_pk_bf16(o1[2], o1[3]); w.z = cvt_pk_bf16(o2[0], o2[1]); w.w = cvt_pk_bf16(o2[2], o2[3]);
                        *(u32x4*)(rowp + bj * HALF) = w;
                    }
                }
        } else {
#pragma unroll
            for (int ai = 0; ai < 2; ++ai)
#pragma unroll
                for (int m = 0; m < 4; ++m) {
                    bf16_t* rowp = P + (size_t)(row0 + ai * HALF + m * 16) * 3584 + col0;
#pragma unroll
                    for (int bj = 0; bj < 2; ++bj) {
                        const f32x4 v0 = acc[ai][bj][m][0], v1 = acc[ai][bj][m][1];
                        u32x4 w; w.x = cvt_pk_bf16(v0[0], v0[1]); w.y = cvt_pk_bf16(v0[2], v0[3]); w.z = cvt_pk_bf16(v1[0], v1[1]); w.w = cvt_pk_bf16(v1[2], v1[3]);
                        *(u32x4*)(rowp + bj * HALF) = w;
                    }
                }
        }
    }
};

struct EpiY {
    static constexpr bool PERM = true, AFTER_DRAIN = false;
    bf16_t* Y; float* ssq;
    __device__ __forceinline__ void operator()(const f32x4 (&acc)[2][2][4][2], const Unit& u, int wr, int wc, int fr, int fq) const {
        asm volatile("" : "+v"(fr), "+v"(fq));
        const int row0 = u.pm * BM + wr * 64 + fr, col0 = u.pn * BM + wc * 32 + 8 * fq;
#pragma unroll
        for (int ai = 0; ai < 2; ++ai)
#pragma unroll
            for (int m = 0; m < 4; ++m) {
                const int r = row0 + ai * HALF + m * 16;
                bf16_t* rowp = Y + (size_t)r * 1024 + col0;
                float s = 0.f;
#pragma unroll
                for (int bj = 0; bj < 2; ++bj) {
                    const f32x4 v0 = acc[ai][bj][m][0], v1 = acc[ai][bj][m][1];
                    s += (v0[0] * v0[0] + v0[1] * v0[1]) + (v0[2] * v0[2] + v0[3] * v0[3]) + (v1[0] * v1[0] + v1[1] * v1[1]) + (v1[2] * v1[2] + v1[3] * v1[3]);
                    u32x4 w; w.x = cvt_pk_bf16(v0[0], v0[1]); w.y = cvt_pk_bf16(v0[2], v0[3]); w.z = cvt_pk_bf16(v1[0], v1[1]); w.w = cvt_pk_bf16(v1[2], v1[3]);
                    *(u32x4*)(rowp + bj * HALF) = w;
                }
                s += __shfl_xor(s, 16); s += __shfl_xor(s, 32);
                if (fq == 0) ssq[(size_t)r * 16 + u.pn * 4 + wc] = s;
            }
    }
};

struct EpiFfn {
    static constexpr bool PERM = true, AFTER_DRAIN = false;
    bf16_t* ACT; const float* cw; const float* cache; float* outp; float* outs; PG8_LAS float* halo; const float* rs2;
    __device__ __forceinline__ void operator()(const f32x4 (&acc)[2][2][4][2], const Unit& u, int wr, int wc, int fr, int fq) const {
        asm volatile("" : "+v"(fr), "+v"(fq));
        const int lc0 = wc * 32 + 8 * fq, ch0 = u.pn * 128 + lc0;
        const bool sample = false;
        const int par = u.pm & 1;
        float rs[2][4];
#pragma unroll
        for (int ai = 0; ai < 2; ++ai)
#pragma unroll
            for (int m = 0; m < 4; ++m) rs[ai][m] = rs2[u.pm * BM + ai * HALF + wr * 64 + m * 16 + fr];
        f32x4 w0[2], w1[2], w2[2];
#pragma unroll
        for (int n = 0; n < 2; ++n) { w0[n] = *(const f32x4*)(cw + ch0 + 4 * n); w1[n] = *(const f32x4*)(cw + 4096 + ch0 + 4 * n); w2[n] = *(const f32x4*)(cw + 8192 + ch0 + 4 * n); }
        if (!sample && fr >= 14) {
#pragma unroll
            for (int ai = 0; ai < 2; ++ai) { PG8_LAS float* hp = halo + ((par * 4 + 2 * ai + wr) * 2 + (fr - 14)) * 128 + lc0;
                *(PG8_LAS f32x4*)hp = acc[ai][0][3][0] * rs[ai][3]; *(PG8_LAS f32x4*)(hp + 4) = acc[ai][0][3][1] * rs[ai][3]; }
        }
        asm volatile("s_waitcnt lgkmcnt(0)" ::: "memory"); __builtin_amdgcn_s_barrier(); asm volatile("" ::: "memory");
#pragma unroll
        for (int ai = 0; ai < 2; ++ai) {
            const int blk = 2 * ai + wr;
#pragma unroll
            for (int m = 0; m < 4; ++m) {
                f32x4 pv[2]; pv[0] = (f32x4){0.f, 0.f, 0.f, 0.f}; pv[1] = pv[0];
                const int sb = 8 * ai + 4 * wr + m;
                if (sample) {
                    if (fr >= 14 && sb < 8) { const float* cp = cache + (size_t)(sb * 2 + fr - 14) * 4096 + ch0; pv[0] = *(const f32x4*)cp; pv[1] = *(const f32x4*)(cp + 4); }
                } else if (m == 0) {
                    if (fr >= 14) {
                        const bool zero = (blk == 0) && ((u.pm & 15) == 0);
                        const int hb = (blk == 0) ? ((par ^ 1) * 4 + 3) : (par * 4 + blk - 1);
                        if (!zero) { const PG8_LAS float* hp = halo + (hb * 2 + fr - 14) * 128 + lc0; pv[0] = *(const PG8_LAS f32x4*)hp; pv[1] = *(const PG8_LAS f32x4*)(hp + 4); }
                    }
                } else { pv[0] = acc[ai][0][m - 1][0] * rs[ai][m - 1]; pv[1] = acc[ai][0][m - 1][1] * rs[ai][m - 1]; }
                const int r = u.pm * BM + ai * HALF + wr * 64 + m * 16 + fr;
                float a8[8];
#pragma unroll
                for (int n = 0; n < 2; ++n)
#pragma unroll
                    for (int e = 0; e < 4; ++e) {
                        const float cur = acc[ai][0][m][n][e] * rs[ai][m], pr = pv[n][e];
                        const float p1 = dpp_shr1(cur) + dpp_shl15(pr), p2 = dpp_shr2(cur) + dpp_shl14(pr);
                        const float uc = w0[n][e] * p2 + w1[n][e] * p1 + w2[n][e] * cur;
                        a8[4 * n + e] = gelu_tanh(uc) * (acc[ai][1][m][n][e] * rs[ai][m]);
                    }
                u32x4 w; w.x = cvt_pk_bf16(a8[0], a8[1]); w.y = cvt_pk_bf16(a8[2], a8[3]); w.z = cvt_pk_bf16(a8[4], a8[5]); w.w = cvt_pk_bf16(a8[6], a8[7]);
                *(u32x4*)(ACT + (size_t)r * 4096 + ch0) = w;
                if (sample) {
                    if (fr >= 14 && sb < 8) { float* op = outs + (size_t)(sb * 2 + fr - 14) * 4096 + ch0; *(f32x4*)op = acc[ai][0][m][0]; *(f32x4*)(op + 4) = acc[ai][0][m][1]; }
                } else if (m == 3 && blk == 3 && (u.pm & 15) == 15 && fr >= 14) {
                    float* op = outp + (size_t)((u.pm >> 4) * 2 + fr - 14) * 4096 + ch0; *(f32x4*)op = acc[ai][0][m][0] * rs[ai][m]; *(f32x4*)(op + 4) = acc[ai][0][m][1] * rs[ai][m];
                }
            }
        }
    }
};
struct WalkOrder {
    int G, c;
    __device__ __forceinline__ bool next(int i, Unit& u) const {
        int w = c, rem = i;
        while (w < 256) { const int len = 16;
            if (rem < len) { if (w < 256) { u.pm = (w >> 5) * 16 + rem; u.pn = w & 31; } else { u.pm = 128; u.pn = w - 256; } return true; }
            rem -= len; w += G; }
        return false;
    }
    __device__ __forceinline__ void a_ready(const Unit&) const {}
    __device__ __forceinline__ void done(const Unit&) const {}
};
template <class Epi, class Sched, bool ALIGN_EPI = false, bool SP2 = false>
__device__ __forceinline__ void gemm_phase(PG8_LAS unsigned char* lds, const Gemm g, const Sched& S, const Epi& E) {
    int tid_raw = threadIdx.x; asm volatile("" : "+v"(tid_raw));
    const int tid = tid_raw, wid = __builtin_amdgcn_readfirstlane(tid >> 6), lane = tid & 63, wr = wid >> 2, wc = wid & 3, fr = lane & 15, fq = lane >> 4;
    const int K = g.K, nt = K / BK;
    unsigned voffA[2], voffB[2];
#pragma unroll
    for (int i = 0; i < 2; ++i) { int R, C; stage_rc(tid * 16 + i * 8192, R, C); const int Rb = Epi::PERM ? ((R & ~31) + perm32(R & 31)) : R;
        voffA[i] = (unsigned)(R * K + C) * 2u; voffB[i] = (unsigned)(Rb * K + C) * 2u; }
    const size_t kstep = (size_t)(BK * 2);
    const size_t hstep = (size_t)HALF * K * 2;
    const size_t tstep = 2 * hstep;
    const unsigned ldsw = (unsigned)wid * 1024u;
    const int aoff = lds_byte(wr * 64 + fr, fq * 8), boff = lds_byte(wc * 32 + fr, fq * 8);
#define PG8_SA(b, h) (((b) * 2 + (h)) * HTB)
#define PG8_SB(b, h) ((4 + (b) * 2 + (h)) * HTB)
#define PG8_STAGE(bufoff, gbase, voff) do { _Pragma("unroll") for (int _i = 0; _i < 2; ++_i) \
        __builtin_amdgcn_global_load_lds((const unsigned*)((const char*)(gbase) + (voff)[_i]), (PG8_LAS unsigned*)(lds + (bufoff) + ldsw + _i * 8192), 16, 0, 0); } while (0)
#define PG8_LDA(dst, b, h) do { _Pragma("unroll") for (int m = 0; m < 4; ++m) _Pragma("unroll") for (int k = 0; k < 2; ++k) dst[m][k] = *(const PG8_LAS bf16x8*)(lds + PG8_SA(b, h) + aoff + m * 2048 + k * 1024); } while (0)
#define PG8_LDB(dst, b, h) do { _Pragma("unroll") for (int n = 0; n < 2; ++n) _Pragma("unroll") for (int k = 0; k < 2; ++k) dst[n][k] = *(const PG8_LAS bf16x8*)(lds + PG8_SB(b, h) + boff + n * 2048 + k * 1024); } while (0)
#define PG8_MMA(ai, bj, At, Bt) do { __builtin_amdgcn_s_setprio(1); _Pragma("unroll") for (int m = 0; m < 4; ++m) _Pragma("unroll") for (int n = 0; n < 2; ++n) _Pragma("unroll") for (int k = 0; k < 2; ++k) \
        acc[ai][bj][m][n] = __builtin_amdgcn_mfma_f32_16x16x32_bf16(Bt[n][k], At[m][k], acc[ai][bj][m][n], 0, 0, 0); __builtin_amdgcn_s_setprio(0); } while (0)
#define PG8_WAIT_V(n) asm volatile("s_waitcnt vmcnt(" #n ")" ::: "memory")
#define PG8_WAIT_L(n) asm volatile("s_waitcnt lgkmcnt(" #n ")" ::: "memory")
#define PG8_BAR __builtin_amdgcn_s_barrier()
#define PG8_SCHED __builtin_amdgcn_sched_barrier(0)
    Unit cur, nxt; int ui = 0;
    if (!S.next(0, cur)) return;
    f32x4 acc[2][2][4][2];
#pragma unroll
    for (int a = 0; a < 2; ++a)
#pragma unroll
        for (int b = 0; b < 2; ++b)
#pragma unroll
            for (int m = 0; m < 4; ++m)
#pragma unroll
                for (int n = 0; n < 2; ++n) acc[a][b][m][n] = (f32x4){0.f, 0.f, 0.f, 0.f};
    bf16x8 At[4][2], B0[2][2], B1[2][2];
    const char* cA = (const char*)g.A + (size_t)cur.pm * tstep; const char* cB = (const char*)g.Bt + (size_t)cur.pn * tstep;
    S.a_ready(cur);
    if constexpr (SP2) {
        PG8_STAGE(PG8_SB(0, 0), cB, voffB); PG8_STAGE(PG8_SB(0, 1), cB + hstep, voffB); PG8_STAGE(PG8_SA(0, 0), cA, voffA); PG8_STAGE(PG8_SA(0, 1), cA + hstep, voffA);
        if (wr == 1) PG8_BAR;
        PG8_WAIT_V(2); PG8_BAR;
        PG8_STAGE(PG8_SB(1, 0), cB + kstep, voffB); PG8_STAGE(PG8_SA(1, 0), cA + kstep, voffA); PG8_STAGE(PG8_SB(1, 1), cB + hstep + kstep, voffB);
        PG8_WAIT_V(6); PG8_BAR;
    } else {
        PG8_STAGE(PG8_SB(0, 0), cB, voffB); PG8_STAGE(PG8_SA(0, 0), cA, voffA); PG8_STAGE(PG8_SB(0, 1), cB + hstep, voffB); PG8_STAGE(PG8_SA(0, 1), cA + hstep, voffA);
        if (wr == 1) PG8_BAR;
        PG8_WAIT_V(4); PG8_BAR;
        PG8_STAGE(PG8_SB(1, 0), cB + kstep, voffB); PG8_STAGE(PG8_SA(1, 0), cA + kstep, voffA); PG8_STAGE(PG8_SB(1, 1), cB + hstep + kstep, voffB);
        PG8_WAIT_V(6); PG8_BAR;
    }
    for (;;) {
        const bool has_next = S.next(ui + 1, nxt);
        const char* nA = has_next ? (const char*)g.A + (size_t)nxt.pm * tstep : cA; const char* nB = has_next ? (const char*)g.Bt + (size_t)nxt.pn * tstep : cB;
        for (int t = 0; t < nt; t += 2) {
            const bool last = (t == nt - 2);
            const char* a1 = cA + (size_t)(t + 1) * kstep;
            const char* a2 = last ? nA : cA + (size_t)(t + 2) * kstep; const char* b2 = last ? nB : cB + (size_t)(t + 2) * kstep;
            const char* a3 = a2 + kstep; const char* b3 = b2 + kstep;
            if (last && has_next) S.a_ready(nxt);
            if constexpr (SP2) {
            PG8_LDB(B0, 0, 0); PG8_LDB(B1, 0, 1); PG8_SCHED; PG8_LDA(At, 0, 0); PG8_STAGE(PG8_SA(1, 1), a1 + hstep, voffA);
            PG8_WAIT_V(8); PG8_WAIT_L(0); PG8_BAR; PG8_MMA(0, 0, At, B0); PG8_MMA(0, 1, At, B1); PG8_BAR; PG8_SCHED;
            PG8_LDA(At, 0, 1); PG8_STAGE(PG8_SB(0, 0), b2, voffB); PG8_STAGE(PG8_SB(0, 1), b2 + hstep, voffB); PG8_STAGE(PG8_SA(0, 0), a2, voffA);
            PG8_WAIT_V(8); PG8_WAIT_L(0); PG8_BAR; PG8_MMA(1, 0, At, B0); PG8_MMA(1, 1, At, B1); PG8_BAR; PG8_SCHED;
            PG8_LDB(B0, 1, 0); PG8_LDB(B1, 1, 1); PG8_SCHED; PG8_LDA(At, 1, 0); PG8_STAGE(PG8_SA(0, 1), a2 + hstep, voffA);
            PG8_WAIT_V(8); PG8_WAIT_L(0); PG8_BAR; PG8_MMA(0, 0, At, B0); PG8_MMA(0, 1, At, B1); PG8_BAR; PG8_SCHED;
            PG8_LDA(At, 1, 1); PG8_STAGE(PG8_SB(1, 0), b3, voffB); PG8_STAGE(PG8_SB(1, 1), b3 + hstep, voffB); PG8_STAGE(PG8_SA(1, 0), a3, voffA);
            PG8_WAIT_V(8); PG8_WAIT_L(0); PG8_BAR; PG8_MMA(1, 0, At, B0); PG8_MMA(1, 1, At, B1); PG8_BAR; PG8_SCHED;
            } else {
            PG8_LDB(B0, 0, 0); PG8_SCHED; PG8_LDA(At, 0, 0); PG8_STAGE(PG8_SA(1, 1), a1 + hstep, voffA);
            PG8_WAIT_L(8); PG8_BAR; PG8_WAIT_L(0); PG8_MMA(0, 0, At, B0); PG8_BAR; PG8_SCHED;
            PG8_LDB(B1, 0, 1); PG8_STAGE(PG8_SB(0, 0), b2, voffB);
            PG8_BAR; PG8_WAIT_L(0); PG8_MMA(0, 1, At, B1); PG8_BAR;
            PG8_LDA(At, 0, 1); PG8_STAGE(PG8_SA(0, 0), a2, voffA);
            PG8_BAR; PG8_WAIT_L(0); PG8_MMA(1, 0, At, B0); PG8_BAR; PG8_SCHED;
            PG8_STAGE(PG8_SB(0, 1), b2 + hstep, voffB);
            PG8_WAIT_V(6); PG8_BAR; PG8_MMA(1, 1, At, B1); PG8_BAR;
            PG8_LDB(B0, 1, 0); PG8_SCHED; PG8_LDA(At, 1, 0); PG8_STAGE(PG8_SA(0, 1), a2 + hstep, voffA);
            PG8_WAIT_L(8); PG8_BAR; PG8_WAIT_L(0); PG8_MMA(0, 0, At, B0); PG8_BAR; PG8_SCHED;
            PG8_LDB(B1, 1, 1); PG8_STAGE(PG8_SB(1, 0), b3, voffB);
            PG8_BAR; PG8_WAIT_L(0); PG8_MMA(0, 1, At, B1); PG8_BAR;
            PG8_LDA(At, 1, 1); PG8_STAGE(PG8_SA(1, 0), a3, voffA);
            PG8_BAR; PG8_WAIT_L(0); PG8_MMA(1, 0, At, B0); PG8_BAR; PG8_SCHED;
            PG8_STAGE(PG8_SB(1, 1), b3 + hstep, voffB);
            PG8_WAIT_V(6); PG8_BAR; PG8_MMA(1, 1, At, B1); PG8_BAR;
            }
        }
        if constexpr (ALIGN_EPI) { if (wr == 0) PG8_BAR; }
        if constexpr (!Epi::AFTER_DRAIN) { E(acc, cur, wr, wc, fr, fq); S.done(cur); }
        if (!has_next) break;
#pragma unroll
        for (int a = 0; a < 2; ++a)
#pragma unroll
            for (int b = 0; b < 2; ++b)
#pragma unroll
                for (int m = 0; m < 4; ++m)
#pragma unroll
                    for (int n = 0; n < 2; ++n) acc[a][b][m][n] = (f32x4){0.f, 0.f, 0.f, 0.f};
        cur = nxt; cA = nA; cB = nB; ++ui;
        if constexpr (ALIGN_EPI) { if (wr == 1) PG8_BAR; }
    }
    PG8_WAIT_V(0);
    if constexpr (!ALIGN_EPI) { if (wr == 0) PG8_BAR; }
    PG8_BAR;
    if constexpr (Epi::AFTER_DRAIN) { E.fused(acc, cur, wr, wc, fr, fq, lds, wid, lane); S.done(cur); }
#undef PG8_SA
#undef PG8_SB
#undef PG8_STAGE
#undef PG8_LDA
#undef PG8_LDB
#undef PG8_MMA
#undef PG8_WAIT_V
#undef PG8_WAIT_L
#undef PG8_BAR
#undef PG8_SCHED
}
}

using pg8::bf16_t; using pg8::bf16x8; using pg8::f32x4; using pg8::u32x4;
#define LAS __attribute__((address_space(3)))
typedef unsigned u32x2 __attribute__((ext_vector_type(2)));
constexpr int DM = 1024, NIN = 3584, DFF = 4096;
constexpr int TOK_P = 32768, TOK = 32896, TOKPAD = 33024;
constexpr float EPS = 1e-6f;
constexpr size_t WS_WIN = 16384;
constexpr size_t WS_WOUT = WS_WIN + (size_t)NIN * DM * 2;
constexpr size_t WS_WFF1 = WS_WOUT + (size_t)DM * DM * 2;
constexpr size_t WS_WDN = WS_WFF1 + (size_t)2 * DFF * DM * 2;
constexpr size_t WS_COS = WS_WDN + (size_t)DM * DFF * 2;
constexpr size_t WS_SIN = WS_COS + (size_t)4112 * 64 * 4;
constexpr size_t WS_SSQ1 = WS_SIN + (size_t)4112 * 64 * 4;
constexpr size_t WS_SSQ2 = WS_SSQ1 + (size_t)TOKPAD * 16 * 4;
constexpr size_t WS_UG = WS_SSQ2 + (size_t)TOKPAD * 16 * 4;
constexpr size_t WS_PS = WS_UG + (size_t)256 * 65536;
constexpr size_t WS_YS = WS_PS + (size_t)128 * NIN * 4;
constexpr size_t WS_FS = WS_YS + (size_t)4 * 128 * DM * 4;
constexpr size_t WS_RA = WS_FS + (size_t)4 * 128 * DM * 4;
constexpr size_t WS_RB = WS_RA + (size_t)TOKPAD * DM * 2;
constexpr size_t WS_Y = WS_RB + (size_t)TOKPAD * DFF * 2;
constexpr size_t WS_RS2 = WS_Y + (size_t)TOKPAD * DM * 2;
constexpr size_t WS_END = WS_RS2 + (size_t)TOK_P * 4;
constexpr size_t O_SRP = (size_t)TOK * DM, O_CCP = O_SRP + 524288, O_CFP = O_CCP + 8192, O_SRS = O_CFP + 65536, O_CCS = O_SRS + 524288, O_CFS = O_CCS + 8192;
constexpr int LDS_HALO = 131072, LDS_BARW = 131072 + 8192, LDS_BYTES = LDS_BARW + 16;

struct Params { const float* in[17]; float* out; unsigned char* ws; };

__device__ __forceinline__ float dppf(float v, const int ctrl_sel) {
    const int iv = __builtin_bit_cast(int, v); int r;
    switch (ctrl_sel) { case 1: r = __builtin_amdgcn_update_dpp(0, iv, 0x111, 0xf, 0xf, true); break; case 2: r = __builtin_amdgcn_update_dpp(0, iv, 0x112, 0xf, 0xf, true); break;
        case 4: r = __builtin_amdgcn_update_dpp(0, iv, 0x114, 0xf, 0xf, true); break; case 8: r = __builtin_amdgcn_update_dpp(0, iv, 0x118, 0xf, 0xf, true); break;
        case 15: r = __builtin_amdgcn_update_dpp(0, iv, 0x142, 0xa, 0xf, false); break; default: r = __builtin_amdgcn_update_dpp(0, iv, 0x143, 0xc, 0xf, false); break; }
    return __builtin_bit_cast(float, r);
}
__device__ __forceinline__ float wave_sum(float v) {
    v += dppf(v, 1); v += dppf(v, 2); v += dppf(v, 4); v += dppf(v, 8); v += dppf(v, 15); v += dppf(v, 31);
    return __builtin_bit_cast(float, __builtin_amdgcn_readlane(__builtin_bit_cast(int, v), 63));
}
__device__ __forceinline__ float bf2f(unsigned short b) { return __uint_as_float(((unsigned)b) << 16); }
__device__ __forceinline__ unsigned pk2(float a, float b) { return pg8::cvt_pk_bf16(a, b); }
__device__ __forceinline__ unsigned pk2s(float a, float b) { unsigned r; asm("v_cvt_pk_bf16_f32 %0, %1, %2" : "=v"(r) : "v"(a), "v"(b)); return r; }
__device__ __forceinline__ float silu_f(float g) { return g * __builtin_amdgcn_rcpf(1.0f + __builtin_amdgcn_exp2f(-1.4426950408889634f * g)); }
__device__ __forceinline__ int dmap(int P) { return ((P >> 2) & 1) * 64 + (P >> 3) * 4 + (P & 3); }
__device__ __forceinline__ int pmap(int d) { return ((d >> 4) & 3) * 32 + ((d >> 2) & 3) * 8 + ((d >> 6) & 1) * 4 + (d & 3); }

constexpr int RB = 6;
__device__ __forceinline__ f32x4 unpack_bf4(const u32x2 w) { f32x4 v; v[0] = __uint_as_float(w.x << 16); v[1] = __uint_as_float(w.x & 0xffff0000u); v[2] = __uint_as_float(w.y << 16); v[3] = __uint_as_float(w.y & 0xffff0000u); return v; }
__device__ __forceinline__ float sumsq4(const f32x4 a) { return (a[0] * a[0] + a[1] * a[1]) + (a[2] * a[2] + a[3] * a[3]); }
template <int MODE> __device__ __forceinline__ int rowmap(int c) {
    if (MODE == 0) { if (c < 1024) return (c & ~127) + pmap(c & 127); return c; }
    if (MODE == 1) return c;
    if (MODE == 2) return ((c >> 7) << 8) + (c & 127);
    return ((c >> 7) << 8) + 128 + (c & 127);
}
template <int MODE, bool GAIN = false>
__device__ __forceinline__ void transpose_item(const float* W, int K, int N, bf16_t* WT, LAS float* scr, int item, int lane, const float* gain = nullptr) {
    const int nblk = N / 32, kb = item / nblk, nb = item % nblk, k0 = 64 * kb, n0 = 32 * nb;
#pragma unroll
    for (int i = 0; i < 32; ++i) { const int kk = 2 * i + (lane >> 5); scr[kk * 33 + (lane & 31)] = W[(size_t)(k0 + kk) * N + n0 + (lane & 31)]; }
    asm volatile("s_waitcnt lgkmcnt(0)" ::: "memory");
    const int c = lane & 7;
    f32x4 ga = (f32x4){1.f, 1.f, 1.f, 1.f}, gb = ga;
    if (GAIN) { ga = *(const f32x4*)(gain + k0 + 8 * c); gb = *(const f32x4*)(gain + k0 + 8 * c + 4); }
#pragma unroll
    for (int j = 0; j < 4; ++j) { const int n = (lane >> 3) + 8 * j; const LAS float* s = scr + (8 * c) * 33 + n;
        u32x4 o; o.x = pk2(s[0 * 33] * ga[0], s[1 * 33] * ga[1]); o.y = pk2(s[2 * 33] * ga[2], s[3 * 33] * ga[3]); o.z = pk2(s[4 * 33] * gb[0], s[5 * 33] * gb[1]); o.w = pk2(s[6 * 33] * gb[2], s[7 * 33] * gb[3]);
        *(u32x4*)(WT + (size_t)rowmap<MODE>(n0 + n) * K + k0 + 8 * c) = o; }
    asm volatile("s_waitcnt lgkmcnt(0)" ::: "memory");
}
__device__ __forceinline__ void phase0(const Params& p, LAS unsigned char* lds, int tid, int wid, int lane) {
    LAS float* scr = (LAS float*)(lds + wid * 8448);
    const int gw = blockIdx.x * 8 + wid, NGW = gridDim.x * 8;
    bf16_t* win = (bf16_t*)(p.ws + WS_WIN); bf16_t* wout = (bf16_t*)(p.ws + WS_WOUT); bf16_t* wff1 = (bf16_t*)(p.ws + WS_WFF1); bf16_t* wdn = (bf16_t*)(p.ws + WS_WDN);
    constexpr int I_IN = 16 * 112, I_OUT = 16 * 32, I_UP = 16 * 128, I_DN = 64 * 32, NITEMS = I_IN + I_OUT + 2 * I_UP + I_DN;
    for (int it = gw; it < NITEMS; it += NGW) {
        int r = it;
        if (r < I_IN) { transpose_item<0>(p.in[5], DM, NIN, win, scr, r, lane); continue; } r -= I_IN;
        if (r < I_OUT) { transpose_item<1>(p.in[6], DM, DM, wout, scr, r, lane); continue; } r -= I_OUT;
        if (r < I_UP) { transpose_item<2, true>(p.in[13], DM, DFF, wff1, scr, r, lane, p.in[11]); continue; } r -= I_UP;
        if (r < I_UP) { transpose_item<3, true>(p.in[14], DM, DFF, wff1, scr, r, lane, p.in[11]); continue; } r -= I_UP;
        transpose_item<1>(p.in[16], DFF, DM, wdn, scr, r, lane);
    }
    float* cosT = (float*)(p.ws + WS_COS); float* sinT = (float*)(p.ws + WS_SIN);
    for (int idx = blockIdx.x * 512 + tid; idx < 4112 * 64; idx += gridDim.x * 512) {
        const int pos = idx >> 6, f = idx & 63;
        const float inv = exp2f(-(float)(2 * f) * (1.0f / 128.0f) * 13.287712379549449f);
        const float ang = (float)pos * inv;
        const double rev = (double)ang * 0.15915494309189535;
        const float fr = (float)(rev - floor(rev));
        cosT[idx] = __builtin_amdgcn_cosf(fr); sinT[idx] = __builtin_amdgcn_sinf(fr);
    }
    bf16_t* H = (bf16_t*)(p.ws + WS_RA);
    const float* wpre = p.in[9];
    f32x4 wpr[4];
#pragma unroll
    for (int j = 0; j < 4; ++j) wpr[j] = *((const f32x4*)wpre + lane + 64 * j);
#pragma unroll 1
    for (int base = gw; base < TOK; base += RB * NGW) {
        f32x4 v[RB][4]; float s[RB];
#pragma unroll
        for (int k = 0; k < RB; ++k) { const int rr = min(base + k * NGW, TOK - 1);
            const float* xrow = rr < TOK_P ? p.in[0] + (size_t)rr * DM : p.in[1] + (size_t)(rr - TOK_P) * DM; s[k] = 0.f;
#pragma unroll
            for (int j = 0; j < 4; ++j) { v[k][j] = __builtin_nontemporal_load((const f32x4*)xrow + lane + 64 * j); s[k] += sumsq4(v[k][j]); } }
#pragma unroll
        for (int k = 0; k < RB; ++k) { const int r = base + k * NGW; const float rstd = rsqrtf(wave_sum(s[k]) * (1.0f / DM) + EPS);
            if (r < TOK) {
#pragma unroll
                for (int j = 0; j < 4; ++j) { const f32x4 y = (v[k][j] * rstd) * wpr[j];
                    __builtin_nontemporal_store((u32x2){pk2(y[0], y[1]), pk2(y[2], y[3])}, (u32x2*)(H + (size_t)r * DM) + lane + 64 * j); } } }
    }
}

constexpr int QI_OFF = 0, KI_OFF = 17408, KT_OFF = 34816, VT_OFF = 53248, SI_OFF = 71680, ST_OFF = 80896, GI_OFF = 115712;
#define MFMA16(a, b, c) __builtin_amdgcn_mfma_f32_16x16x32_bf16((a), (b), (c), 0, 0, 0)
#define RET_ISSUE(S, nn) do { _Pragma("unroll") for (int i_ = 0; i_ < 2; ++i_) { \
        const bf16_t* rowp_ = P + (tok0 + (size_t)(nn) * 64 + 2 * (tid >> 4) + i_) * NIN + 128 * h + (tid & 15) * 8; \
        if (FULL) { rq[S][i_] = *(const u32x4*)rowp_; rg[S][i_] = *(const u32x4*)(rowp_ + 1536); } rk[S][i_] = *(const u32x4*)(rowp_ + 512); rv[S][i_] = *(const u32x4*)(rowp_ + 1024); } } while (0)
#define RET_STAGE_A(S) do { const int j_ = 2 * (tid >> 4), ch_ = tid & 15; \
        if (FULL) { _Pragma("unroll") for (int i_ = 0; i_ < 2; ++i_) { *(LAS u32x4*)(lds + QI_OFF + (j_ + i_) * 272 + ch_ * 16) = rq[S][i_]; *(LAS u32x4*)(lds + KI_OFF + (j_ + i_) * 272 + ch_ * 16) = rk[S][i_]; *(LAS u32x4*)(lds + GI_OFF + (j_ + i_) * 272 + ch_ * 16) = rg[S][i_]; } } \
        const float te0_ = __builtin_amdgcn_exp2f(l2g * (float)(63 - j_)), te1_ = __builtin_amdgcn_exp2f(l2g * (float)(62 - j_)); \
        const unsigned ka_[4] = {rk[S][0].x, rk[S][0].y, rk[S][0].z, rk[S][0].w}, kb_[4] = {rk[S][1].x, rk[S][1].y, rk[S][1].z, rk[S][1].w}; \
        const unsigned va_[4] = {rv[S][0].x, rv[S][0].y, rv[S][0].z, rv[S][0].w}, vb_[4] = {rv[S][1].x, rv[S][1].y, rv[S][1].z, rv[S][1].w}; \
        const int cofs_ = 16 * ((j_ >> 3) ^ (ch_ & 7)) + 2 * (j_ & 7); \
        _Pragma("unroll") for (int e2 = 0; e2 < 4; ++e2) { const int row_ = 8 * ch_ + 2 * e2; \
            *(LAS unsigned*)(lds + KT_OFF + row_ * 144 + cofs_) = pk2(__uint_as_float(ka_[e2] << 16) * te0_, __uint_as_float(kb_[e2] << 16) * te1_); \
            *(LAS unsigned*)(lds + KT_OFF + (row_ + 1) * 144 + cofs_) = pk2(__uint_as_float(ka_[e2] & 0xffff0000u) * te0_, __uint_as_float(kb_[e2] & 0xffff0000u) * te1_); \
            *(LAS unsigned*)(lds + VT_OFF + row_ * 144 + cofs_) = (va_[e2] & 0xffffu) | (vb_[e2] << 16); \
            *(LAS unsigned*)(lds + VT_OFF + (row_ + 1) * 144 + cofs_) = (va_[e2] >> 16) | (vb_[e2] & 0xffff0000u); } } while (0)
#define WG_BAR() do { asm volatile("s_waitcnt lgkmcnt(0)" ::: "memory"); __builtin_amdgcn_s_barrier(); asm volatile("" ::: "memory"); } while (0)
template <bool FULL>
__device__ __forceinline__ void ret_unit(const Params& p, LAS unsigned char* lds, int unit, int tid, int wid, int lane) {
    asm volatile("" : "+v"(tid), "+v"(lane));
    const int G = unit & 7, h = (unit >> 3) & 3, b = unit >> 5;
    const bf16_t* P = (const bf16_t*)(p.ws + WS_RB);
    bf16_t* MIX = (bf16_t*)(p.ws + WS_RA);
    float* UG = (float*)(p.ws + WS_UG);
    const size_t tok0 = (size_t)b * 4096 + (size_t)G * 512;
    const float l2g = log2f(1.0f - exp2f(-5.0f - (float)h));
    const float g64 = __builtin_amdgcn_exp2f(l2g * 64.0f);
    const bool is_state = wid >= 4; const int w4 = wid & 3;
    const int l15 = lane & 15, l4 = lane >> 4;
    const int vtL = l4 ^ (l15 >> 3);
    const int vtb0 = VT_OFF + l15 * 144 + 16 * vtL, vtb1 = VT_OFF + l15 * 144 + 16 * (vtL ^ 2);
#define VT_ADDR(nt, ks) ((((nt) & 1) ? vtb1 : vtb0) + (nt) * 2304 + 16 * (((4 * (ks)) ^ (2 * ((nt) & 3))) & 4))
    constexpr int PD = FULL ? 1 : 4;
    u32x4 rq[PD][2], rk[PD][2], rv[PD][2], rg[PD][2];
    if (is_state) {
        f32x4 st[2][8];
#pragma unroll
        for (int mt = 0; mt < 2; ++mt)
#pragma unroll
            for (int nt = 0; nt < 8; ++nt) st[mt][nt] = (f32x4){0.f, 0.f, 0.f, 0.f};
        if (FULL) {
#pragma unroll 1
            for (int Gp = 0; Gp < G; Gp += 2) {
                const float wa = __builtin_amdgcn_exp2f(l2g * 512.0f * (float)(G - 1 - Gp));
                const bool two = Gp + 1 < G;
                const float wb = two ? __builtin_amdgcn_exp2f(l2g * 512.0f * (float)(G - 2 - Gp)) : 0.f;
                const u32x2* sa = (const u32x2*)UG + ((size_t)((b * 4 + h) * 8 + Gp) * 4 + w4) * 1024 + lane;
                const u32x2* sb = two ? sa + 4 * 1024 : sa;
#pragma unroll
                for (int mt = 0; mt < 2; ++mt)
#pragma unroll
                    for (int nt = 0; nt < 8; ++nt) st[mt][nt] += unpack_bf4(sa[(mt * 8 + nt) * 64]) * wa + unpack_bf4(sb[(mt * 8 + nt) * 64]) * wb;
            }
        }
#pragma unroll
        for (int s = 0; s < PD; ++s) RET_ISSUE(s, s);
#pragma unroll 1
        for (int n0 = 0; n0 < 8; n0 += PD) {
#pragma unroll
          for (int s = 0; s < PD; ++s) { const int n = n0 + s;
            RET_STAGE_A(s);
            if (n + PD < 8) RET_ISSUE(s, n + PD);
            if (FULL) {
#pragma unroll
                for (int mt = 0; mt < 2; ++mt)
#pragma unroll
                    for (int nt = 0; nt < 8; ++nt) { const int e = 16 * nt + l15, dk0 = 32 * w4 + 16 * mt + 4 * l4;
                        *(LAS u32x2*)(lds + ST_OFF + e * 272 + dk0 * 2) = (u32x2){pk2(st[mt][nt][0], st[mt][nt][1]), pk2(st[mt][nt][2], st[mt][nt][3])}; }
            }
            WG_BAR();
            if (FULL) {
                bf16x8 ak[4];
#pragma unroll
                for (int ks = 0; ks < 4; ++ks) ak[ks] = *(const LAS bf16x8*)(lds + KI_OFF + (16 * w4 + l15) * 272 + (32 * ks + 8 * l4) * 2);
#pragma unroll
                for (int it = 0; it < 4; ++it) {
                    bf16x8 bq[4];
#pragma unroll
                    for (int ks = 0; ks < 4; ++ks) bq[ks] = *(const LAS bf16x8*)(lds + QI_OFF + (16 * it + l15) * 272 + (32 * ks + 8 * l4) * 2);
                    f32x4 sa = (f32x4){0.f, 0.f, 0.f, 0.f};
#pragma unroll
                    for (int ks = 0; ks < 4; ++ks) sa = MFMA16(ak[ks], bq[ks], sa);
                    const int i = 16 * it + l15, j0 = 16 * w4 + 4 * l4;
#pragma unroll
                    for (int r = 0; r < 4; ++r) { const int d = i - (j0 + r); sa[r] *= __builtin_amdgcn_exp2f(l2g * (float)(d < 0 ? -d : d)); }
                    *(LAS u32x2*)(lds + SI_OFF + i * 144 + j0 * 2) = (u32x2){pk2(sa[0], sa[1]), pk2(sa[2], sa[3])};
                }
            }
            WG_BAR();
#pragma unroll
            for (int mt = 0; mt < 2; ++mt)
#pragma unroll
                for (int nt = 0; nt < 8; ++nt) st[mt][nt] = st[mt][nt] * g64;
#pragma unroll
            for (int ks = 0; ks < 2; ++ks) {
                bf16x8 akt[2];
#pragma unroll
                for (int mt = 0; mt < 2; ++mt) { const int row = 32 * w4 + 16 * mt + l15; akt[mt] = *(const LAS bf16x8*)(lds + KT_OFF + row * 144 + 16 * ((4 * ks + l4) ^ ((row >> 3) & 7))); }
#pragma unroll
                for (int nh = 0; nh < 2; ++nh) {
                    bf16x8 bv[4];
#pragma unroll
                    for (int nt = 0; nt < 4; ++nt) bv[nt] = *(const LAS bf16x8*)(lds + VT_ADDR(4 * nh + nt, ks));
#pragma unroll
                    for (int nt = 0; nt < 4; ++nt)
#pragma unroll
                        for (int mt = 0; mt < 2; ++mt) st[mt][4 * nh + nt] = MFMA16(akt[mt], bv[nt], st[mt][4 * nh + nt]);
                }
            }
            WG_BAR();
          }
        }
        if (!FULL) {
            u32x2* dst = (u32x2*)UG + ((size_t)unit * 4 + w4) * 1024 + lane;
#pragma unroll
            for (int mt = 0; mt < 2; ++mt)
#pragma unroll
                for (int nt = 0; nt < 8; ++nt) dst[(mt * 8 + nt) * 64] = (u32x2){pk2(st[mt][nt][0], st[mt][nt][1]), pk2(st[mt][nt][2], st[mt][nt][3])};
        } else if (G == 7) {
            float* o = p.out + O_SRP + (size_t)(b * 4 + h) * 16384 + (64 * (l4 & 1) + 16 * w4 + 4 * (l4 >> 1)) * 128 + l15;
#pragma unroll
            for (int mt = 0; mt < 2; ++mt)
#pragma unroll
                for (int nt = 0; nt < 8; ++nt)
#pragma unroll
                    for (int r = 0; r < 4; ++r) o[(8 * mt + r) * 128 + 16 * nt] = st[mt][nt][r];
        }
    } else {
        float rwv[8];
#pragma unroll
        for (int nt = 0; nt < 8; ++nt) rwv[nt] = p.in[8][128 * h + 16 * nt + l15];
#pragma unroll
        for (int s = 0; s < PD; ++s) RET_ISSUE(s, s);
#pragma unroll 1
        for (int n0 = 0; n0 < 8; n0 += PD) {
#pragma unroll
          for (int s = 0; s < PD; ++s) { const int n = n0 + s;
            RET_STAGE_A(s);
            if (n + PD < 8) RET_ISSUE(s, n + PD);
            WG_BAR();
            f32x4 acc[8];
            if (FULL) {
                f32x4 fsv;
#pragma unroll
                for (int r = 0; r < 4; ++r) fsv[r] = __builtin_amdgcn_exp2f(l2g * (float)(16 * w4 + 4 * l4 + r + 1));
#pragma unroll
                for (int nt = 0; nt < 8; ++nt) acc[nt] = (f32x4){0.f, 0.f, 0.f, 0.f};
                bf16x8 aq[4];
#pragma unroll
                for (int ks = 0; ks < 4; ++ks) aq[ks] = *(const LAS bf16x8*)(lds + QI_OFF + (16 * w4 + l15) * 272 + (32 * ks + 8 * l4) * 2);
#pragma unroll
                for (int ks = 0; ks < 4; ++ks)
#pragma unroll
                    for (int nh = 0; nh < 2; ++nh) {
                        bf16x8 bs[4];
#pragma unroll
                        for (int nt = 0; nt < 4; ++nt) bs[nt] = *(const LAS bf16x8*)(lds + ST_OFF + (16 * (4 * nh + nt) + l15) * 272 + (32 * ks + 8 * l4) * 2);
#pragma unroll
                        for (int nt = 0; nt < 4; ++nt) acc[4 * nh + nt] = MFMA16(aq[ks], bs[nt], acc[4 * nh + nt]);
                    }
#pragma unroll
                for (int nt = 0; nt < 8; ++nt) acc[nt] = acc[nt] * fsv;
            }
            WG_BAR();
            if (FULL) {
                bf16x8 as_[2];
#pragma unroll
                for (int ks = 0; ks < 2; ++ks) as_[ks] = *(const LAS bf16x8*)(lds + SI_OFF + (16 * w4 + l15) * 144 + 16 * (4 * ks + l4));
#pragma unroll
                for (int ks = 0; ks < 2; ++ks)
#pragma unroll
                    for (int nh = 0; nh < 2; ++nh) {
                        bf16x8 bv[4];
#pragma unroll
                        for (int nt = 0; nt < 4; ++nt) bv[nt] = *(const LAS bf16x8*)(lds + VT_ADDR(4 * nh + nt, ks));
#pragma unroll
                        for (int nt = 0; nt < 4; ++nt) acc[4 * nh + nt] = MFMA16(as_[ks], bv[nt], acc[4 * nh + nt]);
                    }
                unsigned short gq[4][8];
#pragma unroll
                for (int r = 0; r < 4; ++r)
#pragma unroll
                    for (int nt = 0; nt < 8; ++nt) gq[r][nt] = *(const LAS unsigned short*)(lds + GI_OFF + (16 * w4 + 4 * l4 + r) * 272 + (16 * nt + l15) * 2);
                float rstd[4];
#pragma unroll
                for (int r = 0; r < 4; ++r) { float ss = 0.f;
#pragma unroll
                    for (int nt = 0; nt < 8; ++nt) ss += acc[nt][r] * acc[nt][r];
                    ss += dppf(ss, 1); ss += dppf(ss, 2); ss += dppf(ss, 4); ss += dppf(ss, 8);
                    ss = __shfl(ss, (lane & 48) | 15);
                    rstd[r] = rsqrtf(ss * (1.0f / 128.0f) + EPS); }
#pragma unroll
                for (int r = 0; r < 4; ++r)
#pragma unroll
                    for (int nt = 0; nt < 8; ++nt)
                        *(LAS unsigned short*)(lds + QI_OFF + (16 * w4 + 4 * l4 + r) * 272 + (16 * nt + l15) * 2) = (unsigned short)(pk2s(acc[nt][r] * rstd[r] * rwv[nt] * silu_f(bf2f(gq[r][nt])), 0.f) & 0xffffu);
#pragma unroll
                for (int q = 0; q < 4; ++q) { const int cidx = lane + 64 * q, row = 16 * w4 + (cidx >> 4), ch = cidx & 15;
                    const u32x4 v = *(const LAS u32x4*)(lds + QI_OFF + row * 272 + ch * 16);
                    *(u32x4*)(MIX + (tok0 + (size_t)n * 64 + row) * DM + 128 * h + ch * 8) = v; }
            }
            WG_BAR();
          }
        }
    }
#ifndef CONVREP
#define CONVREP 1
#endif
    if (FULL) for (int crep_ = 0; crep_ < CONVREP; ++crep_) {
        const int c0 = 128 * h + 8 * (tid & 15), run = tid >> 4, t0 = G * 512 + run * 16;
        const float* cwp = p.in[7];
        float w0[8], w1[8], w2[8], p1[8], p2[8];
#pragma unroll
        for (int e = 0; e < 8; ++e) { w0[e] = cwp[c0 + e]; w1[e] = cwp[512 + c0 + e]; w2[e] = cwp[1024 + c0 + e]; p1[e] = 0.f; p2[e] = 0.f; }
        if (t0 > 0) {
            const bf16_t* r2 = P + ((size_t)b * 4096 + t0 - 2) * NIN; const bf16_t* r1 = r2 + NIN;
            const u32x4 c2 = *(const u32x4*)(r2 + 2560 + c0), h2 = *(const u32x4*)(r2 + 3072 + c0), c1 = *(const u32x4*)(r1 + 2560 + c0), h1 = *(const u32x4*)(r1 + 3072 + c0);
            const unsigned c2w[4] = {c2.x, c2.y, c2.z, c2.w}, h2w[4] = {h2.x, h2.y, h2.z, h2.w}, c1w[4] = {c1.x, c1.y, c1.z, c1.w}, h1w[4] = {h1.x, h1.y, h1.z, h1.w};
#pragma unroll
            for (int e = 0; e < 4; ++e) {
                p2[2 * e] = __uint_as_float(c2w[e] << 16) * __uint_as_float(h2w[e] << 16); p2[2 * e + 1] = __uint_as_float(c2w[e] & 0xffff0000u) * __uint_as_float(h2w[e] & 0xffff0000u);
                p1[2 * e] = __uint_as_float(c1w[e] << 16) * __uint_as_float(h1w[e] << 16); p1[2 * e + 1] = __uint_as_float(c1w[e] & 0xffff0000u) * __uint_as_float(h1w[e] & 0xffff0000u); }
        }
#pragma unroll 8
        for (int t = 0; t < 16; ++t) {
            const size_t row = (size_t)b * 4096 + t0 + t;
            const bf16_t* rp = P + row * NIN;
            const u32x4 bb = *(const u32x4*)(rp + 2048 + c0), cc = *(const u32x4*)(rp + 2560 + c0), hh = *(const u32x4*)(rp + 3072 + c0);
            const unsigned bw[4] = {bb.x, bb.y, bb.z, bb.w}, cw4[4] = {cc.x, cc.y, cc.z, cc.w}, hw[4] = {hh.x, hh.y, hh.z, hh.w};
            float y[8];
#pragma unroll
            for (int e = 0; e < 4; ++e) {
                const float ca = __uint_as_float(cw4[e] << 16) * __uint_as_float(hw[e] << 16), cb = __uint_as_float(cw4[e] & 0xffff0000u) * __uint_as_float(hw[e] & 0xffff0000u);
                y[2 * e] = __uint_as_float(bw[e] << 16) * (w0[2 * e] * p2[2 * e] + w1[2 * e] * p1[2 * e] + w2[2 * e] * ca);
                y[2 * e + 1] = __uint_as_float(bw[e] & 0xffff0000u) * (w0[2 * e + 1] * p2[2 * e + 1] + w1[2 * e + 1] * p1[2 * e + 1] + w2[2 * e + 1] * cb);
                p2[2 * e] = p1[2 * e]; p2[2 * e + 1] = p1[2 * e + 1]; p1[2 * e] = ca; p1[2 * e + 1] = cb;
            }
            *(u32x4*)(MIX + row * DM + 512 + c0) = (u32x4){pk2(y[0], y[1]), pk2(y[2], y[3]), pk2(y[4], y[5]), pk2(y[6], y[7])};
        }
        if (G == 7 && run == 31) {
            float* o = p.out + O_CCP + (size_t)b * 1024 + c0;
#pragma unroll
            for (int e = 0; e < 8; ++e) { o[e] = p2[e]; o[512 + e] = p1[e]; }
        }
    }
#undef VT_ADDR
}

__device__ __forceinline__ float ch_at(const float* PS, const float* cache, int b, int t, int ch) {
    if (t < 0) return cache[(b * 2 + (t + 2)) * 512 + ch];
    const float* rp = PS + (size_t)(16 * b + t) * NIN;
    return rp[2560 + ch] * rp[3072 + ch];
}
__device__ __forceinline__ void sample_unit(const Params& p, LAS unsigned char* lds, int sup, int tid, int wid, int lane) {
    const int su = sup >> 2, part = sup & 3;
    const int b = su >> 2, h = su & 3, ts0 = TOK_P + 16 * b;
    const float* PS = (const float*)(p.ws + WS_PS);
    bf16_t* MIX = (bf16_t*)(p.ws + WS_RA);
    LAS float* qs = (LAS float*)lds; LAS float* ks = qs + 2048; LAS float* vs = qs + 4096; LAS float* Ssm = qs + 6144; LAS float* osm = qs + 6400;
    const float l2g = log2f(1.0f - exp2f(-5.0f - (float)h));
    const float* cosT = (const float*)(p.ws + WS_COS); const float* sinT = (const float*)(p.ws + WS_SIN);
    for (int idx = tid; idx < 2048; idx += 512) { const int i = idx >> 7, c = idx & 127, d = dmap(c);
        const float* rp = PS + (size_t)(16 * b + i) * NIN + 128 * h;
        const float cs = cosT[(4096 + i) * 64 + (d & 63)], sn = sinT[(4096 + i) * 64 + (d & 63)];
        const float xq = rp[c], xqp = rp[c ^ 4], xk = rp[512 + c], xkp = rp[512 + (c ^ 4)];
        qs[i * 128 + d] = d < 64 ? xq * cs - xqp * sn : xq * cs + xqp * sn;
        ks[i * 128 + d] = (d < 64 ? xk * cs - xkp * sn : xk * cs + xkp * sn) * 0.08838834764831845f;
        vs[i * 128 + c] = rp[1024 + c]; }
    const int e = tid & 127, sub = tid >> 7, irow = 4 * part + sub;
    LAS float* s0 = qs + 8704;
    { const float* s0g = p.in[2] + (size_t)su * 16384; f32x4 t8[8];
#pragma unroll
      for (int q = 0; q < 8; ++q) t8[q] = *((const f32x4*)s0g + tid + 512 * q);
#pragma unroll
      for (int q = 0; q < 8; ++q) *((LAS f32x4*)s0 + tid + 512 * q) = t8[q]; }
    __syncthreads();
    if (tid < 64) { const int i = 4 * part + (tid >> 4), j = tid & 15; float s = 0.f;
        for (int d = 0; d < 128; ++d) s += qs[i * 128 + d] * ks[j * 128 + d];
        const int dd = i - j; Ssm[i * 16 + j] = s * __builtin_amdgcn_exp2f(l2g * (float)(dd < 0 ? -dd : dd)); }
    float cr = 0.f;
#pragma unroll 8
    for (int d = 0; d < 128; ++d) cr += qs[irow * 128 + d] * s0[d * 128 + e];
    __syncthreads();
    { float o = 0.f;
      for (int j = 0; j < 16; ++j) o += Ssm[irow * 16 + j] * vs[j * 128 + e];
      osm[irow * 128 + e] = o + __builtin_amdgcn_exp2f(l2g * (float)(irow + 1)) * cr; }
    __syncthreads();
    if (wid < 4) { const int i = 4 * part + wid; const float v0 = osm[i * 128 + lane], v1 = osm[i * 128 + 64 + lane];
        const float rstd = rsqrtf(wave_sum(v0 * v0 + v1 * v1) * (1.0f / 128.0f) + EPS);
        const size_t token = (size_t)(ts0 + i);
        const float g0 = PS[(size_t)(16 * b + i) * NIN + 1536 + 128 * h + lane], g1 = PS[(size_t)(16 * b + i) * NIN + 1536 + 128 * h + 64 + lane];
        MIX[token * DM + 128 * h + lane] = (bf16_t)(pk2(v0 * rstd * p.in[8][128 * h + lane] * silu_f(g0), 0.f) & 0xffffu);
        MIX[token * DM + 128 * h + 64 + lane] = (bf16_t)(pk2(v1 * rstd * p.in[8][128 * h + 64 + lane] * silu_f(g1), 0.f) & 0xffffu); }
    const float g16 = __builtin_amdgcn_exp2f(l2g * 16.0f);
    float* outS = p.out + O_SRS + (size_t)su * 16384;
#pragma unroll 2
    for (int dd = 0; dd < 8; ++dd) { const int d = 32 * part + sub + 4 * dd; float a = g16 * s0[d * 128 + e];
        for (int j = 0; j < 16; ++j) a += __builtin_amdgcn_exp2f(l2g * (float)(15 - j)) * ks[j * 128 + d] * vs[j * 128 + e];
        outS[d * 128 + e] = a; }
    { const int ch = 128 * h + e; const float* cache = p.in[3]; const float* cwp = p.in[7];
      const float w0 = cwp[ch], w1 = cwp[512 + ch], w2 = cwp[1024 + ch];
      const int t = irow;
      const float c0 = ch_at(PS, cache, b, t - 2, ch), c1 = ch_at(PS, cache, b, t - 1, ch), c2 = ch_at(PS, cache, b, t, ch);
      const float y = PS[(size_t)(16 * b + t) * NIN + 2048 + ch] * (w0 * c0 + w1 * c1 + w2 * c2);
      MIX[(size_t)(ts0 + t) * DM + 512 + ch] = (bf16_t)(pk2(y, 0.f) & 0xffffu);
      if (t >= 14) p.out[O_CCS + (size_t)(b * 2 + t - 14) * 512 + ch] = c2; }
    __syncthreads();
}

constexpr int TG_B = 34816, TG_BUF = 34816 + 32 * 272;
template <int NB>
__device__ __forceinline__ void thin_gemm2(LAS unsigned char* lds, const bf16_t* A, int lda, const bf16_t* Bt, int ldb, int n0, int nbstride, int kbeg, int klen, f32x4 (&acc)[NB], int tid, int wid, int lane) {
    const int l15 = lane & 15, l4 = lane >> 4, nkb = klen >> 7;
    const bool hasb = tid < NB * 256;
    const bf16_t* ag = A + (size_t)(tid >> 4) * lda + kbeg + (tid & 15) * 8;
    const bf16_t* bg = Bt + (size_t)(n0 + (tid >> 8) * nbstride + ((tid >> 4) & 15)) * ldb + kbeg + (tid & 15) * 8;
    const int sto = (tid >> 4) * 272 + (tid & 15) * 16;
    const int fro = l15 * 272 + (8 * l4) * 2;
    u32x4 Xa[4], Ya[4], Xb = (u32x4){0u, 0u, 0u, 0u}, Yb = Xb;
#define TG_LOAD(R, kb) do { _Pragma("unroll") for (int i_ = 0; i_ < 4; ++i_) R##a[i_] = *(const u32x4*)(ag + (size_t)(32 * i_) * lda + (kb) * 128); if (hasb) R##b = *(const u32x4*)(bg + (kb) * 128); } while (0)
#define TG_STORE(R, buf) do { _Pragma("unroll") for (int i_ = 0; i_ < 4; ++i_) *(LAS u32x4*)(lds + (buf) * TG_BUF + sto + i_ * 32 * 272) = R##a[i_]; if (hasb) *(LAS u32x4*)(lds + (buf) * TG_BUF + TG_B + sto) = R##b; } while (0)
#define TG_COMP(buf) do { _Pragma("unroll") for (int ks = 0; ks < 4; ++ks) { const bf16x8 a_ = *(const LAS bf16x8*)(lds + (buf) * TG_BUF + 16 * wid * 272 + fro + ks * 64); \
        _Pragma("unroll") for (int nb = 0; nb < NB; ++nb) { const bf16x8 b_ = *(const LAS bf16x8*)(lds + (buf) * TG_BUF + TG_B + 16 * nb * 272 + fro + ks * 64); acc[nb] = MFMA16(a_, b_, acc[nb]); } } } while (0)
#pragma unroll
    for (int nb = 0; nb < NB; ++nb) acc[nb] = (f32x4){0.f, 0.f, 0.f, 0.f};
    TG_LOAD(X, 0); TG_LOAD(Y, 1);
    TG_STORE(X, 0); WG_BAR();
#pragma unroll 1
    for (int kb = 0; kb < nkb; kb += 2) {
        if (kb + 2 < nkb) TG_LOAD(X, kb + 2);
        TG_COMP(0);
        TG_STORE(Y, 1); WG_BAR();
        if (kb + 3 < nkb) TG_LOAD(Y, kb + 3);
        TG_COMP(1);
        if (kb + 2 < nkb) TG_STORE(X, 0);
        WG_BAR();
    }
#undef TG_LOAD
#undef TG_STORE
#undef TG_COMP
}
template <int NB>
__device__ __forceinline__ void thin_gemm(const bf16_t* A, int lda, const bf16_t* Bt, int ldb, int n0, int nbstride, int kbeg, int klen, f32x4 (&acc)[NB], int wid, int lane) {
    const int l15 = lane & 15, l4 = lane >> 4;
    const bf16_t* ap = A + (size_t)(16 * wid + l15) * lda + kbeg + 8 * l4;
    const bf16_t* bp = Bt + (size_t)(n0 + l15) * ldb + kbeg + 8 * l4;
#pragma unroll
    for (int nb = 0; nb < NB; ++nb) acc[nb] = (f32x4){0.f, 0.f, 0.f, 0.f};
#pragma unroll 1
    for (int s0 = 0; s0 < klen; s0 += 256) {
        bf16x8 a[8], b[NB][8];
#pragma unroll
        for (int s = 0; s < 8; ++s) { a[s] = *(const bf16x8*)(ap + s0 + 32 * s);
#pragma unroll
            for (int nb = 0; nb < NB; ++nb) b[nb][s] = *(const bf16x8*)(bp + (size_t)nb * nbstride * ldb + s0 + 32 * s); }
#pragma unroll
        for (int s = 0; s < 8; ++s)
#pragma unroll
            for (int nb = 0; nb < NB; ++nb) acc[nb] = MFMA16(a[s], b[nb][s], acc[nb]);
    }
}
__device__ __forceinline__ void thin_store(const f32x4& acc, float* out, int ldo, int col, int wid, int lane) {
#pragma unroll
    for (int r = 0; r < 4; ++r) out[(size_t)(16 * wid + 4 * (lane >> 4) + r) * ldo + col + (lane & 15)] = acc[r];
}
__device__ __forceinline__ void thin_ffn1(const Params& p, LAS unsigned char* lds, int c, int tid, int wid, int lane) {
    const int pn = c >> 3, j16 = c & 7, l15 = lane & 15, l4 = lane >> 4;
    f32x4 acc[2];
    thin_gemm2<2>(lds, (const bf16_t*)(p.ws + WS_Y) + (size_t)TOK_P * DM, DM, (const bf16_t*)(p.ws + WS_WFF1), DM, 256 * pn + 16 * j16, 128, 0, DM, acc, tid, wid, lane);
    const int ch = 128 * pn + 16 * j16 + l15, b = wid;
    const float* cw = p.in[15]; const float* cache = p.in[4] + (size_t)b * 2 * DFF + ch;
    const float w0 = cw[ch], w1 = cw[DFF + ch], w2 = cw[2 * DFF + ch];
    const f32x4 up = acc[0], gt = acc[1];
    float pm1 = __shfl_up(up[3], 16), pm2 = __shfl_up(up[2], 16);
    if (l4 == 0) { pm1 = cache[DFF]; pm2 = cache[0]; }
    float uc[4];
    uc[0] = w0 * pm2 + w1 * pm1 + w2 * up[0];
    uc[1] = w0 * pm1 + w1 * up[0] + w2 * up[1];
    uc[2] = w0 * up[0] + w1 * up[1] + w2 * up[2];
    uc[3] = w0 * up[1] + w1 * up[2] + w2 * up[3];
    bf16_t* ACT = (bf16_t*)(p.ws + WS_RB);
#pragma unroll
    for (int r = 0; r < 4; ++r) ACT[(size_t)(TOK_P + 16 * wid + 4 * l4 + r) * DFF + ch] = (bf16_t)(pk2(pg8::gelu_tanh(uc[r]) * gt[r], 0.f) & 0xffffu);
    if (l4 == 3) { float* o = p.out + O_CFS + (size_t)b * 2 * DFF + ch; o[0] = up[2]; o[DFF] = up[3]; }
}

__device__ __forceinline__ void phase4(const Params& p, int wid, int lane) {
    const int gw = blockIdx.x * 8 + wid, NGW = gridDim.x * 8;
    bf16_t* Y = (bf16_t*)(p.ws + WS_Y); const float* ssq = (const float*)(p.ws + WS_SSQ1); float* RS2 = (float*)(p.ws + WS_RS2);
    const float* wpost = p.in[10];
    f32x4 wpo[4];
#pragma unroll
    for (int j = 0; j < 4; ++j) wpo[j] = *((const f32x4*)wpost + lane + 64 * j);
#pragma unroll 1
    for (int base = gw; base < TOK_P; base += RB * NGW) {
        f32x4 v[RB][4]; u32x2 yw[RB][4]; float sq[RB];
#pragma unroll
        for (int k = 0; k < RB; ++k) { const int rr = min(base + k * NGW, TOK_P - 1);
            sq[k] = lane < 16 ? ssq[(size_t)rr * 16 + lane] : 0.f;
#pragma unroll
            for (int j = 0; j < 4; ++j) { v[k][j] = __builtin_nontemporal_load((const f32x4*)(p.in[0] + (size_t)rr * DM) + lane + 64 * j); yw[k][j] = __builtin_nontemporal_load((const u32x2*)(Y + (size_t)rr * DM) + lane + 64 * j); } }
        float s2[RB];
#pragma unroll
        for (int k = 0; k < RB; ++k) { const float rstd1 = rsqrtf(wave_sum(sq[k]) * (1.0f / DM) + EPS); s2[k] = 0.f;
#pragma unroll
            for (int j = 0; j < 4; ++j) { v[k][j] = v[k][j] + (unpack_bf4(yw[k][j]) * rstd1) * wpo[j]; s2[k] += sumsq4(v[k][j]); } }
#pragma unroll
        for (int k = 0; k < RB; ++k) { const int r = base + k * NGW; const float rstd2 = rsqrtf(wave_sum(s2[k]) * (1.0f / DM) + EPS);
            if (r < TOK_P) {
                if (lane == 0) RS2[r] = rstd2;
#pragma unroll
                for (int j = 0; j < 4; ++j) *((u32x2*)(Y + (size_t)r * DM) + lane + 64 * j) = (u32x2){pk2(v[k][j][0], v[k][j][1]), pk2(v[k][j][2], v[k][j][3])}; } }
    }
    for (int r = TOK_P + gw; r < TOK; r += NGW) {
        const float* xrow = p.in[1] + (size_t)(r - TOK_P) * DM; const float* ys = (const float*)(p.ws + WS_YS) + (size_t)(r - TOK_P) * DM;
        f32x4 yv[4], v[4]; float s = 0.f, s2 = 0.f;
#pragma unroll
        for (int j = 0; j < 4; ++j) { f32x4 a = *((const f32x4*)ys + lane + 64 * j);
#pragma unroll
            for (int q = 1; q < 4; ++q) a += *((const f32x4*)(ys + (size_t)q * 128 * DM) + lane + 64 * j);
            yv[j] = a; s += sumsq4(a); }
        const float rstd1 = rsqrtf(wave_sum(s) * (1.0f / DM) + EPS);
#pragma unroll
        for (int j = 0; j < 4; ++j) { v[j] = *((const f32x4*)xrow + lane + 64 * j) + (yv[j] * rstd1) * wpo[j]; s2 += sumsq4(v[j]);
 }
        const float rstd2 = rsqrtf(wave_sum(s2) * (1.0f / DM) + EPS);
#pragma unroll
        for (int j = 0; j < 4; ++j) { const f32x4 y = v[j] * rstd2; *((u32x2*)(Y + (size_t)r * DM) + lane + 64 * j) = (u32x2){pk2(y[0], y[1]), pk2(y[2], y[3])}; }
    }
}
__device__ __forceinline__ void phase7(const Params& p, int wid, int lane) {
    const int gw = blockIdx.x * 8 + wid, NGW = gridDim.x * 8;
    const bf16_t* F = (const bf16_t*)(p.ws + WS_RA); const bf16_t* Y = (const bf16_t*)(p.ws + WS_Y);
    const float* ssq1 = (const float*)(p.ws + WS_SSQ1); const float* ssq2 = (const float*)(p.ws + WS_SSQ2);
    f32x4 wm[4], wf[4];
#pragma unroll
    for (int j = 0; j < 4; ++j) { wm[j] = *((const f32x4*)p.in[10] + lane + 64 * j); wf[j] = *((const f32x4*)p.in[12] + lane + 64 * j); }
    constexpr int RB7 = 6;
#pragma unroll 1
    for (int base = gw; base < TOK_P; base += RB7 * NGW) {
        u32x2 xw[RB7][4], fw[RB7][4]; float sq2[RB7];
#pragma unroll
        for (int k = 0; k < RB7; ++k) { const int rr = min(base + k * NGW, TOK_P - 1);
            sq2[k] = lane < 16 ? ssq2[(size_t)rr * 16 + lane] : 0.f;
#pragma unroll
            for (int j = 0; j < 4; ++j) { xw[k][j] = __builtin_nontemporal_load((const u32x2*)(Y + (size_t)rr * DM) + lane + 64 * j); fw[k][j] = __builtin_nontemporal_load((const u32x2*)(F + (size_t)rr * DM) + lane + 64 * j); } }
#pragma unroll
        for (int k = 0; k < RB7; ++k) { const int r = base + k * NGW;
            const float rstd2 = rsqrtf(wave_sum(sq2[k]) * (1.0f / DM) + EPS);
            if (r < TOK_P) {
#pragma unroll
                for (int j = 0; j < 4; ++j) __builtin_nontemporal_store(unpack_bf4(xw[k][j]) + (unpack_bf4(fw[k][j]) * rstd2) * wf[j], (f32x4*)(p.out + (size_t)r * DM) + lane + 64 * j); } }
    }
    for (int r = TOK_P + gw; r < TOK; r += NGW) {
        const float* xrow = p.in[1] + (size_t)(r - TOK_P) * DM;
        const float* ys = (const float*)(p.ws + WS_YS) + (size_t)(r - TOK_P) * DM; const float* fs = (const float*)(p.ws + WS_FS) + (size_t)(r - TOK_P) * DM;
        f32x4 yv[4], fv[4]; float s1 = 0.f, s2 = 0.f;
#pragma unroll
        for (int j = 0; j < 4; ++j) { f32x4 a = *((const f32x4*)ys + lane + 64 * j), c = *((const f32x4*)fs + lane + 64 * j);
#pragma unroll
            for (int q = 1; q < 4; ++q) { a += *((const f32x4*)(ys + (size_t)q * 128 * DM) + lane + 64 * j); c += *((const f32x4*)(fs + (size_t)q * 128 * DM) + lane + 64 * j); }
            yv[j] = a; fv[j] = c; s1 += sumsq4(a); s2 += sumsq4(c); }
        const float rstd1 = rsqrtf(wave_sum(s1) * (1.0f / DM) + EPS), rstd2 = rsqrtf(wave_sum(s2) * (1.0f / DM) + EPS);
#pragma unroll
        for (int j = 0; j < 4; ++j) *((f32x4*)(p.out + (size_t)r * DM) + lane + 64 * j) = *((const f32x4*)xrow + lane + 64 * j) + (yv[j] * rstd1) * wm[j] + (fv[j] * rstd2) * wf[j];
    }
}


#define XB_TMO      128
#define XB_XCNT(j)  (256  + 64 * (j))
#define XB_XSUB(j)  (1280 + 64 * (j))
#define XB_XGEN(j)  (2304 + 64 * (j))
#define XB_TOP      3328
#define XB_TOPGEN   3392
#define XCD_BAR_WORDS 3456
#define XB_SPIN_CAP (1u << 18)

__device__ __forceinline__ unsigned xb_ld(unsigned* p)              { return __hip_atomic_load(p, __ATOMIC_RELAXED, __HIP_MEMORY_SCOPE_AGENT); }
__device__ __forceinline__ unsigned xb_add(unsigned* p, unsigned v) { return __hip_atomic_fetch_add(p, v, __ATOMIC_RELAXED, __HIP_MEMORY_SCOPE_AGENT); }
__device__ __forceinline__ unsigned xb_xcc_id() { return (unsigned)__builtin_amdgcn_s_getreg((3 << 11) | 20) & 0xFu; }
#define XB_SPIN(cond, bar) do { unsigned _sp = 0; while (cond) { __builtin_amdgcn_s_sleep(1); \
    if ((++_sp & 255u) == 0u) { if (xb_ld(&(bar)[XB_TMO])) break; if (_sp > XB_SPIN_CAP) { atomicAdd(&(bar)[XB_TMO], 1u); break; } } } } while (0)

struct XcdBarrier {
    unsigned* bar; unsigned x;
    volatile LAS unsigned* st;
};

__device__ __forceinline__ XcdBarrier xcd_barrier_post(unsigned* bar, volatile LAS unsigned* st) {
    XcdBarrier b; b.bar = bar; b.x = xb_xcc_id(); b.st = st;
    if (threadIdx.x == 0) (void)xb_add(&bar[XB_XCNT(b.x)], 1u);
    return b;
}
__device__ __forceinline__ void xcd_barrier_complete(unsigned* bar, unsigned x, unsigned& nloc, unsigned& nx) {
    const unsigned G = gridDim.x * gridDim.y * gridDim.z;
    unsigned sum, cnt, mine, sp = 0u;
    for (;;) {
        sum = 0u; cnt = 0u; mine = 0u;
#pragma unroll
        for (unsigned j = 0; j < 16; ++j) { const unsigned c = xb_ld(&bar[XB_XCNT(j)]); sum += c; cnt += (c > 0u) ? 1u : 0u; mine = (j == x) ? c : mine; }
        if (sum == G) break;
        __builtin_amdgcn_s_sleep(1);
        if ((++sp & 255u) == 0u) { if (xb_ld(&bar[XB_TMO])) break; if (sp > XB_SPIN_CAP) { atomicAdd(&bar[XB_TMO], 1u); break; } }
    }
    nloc = mine > 0u ? mine : 1u; nx = cnt > 0u ? cnt : 1u;
}

__device__ __forceinline__ void xcd_barrier(const XcdBarrier& b) {
    asm volatile("s_waitcnt vmcnt(0)" ::: "memory");
    __syncthreads();
    if (threadIdx.x == 0) {
        unsigned* bar = b.bar;
        __builtin_amdgcn_s_waitcnt(0);
        unsigned nloc = b.st[0], nx = b.st[1];
        if (nloc == 0u) { xcd_barrier_complete(bar, b.x, nloc, nx); b.st[0] = nloc; b.st[1] = nx; }
        const unsigned old = xb_add(&bar[XB_XSUB(b.x)], 1u);
        const unsigned gen = old / nloc;
        if (old + 1u == (gen + 1u) * nloc) {
            __builtin_amdgcn_fence(__ATOMIC_RELEASE, "agent");
            asm volatile("s_waitcnt vmcnt(0)" ::: "memory");
            const unsigned og = xb_add(&bar[XB_TOP], 1u);
            const unsigned tg = og / nx;
            if (og + 1u == (tg + 1u) * nx) xb_add(&bar[XB_TOPGEN], 1u);
            else XB_SPIN(xb_ld(&bar[XB_TOPGEN]) == tg, bar);
            __builtin_amdgcn_fence(__ATOMIC_ACQUIRE, "agent");
            xb_add(&bar[XB_XGEN(b.x)], 1u);
            asm volatile("s_waitcnt vmcnt(0)" ::: "memory");
        } else {
            XB_SPIN(xb_ld(&bar[XB_XGEN(b.x)]) == gen, bar);
            __builtin_amdgcn_fence(__ATOMIC_ACQUIRE, "agent");
            asm volatile("s_waitcnt vmcnt(0)" ::: "memory");
        }
    }
    __syncthreads();
}

#ifndef MK_LAUNCHES
#define MK_LAUNCHES 1
#endif
#ifndef REP0
#define REP0 1
#endif
#ifndef REP1
#define REP1 1
#endif
#ifndef REP2
#define REP2 1
#endif
#ifndef REP3
#define REP3 1
#endif
#ifndef REP4
#define REP4 1
#endif
#ifndef REP5
#define REP5 1
#endif
#ifndef REP6
#define REP6 1
#endif
#ifndef REP7
#define REP7 1
#endif
#define REPEAT(n) for (int rep_ = 0; rep_ < (n); ++rep_, ((rep_ < (n)) ? GRIDSYNC() : (void)0))
template <int PH_LO, int PH_HI>
__device__ __forceinline__ void run_phases(const Params& p, LAS unsigned char* lds) {
    int tid = threadIdx.x, lane = tid & 63; const int wid = __builtin_amdgcn_readfirstlane(tid >> 6);
    const int G = gridDim.x, c = blockIdx.x;
#define LAUNDER() asm volatile("" : "+v"(tid), "+v"(lane))
    XcdBarrier bar_;
    if (PH_HI - PH_LO > 1) {
        volatile LAS unsigned* stw = (volatile LAS unsigned*)(lds + LDS_BARW);
        if (threadIdx.x == 0) { stw[0] = 0u; stw[1] = 0u; }
        __syncthreads();
        bar_ = xcd_barrier_post((unsigned*)p.ws, stw);
        if (p.ws == nullptr) cg::this_grid().sync();
    }
#define GRIDSYNC() xcd_barrier(bar_)
#define SEAM(ph) do { if (PH_LO <= (ph) && (ph) + 1 < PH_HI) { GRIDSYNC(); } } while (0)
#ifdef XSYNC
    for (int xs_ = 0; xs_ < XSYNC; ++xs_) GRIDSYNC();
#endif
    if (PH_LO <= 0 && 0 < PH_HI) REPEAT(REP0) { LAUNDER(); phase0(p, lds, tid, wid, lane); }
    SEAM(0);
    if (PH_LO <= 1 && 1 < PH_HI) REPEAT(REP1) {
        for (int t = c; t < 224; t += G) { f32x4 acc[1]; thin_gemm2<1>(lds, (const bf16_t*)(p.ws + WS_RA) + (size_t)TOK_P * DM, DM, (const bf16_t*)(p.ws + WS_WIN), DM, 16 * t, 0, 0, DM, acc, tid, wid, lane);
            thin_store(acc[0], (float*)(p.ws + WS_PS), NIN, 16 * t, wid, lane); }
        pg8::Gemm g{(const bf16_t*)(p.ws + WS_RA), (const bf16_t*)(p.ws + WS_WIN), TOK_P, NIN, DM};
        pg8::StaticOrder S; S.init(TOK_P, NIN, G, c);
        pg8::EpiIn E{(bf16_t*)(p.ws + WS_RB), (const float*)(p.ws + WS_COS), (const float*)(p.ws + WS_SIN)};
        pg8::gemm_phase<pg8::EpiIn, pg8::StaticOrder, true, true>(lds, g, S, E);
    }
    SEAM(1);
    if (PH_LO <= 2 && 2 < PH_HI) REPEAT(REP2) {
#ifndef RUREP
#define RUREP 1
#endif
        for (int rrep_ = 0; rrep_ < RUREP; ++rrep_) for (int u = c; u < 256; u += G) ret_unit<false>(p, lds, u, tid, wid, lane);
        LAUNDER();
#ifndef SUREP
#define SUREP 1
#endif
        for (int srep_ = 0; srep_ < SUREP; ++srep_) for (int su = c; su < 128; su += G) sample_unit(p, lds, su, tid, wid, lane);
    }
    SEAM(2);
    if (PH_LO <= 3 && 3 < PH_HI) REPEAT(REP3) {
        for (int u = c; u < 256; u += G) ret_unit<true>(p, lds, u, tid, wid, lane);
    }
    SEAM(3);
    if (PH_LO <= 4 && 4 < PH_HI) REPEAT(REP4) {
        for (int t = c; t < 256; t += G) { f32x4 acc[1]; const int kq = t >> 6, nt = t & 63;
            thin_gemm2<1>(lds, (const bf16_t*)(p.ws + WS_RA) + (size_t)TOK_P * DM, DM, (const bf16_t*)(p.ws + WS_WOUT), DM, 16 * nt, 0, 256 * kq, 256, acc, tid, wid, lane);
            thin_store(acc[0], (float*)(p.ws + WS_YS) + (size_t)kq * 128 * DM, DM, 16 * nt, wid, lane); }
        pg8::Gemm g{(const bf16_t*)(p.ws + WS_RA), (const bf16_t*)(p.ws + WS_WOUT), TOK_P, DM, DM};
        pg8::StaticOrder S; S.init(TOK_P, DM, G, c);
        pg8::EpiY E{(bf16_t*)(p.ws + WS_Y), (float*)(p.ws + WS_SSQ1)};
        pg8::gemm_phase<pg8::EpiY, pg8::StaticOrder, true, true>(lds, g, S, E);
    }
    SEAM(4);
    if (PH_LO <= 5 && 5 < PH_HI) REPEAT(REP5) { LAUNDER(); phase4(p, wid, lane); }
    SEAM(5);
    if (PH_LO <= 6 && 6 < PH_HI) REPEAT(REP6) {
        for (int t = c; t < 256; t += G) thin_ffn1(p, lds, t, tid, wid, lane);
        pg8::Gemm g{(const bf16_t*)(p.ws + WS_Y), (const bf16_t*)(p.ws + WS_WFF1), TOK_P, 2 * DFF, DM};
        pg8::WalkOrder S{G, c};
        pg8::EpiFfn E{(bf16_t*)(p.ws + WS_RB), p.in[15], p.in[4], p.out + O_CFP, p.out + O_CFS, (LAS float*)(lds + LDS_HALO), (const float*)(p.ws + WS_RS2)};
        pg8::gemm_phase<pg8::EpiFfn, pg8::WalkOrder, true, true>(lds, g, S, E);
    }
    SEAM(6);
    if (PH_LO <= 7 && 7 < PH_HI) REPEAT(REP7) {
        for (int t = c; t < 256; t += G) { f32x4 acc[1]; const int kq = t >> 6, nt = t & 63;
            thin_gemm2<1>(lds, (const bf16_t*)(p.ws + WS_RB) + (size_t)TOK_P * DFF, DFF, (const bf16_t*)(p.ws + WS_WDN), DFF, 16 * nt, 0, 1024 * kq, 1024, acc, tid, wid, lane);
            thin_store(acc[0], (float*)(p.ws + WS_FS) + (size_t)kq * 128 * DM, DM, 16 * nt, wid, lane); }
        pg8::Gemm g{(const bf16_t*)(p.ws + WS_RB), (const bf16_t*)(p.ws + WS_WDN), TOK_P, DM, DFF};
        pg8::StaticOrder S; S.init(TOK_P, DM, G, c);
        pg8::EpiY E{(bf16_t*)(p.ws + WS_RA), (float*)(p.ws + WS_SSQ2)};
        pg8::gemm_phase<pg8::EpiY, pg8::StaticOrder, true, true>(lds, g, S, E);
    }
    SEAM(7);
#ifndef REP8
#define REP8 1
#endif
    if (PH_LO <= 8 && 8 < PH_HI) REPEAT(REP8) { LAUNDER(); phase7(p, wid, lane); }
#undef SEAM
}
constexpr int NPH = 9;
#if MK_LAUNCHES == 1
__global__ void __launch_bounds__(512, 2) fwd_kernel(Params p) {
    extern __shared__ __attribute__((aligned(16))) unsigned char smem[];
    run_phases<0, NPH>(p, (LAS unsigned char*)smem);
}
#else
template <int PH>
__global__ void __launch_bounds__(512, 2) fwd_phase(Params p) {
    extern __shared__ __attribute__((aligned(16))) unsigned char smem[];
    run_phases<PH, PH + 1>(p, (LAS unsigned char*)smem);
}
template <int PH> static void launch_phase(const Params& p, int grid, hipStream_t stream) {
    static bool attr = false;
    if (!attr) { (void)hipFuncSetAttribute((const void*)fwd_phase<PH>, hipFuncAttributeMaxDynamicSharedMemorySize, LDS_BYTES); attr = true; }
    hipLaunchKernelGGL(fwd_phase<PH>, dim3(grid), dim3(512), LDS_BYTES, stream, p);
}
#endif

extern "C" void kernel_launch(void* const* d_in, const int* in_sizes, int n_in, void* d_out, int out_size, void* d_ws, size_t ws_size, hipStream_t stream) {
    static int grid = 0;
    if (grid == 0) {
        if (n_in != 17 || ws_size < WS_END) { fprintf(stderr, "kernel_launch: expected 17 inputs and >= %zu bytes of workspace (got %d, %zu)\n", (size_t)WS_END, n_in, ws_size); grid = -1; return; }
        int dev = 0, cus = 0, per_cu = 0;
        (void)hipGetDevice(&dev); (void)hipDeviceGetAttribute(&cus, hipDeviceAttributeMultiprocessorCount, dev);
#if MK_LAUNCHES == 1
        if (hipFuncSetAttribute((const void*)fwd_kernel, hipFuncAttributeMaxDynamicSharedMemorySize, LDS_BYTES) != hipSuccess) { fprintf(stderr, "kernel_launch: hipFuncSetAttribute failed\n"); grid = -1; return; }
        if (hipOccupancyMaxActiveBlocksPerMultiprocessor(&per_cu, (const void*)fwd_kernel, 512, LDS_BYTES) != hipSuccess || per_cu < 1) { fprintf(stderr, "kernel_launch: occupancy query says %d\n", per_cu); per_cu = 1; }
        (void)hipGetLastError();
#endif
        grid = cus > 0 ? cus : 256;
    }
    if (grid < 0) return;
    Params p{};
    for (int i = 0; i < 17; ++i) p.in[i] = (const float*)d_in[i];
    p.out = (float*)d_out; p.ws = (unsigned char*)d_ws;
#if MK_LAUNCHES == 1
    if (hipMemsetAsync(d_ws, 0, 16384, stream) != hipSuccess) { fprintf(stderr, "kernel_launch: hipMemsetAsync failed\n"); return; }
    void* args[] = {&p};
    const hipError_t e = hipLaunchCooperativeKernel((const void*)fwd_kernel, dim3(grid), dim3(512), args, LDS_BYTES, stream);
    if (e != hipSuccess) fprintf(stderr, "kernel_launch: cooperative launch failed: %s (grid %d)\n", hipGetErrorString(e), grid);
#else
    launch_phase<0>(p, grid, stream); launch_phase<1>(p, grid, stream); launch_phase<2>(p, grid, stream); launch_phase<3>(p, grid, stream); launch_phase<4>(p, grid, stream);
    launch_phase<5>(p, grid, stream); launch_phase<6>(p, grid, stream); launch_phase<7>(p, grid, stream); launch_phase<8>(p, grid, stream);
#endif
}
```

```cpp
#include <hip/hip_runtime.h>
#include <hip/hip_cooperative_groups.h>
#include <cstdio>
#include <cstdint>
namespace cg = cooperative_groups;
namespace pg8 {
#define PG8_LAS __attribute__((address_space(3)))
typedef unsigned short bf16_t;
typedef short bf16x8 __attribute__((ext_vector_type(8)));
typedef float f32x4 __attribute__((ext_vector_type(4)));
typedef unsigned u32x4 __attribute__((ext_vector_type(4)));
constexpr int BM = 256, BK = 64, HALF = 128, HTB = HALF * BK * 2  , STAGE_BYTES = 8 * HTB, NXCD = 8, WGM = 8;

__host__ __device__ __forceinline__ int lds_byte(int r, int c) { const int st = (r >> 4) * 2 + (c >> 5), rr = r & 15, cc = c & 31, ob = rr * 64 + cc * 2; return st * 1024 + (ob ^ (((ob >> 9) & 1) << 5)); }
__host__ __device__ __forceinline__ void stage_rc(int b, int& R, int& C) { const int st = b / 1024, sb = b % 1024, swz = sb ^ (((sb >> 9) & 1) << 5); R = (st >> 1) * 16 + swz / 64; C = (st & 1) * 32 + (swz % 64) / 2; }
__host__ __device__ __forceinline__ int perm32(int rho) { const int n = rho >> 4, i = rho & 15; return 8 * (i >> 2) + 4 * n + (i & 3); }

struct Unit { int pm, pn; };
struct Gemm { const bf16_t* A; const bf16_t* Bt; int M, N, K; };

struct StaticOrder {
    int nM, nN, nwg, G, c;
    __host__ __device__ void init(int M, int N, int G_, int c_) { nM = M / BM; nN = N / BM; nwg = nM * nN; G = G_; c = c_; }
    __host__ __device__ bool next(int i, Unit& u) const {
        const long L = (long)i * G + c; if (L >= nwg) return false;
        int wgid = (int)L; { const int q = nwg / NXCD, r = nwg % NXCD, xcd = wgid % NXCD, off = wgid / NXCD; wgid = (xcd < r ? xcd * (q + 1) : r * (q + 1) + (xcd - r) * q) + off; }
        const int nig = WGM * nN, gid = wgid / nig, fm = gid * WGM, gsz = (nM - fm) < WGM ? (nM - fm) : WGM;
        u.pm = fm + ((wgid % nig) % gsz); u.pn = (wgid % nig) / gsz; return true;
    }
    __device__ __forceinline__ void a_ready(const Unit&) const {}
    __device__ __forceinline__ void done(const Unit&) const {}
};
__device__ __forceinline__ unsigned cvt_pk_bf16(float lo, float hi) { unsigned r; asm volatile("v_cvt_pk_bf16_f32 %0, %1, %2" : "=v"(r) : "v"(lo), "v"(hi)); return r; }
__device__ __forceinline__ float dpp_shr1(float v) { return __builtin_bit_cast(float, __builtin_amdgcn_update_dpp(0, __builtin_bit_cast(int, v), 0x111, 0xf, 0xf, true)); }
__device__ __forceinline__ float dpp_shr2(float v) { return __builtin_bit_cast(float, __builtin_amdgcn_update_dpp(0, __builtin_bit_cast(int, v), 0x112, 0xf, 0xf, true)); }
__device__ __forceinline__ float dpp_shl15(float v) { return __builtin_bit_cast(float, __builtin_amdgcn_update_dpp(0, __builtin_bit_cast(int, v), 0x10F, 0xf, 0xf, true)); }
__device__ __forceinline__ float dpp_shl14(float v) { return __builtin_bit_cast(float, __builtin_amdgcn_update_dpp(0, __builtin_bit_cast(int, v), 0x10E, 0xf, 0xf, true)); }
__device__ __forceinline__ float gelu_tanh(float x) {
    const float z = 0.7978845608028654f * (x + 0.044715f * x * x * x);
    const float e = __builtin_amdgcn_exp2f(-2.8853900817779268f * z);
    return x * __builtin_amdgcn_rcpf(1.0f + e);
}
constexpr int TOKP = 32768;

struct EpiIn {
    static constexpr bool PERM = true, AFTER_DRAIN = false;
    bf16_t* P; const float* cosT; const float* sinT; const float* rs0;
    __device__ __forceinline__ void operator()(const f32x4 (&acc)[2][2][4][2], const Unit& u, int wr, int wc, int fr, int fq) const {
        asm volatile("" : "+v"(fr), "+v"(fq));
        const int row0 = u.pm * BM + wr * 64 + fr, col0 = u.pn * BM + wc * 32 + 8 * fq;
        if (u.pn < 4) {
            const float sc = (u.pn >= 2) ? 0.08838834764831845f : 1.0f;
            const int f0 = 16 * wc + 4 * fq;
#pragma unroll
            for (int ai = 0; ai < 2; ++ai)
#pragma unroll
                for (int m = 0; m < 4; ++m) {
                    const int r = row0 + ai * HALF + m * 16;
                    const int pos = r < TOKP ? (r & 4095) : 4096 + ((r - TOKP) & 15);
                    const float rsr = rs0[r] * sc;
                    const f32x4 c4 = *(const f32x4*)(cosT + pos * 64 + f0) * rsr, s4 = *(const f32x4*)(sinT + pos * 64 + f0) * rsr;
                    bf16_t* rowp = P + (size_t)r * 3584 + col0;
#pragma unroll
                    for (int bj = 0; bj < 2; ++bj) {
                        const f32x4 x1 = acc[ai][bj][m][0], x2 = acc[ai][bj][m][1];
                        const f32x4 o1 = x1 * c4 - x2 * s4, o2 = x2 * c4 + x1 * s4;
                        u32x4 w; w.x = cvt_pk_bf16(o1[0], o1[1]); w.y = cvt_pk_bf16(o1[2], o1[3]); w.z = cvt_pk_bf16(o2[0], o2[1]); w.w = cvt_pk_bf16(o2[2], o2[3]);
                        *(u32x4*)(rowp + bj * HALF) = w;
                    }
                }
        } else {
#pragma unroll
            for (int ai = 0; ai < 2; ++ai)
#pragma unroll
                for (int m = 0; m < 4; ++m) {
                    bf16_t* rowp = P + (size_t)(row0 + ai * HALF + m * 16) * 3584 + col0;
                    const float rsr = rs0[row0 + ai * HALF + m * 16];
#pragma unroll
                    for (int bj = 0; bj < 2; ++bj) {
                        const f32x4 v0 = acc[ai][bj][m][0] * rsr, v1 = acc[ai][bj][m][1] * rsr;
                        u32x4 w; w.x = cvt_pk_bf16(v0[0], v0[1]); w.y = cvt_pk_bf16(v0[2], v0[3]); w.z = cvt_pk_bf16(v1[0], v1[1]); w.w = cvt_pk_bf16(v1[2], v1[3]);
                        *(u32x4*)(rowp + bj * HALF) = w;
                    }
                }
        }
    }
};

struct EpiY {
    static constexpr bool PERM = true, AFTER_DRAIN = false;
    bf16_t* Y; float* ssq;
    __device__ __forceinline__ void operator()(const f32x4 (&acc)[2][2][4][2], const Unit& u, int wr, int wc, int fr, int fq) const {
        asm volatile("" : "+v"(fr), "+v"(fq));
        const int row0 = u.pm * BM + wr * 64 + fr, col0 = u.pn * BM + wc * 32 + 8 * fq;
#pragma unroll
        for (int ai = 0; ai < 2; ++ai)
#pragma unroll
            for (int m = 0; m < 4; ++m) {
                const int r = row0 + ai * HALF + m * 16;
                bf16_t* rowp = Y + (size_t)r * 1024 + col0;
                float s = 0.f;
#pragma unroll
                for (int bj = 0; bj < 2; ++bj) {
                    const f32x4 v0 = acc[ai][bj][m][0], v1 = acc[ai][bj][m][1];
                    s += (v0[0] * v0[0] + v0[1] * v0[1]) + (v0[2] * v0[2] + v0[3] * v0[3]) + (v1[0] * v1[0] + v1[1] * v1[1]) + (v1[2] * v1[2] + v1[3] * v1[3]);
                    u32x4 w; w.x = cvt_pk_bf16(v0[0], v0[1]); w.y = cvt_pk_bf16(v0[2], v0[3]); w.z = cvt_pk_bf16(v1[0], v1[1]); w.w = cvt_pk_bf16(v1[2], v1[3]);
                    *(u32x4*)(rowp + bj * HALF) = w;
                }
                s += __shfl_xor(s, 16); s += __shfl_xor(s, 32);
                if (fq == 0) ssq[(size_t)r * 16 + u.pn * 4 + wc] = s;
            }
    }
};

struct EpiFfn {
    static constexpr bool PERM = true, AFTER_DRAIN = false;
    bf16_t* ACT; const float* cw; const float* cache; float* outp; float* outs; PG8_LAS float* halo; const float* rs2;
    __device__ __forceinline__ void operator()(const f32x4 (&acc)[2][2][4][2], const Unit& u, int wr, int wc, int fr, int fq) const {
        asm volatile("" : "+v"(fr), "+v"(fq));
        const int lc0 = wc * 32 + 8 * fq, ch0 = u.pn * 128 + lc0;
        const bool sample = false;
        const int par = u.pm & 1;
        float rs[2][4];
#pragma unroll
        for (int ai = 0; ai < 2; ++ai)
#pragma unroll
            for (int m = 0; m < 4; ++m) rs[ai][m] = rs2[u.pm * BM + ai * HALF + wr * 64 + m * 16 + fr];
        f32x4 w0[2], w1[2], w2[2];
#pragma unroll
        for (int n = 0; n < 2; ++n) { w0[n] = *(const f32x4*)(cw + ch0 + 4 * n); w1[n] = *(const f32x4*)(cw + 4096 + ch0 + 4 * n); w2[n] = *(const f32x4*)(cw + 8192 + ch0 + 4 * n); }
        if (!sample && fr >= 14) {
#pragma unroll
            for (int ai = 0; ai < 2; ++ai) { PG8_LAS float* hp = halo + ((par * 4 + 2 * ai + wr) * 2 + (fr - 14)) * 128 + lc0;
                *(PG8_LAS f32x4*)hp = acc[ai][0][3][0] * rs[ai][3]; *(PG8_LAS f32x4*)(hp + 4) = acc[ai][0][3][1] * rs[ai][3]; }
        }
        asm volatile("s_waitcnt lgkmcnt(0)" ::: "memory"); __builtin_amdgcn_s_barrier(); asm volatile("" ::: "memory");
#pragma unroll
        for (int ai = 0; ai < 2; ++ai) {
            const int blk = 2 * ai + wr;
#pragma unroll
            for (int m = 0; m < 4; ++m) {
                f32x4 pv[2]; pv[0] = (f32x4){0.f, 0.f, 0.f, 0.f}; pv[1] = pv[0];
                const int sb = 8 * ai + 4 * wr + m;
                if (sample) {
                    if (fr >= 14 && sb < 8) { const float* cp = cache + (size_t)(sb * 2 + fr - 14) * 4096 + ch0; pv[0] = *(const f32x4*)cp; pv[1] = *(const f32x4*)(cp + 4); }
                } else if (m == 0) {
                    if (fr >= 14) {
                        const bool zero = (blk == 0) && ((u.pm & 15) == 0);
                        const int hb = (blk == 0) ? ((par ^ 1) * 4 + 3) : (par * 4 + blk - 1);
                        if (!zero) { const PG8_LAS float* hp = halo + (hb * 2 + fr - 14) * 128 + lc0; pv[0] = *(const PG8_LAS f32x4*)hp; pv[1] = *(const PG8_LAS f32x4*)(hp + 4); }
                    }
                } else { pv[0] = acc[ai][0][m - 1][0] * rs[ai][m - 1]; pv[1] = acc[ai][0][m - 1][1] * rs[ai][m - 1]; }
                const int r = u.pm * BM + ai * HALF + wr * 64 + m * 16 + fr;
                float a8[8];
#pragma unroll
                for (int n = 0; n < 2; ++n)
#pragma unroll
                    for (int e = 0; e < 4; ++e) {
                        const float cur = acc[ai][0][m][n][e] * rs[ai][m], pr = pv[n][e];
                        const float p1 = dpp_shr1(cur) + dpp_shl15(pr), p2 = dpp_shr2(cur) + dpp_shl14(pr);
                        const float uc = w0[n][e] * p2 + w1[n][e] * p1 + w2[n][e] * cur;
                        a8[4 * n + e] = gelu_tanh(uc) * (acc[ai][1][m][n][e] * rs[ai][m]);
                    }
                u32x4 w; w.x = cvt_pk_bf16(a8[0], a8[1]); w.y = cvt_pk_bf16(a8[2], a8[3]); w.z = cvt_pk_bf16(a8[4], a8[5]); w.w = cvt_pk_bf16(a8[6], a8[7]);
                *(u32x4*)(ACT + (size_t)r * 4096 + ch0) = w;
                if (sample) {
                    if (fr >= 14 && sb < 8) { float* op = outs + (size_t)(sb * 2 + fr - 14) * 4096 + ch0; *(f32x4*)op = acc[ai][0][m][0]; *(f32x4*)(op + 4) = acc[ai][0][m][1]; }
                } else if (m == 3 && blk == 3 && (u.pm & 15) == 15 && fr >= 14) {
                    float* op = outp + (size_t)((u.pm >> 4) * 2 + fr - 14) * 4096 + ch0; *(f32x4*)op = acc[ai][0][m][0] * rs[ai][m]; *(f32x4*)(op + 4) = acc[ai][0][m][1] * rs[ai][m];
                }
            }
        }
    }
};
struct WalkOrder {
    int G, c;
    __device__ __forceinline__ bool next(int i, Unit& u) const {
        int w = c, rem = i;
        while (w < 256) { const int len = 16;
            if (rem < len) { if (w < 256) { u.pm = (w >> 5) * 16 + rem; u.pn = w & 31; } else { u.pm = 128; u.pn = w - 256; } return true; }
            rem -= len; w += G; }
        return false;
    }
    __device__ __forceinline__ void a_ready(const Unit&) const {}
    __device__ __forceinline__ void done(const Unit&) const {}
};
template <class Epi, class Sched, bool ALIGN_EPI = false, bool SP2 = false>
__device__ __forceinline__ void gemm_phase(PG8_LAS unsigned char* lds, const Gemm g, const Sched& S, const Epi& E) {
    int tid_raw = threadIdx.x; asm volatile("" : "+v"(tid_raw));
    const int tid = tid_raw, wid = __builtin_amdgcn_readfirstlane(tid >> 6), lane = tid & 63, wr = wid >> 2, wc = wid & 3, fr = lane & 15, fq = lane >> 4;
    const int K = g.K, nt = K / BK;
    unsigned voffA[2], voffB[2];
#pragma unroll
    for (int i = 0; i < 2; ++i) { int R, C; stage_rc(tid * 16 + i * 8192, R, C); const int Rb = Epi::PERM ? ((R & ~31) + perm32(R & 31)) : R;
        voffA[i] = (unsigned)(R * K + C) * 2u; voffB[i] = (unsigned)(Rb * K + C) * 2u; }
    const size_t kstep = (size_t)(BK * 2);
    const size_t hstep = (size_t)HALF * K * 2;
    const size_t tstep = 2 * hstep;
    const unsigned ldsw = (unsigned)wid * 1024u;
    const int aoff = lds_byte(wr * 64 + fr, fq * 8), boff = lds_byte(wc * 32 + fr, fq * 8);
#define PG8_SA(b, h) (((b) * 2 + (h)) * HTB)
#define PG8_SB(b, h) ((4 + (b) * 2 + (h)) * HTB)
#define PG8_STAGE(bufoff, gbase, voff) do { _Pragma("unroll") for (int _i = 0; _i < 2; ++_i) \
        __builtin_amdgcn_global_load_lds((const unsigned*)((const char*)(gbase) + (voff)[_i]), (PG8_LAS unsigned*)(lds + (bufoff) + ldsw + _i * 8192), 16, 0, 0); } while (0)
#define PG8_LDA(dst, b, h) do { _Pragma("unroll") for (int m = 0; m < 4; ++m) _Pragma("unroll") for (int k = 0; k < 2; ++k) dst[m][k] = *(const PG8_LAS bf16x8*)(lds + PG8_SA(b, h) + aoff + m * 2048 + k * 1024); } while (0)
#define PG8_LDB(dst, b, h) do { _Pragma("unroll") for (int n = 0; n < 2; ++n) _Pragma("unroll") for (int k = 0; k < 2; ++k) dst[n][k] = *(const PG8_LAS bf16x8*)(lds + PG8_SB(b, h) + boff + n * 2048 + k * 1024); } while (0)
#define PG8_MMA(ai, bj, At, Bt) do { __builtin_amdgcn_s_setprio(1); _Pragma("unroll") for (int m = 0; m < 4; ++m) _Pragma("unroll") for (int n = 0; n < 2; ++n) _Pragma("unroll") for (int k = 0; k < 2; ++k) \
        acc[ai][bj][m][n] = __builtin_amdgcn_mfma_f32_16x16x32_bf16(Bt[n][k], At[m][k], acc[ai][bj][m][n], 0, 0, 0); __builtin_amdgcn_s_setprio(0); } while (0)
#define PG8_WAIT_V(n) asm volatile("s_waitcnt vmcnt(" #n ")" ::: "memory")
#define PG8_WAIT_L(n) asm volatile("s_waitcnt lgkmcnt(" #n ")" ::: "memory")
#define PG8_BAR __builtin_amdgcn_s_barrier()
#define PG8_SCHED __builtin_amdgcn_sched_barrier(0)
    Unit cur, nxt; int ui = 0;
    if (!S.next(0, cur)) return;
    f32x4 acc[2][2][4][2];
#pragma unroll
    for (int a = 0; a < 2; ++a)
#pragma unroll
        for (int b = 0; b < 2; ++b)
#pragma unroll
            for (int m = 0; m < 4; ++m)
#pragma unroll
                for (int n = 0; n < 2; ++n) acc[a][b][m][n] = (f32x4){0.f, 0.f, 0.f, 0.f};
    bf16x8 At[4][2], B0[2][2], B1[2][2];
    const char* cA = (const char*)g.A + (size_t)cur.pm * tstep; const char* cB = (const char*)g.Bt + (size_t)cur.pn * tstep;
    S.a_ready(cur);
    if constexpr (SP2) {
        PG8_STAGE(PG8_SB(0, 0), cB, voffB); PG8_STAGE(PG8_SB(0, 1), cB + hstep, voffB); PG8_STAGE(PG8_SA(0, 0), cA, voffA); PG8_STAGE(PG8_SA(0, 1), cA + hstep, voffA);
        if (wr == 1) PG8_BAR;
        PG8_WAIT_V(2); PG8_BAR;
        PG8_STAGE(PG8_SB(1, 0), cB + kstep, voffB); PG8_STAGE(PG8_SA(1, 0), cA + kstep, voffA); PG8_STAGE(PG8_SB(1, 1), cB + hstep + kstep, voffB);
        PG8_WAIT_V(6); PG8_BAR;
    } else {
        PG8_STAGE(PG8_SB(0, 0), cB, voffB); PG8_STAGE(PG8_SA(0, 0), cA, voffA); PG8_STAGE(PG8_SB(0, 1), cB + hstep, voffB); PG8_STAGE(PG8_SA(0, 1), cA + hstep, voffA);
        if (wr == 1) PG8_BAR;
        PG8_WAIT_V(4); PG8_BAR;
        PG8_STAGE(PG8_SB(1, 0), cB + kstep, voffB); PG8_STAGE(PG8_SA(1, 0), cA + kstep, voffA); PG8_STAGE(PG8_SB(1, 1), cB + hstep + kstep, voffB);
        PG8_WAIT_V(6); PG8_BAR;
    }
    for (;;) {
        const bool has_next = S.next(ui + 1, nxt);
        const char* nA = has_next ? (const char*)g.A + (size_t)nxt.pm * tstep : cA; const char* nB = has_next ? (const char*)g.Bt + (size_t)nxt.pn * tstep : cB;
        for (int t = 0; t < nt; t += 2) {
            const bool last = (t == nt - 2);
            const char* a1 = cA + (size_t)(t + 1) * kstep;
            const char* a2 = last ? nA : cA + (size_t)(t + 2) * kstep; const char* b2 = last ? nB : cB + (size_t)(t + 2) * kstep;
            const char* a3 = a2 + kstep; const char* b3 = b2 + kstep;
            if (last && has_next) S.a_ready(nxt);
            if constexpr (SP2) {
            PG8_LDB(B0, 0, 0); PG8_LDB(B1, 0, 1); PG8_SCHED; PG8_LDA(At, 0, 0); PG8_STAGE(PG8_SA(1, 1), a1 + hstep, voffA);
            PG8_WAIT_V(8); PG8_WAIT_L(0); PG8_BAR; PG8_MMA(0, 0, At, B0); PG8_MMA(0, 1, At, B1); PG8_BAR; PG8_SCHED;
            PG8_LDA(At, 0, 1); PG8_STAGE(PG8_SB(0, 0), b2, voffB); PG8_STAGE(PG8_SB(0, 1), b2 + hstep, voffB); PG8_STAGE(PG8_SA(0, 0), a2, voffA);
            PG8_WAIT_V(8); PG8_WAIT_L(0); PG8_BAR; PG8_MMA(1, 0, At, B0); PG8_MMA(1, 1, At, B1); PG8_BAR; PG8_SCHED;
            PG8_LDB(B0, 1, 0); PG8_LDB(B1, 1, 1); PG8_SCHED; PG8_LDA(At, 1, 0); PG8_STAGE(PG8_SA(0, 1), a2 + hstep, voffA);
            PG8_WAIT_V(8); PG8_WAIT_L(0); PG8_BAR; PG8_MMA(0, 0, At, B0); PG8_MMA(0, 1, At, B1); PG8_BAR; PG8_SCHED;
            PG8_LDA(At, 1, 1); PG8_STAGE(PG8_SB(1, 0), b3, voffB); PG8_STAGE(PG8_SB(1, 1), b3 + hstep, voffB); PG8_STAGE(PG8_SA(1, 0), a3, voffA);
            PG8_WAIT_V(8); PG8_WAIT_L(0); PG8_BAR; PG8_MMA(1, 0, At, B0); PG8_MMA(1, 1, At, B1); PG8_BAR; PG8_SCHED;
            } else {
            PG8_LDB(B0, 0, 0); PG8_SCHED; PG8_LDA(At, 0, 0); PG8_STAGE(PG8_SA(1, 1), a1 + hstep, voffA);
            PG8_WAIT_L(8); PG8_BAR; PG8_WAIT_L(0); PG8_MMA(0, 0, At, B0); PG8_BAR; PG8_SCHED;
            PG8_LDB(B1, 0, 1); PG8_STAGE(PG8_SB(0, 0), b2, voffB);
            PG8_BAR; PG8_WAIT_L(0); PG8_MMA(0, 1, At, B1); PG8_BAR;
            PG8_LDA(At, 0, 1); PG8_STAGE(PG8_SA(0, 0), a2, voffA);
            PG8_BAR; PG8_WAIT_L(0); PG8_MMA(1, 0, At, B0); PG8_BAR; PG8_SCHED;
            PG8_STAGE(PG8_SB(0, 1), b2 + hstep, voffB);
            PG8_WAIT_V(6); PG8_BAR; PG8_MMA(1, 1, At, B1); PG8_BAR;
            PG8_LDB(B0, 1, 0); PG8_SCHED; PG8_LDA(At, 1, 0); PG8_STAGE(PG8_SA(0, 1), a2 + hstep, voffA);
            PG8_WAIT_L(8); PG8_BAR; PG8_WAIT_L(0); PG8_MMA(0, 0, At, B0); PG8_BAR; PG8_SCHED;
            PG8_LDB(B1, 1, 1); PG8_STAGE(PG8_SB(1, 0), b3, voffB);
            PG8_BAR; PG8_WAIT_L(0); PG8_MMA(0, 1, At, B1); PG8_BAR;
            PG8_LDA(At, 1, 1); PG8_STAGE(PG8_SA(1, 0), a3, voffA);
            PG8_BAR; PG8_WAIT_L(0); PG8_MMA(1, 0, At, B0); PG8_BAR; PG8_SCHED;
            PG8_STAGE(PG8_SB(1, 1), b3 + hstep, voffB);
            PG8_WAIT_V(6); PG8_BAR; PG8_MMA(1, 1, At, B1); PG8_BAR;
            }
        }
        if constexpr (ALIGN_EPI) { if (wr == 0) PG8_BAR; }
        if constexpr (!Epi::AFTER_DRAIN) { E(acc, cur, wr, wc, fr, fq); S.done(cur); }
        if (!has_next) break;
#pragma unroll
        for (int a = 0; a < 2; ++a)
#pragma unroll
            for (int b = 0; b < 2; ++b)
#pragma unroll
                for (int m = 0; m < 4; ++m)
#pragma unroll
                    for (int n = 0; n < 2; ++n) acc[a][b][m][n] = (f32x4){0.f, 0.f, 0.f, 0.f};
        cur = nxt; cA = nA; cB = nB; ++ui;
        if constexpr (ALIGN_EPI) { if (wr == 1) PG8_BAR; }
    }
    PG8_WAIT_V(0);
    if constexpr (!ALIGN_EPI) { if (wr == 0) PG8_BAR; }
    PG8_BAR;
    if constexpr (Epi::AFTER_DRAIN) { E.fused(acc, cur, wr, wc, fr, fq, lds, wid, lane); S.done(cur); }
#undef PG8_SA
#undef PG8_SB
#undef PG8_STAGE
#undef PG8_LDA
#undef PG8_LDB
#undef PG8_MMA
#undef PG8_WAIT_V
#undef PG8_WAIT_L
#undef PG8_BAR
#undef PG8_SCHED
}
}

using pg8::bf16_t; using pg8::bf16x8; using pg8::f32x4; using pg8::u32x4;
#define LAS __attribute__((address_space(3)))
typedef unsigned u32x2 __attribute__((ext_vector_type(2)));
constexpr int DM = 1024, NIN = 3584, DFF = 4096;
constexpr int TOK_P = 32768, TOK = 32896, TOKPAD = 33024;
constexpr float EPS = 1e-6f;
constexpr size_t WS_WIN = 16384;
constexpr size_t WS_WOUT = WS_WIN + (size_t)NIN * DM * 2;
constexpr size_t WS_WFF1 = WS_WOUT + (size_t)DM * DM * 2;
constexpr size_t WS_WDN = WS_WFF1 + (size_t)2 * DFF * DM * 2;
constexpr size_t WS_COS = WS_WDN + (size_t)DM * DFF * 2;
constexpr size_t WS_SIN = WS_COS + (size_t)4112 * 64 * 4;
constexpr size_t WS_SSQ1 = WS_SIN + (size_t)4112 * 64 * 4;
constexpr size_t WS_SSQ2 = WS_SSQ1 + (size_t)TOKPAD * 16 * 4;
constexpr size_t WS_UG = WS_SSQ2 + (size_t)TOKPAD * 16 * 4;
constexpr size_t WS_PS = WS_UG + (size_t)256 * 32768;
constexpr size_t WS_YS = WS_PS + (size_t)128 * NIN * 4;
constexpr size_t WS_FS = WS_YS + (size_t)4 * 128 * DM * 4;
constexpr size_t WS_RA = WS_FS + (size_t)4 * 128 * DM * 4;
constexpr size_t WS_RB = WS_RA + (size_t)TOKPAD * DM * 2;
constexpr size_t WS_Y = WS_RB + (size_t)TOKPAD * DFF * 2;
constexpr size_t WS_RS2 = WS_Y + (size_t)TOKPAD * DM * 2;
constexpr size_t WS_RS0 = WS_RS2 + (size_t)TOK_P * 4;
constexpr size_t WS_XB = WS_RS0 + (size_t)TOK_P * 4;
constexpr size_t WS_END = WS_XB + (size_t)TOK_P * DM * 2;
constexpr size_t O_SRP = (size_t)TOK * DM, O_CCP = O_SRP + 524288, O_CFP = O_CCP + 8192, O_SRS = O_CFP + 65536, O_CCS = O_SRS + 524288, O_CFS = O_CCS + 8192;
constexpr int LDS_HALO = 131072, LDS_BARW = 131072 + 8192, LDS_BYTES = LDS_BARW + 16;

struct Params { const float* in[17]; float* out; unsigned char* ws; };

__device__ __forceinline__ float dppf(float v, const int ctrl_sel) {
    const int iv = __builtin_bit_cast(int, v); int r;
    switch (ctrl_sel) { case 1: r = __builtin_amdgcn_update_dpp(0, iv, 0x111, 0xf, 0xf, true); break; case 2: r = __builtin_amdgcn_update_dpp(0, iv, 0x112, 0xf, 0xf, true); break;
        case 4: r = __builtin_amdgcn_update_dpp(0, iv, 0x114, 0xf, 0xf, true); break; case 8: r = __builtin_amdgcn_update_dpp(0, iv, 0x118, 0xf, 0xf, true); break;
        case 15: r = __builtin_amdgcn_update_dpp(0, iv, 0x142, 0xa, 0xf, false); break; default: r = __builtin_amdgcn_update_dpp(0, iv, 0x143, 0xc, 0xf, false); break; }
    return __builtin_bit_cast(float, r);
}
__device__ __forceinline__ float wave_sum(float v) {
    v += dppf(v, 1); v += dppf(v, 2); v += dppf(v, 4); v += dppf(v, 8); v += dppf(v, 15); v += dppf(v, 31);
    return __builtin_bit_cast(float, __builtin_amdgcn_readlane(__builtin_bit_cast(int, v), 63));
}
__device__ __forceinline__ float bf2f(unsigned short b) { return __uint_as_float(((unsigned)b) << 16); }
__device__ __forceinline__ unsigned pk2(float a, float b) { return pg8::cvt_pk_bf16(a, b); }
__device__ __forceinline__ unsigned pk2s(float a, float b) { unsigned r; asm("v_cvt_pk_bf16_f32 %0, %1, %2" : "=v"(r) : "v"(a), "v"(b)); return r; }
__device__ __forceinline__ float silu_f(float g) { return g * __builtin_amdgcn_rcpf(1.0f + __builtin_amdgcn_exp2f(-1.4426950408889634f * g)); }
__device__ __forceinline__ int dmap(int P) { return ((P >> 2) & 1) * 64 + (P >> 3) * 4 + (P & 3); }
__device__ __forceinline__ int pmap(int d) { return ((d >> 4) & 3) * 32 + ((d >> 2) & 3) * 8 + ((d >> 6) & 1) * 4 + (d & 3); }

constexpr int RB = 6;
__device__ __forceinline__ f32x4 unpack_bf4(const u32x2 w) { f32x4 v; v[0] = __uint_as_float(w.x << 16); v[1] = __uint_as_float(w.x & 0xffff0000u); v[2] = __uint_as_float(w.y << 16); v[3] = __uint_as_float(w.y & 0xffff0000u); return v; }
__device__ __forceinline__ float sumsq4(const f32x4 a) { return (a[0] * a[0] + a[1] * a[1]) + (a[2] * a[2] + a[3] * a[3]); }
template <int MODE> __device__ __forceinline__ int rowmap(int c) {
    if (MODE == 0) { if (c < 1024) return (c & ~127) + pmap(c & 127); return c; }
    if (MODE == 1) return c;
    if (MODE == 2) return ((c >> 7) << 8) + (c & 127);
    return ((c >> 7) << 8) + 128 + (c & 127);
}
template <int MODE, bool GAIN = false>
__device__ __forceinline__ void transpose_item(const float* W, int K, int N, bf16_t* WT, LAS float* scr, int item, int lane, const float* gain = nullptr) {
    const int nblk = N / 32, kb = item / nblk, nb = item % nblk, k0 = 64 * kb, n0 = 32 * nb;
#pragma unroll
    for (int i = 0; i < 32; ++i) { const int kk = 2 * i + (lane >> 5); scr[kk * 33 + (lane & 31)] = W[(size_t)(k0 + kk) * N + n0 + (lane & 31)]; }
    asm volatile("s_waitcnt lgkmcnt(0)" ::: "memory");
    const int c = lane & 7;
    f32x4 ga = (f32x4){1.f, 1.f, 1.f, 1.f}, gb = ga;
    if (GAIN) { ga = *(const f32x4*)(gain + k0 + 8 * c); gb = *(const f32x4*)(gain + k0 + 8 * c + 4); }
#pragma unroll
    for (int j = 0; j < 4; ++j) { const int n = (lane >> 3) + 8 * j; const LAS float* s = scr + (8 * c) * 33 + n;
        u32x4 o; o.x = pk2(s[0 * 33] * ga[0], s[1 * 33] * ga[1]); o.y = pk2(s[2 * 33] * ga[2], s[3 * 33] * ga[3]); o.z = pk2(s[4 * 33] * gb[0], s[5 * 33] * gb[1]); o.w = pk2(s[6 * 33] * gb[2], s[7 * 33] * gb[3]);
        *(u32x4*)(WT + (size_t)rowmap<MODE>(n0 + n) * K + k0 + 8 * c) = o; }
    asm volatile("s_waitcnt lgkmcnt(0)" ::: "memory");
}
__device__ __forceinline__ void phase0(const Params& p, LAS unsigned char* lds, int tid, int wid, int lane) {
    LAS float* scr = (LAS float*)(lds + wid * 8448);
    const int gw = blockIdx.x * 8 + wid, NGW = gridDim.x * 8;
    bf16_t* win = (bf16_t*)(p.ws + WS_WIN); bf16_t* wout = (bf16_t*)(p.ws + WS_WOUT); bf16_t* wff1 = (bf16_t*)(p.ws + WS_WFF1); bf16_t* wdn = (bf16_t*)(p.ws + WS_WDN);
    constexpr int I_IN = 16 * 112, I_OUT = 16 * 32, I_UP = 16 * 128, I_DN = 64 * 32, NITEMS = I_IN + I_OUT + 2 * I_UP + I_DN;
    for (int it = gw; it < NITEMS; it += NGW) {
        int r = it;
        if (r < I_IN) { transpose_item<0, true>(p.in[5], DM, NIN, win, scr, r, lane, p.in[9]); continue; } r -= I_IN;
        if (r < I_OUT) { transpose_item<1>(p.in[6], DM, DM, wout, scr, r, lane); continue; } r -= I_OUT;
        if (r < I_UP) { transpose_item<2, true>(p.in[13], DM, DFF, wff1, scr, r, lane, p.in[11]); continue; } r -= I_UP;
        if (r < I_UP) { transpose_item<3, true>(p.in[14], DM, DFF, wff1, scr, r, lane, p.in[11]); continue; } r -= I_UP;
        transpose_item<1>(p.in[16], DFF, DM, wdn, scr, r, lane);
    }
    float* cosT = (float*)(p.ws + WS_COS); float* sinT = (float*)(p.ws + WS_SIN);
    for (int idx = blockIdx.x * 512 + tid; idx < 4112 * 64; idx += gridDim.x * 512) {
        const int pos = idx >> 6, f = idx & 63;
        const float inv = exp2f(-(float)(2 * f) * (1.0f / 128.0f) * 13.287712379549449f);
        const float ang = (float)pos * inv;
        const double rev = (double)ang * 0.15915494309189535;
        const float fr = (float)(rev - floor(rev));
        cosT[idx] = __builtin_amdgcn_cosf(fr); sinT[idx] = __builtin_amdgcn_sinf(fr);
    }
    bf16_t* H = (bf16_t*)(p.ws + WS_RA); bf16_t* XB = (bf16_t*)(p.ws + WS_XB); float* RS0 = (float*)(p.ws + WS_RS0);
#pragma unroll 1
    for (int base = gw; base < TOK; base += RB * NGW) {
        f32x4 v[RB][4]; float s[RB];
#pragma unroll
        for (int k = 0; k < RB; ++k) { const int rr = min(base + k * NGW, TOK - 1);
            const float* xrow = rr < TOK_P ? p.in[0] + (size_t)rr * DM : p.in[1] + (size_t)(rr - TOK_P) * DM; s[k] = 0.f;
#pragma unroll
            for (int j = 0; j < 4; ++j) { v[k][j] = __builtin_nontemporal_load((const f32x4*)xrow + lane + 64 * j); s[k] += sumsq4(v[k][j]); } }
#pragma unroll
        for (int k = 0; k < RB; ++k) { const int r = base + k * NGW; const float rstd = rsqrtf(wave_sum(s[k]) * (1.0f / DM) + EPS);
            if (r < TOK_P) {
                if (lane == 0) RS0[r] = rstd;
#pragma unroll
                for (int j = 0; j < 4; ++j) *((u32x2*)(XB + (size_t)r * DM) + lane + 64 * j) = (u32x2){pk2(v[k][j][0], v[k][j][1]), pk2(v[k][j][2], v[k][j][3])};
            } else if (r < TOK) {
#pragma unroll
                for (int j = 0; j < 4; ++j) { const f32x4 y = v[k][j] * rstd; *((u32x2*)(H + (size_t)r * DM) + lane + 64 * j) = (u32x2){pk2(y[0], y[1]), pk2(y[2], y[3])}; } } }
    }
}

constexpr int QI_OFF = 0, KI_OFF = 17408, KT_OFF = 34816, VT_OFF = 53248, SI_OFF = 71680, ST_OFF = 80896, GI_OFF = 115712;
#define MFMA16(a, b, c) __builtin_amdgcn_mfma_f32_16x16x32_bf16((a), (b), (c), 0, 0, 0)
#define RET_ISSUE(S, nn) do { _Pragma("unroll") for (int i_ = 0; i_ < 2; ++i_) { \
        const bf16_t* rowp_ = P + (tok0 + (size_t)(nn) * 64 + 2 * (tid >> 4) + i_) * NIN + 128 * h + (tid & 15) * 8; \
        if (FULL) { rq[S][i_] = *(const u32x4*)rowp_; rg[S][i_] = *(const u32x4*)(rowp_ + 1536); } rk[S][i_] = *(const u32x4*)(rowp_ + 512); rv[S][i_] = *(const u32x4*)(rowp_ + 1024); } } while (0)
#define RET_STAGE_A(S) do { const int j_ = 2 * (tid >> 4), ch_ = tid & 15; \
        if (FULL) { _Pragma("unroll") for (int i_ = 0; i_ < 2; ++i_) { *(LAS u32x4*)(lds + QI_OFF + (j_ + i_) * 272 + ch_ * 16) = rq[S][i_]; *(LAS u32x4*)(lds + KI_OFF + (j_ + i_) * 272 + ch_ * 16) = rk[S][i_]; *(LAS u32x4*)(lds + GI_OFF + (j_ + i_) * 272 + ch_ * 16) = rg[S][i_]; } } \
        const float te0_ = __builtin_amdgcn_exp2f(l2g * (float)(63 - j_)), te1_ = __builtin_amdgcn_exp2f(l2g * (float)(62 - j_)); \
        const unsigned ka_[4] = {rk[S][0].x, rk[S][0].y, rk[S][0].z, rk[S][0].w}, kb_[4] = {rk[S][1].x, rk[S][1].y, rk[S][1].z, rk[S][1].w}; \
        const unsigned va_[4] = {rv[S][0].x, rv[S][0].y, rv[S][0].z, rv[S][0].w}, vb_[4] = {rv[S][1].x, rv[S][1].y, rv[S][1].z, rv[S][1].w}; \
        const int cofs_ = 16 * ((j_ >> 3) ^ (ch_ & 7)) + 2 * (j_ & 7); \
        _Pragma("unroll") for (int e2 = 0; e2 < 4; ++e2) { const int row_ = 8 * ch_ + 2 * e2; \
            *(LAS unsigned*)(lds + KT_OFF + row_ * 144 + cofs_) = pk2(__uint_as_float(ka_[e2] << 16) * te0_, __uint_as_float(kb_[e2] << 16) * te1_); \
            *(LAS unsigned*)(lds + KT_OFF + (row_ + 1) * 144 + cofs_) = pk2(__uint_as_float(ka_[e2] & 0xffff0000u) * te0_, __uint_as_float(kb_[e2] & 0xffff0000u) * te1_); \
            *(LAS unsigned*)(lds + VT_OFF + row_ * 144 + cofs_) = (va_[e2] & 0xffffu) | (vb_[e2] << 16); \
            *(LAS unsigned*)(lds + VT_OFF + (row_ + 1) * 144 + cofs_) = (va_[e2] >> 16) | (vb_[e2] & 0xffff0000u); } } while (0)
#define WG_BAR() do { asm volatile("s_waitcnt lgkmcnt(0)" ::: "memory"); __builtin_amdgcn_s_barrier(); asm volatile("" ::: "memory"); } while (0)
template <bool FULL>
__device__ __forceinline__ void ret_unit(const Params& p, LAS unsigned char* lds, int unit, int tid, int wid, int lane) {
    asm volatile("" : "+v"(tid), "+v"(lane));
    const int G = unit & 7, h = (unit >> 3) & 3, b = unit >> 5;
    const bf16_t* P = (const bf16_t*)(p.ws + WS_RB);
    bf16_t* MIX = (bf16_t*)(p.ws + WS_RA);
    float* UG = (float*)(p.ws + WS_UG);
    const size_t tok0 = (size_t)b * 4096 + (size_t)G * 512;
    const float l2g = log2f(1.0f - exp2f(-5.0f - (float)h));
    const float g64 = __builtin_amdgcn_exp2f(l2g * 64.0f);
    const bool is_state = wid >= 4; const int w4 = wid & 3;
    const int l15 = lane & 15, l4 = lane >> 4;
    const int vtL = l4 ^ (l15 >> 3);
    const int vtb0 = VT_OFF + l15 * 144 + 16 * vtL, vtb1 = VT_OFF + l15 * 144 + 16 * (vtL ^ 2);
#define VT_ADDR(nt, ks) ((((nt) & 1) ? vtb1 : vtb0) + (nt) * 2304 + 16 * (((4 * (ks)) ^ (2 * ((nt) & 3))) & 4))
    constexpr int PD = FULL ? 1 : 4;
    u32x4 rq[PD][2], rk[PD][2], rv[PD][2], rg[PD][2];
    if (is_state) {
        f32x4 st[2][8];
#pragma unroll
        for (int mt = 0; mt < 2; ++mt)
#pragma unroll
            for (int nt = 0; nt < 8; ++nt) st[mt][nt] = (f32x4){0.f, 0.f, 0.f, 0.f};
        if (FULL) {
#pragma unroll 1
            for (int Gp = 0; Gp < G; Gp += 2) {
                const float wa = __builtin_amdgcn_exp2f(l2g * 512.0f * (float)(G - 1 - Gp));
                const bool two = Gp + 1 < G;
                const float wb = two ? __builtin_amdgcn_exp2f(l2g * 512.0f * (float)(G - 2 - Gp)) : 0.f;
                const u32x2* sa = (const u32x2*)UG + ((size_t)((b * 4 + h) * 8 + Gp) * 4 + w4) * 1024 + lane;
                const u32x2* sb = two ? sa + 4 * 1024 : sa;
#pragma unroll
                for (int mt = 0; mt < 2; ++mt)
#pragma unroll
                    for (int nt = 0; nt < 8; ++nt) st[mt][nt] += unpack_bf4(sa[(mt * 8 + nt) * 64]) * wa + unpack_bf4(sb[(mt * 8 + nt) * 64]) * wb;
            }
        }
#pragma unroll
        for (int s = 0; s < PD; ++s) RET_ISSUE(s, s);
#pragma unroll 1
        for (int n0 = 0; n0 < 8; n0 += PD) {
#pragma unroll
          for (int s = 0; s < PD; ++s) { const int n = n0 + s;
            RET_STAGE_A(s);
            if (n + PD < 8) RET_ISSUE(s, n + PD);
            if (FULL) {
#pragma unroll
                for (int mt = 0; mt < 2; ++mt)
#pragma unroll
                    for (int nt = 0; nt < 8; ++nt) { const int e = 16 * nt + l15, dk0 = 32 * w4 + 16 * mt + 4 * l4;
                        *(LAS u32x2*)(lds + ST_OFF + e * 272 + dk0 * 2) = (u32x2){pk2(st[mt][nt][0], st[mt][nt][1]), pk2(st[mt][nt][2], st[mt][nt][3])}; }
            }
            WG_BAR();
            if (FULL) {
                bf16x8 ak[4];
#pragma unroll
                for (int ks = 0; ks < 4; ++ks) ak[ks] = *(const LAS bf16x8*)(lds + KI_OFF + (16 * w4 + l15) * 272 + (32 * ks + 8 * l4) * 2);
#pragma unroll
                for (int it = 0; it < 4; ++it) {
                    bf16x8 bq[4];
#pragma unroll
                    for (int ks = 0; ks < 4; ++ks) bq[ks] = *(const LAS bf16x8*)(lds + QI_OFF + (16 * it + l15) * 272 + (32 * ks + 8 * l4) * 2);
                    f32x4 sa = (f32x4){0.f, 0.f, 0.f, 0.f};
#pragma unroll
                    for (int ks = 0; ks < 4; ++ks) sa = MFMA16(ak[ks], bq[ks], sa);
                    const int i = 16 * it + l15, j0 = 16 * w4 + 4 * l4;
#pragma unroll
                    for (int r = 0; r < 4; ++r) { const int d = i - (j0 + r); sa[r] *= __builtin_amdgcn_exp2f(l2g * (float)(d < 0 ? -d : d)); }
                    *(LAS u32x2*)(lds + SI_OFF + i * 144 + j0 * 2) = (u32x2){pk2(sa[0], sa[1]), pk2(sa[2], sa[3])};
                }
            }
            WG_BAR();
#pragma unroll
            for (int mt = 0; mt < 2; ++mt)
#pragma unroll
                for (int nt = 0; nt < 8; ++nt) st[mt][nt] = st[mt][nt] * g64;
#pragma unroll
            for (int ks = 0; ks < 2; ++ks) {
                bf16x8 akt[2];
#pragma unroll
                for (int mt = 0; mt < 2; ++mt) { const int row = 32 * w4 + 16 * mt + l15; akt[mt] = *(const LAS bf16x8*)(lds + KT_OFF + row * 144 + 16 * ((4 * ks + l4) ^ ((row >> 3) & 7))); }
#pragma unroll
                for (int nh = 0; nh < 2; ++nh) {
                    bf16x8 bv[4];
#pragma unroll
                    for (int nt = 0; nt < 4; ++nt) bv[nt] = *(const LAS bf16x8*)(lds + VT_ADDR(4 * nh + nt, ks));
#pragma unroll
                    for (int nt = 0; nt < 4; ++nt)
#pragma unroll
                        for (int mt = 0; mt < 2; ++mt) st[mt][4 * nh + nt] = MFMA16(akt[mt], bv[nt], st[mt][4 * nh + nt]);
                }
            }
            WG_BAR();
          }
        }
        if (!FULL) {
            u32x2* dst = (u32x2*)UG + ((size_t)unit * 4 + w4) * 1024 + lane;
#pragma unroll
            for (int mt = 0; mt < 2; ++mt)
#pragma unroll
                for (int nt = 0; nt < 8; ++nt) dst[(mt * 8 + nt) * 64] = (u32x2){pk2(st[mt][nt][0], st[mt][nt][1]), pk2(st[mt][nt][2], st[mt][nt][3])};
        } else if (G == 7) {
            float* o = p.out + O_SRP + (size_t)(b * 4 + h) * 16384 + (64 * (l4 & 1) + 16 * w4 + 4 * (l4 >> 1)) * 128 + l15;
#pragma unroll
            for (int mt = 0; mt < 2; ++mt)
#pragma unroll
                for (int nt = 0; nt < 8; ++nt)
#pragma unroll
                    for (int r = 0; r < 4; ++r) o[(8 * mt + r) * 128 + 16 * nt] = st[mt][nt][r];
        }
    } else {
        float rwv[8];
#pragma unroll
        for (int nt = 0; nt < 8; ++nt) rwv[nt] = p.in[8][128 * h + 16 * nt + l15];
#pragma unroll
        for (int s = 0; s < PD; ++s) RET_ISSUE(s, s);
#pragma unroll 1
        for (int n0 = 0; n0 < 8; n0 += PD) {
#pragma unroll
          for (int s = 0; s < PD; ++s) { const int n = n0 + s;
            RET_STAGE_A(s);
            if (n + PD < 8) RET_ISSUE(s, n + PD);
            WG_BAR();
            f32x4 acc[8];
            if (FULL) {
                f32x4 fsv;
#pragma unroll
                for (int r = 0; r < 4; ++r) fsv[r] = __builtin_amdgcn_exp2f(l2g * (float)(16 * w4 + 4 * l4 + r + 1));
#pragma unroll
                for (int nt = 0; nt < 8; ++nt) acc[nt] = (f32x4){0.f, 0.f, 0.f, 0.f};
                bf16x8 aq[4];
#pragma unroll
                for (int ks = 0; ks < 4; ++ks) aq[ks] = *(const LAS bf16x8*)(lds + QI_OFF + (16 * w4 + l15) * 272 + (32 * ks + 8 * l4) * 2);
#pragma unroll
                for (int ks = 0; ks < 4; ++ks)
#pragma unroll
                    for (int nh = 0; nh < 2; ++nh) {
                        bf16x8 bs[4];
#pragma unroll
                        for (int nt = 0; nt < 4; ++nt) bs[nt] = *(const LAS bf16x8*)(lds + ST_OFF + (16 * (4 * nh + nt) + l15) * 272 + (32 * ks + 8 * l4) * 2);
#pragma unroll
                        for (int nt = 0; nt < 4; ++nt) acc[4 * nh + nt] = MFMA16(aq[ks], bs[nt], acc[4 * nh + nt]);
                    }
#pragma unroll
                for (int nt = 0; nt < 8; ++nt) acc[nt] = acc[nt] * fsv;
            }
            WG_BAR();
            if (FULL) {
                bf16x8 as_[2];
#pragma unroll
                for (int ks = 0; ks < 2; ++ks) as_[ks] = *(const LAS bf16x8*)(lds + SI_OFF + (16 * w4 + l15) * 144 + 16 * (4 * ks + l4));
#pragma unroll
                for (int ks = 0; ks < 2; ++ks)
#pragma unroll
                    for (int nh = 0; nh < 2; ++nh) {
                        bf16x8 bv[4];
#pragma unroll
                        for (int nt = 0; nt < 4; ++nt) bv[nt] = *(const LAS bf16x8*)(lds + VT_ADDR(4 * nh + nt, ks));
#pragma unroll
                        for (int nt = 0; nt < 4; ++nt) acc[4 * nh + nt] = MFMA16(as_[ks], bv[nt], acc[4 * nh + nt]);
                    }
                unsigned short gq[4][8];
#pragma unroll
                for (int r = 0; r < 4; ++r)
#pragma unroll
                    for (int nt = 0; nt < 8; ++nt) gq[r][nt] = *(const LAS unsigned short*)(lds + GI_OFF + (16 * w4 + 4 * l4 + r) * 272 + (16 * nt + l15) * 2);
                float rstd[4];
#pragma unroll
                for (int r = 0; r < 4; ++r) { float ss = 0.f;
#pragma unroll
                    for (int nt = 0; nt < 8; ++nt) ss += acc[nt][r] * acc[nt][r];
                    ss += dppf(ss, 1); ss += dppf(ss, 2); ss += dppf(ss, 4); ss += dppf(ss, 8);
                    ss = __shfl(ss, (lane & 48) | 15);
                    rstd[r] = rsqrtf(ss * (1.0f / 128.0f) + EPS); }
#pragma unroll
                for (int r = 0; r < 4; ++r)
#pragma unroll
                    for (int nt = 0; nt < 8; ++nt)
                        *(LAS unsigned short*)(lds + QI_OFF + (16 * w4 + 4 * l4 + r) * 272 + (16 * nt + l15) * 2) = (unsigned short)(pk2s(acc[nt][r] * rstd[r] * rwv[nt] * silu_f(bf2f(gq[r][nt])), 0.f) & 0xffffu);
#pragma unroll
                for (int q = 0; q < 4; ++q) { const int cidx = lane + 64 * q, row = 16 * w4 + (cidx >> 4), ch = cidx & 15;
                    const u32x4 v = *(const LAS u32x4*)(lds + QI_OFF + row * 272 + ch * 16);
                    *(u32x4*)(MIX + (tok0 + (size_t)n * 64 + row) * DM + 128 * h + ch * 8) = v; }
            }
            WG_BAR();
          }
        }
    }
#ifndef CONVREP
#define CONVREP 1
#endif
    if (FULL) for (int crep_ = 0; crep_ < CONVREP; ++crep_) {
        const int c0 = 128 * h + 8 * (tid & 15), run = tid >> 4, t0 = G * 512 + run * 16;
        const float* cwp = p.in[7];
        float w0[8], w1[8], w2[8], p1[8], p2[8];
#pragma unroll
        for (int e = 0; e < 8; ++e) { w0[e] = cwp[c0 + e]; w1[e] = cwp[512 + c0 + e]; w2[e] = cwp[1024 + c0 + e]; p1[e] = 0.f; p2[e] = 0.f; }
        if (t0 > 0) {
            const bf16_t* r2 = P + ((size_t)b * 4096 + t0 - 2) * NIN; const bf16_t* r1 = r2 + NIN;
            const u32x4 c2 = *(const u32x4*)(r2 + 2560 + c0), h2 = *(const u32x4*)(r2 + 3072 + c0), c1 = *(const u32x4*)(r1 + 2560 + c0), h1 = *(const u32x4*)(r1 + 3072 + c0);
            const unsigned c2w[4] = {c2.x, c2.y, c2.z, c2.w}, h2w[4] = {h2.x, h2.y, h2.z, h2.w}, c1w[4] = {c1.x, c1.y, c1.z, c1.w}, h1w[4] = {h1.x, h1.y, h1.z, h1.w};
#pragma unroll
            for (int e = 0; e < 4; ++e) {
                p2[2 * e] = __uint_as_float(c2w[e] << 16) * __uint_as_float(h2w[e] << 16); p2[2 * e + 1] = __uint_as_float(c2w[e] & 0xffff0000u) * __uint_as_float(h2w[e] & 0xffff0000u);
                p1[2 * e] = __uint_as_float(c1w[e] << 16) * __uint_as_float(h1w[e] << 16); p1[2 * e + 1] = __uint_as_float(c1w[e] & 0xffff0000u) * __uint_as_float(h1w[e] & 0xffff0000u); }
        }
#pragma unroll 8
        for (int t = 0; t < 16; ++t) {
            const size_t row = (size_t)b * 4096 + t0 + t;
            const bf16_t* rp = P + row * NIN;
            const u32x4 bb = *(const u32x4*)(rp + 2048 + c0), cc = *(const u32x4*)(rp + 2560 + c0), hh = *(const u32x4*)(rp + 3072 + c0);
            const unsigned bw[4] = {bb.x, bb.y, bb.z, bb.w}, cw4[4] = {cc.x, cc.y, cc.z, cc.w}, hw[4] = {hh.x, hh.y, hh.z, hh.w};
            float y[8];
#pragma unroll
            for (int e = 0; e < 4; ++e) {
                const float ca = __uint_as_float(cw4[e] << 16) * __uint_as_float(hw[e] << 16), cb = __uint_as_float(cw4[e] & 0xffff0000u) * __uint_as_float(hw[e] & 0xffff0000u);
                y[2 * e] = __uint_as_float(bw[e] << 16) * (w0[2 * e] * p2[2 * e] + w1[2 * e] * p1[2 * e] + w2[2 * e] * ca);
                y[2 * e + 1] = __uint_as_float(bw[e] & 0xffff0000u) * (w0[2 * e + 1] * p2[2 * e + 1] + w1[2 * e + 1] * p1[2 * e + 1] + w2[2 * e + 1] * cb);
                p2[2 * e] = p1[2 * e]; p2[2 * e + 1] = p1[2 * e + 1]; p1[2 * e] = ca; p1[2 * e + 1] = cb;
            }
            *(u32x4*)(MIX + row * DM + 512 + c0) = (u32x4){pk2(y[0], y[1]), pk2(y[2], y[3]), pk2(y[4], y[5]), pk2(y[6], y[7])};
        }
        if (G == 7 && run == 31) {
            float* o = p.out + O_CCP + (size_t)b * 1024 + c0;
#pragma unroll
            for (int e = 0; e < 8; ++e) { o[e] = p2[e]; o[512 + e] = p1[e]; }
        }
    }
#undef VT_ADDR
}

__device__ __forceinline__ float ch_at(const float* PS, const float* cache, int b, int t, int ch) {
    if (t < 0) return cache[(b * 2 + (t + 2)) * 512 + ch];
    const float* rp = PS + (size_t)(16 * b + t) * NIN;
    return rp[2560 + ch] * rp[3072 + ch];
}
__device__ __forceinline__ void sample_unit(const Params& p, LAS unsigned char* lds, int sup, int tid, int wid, int lane) {
    const int su = sup >> 2, part = sup & 3;
    const int b = su >> 2, h = su & 3, ts0 = TOK_P + 16 * b;
    const float* PS = (const float*)(p.ws + WS_PS);
    bf16_t* MIX = (bf16_t*)(p.ws + WS_RA);
    LAS float* qs = (LAS float*)lds; LAS float* ks = qs + 2048; LAS float* vs = qs + 4096; LAS float* Ssm = qs + 6144; LAS float* osm = qs + 6400;
    const float l2g = log2f(1.0f - exp2f(-5.0f - (float)h));
    const float* cosT = (const float*)(p.ws + WS_COS); const float* sinT = (const float*)(p.ws + WS_SIN);
    for (int idx = tid; idx < 2048; idx += 512) { const int i = idx >> 7, c = idx & 127, d = dmap(c);
        const float* rp = PS + (size_t)(16 * b + i) * NIN + 128 * h;
        const float cs = cosT[(4096 + i) * 64 + (d & 63)], sn = sinT[(4096 + i) * 64 + (d & 63)];
        const float xq = rp[c], xqp = rp[c ^ 4], xk = rp[512 + c], xkp = rp[512 + (c ^ 4)];
        qs[i * 128 + d] = d < 64 ? xq * cs - xqp * sn : xq * cs + xqp * sn;
        ks[i * 128 + d] = (d < 64 ? xk * cs - xkp * sn : xk * cs + xkp * sn) * 0.08838834764831845f;
        vs[i * 128 + c] = rp[1024 + c]; }
    const int e = tid & 127, sub = tid >> 7, irow = 4 * part + sub;
    LAS float* s0 = qs + 8704;
    { const float* s0g = p.in[2] + (size_t)su * 16384; f32x4 t8[8];
#pragma unroll
      for (int q = 0; q < 8; ++q) t8[q] = *((const f32x4*)s0g + tid + 512 * q);
#pragma unroll
      for (int q = 0; q < 8; ++q) *((LAS f32x4*)s0 + tid + 512 * q) = t8[q]; }
    __syncthreads();
    if (tid < 64) { const int i = 4 * part + (tid >> 4), j = tid & 15; float s = 0.f;
        for (int d = 0; d < 128; ++d) s += qs[i * 128 + d] * ks[j * 128 + d];
        const int dd = i - j; Ssm[i * 16 + j] = s * __builtin_amdgcn_exp2f(l2g * (float)(dd < 0 ? -dd : dd)); }
    float cr = 0.f;
#pragma unroll 8
    for (int d = 0; d < 128; ++d) cr += qs[irow * 128 + d] * s0[d * 128 + e];
    __syncthreads();
    { float o = 0.f;
      for (int j = 0; j < 16; ++j) o += Ssm[irow * 16 + j] * vs[j * 128 + e];
      osm[irow * 128 + e] = o + __builtin_amdgcn_exp2f(l2g * (float)(irow + 1)) * cr; }
    __syncthreads();
    if (wid < 4) { const int i = 4 * part + wid; const float v0 = osm[i * 128 + lane], v1 = osm[i * 128 + 64 + lane];
        const float rstd = rsqrtf(wave_sum(v0 * v0 + v1 * v1) * (1.0f / 128.0f) + EPS);
        const size_t token = (size_t)(ts0 + i);
        const float g0 = PS[(size_t)(16 * b + i) * NIN + 1536 + 128 * h + lane], g1 = PS[(size_t)(16 * b + i) * NIN + 1536 + 128 * h + 64 + lane];
        MIX[token * DM + 128 * h + lane] = (bf16_t)(pk2(v0 * rstd * p.in[8][128 * h + lane] * silu_f(g0), 0.f) & 0xffffu);
        MIX[token * DM + 128 * h + 64 + lane] = (bf16_t)(pk2(v1 * rstd * p.in[8][128 * h + 64 + lane] * silu_f(g1), 0.f) & 0xffffu); }
    const float g16 = __builtin_amdgcn_exp2f(l2g * 16.0f);
    float* outS = p.out + O_SRS + (size_t)su * 16384;
#pragma unroll 2
    for (int dd = 0; dd < 8; ++dd) { const int d = 32 * part + sub + 4 * dd; float a = g16 * s0[d * 128 + e];
        for (int j = 0; j < 16; ++j) a += __builtin_amdgcn_exp2f(l2g * (float)(15 - j)) * ks[j * 128 + d] * vs[j * 128 + e];
        outS[d * 128 + e] = a; }
    { const int ch = 128 * h + e; const float* cache = p.in[3]; const float* cwp = p.in[7];
      const float w0 = cwp[ch], w1 = cwp[512 + ch], w2 = cwp[1024 + ch];
      const int t = irow;
      const float c0 = ch_at(PS, cache, b, t - 2, ch), c1 = ch_at(PS, cache, b, t - 1, ch), c2 = ch_at(PS, cache, b, t, ch);
      const float y = PS[(size_t)(16 * b + t) * NIN + 2048 + ch] * (w0 * c0 + w1 * c1 + w2 * c2);
      MIX[(size_t)(ts0 + t) * DM + 512 + ch] = (bf16_t)(pk2(y, 0.f) & 0xffffu);
      if (t >= 14) p.out[O_CCS + (size_t)(b * 2 + t - 14) * 512 + ch] = c2; }
    __syncthreads();
}

constexpr int TG_B = 34816, TG_BUF = 34816 + 32 * 272;
template <int NB>
__device__ __forceinline__ void thin_gemm2(LAS unsigned char* lds, const bf16_t* A, int lda, const bf16_t* Bt, int ldb, int n0, int nbstride, int kbeg, int klen, f32x4 (&acc)[NB], int tid, int wid, int lane) {
    const int l15 = lane & 15, l4 = lane >> 4, nkb = klen >> 7;
    const bool hasb = tid < NB * 256;
    const bf16_t* ag = A + (size_t)(tid >> 4) * lda + kbeg + (tid & 15) * 8;
    const bf16_t* bg = Bt + (size_t)(n0 + (tid >> 8) * nbstride + ((tid >> 4) & 15)) * ldb + kbeg + (tid & 15) * 8;
    const int sto = (tid >> 4) * 272 + (tid & 15) * 16;
    const int fro = l15 * 272 + (8 * l4) * 2;
    u32x4 Xa[4], Ya[4], Xb = (u32x4){0u, 0u, 0u, 0u}, Yb = Xb;
#define TG_LOAD(R, kb) do { _Pragma("unroll") for (int i_ = 0; i_ < 4; ++i_) R##a[i_] = *(const u32x4*)(ag + (size_t)(32 * i_) * lda + (kb) * 128); if (hasb) R##b = *(const u32x4*)(bg + (kb) * 128); } while (0)
#define TG_STORE(R, buf) do { _Pragma("unroll") for (int i_ = 0; i_ < 4; ++i_) *(LAS u32x4*)(lds + (buf) * TG_BUF + sto + i_ * 32 * 272) = R##a[i_]; if (hasb) *(LAS u32x4*)(lds + (buf) * TG_BUF + TG_B + sto) = R##b; } while (0)
#define TG_COMP(buf) do { _Pragma("unroll") for (int ks = 0; ks < 4; ++ks) { const bf16x8 a_ = *(const LAS bf16x8*)(lds + (buf) * TG_BUF + 16 * wid * 272 + fro + ks * 64); \
        _Pragma("unroll") for (int nb = 0; nb < NB; ++nb) { const bf16x8 b_ = *(const LAS bf16x8*)(lds + (buf) * TG_BUF + TG_B + 16 * nb * 272 + fro + ks * 64); acc[nb] = MFMA16(a_, b_, acc[nb]); } } } while (0)
#pragma unroll
    for (int nb = 0; nb < NB; ++nb) acc[nb] = (f32x4){0.f, 0.f, 0.f, 0.f};
    TG_LOAD(X, 0); TG_LOAD(Y, 1);
    TG_STORE(X, 0); WG_BAR();
#pragma unroll 1
    for (int kb = 0; kb < nkb; kb += 2) {
        if (kb + 2 < nkb) TG_LOAD(X, kb + 2);
        TG_COMP(0);
        TG_STORE(Y, 1); WG_BAR();
        if (kb + 3 < nkb) TG_LOAD(Y, kb + 3);
        TG_COMP(1);
        if (kb + 2 < nkb) TG_STORE(X, 0);
        WG_BAR();
    }
#undef TG_LOAD
#undef TG_STORE
#undef TG_COMP
}
template <int NB>
__device__ __forceinline__ void thin_gemm(const bf16_t* A, int lda, const bf16_t* Bt, int ldb, int n0, int nbstride, int kbeg, int klen, f32x4 (&acc)[NB], int wid, int lane) {
    const int l15 = lane & 15, l4 = lane >> 4;
    const bf16_t* ap = A + (size_t)(16 * wid + l15) * lda + kbeg + 8 * l4;
    const bf16_t* bp = Bt + (size_t)(n0 + l15) * ldb + kbeg + 8 * l4;
#pragma unroll
    for (int nb = 0; nb < NB; ++nb) acc[nb] = (f32x4){0.f, 0.f, 0.f, 0.f};
#pragma unroll 1
    for (int s0 = 0; s0 < klen; s0 += 256) {
        bf16x8 a[8], b[NB][8];
#pragma unroll
        for (int s = 0; s < 8; ++s) { a[s] = *(const bf16x8*)(ap + s0 + 32 * s);
#pragma unroll
            for (int nb = 0; nb < NB; ++nb) b[nb][s] = *(const bf16x8*)(bp + (size_t)nb * nbstride * ldb + s0 + 32 * s); }
#pragma unroll
        for (int s = 0; s < 8; ++s)
#pragma unroll
            for (int nb = 0; nb < NB; ++nb) acc[nb] = MFMA16(a[s], b[nb][s], acc[nb]);
    }
}
__device__ __forceinline__ void thin_store(const f32x4& acc, float* out, int ldo, int col, int wid, int lane) {
#pragma unroll
    for (int r = 0; r < 4; ++r) out[(size_t)(16 * wid + 4 * (lane >> 4) + r) * ldo + col + (lane & 15)] = acc[r];
}
__device__ __forceinline__ void thin_ffn1(const Params& p, LAS unsigned char* lds, int c, int tid, int wid, int lane) {
    const int pn = c >> 3, j16 = c & 7, l15 = lane & 15, l4 = lane >> 4;
    f32x4 acc[2];
    thin_gemm2<2>(lds, (const bf16_t*)(p.ws + WS_Y) + (size_t)TOK_P * DM, DM, (const bf16_t*)(p.ws + WS_WFF1), DM, 256 * pn + 16 * j16, 128, 0, DM, acc, tid, wid, lane);
    const int ch = 128 * pn + 16 * j16 + l15, b = wid;
    const float* cw = p.in[15]; const float* cache = p.in[4] + (size_t)b * 2 * DFF + ch;
    const float w0 = cw[ch], w1 = cw[DFF + ch], w2 = cw[2 * DFF + ch];
    const f32x4 up = acc[0], gt = acc[1];
    float pm1 = __shfl_up(up[3], 16), pm2 = __shfl_up(up[2], 16);
    if (l4 == 0) { pm1 = cache[DFF]; pm2 = cache[0]; }
    float uc[4];
    uc[0] = w0 * pm2 + w1 * pm1 + w2 * up[0];
    uc[1] = w0 * pm1 + w1 * up[0] + w2 * up[1];
    uc[2] = w0 * up[0] + w1 * up[1] + w2 * up[2];
    uc[3] = w0 * up[1] + w1 * up[2] + w2 * up[3];
    bf16_t* ACT = (bf16_t*)(p.ws + WS_RB);
#pragma unroll
    for (int r = 0; r < 4; ++r) ACT[(size_t)(TOK_P + 16 * wid + 4 * l4 + r) * DFF + ch] = (bf16_t)(pk2(pg8::gelu_tanh(uc[r]) * gt[r], 0.f) & 0xffffu);
    if (l4 == 3) { float* o = p.out + O_CFS + (size_t)b * 2 * DFF + ch; o[0] = up[2]; o[DFF] = up[3]; }
}

__device__ __forceinline__ void phase4(const Params& p, int wid, int lane) {
    const int gw = blockIdx.x * 8 + wid, NGW = gridDim.x * 8;
    bf16_t* Y = (bf16_t*)(p.ws + WS_Y); const float* ssq = (const float*)(p.ws + WS_SSQ1); float* RS2 = (float*)(p.ws + WS_RS2); const bf16_t* XB = (const bf16_t*)(p.ws + WS_XB);
    const float* wpost = p.in[10];
    f32x4 wpo[4];
#pragma unroll
    for (int j = 0; j < 4; ++j) wpo[j] = *((const f32x4*)wpost + lane + 64 * j);
#pragma unroll 1
    for (int base = gw; base < TOK_P; base += RB * NGW) {
        f32x4 v[RB][4]; u32x2 yw[RB][4]; float sq[RB];
#pragma unroll
        for (int k = 0; k < RB; ++k) { const int rr = min(base + k * NGW, TOK_P - 1);
            sq[k] = lane < 16 ? ssq[(size_t)rr * 16 + lane] : 0.f;
#pragma unroll
            for (int j = 0; j < 4; ++j) { v[k][j] = unpack_bf4(__builtin_nontemporal_load((const u32x2*)(XB + (size_t)rr * DM) + lane + 64 * j)); yw[k][j] = __builtin_nontemporal_load((const u32x2*)(Y + (size_t)rr * DM) + lane + 64 * j); } }
        float s2[RB];
#pragma unroll
        for (int k = 0; k < RB; ++k) { const float rstd1 = rsqrtf(wave_sum(sq[k]) * (1.0f / DM) + EPS); s2[k] = 0.f;
#pragma unroll
            for (int j = 0; j < 4; ++j) { v[k][j] = v[k][j] + (unpack_bf4(yw[k][j]) * rstd1) * wpo[j]; s2[k] += sumsq4(v[k][j]); } }
#pragma unroll
        for (int k = 0; k < RB; ++k) { const int r = base + k * NGW; const float rstd2 = rsqrtf(wave_sum(s2[k]) * (1.0f / DM) + EPS);
            if (r < TOK_P) {
                if (lane == 0) RS2[r] = rstd2;
#pragma unroll
                for (int j = 0; j < 4; ++j) *((u32x2*)(Y + (size_t)r * DM) + lane + 64 * j) = (u32x2){pk2(v[k][j][0], v[k][j][1]), pk2(v[k][j][2], v[k][j][3])}; } }
    }
    for (int r = TOK_P + gw; r < TOK; r += NGW) {
        const float* xrow = p.in[1] + (size_t)(r - TOK_P) * DM; const float* ys = (const float*)(p.ws + WS_YS) + (size_t)(r - TOK_P) * DM;
        f32x4 yv[4], v[4]; float s = 0.f, s2 = 0.f;
#pragma unroll
        for (int j = 0; j < 4; ++j) { f32x4 a = *((const f32x4*)ys + lane + 64 * j);
#pragma unroll
            for (int q = 1; q < 4; ++q) a += *((const f32x4*)(ys + (size_t)q * 128 * DM) + lane + 64 * j);
            yv[j] = a; s += sumsq4(a); }
        const float rstd1 = rsqrtf(wave_sum(s) * (1.0f / DM) + EPS);
#pragma unroll
        for (int j = 0; j < 4; ++j) { v[j] = *((const f32x4*)xrow + lane + 64 * j) + (yv[j] * rstd1) * wpo[j]; s2 += sumsq4(v[j]);
 }
        const float rstd2 = rsqrtf(wave_sum(s2) * (1.0f / DM) + EPS);
#pragma unroll
        for (int j = 0; j < 4; ++j) { const f32x4 y = v[j] * rstd2; *((u32x2*)(Y + (size_t)r * DM) + lane + 64 * j) = (u32x2){pk2(y[0], y[1]), pk2(y[2], y[3])}; }
    }
}
__device__ __forceinline__ void phase7(const Params& p, int wid, int lane) {
    const int gw = blockIdx.x * 8 + wid, NGW = gridDim.x * 8;
    const bf16_t* F = (const bf16_t*)(p.ws + WS_RA); const bf16_t* Y = (const bf16_t*)(p.ws + WS_Y);
    const float* ssq1 = (const float*)(p.ws + WS_SSQ1); const float* ssq2 = (const float*)(p.ws + WS_SSQ2);
    f32x4 wm[4], wf[4];
#pragma unroll
    for (int j = 0; j < 4; ++j) { wm[j] = *((const f32x4*)p.in[10] + lane + 64 * j); wf[j] = *((const f32x4*)p.in[12] + lane + 64 * j); }
    constexpr int RB7 = 6;
#pragma unroll 1
    for (int base = gw; base < TOK_P; base += RB7 * NGW) {
        u32x2 xw[RB7][4], fw[RB7][4]; float sq2[RB7];
#pragma unroll
        for (int k = 0; k < RB7; ++k) { const int rr = min(base + k * NGW, TOK_P - 1);
            sq2[k] = lane < 16 ? ssq2[(size_t)rr * 16 + lane] : 0.f;
#pragma unroll
            for (int j = 0; j < 4; ++j) { xw[k][j] = __builtin_nontemporal_load((const u32x2*)(Y + (size_t)rr * DM) + lane + 64 * j); fw[k][j] = __builtin_nontemporal_load((const u32x2*)(F + (size_t)rr * DM) + lane + 64 * j); } }
#pragma unroll
        for (int k = 0; k < RB7; ++k) { const int r = base + k * NGW;
            const float rstd2 = rsqrtf(wave_sum(sq2[k]) * (1.0f / DM) + EPS);
            if (r < TOK_P) {
#pragma unroll
                for (int j = 0; j < 4; ++j) __builtin_nontemporal_store(unpack_bf4(xw[k][j]) + (unpack_bf4(fw[k][j]) * rstd2) * wf[j], (f32x4*)(p.out + (size_t)r * DM) + lane + 64 * j); } }
    }
    for (int r = TOK_P + gw; r < TOK; r += NGW) {
        const float* xrow = p.in[1] + (size_t)(r - TOK_P) * DM;
        const float* ys = (const float*)(p.ws + WS_YS) + (size_t)(r - TOK_P) * DM; const float* fs = (const float*)(p.ws + WS_FS) + (size_t)(r - TOK_P) * DM;
        f32x4 yv[4], fv[4]; float s1 = 0.f, s2 = 0.f;
#pragma unroll
        for (int j = 0; j < 4; ++j) { f32x4 a = *((const f32x4*)ys + lane + 64 * j), c = *((const f32x4*)fs + lane + 64 * j);
#pragma unroll
            for (int q = 1; q < 4; ++q) { a += *((const f32x4*)(ys + (size_t)q * 128 * DM) + lane + 64 * j); c += *((const f32x4*)(fs + (size_t)q * 128 * DM) + lane + 64 * j); }
            yv[j] = a; fv[j] = c; s1 += sumsq4(a); s2 += sumsq4(c); }
        const float rstd1 = rsqrtf(wave_sum(s1) * (1.0f / DM) + EPS), rstd2 = rsqrtf(wave_sum(s2) * (1.0f / DM) + EPS);
#pragma unroll
        for (int j = 0; j < 4; ++j) *((f32x4*)(p.out + (size_t)r * DM) + lane + 64 * j) = *((const f32x4*)xrow + lane + 64 * j) + (yv[j] * rstd1) * wm[j] + (fv[j] * rstd2) * wf[j];
    }
}


#define XB_TMO      128
#define XB_XCNT(j)  (256  + 64 * (j))
#define XB_XSUB(j)  (1280 + 64 * (j))
#define XB_XGEN(j)  (2304 + 64 * (j))
#define XB_TOP      3328
#define XB_TOPGEN   3392
#define XCD_BAR_WORDS 3456
#define XB_SPIN_CAP (1u << 18)

__device__ __forceinline__ unsigned xb_ld(unsigned* p)              { return __hip_atomic_load(p, __ATOMIC_RELAXED, __HIP_MEMORY_SCOPE_AGENT); }
__device__ __forceinline__ unsigned xb_add(unsigned* p, unsigned v) { return __hip_atomic_fetch_add(p, v, __ATOMIC_RELAXED, __HIP_MEMORY_SCOPE_AGENT); }
__device__ __forceinline__ unsigned xb_xcc_id() { return (unsigned)__builtin_amdgcn_s_getreg((3 << 11) | 20) & 0xFu; }
#define XB_SPIN(cond, bar) do { unsigned _sp = 0; while (cond) { __builtin_amdgcn_s_sleep(1); \
    if ((++_sp & 255u) == 0u) { if (xb_ld(&(bar)[XB_TMO])) break; if (_sp > XB_SPIN_CAP) { atomicAdd(&(bar)[XB_TMO], 1u); break; } } } } while (0)

struct XcdBarrier {
    unsigned* bar; unsigned x;
    volatile LAS unsigned* st;
};

__device__ __forceinline__ XcdBarrier xcd_barrier_post(unsigned* bar, volatile LAS unsigned* st) {
    XcdBarrier b; b.bar = bar; b.x = xb_xcc_id(); b.st = st;
    if (threadIdx.x == 0) (void)xb_add(&bar[XB_XCNT(b.x)], 1u);
    return b;
}
__device__ __forceinline__ void xcd_barrier_complete(unsigned* bar, unsigned x, unsigned& nloc, unsigned& nx) {
    const unsigned G = gridDim.x * gridDim.y * gridDim.z;
    unsigned sum, cnt, mine, sp = 0u;
    for (;;) {
        sum = 0u; cnt = 0u; mine = 0u;
#pragma unroll
        for (unsigned j = 0; j < 16; ++j) { const unsigned c = xb_ld(&bar[XB_XCNT(j)]); sum += c; cnt += (c > 0u) ? 1u : 0u; mine = (j == x) ? c : mine; }
        if (sum == G) break;
        __builtin_amdgcn_s_sleep(1);
        if ((++sp & 255u) == 0u) { if (xb_ld(&bar[XB_TMO])) break; if (sp > XB_SPIN_CAP) { atomicAdd(&bar[XB_TMO], 1u); break; } }
    }
    nloc = mine > 0u ? mine : 1u; nx = cnt > 0u ? cnt : 1u;
}

__device__ __forceinline__ void xcd_barrier(const XcdBarrier& b) {
    asm volatile("s_waitcnt vmcnt(0)" ::: "memory");
    __syncthreads();
    if (threadIdx.x == 0) {
        unsigned* bar = b.bar;
        __builtin_amdgcn_s_waitcnt(0);
        unsigned nloc = b.st[0], nx = b.st[1];
        if (nloc == 0u) { xcd_barrier_complete(bar, b.x, nloc, nx); b.st[0] = nloc; b.st[1] = nx; }
        const unsigned old = xb_add(&bar[XB_XSUB(b.x)], 1u);
        const unsigned gen = old / nloc;
        if (old + 1u == (gen + 1u) * nloc) {
            __builtin_amdgcn_fence(__ATOMIC_RELEASE, "agent");
            asm volatile("s_waitcnt vmcnt(0)" ::: "memory");
            const unsigned og = xb_add(&bar[XB_TOP], 1u);
            const unsigned tg = og / nx;
            if (og + 1u == (tg + 1u) * nx) xb_add(&bar[XB_TOPGEN], 1u);
            else XB_SPIN(xb_ld(&bar[XB_TOPGEN]) == tg, bar);
            __builtin_amdgcn_fence(__ATOMIC_ACQUIRE, "agent");
            xb_add(&bar[XB_XGEN(b.x)], 1u);
            asm volatile("s_waitcnt vmcnt(0)" ::: "memory");
        } else {
            XB_SPIN(xb_ld(&bar[XB_XGEN(b.x)]) == gen, bar);
            __builtin_amdgcn_fence(__ATOMIC_ACQUIRE, "agent");
            asm volatile("s_waitcnt vmcnt(0)" ::: "memory");
        }
    }
    __syncthreads();
}

#ifndef MK_LAUNCHES
#define MK_LAUNCHES 1
#endif
#ifndef REP0
#define REP0 1
#endif
#ifndef REP1
#define REP1 1
#endif
#ifndef REP2
#define REP2 1
#endif
#ifndef REP3
#define REP3 1
#endif
#ifndef REP4
#define REP4 1
#endif
#ifndef REP5
#define REP5 1
#endif
#ifndef REP6
#define REP6 1
#endif
#ifndef REP7
#define REP7 1
#endif
#define REPEAT(n) for (int rep_ = 0; rep_ < (n); ++rep_, ((rep_ < (n)) ? GRIDSYNC() : (void)0))
template <int PH_LO, int PH_HI>
__device__ __forceinline__ void run_phases(const Params& p, LAS unsigned char* lds) {
    int tid = threadIdx.x, lane = tid & 63; const int wid = __builtin_amdgcn_readfirstlane(tid >> 6);
    const int G = gridDim.x, c = blockIdx.x;
#define LAUNDER() asm volatile("" : "+v"(tid), "+v"(lane))
    XcdBarrier bar_;
    if (PH_HI - PH_LO > 1) {
        volatile LAS unsigned* stw = (volatile LAS unsigned*)(lds + LDS_BARW);
        if (threadIdx.x == 0) { stw[0] = 0u; stw[1] = 0u; }
        __syncthreads();
        bar_ = xcd_barrier_post((unsigned*)p.ws, stw);
        if (p.ws == nullptr) cg::this_grid().sync();
    }
#define GRIDSYNC() xcd_barrier(bar_)
#define SEAM(ph) do { if (PH_LO <= (ph) && (ph) + 1 < PH_HI) { GRIDSYNC(); } } while (0)
#ifdef XSYNC
    for (int xs_ = 0; xs_ < XSYNC; ++xs_) GRIDSYNC();
#endif
    if (PH_LO <= 0 && 0 < PH_HI) REPEAT(REP0) { LAUNDER(); phase0(p, lds, tid, wid, lane); }
    SEAM(0);
    if (PH_LO <= 1 && 1 < PH_HI) REPEAT(REP1) {
        for (int t = c; t < 224; t += G) { f32x4 acc[1]; thin_gemm2<1>(lds, (const bf16_t*)(p.ws + WS_RA) + (size_t)TOK_P * DM, DM, (const bf16_t*)(p.ws + WS_WIN), DM, 16 * t, 0, 0, DM, acc, tid, wid, lane);
            thin_store(acc[0], (float*)(p.ws + WS_PS), NIN, 16 * t, wid, lane); }
        pg8::Gemm g{(const bf16_t*)(p.ws + WS_XB), (const bf16_t*)(p.ws + WS_WIN), TOK_P, NIN, DM};
        pg8::StaticOrder S; S.init(TOK_P, NIN, G, c);
        pg8::EpiIn E{(bf16_t*)(p.ws + WS_RB), (const float*)(p.ws + WS_COS), (const float*)(p.ws + WS_SIN), (const float*)(p.ws + WS_RS0)};
        pg8::gemm_phase<pg8::EpiIn, pg8::StaticOrder, true, true>(lds, g, S, E);
    }
    SEAM(1);
    if (PH_LO <= 2 && 2 < PH_HI) REPEAT(REP2) {
#ifndef RUREP
#define RUREP 1
#endif
        for (int rrep_ = 0; rrep_ < RUREP; ++rrep_) for (int u = c; u < 256; u += G) ret_unit<false>(p, lds, u, tid, wid, lane);
        LAUNDER();
#ifndef SUREP
#define SUREP 1
#endif
        for (int srep_ = 0; srep_ < SUREP; ++srep_) for (int su = c; su < 128; su += G) sample_unit(p, lds, su, tid, wid, lane);
    }
    SEAM(2);
    if (PH_LO <= 3 && 3 < PH_HI) REPEAT(REP3) {
        for (int u = c; u < 256; u += G) ret_unit<true>(p, lds, u, tid, wid, lane);
    }
    SEAM(3);
    if (PH_LO <= 4 && 4 < PH_HI) REPEAT(REP4) {
        for (int t = c; t < 256; t += G) { f32x4 acc[1]; const int kq = t >> 6, nt = t & 63;
            thin_gemm2<1>(lds, (const bf16_t*)(p.ws + WS_RA) + (size_t)TOK_P * DM, DM, (const bf16_t*)(p.ws + WS_WOUT), DM, 16 * nt, 0, 256 * kq, 256, acc, tid, wid, lane);
            thin_store(acc[0], (float*)(p.ws + WS_YS) + (size_t)kq * 128 * DM, DM, 16 * nt, wid, lane); }
        pg8::Gemm g{(const bf16_t*)(p.ws + WS_RA), (const bf16_t*)(p.ws + WS_WOUT), TOK_P, DM, DM};
        pg8::StaticOrder S; S.init(TOK_P, DM, G, c);
        pg8::EpiY E{(bf16_t*)(p.ws + WS_Y), (float*)(p.ws + WS_SSQ1)};
        pg8::gemm_phase<pg8::EpiY, pg8::StaticOrder, true, true>(lds, g, S, E);
    }
    SEAM(4);
    if (PH_LO <= 5 && 5 < PH_HI) REPEAT(REP5) { LAUNDER(); phase4(p, wid, lane); }
    SEAM(5);
    if (PH_LO <= 6 && 6 < PH_HI) REPEAT(REP6) {
        for (int t = c; t < 256; t += G) thin_ffn1(p, lds, t, tid, wid, lane);
        pg8::Gemm g{(const bf16_t*)(p.ws + WS_Y), (const bf16_t*)(p.ws + WS_WFF1), TOK_P, 2 * DFF, DM};
        pg8::WalkOrder S{G, c};
        pg8::EpiFfn E{(bf16_t*)(p.ws + WS_RB), p.in[15], p.in[4], p.out + O_CFP, p.out + O_CFS, (LAS float*)(lds + LDS_HALO), (const float*)(p.ws + WS_RS2)};
        pg8::gemm_phase<pg8::EpiFfn, pg8::WalkOrder, true, true>(lds, g, S, E);
    }
    SEAM(6);
    if (PH_LO <= 7 && 7 < PH_HI) REPEAT(REP7) {
        for (int t = c; t < 256; t += G) { f32x4 acc[1]; const int kq = t >> 6, nt = t & 63;
            thin_gemm2<1>(lds, (const bf16_t*)(p.ws + WS_RB) + (size_t)TOK_P * DFF, DFF, (const bf16_t*)(p.ws + WS_WDN), DFF, 16 * nt, 0, 1024 * kq, 1024, acc, tid, wid, lane);
            thin_store(acc[0], (float*)(p.ws + WS_FS) + (size_t)kq * 128 * DM, DM, 16 * nt, wid, lane); }
        pg8::Gemm g{(const bf16_t*)(p.ws + WS_RB), (const bf16_t*)(p.ws + WS_WDN), TOK_P, DM, DFF};
        pg8::StaticOrder S; S.init(TOK_P, DM, G, c);
        pg8::EpiY E{(bf16_t*)(p.ws + WS_RA), (float*)(p.ws + WS_SSQ2)};
        pg8::gemm_phase<pg8::EpiY, pg8::StaticOrder, true, true>(lds, g, S, E);
    }
    SEAM(7);
#ifndef REP8
#define REP8 1
#endif
    if (PH_LO <= 8 && 8 < PH_HI) REPEAT(REP8) { LAUNDER(); phase7(p, wid, lane); }
#undef SEAM
}
constexpr int NPH = 9;
#if MK_LAUNCHES == 1
__global__ void __launch_bounds__(512, 2) fwd_kernel(Params p) {
    extern __shared__ __attribute__((aligned(16))) unsigned char smem[];
    run_phases<0, NPH>(p, (LAS unsigned char*)smem);
}
#else
template <int PH>
__global__ void __launch_bounds__(512, 2) fwd_phase(Params p) {
    extern __shared__ __attribute__((aligned(16))) unsigned char smem[];
    run_phases<PH, PH + 1>(p, (LAS unsigned char*)smem);
}
template <int PH> static void launch_phase(const Params& p, int grid, hipStream_t stream) {
    static bool attr = false;
    if (!attr) { (void)hipFuncSetAttribute((const void*)fwd_phase<PH>, hipFuncAttributeMaxDynamicSharedMemorySize, LDS_BYTES); attr = true; }
    hipLaunchKernelGGL(fwd_phase<PH>, dim3(grid), dim3(512), LDS_BYTES, stream, p);
}
#endif

extern "C" void kernel_launch(void* const* d_in, const int* in_sizes, int n_in, void* d_out, int out_size, void* d_ws, size_t ws_size, hipStream_t stream) {
    static int grid = 0;
    if (grid == 0) {
        if (n_in != 17 || ws_size < WS_END) { fprintf(stderr, "kernel_launch: expected 17 inputs and >= %zu bytes of workspace (got %d, %zu)\n", (size_t)WS_END, n_in, ws_size); grid = -1; return; }
        int dev = 0, cus = 0, per_cu = 0;
        (void)hipGetDevice(&dev); (void)hipDeviceGetAttribute(&cus, hipDeviceAttributeMultiprocessorCount, dev);
#if MK_LAUNCHES == 1
        if (hipFuncSetAttribute((const void*)fwd_kernel, hipFuncAttributeMaxDynamicSharedMemorySize, LDS_BYTES) != hipSuccess) { fprintf(stderr, "kernel_launch: hipFuncSetAttribute failed\n"); grid = -1; return; }
        if (hipOccupancyMaxActiveBlocksPerMultiprocessor(&per_cu, (const void*)fwd_kernel, 512, LDS_BYTES) != hipSuccess || per_cu < 1) { fprintf(stderr, "kernel_launch: occupancy query says %d\n", per_cu); per_cu = 1; }
        (void)hipGetLastError();
#endif
        grid = cus > 0 ? cus : 256;
    }
    if (grid < 0) return;
    Params p{};
    for (int i = 0; i < 17; ++i) p.in[i] = (const float*)d_in[i];
    p.out = (float*)d_out; p.ws = (unsigned char*)d_ws;
#if MK_LAUNCHES == 1
    if (hipMemsetAsync(d_ws, 0, 16384, stream) != hipSuccess) { fprintf(stderr, "kernel_launch: hipMemsetAsync failed\n"); return; }
    void* args[] = {&p};
    const hipError_t e = hipLaunchCooperativeKernel((const void*)fwd_kernel, dim3(grid), dim3(512), args, LDS_BYTES, stream);
    if (e != hipSuccess) fprintf(stderr, "kernel_launch: cooperative launch failed: %s (grid %d)\n", hipGetErrorString(e), grid);
#else
    launch_phase<0>(p, grid, stream); launch_phase<1>(p, grid, stream); launch_phase<2>(p, grid, stream); launch_phase<3>(p, grid, stream); launch_phase<4>(p, grid, stream);
    launch_phase<5>(p, grid, stream); launch_phase<6>(p, grid, stream); launch_phase<7>(p, grid, stream); launch_phase<8>(p, grid, stream);
#endif
}
```

```cpp
#include <hip/hip_runtime.h>
#include <hip/hip_cooperative_groups.h>
#include <cstdio>
#include <cstdint>
namespace cg = cooperative_groups;
namespace pg8 {
#define PG8_LAS __attribute__((address_space(3)))
typedef unsigned short bf16_t;
typedef short bf16x8 __attribute__((ext_vector_type(8)));
typedef float f32x4 __attribute__((ext_vector_type(4)));
typedef unsigned u32x4 __attribute__((ext_vector_type(4)));
constexpr int BM = 256, BK = 64, HALF = 128, HTB = HALF * BK * 2  , STAGE_BYTES = 8 * HTB, NXCD = 8, WGM = 8;

__host__ __device__ __forceinline__ int lds_byte(int r, int c) { const int st = (r >> 4) * 2 + (c >> 5), rr = r & 15, cc = c & 31, ob = rr * 64 + cc * 2; return st * 1024 + (ob ^ (((ob >> 9) & 1) << 5)); }
__host__ __device__ __forceinline__ void stage_rc(int b, int& R, int& C) { const int st = b / 1024, sb = b % 1024, swz = sb ^ (((sb >> 9) & 1) << 5); R = (st >> 1) * 16 + swz / 64; C = (st & 1) * 32 + (swz % 64) / 2; }
__host__ __device__ __forceinline__ int perm32(int rho) { const int n = rho >> 4, i = rho & 15; return 8 * (i >> 2) + 4 * n + (i & 3); }

struct Unit { int pm, pn; };
struct Gemm { const bf16_t* A; const bf16_t* Bt; int M, N, K; };

struct StaticOrder {
    int nM, nN, nwg, G, c;
    __host__ __device__ void init(int M, int N, int G_, int c_) { nM = M / BM; nN = N / BM; nwg = nM * nN; G = G_; c = c_; }
    __host__ __device__ bool next(int i, Unit& u) const {
        const long L = (long)i * G + c; if (L >= nwg) return false;
        int wgid = (int)L; { const int q = nwg / NXCD, r = nwg % NXCD, xcd = wgid % NXCD, off = wgid / NXCD; wgid = (xcd < r ? xcd * (q + 1) : r * (q + 1) + (xcd - r) * q) + off; }
        const int nig = WGM * nN, gid = wgid / nig, fm = gid * WGM, gsz = (nM - fm) < WGM ? (nM - fm) : WGM;
        u.pm = fm + ((wgid % nig) % gsz); u.pn = (wgid % nig) / gsz; return true;
    }
    __device__ __forceinline__ void a_ready(const Unit&) const {}
    __device__ __forceinline__ void done(const Unit&) const {}
};
__device__ __forceinline__ unsigned cvt_pk_bf16(float lo, float hi) { unsigned r; asm volatile("v_cvt_pk_bf16_f32 %0, %1, %2" : "=v"(r) : "v"(lo), "v"(hi)); return r; }
__device__ __forceinline__ float dpp_shr1(float v) { return __builtin_bit_cast(float, __builtin_amdgcn_update_dpp(0, __builtin_bit_cast(int, v), 0x111, 0xf, 0xf, true)); }
__device__ __forceinline__ float dpp_shr2(float v) { return __builtin_bit_cast(float, __builtin_amdgcn_update_dpp(0, __builtin_bit_cast(int, v), 0x112, 0xf, 0xf, true)); }
__device__ __forceinline__ float dpp_shl15(float v) { return __builtin_bit_cast(float, __builtin_amdgcn_update_dpp(0, __builtin_bit_cast(int, v), 0x10F, 0xf, 0xf, true)); }
__device__ __forceinline__ float dpp_shl14(float v) { return __builtin_bit_cast(float, __builtin_amdgcn_update_dpp(0, __builtin_bit_cast(int, v), 0x10E, 0xf, 0xf, true)); }
__device__ __forceinline__ float gelu_tanh(float x) {
    const float z = 0.7978845608028654f * (x + 0.044715f * x * x * x);
    const float e = __builtin_amdgcn_exp2f(-2.8853900817779268f * z);
    return x * __builtin_amdgcn_rcpf(1.0f + e);
}
constexpr int TOKP = 32768;

struct EpiIn {
    static constexpr bool PERM = true, AFTER_DRAIN = false;
    bf16_t* P; const float* cosT; const float* sinT; const float* rs0;
    __device__ __forceinline__ void operator()(const f32x4 (&acc)[2][2][4][2], const Unit& u, int wr, int wc, int fr, int fq) const {
        asm volatile("" : "+v"(fr), "+v"(fq));
        const int row0 = u.pm * BM + wr * 64 + fr, col0 = u.pn * BM + wc * 32 + 8 * fq;
        if (u.pn < 4) {
            const float sc = (u.pn >= 2) ? 0.08838834764831845f : 1.0f;
            const int f0 = 16 * wc + 4 * fq;
#pragma unroll
            for (int ai = 0; ai < 2; ++ai)
#pragma unroll
                for (int m = 0; m < 4; ++m) {
                    const int r = row0 + ai * HALF + m * 16;
                    const int pos = r < TOKP ? (r & 4095) : 4096 + ((r - TOKP) & 15);
                    const float rsr = rs0[r] * sc;
                    const f32x4 c4 = *(const f32x4*)(cosT + pos * 64 + f0) * rsr, s4 = *(const f32x4*)(sinT + pos * 64 + f0) * rsr;
                    bf16_t* rowp = P + (size_t)r * 3584 + col0;
#pragma unroll
                    for (int bj = 0; bj < 2; ++bj) {
                        const f32x4 x1 = acc[ai][bj][m][0], x2 = acc[ai][bj][m][1];
                        const f32x4 o1 = x1 * c4 - x2 * s4, o2 = x2 * c4 + x1 * s4;
                        u32x4 w; w.x = cvt_pk_bf16(o1[0], o1[1]); w.y = cvt_pk_bf16(o1[2], o1[3]); w.z = cvt_pk_bf16(o2[0], o2[1]); w.w = cvt_pk_bf16(o2[2], o2[3]);
                        *(u32x4*)(rowp + bj * HALF) = w;
                    }
                }
        } else {
#pragma unroll
            for (int ai = 0; ai < 2; ++ai)
#pragma unroll
                for (int m = 0; m < 4; ++m) {
                    bf16_t* rowp = P + (size_t)(row0 + ai * HALF + m * 16) * 3584 + col0;
                    const float rsr = rs0[row0 + ai * HALF + m * 16];
#pragma unroll
                    for (int bj = 0; bj < 2; ++bj) {
                        const f32x4 v0 = acc[ai][bj][m][0] * rsr, v1 = acc[ai][bj][m][1] * rsr;
                        u32x4 w; w.x = cvt_pk_bf16(v0[0], v0[1]); w.y = cvt_pk_bf16(v0[2], v0[3]); w.z = cvt_pk_bf16(v1[0], v1[1]); w.w = cvt_pk_bf16(v1[2], v1[3]);
                        *(u32x4*)(rowp + bj * HALF) = w;
                    }
                }
        }
    }
};

struct EpiY {
    static constexpr bool PERM = true, AFTER_DRAIN = false;
    bf16_t* Y; float* ssq;
    __device__ __forceinline__ void operator()(const f32x4 (&acc)[2][2][4][2], const Unit& u, int wr, int wc, int fr, int fq) const {
        asm volatile("" : "+v"(fr), "+v"(fq));
        const int row0 = u.pm * BM + wr * 64 + fr, col0 = u.pn * BM + wc * 32 + 8 * fq;
#pragma unroll
        for (int ai = 0; ai < 2; ++ai)
#pragma unroll
            for (int m = 0; m < 4; ++m) {
                const int r = row0 + ai * HALF + m * 16;
                bf16_t* rowp = Y + (size_t)r * 1024 + col0;
                float s = 0.f;
#pragma unroll
                for (int bj = 0; bj < 2; ++bj) {
                    const f32x4 v0 = acc[ai][bj][m][0], v1 = acc[ai][bj][m][1];
                    s += (v0[0] * v0[0] + v0[1] * v0[1]) + (v0[2] * v0[2] + v0[3] * v0[3]) + (v1[0] * v1[0] + v1[1] * v1[1]) + (v1[2] * v1[2] + v1[3] * v1[3]);
                    u32x4 w; w.x = cvt_pk_bf16(v0[0], v0[1]); w.y = cvt_pk_bf16(v0[2], v0[3]); w.z = cvt_pk_bf16(v1[0], v1[1]); w.w = cvt_pk_bf16(v1[2], v1[3]);
                    *(u32x4*)(rowp + bj * HALF) = w;
                }
                s += __shfl_xor(s, 16); s += __shfl_xor(s, 32);
                if (fq == 0) ssq[(size_t)r * 16 + u.pn * 4 + wc] = s;
            }
    }
};

struct EpiFfn {
    static constexpr bool PERM = true, AFTER_DRAIN = false;
    bf16_t* ACT; const float* cw; const float* cache; float* outp; float* outs; PG8_LAS float* halo; const float* rs2;
    __device__ __forceinline__ void operator()(const f32x4 (&acc)[2][2][4][2], const Unit& u, int wr, int wc, int fr, int fq) const {
        asm volatile("" : "+v"(fr), "+v"(fq));
        const int lc0 = wc * 32 + 8 * fq, ch0 = u.pn * 128 + lc0;
        const bool sample = false;
        const int par = u.pm & 1;
        float rs[2][4];
#pragma unroll
        for (int ai = 0; ai < 2; ++ai)
#pragma unroll
            for (int m = 0; m < 4; ++m) rs[ai][m] = rs2[u.pm * BM + ai * HALF + wr * 64 + m * 16 + fr];
        f32x4 w0[2], w1[2], w2[2];
#pragma unroll
        for (int n = 0; n < 2; ++n) { w0[n] = *(const f32x4*)(cw + ch0 + 4 * n); w1[n] = *(const f32x4*)(cw + 4096 + ch0 + 4 * n); w2[n] = *(const f32x4*)(cw + 8192 + ch0 + 4 * n); }
        if (!sample && fr >= 14) {
#pragma unroll
            for (int ai = 0; ai < 2; ++ai) { PG8_LAS float* hp = halo + ((par * 4 + 2 * ai + wr) * 2 + (fr - 14)) * 128 + lc0;
                *(PG8_LAS f32x4*)hp = acc[ai][0][3][0] * rs[ai][3]; *(PG8_LAS f32x4*)(hp + 4) = acc[ai][0][3][1] * rs[ai][3]; }
        }
        asm volatile("s_waitcnt lgkmcnt(0)" ::: "memory"); __builtin_amdgcn_s_barrier(); asm volatile("" ::: "memory");
#pragma unroll
        for (int ai = 0; ai < 2; ++ai) {
            const int blk = 2 * ai + wr;
#pragma unroll
            for (int m = 0; m < 4; ++m) {
                f32x4 pv[2]; pv[0] = (f32x4){0.f, 0.f, 0.f, 0.f}; pv[1] = pv[0];
                const int sb = 8 * ai + 4 * wr + m;
                if (sample) {
                    if (fr >= 14 && sb < 8) { const float* cp = cache + (size_t)(sb * 2 + fr - 14) * 4096 + ch0; pv[0] = *(const f32x4*)cp; pv[1] = *(const f32x4*)(cp + 4); }
                } else if (m == 0) {
                    if (fr >= 14) {
                        const bool zero = (blk == 0) && ((u.pm & 15) == 0);
                        const int hb = (blk == 0) ? ((par ^ 1) * 4 + 3) : (par * 4 + blk - 1);
                        if (!zero) { const PG8_LAS float* hp = halo + (hb * 2 + fr - 14) * 128 + lc0; pv[0] = *(const PG8_LAS f32x4*)hp; pv[1] = *(const PG8_LAS f32x4*)(hp + 4); }
                    }
                } else { pv[0] = acc[ai][0][m - 1][0] * rs[ai][m - 1]; pv[1] = acc[ai][0][m - 1][1] * rs[ai][m - 1]; }
                const int r = u.pm * BM + ai * HALF + wr * 64 + m * 16 + fr;
                f32x4 a4[2];
#pragma unroll
                for (int n = 0; n < 2; ++n) {
                    const f32x4 cur = acc[ai][0][m][n] * rs[ai][m], gt = acc[ai][1][m][n] * rs[ai][m];
                    f32x4 p1, p2;
#pragma unroll
                    for (int e = 0; e < 4; ++e) { p1[e] = dpp_shr1(cur[e]) + dpp_shl15(pv[n][e]); p2[e] = dpp_shr2(cur[e]) + dpp_shl14(pv[n][e]); }
                    const f32x4 uc = w0[n] * p2 + w1[n] * p1 + w2[n] * cur;
                    const f32x4 zz = (uc * uc * 0.044715f + 1.0f) * uc * (-2.8853900817779268f * 0.7978845608028654f);
                    f32x4 rr;
#pragma unroll
                    for (int e = 0; e < 4; ++e) rr[e] = __builtin_amdgcn_rcpf(1.0f + __builtin_amdgcn_exp2f(zz[e]));
                    a4[n] = uc * rr * gt;
                }
                u32x4 w; w.x = cvt_pk_bf16(a4[0][0], a4[0][1]); w.y = cvt_pk_bf16(a4[0][2], a4[0][3]); w.z = cvt_pk_bf16(a4[1][0], a4[1][1]); w.w = cvt_pk_bf16(a4[1][2], a4[1][3]);
                *(u32x4*)(ACT + (size_t)r * 4096 + ch0) = w;
                if (sample) {
                    if (fr >= 14 && sb < 8) { float* op = outs + (size_t)(sb * 2 + fr - 14) * 4096 + ch0; *(f32x4*)op = acc[ai][0][m][0]; *(f32x4*)(op + 4) = acc[ai][0][m][1]; }
                } else if (m == 3 && blk == 3 && (u.pm & 15) == 15 && fr >= 14) {
                    float* op = outp + (size_t)((u.pm >> 4) * 2 + fr - 14) * 4096 + ch0; *(f32x4*)op = acc[ai][0][m][0] * rs[ai][m]; *(f32x4*)(op + 4) = acc[ai][0][m][1] * rs[ai][m];
                }
            }
        }
    }
};
struct WalkOrder {
    int G, c;
    __device__ __forceinline__ bool next(int i, Unit& u) const {
        int w = c, rem = i;
        while (w < 256) { const int len = 16;
            if (rem < len) { if (w < 256) { u.pm = (w >> 5) * 16 + rem; u.pn = w & 31; } else { u.pm = 128; u.pn = w - 256; } return true; }
            rem -= len; w += G; }
        return false;
    }
    __device__ __forceinline__ void a_ready(const Unit&) const {}
    __device__ __forceinline__ void done(const Unit&) const {}
};
template <class Epi, class Sched, bool ALIGN_EPI = false, bool SP2 = false>
__device__ __forceinline__ void gemm_phase(PG8_LAS unsigned char* lds, const Gemm g, const Sched& S, const Epi& E) {
    int tid_raw = threadIdx.x; asm volatile("" : "+v"(tid_raw));
    const int tid = tid_raw, wid = __builtin_amdgcn_readfirstlane(tid >> 6), lane = tid & 63, wr = wid >> 2, wc = wid & 3, fr = lane & 15, fq = lane >> 4;
    const int K = g.K, nt = K / BK;
    unsigned voffA[2], voffB[2];
#pragma unroll
    for (int i = 0; i < 2; ++i) { int R, C; stage_rc(tid * 16 + i * 8192, R, C); const int Rb = Epi::PERM ? ((R & ~31) + perm32(R & 31)) : R;
        voffA[i] = (unsigned)(R * K + C) * 2u; voffB[i] = (unsigned)(Rb * K + C) * 2u; }
    const size_t kstep = (size_t)(BK * 2);
    const size_t hstep = (size_t)HALF * K * 2;
    const size_t tstep = 2 * hstep;
    const unsigned ldsw = (unsigned)wid * 1024u;
    const int aoff = lds_byte(wr * 64 + fr, fq * 8), boff = lds_byte(wc * 32 + fr, fq * 8);
#define PG8_SA(b, h) (((b) * 2 + (h)) * HTB)
#define PG8_SB(b, h) ((4 + (b) * 2 + (h)) * HTB)
#define PG8_STAGE(bufoff, gbase, voff) do { _Pragma("unroll") for (int _i = 0; _i < 2; ++_i) \
        __builtin_amdgcn_global_load_lds((const unsigned*)((const char*)(gbase) + (voff)[_i]), (PG8_LAS unsigned*)(lds + (bufoff) + ldsw + _i * 8192), 16, 0, 0); } while (0)
#define PG8_LDA(dst, b, h) do { _Pragma("unroll") for (int m = 0; m < 4; ++m) _Pragma("unroll") for (int k = 0; k < 2; ++k) dst[m][k] = *(const PG8_LAS bf16x8*)(lds + PG8_SA(b, h) + aoff + m * 2048 + k * 1024); } while (0)
#define PG8_LDB(dst, b, h) do { _Pragma("unroll") for (int n = 0; n < 2; ++n) _Pragma("unroll") for (int k = 0; k < 2; ++k) dst[n][k] = *(const PG8_LAS bf16x8*)(lds + PG8_SB(b, h) + boff + n * 2048 + k * 1024); } while (0)
#define PG8_MMA(ai, bj, At, Bt) do { __builtin_amdgcn_s_setprio(1); _Pragma("unroll") for (int m = 0; m < 4; ++m) _Pragma("unroll") for (int n = 0; n < 2; ++n) _Pragma("unroll") for (int k = 0; k < 2; ++k) \
        acc[ai][bj][m][n] = __builtin_amdgcn_mfma_f32_16x16x32_bf16(Bt[n][k], At[m][k], acc[ai][bj][m][n], 0, 0, 0); __builtin_amdgcn_s_setprio(0); } while (0)
#define PG8_WAIT_V(n) asm volatile("s_waitcnt vmcnt(" #n ")" ::: "memory")
#define PG8_WAIT_L(n) asm volatile("s_waitcnt lgkmcnt(" #n ")" ::: "memory")
#define PG8_BAR __builtin_amdgcn_s_barrier()
#define PG8_SCHED __builtin_amdgcn_sched_barrier(0)
    Unit cur, nxt; int ui = 0;
    if (!S.next(0, cur)) return;
    f32x4 acc[2][2][4][2];
#pragma unroll
    for (int a = 0; a < 2; ++a)
#pragma unroll
        for (int b = 0; b < 2; ++b)
#pragma unroll
            for (int m = 0; m < 4; ++m)
#pragma unroll
                for (int n = 0; n < 2; ++n) acc[a][b][m][n] = (f32x4){0.f, 0.f, 0.f, 0.f};
    bf16x8 At[4][2], B0[2][2], B1[2][2];
    const char* cA = (const char*)g.A + (size_t)cur.pm * tstep; const char* cB = (const char*)g.Bt + (size_t)cur.pn * tstep;
    S.a_ready(cur);
    if constexpr (SP2) {
        PG8_STAGE(PG8_SB(0, 0), cB, voffB); PG8_STAGE(PG8_SB(0, 1), cB + hstep, voffB); PG8_STAGE(PG8_SA(0, 0), cA, voffA); PG8_STAGE(PG8_SA(0, 1), cA + hstep, voffA);
        if (wr == 1) PG8_BAR;
        PG8_WAIT_V(2); PG8_BAR;
        PG8_STAGE(PG8_SB(1, 0), cB + kstep, voffB); PG8_STAGE(PG8_SA(1, 0), cA + kstep, voffA); PG8_STAGE(PG8_SB(1, 1), cB + hstep + kstep, voffB);
        PG8_WAIT_V(6); PG8_BAR;
    } else {
        PG8_STAGE(PG8_SB(0, 0), cB, voffB); PG8_STAGE(PG8_SA(0, 0), cA, voffA); PG8_STAGE(PG8_SB(0, 1), cB + hstep, voffB); PG8_STAGE(PG8_SA(0, 1), cA + hstep, voffA);
        if (wr == 1) PG8_BAR;
        PG8_WAIT_V(4); PG8_BAR;
        PG8_STAGE(PG8_SB(1, 0), cB + kstep, voffB); PG8_STAGE(PG8_SA(1, 0), cA + kstep, voffA); PG8_STAGE(PG8_SB(1, 1), cB + hstep + kstep, voffB);
        PG8_WAIT_V(6); PG8_BAR;
    }
    for (;;) {
        const bool has_next = S.next(ui + 1, nxt);
        const char* nA = has_next ? (const char*)g.A + (size_t)nxt.pm * tstep : cA; const char* nB = has_next ? (const char*)g.Bt + (size_t)nxt.pn * tstep : cB;
        for (int t = 0; t < nt; t += 2) {
            const bool last = (t == nt - 2);
            const char* a1 = cA + (size_t)(t + 1) * kstep;
            const char* a2 = last ? nA : cA + (size_t)(t + 2) * kstep; const char* b2 = last ? nB : cB + (size_t)(t + 2) * kstep;
            const char* a3 = a2 + kstep; const char* b3 = b2 + kstep;
            if (last && has_next) S.a_ready(nxt);
            if constexpr (SP2) {
            PG8_LDB(B0, 0, 0); PG8_LDB(B1, 0, 1); PG8_SCHED; PG8_LDA(At, 0, 0); PG8_STAGE(PG8_SA(1, 1), a1 + hstep, voffA);
            PG8_WAIT_V(8); PG8_WAIT_L(0); PG8_BAR; PG8_MMA(0, 0, At, B0); PG8_MMA(0, 1, At, B1); PG8_BAR; PG8_SCHED;
            PG8_LDA(At, 0, 1); PG8_STAGE(PG8_SB(0, 0), b2, voffB); PG8_STAGE(PG8_SB(0, 1), b2 + hstep, voffB); PG8_STAGE(PG8_SA(0, 0), a2, voffA);
            PG8_WAIT_V(8); PG8_WAIT_L(0); PG8_BAR; PG8_MMA(1, 0, At, B0); PG8_MMA(1, 1, At, B1); PG8_BAR; PG8_SCHED;
            PG8_LDB(B0, 1, 0); PG8_LDB(B1, 1, 1); PG8_SCHED; PG8_LDA(At, 1, 0); PG8_STAGE(PG8_SA(0, 1), a2 + hstep, voffA);
            PG8_WAIT_V(8); PG8_WAIT_L(0); PG8_BAR; PG8_MMA(0, 0, At, B0); PG8_MMA(0, 1, At, B1); PG8_BAR; PG8_SCHED;
            PG8_LDA(At, 1, 1); PG8_STAGE(PG8_SB(1, 0), b3, voffB); PG8_STAGE(PG8_SB(1, 1), b3 + hstep, voffB); PG8_STAGE(PG8_SA(1, 0), a3, voffA);
            PG8_WAIT_V(8); PG8_WAIT_L(0); PG8_BAR; PG8_MMA(1, 0, At, B0); PG8_MMA(1, 1, At, B1); PG8_BAR; PG8_SCHED;
            } else {
            PG8_LDB(B0, 0, 0); PG8_SCHED; PG8_LDA(At, 0, 0); PG8_STAGE(PG8_SA(1, 1), a1 + hstep, voffA);
            PG8_WAIT_L(8); PG8_BAR; PG8_WAIT_L(0); PG8_MMA(0, 0, At, B0); PG8_BAR; PG8_SCHED;
            PG8_LDB(B1, 0, 1); PG8_STAGE(PG8_SB(0, 0), b2, voffB);
            PG8_BAR; PG8_WAIT_L(0); PG8_MMA(0, 1, At, B1); PG8_BAR;
            PG8_LDA(At, 0, 1); PG8_STAGE(PG8_SA(0, 0), a2, voffA);
            PG8_BAR; PG8_WAIT_L(0); PG8_MMA(1, 0, At, B0); PG8_BAR; PG8_SCHED;
            PG8_STAGE(PG8_SB(0, 1), b2 + hstep, voffB);
            PG8_WAIT_V(6); PG8_BAR; PG8_MMA(1, 1, At, B1); PG8_BAR;
            PG8_LDB(B0, 1, 0); PG8_SCHED; PG8_LDA(At, 1, 0); PG8_STAGE(PG8_SA(0, 1), a2 + hstep, voffA);
            PG8_WAIT_L(8); PG8_BAR; PG8_WAIT_L(0); PG8_MMA(0, 0, At, B0); PG8_BAR; PG8_SCHED;
            PG8_LDB(B1, 1, 1); PG8_STAGE(PG8_SB(1, 0), b3, voffB);
            PG8_BAR; PG8_WAIT_L(0); PG8_MMA(0, 1, At, B1); PG8_BAR;
            PG8_LDA(At, 1, 1); PG8_STAGE(PG8_SA(1, 0), a3, voffA);
            PG8_BAR; PG8_WAIT_L(0); PG8_MMA(1, 0, At, B0); PG8_BAR; PG8_SCHED;
            PG8_STAGE(PG8_SB(1, 1), b3 + hstep, voffB);
            PG8_WAIT_V(6); PG8_BAR; PG8_MMA(1, 1, At, B1); PG8_BAR;
            }
        }
        if constexpr (ALIGN_EPI) { if (wr == 0) PG8_BAR; }
        if constexpr (!Epi::AFTER_DRAIN) { E(acc, cur, wr, wc, fr, fq); S.done(cur); }
        if (!has_next) break;
#pragma unroll
        for (int a = 0; a < 2; ++a)
#pragma unroll
            for (int b = 0; b < 2; ++b)
#pragma unroll
                for (int m = 0; m < 4; ++m)
#pragma unroll
                    for (int n = 0; n < 2; ++n) acc[a][b][m][n] = (f32x4){0.f, 0.f, 0.f, 0.f};
        cur = nxt; cA = nA; cB = nB; ++ui;
        if constexpr (ALIGN_EPI) { if (wr == 1) PG8_BAR; }
    }
    PG8_WAIT_V(0);
    if constexpr (!ALIGN_EPI) { if (wr == 0) PG8_BAR; }
    PG8_BAR;
    if constexpr (Epi::AFTER_DRAIN) { E.fused(acc, cur, wr, wc, fr, fq, lds, wid, lane); S.done(cur); }
#undef PG8_SA
#undef PG8_SB
#undef PG8_STAGE
#undef PG8_LDA
#undef PG8_LDB
#undef PG8_MMA
#undef PG8_WAIT_V
#undef PG8_WAIT_L
#undef PG8_BAR
#undef PG8_SCHED
}
}

using pg8::bf16_t; using pg8::bf16x8; using pg8::f32x4; using pg8::u32x4;
#define LAS __attribute__((address_space(3)))
typedef unsigned u32x2 __attribute__((ext_vector_type(2)));
constexpr int DM = 1024, NIN = 3584, DFF = 4096;
constexpr int TOK_P = 32768, TOK = 32896, TOKPAD = 33024;
constexpr float EPS = 1e-6f;
constexpr size_t WS_WIN = 16384;
constexpr size_t WS_WOUT = WS_WIN + (size_t)NIN * DM * 2;
constexpr size_t WS_WFF1 = WS_WOUT + (size_t)DM * DM * 2;
constexpr size_t WS_WDN = WS_WFF1 + (size_t)2 * DFF * DM * 2;
constexpr size_t WS_COS = WS_WDN + (size_t)DM * DFF * 2;
constexpr size_t WS_SIN = WS_COS + (size_t)4112 * 64 * 4;
constexpr size_t WS_SSQ1 = WS_SIN + (size_t)4112 * 64 * 4;
constexpr size_t WS_SSQ2 = WS_SSQ1 + (size_t)TOKPAD * 16 * 4;
constexpr size_t WS_UG = WS_SSQ2 + (size_t)TOKPAD * 16 * 4;
constexpr size_t WS_PS = WS_UG + (size_t)256 * 32768;
constexpr size_t WS_YS = WS_PS + (size_t)128 * NIN * 4;
constexpr size_t WS_FS = WS_YS + (size_t)4 * 128 * DM * 4;
constexpr size_t WS_RA = WS_FS + (size_t)4 * 128 * DM * 4;
constexpr size_t WS_RB = WS_RA + (size_t)TOKPAD * DM * 2;
constexpr size_t WS_Y = WS_RB + (size_t)TOKPAD * DFF * 2;
constexpr size_t WS_RS2 = WS_Y + (size_t)TOKPAD * DM * 2;
constexpr size_t WS_RS0 = WS_RS2 + (size_t)TOK_P * 4;
constexpr size_t WS_XB = WS_RS0 + (size_t)TOK_P * 4;
constexpr size_t WS_END = WS_XB + (size_t)TOK_P * DM * 2;
constexpr size_t O_SRP = (size_t)TOK * DM, O_CCP = O_SRP + 524288, O_CFP = O_CCP + 8192, O_SRS = O_CFP + 65536, O_CCS = O_SRS + 524288, O_CFS = O_CCS + 8192;
constexpr int LDS_HALO = 131072, LDS_BARW = 131072 + 8192, LDS_BYTES = LDS_BARW + 16;

struct Params { const float* in[17]; float* out; unsigned char* ws; };

__device__ __forceinline__ float dppf(float v, const int ctrl_sel) {
    const int iv = __builtin_bit_cast(int, v); int r;
    switch (ctrl_sel) { case 1: r = __builtin_amdgcn_update_dpp(0, iv, 0x111, 0xf, 0xf, true); break; case 2: r = __builtin_amdgcn_update_dpp(0, iv, 0x112, 0xf, 0xf, true); break;
        case 4: r = __builtin_amdgcn_update_dpp(0, iv, 0x114, 0xf, 0xf, true); break; case 8: r = __builtin_amdgcn_update_dpp(0, iv, 0x118, 0xf, 0xf, true); break;
        case 15: r = __builtin_amdgcn_update_dpp(0, iv, 0x142, 0xa, 0xf, false); break; default: r = __builtin_amdgcn_update_dpp(0, iv, 0x143, 0xc, 0xf, false); break; }
    return __builtin_bit_cast(float, r);
}
__device__ __forceinline__ float wave_sum(float v) {
    v += dppf(v, 1); v += dppf(v, 2); v += dppf(v, 4); v += dppf(v, 8); v += dppf(v, 15); v += dppf(v, 31);
    return __builtin_bit_cast(float, __builtin_amdgcn_readlane(__builtin_bit_cast(int, v), 63));
}
__device__ __forceinline__ float bf2f(unsigned short b) { return __uint_as_float(((unsigned)b) << 16); }
__device__ __forceinline__ unsigned pk2(float a, float b) { return pg8::cvt_pk_bf16(a, b); }
__device__ __forceinline__ unsigned pk2s(float a, float b) { unsigned r; asm("v_cvt_pk_bf16_f32 %0, %1, %2" : "=v"(r) : "v"(a), "v"(b)); return r; }
__device__ __forceinline__ float silu_f(float g) { return g * __builtin_amdgcn_rcpf(1.0f + __builtin_amdgcn_exp2f(-1.4426950408889634f * g)); }
__device__ __forceinline__ int dmap(int P) { return ((P >> 2) & 1) * 64 + (P >> 3) * 4 + (P & 3); }
__device__ __forceinline__ int pmap(int d) { return ((d >> 4) & 3) * 32 + ((d >> 2) & 3) * 8 + ((d >> 6) & 1) * 4 + (d & 3); }

constexpr int RB = 6;
__device__ __forceinline__ f32x4 unpack_bf4(const u32x2 w) { f32x4 v; v[0] = __uint_as_float(w.x << 16); v[1] = __uint_as_float(w.x & 0xffff0000u); v[2] = __uint_as_float(w.y << 16); v[3] = __uint_as_float(w.y & 0xffff0000u); return v; }
__device__ __forceinline__ float sumsq4(const f32x4 a) { return (a[0] * a[0] + a[1] * a[1]) + (a[2] * a[2] + a[3] * a[3]); }
template <int MODE> __device__ __forceinline__ int rowmap(int c) {
    if (MODE == 0) { if (c < 1024) return (c & ~127) + pmap(c & 127); return c; }
    if (MODE == 1) return c;
    if (MODE == 2) return ((c >> 7) << 8) + (c & 127);
    return ((c >> 7) << 8) + 128 + (c & 127);
}
template <int MODE, bool GAIN = false>
__device__ __forceinline__ void transpose_item(const float* W, int K, int N, bf16_t* WT, LAS float* scr, int item, int lane, const float* gain = nullptr) {
    const int nblk = N / 32, kb = item / nblk, nb = item % nblk, k0 = 64 * kb, n0 = 32 * nb;
#pragma unroll
    for (int i = 0; i < 32; ++i) { const int kk = 2 * i + (lane >> 5); scr[kk * 33 + (lane & 31)] = W[(size_t)(k0 + kk) * N + n0 + (lane & 31)]; }
    asm volatile("s_waitcnt lgkmcnt(0)" ::: "memory");
    const int c = lane & 7;
    f32x4 ga = (f32x4){1.f, 1.f, 1.f, 1.f}, gb = ga;
    if (GAIN) { ga = *(const f32x4*)(gain + k0 + 8 * c); gb = *(const f32x4*)(gain + k0 + 8 * c + 4); }
#pragma unroll
    for (int j = 0; j < 4; ++j) { const int n = (lane >> 3) + 8 * j; const LAS float* s = scr + (8 * c) * 33 + n;
        u32x4 o; o.x = pk2(s[0 * 33] * ga[0], s[1 * 33] * ga[1]); o.y = pk2(s[2 * 33] * ga[2], s[3 * 33] * ga[3]); o.z = pk2(s[4 * 33] * gb[0], s[5 * 33] * gb[1]); o.w = pk2(s[6 * 33] * gb[2], s[7 * 33] * gb[3]);
        *(u32x4*)(WT + (size_t)rowmap<MODE>(n0 + n) * K + k0 + 8 * c) = o; }
    asm volatile("s_waitcnt lgkmcnt(0)" ::: "memory");
}
__device__ __forceinline__ void phase0(const Params& p, LAS unsigned char* lds, int tid, int wid, int lane) {
    LAS float* scr = (LAS float*)(lds + wid * 8448);
    const int gw = blockIdx.x * 8 + wid, NGW = gridDim.x * 8;
    bf16_t* win = (bf16_t*)(p.ws + WS_WIN); bf16_t* wout = (bf16_t*)(p.ws + WS_WOUT); bf16_t* wff1 = (bf16_t*)(p.ws + WS_WFF1); bf16_t* wdn = (bf16_t*)(p.ws + WS_WDN);
    constexpr int I_IN = 16 * 112, I_OUT = 16 * 32, I_UP = 16 * 128, I_DN = 64 * 32, NITEMS = I_IN + I_OUT + 2 * I_UP + I_DN;
    for (int it = gw; it < NITEMS; it += NGW) {
        int r = it;
        if (r < I_IN) { transpose_item<0, true>(p.in[5], DM, NIN, win, scr, r, lane, p.in[9]); continue; } r -= I_IN;
        if (r < I_OUT) { transpose_item<1>(p.in[6], DM, DM, wout, scr, r, lane); continue; } r -= I_OUT;
        if (r < I_UP) { transpose_item<2, true>(p.in[13], DM, DFF, wff1, scr, r, lane, p.in[11]); continue; } r -= I_UP;
        if (r < I_UP) { transpose_item<3, true>(p.in[14], DM, DFF, wff1, scr, r, lane, p.in[11]); continue; } r -= I_UP;
        transpose_item<1>(p.in[16], DFF, DM, wdn, scr, r, lane);
    }
    float* cosT = (float*)(p.ws + WS_COS); float* sinT = (float*)(p.ws + WS_SIN);
    for (int idx = blockIdx.x * 512 + tid; idx < 4112 * 64; idx += gridDim.x * 512) {
        const int pos = idx >> 6, f = idx & 63;
        const float inv = exp2f(-(float)(2 * f) * (1.0f / 128.0f) * 13.287712379549449f);
        const float ang = (float)pos * inv;
        const double rev = (double)ang * 0.15915494309189535;
        const float fr = (float)(rev - floor(rev));
        cosT[idx] = __builtin_amdgcn_cosf(fr); sinT[idx] = __builtin_amdgcn_sinf(fr);
    }
    bf16_t* H = (bf16_t*)(p.ws + WS_RA); bf16_t* XB = (bf16_t*)(p.ws + WS_XB); float* RS0 = (float*)(p.ws + WS_RS0);
#pragma unroll 1
    for (int base = gw; base < TOK; base += RB * NGW) {
        f32x4 v[RB][4]; float s[RB];
#pragma unroll
        for (int k = 0; k < RB; ++k) { const int rr = min(base + k * NGW, TOK - 1);
            const float* xrow = rr < TOK_P ? p.in[0] + (size_t)rr * DM : p.in[1] + (size_t)(rr - TOK_P) * DM; s[k] = 0.f;
#pragma unroll
            for (int j = 0; j < 4; ++j) { v[k][j] = __builtin_nontemporal_load((const f32x4*)xrow + lane + 64 * j); s[k] += sumsq4(v[k][j]); } }
#pragma unroll
        for (int k = 0; k < RB; ++k) { const int r = base + k * NGW; const float rstd = rsqrtf(wave_sum(s[k]) * (1.0f / DM) + EPS);
            if (r < TOK_P) {
                if (lane == 0) RS0[r] = rstd;
#pragma unroll
                for (int j = 0; j < 4; ++j) *((u32x2*)(XB + (size_t)r * DM) + lane + 64 * j) = (u32x2){pk2(v[k][j][0], v[k][j][1]), pk2(v[k][j][2], v[k][j][3])};
            } else if (r < TOK) {
#pragma unroll
                for (int j = 0; j < 4; ++j) { const f32x4 y = v[k][j] * rstd; *((u32x2*)(H + (size_t)r * DM) + lane + 64 * j) = (u32x2){pk2(y[0], y[1]), pk2(y[2], y[3])}; } } }
    }
}

constexpr int QI_OFF = 0, KI_OFF = 17408, KT_OFF = 34816, VT_OFF = 53248, SI_OFF = 71680, ST_OFF = 80896, GI_OFF = 115712;
#define MFMA16(a, b, c) __builtin_amdgcn_mfma_f32_16x16x32_bf16((a), (b), (c), 0, 0, 0)
#define RET_ISSUE(S, nn) do { _Pragma("unroll") for (int i_ = 0; i_ < 2; ++i_) { \
        const bf16_t* rowp_ = P + (tok0 + (size_t)(nn) * 64 + 2 * (tid >> 4) + i_) * NIN + 128 * h + (tid & 15) * 8; \
        if (FULL) { rq[S][i_] = *(const u32x4*)rowp_; rg[S][i_] = *(const u32x4*)(rowp_ + 1536); } rk[S][i_] = *(const u32x4*)(rowp_ + 512); rv[S][i_] = *(const u32x4*)(rowp_ + 1024); } } while (0)
#define RET_STAGE_A(S) do { const int j_ = 2 * (tid >> 4), ch_ = tid & 15; \
        if (FULL) { _Pragma("unroll") for (int i_ = 0; i_ < 2; ++i_) { *(LAS u32x4*)(lds + QI_OFF + (j_ + i_) * 272 + ch_ * 16) = rq[S][i_]; *(LAS u32x4*)(lds + KI_OFF + (j_ + i_) * 272 + ch_ * 16) = rk[S][i_]; *(LAS u32x4*)(lds + GI_OFF + (j_ + i_) * 272 + ch_ * 16) = rg[S][i_]; } } \
        const float te0_ = __builtin_amdgcn_exp2f(l2g * (float)(63 - j_)), te1_ = __builtin_amdgcn_exp2f(l2g * (float)(62 - j_)); \
        const unsigned ka_[4] = {rk[S][0].x, rk[S][0].y, rk[S][0].z, rk[S][0].w}, kb_[4] = {rk[S][1].x, rk[S][1].y, rk[S][1].z, rk[S][1].w}; \
        const unsigned va_[4] = {rv[S][0].x, rv[S][0].y, rv[S][0].z, rv[S][0].w}, vb_[4] = {rv[S][1].x, rv[S][1].y, rv[S][1].z, rv[S][1].w}; \
        const int cofs_ = 16 * ((j_ >> 3) ^ (ch_ & 7)) + 2 * (j_ & 7); \
        _Pragma("unroll") for (int e2 = 0; e2 < 4; ++e2) { const int row_ = 8 * ch_ + 2 * e2; \
            *(LAS unsigned*)(lds + KT_OFF + row_ * 144 + cofs_) = pk2(__uint_as_float(ka_[e2] << 16) * te0_, __uint_as_float(kb_[e2] << 16) * te1_); \
            *(LAS unsigned*)(lds + KT_OFF + (row_ + 1) * 144 + cofs_) = pk2(__uint_as_float(ka_[e2] & 0xffff0000u) * te0_, __uint_as_float(kb_[e2] & 0xffff0000u) * te1_); \
            *(LAS unsigned*)(lds + VT_OFF + row_ * 144 + cofs_) = (va_[e2] & 0xffffu) | (vb_[e2] << 16); \
            *(LAS unsigned*)(lds + VT_OFF + (row_ + 1) * 144 + cofs_) = (va_[e2] >> 16) | (vb_[e2] & 0xffff0000u); } } while (0)
#define WG_BAR() do { asm volatile("s_waitcnt lgkmcnt(0)" ::: "memory"); __builtin_amdgcn_s_barrier(); asm volatile("" ::: "memory"); } while (0)
template <bool FULL>
__device__ __forceinline__ void ret_unit(const Params& p, LAS unsigned char* lds, int unit, int tid, int wid, int lane) {
    asm volatile("" : "+v"(tid), "+v"(lane));
    const int G = unit & 7, h = (unit >> 3) & 3, b = unit >> 5;
    const bf16_t* P = (const bf16_t*)(p.ws + WS_RB);
    bf16_t* MIX = (bf16_t*)(p.ws + WS_RA);
    float* UG = (float*)(p.ws + WS_UG);
    const size_t tok0 = (size_t)b * 4096 + (size_t)G * 512;
    const float l2g = log2f(1.0f - exp2f(-5.0f - (float)h));
    const float g64 = __builtin_amdgcn_exp2f(l2g * 64.0f);
    const bool is_state = wid >= 4; const int w4 = wid & 3;
    const int l15 = lane & 15, l4 = lane >> 4;
    const int vtL = l4 ^ (l15 >> 3);
    const int vtb0 = VT_OFF + l15 * 144 + 16 * vtL, vtb1 = VT_OFF + l15 * 144 + 16 * (vtL ^ 2);
#define VT_ADDR(nt, ks) ((((nt) & 1) ? vtb1 : vtb0) + (nt) * 2304 + 16 * (((4 * (ks)) ^ (2 * ((nt) & 3))) & 4))
    constexpr int PD = FULL ? 1 : 4;
    u32x4 rq[PD][2], rk[PD][2], rv[PD][2], rg[PD][2];
    if (is_state) {
        f32x4 st[2][8];
#pragma unroll
        for (int mt = 0; mt < 2; ++mt)
#pragma unroll
            for (int nt = 0; nt < 8; ++nt) st[mt][nt] = (f32x4){0.f, 0.f, 0.f, 0.f};
        if (FULL) {
#pragma unroll 1
            for (int Gp = 0; Gp < G; Gp += 2) {
                const float wa = __builtin_amdgcn_exp2f(l2g * 512.0f * (float)(G - 1 - Gp));
                const bool two = Gp + 1 < G;
                const float wb = two ? __builtin_amdgcn_exp2f(l2g * 512.0f * (float)(G - 2 - Gp)) : 0.f;
                const u32x2* sa = (const u32x2*)UG + ((size_t)((b * 4 + h) * 8 + Gp) * 4 + w4) * 1024 + lane;
                const u32x2* sb = two ? sa + 4 * 1024 : sa;
#pragma unroll
                for (int mt = 0; mt < 2; ++mt)
#pragma unroll
                    for (int nt = 0; nt < 8; ++nt) st[mt][nt] += unpack_bf4(sa[(mt * 8 + nt) * 64]) * wa + unpack_bf4(sb[(mt * 8 + nt) * 64]) * wb;
            }
        }
#pragma unroll
        for (int s = 0; s < PD; ++s) RET_ISSUE(s, s);
#pragma unroll 1
        for (int n0 = 0; n0 < 8; n0 += PD) {
#pragma unroll
          for (int s = 0; s < PD; ++s) { const int n = n0 + s;
            RET_STAGE_A(s);
            if (n + PD < 8) RET_ISSUE(s, n + PD);
            if (FULL) {
#pragma unroll
                for (int mt = 0; mt < 2; ++mt)
#pragma unroll
                    for (int nt = 0; nt < 8; ++nt) { const int e = 16 * nt + l15, dk0 = 32 * w4 + 16 * mt + 4 * l4;
                        *(LAS u32x2*)(lds + ST_OFF + e * 272 + dk0 * 2) = (u32x2){pk2(st[mt][nt][0], st[mt][nt][1]), pk2(st[mt][nt][2], st[mt][nt][3])}; }
            }
            WG_BAR();
            if (FULL) {
                bf16x8 ak[4];
#pragma unroll
                for (int ks = 0; ks < 4; ++ks) ak[ks] = *(const LAS bf16x8*)(lds + KI_OFF + (16 * w4 + l15) * 272 + (32 * ks + 8 * l4) * 2);
#pragma unroll
                for (int it = 0; it < 4; ++it) {
                    bf16x8 bq[4];
#pragma unroll
                    for (int ks = 0; ks < 4; ++ks) bq[ks] = *(const LAS bf16x8*)(lds + QI_OFF + (16 * it + l15) * 272 + (32 * ks + 8 * l4) * 2);
                    f32x4 sa = (f32x4){0.f, 0.f, 0.f, 0.f};
#pragma unroll
                    for (int ks = 0; ks < 4; ++ks) sa = MFMA16(ak[ks], bq[ks], sa);
                    const int i = 16 * it + l15, j0 = 16 * w4 + 4 * l4;
#pragma unroll
                    for (int r = 0; r < 4; ++r) { const int d = i - (j0 + r); sa[r] *= __builtin_amdgcn_exp2f(l2g * (float)(d < 0 ? -d : d)); }
                    *(LAS u32x2*)(lds + SI_OFF + i * 144 + j0 * 2) = (u32x2){pk2(sa[0], sa[1]), pk2(sa[2], sa[3])};
                }
            }
            WG_BAR();
#pragma unroll
            for (int mt = 0; mt < 2; ++mt)
#pragma unroll
                for (int nt = 0; nt < 8; ++nt) st[mt][nt] = st[mt][nt] * g64;
#pragma unroll
            for (int ks = 0; ks < 2; ++ks) {
                bf16x8 akt[2];
#pragma unroll
                for (int mt = 0; mt < 2; ++mt) { const int row = 32 * w4 + 16 * mt + l15; akt[mt] = *(const LAS bf16x8*)(lds + KT_OFF + row * 144 + 16 * ((4 * ks + l4) ^ ((row >> 3) & 7))); }
#pragma unroll
                for (int nh = 0; nh < 2; ++nh) {
                    bf16x8 bv[4];
#pragma unroll
                    for (int nt = 0; nt < 4; ++nt) bv[nt] = *(const LAS bf16x8*)(lds + VT_ADDR(4 * nh + nt, ks));
#pragma unroll
                    for (int nt = 0; nt < 4; ++nt)
#pragma unroll
                        for (int mt = 0; mt < 2; ++mt) st[mt][4 * nh + nt] = MFMA16(akt[mt], bv[nt], st[mt][4 * nh + nt]);
                }
            }
            WG_BAR();
          }
        }
        if (!FULL) {
            u32x2* dst = (u32x2*)UG + ((size_t)unit * 4 + w4) * 1024 + lane;
#pragma unroll
            for (int mt = 0; mt < 2; ++mt)
#pragma unroll
                for (int nt = 0; nt < 8; ++nt) dst[(mt * 8 + nt) * 64] = (u32x2){pk2(st[mt][nt][0], st[mt][nt][1]), pk2(st[mt][nt][2], st[mt][nt][3])};
        } else if (G == 7) {
            float* o = p.out + O_SRP + (size_t)(b * 4 + h) * 16384 + (64 * (l4 & 1) + 16 * w4 + 4 * (l4 >> 1)) * 128 + l15;
#pragma unroll
            for (int mt = 0; mt < 2; ++mt)
#pragma unroll
                for (int nt = 0; nt < 8; ++nt)
#pragma unroll
                    for (int r = 0; r < 4; ++r) o[(8 * mt + r) * 128 + 16 * nt] = st[mt][nt][r];
        }
    } else {
        float rwv[8];
#pragma unroll
        for (int nt = 0; nt < 8; ++nt) rwv[nt] = p.in[8][128 * h + 16 * nt + l15];
#pragma unroll
        for (int s = 0; s < PD; ++s) RET_ISSUE(s, s);
#pragma unroll 1
        for (int n0 = 0; n0 < 8; n0 += PD) {
#pragma unroll
          for (int s = 0; s < PD; ++s) { const int n = n0 + s;
            RET_STAGE_A(s);
            if (n + PD < 8) RET_ISSUE(s, n + PD);
            WG_BAR();
            f32x4 acc[8];
            if (FULL) {
                f32x4 fsv;
#pragma unroll
                for (int r = 0; r < 4; ++r) fsv[r] = __builtin_amdgcn_exp2f(l2g * (float)(16 * w4 + 4 * l4 + r + 1));
#pragma unroll
                for (int nt = 0; nt < 8; ++nt) acc[nt] = (f32x4){0.f, 0.f, 0.f, 0.f};
                bf16x8 aq[4];
#pragma unroll
                for (int ks = 0; ks < 4; ++ks) aq[ks] = *(const LAS bf16x8*)(lds + QI_OFF + (16 * w4 + l15) * 272 + (32 * ks + 8 * l4) * 2);
#pragma unroll
                for (int ks = 0; ks < 4; ++ks)
#pragma unroll
                    for (int nh = 0; nh < 2; ++nh) {
                        bf16x8 bs[4];
#pragma unroll
                        for (int nt = 0; nt < 4; ++nt) bs[nt] = *(const LAS bf16x8*)(lds + ST_OFF + (16 * (4 * nh + nt) + l15) * 272 + (32 * ks + 8 * l4) * 2);
#pragma unroll
                        for (int nt = 0; nt < 4; ++nt) acc[4 * nh + nt] = MFMA16(aq[ks], bs[nt], acc[4 * nh + nt]);
                    }
#pragma unroll
                for (int nt = 0; nt < 8; ++nt) acc[nt] = acc[nt] * fsv;
            }
            WG_BAR();
            if (FULL) {
                bf16x8 as_[2];
#pragma unroll
                for (int ks = 0; ks < 2; ++ks) as_[ks] = *(const LAS bf16x8*)(lds + SI_OFF + (16 * w4 + l15) * 144 + 16 * (4 * ks + l4));
#pragma unroll
                for (int ks = 0; ks < 2; ++ks)
#pragma unroll
                    for (int nh = 0; nh < 2; ++nh) {
                        bf16x8 bv[4];
#pragma unroll
                        for (int nt = 0; nt < 4; ++nt) bv[nt] = *(const LAS bf16x8*)(lds + VT_ADDR(4 * nh + nt, ks));
#pragma unroll
                        for (int nt = 0; nt < 4; ++nt) acc[4 * nh + nt] = MFMA16(as_[ks], bv[nt], acc[4 * nh + nt]);
                    }
                unsigned short gq[4][8];
#pragma unroll
                for (int r = 0; r < 4; ++r)
#pragma unroll
                    for (int nt = 0; nt < 8; ++nt) gq[r][nt] = *(const LAS unsigned short*)(lds + GI_OFF + (16 * w4 + 4 * l4 + r) * 272 + (16 * nt + l15) * 2);
                float rstd[4];
#pragma unroll
                for (int r = 0; r < 4; ++r) { float ss = 0.f;
#pragma unroll
                    for (int nt = 0; nt < 8; ++nt) ss += acc[nt][r] * acc[nt][r];
                    ss += dppf(ss, 1); ss += dppf(ss, 2); ss += dppf(ss, 4); ss += dppf(ss, 8);
                    ss = __shfl(ss, (lane & 48) | 15);
                    rstd[r] = rsqrtf(ss * (1.0f / 128.0f) + EPS); }
#pragma unroll
                for (int r = 0; r < 4; ++r)
#pragma unroll
                    for (int nt = 0; nt < 8; ++nt)
                        *(LAS unsigned short*)(lds + QI_OFF + (16 * w4 + 4 * l4 + r) * 272 + (16 * nt + l15) * 2) = (unsigned short)(pk2s(acc[nt][r] * rstd[r] * rwv[nt] * silu_f(bf2f(gq[r][nt])), 0.f) & 0xffffu);
#pragma unroll
                for (int q = 0; q < 4; ++q) { const int cidx = lane + 64 * q, row = 16 * w4 + (cidx >> 4), ch = cidx & 15;
                    const u32x4 v = *(const LAS u32x4*)(lds + QI_OFF + row * 272 + ch * 16);
                    *(u32x4*)(MIX + (tok0 + (size_t)n * 64 + row) * DM + 128 * h + ch * 8) = v; }
            }
            WG_BAR();
          }
        }
    }
#ifndef CONVREP
#define CONVREP 1
#endif
    if (FULL) for (int crep_ = 0; crep_ < CONVREP; ++crep_) {
        const int c0 = 128 * h + 8 * (tid & 15), run = tid >> 4, t0 = G * 512 + run * 16;
        const float* cwp = p.in[7];
        float w0[8], w1[8], w2[8], p1[8], p2[8];
#pragma unroll
        for (int e = 0; e < 8; ++e) { w0[e] = cwp[c0 + e]; w1[e] = cwp[512 + c0 + e]; w2[e] = cwp[1024 + c0 + e]; p1[e] = 0.f; p2[e] = 0.f; }
        if (t0 > 0) {
            const bf16_t* r2 = P + ((size_t)b * 4096 + t0 - 2) * NIN; const bf16_t* r1 = r2 + NIN;
            const u32x4 c2 = *(const u32x4*)(r2 + 2560 + c0), h2 = *(const u32x4*)(r2 + 3072 + c0), c1 = *(const u32x4*)(r1 + 2560 + c0), h1 = *(const u32x4*)(r1 + 3072 + c0);
            const unsigned c2w[4] = {c2.x, c2.y, c2.z, c2.w}, h2w[4] = {h2.x, h2.y, h2.z, h2.w}, c1w[4] = {c1.x, c1.y, c1.z, c1.w}, h1w[4] = {h1.x, h1.y, h1.z, h1.w};
#pragma unroll
            for (int e = 0; e < 4; ++e) {
                p2[2 * e] = __uint_as_float(c2w[e] << 16) * __uint_as_float(h2w[e] << 16); p2[2 * e + 1] = __uint_as_float(c2w[e] & 0xffff0000u) * __uint_as_float(h2w[e] & 0xffff0000u);
                p1[2 * e] = __uint_as_float(c1w[e] << 16) * __uint_as_float(h1w[e] << 16); p1[2 * e + 1] = __uint_as_float(c1w[e] & 0xffff0000u) * __uint_as_float(h1w[e] & 0xffff0000u); }
        }
#pragma unroll 8
        for (int t = 0; t < 16; ++t) {
            const size_t row = (size_t)b * 4096 + t0 + t;
            const bf16_t* rp = P + row * NIN;
            const u32x4 bb = *(const u32x4*)(rp + 2048 + c0), cc = *(const u32x4*)(rp + 2560 + c0), hh = *(const u32x4*)(rp + 3072 + c0);
            const unsigned bw[4] = {bb.x, bb.y, bb.z, bb.w}, cw4[4] = {cc.x, cc.y, cc.z, cc.w}, hw[4] = {hh.x, hh.y, hh.z, hh.w};
            float y[8];
#pragma unroll
            for (int e = 0; e < 4; ++e) {
                const float ca = __uint_as_float(cw4[e] << 16) * __uint_as_float(hw[e] << 16), cb = __uint_as_float(cw4[e] & 0xffff0000u) * __uint_as_float(hw[e] & 0xffff0000u);
                y[2 * e] = __uint_as_float(bw[e] << 16) * (w0[2 * e] * p2[2 * e] + w1[2 * e] * p1[2 * e] + w2[2 * e] * ca);
                y[2 * e + 1] = __uint_as_float(bw[e] & 0xffff0000u) * (w0[2 * e + 1] * p2[2 * e + 1] + w1[2 * e + 1] * p1[2 * e + 1] + w2[2 * e + 1] * cb);
                p2[2 * e] = p1[2 * e]; p2[2 * e + 1] = p1[2 * e + 1]; p1[2 * e] = ca; p1[2 * e + 1] = cb;
            }
            *(u32x4*)(MIX + row * DM + 512 + c0) = (u32x4){pk2(y[0], y[1]), pk2(y[2], y[3]), pk2(y[4], y[5]), pk2(y[6], y[7])};
        }
        if (G == 7 && run == 31) {
            float* o = p.out + O_CCP + (size_t)b * 1024 + c0;
#pragma unroll
            for (int e = 0; e < 8; ++e) { o[e] = p2[e]; o[512 + e] = p1[e]; }
        }
    }
#undef VT_ADDR
}

__device__ __forceinline__ float ch_at(const float* PS, const float* cache, int b, int t, int ch) {
    if (t < 0) return cache[(b * 2 + (t + 2)) * 512 + ch];
    const float* rp = PS + (size_t)(16 * b + t) * NIN;
    return rp[2560 + ch] * rp[3072 + ch];
}
__device__ __forceinline__ void sample_unit(const Params& p, LAS unsigned char* lds, int sup, int tid, int wid, int lane) {
    const int su = sup >> 2, part = sup & 3;
    const int b = su >> 2, h = su & 3, ts0 = TOK_P + 16 * b;
    const float* PS = (const float*)(p.ws + WS_PS);
    bf16_t* MIX = (bf16_t*)(p.ws + WS_RA);
    LAS float* qs = (LAS float*)lds; LAS float* ks = qs + 2048; LAS float* vs = qs + 4096; LAS float* Ssm = qs + 6144; LAS float* osm = qs + 6400;
    const float l2g = log2f(1.0f - exp2f(-5.0f - (float)h));
    const float* cosT = (const float*)(p.ws + WS_COS); const float* sinT = (const float*)(p.ws + WS_SIN);
    for (int idx = tid; idx < 2048; idx += 512) { const int i = idx >> 7, c = idx & 127, d = dmap(c);
        const float* rp = PS + (size_t)(16 * b + i) * NIN + 128 * h;
        const float cs = cosT[(4096 + i) * 64 + (d & 63)], sn = sinT[(4096 + i) * 64 + (d & 63)];
        const float xq = rp[c], xqp = rp[c ^ 4], xk = rp[512 + c], xkp = rp[512 + (c ^ 4)];
        qs[i * 128 + d] = d < 64 ? xq * cs - xqp * sn : xq * cs + xqp * sn;
        ks[i * 128 + d] = (d < 64 ? xk * cs - xkp * sn : xk * cs + xkp * sn) * 0.08838834764831845f;
        vs[i * 128 + c] = rp[1024 + c]; }
    const int e = tid & 127, sub = tid >> 7, irow = 4 * part + sub;
    LAS float* s0 = qs + 8704;
    { const float* s0g = p.in[2] + (size_t)su * 16384; f32x4 t8[8];
#pragma unroll
      for (int q = 0; q < 8; ++q) t8[q] = *((const f32x4*)s0g + tid + 512 * q);
#pragma unroll
      for (int q = 0; q < 8; ++q) *((LAS f32x4*)s0 + tid + 512 * q) = t8[q]; }
    __syncthreads();
    if (tid < 64) { const int i = 4 * part + (tid >> 4), j = tid & 15; float s = 0.f;
        for (int d = 0; d < 128; ++d) s += qs[i * 128 + d] * ks[j * 128 + d];
        const int dd = i - j; Ssm[i * 16 + j] = s * __builtin_amdgcn_exp2f(l2g * (float)(dd < 0 ? -dd : dd)); }
    float cr = 0.f;
#pragma unroll 8
    for (int d = 0; d < 128; ++d) cr += qs[irow * 128 + d] * s0[d * 128 + e];
    __syncthreads();
    { float o = 0.f;
      for (int j = 0; j < 16; ++j) o += Ssm[irow * 16 + j] * vs[j * 128 + e];
      osm[irow * 128 + e] = o + __builtin_amdgcn_exp2f(l2g * (float)(irow + 1)) * cr; }
    __syncthreads();
    if (wid < 4) { const int i = 4 * part + wid; const float v0 = osm[i * 128 + lane], v1 = osm[i * 128 + 64 + lane];
        const float rstd = rsqrtf(wave_sum(v0 * v0 + v1 * v1) * (1.0f / 128.0f) + EPS);
        const size_t token = (size_t)(ts0 + i);
        const float g0 = PS[(size_t)(16 * b + i) * NIN + 1536 + 128 * h + lane], g1 = PS[(size_t)(16 * b + i) * NIN + 1536 + 128 * h + 64 + lane];
        MIX[token * DM + 128 * h + lane] = (bf16_t)(pk2(v0 * rstd * p.in[8][128 * h + lane] * silu_f(g0), 0.f) & 0xffffu);
        MIX[token * DM + 128 * h + 64 + lane] = (bf16_t)(pk2(v1 * rstd * p.in[8][128 * h + 64 + lane] * silu_f(g1), 0.f) & 0xffffu); }
    const float g16 = __builtin_amdgcn_exp2f(l2g * 16.0f);
    float* outS = p.out + O_SRS + (size_t)su * 16384;
#pragma unroll 2
    for (int dd = 0; dd < 8; ++dd) { const int d = 32 * part + sub + 4 * dd; float a = g16 * s0[d * 128 + e];
        for (int j = 0; j < 16; ++j) a += __builtin_amdgcn_exp2f(l2g * (float)(15 - j)) * ks[j * 128 + d] * vs[j * 128 + e];
        outS[d * 128 + e] = a; }
    { const int ch = 128 * h + e; const float* cache = p.in[3]; const float* cwp = p.in[7];
      const float w0 = cwp[ch], w1 = cwp[512 + ch], w2 = cwp[1024 + ch];
      const int t = irow;
      const float c0 = ch_at(PS, cache, b, t - 2, ch), c1 = ch_at(PS, cache, b, t - 1, ch), c2 = ch_at(PS, cache, b, t, ch);
      const float y = PS[(size_t)(16 * b + t) * NIN + 2048 + ch] * (w0 * c0 + w1 * c1 + w2 * c2);
      MIX[(size_t)(ts0 + t) * DM + 512 + ch] = (bf16_t)(pk2(y, 0.f) & 0xffffu);
      if (t >= 14) p.out[O_CCS + (size_t)(b * 2 + t - 14) * 512 + ch] = c2; }
    __syncthreads();
}

constexpr int TG_B = 34816, TG_BUF = 34816 + 32 * 272;
template <int NB>
__device__ __forceinline__ void thin_gemm2(LAS unsigned char* lds, const bf16_t* A, int lda, const bf16_t* Bt, int ldb, int n0, int nbstride, int kbeg, int klen, f32x4 (&acc)[NB], int tid, int wid, int lane) {
    const int l15 = lane & 15, l4 = lane >> 4, nkb = klen >> 7;
    const bool hasb = tid < NB * 256;
    const bf16_t* ag = A + (size_t)(tid >> 4) * lda + kbeg + (tid & 15) * 8;
    const bf16_t* bg = Bt + (size_t)(n0 + (tid >> 8) * nbstride + ((tid >> 4) & 15)) * ldb + kbeg + (tid & 15) * 8;
    const int sto = (tid >> 4) * 272 + (tid & 15) * 16;
    const int fro = l15 * 272 + (8 * l4) * 2;
    u32x4 Xa[4], Ya[4], Xb = (u32x4){0u, 0u, 0u, 0u}, Yb = Xb;
#define TG_LOAD(R, kb) do { _Pragma("unroll") for (int i_ = 0; i_ < 4; ++i_) R##a[i_] = *(const u32x4*)(ag + (size_t)(32 * i_) * lda + (kb) * 128); if (hasb) R##b = *(const u32x4*)(bg + (kb) * 128); } while (0)
#define TG_STORE(R, buf) do { _Pragma("unroll") for (int i_ = 0; i_ < 4; ++i_) *(LAS u32x4*)(lds + (buf) * TG_BUF + sto + i_ * 32 * 272) = R##a[i_]; if (hasb) *(LAS u32x4*)(lds + (buf) * TG_BUF + TG_B + sto) = R##b; } while (0)
#define TG_COMP(buf) do { _Pragma("unroll") for (int ks = 0; ks < 4; ++ks) { const bf16x8 a_ = *(const LAS bf16x8*)(lds + (buf) * TG_BUF + 16 * wid * 272 + fro + ks * 64); \
        _Pragma("unroll") for (int nb = 0; nb < NB; ++nb) { const bf16x8 b_ = *(const LAS bf16x8*)(lds + (buf) * TG_BUF + TG_B + 16 * nb * 272 + fro + ks * 64); acc[nb] = MFMA16(a_, b_, acc[nb]); } } } while (0)
#pragma unroll
    for (int nb = 0; nb < NB; ++nb) acc[nb] = (f32x4){0.f, 0.f, 0.f, 0.f};
    TG_LOAD(X, 0); TG_LOAD(Y, 1);
    TG_STORE(X, 0); WG_BAR();
#pragma unroll 1
    for (int kb = 0; kb < nkb; kb += 2) {
        if (kb + 2 < nkb) TG_LOAD(X, kb + 2);
        TG_COMP(0);
        TG_STORE(Y, 1); WG_BAR();
        if (kb + 3 < nkb) TG_LOAD(Y, kb + 3);
        TG_COMP(1);
        if (kb + 2 < nkb) TG_STORE(X, 0);
        WG_BAR();
    }
#undef TG_LOAD
#undef TG_STORE
#undef TG_COMP
}
template <int NB>
__device__ __forceinline__ void thin_gemm(const bf16_t* A, int lda, const bf16_t* Bt, int ldb, int n0, int nbstride, int kbeg, int klen, f32x4 (&acc)[NB], int wid, int lane) {
    const int l15 = lane & 15, l4 = lane >> 4;
    const bf16_t* ap = A + (size_t)(16 * wid + l15) * lda + kbeg + 8 * l4;
    const bf16_t* bp = Bt + (size_t)(n0 + l15) * ldb + kbeg + 8 * l4;
#pragma unroll
    for (int nb = 0; nb < NB; ++nb) acc[nb] = (f32x4){0.f, 0.f, 0.f, 0.f};
#pragma unroll 1
    for (int s0 = 0; s0 < klen; s0 += 256) {
        bf16x8 a[8], b[NB][8];
#pragma unroll
        for (int s = 0; s < 8; ++s) { a[s] = *(const bf16x8*)(ap + s0 + 32 * s);
#pragma unroll
            for (int nb = 0; nb < NB; ++nb) b[nb][s] = *(const bf16x8*)(bp + (size_t)nb * nbstride * ldb + s0 + 32 * s); }
#pragma unroll
        for (int s = 0; s < 8; ++s)
#pragma unroll
            for (int nb = 0; nb < NB; ++nb) acc[nb] = MFMA16(a[s], b[nb][s], acc[nb]);
    }
}
__device__ __forceinline__ void thin_store(const f32x4& acc, float* out, int ldo, int col, int wid, int lane) {
#pragma unroll
    for (int r = 0; r < 4; ++r) out[(size_t)(16 * wid + 4 * (lane >> 4) + r) * ldo + col + (lane & 15)] = acc[r];
}
__device__ __forceinline__ void thin_ffn1(const Params& p, LAS unsigned char* lds, int c, int tid, int wid, int lane) {
    const int pn = c >> 3, j16 = c & 7, l15 = lane & 15, l4 = lane >> 4;
    f32x4 acc[2];
    thin_gemm2<2>(lds, (const bf16_t*)(p.ws + WS_Y) + (size_t)TOK_P * DM, DM, (const bf16_t*)(p.ws + WS_WFF1), DM, 256 * pn + 16 * j16, 128, 0, DM, acc, tid, wid, lane);
    const int ch = 128 * pn + 16 * j16 + l15, b = wid;
    const float* cw = p.in[15]; const float* cache = p.in[4] + (size_t)b * 2 * DFF + ch;
    const float w0 = cw[ch], w1 = cw[DFF + ch], w2 = cw[2 * DFF + ch];
    const f32x4 up = acc[0], gt = acc[1];
    float pm1 = __shfl_up(up[3], 16), pm2 = __shfl_up(up[2], 16);
    if (l4 == 0) { pm1 = cache[DFF]; pm2 = cache[0]; }
    float uc[4];
    uc[0] = w0 * pm2 + w1 * pm1 + w2 * up[0];
    uc[1] = w0 * pm1 + w1 * up[0] + w2 * up[1];
    uc[2] = w0 * up[0] + w1 * up[1] + w2 * up[2];
    uc[3] = w0 * up[1] + w1 * up[2] + w2 * up[3];
    bf16_t* ACT = (bf16_t*)(p.ws + WS_RB);
#pragma unroll
    for (int r = 0; r < 4; ++r) ACT[(size_t)(TOK_P + 16 * wid + 4 * l4 + r) * DFF + ch] = (bf16_t)(pk2(pg8::gelu_tanh(uc[r]) * gt[r], 0.f) & 0xffffu);
    if (l4 == 3) { float* o = p.out + O_CFS + (size_t)b * 2 * DFF + ch; o[0] = up[2]; o[DFF] = up[3]; }
}

__device__ __forceinline__ void phase4(const Params& p, int wid, int lane) {
    const int gw = blockIdx.x * 8 + wid, NGW = gridDim.x * 8;
    bf16_t* Y = (bf16_t*)(p.ws + WS_Y); const float* ssq = (const float*)(p.ws + WS_SSQ1); float* RS2 = (float*)(p.ws + WS_RS2); const bf16_t* XB = (const bf16_t*)(p.ws + WS_XB);
    const float* wpost = p.in[10];
    f32x4 wpo[4];
#pragma unroll
    for (int j = 0; j < 4; ++j) wpo[j] = *((const f32x4*)wpost + lane + 64 * j);
#pragma unroll 1
    for (int base = gw; base < TOK_P; base += RB * NGW) {
        f32x4 v[RB][4]; u32x2 yw[RB][4]; float sq[RB];
#pragma unroll
        for (int k = 0; k < RB; ++k) { const int rr = min(base + k * NGW, TOK_P - 1);
            sq[k] = lane < 16 ? ssq[(size_t)rr * 16 + lane] : 0.f;
#pragma unroll
            for (int j = 0; j < 4; ++j) { v[k][j] = unpack_bf4(__builtin_nontemporal_load((const u32x2*)(XB + (size_t)rr * DM) + lane + 64 * j)); yw[k][j] = __builtin_nontemporal_load((const u32x2*)(Y + (size_t)rr * DM) + lane + 64 * j); } }
        float s2[RB];
#pragma unroll
        for (int k = 0; k < RB; ++k) { const float rstd1 = rsqrtf(wave_sum(sq[k]) * (1.0f / DM) + EPS); s2[k] = 0.f;
#pragma unroll
            for (int j = 0; j < 4; ++j) { v[k][j] = v[k][j] + (unpack_bf4(yw[k][j]) * rstd1) * wpo[j]; s2[k] += sumsq4(v[k][j]); } }
#pragma unroll
        for (int k = 0; k < RB; ++k) { const int r = base + k * NGW; const float rstd2 = rsqrtf(wave_sum(s2[k]) * (1.0f / DM) + EPS);
            if (r < TOK_P) {
                if (lane == 0) RS2[r] = rstd2;
#pragma unroll
                for (int j = 0; j < 4; ++j) *((u32x2*)(Y + (size_t)r * DM) + lane + 64 * j) = (u32x2){pk2(v[k][j][0], v[k][j][1]), pk2(v[k][j][2], v[k][j][3])}; } }
    }
    for (int r = TOK_P + gw; r < TOK; r += NGW) {
        const float* xrow = p.in[1] + (size_t)(r - TOK_P) * DM; const float* ys = (const float*)(p.ws + WS_YS) + (size_t)(r - TOK_P) * DM;
        f32x4 yv[4], v[4]; float s = 0.f, s2 = 0.f;
#pragma unroll
        for (int j = 0; j < 4; ++j) { f32x4 a = *((const f32x4*)ys + lane + 64 * j);
#pragma unroll
            for (int q = 1; q < 4; ++q) a += *((const f32x4*)(ys + (size_t)q * 128 * DM) + lane + 64 * j);
            yv[j] = a; s += sumsq4(a); }
        const float rstd1 = rsqrtf(wave_sum(s) * (1.0f / DM) + EPS);
#pragma unroll
        for (int j = 0; j < 4; ++j) { v[j] = *((const f32x4*)xrow + lane + 64 * j) + (yv[j] * rstd1) * wpo[j]; s2 += sumsq4(v[j]);
 }
        const float rstd2 = rsqrtf(wave_sum(s2) * (1.0f / DM) + EPS);
#pragma unroll
        for (int j = 0; j < 4; ++j) { const f32x4 y = v[j] * rstd2; *((u32x2*)(Y + (size_t)r * DM) + lane + 64 * j) = (u32x2){pk2(y[0], y[1]), pk2(y[2], y[3])}; }
    }
}
__device__ __forceinline__ void phase7(const Params& p, int wid, int lane) {
    const int gw = blockIdx.x * 8 + wid, NGW = gridDim.x * 8;
    const bf16_t* F = (const bf16_t*)(p.ws + WS_RA); const bf16_t* Y = (const bf16_t*)(p.ws + WS_Y);
    const float* ssq1 = (const float*)(p.ws + WS_SSQ1); const float* ssq2 = (const float*)(p.ws + WS_SSQ2);
    f32x4 wm[4], wf[4];
#pragma unroll
    for (int j = 0; j < 4; ++j) { wm[j] = *((const f32x4*)p.in[10] + lane + 64 * j); wf[j] = *((const f32x4*)p.in[12] + lane + 64 * j); }
    constexpr int RB7 = 6;
#pragma unroll 1
    for (int base = gw; base < TOK_P; base += RB7 * NGW) {
        u32x2 xw[RB7][4], fw[RB7][4]; float sq2[RB7];
#pragma unroll
        for (int k = 0; k < RB7; ++k) { const int rr = min(base + k * NGW, TOK_P - 1);
            sq2[k] = lane < 16 ? ssq2[(size_t)rr * 16 + lane] : 0.f;
#pragma unroll
            for (int j = 0; j < 4; ++j) { xw[k][j] = __builtin_nontemporal_load((const u32x2*)(Y + (size_t)rr * DM) + lane + 64 * j); fw[k][j] = __builtin_nontemporal_load((const u32x2*)(F + (size_t)rr * DM) + lane + 64 * j); } }
#pragma unroll
        for (int k = 0; k < RB7; ++k) { const int r = base + k * NGW;
            const float rstd2 = rsqrtf(wave_sum(sq2[k]) * (1.0f / DM) + EPS);
            if (r < TOK_P) {
#pragma unroll
                for (int j = 0; j < 4; ++j) __builtin_nontemporal_store(unpack_bf4(xw[k][j]) + (unpack_bf4(fw[k][j]) * rstd2) * wf[j], (f32x4*)(p.out + (size_t)r * DM) + lane + 64 * j); } }
    }
    for (int r = TOK_P + gw; r < TOK; r += NGW) {
        const float* xrow = p.in[1] + (size_t)(r - TOK_P) * DM;
        const float* ys = (const float*)(p.ws + WS_YS) + (size_t)(r - TOK_P) * DM; const float* fs = (const float*)(p.ws + WS_FS) + (size_t)(r - TOK_P) * DM;
        f32x4 yv[4], fv[4]; float s1 = 0.f, s2 = 0.f;
#pragma unroll
        for (int j = 0; j < 4; ++j) { f32x4 a = *((const f32x4*)ys + lane + 64 * j), c = *((const f32x4*)fs + lane + 64 * j);
#pragma unroll
            for (int q = 1; q < 4; ++q) { a += *((const f32x4*)(ys + (size_t)q * 128 * DM) + lane + 64 * j); c += *((const f32x4*)(fs + (size_t)q * 128 * DM) + lane + 64 * j); }
            yv[j] = a; fv[j] = c; s1 += sumsq4(a); s2 += sumsq4(c); }
        const float rstd1 = rsqrtf(wave_sum(s1) * (1.0f / DM) + EPS), rstd2 = rsqrtf(wave_sum(s2) * (1.0f / DM) + EPS);
#pragma unroll
        for (int j = 0; j < 4; ++j) *((f32x4*)(p.out + (size_t)r * DM) + lane + 64 * j) = *((const f32x4*)xrow + lane + 64 * j) + (yv[j] * rstd1) * wm[j] + (fv[j] * rstd2) * wf[j];
    }
}


#define XB_TMO      128
#define XB_XCNT(j)  (256  + 64 * (j))
#define XB_XSUB(j)  (1280 + 64 * (j))
#define XB_XGEN(j)  (2304 + 64 * (j))
#define XB_TOP      3328
#define XB_TOPGEN   3392
#define XCD_BAR_WORDS 3456
#define XB_SPIN_CAP (1u << 18)

__device__ __forceinline__ unsigned xb_ld(unsigned* p)              { return __hip_atomic_load(p, __ATOMIC_RELAXED, __HIP_MEMORY_SCOPE_AGENT); }
__device__ __forceinline__ unsigned xb_add(unsigned* p, unsigned v) { return __hip_atomic_fetch_add(p, v, __ATOMIC_RELAXED, __HIP_MEMORY_SCOPE_AGENT); }
__device__ __forceinline__ unsigned xb_xcc_id() { return (unsigned)__builtin_amdgcn_s_getreg((3 << 11) | 20) & 0xFu; }
#define XB_SPIN(cond, bar) do { unsigned _sp = 0; while (cond) { __builtin_amdgcn_s_sleep(1); \
    if ((++_sp & 255u) == 0u) { if (xb_ld(&(bar)[XB_TMO])) break; if (_sp > XB_SPIN_CAP) { atomicAdd(&(bar)[XB_TMO], 1u); break; } } } } while (0)

struct XcdBarrier {
    unsigned* bar; unsigned x;
    volatile LAS unsigned* st;
};

__device__ __forceinline__ XcdBarrier xcd_barrier_post(unsigned* bar, volatile LAS unsigned* st) {
    XcdBarrier b; b.bar = bar; b.x = xb_xcc_id(); b.st = st;
    if (threadIdx.x == 0) (void)xb_add(&bar[XB_XCNT(b.x)], 1u);
    return b;
}
__device__ __forceinline__ void xcd_barrier_complete(unsigned* bar, unsigned x, unsigned& nloc, unsigned& nx) {
    const unsigned G = gridDim.x * gridDim.y * gridDim.z;
    unsigned sum, cnt, mine, sp = 0u;
    for (;;) {
        sum = 0u; cnt = 0u; mine = 0u;
#pragma unroll
        for (unsigned j = 0; j < 16; ++j) { const unsigned c = xb_ld(&bar[XB_XCNT(j)]); sum += c; cnt += (c > 0u) ? 1u : 0u; mine = (j == x) ? c : mine; }
        if (sum == G) break;
        __builtin_amdgcn_s_sleep(1);
        if ((++sp & 255u) == 0u) { if (xb_ld(&bar[XB_TMO])) break; if (sp > XB_SPIN_CAP) { atomicAdd(&bar[XB_TMO], 1u); break; } }
    }
    nloc = mine > 0u ? mine : 1u; nx = cnt > 0u ? cnt : 1u;
}

__device__ __forceinline__ void xcd_barrier(const XcdBarrier& b) {
    asm volatile("s_waitcnt vmcnt(0)" ::: "memory");
    __syncthreads();
    if (threadIdx.x == 0) {
        unsigned* bar = b.bar;
        __builtin_amdgcn_s_waitcnt(0);
        unsigned nloc = b.st[0], nx = b.st[1];
        if (nloc == 0u) { xcd_barrier_complete(bar, b.x, nloc, nx); b.st[0] = nloc; b.st[1] = nx; }
        const unsigned old = xb_add(&bar[XB_XSUB(b.x)], 1u);
        const unsigned gen = old / nloc;
        if (old + 1u == (gen + 1u) * nloc) {
            __builtin_amdgcn_fence(__ATOMIC_RELEASE, "agent");
            asm volatile("s_waitcnt vmcnt(0)" ::: "memory");
            const unsigned og = xb_add(&bar[XB_TOP], 1u);
            const unsigned tg = og / nx;
            if (og + 1u == (tg + 1u) * nx) xb_add(&bar[XB_TOPGEN], 1u);
            else XB_SPIN(xb_ld(&bar[XB_TOPGEN]) == tg, bar);
            __builtin_amdgcn_fence(__ATOMIC_ACQUIRE, "agent");
            xb_add(&bar[XB_XGEN(b.x)], 1u);
            asm volatile("s_waitcnt vmcnt(0)" ::: "memory");
        } else {
            XB_SPIN(xb_ld(&bar[XB_XGEN(b.x)]) == gen, bar);
            __builtin_amdgcn_fence(__ATOMIC_ACQUIRE, "agent");
            asm volatile("s_waitcnt vmcnt(0)" ::: "memory");
        }
    }
    __syncthreads();
}

#ifndef MK_LAUNCHES
#define MK_LAUNCHES 1
#endif
#ifndef REP0
#define REP0 1
#endif
#ifndef REP1
#define REP1 1
#endif
#ifndef REP2
#define REP2 1
#endif
#ifndef REP3
#define REP3 1
#endif
#ifndef REP4
#define REP4 1
#endif
#ifndef REP5
#define REP5 1
#endif
#ifndef REP6
#define REP6 1
#endif
#ifndef REP7
#define REP7 1
#endif
#define REPEAT(n) for (int rep_ = 0; rep_ < (n); ++rep_, ((rep_ < (n)) ? GRIDSYNC() : (void)0))
template <int PH_LO, int PH_HI>
__device__ __forceinline__ void run_phases(const Params& p, LAS unsigned char* lds) {
    int tid = threadIdx.x, lane = tid & 63; const int wid = __builtin_amdgcn_readfirstlane(tid >> 6);
    const int G = gridDim.x, c = blockIdx.x;
#define LAUNDER() asm volatile("" : "+v"(tid), "+v"(lane))
    XcdBarrier bar_;
    if (PH_HI - PH_LO > 1) {
        volatile LAS unsigned* stw = (volatile LAS unsigned*)(lds + LDS_BARW);
        if (threadIdx.x == 0) { stw[0] = 0u; stw[1] = 0u; }
        __syncthreads();
        bar_ = xcd_barrier_post((unsigned*)p.ws, stw);
        if (p.ws == nullptr) cg::this_grid().sync();
    }
#define GRIDSYNC() xcd_barrier(bar_)
#define SEAM(ph) do { if (PH_LO <= (ph) && (ph) + 1 < PH_HI) { GRIDSYNC(); } } while (0)
#ifdef XSYNC
    for (int xs_ = 0; xs_ < XSYNC; ++xs_) GRIDSYNC();
#endif
    if (PH_LO <= 0 && 0 < PH_HI) REPEAT(REP0) { LAUNDER(); phase0(p, lds, tid, wid, lane); }
    SEAM(0);
    if (PH_LO <= 1 && 1 < PH_HI) REPEAT(REP1) {
        for (int t = c; t < 224; t += G) { f32x4 acc[1]; thin_gemm2<1>(lds, (const bf16_t*)(p.ws + WS_RA) + (size_t)TOK_P * DM, DM, (const bf16_t*)(p.ws + WS_WIN), DM, 16 * t, 0, 0, DM, acc, tid, wid, lane);
            thin_store(acc[0], (float*)(p.ws + WS_PS), NIN, 16 * t, wid, lane); }
        pg8::Gemm g{(const bf16_t*)(p.ws + WS_XB), (const bf16_t*)(p.ws + WS_WIN), TOK_P, NIN, DM};
        pg8::StaticOrder S; S.init(TOK_P, NIN, G, c);
        pg8::EpiIn E{(bf16_t*)(p.ws + WS_RB), (const float*)(p.ws + WS_COS), (const float*)(p.ws + WS_SIN), (const float*)(p.ws + WS_RS0)};
        pg8::gemm_phase<pg8::EpiIn, pg8::StaticOrder, true, true>(lds, g, S, E);
    }
    SEAM(1);
    if (PH_LO <= 2 && 2 < PH_HI) REPEAT(REP2) {
#ifndef RUREP
#define RUREP 1
#endif
        for (int rrep_ = 0; rrep_ < RUREP; ++rrep_) for (int u = c; u < 256; u += G) ret_unit<false>(p, lds, u, tid, wid, lane);
        LAUNDER();
#ifndef SUREP
#define SUREP 1
#endif
        for (int srep_ = 0; srep_ < SUREP; ++srep_) for (int su = c; su < 128; su += G) sample_unit(p, lds, su, tid, wid, lane);
    }
    SEAM(2);
    if (PH_LO <= 3 && 3 < PH_HI) REPEAT(REP3) {
        for (int u = c; u < 256; u += G) ret_unit<true>(p, lds, u, tid, wid, lane);
    }
    SEAM(3);
    if (PH_LO <= 4 && 4 < PH_HI) REPEAT(REP4) {
        for (int t = c; t < 256; t += G) { f32x4 acc[1]; const int kq = t >> 6, nt = t & 63;
            thin_gemm2<1>(lds, (const bf16_t*)(p.ws + WS_RA) + (size_t)TOK_P * DM, DM, (const bf16_t*)(p.ws + WS_WOUT), DM, 16 * nt, 0, 256 * kq, 256, acc, tid, wid, lane);
            thin_store(acc[0], (float*)(p.ws + WS_YS) + (size_t)kq * 128 * DM, DM, 16 * nt, wid, lane); }
        pg8::Gemm g{(const bf16_t*)(p.ws + WS_RA), (const bf16_t*)(p.ws + WS_WOUT), TOK_P, DM, DM};
        pg8::StaticOrder S; S.init(TOK_P, DM, G, c);
        pg8::EpiY E{(bf16_t*)(p.ws + WS_Y), (float*)(p.ws + WS_SSQ1)};
        pg8::gemm_phase<pg8::EpiY, pg8::StaticOrder, true, true>(lds, g, S, E);
    }
    SEAM(4);
    if (PH_LO <= 5 && 5 < PH_HI) REPEAT(REP5) { LAUNDER(); phase4(p, wid, lane); }
    SEAM(5);
    if (PH_LO <= 6 && 6 < PH_HI) REPEAT(REP6) {
        for (int t = c; t < 256; t += G) thin_ffn1(p, lds, t, tid, wid, lane);
        pg8::Gemm g{(const bf16_t*)(p.ws + WS_Y), (const bf16_t*)(p.ws + WS_WFF1), TOK_P, 2 * DFF, DM};
        pg8::WalkOrder S{G, c};
        pg8::EpiFfn E{(bf16_t*)(p.ws + WS_RB), p.in[15], p.in[4], p.out + O_CFP, p.out + O_CFS, (LAS float*)(lds + LDS_HALO), (const float*)(p.ws + WS_RS2)};
        pg8::gemm_phase<pg8::EpiFfn, pg8::WalkOrder, true, true>(lds, g, S, E);
    }
    SEAM(6);
    if (PH_LO <= 7 && 7 < PH_HI) REPEAT(REP7) {
        for (int t = c; t < 256; t += G) { f32x4 acc[1]; const int kq = t >> 6, nt = t & 63;
            thin_gemm2<1>(lds, (const bf16_t*)(p.ws + WS_RB) + (size_t)TOK_P * DFF, DFF, (const bf16_t*)(p.ws + WS_WDN), DFF, 16 * nt, 0, 1024 * kq, 1024, acc, tid, wid, lane);
            thin_store(acc[0], (float*)(p.ws + WS_FS) + (size_t)kq * 128 * DM, DM, 16 * nt, wid, lane); }
        pg8::Gemm g{(const bf16_t*)(p.ws + WS_RB), (const bf16_t*)(p.ws + WS_WDN), TOK_P, DM, DFF};
        pg8::StaticOrder S; S.init(TOK_P, DM, G, c);
        pg8::EpiY E{(bf16_t*)(p.ws + WS_RA), (float*)(p.ws + WS_SSQ2)};
        pg8::gemm_phase<pg8::EpiY, pg8::StaticOrder, true, true>(lds, g, S, E);
    }
    SEAM(7);
#ifndef REP8
#define REP8 1
#endif
    if (PH_LO <= 8 && 8 < PH_HI) REPEAT(REP8) { LAUNDER(); phase7(p, wid, lane); }
#undef SEAM
}
constexpr int NPH = 9;
#if MK_LAUNCHES == 1
__global__ void __launch_bounds__(512, 2) fwd_kernel(Params p) {
    extern __shared__ __attribute__((aligned(16))) unsigned char smem[];
    run_phases<0, NPH>(p, (LAS unsigned char*)smem);
}
#else
template <int PH>
__global__ void __launch_bounds__(512, 2) fwd_phase(Params p) {
    extern __shared__ __attribute__((aligned(16))) unsigned char smem[];
    run_phases<PH, PH + 1>(p, (LAS unsigned char*)smem);
}
template <int PH> static void launch_phase(const Params& p, int grid, hipStream_t stream) {
    static bool attr = false;
    if (!attr) { (void)hipFuncSetAttribute((const void*)fwd_phase<PH>, hipFuncAttributeMaxDynamicSharedMemorySize, LDS_BYTES); attr = true; }
    hipLaunchKernelGGL(fwd_phase<PH>, dim3(grid), dim3(512), LDS_BYTES, stream, p);
}
#endif

extern "C" void kernel_launch(void* const* d_in, const int* in_sizes, int n_in, void* d_out, int out_size, void* d_ws, size_t ws_size, hipStream_t stream) {
    static int grid = 0;
    if (grid == 0) {
        if (n_in != 17 || ws_size < WS_END) { fprintf(stderr, "kernel_launch: expected 17 inputs and >= %zu bytes of workspace (got %d, %zu)\n", (size_t)WS_END, n_in, ws_size); grid = -1; return; }
        int dev = 0, cus = 0, per_cu = 0;
        (void)hipGetDevice(&dev); (void)hipDeviceGetAttribute(&cus, hipDeviceAttributeMultiprocessorCount, dev);
#if MK_LAUNCHES == 1
        if (hipFuncSetAttribute((const void*)fwd_kernel, hipFuncAttributeMaxDynamicSharedMemorySize, LDS_BYTES) != hipSuccess) { fprintf(stderr, "kernel_launch: hipFuncSetAttribute failed\n"); grid = -1; return; }
        if (hipOccupancyMaxActiveBlocksPerMultiprocessor(&per_cu, (const void*)fwd_kernel, 512, LDS_BYTES) != hipSuccess || per_cu < 1) { fprintf(stderr, "kernel_launch: occupancy query says %d\n", per_cu); per_cu = 1; }
        (void)hipGetLastError();
#endif
        grid = cus > 0 ? cus : 256;
    }
    if (grid < 0) return;
    Params p{};
    for (int i = 0; i < 17; ++i) p.in[i] = (const float*)d_in[i];
    p.out = (float*)d_out; p.ws = (unsigned char*)d_ws;
#if MK_LAUNCHES == 1
    if (hipMemsetAsync(d_ws, 0, 16384, stream) != hipSuccess) { fprintf(stderr, "kernel_launch: hipMemsetAsync failed\n"); return; }
    void* args[] = {&p};
    const hipError_t e = hipLaunchCooperativeKernel((const void*)fwd_kernel, dim3(grid), dim3(512), args, LDS_BYTES, stream);
    if (e != hipSuccess) fprintf(stderr, "kernel_launch: cooperative launch failed: %s (grid %d)\n", hipGetErrorString(e), grid);
#else
    launch_phase<0>(p, grid, stream); launch_phase<1>(p, grid, stream); launch_phase<2>(p, grid, stream); launch_phase<3>(p, grid, stream); launch_phase<4>(p, grid, stream);
    launch_phase<5>(p, grid, stream); launch_phase<6>(p, grid, stream); launch_phase<7>(p, grid, stream); launch_phase<8>(p, grid, stream);
#endif
}
```

```cpp
#include <hip/hip_runtime.h>
#include <hip/hip_cooperative_groups.h>
#include <cstdio>
#include <cstdint>
namespace cg = cooperative_groups;
namespace pg8 {
#define PG8_LAS __attribute__((address_space(3)))
typedef unsigned short bf16_t;
typedef short bf16x8 __attribute__((ext_vector_type(8)));
typedef float f32x4 __attribute__((ext_vector_type(4)));
typedef unsigned u32x4 __attribute__((ext_vector_type(4)));
constexpr int BM = 256, BK = 64, HALF = 128, HTB = HALF * BK * 2  , STAGE_BYTES = 8 * HTB, NXCD = 8, WGM = 8;

__host__ __device__ __forceinline__ int lds_byte(int r, int c) { const int st = (r >> 4) * 2 + (c >> 5), rr = r & 15, cc = c & 31, ob = rr * 64 + cc * 2; return st * 1024 + (ob ^ (((ob >> 9) & 1) << 5)); }
__host__ __device__ __forceinline__ void stage_rc(int b, int& R, int& C) { const int st = b / 1024, sb = b % 1024, swz = sb ^ (((sb >> 9) & 1) << 5); R = (st >> 1) * 16 + swz / 64; C = (st & 1) * 32 + (swz % 64) / 2; }
__host__ __device__ __forceinline__ int perm32(int rho) { const int n = rho >> 4, i = rho & 15; return 8 * (i >> 2) + 4 * n + (i & 3); }

struct Unit { int pm, pn; };
struct Gemm { const bf16_t* A; const bf16_t* Bt; int M, N, K; };

struct StaticOrder {
    int nM, nN, nwg, G, c;
    __host__ __device__ void init(int M, int N, int G_, int c_) { nM = M / BM; nN = N / BM; nwg = nM * nN; G = G_; c = c_; }
    __host__ __device__ bool next(int i, Unit& u) const {
        const long L = (long)i * G + c; if (L >= nwg) return false;
        int wgid = (int)L; { const int q = nwg / NXCD, r = nwg % NXCD, xcd = wgid % NXCD, off = wgid / NXCD; wgid = (xcd < r ? xcd * (q + 1) : r * (q + 1) + (xcd - r) * q) + off; }
        const int nig = WGM * nN, gid = wgid / nig, fm = gid * WGM, gsz = (nM - fm) < WGM ? (nM - fm) : WGM;
        u.pm = fm + ((wgid % nig) % gsz); u.pn = (wgid % nig) / gsz; return true;
    }
    __device__ __forceinline__ void a_ready(const Unit&) const {}
    __device__ __forceinline__ void done(const Unit&) const {}
};
__device__ __forceinline__ unsigned cvt_pk_bf16(float lo, float hi) { unsigned r; asm volatile("v_cvt_pk_bf16_f32 %0, %1, %2" : "=v"(r) : "v"(lo), "v"(hi)); return r; }
__device__ __forceinline__ float dpp_shr1(float v) { return __builtin_bit_cast(float, __builtin_amdgcn_update_dpp(0, __builtin_bit_cast(int, v), 0x111, 0xf, 0xf, true)); }
__device__ __forceinline__ float dpp_shr2(float v) { return __builtin_bit_cast(float, __builtin_amdgcn_update_dpp(0, __builtin_bit_cast(int, v), 0x112, 0xf, 0xf, true)); }
__device__ __forceinline__ float dpp_shl15(float v) { return __builtin_bit_cast(float, __builtin_amdgcn_update_dpp(0, __builtin_bit_cast(int, v), 0x10F, 0xf, 0xf, true)); }
__device__ __forceinline__ float dpp_shl14(float v) { return __builtin_bit_cast(float, __builtin_amdgcn_update_dpp(0, __builtin_bit_cast(int, v), 0x10E, 0xf, 0xf, true)); }
__device__ __forceinline__ float gelu_tanh(float x) {
    const float z = 0.7978845608028654f * (x + 0.044715f * x * x * x);
    const float e = __builtin_amdgcn_exp2f(-2.8853900817779268f * z);
    return x * __builtin_amdgcn_rcpf(1.0f + e);
}
constexpr int TOKP = 32768;

struct EpiIn {
    static constexpr bool PERM = true, AFTER_DRAIN = false;
    bf16_t* P; const float* cosT; const float* sinT; const float* rs0;
    __device__ __forceinline__ void operator()(const f32x4 (&acc)[2][2][4][2], const Unit& u, int wr, int wc, int fr, int fq) const {
        asm volatile("" : "+v"(fr), "+v"(fq));
        const int row0 = u.pm * BM + wr * 64 + fr, col0 = u.pn * BM + wc * 32 + 8 * fq;
        if (u.pn < 4) {
            const float sc = (u.pn >= 2) ? 0.08838834764831845f : 1.0f;
            const int f0 = 16 * wc + 4 * fq;
#pragma unroll
            for (int ai = 0; ai < 2; ++ai)
#pragma unroll
                for (int m = 0; m < 4; ++m) {
                    const int r = row0 + ai * HALF + m * 16;
                    const int pos = r < TOKP ? (r & 4095) : 4096 + ((r - TOKP) & 15);
                    const float rsr = rs0[r] * sc;
                    const f32x4 c4 = *(const f32x4*)(cosT + pos * 64 + f0) * rsr, s4 = *(const f32x4*)(sinT + pos * 64 + f0) * rsr;
                    bf16_t* rowp = P + (size_t)r * 3584 + col0;
#pragma unroll
                    for (int bj = 0; bj < 2; ++bj) {
                        const f32x4 x1 = acc[ai][bj][m][0], x2 = acc[ai][bj][m][1];
                        const f32x4 o1 = x1 * c4 - x2 * s4, o2 = x2 * c4 + x1 * s4;
                        u32x4 w; w.x = cvt_pk_bf16(o1[0], o1[1]); w.y = cvt_pk_bf16(o1[2], o1[3]); w.z = cvt_pk_bf16(o2[0], o2[1]); w.w = cvt_pk_bf16(o2[2], o2[3]);
                        *(u32x4*)(rowp + bj * HALF) = w;
                    }
                }
        } else if (u.pn >= 10) {
#pragma unroll
            for (int ai = 0; ai < 2; ++ai)
#pragma unroll
                for (int m = 0; m < 4; ++m) {
                    const int r = row0 + ai * HALF + m * 16;
                    float rsr = rs0[r]; rsr *= rsr;
                    const f32x4 v0 = acc[ai][0][m][0] * acc[ai][1][m][0] * rsr, v1 = acc[ai][0][m][1] * acc[ai][1][m][1] * rsr;
                    u32x4 w; w.x = cvt_pk_bf16(v0[0], v0[1]); w.y = cvt_pk_bf16(v0[2], v0[3]); w.z = cvt_pk_bf16(v1[0], v1[1]); w.w = cvt_pk_bf16(v1[2], v1[3]);
                    *(u32x4*)(P + (size_t)r * 3584 + 2560 + 128 * (u.pn - 10) + wc * 32 + 8 * fq) = w;
                }
        } else {
#pragma unroll
            for (int ai = 0; ai < 2; ++ai)
#pragma unroll
                for (int m = 0; m < 4; ++m) {
                    bf16_t* rowp = P + (size_t)(row0 + ai * HALF + m * 16) * 3584 + col0;
                    const float rsr = rs0[row0 + ai * HALF + m * 16];
#pragma unroll
                    for (int bj = 0; bj < 2; ++bj) {
                        const f32x4 v0 = acc[ai][bj][m][0] * rsr, v1 = acc[ai][bj][m][1] * rsr;
                        u32x4 w; w.x = cvt_pk_bf16(v0[0], v0[1]); w.y = cvt_pk_bf16(v0[2], v0[3]); w.z = cvt_pk_bf16(v1[0], v1[1]); w.w = cvt_pk_bf16(v1[2], v1[3]);
                        *(u32x4*)(rowp + bj * HALF) = w;
                    }
                }
        }
    }
};

struct EpiY {
    static constexpr bool PERM = true, AFTER_DRAIN = false;
    bf16_t* Y; float* ssq;
    __device__ __forceinline__ void operator()(const f32x4 (&acc)[2][2][4][2], const Unit& u, int wr, int wc, int fr, int fq) const {
        asm volatile("" : "+v"(fr), "+v"(fq));
        const int row0 = u.pm * BM + wr * 64 + fr, col0 = u.pn * BM + wc * 32 + 8 * fq;
#pragma unroll
        for (int ai = 0; ai < 2; ++ai)
#pragma unroll
            for (int m = 0; m < 4; ++m) {
                const int r = row0 + ai * HALF + m * 16;
                bf16_t* rowp = Y + (size_t)r * 1024 + col0;
                float s = 0.f;
#pragma unroll
                for (int bj = 0; bj < 2; ++bj) {
                    const f32x4 v0 = acc[ai][bj][m][0], v1 = acc[ai][bj][m][1];
                    s += (v0[0] * v0[0] + v0[1] * v0[1]) + (v0[2] * v0[2] + v0[3] * v0[3]) + (v1[0] * v1[0] + v1[1] * v1[1]) + (v1[2] * v1[2] + v1[3] * v1[3]);
                    u32x4 w; w.x = cvt_pk_bf16(v0[0], v0[1]); w.y = cvt_pk_bf16(v0[2], v0[3]); w.z = cvt_pk_bf16(v1[0], v1[1]); w.w = cvt_pk_bf16(v1[2], v1[3]);
                    *(u32x4*)(rowp + bj * HALF) = w;
                }
                s += __shfl_xor(s, 16); s += __shfl_xor(s, 32);
                if (fq == 0) ssq[(size_t)r * 16 + u.pn * 4 + wc] = s;
            }
    }
};

struct EpiFfn {
    static constexpr bool PERM = true, AFTER_DRAIN = false;
    bf16_t* ACT; const float* cw; const float* cache; float* outp; float* outs; PG8_LAS float* halo; const float* rs2;
    __device__ __forceinline__ void operator()(const f32x4 (&acc)[2][2][4][2], const Unit& u, int wr, int wc, int fr, int fq) const {
        asm volatile("" : "+v"(fr), "+v"(fq));
        const int lc0 = wc * 32 + 8 * fq, ch0 = u.pn * 128 + lc0;
        const bool sample = false;
        const int par = u.pm & 1;
        float rs[2][4];
#pragma unroll
        for (int ai = 0; ai < 2; ++ai)
#pragma unroll
            for (int m = 0; m < 4; ++m) rs[ai][m] = rs2[u.pm * BM + ai * HALF + wr * 64 + m * 16 + fr];
        f32x4 w0[2], w1[2], w2[2];
#pragma unroll
        for (int n = 0; n < 2; ++n) { w0[n] = *(const f32x4*)(cw + ch0 + 4 * n); w1[n] = *(const f32x4*)(cw + 4096 + ch0 + 4 * n); w2[n] = *(const f32x4*)(cw + 8192 + ch0 + 4 * n); }
        if (!sample && fr >= 14) {
#pragma unroll
            for (int ai = 0; ai < 2; ++ai) { PG8_LAS float* hp = halo + ((par * 4 + 2 * ai + wr) * 2 + (fr - 14)) * 128 + lc0;
                *(PG8_LAS f32x4*)hp = acc[ai][0][3][0] * rs[ai][3]; *(PG8_LAS f32x4*)(hp + 4) = acc[ai][0][3][1] * rs[ai][3]; }
        }
        asm volatile("s_waitcnt lgkmcnt(0)" ::: "memory"); __builtin_amdgcn_s_barrier(); asm volatile("" ::: "memory");
#pragma unroll
        for (int ai = 0; ai < 2; ++ai) {
            const int blk = 2 * ai + wr;
#pragma unroll
            for (int m = 0; m < 4; ++m) {
                f32x4 pv[2]; pv[0] = (f32x4){0.f, 0.f, 0.f, 0.f}; pv[1] = pv[0];
                const int sb = 8 * ai + 4 * wr + m;
                if (sample) {
                    if (fr >= 14 && sb < 8) { const float* cp = cache + (size_t)(sb * 2 + fr - 14) * 4096 + ch0; pv[0] = *(const f32x4*)cp; pv[1] = *(const f32x4*)(cp + 4); }
                } else if (m == 0) {
                    if (fr >= 14) {
                        const bool zero = (blk == 0) && ((u.pm & 15) == 0);
                        const int hb = (blk == 0) ? ((par ^ 1) * 4 + 3) : (par * 4 + blk - 1);
                        if (!zero) { const PG8_LAS float* hp = halo + (hb * 2 + fr - 14) * 128 + lc0; pv[0] = *(const PG8_LAS f32x4*)hp; pv[1] = *(const PG8_LAS f32x4*)(hp + 4); }
                    }
                } else { pv[0] = acc[ai][0][m - 1][0] * rs[ai][m - 1]; pv[1] = acc[ai][0][m - 1][1] * rs[ai][m - 1]; }
                const int r = u.pm * BM + ai * HALF + wr * 64 + m * 16 + fr;
                f32x4 a4[2];
#pragma unroll
                for (int n = 0; n < 2; ++n) {
                    const f32x4 cur = acc[ai][0][m][n] * rs[ai][m], gt = acc[ai][1][m][n] * rs[ai][m];
                    f32x4 p1, p2;
#pragma unroll
                    for (int e = 0; e < 4; ++e) { p1[e] = dpp_shr1(cur[e]) + dpp_shl15(pv[n][e]); p2[e] = dpp_shr2(cur[e]) + dpp_shl14(pv[n][e]); }
                    const f32x4 uc = w0[n] * p2 + w1[n] * p1 + w2[n] * cur;
                    const f32x4 zz = (uc * uc * 0.044715f + 1.0f) * uc * (-2.8853900817779268f * 0.7978845608028654f);
                    f32x4 rr;
#pragma unroll
                    for (int e = 0; e < 4; ++e) rr[e] = __builtin_amdgcn_rcpf(1.0f + __builtin_amdgcn_exp2f(zz[e]));
                    a4[n] = uc * rr * gt;
                }
                u32x4 w; w.x = cvt_pk_bf16(a4[0][0], a4[0][1]); w.y = cvt_pk_bf16(a4[0][2], a4[0][3]); w.z = cvt_pk_bf16(a4[1][0], a4[1][1]); w.w = cvt_pk_bf16(a4[1][2], a4[1][3]);
                *(u32x4*)(ACT + (size_t)r * 4096 + ch0) = w;
                if (sample) {
                    if (fr >= 14 && sb < 8) { float* op = outs + (size_t)(sb * 2 + fr - 14) * 4096 + ch0; *(f32x4*)op = acc[ai][0][m][0]; *(f32x4*)(op + 4) = acc[ai][0][m][1]; }
                } else if (m == 3 && blk == 3 && (u.pm & 15) == 15 && fr >= 14) {
                    float* op = outp + (size_t)((u.pm >> 4) * 2 + fr - 14) * 4096 + ch0; *(f32x4*)op = acc[ai][0][m][0] * rs[ai][m]; *(f32x4*)(op + 4) = acc[ai][0][m][1] * rs[ai][m];
                }
            }
        }
    }
};
struct WalkOrder {
    int G, c;
    __device__ __forceinline__ bool next(int i, Unit& u) const {
        int w = c, rem = i;
        while (w < 256) { const int len = 16;
            if (rem < len) { if (w < 256) { u.pm = (w >> 5) * 16 + rem; u.pn = w & 31; } else { u.pm = 128; u.pn = w - 256; } return true; }
            rem -= len; w += G; }
        return false;
    }
    __device__ __forceinline__ void a_ready(const Unit&) const {}
    __device__ __forceinline__ void done(const Unit&) const {}
};
template <class Epi, class Sched, bool ALIGN_EPI = false, bool SP2 = false>
__device__ __forceinline__ void gemm_phase(PG8_LAS unsigned char* lds, const Gemm g, const Sched& S, const Epi& E) {
    int tid_raw = threadIdx.x; asm volatile("" : "+v"(tid_raw));
    const int tid = tid_raw, wid = __builtin_amdgcn_readfirstlane(tid >> 6), lane = tid & 63, wr = wid >> 2, wc = wid & 3, fr = lane & 15, fq = lane >> 4;
    const int K = g.K, nt = K / BK;
    unsigned voffA[2], voffB[2];
#pragma unroll
    for (int i = 0; i < 2; ++i) { int R, C; stage_rc(tid * 16 + i * 8192, R, C); const int Rb = Epi::PERM ? ((R & ~31) + perm32(R & 31)) : R;
        voffA[i] = (unsigned)(R * K + C) * 2u; voffB[i] = (unsigned)(Rb * K + C) * 2u; }
    const size_t kstep = (size_t)(BK * 2);
    const size_t hstep = (size_t)HALF * K * 2;
    const size_t tstep = 2 * hstep;
    const unsigned ldsw = (unsigned)wid * 1024u;
    const int aoff = lds_byte(wr * 64 + fr, fq * 8), boff = lds_byte(wc * 32 + fr, fq * 8);
#define PG8_SA(b, h) (((b) * 2 + (h)) * HTB)
#define PG8_SB(b, h) ((4 + (b) * 2 + (h)) * HTB)
#define PG8_STAGE(bufoff, gbase, voff) do { _Pragma("unroll") for (int _i = 0; _i < 2; ++_i) \
        __builtin_amdgcn_global_load_lds((const unsigned*)((const char*)(gbase) + (voff)[_i]), (PG8_LAS unsigned*)(lds + (bufoff) + ldsw + _i * 8192), 16, 0, 0); } while (0)
#define PG8_LDA(dst, b, h) do { _Pragma("unroll") for (int m = 0; m < 4; ++m) _Pragma("unroll") for (int k = 0; k < 2; ++k) dst[m][k] = *(const PG8_LAS bf16x8*)(lds + PG8_SA(b, h) + aoff + m * 2048 + k * 1024); } while (0)
#define PG8_LDB(dst, b, h) do { _Pragma("unroll") for (int n = 0; n < 2; ++n) _Pragma("unroll") for (int k = 0; k < 2; ++k) dst[n][k] = *(const PG8_LAS bf16x8*)(lds + PG8_SB(b, h) + boff + n * 2048 + k * 1024); } while (0)
#define PG8_MMA(ai, bj, At, Bt) do { __builtin_amdgcn_s_setprio(1); _Pragma("unroll") for (int m = 0; m < 4; ++m) _Pragma("unroll") for (int n = 0; n < 2; ++n) _Pragma("unroll") for (int k = 0; k < 2; ++k) \
        acc[ai][bj][m][n] = __builtin_amdgcn_mfma_f32_16x16x32_bf16(Bt[n][k], At[m][k], acc[ai][bj][m][n], 0, 0, 0); __builtin_amdgcn_s_setprio(0); } while (0)
#define PG8_WAIT_V(n) asm volatile("s_waitcnt vmcnt(" #n ")" ::: "memory")
#define PG8_WAIT_L(n) asm volatile("s_waitcnt lgkmcnt(" #n ")" ::: "memory")
#define PG8_BAR __builtin_amdgcn_s_barrier()
#define PG8_SCHED __builtin_amdgcn_sched_barrier(0)
    Unit cur, nxt; int ui = 0;
    if (!S.next(0, cur)) return;
    f32x4 acc[2][2][4][2];
#pragma unroll
    for (int a = 0; a < 2; ++a)
#pragma unroll
        for (int b = 0; b < 2; ++b)
#pragma unroll
            for (int m = 0; m < 4; ++m)
#pragma unroll
                for (int n = 0; n < 2; ++n) acc[a][b][m][n] = (f32x4){0.f, 0.f, 0.f, 0.f};
    bf16x8 At[4][2], B0[2][2], B1[2][2];
    const char* cA = (const char*)g.A + (size_t)cur.pm * tstep; const char* cB = (const char*)g.Bt + (size_t)cur.pn * tstep;
    S.a_ready(cur);
    if constexpr (SP2) {
        PG8_STAGE(PG8_SB(0, 0), cB, voffB); PG8_STAGE(PG8_SB(0, 1), cB + hstep, voffB); PG8_STAGE(PG8_SA(0, 0), cA, voffA); PG8_STAGE(PG8_SA(0, 1), cA + hstep, voffA);
        if (wr == 1) PG8_BAR;
        PG8_WAIT_V(2); PG8_BAR;
        PG8_STAGE(PG8_SB(1, 0), cB + kstep, voffB); PG8_STAGE(PG8_SA(1, 0), cA + kstep, voffA); PG8_STAGE(PG8_SB(1, 1), cB + hstep + kstep, voffB);
        PG8_WAIT_V(6); PG8_BAR;
    } else {
        PG8_STAGE(PG8_SB(0, 0), cB, voffB); PG8_STAGE(PG8_SA(0, 0), cA, voffA); PG8_STAGE(PG8_SB(0, 1), cB + hstep, voffB); PG8_STAGE(PG8_SA(0, 1), cA + hstep, voffA);
        if (wr == 1) PG8_BAR;
        PG8_WAIT_V(4); PG8_BAR;
        PG8_STAGE(PG8_SB(1, 0), cB + kstep, voffB); PG8_STAGE(PG8_SA(1, 0), cA + kstep, voffA); PG8_STAGE(PG8_SB(1, 1), cB + hstep + kstep, voffB);
        PG8_WAIT_V(6); PG8_BAR;
    }
    for (;;) {
        const bool has_next = S.next(ui + 1, nxt);
        const char* nA = has_next ? (const char*)g.A + (size_t)nxt.pm * tstep : cA; const char* nB = has_next ? (const char*)g.Bt + (size_t)nxt.pn * tstep : cB;
        for (int t = 0; t < nt; t += 2) {
            const bool last = (t == nt - 2);
            const char* a1 = cA + (size_t)(t + 1) * kstep;
            const char* a2 = last ? nA : cA + (size_t)(t + 2) * kstep; const char* b2 = last ? nB : cB + (size_t)(t + 2) * kstep;
            const char* a3 = a2 + kstep; const char* b3 = b2 + kstep;
            if (last && has_next) S.a_ready(nxt);
            if constexpr (SP2) {
            PG8_LDB(B0, 0, 0); PG8_LDB(B1, 0, 1); PG8_SCHED; PG8_LDA(At, 0, 0); PG8_STAGE(PG8_SA(1, 1), a1 + hstep, voffA);
            PG8_WAIT_V(8); PG8_WAIT_L(0); PG8_BAR; PG8_MMA(0, 0, At, B0); PG8_MMA(0, 1, At, B1); PG8_BAR; PG8_SCHED;
            PG8_LDA(At, 0, 1); PG8_STAGE(PG8_SB(0, 0), b2, voffB); PG8_STAGE(PG8_SB(0, 1), b2 + hstep, voffB); PG8_STAGE(PG8_SA(0, 0), a2, voffA);
            PG8_WAIT_V(8); PG8_WAIT_L(0); PG8_BAR; PG8_MMA(1, 0, At, B0); PG8_MMA(1, 1, At, B1); PG8_BAR; PG8_SCHED;
            PG8_LDB(B0, 1, 0); PG8_LDB(B1, 1, 1); PG8_SCHED; PG8_LDA(At, 1, 0); PG8_STAGE(PG8_SA(0, 1), a2 + hstep, voffA);
            PG8_WAIT_V(8); PG8_WAIT_L(0); PG8_BAR; PG8_MMA(0, 0, At, B0); PG8_MMA(0, 1, At, B1); PG8_BAR; PG8_SCHED;
            PG8_LDA(At, 1, 1); PG8_STAGE(PG8_SB(1, 0), b3, voffB); PG8_STAGE(PG8_SB(1, 1), b3 + hstep, voffB); PG8_STAGE(PG8_SA(1, 0), a3, voffA);
            PG8_WAIT_V(8); PG8_WAIT_L(0); PG8_BAR; PG8_MMA(1, 0, At, B0); PG8_MMA(1, 1, At, B1); PG8_BAR; PG8_SCHED;
            } else {
            PG8_LDB(B0, 0, 0); PG8_SCHED; PG8_LDA(At, 0, 0); PG8_STAGE(PG8_SA(1, 1), a1 + hstep, voffA);
            PG8_WAIT_L(8); PG8_BAR; PG8_WAIT_L(0); PG8_MMA(0, 0, At, B0); PG8_BAR; PG8_SCHED;
            PG8_LDB(B1, 0, 1); PG8_STAGE(PG8_SB(0, 0), b2, voffB);
            PG8_BAR; PG8_WAIT_L(0); PG8_MMA(0, 1, At, B1); PG8_BAR;
            PG8_LDA(At, 0, 1); PG8_STAGE(PG8_SA(0, 0), a2, voffA);
            PG8_BAR; PG8_WAIT_L(0); PG8_MMA(1, 0, At, B0); PG8_BAR; PG8_SCHED;
            PG8_STAGE(PG8_SB(0, 1), b2 + hstep, voffB);
            PG8_WAIT_V(6); PG8_BAR; PG8_MMA(1, 1, At, B1); PG8_BAR;
            PG8_LDB(B0, 1, 0); PG8_SCHED; PG8_LDA(At, 1, 0); PG8_STAGE(PG8_SA(0, 1), a2 + hstep, voffA);
            PG8_WAIT_L(8); PG8_BAR; PG8_WAIT_L(0); PG8_MMA(0, 0, At, B0); PG8_BAR; PG8_SCHED;
            PG8_LDB(B1, 1, 1); PG8_STAGE(PG8_SB(1, 0), b3, voffB);
            PG8_BAR; PG8_WAIT_L(0); PG8_MMA(0, 1, At, B1); PG8_BAR;
            PG8_LDA(At, 1, 1); PG8_STAGE(PG8_SA(1, 0), a3, voffA);
            PG8_BAR; PG8_WAIT_L(0); PG8_MMA(1, 0, At, B0); PG8_BAR; PG8_SCHED;
            PG8_STAGE(PG8_SB(1, 1), b3 + hstep, voffB);
            PG8_WAIT_V(6); PG8_BAR; PG8_MMA(1, 1, At, B1); PG8_BAR;
            }
        }
        if constexpr (ALIGN_EPI) { if (wr == 0) PG8_BAR; }
        if constexpr (!Epi::AFTER_DRAIN) { E(acc, cur, wr, wc, fr, fq); S.done(cur); }
        if (!has_next) break;
#pragma unroll
        for (int a = 0; a < 2; ++a)
#pragma unroll
            for (int b = 0; b < 2; ++b)
#pragma unroll
                for (int m = 0; m < 4; ++m)
#pragma unroll
                    for (int n = 0; n < 2; ++n) acc[a][b][m][n] = (f32x4){0.f, 0.f, 0.f, 0.f};
        cur = nxt; cA = nA; cB = nB; ++ui;
        if constexpr (ALIGN_EPI) { if (wr == 1) PG8_BAR; }
    }
    PG8_WAIT_V(0);
    if constexpr (!ALIGN_EPI) { if (wr == 0) PG8_BAR; }
    PG8_BAR;
    if constexpr (Epi::AFTER_DRAIN) { E.fused(acc, cur, wr, wc, fr, fq, lds, wid, lane); S.done(cur); }
#undef PG8_SA
#undef PG8_SB
#undef PG8_STAGE
#undef PG8_LDA
#undef PG8_LDB
#undef PG8_MMA
#undef PG8_WAIT_V
#undef PG8_WAIT_L
#undef PG8_BAR
#undef PG8_SCHED
}
}

using pg8::bf16_t; using pg8::bf16x8; using pg8::f32x4; using pg8::u32x4;
#define LAS __attribute__((address_space(3)))
typedef unsigned u32x2 __attribute__((ext_vector_type(2)));
constexpr int DM = 1024, NIN = 3584, DFF = 4096;
constexpr int TOK_P = 32768, TOK = 32896, TOKPAD = 33024;
constexpr float EPS = 1e-6f;
constexpr size_t WS_WIN = 16384;
constexpr size_t WS_WOUT = WS_WIN + (size_t)NIN * DM * 2;
constexpr size_t WS_WFF1 = WS_WOUT + (size_t)DM * DM * 2;
constexpr size_t WS_WDN = WS_WFF1 + (size_t)2 * DFF * DM * 2;
constexpr size_t WS_COS = WS_WDN + (size_t)DM * DFF * 2;
constexpr size_t WS_SIN = WS_COS + (size_t)4112 * 64 * 4;
constexpr size_t WS_SSQ1 = WS_SIN + (size_t)4112 * 64 * 4;
constexpr size_t WS_SSQ2 = WS_SSQ1 + (size_t)TOKPAD * 16 * 4;
constexpr size_t WS_UG = WS_SSQ2 + (size_t)TOKPAD * 16 * 4;
constexpr size_t WS_PS = WS_UG + (size_t)256 * 32768;
constexpr size_t WS_YS = WS_PS + (size_t)128 * NIN * 4;
constexpr size_t WS_FS = WS_YS + (size_t)4 * 128 * DM * 4;
constexpr size_t WS_RA = WS_FS + (size_t)4 * 128 * DM * 4;
constexpr size_t WS_RB = WS_RA + (size_t)TOKPAD * DM * 2;
constexpr size_t WS_Y = WS_RB + (size_t)TOKPAD * DFF * 2;
constexpr size_t WS_RS2 = WS_Y + (size_t)TOKPAD * DM * 2;
constexpr size_t WS_RS0 = WS_RS2 + (size_t)TOK_P * 4;
constexpr size_t WS_XB = WS_RS0 + (size_t)TOK_P * 4;
constexpr size_t WS_END = WS_XB + (size_t)TOK_P * DM * 2;
constexpr size_t O_SRP = (size_t)TOK * DM, O_CCP = O_SRP + 524288, O_CFP = O_CCP + 8192, O_SRS = O_CFP + 65536, O_CCS = O_SRS + 524288, O_CFS = O_CCS + 8192;
constexpr int LDS_HALO = 131072, LDS_BARW = 131072 + 8192, LDS_BYTES = LDS_BARW + 16;

struct Params { const float* in[17]; float* out; unsigned char* ws; };

__device__ __forceinline__ float dppf(float v, const int ctrl_sel) {
    const int iv = __builtin_bit_cast(int, v); int r;
    switch (ctrl_sel) { case 1: r = __builtin_amdgcn_update_dpp(0, iv, 0x111, 0xf, 0xf, true); break; case 2: r = __builtin_amdgcn_update_dpp(0, iv, 0x112, 0xf, 0xf, true); break;
        case 4: r = __builtin_amdgcn_update_dpp(0, iv, 0x114, 0xf, 0xf, true); break; case 8: r = __builtin_amdgcn_update_dpp(0, iv, 0x118, 0xf, 0xf, true); break;
        case 15: r = __builtin_amdgcn_update_dpp(0, iv, 0x142, 0xa, 0xf, false); break; default: r = __builtin_amdgcn_update_dpp(0, iv, 0x143, 0xc, 0xf, false); break; }
    return __builtin_bit_cast(float, r);
}
__device__ __forceinline__ float wave_sum(float v) {
    v += dppf(v, 1); v += dppf(v, 2); v += dppf(v, 4); v += dppf(v, 8); v += dppf(v, 15); v += dppf(v, 31);
    return __builtin_bit_cast(float, __builtin_amdgcn_readlane(__builtin_bit_cast(int, v), 63));
}
__device__ __forceinline__ float bf2f(unsigned short b) { return __uint_as_float(((unsigned)b) << 16); }
__device__ __forceinline__ unsigned pk2(float a, float b) { return pg8::cvt_pk_bf16(a, b); }
__device__ __forceinline__ unsigned pk2s(float a, float b) { unsigned r; asm("v_cvt_pk_bf16_f32 %0, %1, %2" : "=v"(r) : "v"(a), "v"(b)); return r; }
__device__ __forceinline__ float silu_f(float g) { return g * __builtin_amdgcn_rcpf(1.0f + __builtin_amdgcn_exp2f(-1.4426950408889634f * g)); }
__device__ __forceinline__ int dmap(int P) { return ((P >> 2) & 1) * 64 + (P >> 3) * 4 + (P & 3); }
__device__ __forceinline__ int pmap(int d) { return ((d >> 4) & 3) * 32 + ((d >> 2) & 3) * 8 + ((d >> 6) & 1) * 4 + (d & 3); }

constexpr int RB = 6;
__device__ __forceinline__ f32x4 unpack_bf4(const u32x2 w) { f32x4 v; v[0] = __uint_as_float(w.x << 16); v[1] = __uint_as_float(w.x & 0xffff0000u); v[2] = __uint_as_float(w.y << 16); v[3] = __uint_as_float(w.y & 0xffff0000u); return v; }
__device__ __forceinline__ float sumsq4(const f32x4 a) { return (a[0] * a[0] + a[1] * a[1]) + (a[2] * a[2] + a[3] * a[3]); }
template <int MODE> __device__ __forceinline__ int rowmap(int c) {
    if (MODE == 0) { if (c < 1024) return (c & ~127) + pmap(c & 127);
        if (c >= 2560) { const int cc = (c - 2560) & 511, hcsel = (c >= 3072) ? 128 : 0; return 2560 + ((cc >> 7) << 8) + hcsel + (cc & 127); }
        return c; }
    if (MODE == 1) return c;
    if (MODE == 2) return ((c >> 7) << 8) + (c & 127);
    return ((c >> 7) << 8) + 128 + (c & 127);
}
template <int MODE, bool GAIN = false>
__device__ __forceinline__ void transpose_item(const float* W, int K, int N, bf16_t* WT, LAS float* scr, int item, int lane, const float* gain = nullptr) {
    const int nblk = N / 32, kb = item / nblk, nb = item % nblk, k0 = 64 * kb, n0 = 32 * nb;
#pragma unroll
    for (int i = 0; i < 32; ++i) { const int kk = 2 * i + (lane >> 5); scr[kk * 33 + (lane & 31)] = W[(size_t)(k0 + kk) * N + n0 + (lane & 31)]; }
    asm volatile("s_waitcnt lgkmcnt(0)" ::: "memory");
    const int c = lane & 7;
    f32x4 ga = (f32x4){1.f, 1.f, 1.f, 1.f}, gb = ga;
    if (GAIN) { ga = *(const f32x4*)(gain + k0 + 8 * c); gb = *(const f32x4*)(gain + k0 + 8 * c + 4); }
#pragma unroll
    for (int j = 0; j < 4; ++j) { const int n = (lane >> 3) + 8 * j; const LAS float* s = scr + (8 * c) * 33 + n;
        u32x4 o; o.x = pk2(s[0 * 33] * ga[0], s[1 * 33] * ga[1]); o.y = pk2(s[2 * 33] * ga[2], s[3 * 33] * ga[3]); o.z = pk2(s[4 * 33] * gb[0], s[5 * 33] * gb[1]); o.w = pk2(s[6 * 33] * gb[2], s[7 * 33] * gb[3]);
        *(u32x4*)(WT + (size_t)rowmap<MODE>(n0 + n) * K + k0 + 8 * c) = o; }
    asm volatile("s_waitcnt lgkmcnt(0)" ::: "memory");
}
__device__ __forceinline__ void phase0(const Params& p, LAS unsigned char* lds, int tid, int wid, int lane) {
    LAS float* scr = (LAS float*)(lds + wid * 8448);
    const int gw = blockIdx.x * 8 + wid, NGW = gridDim.x * 8;
    bf16_t* win = (bf16_t*)(p.ws + WS_WIN); bf16_t* wout = (bf16_t*)(p.ws + WS_WOUT); bf16_t* wff1 = (bf16_t*)(p.ws + WS_WFF1); bf16_t* wdn = (bf16_t*)(p.ws + WS_WDN);
    constexpr int I_IN = 16 * 112, I_OUT = 16 * 32, I_UP = 16 * 128, I_DN = 64 * 32, NITEMS = I_IN + I_OUT + 2 * I_UP + I_DN;
    for (int it = gw; it < NITEMS; it += NGW) {
        int r = it;
        if (r < I_IN) { transpose_item<0, true>(p.in[5], DM, NIN, win, scr, r, lane, p.in[9]); continue; } r -= I_IN;
        if (r < I_OUT) { transpose_item<1>(p.in[6], DM, DM, wout, scr, r, lane); continue; } r -= I_OUT;
        if (r < I_UP) { transpose_item<2, true>(p.in[13], DM, DFF, wff1, scr, r, lane, p.in[11]); continue; } r -= I_UP;
        if (r < I_UP) { transpose_item<3, true>(p.in[14], DM, DFF, wff1, scr, r, lane, p.in[11]); continue; } r -= I_UP;
        transpose_item<1>(p.in[16], DFF, DM, wdn, scr, r, lane);
    }
    float* cosT = (float*)(p.ws + WS_COS); float* sinT = (float*)(p.ws + WS_SIN);
    for (int idx = blockIdx.x * 512 + tid; idx < 4112 * 64; idx += gridDim.x * 512) {
        const int pos = idx >> 6, f = idx & 63;
        const float inv = exp2f(-(float)(2 * f) * (1.0f / 128.0f) * 13.287712379549449f);
        const float ang = (float)pos * inv;
        const double rev = (double)ang * 0.15915494309189535;
        const float fr = (float)(rev - floor(rev));
        cosT[idx] = __builtin_amdgcn_cosf(fr); sinT[idx] = __builtin_amdgcn_sinf(fr);
    }
    bf16_t* H = (bf16_t*)(p.ws + WS_RA); bf16_t* XB = (bf16_t*)(p.ws + WS_XB); float* RS0 = (float*)(p.ws + WS_RS0);
#pragma unroll 1
    for (int base = gw; base < TOK; base += RB * NGW) {
        f32x4 v[RB][4]; float s[RB];
#pragma unroll
        for (int k = 0; k < RB; ++k) { const int rr = min(base + k * NGW, TOK - 1);
            const float* xrow = rr < TOK_P ? p.in[0] + (size_t)rr * DM : p.in[1] + (size_t)(rr - TOK_P) * DM; s[k] = 0.f;
#pragma unroll
            for (int j = 0; j < 4; ++j) { v[k][j] = __builtin_nontemporal_load((const f32x4*)xrow + lane + 64 * j); s[k] += sumsq4(v[k][j]); } }
#pragma unroll
        for (int k = 0; k < RB; ++k) { const int r = base + k * NGW; const float rstd = rsqrtf(wave_sum(s[k]) * (1.0f / DM) + EPS);
            if (r < TOK_P) {
                if (lane == 0) RS0[r] = rstd;
#pragma unroll
                for (int j = 0; j < 4; ++j) *((u32x2*)(XB + (size_t)r * DM) + lane + 64 * j) = (u32x2){pk2(v[k][j][0], v[k][j][1]), pk2(v[k][j][2], v[k][j][3])};
            } else if (r < TOK) {
#pragma unroll
                for (int j = 0; j < 4; ++j) { const f32x4 y = v[k][j] * rstd; *((u32x2*)(H + (size_t)r * DM) + lane + 64 * j) = (u32x2){pk2(y[0], y[1]), pk2(y[2], y[3])}; } } }
    }
}

constexpr int QI_OFF = 0, KI_OFF = 17408, KT_OFF = 34816, VT_OFF = 53248, SI_OFF = 71680, ST_OFF = 80896, GI_OFF = 115712;
#define MFMA16(a, b, c) __builtin_amdgcn_mfma_f32_16x16x32_bf16((a), (b), (c), 0, 0, 0)
#define RET_ISSUE(S, nn) do { _Pragma("unroll") for (int i_ = 0; i_ < 2; ++i_) { \
        const bf16_t* rowp_ = P + (tok0 + (size_t)(nn) * 64 + 2 * (tid >> 4) + i_) * NIN + 128 * h + (tid & 15) * 8; \
        if (FULL) { rq[S][i_] = *(const u32x4*)rowp_; rg[S][i_] = *(const u32x4*)(rowp_ + 1536); } rk[S][i_] = *(const u32x4*)(rowp_ + 512); rv[S][i_] = *(const u32x4*)(rowp_ + 1024); } } while (0)
#define RET_STAGE_A(S) do { const int j_ = 2 * (tid >> 4), ch_ = tid & 15; \
        if (FULL) { _Pragma("unroll") for (int i_ = 0; i_ < 2; ++i_) { *(LAS u32x4*)(lds + QI_OFF + (j_ + i_) * 272 + ch_ * 16) = rq[S][i_]; *(LAS u32x4*)(lds + KI_OFF + (j_ + i_) * 272 + ch_ * 16) = rk[S][i_]; *(LAS u32x4*)(lds + GI_OFF + (j_ + i_) * 272 + ch_ * 16) = rg[S][i_]; } } \
        const float te0_ = __builtin_amdgcn_exp2f(l2g * (float)(63 - j_)), te1_ = __builtin_amdgcn_exp2f(l2g * (float)(62 - j_)); \
        const unsigned ka_[4] = {rk[S][0].x, rk[S][0].y, rk[S][0].z, rk[S][0].w}, kb_[4] = {rk[S][1].x, rk[S][1].y, rk[S][1].z, rk[S][1].w}; \
        const unsigned va_[4] = {rv[S][0].x, rv[S][0].y, rv[S][0].z, rv[S][0].w}, vb_[4] = {rv[S][1].x, rv[S][1].y, rv[S][1].z, rv[S][1].w}; \
        const int cofs_ = 16 * ((j_ >> 3) ^ (ch_ & 7)) + 2 * (j_ & 7); \
        _Pragma("unroll") for (int e2 = 0; e2 < 4; ++e2) { const int row_ = 8 * ch_ + 2 * e2; \
            *(LAS unsigned*)(lds + KT_OFF + row_ * 144 + cofs_) = pk2(__uint_as_float(ka_[e2] << 16) * te0_, __uint_as_float(kb_[e2] << 16) * te1_); \
            *(LAS unsigned*)(lds + KT_OFF + (row_ + 1) * 144 + cofs_) = pk2(__uint_as_float(ka_[e2] & 0xffff0000u) * te0_, __uint_as_float(kb_[e2] & 0xffff0000u) * te1_); \
            *(LAS unsigned*)(lds + VT_OFF + row_ * 144 + cofs_) = (va_[e2] & 0xffffu) | (vb_[e2] << 16); \
            *(LAS unsigned*)(lds + VT_OFF + (row_ + 1) * 144 + cofs_) = (va_[e2] >> 16) | (vb_[e2] & 0xffff0000u); } } while (0)
#define WG_BAR() do { asm volatile("s_waitcnt lgkmcnt(0)" ::: "memory"); __builtin_amdgcn_s_barrier(); asm volatile("" ::: "memory"); } while (0)
template <bool FULL>
__device__ __forceinline__ void ret_unit(const Params& p, LAS unsigned char* lds, int unit, int tid, int wid, int lane) {
    asm volatile("" : "+v"(tid), "+v"(lane));
    const int G = unit & 7, h = (unit >> 3) & 3, b = unit >> 5;
    const bf16_t* P = (const bf16_t*)(p.ws + WS_RB);
    bf16_t* MIX = (bf16_t*)(p.ws + WS_RA);
    float* UG = (float*)(p.ws + WS_UG);
    const size_t tok0 = (size_t)b * 4096 + (size_t)G * 512;
    const float l2g = log2f(1.0f - exp2f(-5.0f - (float)h));
    const float g64 = __builtin_amdgcn_exp2f(l2g * 64.0f);
    const bool is_state = wid >= 4; const int w4 = wid & 3;
    const int l15 = lane & 15, l4 = lane >> 4;
    const int vtL = l4 ^ (l15 >> 3);
    const int vtb0 = VT_OFF + l15 * 144 + 16 * vtL, vtb1 = VT_OFF + l15 * 144 + 16 * (vtL ^ 2);
#define VT_ADDR(nt, ks) ((((nt) & 1) ? vtb1 : vtb0) + (nt) * 2304 + 16 * (((4 * (ks)) ^ (2 * ((nt) & 3))) & 4))
    constexpr int PD = FULL ? 1 : 4;
    u32x4 rq[PD][2], rk[PD][2], rv[PD][2], rg[PD][2];
    if (is_state) {
        f32x4 st[2][8];
#pragma unroll
        for (int mt = 0; mt < 2; ++mt)
#pragma unroll
            for (int nt = 0; nt < 8; ++nt) st[mt][nt] = (f32x4){0.f, 0.f, 0.f, 0.f};
        if (FULL) {
#pragma unroll 1
            for (int Gp = 0; Gp < G; Gp += 2) {
                const float wa = __builtin_amdgcn_exp2f(l2g * 512.0f * (float)(G - 1 - Gp));
                const bool two = Gp + 1 < G;
                const float wb = two ? __builtin_amdgcn_exp2f(l2g * 512.0f * (float)(G - 2 - Gp)) : 0.f;
                const u32x2* sa = (const u32x2*)UG + ((size_t)((b * 4 + h) * 8 + Gp) * 4 + w4) * 1024 + lane;
                const u32x2* sb = two ? sa + 4 * 1024 : sa;
#pragma unroll
                for (int mt = 0; mt < 2; ++mt)
#pragma unroll
                    for (int nt = 0; nt < 8; ++nt) st[mt][nt] += unpack_bf4(sa[(mt * 8 + nt) * 64]) * wa + unpack_bf4(sb[(mt * 8 + nt) * 64]) * wb;
            }
        }
#pragma unroll
        for (int s = 0; s < PD; ++s) RET_ISSUE(s, s);
#pragma unroll 1
        for (int n0 = 0; n0 < 8; n0 += PD) {
#pragma unroll
          for (int s = 0; s < PD; ++s) { const int n = n0 + s;
            RET_STAGE_A(s);
            if (n + PD < 8) RET_ISSUE(s, n + PD);
            if (FULL) {
#pragma unroll
                for (int mt = 0; mt < 2; ++mt)
#pragma unroll
                    for (int nt = 0; nt < 8; ++nt) { const int e = 16 * nt + l15, dk0 = 32 * w4 + 16 * mt + 4 * l4;
                        *(LAS u32x2*)(lds + ST_OFF + e * 272 + dk0 * 2) = (u32x2){pk2(st[mt][nt][0], st[mt][nt][1]), pk2(st[mt][nt][2], st[mt][nt][3])}; }
            }
            WG_BAR();
            if (FULL) {
                bf16x8 ak[4];
#pragma unroll
                for (int ks = 0; ks < 4; ++ks) ak[ks] = *(const LAS bf16x8*)(lds + KI_OFF + (16 * w4 + l15) * 272 + (32 * ks + 8 * l4) * 2);
#pragma unroll
                for (int it = 0; it < 4; ++it) {
                    bf16x8 bq[4];
#pragma unroll
                    for (int ks = 0; ks < 4; ++ks) bq[ks] = *(const LAS bf16x8*)(lds + QI_OFF + (16 * it + l15) * 272 + (32 * ks + 8 * l4) * 2);
                    f32x4 sa = (f32x4){0.f, 0.f, 0.f, 0.f};
#pragma unroll
                    for (int ks = 0; ks < 4; ++ks) sa = MFMA16(ak[ks], bq[ks], sa);
                    const int i = 16 * it + l15, j0 = 16 * w4 + 4 * l4;
#pragma unroll
                    for (int r = 0; r < 4; ++r) { const int d = i - (j0 + r); sa[r] *= __builtin_amdgcn_exp2f(l2g * (float)(d < 0 ? -d : d)); }
                    *(LAS u32x2*)(lds + SI_OFF + i * 144 + j0 * 2) = (u32x2){pk2(sa[0], sa[1]), pk2(sa[2], sa[3])};
                }
            }
            WG_BAR();
#pragma unroll
            for (int mt = 0; mt < 2; ++mt)
#pragma unroll
                for (int nt = 0; nt < 8; ++nt) st[mt][nt] = st[mt][nt] * g64;
#pragma unroll
            for (int ks = 0; ks < 2; ++ks) {
                bf16x8 akt[2];
#pragma unroll
                for (int mt = 0; mt < 2; ++mt) { const int row = 32 * w4 + 16 * mt + l15; akt[mt] = *(const LAS bf16x8*)(lds + KT_OFF + row * 144 + 16 * ((4 * ks + l4) ^ ((row >> 3) & 7))); }
#pragma unroll
                for (int nh = 0; nh < 2; ++nh) {
                    bf16x8 bv[4];
#pragma unroll
                    for (int nt = 0; nt < 4; ++nt) bv[nt] = *(const LAS bf16x8*)(lds + VT_ADDR(4 * nh + nt, ks));
#pragma unroll
                    for (int nt = 0; nt < 4; ++nt)
#pragma unroll
                        for (int mt = 0; mt < 2; ++mt) st[mt][4 * nh + nt] = MFMA16(akt[mt], bv[nt], st[mt][4 * nh + nt]);
                }
            }
            WG_BAR();
          }
        }
        if (!FULL) {
            u32x2* dst = (u32x2*)UG + ((size_t)unit * 4 + w4) * 1024 + lane;
#pragma unroll
            for (int mt = 0; mt < 2; ++mt)
#pragma unroll
                for (int nt = 0; nt < 8; ++nt) dst[(mt * 8 + nt) * 64] = (u32x2){pk2(st[mt][nt][0], st[mt][nt][1]), pk2(st[mt][nt][2], st[mt][nt][3])};
        } else if (G == 7) {
            float* o = p.out + O_SRP + (size_t)(b * 4 + h) * 16384 + (64 * (l4 & 1) + 16 * w4 + 4 * (l4 >> 1)) * 128 + l15;
#pragma unroll
            for (int mt = 0; mt < 2; ++mt)
#pragma unroll
                for (int nt = 0; nt < 8; ++nt)
#pragma unroll
                    for (int r = 0; r < 4; ++r) o[(8 * mt + r) * 128 + 16 * nt] = st[mt][nt][r];
        }
    } else {
        float rwv[8];
#pragma unroll
        for (int nt = 0; nt < 8; ++nt) rwv[nt] = p.in[8][128 * h + 16 * nt + l15];
#pragma unroll
        for (int s = 0; s < PD; ++s) RET_ISSUE(s, s);
#pragma unroll 1
        for (int n0 = 0; n0 < 8; n0 += PD) {
#pragma unroll
          for (int s = 0; s < PD; ++s) { const int n = n0 + s;
            RET_STAGE_A(s);
            if (n + PD < 8) RET_ISSUE(s, n + PD);
            WG_BAR();
            f32x4 acc[8];
            if (FULL) {
                f32x4 fsv;
#pragma unroll
                for (int r = 0; r < 4; ++r) fsv[r] = __builtin_amdgcn_exp2f(l2g * (float)(16 * w4 + 4 * l4 + r + 1));
#pragma unroll
                for (int nt = 0; nt < 8; ++nt) acc[nt] = (f32x4){0.f, 0.f, 0.f, 0.f};
                bf16x8 aq[4];
#pragma unroll
                for (int ks = 0; ks < 4; ++ks) aq[ks] = *(const LAS bf16x8*)(lds + QI_OFF + (16 * w4 + l15) * 272 + (32 * ks + 8 * l4) * 2);
#pragma unroll
                for (int ks = 0; ks < 4; ++ks)
#pragma unroll
                    for (int nh = 0; nh < 2; ++nh) {
                        bf16x8 bs[4];
#pragma unroll
                        for (int nt = 0; nt < 4; ++nt) bs[nt] = *(const LAS bf16x8*)(lds + ST_OFF + (16 * (4 * nh + nt) + l15) * 272 + (32 * ks + 8 * l4) * 2);
#pragma unroll
                        for (int nt = 0; nt < 4; ++nt) acc[4 * nh + nt] = MFMA16(aq[ks], bs[nt], acc[4 * nh + nt]);
                    }
#pragma unroll
                for (int nt = 0; nt < 8; ++nt) acc[nt] = acc[nt] * fsv;
            }
            WG_BAR();
            if (FULL) {
                bf16x8 as_[2];
#pragma unroll
                for (int ks = 0; ks < 2; ++ks) as_[ks] = *(const LAS bf16x8*)(lds + SI_OFF + (16 * w4 + l15) * 144 + 16 * (4 * ks + l4));
#pragma unroll
                for (int ks = 0; ks < 2; ++ks)
#pragma unroll
                    for (int nh = 0; nh < 2; ++nh) {
                        bf16x8 bv[4];
#pragma unroll
                        for (int nt = 0; nt < 4; ++nt) bv[nt] = *(const LAS bf16x8*)(lds + VT_ADDR(4 * nh + nt, ks));
#pragma unroll
                        for (int nt = 0; nt < 4; ++nt) acc[4 * nh + nt] = MFMA16(as_[ks], bv[nt], acc[4 * nh + nt]);
                    }
                unsigned short gq[4][8];
#pragma unroll
                for (int r = 0; r < 4; ++r)
#pragma unroll
                    for (int nt = 0; nt < 8; ++nt) gq[r][nt] = *(const LAS unsigned short*)(lds + GI_OFF + (16 * w4 + 4 * l4 + r) * 272 + (16 * nt + l15) * 2);
                float rstd[4];
#pragma unroll
                for (int r = 0; r < 4; ++r) { float ss = 0.f;
#pragma unroll
                    for (int nt = 0; nt < 8; ++nt) ss += acc[nt][r] * acc[nt][r];
                    ss += dppf(ss, 1); ss += dppf(ss, 2); ss += dppf(ss, 4); ss += dppf(ss, 8);
                    ss = __shfl(ss, (lane & 48) | 15);
                    rstd[r] = rsqrtf(ss * (1.0f / 128.0f) + EPS); }
#pragma unroll
                for (int r = 0; r < 4; ++r)
#pragma unroll
                    for (int nt = 0; nt < 8; ++nt)
                        *(LAS unsigned short*)(lds + QI_OFF + (16 * w4 + 4 * l4 + r) * 272 + (16 * nt + l15) * 2) = (unsigned short)(pk2s(acc[nt][r] * rstd[r] * rwv[nt] * silu_f(bf2f(gq[r][nt])), 0.f) & 0xffffu);
#pragma unroll
                for (int q = 0; q < 4; ++q) { const int cidx = lane + 64 * q, row = 16 * w4 + (cidx >> 4), ch = cidx & 15;
                    const u32x4 v = *(const LAS u32x4*)(lds + QI_OFF + row * 272 + ch * 16);
                    *(u32x4*)(MIX + (tok0 + (size_t)n * 64 + row) * DM + 128 * h + ch * 8) = v; }
            }
            WG_BAR();
          }
        }
    }
#ifndef CONVREP
#define CONVREP 1
#endif
    if (FULL) for (int crep_ = 0; crep_ < CONVREP; ++crep_) {
        const int c0 = 128 * h + 8 * (tid & 15), run = tid >> 4, t0 = G * 512 + run * 16;
        const float* cwp = p.in[7];
        float w0[8], w1[8], w2[8], p1[8], p2[8];
#pragma unroll
        for (int e = 0; e < 8; ++e) { w0[e] = cwp[c0 + e]; w1[e] = cwp[512 + c0 + e]; w2[e] = cwp[1024 + c0 + e]; p1[e] = 0.f; p2[e] = 0.f; }
        if (t0 > 0) {
            const bf16_t* r2 = P + ((size_t)b * 4096 + t0 - 2) * NIN; const bf16_t* r1 = r2 + NIN;
            const u32x4 c2 = *(const u32x4*)(r2 + 2560 + c0), c1 = *(const u32x4*)(r1 + 2560 + c0);
            const unsigned c2w[4] = {c2.x, c2.y, c2.z, c2.w}, c1w[4] = {c1.x, c1.y, c1.z, c1.w};
#pragma unroll
            for (int e = 0; e < 4; ++e) {
                p2[2 * e] = __uint_as_float(c2w[e] << 16); p2[2 * e + 1] = __uint_as_float(c2w[e] & 0xffff0000u);
                p1[2 * e] = __uint_as_float(c1w[e] << 16); p1[2 * e + 1] = __uint_as_float(c1w[e] & 0xffff0000u); }
        }
#pragma unroll 8
        for (int t = 0; t < 16; ++t) {
            const size_t row = (size_t)b * 4096 + t0 + t;
            const bf16_t* rp = P + row * NIN;
            const u32x4 bb = *(const u32x4*)(rp + 2048 + c0), cc = *(const u32x4*)(rp + 2560 + c0);
            const unsigned bw[4] = {bb.x, bb.y, bb.z, bb.w}, cw4[4] = {cc.x, cc.y, cc.z, cc.w};
            float y[8];
#pragma unroll
            for (int e = 0; e < 4; ++e) {
                const float ca = __uint_as_float(cw4[e] << 16), cb = __uint_as_float(cw4[e] & 0xffff0000u);
                y[2 * e] = __uint_as_float(bw[e] << 16) * (w0[2 * e] * p2[2 * e] + w1[2 * e] * p1[2 * e] + w2[2 * e] * ca);
                y[2 * e + 1] = __uint_as_float(bw[e] & 0xffff0000u) * (w0[2 * e + 1] * p2[2 * e + 1] + w1[2 * e + 1] * p1[2 * e + 1] + w2[2 * e + 1] * cb);
                p2[2 * e] = p1[2 * e]; p2[2 * e + 1] = p1[2 * e + 1]; p1[2 * e] = ca; p1[2 * e + 1] = cb;
            }
            *(u32x4*)(MIX + row * DM + 512 + c0) = (u32x4){pk2(y[0], y[1]), pk2(y[2], y[3]), pk2(y[4], y[5]), pk2(y[6], y[7])};
        }
        if (G == 7 && run == 31) {
            float* o = p.out + O_CCP + (size_t)b * 1024 + c0;
#pragma unroll
            for (int e = 0; e < 8; ++e) { o[e] = p2[e]; o[512 + e] = p1[e]; }
        }
    }
#undef VT_ADDR
}

__device__ __forceinline__ float ch_at(const float* PS, const float* cache, int b, int t, int ch) {
    if (t < 0) return cache[(b * 2 + (t + 2)) * 512 + ch];
    const float* rp = PS + (size_t)(16 * b + t) * NIN;
    const int cc = 2560 + ((ch >> 7) << 8) + (ch & 127);
    return rp[cc] * rp[cc + 128];
}
__device__ __forceinline__ void sample_unit(const Params& p, LAS unsigned char* lds, int sup, int tid, int wid, int lane) {
    const int su = sup >> 2, part = sup & 3;
    const int b = su >> 2, h = su & 3, ts0 = TOK_P + 16 * b;
    const float* PS = (const float*)(p.ws + WS_PS);
    bf16_t* MIX = (bf16_t*)(p.ws + WS_RA);
    LAS float* qs = (LAS float*)lds; LAS float* ks = qs + 2048; LAS float* vs = qs + 4096; LAS float* Ssm = qs + 6144; LAS float* osm = qs + 6400;
    const float l2g = log2f(1.0f - exp2f(-5.0f - (float)h));
    const float* cosT = (const float*)(p.ws + WS_COS); const float* sinT = (const float*)(p.ws + WS_SIN);
    for (int idx = tid; idx < 2048; idx += 512) { const int i = idx >> 7, c = idx & 127, d = dmap(c);
        const float* rp = PS + (size_t)(16 * b + i) * NIN + 128 * h;
        const float cs = cosT[(4096 + i) * 64 + (d & 63)], sn = sinT[(4096 + i) * 64 + (d & 63)];
        const float xq = rp[c], xqp = rp[c ^ 4], xk = rp[512 + c], xkp = rp[512 + (c ^ 4)];
        qs[i * 128 + d] = d < 64 ? xq * cs - xqp * sn : xq * cs + xqp * sn;
        ks[i * 128 + d] = (d < 64 ? xk * cs - xkp * sn : xk * cs + xkp * sn) * 0.08838834764831845f;
        vs[i * 128 + c] = rp[1024 + c]; }
    const int e = tid & 127, sub = tid >> 7, irow = 4 * part + sub;
    LAS float* s0 = qs + 8704;
    { const float* s0g = p.in[2] + (size_t)su * 16384; f32x4 t8[8];
#pragma unroll
      for (int q = 0; q < 8; ++q) t8[q] = *((const f32x4*)s0g + tid + 512 * q);
#pragma unroll
      for (int q = 0; q < 8; ++q) *((LAS f32x4*)s0 + tid + 512 * q) = t8[q]; }
    __syncthreads();
    if (tid < 64) { const int i = 4 * part + (tid >> 4), j = tid & 15; float s = 0.f;
        for (int d = 0; d < 128; ++d) s += qs[i * 128 + d] * ks[j * 128 + d];
        const int dd = i - j; Ssm[i * 16 + j] = s * __builtin_amdgcn_exp2f(l2g * (float)(dd < 0 ? -dd : dd)); }
    float cr = 0.f;
#pragma unroll 8
    for (int d = 0; d < 128; ++d) cr += qs[irow * 128 + d] * s0[d * 128 + e];
    __syncthreads();
    { float o = 0.f;
      for (int j = 0; j < 16; ++j) o += Ssm[irow * 16 + j] * vs[j * 128 + e];
      osm[irow * 128 + e] = o + __builtin_amdgcn_exp2f(l2g * (float)(irow + 1)) * cr; }
    __syncthreads();
    if (wid < 4) { const int i = 4 * part + wid; const float v0 = osm[i * 128 + lane], v1 = osm[i * 128 + 64 + lane];
        const float rstd = rsqrtf(wave_sum(v0 * v0 + v1 * v1) * (1.0f / 128.0f) + EPS);
        const size_t token = (size_t)(ts0 + i);
        const float g0 = PS[(size_t)(16 * b + i) * NIN + 1536 + 128 * h + lane], g1 = PS[(size_t)(16 * b + i) * NIN + 1536 + 128 * h + 64 + lane];
        MIX[token * DM + 128 * h + lane] = (bf16_t)(pk2(v0 * rstd * p.in[8][128 * h + lane] * silu_f(g0), 0.f) & 0xffffu);
        MIX[token * DM + 128 * h + 64 + lane] = (bf16_t)(pk2(v1 * rstd * p.in[8][128 * h + 64 + lane] * silu_f(g1), 0.f) & 0xffffu); }
    const float g16 = __builtin_amdgcn_exp2f(l2g * 16.0f);
    float* outS = p.out + O_SRS + (size_t)su * 16384;
#pragma unroll 2
    for (int dd = 0; dd < 8; ++dd) { const int d = 32 * part + sub + 4 * dd; float a = g16 * s0[d * 128 + e];
        for (int j = 0; j < 16; ++j) a += __builtin_amdgcn_exp2f(l2g * (float)(15 - j)) * ks[j * 128 + d] * vs[j * 128 + e];
        outS[d * 128 + e] = a; }
    { const int ch = 128 * h + e; const float* cache = p.in[3]; const float* cwp = p.in[7];
      const float w0 = cwp[ch], w1 = cwp[512 + ch], w2 = cwp[1024 + ch];
      const int t = irow;
      const float c0 = ch_at(PS, cache, b, t - 2, ch), c1 = ch_at(PS, cache, b, t - 1, ch), c2 = ch_at(PS, cache, b, t, ch);
      const float y = PS[(size_t)(16 * b + t) * NIN + 2048 + ch] * (w0 * c0 + w1 * c1 + w2 * c2);
      MIX[(size_t)(ts0 + t) * DM + 512 + ch] = (bf16_t)(pk2(y, 0.f) & 0xffffu);
      if (t >= 14) p.out[O_CCS + (size_t)(b * 2 + t - 14) * 512 + ch] = c2; }
    __syncthreads();
}

constexpr int TG_B = 34816, TG_BUF = 34816 + 32 * 272;
template <int NB>
__device__ __forceinline__ void thin_gemm2(LAS unsigned char* lds, const bf16_t* A, int lda, const bf16_t* Bt, int ldb, int n0, int nbstride, int kbeg, int klen, f32x4 (&acc)[NB], int tid, int wid, int lane) {
    const int l15 = lane & 15, l4 = lane >> 4, nkb = klen >> 7;
    const bool hasb = tid < NB * 256;
    const bf16_t* ag = A + (size_t)(tid >> 4) * lda + kbeg + (tid & 15) * 8;
    const bf16_t* bg = Bt + (size_t)(n0 + (tid >> 8) * nbstride + ((tid >> 4) & 15)) * ldb + kbeg + (tid & 15) * 8;
    const int sto = (tid >> 4) * 272 + (tid & 15) * 16;
    const int fro = l15 * 272 + (8 * l4) * 2;
    u32x4 Xa[4], Ya[4], Xb = (u32x4){0u, 0u, 0u, 0u}, Yb = Xb;
#define TG_LOAD(R, kb) do { _Pragma("unroll") for (int i_ = 0; i_ < 4; ++i_) R##a[i_] = *(const u32x4*)(ag + (size_t)(32 * i_) * lda + (kb) * 128); if (hasb) R##b = *(const u32x4*)(bg + (kb) * 128); } while (0)
#define TG_STORE(R, buf) do { _Pragma("unroll") for (int i_ = 0; i_ < 4; ++i_) *(LAS u32x4*)(lds + (buf) * TG_BUF + sto + i_ * 32 * 272) = R##a[i_]; if (hasb) *(LAS u32x4*)(lds + (buf) * TG_BUF + TG_B + sto) = R##b; } while (0)
#define TG_COMP(buf) do { _Pragma("unroll") for (int ks = 0; ks < 4; ++ks) { const bf16x8 a_ = *(const LAS bf16x8*)(lds + (buf) * TG_BUF + 16 * wid * 272 + fro + ks * 64); \
        _Pragma("unroll") for (int nb = 0; nb < NB; ++nb) { const bf16x8 b_ = *(const LAS bf16x8*)(lds + (buf) * TG_BUF + TG_B + 16 * nb * 272 + fro + ks * 64); acc[nb] = MFMA16(a_, b_, acc[nb]); } } } while (0)
#pragma unroll
    for (int nb = 0; nb < NB; ++nb) acc[nb] = (f32x4){0.f, 0.f, 0.f, 0.f};
    TG_LOAD(X, 0); TG_LOAD(Y, 1);
    TG_STORE(X, 0); WG_BAR();
#pragma unroll 1
    for (int kb = 0; kb < nkb; kb += 2) {
        if (kb + 2 < nkb) TG_LOAD(X, kb + 2);
        TG_COMP(0);
        TG_STORE(Y, 1); WG_BAR();
        if (kb + 3 < nkb) TG_LOAD(Y, kb + 3);
        TG_COMP(1);
        if (kb + 2 < nkb) TG_STORE(X, 0);
        WG_BAR();
    }
#undef TG_LOAD
#undef TG_STORE
#undef TG_COMP
}
template <int NB>
__device__ __forceinline__ void thin_gemm(const bf16_t* A, int lda, const bf16_t* Bt, int ldb, int n0, int nbstride, int kbeg, int klen, f32x4 (&acc)[NB], int wid, int lane) {
    const int l15 = lane & 15, l4 = lane >> 4;
    const bf16_t* ap = A + (size_t)(16 * wid + l15) * lda + kbeg + 8 * l4;
    const bf16_t* bp = Bt + (size_t)(n0 + l15) * ldb + kbeg + 8 * l4;
#pragma unroll
    for (int nb = 0; nb < NB; ++nb) acc[nb] = (f32x4){0.f, 0.f, 0.f, 0.f};
#pragma unroll 1
    for (int s0 = 0; s0 < klen; s0 += 256) {
        bf16x8 a[8], b[NB][8];
#pragma unroll
        for (int s = 0; s < 8; ++s) { a[s] = *(const bf16x8*)(ap + s0 + 32 * s);
#pragma unroll
            for (int nb = 0; nb < NB; ++nb) b[nb][s] = *(const bf16x8*)(bp + (size_t)nb * nbstride * ldb + s0 + 32 * s); }
#pragma unroll
        for (int s = 0; s < 8; ++s)
#pragma unroll
            for (int nb = 0; nb < NB; ++nb) acc[nb] = MFMA16(a[s], b[nb][s], acc[nb]);
    }
}
__device__ __forceinline__ void thin_store(const f32x4& acc, float* out, int ldo, int col, int wid, int lane) {
#pragma unroll
    for (int r = 0; r < 4; ++r) out[(size_t)(16 * wid + 4 * (lane >> 4) + r) * ldo + col + (lane & 15)] = acc[r];
}
__device__ __forceinline__ void thin_ffn1(const Params& p, LAS unsigned char* lds, int c, int tid, int wid, int lane) {
    const int pn = c >> 3, j16 = c & 7, l15 = lane & 15, l4 = lane >> 4;
    f32x4 acc[2];
    thin_gemm2<2>(lds, (const bf16_t*)(p.ws + WS_Y) + (size_t)TOK_P * DM, DM, (const bf16_t*)(p.ws + WS_WFF1), DM, 256 * pn + 16 * j16, 128, 0, DM, acc, tid, wid, lane);
    const int ch = 128 * pn + 16 * j16 + l15, b = wid;
    const float* cw = p.in[15]; const float* cache = p.in[4] + (size_t)b * 2 * DFF + ch;
    const float w0 = cw[ch], w1 = cw[DFF + ch], w2 = cw[2 * DFF + ch];
    const f32x4 up = acc[0], gt = acc[1];
    float pm1 = __shfl_up(up[3], 16), pm2 = __shfl_up(up[2], 16);
    if (l4 == 0) { pm1 = cache[DFF]; pm2 = cache[0]; }
    float uc[4];
    uc[0] = w0 * pm2 + w1 * pm1 + w2 * up[0];
    uc[1] = w0 * pm1 + w1 * up[0] + w2 * up[1];
    uc[2] = w0 * up[0] + w1 * up[1] + w2 * up[2];
    uc[3] = w0 * up[1] + w1 * up[2] + w2 * up[3];
    bf16_t* ACT = (bf16_t*)(p.ws + WS_RB);
#pragma unroll
    for (int r = 0; r < 4; ++r) ACT[(size_t)(TOK_P + 16 * wid + 4 * l4 + r) * DFF + ch] = (bf16_t)(pk2(pg8::gelu_tanh(uc[r]) * gt[r], 0.f) & 0xffffu);
    if (l4 == 3) { float* o = p.out + O_CFS + (size_t)b * 2 * DFF + ch; o[0] = up[2]; o[DFF] = up[3]; }
}

__device__ __forceinline__ void phase4(const Params& p, int wid, int lane) {
    const int gw = blockIdx.x * 8 + wid, NGW = gridDim.x * 8;
    bf16_t* Y = (bf16_t*)(p.ws + WS_Y); const float* ssq = (const float*)(p.ws + WS_SSQ1); float* RS2 = (float*)(p.ws + WS_RS2); const bf16_t* XB = (const bf16_t*)(p.ws + WS_XB);
    const float* wpost = p.in[10];
    f32x4 wpo[4];
#pragma unroll
    for (int j = 0; j < 4; ++j) wpo[j] = *((const f32x4*)wpost + lane + 64 * j);
#pragma unroll 1
    for (int base = gw; base < TOK_P; base += RB * NGW) {
        f32x4 v[RB][4]; u32x2 yw[RB][4]; float sq[RB];
#pragma unroll
        for (int k = 0; k < RB; ++k) { const int rr = min(base + k * NGW, TOK_P - 1);
            sq[k] = lane < 16 ? ssq[(size_t)rr * 16 + lane] : 0.f;
#pragma unroll
            for (int j = 0; j < 4; ++j) { v[k][j] = unpack_bf4(__builtin_nontemporal_load((const u32x2*)(XB + (size_t)rr * DM) + lane + 64 * j)); yw[k][j] = __builtin_nontemporal_load((const u32x2*)(Y + (size_t)rr * DM) + lane + 64 * j); } }
        float s2[RB];
#pragma unroll
        for (int k = 0; k < RB; ++k) { const float rstd1 = rsqrtf(wave_sum(sq[k]) * (1.0f / DM) + EPS); s2[k] = 0.f;
#pragma unroll
            for (int j = 0; j < 4; ++j) { v[k][j] = v[k][j] + (unpack_bf4(yw[k][j]) * rstd1) * wpo[j]; s2[k] += sumsq4(v[k][j]); } }
#pragma unroll
        for (int k = 0; k < RB; ++k) { const int r = base + k * NGW; const float rstd2 = rsqrtf(wave_sum(s2[k]) * (1.0f / DM) + EPS);
            if (r < TOK_P) {
                if (lane == 0) RS2[r] = rstd2;
#pragma unroll
                for (int j = 0; j < 4; ++j) *((u32x2*)(Y + (size_t)r * DM) + lane + 64 * j) = (u32x2){pk2(v[k][j][0], v[k][j][1]), pk2(v[k][j][2], v[k][j][3])}; } }
    }
    for (int r = TOK_P + gw; r < TOK; r += NGW) {
        const float* xrow = p.in[1] + (size_t)(r - TOK_P) * DM; const float* ys = (const float*)(p.ws + WS_YS) + (size_t)(r - TOK_P) * DM;
        f32x4 yv[4], v[4]; float s = 0.f, s2 = 0.f;
#pragma unroll
        for (int j = 0; j < 4; ++j) { f32x4 a = *((const f32x4*)ys + lane + 64 * j);
#pragma unroll
            for (int q = 1; q < 4; ++q) a += *((const f32x4*)(ys + (size_t)q * 128 * DM) + lane + 64 * j);
            yv[j] = a; s += sumsq4(a); }
        const float rstd1 = rsqrtf(wave_sum(s) * (1.0f / DM) + EPS);
#pragma unroll
        for (int j = 0; j < 4; ++j) { v[j] = *((const f32x4*)xrow + lane + 64 * j) + (yv[j] * rstd1) * wpo[j]; s2 += sumsq4(v[j]);
 }
        const float rstd2 = rsqrtf(wave_sum(s2) * (1.0f / DM) + EPS);
#pragma unroll
        for (int j = 0; j < 4; ++j) { const f32x4 y = v[j] * rstd2; *((u32x2*)(Y + (size_t)r * DM) + lane + 64 * j) = (u32x2){pk2(y[0], y[1]), pk2(y[2], y[3])}; }
    }
}
__device__ __forceinline__ void phase7(const Params& p, int wid, int lane) {
    const int gw = blockIdx.x * 8 + wid, NGW = gridDim.x * 8;
    const bf16_t* F = (const bf16_t*)(p.ws + WS_RA); const bf16_t* Y = (const bf16_t*)(p.ws + WS_Y);
    const float* ssq1 = (const float*)(p.ws + WS_SSQ1); const float* ssq2 = (const float*)(p.ws + WS_SSQ2);
    f32x4 wm[4], wf[4];
#pragma unroll
    for (int j = 0; j < 4; ++j) { wm[j] = *((const f32x4*)p.in[10] + lane + 64 * j); wf[j] = *((const f32x4*)p.in[12] + lane + 64 * j); }
    constexpr int RB7 = 6;
#pragma unroll 1
    for (int base = gw; base < TOK_P; base += RB7 * NGW) {
        u32x2 xw[RB7][4], fw[RB7][4]; float sq2[RB7];
#pragma unroll
        for (int k = 0; k < RB7; ++k) { const int rr = min(base + k * NGW, TOK_P - 1);
            sq2[k] = lane < 16 ? ssq2[(size_t)rr * 16 + lane] : 0.f;
#pragma unroll
            for (int j = 0; j < 4; ++j) { xw[k][j] = __builtin_nontemporal_load((const u32x2*)(Y + (size_t)rr * DM) + lane + 64 * j); fw[k][j] = __builtin_nontemporal_load((const u32x2*)(F + (size_t)rr * DM) + lane + 64 * j); } }
#pragma unroll
        for (int k = 0; k < RB7; ++k) { const int r = base + k * NGW;
            const float rstd2 = rsqrtf(wave_sum(sq2[k]) * (1.0f / DM) + EPS);
            if (r < TOK_P) {
#pragma unroll
                for (int j = 0; j < 4; ++j) __builtin_nontemporal_store(unpack_bf4(xw[k][j]) + (unpack_bf4(fw[k][j]) * rstd2) * wf[j], (f32x4*)(p.out + (size_t)r * DM) + lane + 64 * j); } }
    }
    for (int r = TOK_P + gw; r < TOK; r += NGW) {
        const float* xrow = p.in[1] + (size_t)(r - TOK_P) * DM;
        const float* ys = (const float*)(p.ws + WS_YS) + (size_t)(r - TOK_P) * DM; const float* fs = (const float*)(p.ws + WS_FS) + (size_t)(r - TOK_P) * DM;
        f32x4 yv[4], fv[4]; float s1 = 0.f, s2 = 0.f;
#pragma unroll
        for (int j = 0; j < 4; ++j) { f32x4 a = *((const f32x4*)ys + lane + 64 * j), c = *((const f32x4*)fs + lane + 64 * j);
#pragma unroll
            for (int q = 1; q < 4; ++q) { a += *((const f32x4*)(ys + (size_t)q * 128 * DM) + lane + 64 * j); c += *((const f32x4*)(fs + (size_t)q * 128 * DM) + lane + 64 * j); }
            yv[j] = a; fv[j] = c; s1 += sumsq4(a); s2 += sumsq4(c); }
        const float rstd1 = rsqrtf(wave_sum(s1) * (1.0f / DM) + EPS), rstd2 = rsqrtf(wave_sum(s2) * (1.0f / DM) + EPS);
#pragma unroll
        for (int j = 0; j < 4; ++j) *((f32x4*)(p.out + (size_t)r * DM) + lane + 64 * j) = *((const f32x4*)xrow + lane + 64 * j) + (yv[j] * rstd1) * wm[j] + (fv[j] * rstd2) * wf[j];
    }
}


#define XB_TMO      128
#define XB_XCNT(j)  (256  + 64 * (j))
#define XB_XSUB(j)  (1280 + 64 * (j))
#define XB_XGEN(j)  (2304 + 64 * (j))
#define XB_TOP      3328
#define XB_TOPGEN   3392
#define XCD_BAR_WORDS 3456
#define XB_SPIN_CAP (1u << 18)

__device__ __forceinline__ unsigned xb_ld(unsigned* p)              { return __hip_atomic_load(p, __ATOMIC_RELAXED, __HIP_MEMORY_SCOPE_AGENT); }
__device__ __forceinline__ unsigned xb_add(unsigned* p, unsigned v) { return __hip_atomic_fetch_add(p, v, __ATOMIC_RELAXED, __HIP_MEMORY_SCOPE_AGENT); }
__device__ __forceinline__ unsigned xb_xcc_id() { return (unsigned)__builtin_amdgcn_s_getreg((3 << 11) | 20) & 0xFu; }
#define XB_SPIN(cond, bar) do { unsigned _sp = 0; while (cond) { __builtin_amdgcn_s_sleep(1); \
    if ((++_sp & 255u) == 0u) { if (xb_ld(&(bar)[XB_TMO])) break; if (_sp > XB_SPIN_CAP) { atomicAdd(&(bar)[XB_TMO], 1u); break; } } } } while (0)

struct XcdBarrier {
    unsigned* bar; unsigned x;
    volatile LAS unsigned* st;
};

__device__ __forceinline__ XcdBarrier xcd_barrier_post(unsigned* bar, volatile LAS unsigned* st) {
    XcdBarrier b; b.bar = bar; b.x = xb_xcc_id(); b.st = st;
    if (threadIdx.x == 0) (void)xb_add(&bar[XB_XCNT(b.x)], 1u);
    return b;
}
__device__ __forceinline__ void xcd_barrier_complete(unsigned* bar, unsigned x, unsigned& nloc, unsigned& nx) {
    const unsigned G = gridDim.x * gridDim.y * gridDim.z;
    unsigned sum, cnt, mine, sp = 0u;
    for (;;) {
        sum = 0u; cnt = 0u; mine = 0u;
#pragma unroll
        for (unsigned j = 0; j < 16; ++j) { const unsigned c = xb_ld(&bar[XB_XCNT(j)]); sum += c; cnt += (c > 0u) ? 1u : 0u; mine = (j == x) ? c : mine; }
        if (sum == G) break;
        __builtin_amdgcn_s_sleep(1);
        if ((++sp & 255u) == 0u) { if (xb_ld(&bar[XB_TMO])) break; if (sp > XB_SPIN_CAP) { atomicAdd(&bar[XB_TMO], 1u); break; } }
    }
    nloc = mine > 0u ? mine : 1u; nx = cnt > 0u ? cnt : 1u;
}

__device__ __forceinline__ void xcd_barrier(const XcdBarrier& b) {
    asm volatile("s_waitcnt vmcnt(0)" ::: "memory");
    __syncthreads();
    if (threadIdx.x == 0) {
        unsigned* bar = b.bar;
        __builtin_amdgcn_s_waitcnt(0);
        unsigned nloc = b.st[0], nx = b.st[1];
        if (nloc == 0u) { xcd_barrier_complete(bar, b.x, nloc, nx); b.st[0] = nloc; b.st[1] = nx; }
        const unsigned old = xb_add(&bar[XB_XSUB(b.x)], 1u);
        const unsigned gen = old / nloc;
        if (old + 1u == (gen + 1u) * nloc) {
            __builtin_amdgcn_fence(__ATOMIC_RELEASE, "agent");
            asm volatile("s_waitcnt vmcnt(0)" ::: "memory");
            const unsigned og = xb_add(&bar[XB_TOP], 1u);
            const unsigned tg = og / nx;
            if (og + 1u == (tg + 1u) * nx) xb_add(&bar[XB_TOPGEN], 1u);
            else XB_SPIN(xb_ld(&bar[XB_TOPGEN]) == tg, bar);
            __builtin_amdgcn_fence(__ATOMIC_ACQUIRE, "agent");
            xb_add(&bar[XB_XGEN(b.x)], 1u);
            asm volatile("s_waitcnt vmcnt(0)" ::: "memory");
        } else {
            XB_SPIN(xb_ld(&bar[XB_XGEN(b.x)]) == gen, bar);
            __builtin_amdgcn_fence(__ATOMIC_ACQUIRE, "agent");
            asm volatile("s_waitcnt vmcnt(0)" ::: "memory");
        }
    }
    __syncthreads();
}

#ifndef MK_LAUNCHES
#define MK_LAUNCHES 1
#endif
#ifndef REP0
#define REP0 1
#endif
#ifndef REP1
#define REP1 1
#endif
#ifndef REP2
#define REP2 1
#endif
#ifndef REP3
#define REP3 1
#endif
#ifndef REP4
#define REP4 1
#endif
#ifndef REP5
#define REP5 1
#endif
#ifndef REP6
#define REP6 1
#endif
#ifndef REP7
#define REP7 1
#endif
#define REPEAT(n) for (int rep_ = 0; rep_ < (n); ++rep_, ((rep_ < (n)) ? GRIDSYNC() : (void)0))
template <int PH_LO, int PH_HI>
__device__ __forceinline__ void run_phases(const Params& p, LAS unsigned char* lds) {
    int tid = threadIdx.x, lane = tid & 63; const int wid = __builtin_amdgcn_readfirstlane(tid >> 6);
    const int G = gridDim.x, c = blockIdx.x;
#define LAUNDER() asm volatile("" : "+v"(tid), "+v"(lane))
    XcdBarrier bar_;
    if (PH_HI - PH_LO > 1) {
        volatile LAS unsigned* stw = (volatile LAS unsigned*)(lds + LDS_BARW);
        if (threadIdx.x == 0) { stw[0] = 0u; stw[1] = 0u; }
        __syncthreads();
        bar_ = xcd_barrier_post((unsigned*)p.ws, stw);
        if (p.ws == nullptr) cg::this_grid().sync();
    }
#define GRIDSYNC() xcd_barrier(bar_)
#define SEAM(ph) do { if (PH_LO <= (ph) && (ph) + 1 < PH_HI) { GRIDSYNC(); } } while (0)
#ifdef XSYNC
    for (int xs_ = 0; xs_ < XSYNC; ++xs_) GRIDSYNC();
#endif
    if (PH_LO <= 0 && 0 < PH_HI) REPEAT(REP0) { LAUNDER(); phase0(p, lds, tid, wid, lane); }
    SEAM(0);
    if (PH_LO <= 1 && 1 < PH_HI) REPEAT(REP1) {
        for (int t = c; t < 224; t += G) { f32x4 acc[1]; thin_gemm2<1>(lds, (const bf16_t*)(p.ws + WS_RA) + (size_t)TOK_P * DM, DM, (const bf16_t*)(p.ws + WS_WIN), DM, 16 * t, 0, 0, DM, acc, tid, wid, lane);
            thin_store(acc[0], (float*)(p.ws + WS_PS), NIN, 16 * t, wid, lane); }
        pg8::Gemm g{(const bf16_t*)(p.ws + WS_XB), (const bf16_t*)(p.ws + WS_WIN), TOK_P, NIN, DM};
        pg8::StaticOrder S; S.init(TOK_P, NIN, G, c);
        pg8::EpiIn E{(bf16_t*)(p.ws + WS_RB), (const float*)(p.ws + WS_COS), (const float*)(p.ws + WS_SIN), (const float*)(p.ws + WS_RS0)};
        pg8::gemm_phase<pg8::EpiIn, pg8::StaticOrder, true, true>(lds, g, S, E);
    }
    SEAM(1);
    if (PH_LO <= 2 && 2 < PH_HI) REPEAT(REP2) {
#ifndef RUREP
#define RUREP 1
#endif
        for (int rrep_ = 0; rrep_ < RUREP; ++rrep_) for (int u = c; u < 256; u += G) ret_unit<false>(p, lds, u, tid, wid, lane);
        LAUNDER();
#ifndef SUREP
#define SUREP 1
#endif
        for (int srep_ = 0; srep_ < SUREP; ++srep_) for (int su = c; su < 128; su += G) sample_unit(p, lds, su, tid, wid, lane);
    }
    SEAM(2);
    if (PH_LO <= 3 && 3 < PH_HI) REPEAT(REP3) {
        for (int u = c; u < 256; u += G) ret_unit<true>(p, lds, u, tid, wid, lane);
    }
    SEAM(3);
    if (PH_LO <= 4 && 4 < PH_HI) REPEAT(REP4) {
        for (int t = c; t < 256; t += G) { f32x4 acc[1]; const int kq = t >> 6, nt = t & 63;
            thin_gemm2<1>(lds, (const bf16_t*)(p.ws + WS_RA) + (size_t)TOK_P * DM, DM, (const bf16_t*)(p.ws + WS_WOUT), DM, 16 * nt, 0, 256 * kq, 256, acc, tid, wid, lane);
            thin_store(acc[0], (float*)(p.ws + WS_YS) + (size_t)kq * 128 * DM, DM, 16 * nt, wid, lane); }
        pg8::Gemm g{(const bf16_t*)(p.ws + WS_RA), (const bf16_t*)(p.ws + WS_WOUT), TOK_P, DM, DM};
        pg8::StaticOrder S; S.init(TOK_P, DM, G, c);
        pg8::EpiY E{(bf16_t*)(p.ws + WS_Y), (float*)(p.ws + WS_SSQ1)};
        pg8::gemm_phase<pg8::EpiY, pg8::StaticOrder, true, true>(lds, g, S, E);
    }
    SEAM(4);
    if (PH_LO <= 5 && 5 < PH_HI) REPEAT(REP5) { LAUNDER(); phase4(p, wid, lane); }
    SEAM(5);
    if (PH_LO <= 6 && 6 < PH_HI) REPEAT(REP6) {
        for (int t = c; t < 256; t += G) thin_ffn1(p, lds, t, tid, wid, lane);
        pg8::Gemm g{(const bf16_t*)(p.ws + WS_Y), (const bf16_t*)(p.ws + WS_WFF1), TOK_P, 2 * DFF, DM};
        pg8::WalkOrder S{G, c};
        pg8::EpiFfn E{(bf16_t*)(p.ws + WS_RB), p.in[15], p.in[4], p.out + O_CFP, p.out + O_CFS, (LAS float*)(lds + LDS_HALO), (const float*)(p.ws + WS_RS2)};
        pg8::gemm_phase<pg8::EpiFfn, pg8::WalkOrder, true, true>(lds, g, S, E);
    }
    SEAM(6);
    if (PH_LO <= 7 && 7 < PH_HI) REPEAT(REP7) {
        for (int t = c; t < 256; t += G) { f32x4 acc[1]; const int kq = t >> 6, nt = t & 63;
            thin_gemm2<1>(lds, (const bf16_t*)(p.ws + WS_RB) + (size_t)TOK_P * DFF, DFF, (const bf16_t*)(p.ws + WS_WDN), DFF, 16 * nt, 0, 1024 * kq, 1024, acc, tid, wid, lane);
            thin_store(acc[0], (float*)(p.ws + WS_FS) + (size_t)kq * 128 * DM, DM, 16 * nt, wid, lane); }
        pg8::Gemm g{(const bf16_t*)(p.ws + WS_RB), (const bf16_t*)(p.ws + WS_WDN), TOK_P, DM, DFF};
        pg8::StaticOrder S; S.init(TOK_P, DM, G, c);
        pg8::EpiY E{(bf16_t*)(p.ws + WS_RA), (float*)(p.ws + WS_SSQ2)};
        pg8::gemm_phase<pg8::EpiY, pg8::StaticOrder, true, true>(lds, g, S, E);
    }
    SEAM(7);
#ifndef REP8
#define REP8 1
#endif
    if (PH_LO <= 8 && 8 < PH_HI) REPEAT(REP8) { LAUNDER(); phase7(p, wid, lane); }
#undef SEAM
}
constexpr int NPH = 9;
#if MK_LAUNCHES == 1
__global__ void __launch_bounds__(512, 2) fwd_kernel(Params p) {
    extern __shared__ __attribute__((aligned(16))) unsigned char smem[];
    run_phases<0, NPH>(p, (LAS unsigned char*)smem);
}
#else
template <int PH>
__global__ void __launch_bounds__(512, 2) fwd_phase(Params p) {
    extern __shared__ __attribute__((aligned(16))) unsigned char smem[];
    run_phases<PH, PH + 1>(p, (LAS unsigned char*)smem);
}
template <int PH> static void launch_phase(const Params& p, int grid, hipStream_t stream) {
    static bool attr = false;
    if (!attr) { (void)hipFuncSetAttribute((const void*)fwd_phase<PH>, hipFuncAttributeMaxDynamicSharedMemorySize, LDS_BYTES); attr = true; }
    hipLaunchKernelGGL(fwd_phase<PH>, dim3(grid), dim3(512), LDS_BYTES, stream, p);
}
#endif

extern "C" void kernel_launch(void* const* d_in, const int* in_sizes, int n_in, void* d_out, int out_size, void* d_ws, size_t ws_size, hipStream_t stream) {
    static int grid = 0;
    if (grid == 0) {
        if (n_in != 17 || ws_size < WS_END) { fprintf(stderr, "kernel_launch: expected 17 inputs and >= %zu bytes of workspace (got %d, %zu)\n", (size_t)WS_END, n_in, ws_size); grid = -1; return; }
        int dev = 0, cus = 0, per_cu = 0;
        (void)hipGetDevice(&dev); (void)hipDeviceGetAttribute(&cus, hipDeviceAttributeMultiprocessorCount, dev);
#if MK_LAUNCHES == 1
        if (hipFuncSetAttribute((const void*)fwd_kernel, hipFuncAttributeMaxDynamicSharedMemorySize, LDS_BYTES) != hipSuccess) { fprintf(stderr, "kernel_launch: hipFuncSetAttribute failed\n"); grid = -1; return; }
        if (hipOccupancyMaxActiveBlocksPerMultiprocessor(&per_cu, (const void*)fwd_kernel, 512, LDS_BYTES) != hipSuccess || per_cu < 1) { fprintf(stderr, "kernel_launch: occupancy query says %d\n", per_cu); per_cu = 1; }
        (void)hipGetLastError();
#endif
        grid = cus > 0 ? cus : 256;
    }
    if (grid < 0) return;
    Params p{};
    for (int i = 0; i < 17; ++i) p.in[i] = (const float*)d_in[i];
    p.out = (float*)d_out; p.ws = (unsigned char*)d_ws;
#if MK_LAUNCHES == 1
    if (hipMemsetAsync(d_ws, 0, 16384, stream) != hipSuccess) { fprintf(stderr, "kernel_launch: hipMemsetAsync failed\n"); return; }
    void* args[] = {&p};
    const hipError_t e = hipLaunchCooperativeKernel((const void*)fwd_kernel, dim3(grid), dim3(512), args, LDS_BYTES, stream);
    if (e != hipSuccess) fprintf(stderr, "kernel_launch: cooperative launch failed: %s (grid %d)\n", hipGetErrorString(e), grid);
#else
    launch_phase<0>(p, grid, stream); launch_phase<1>(p, grid, stream); launch_phase<2>(p, grid, stream); launch_phase<3>(p, grid, stream); launch_phase<4>(p, grid, stream);
    launch_phase<5>(p, grid, stream); launch_phase<6>(p, grid, stream); launch_phase<7>(p, grid, stream); launch_phase<8>(p, grid, stream);
#endif
}
```

```cpp
#include <hip/hip_runtime.h>
#include <hip/hip_cooperative_groups.h>
#include <cstdio>
#include <cstdint>
namespace cg = cooperative_groups;
namespace pg8 {
#define PG8_LAS __attribute__((address_space(3)))
typedef unsigned short bf16_t;
typedef short bf16x8 __attribute__((ext_vector_type(8)));
typedef float f32x4 __attribute__((ext_vector_type(4)));
typedef unsigned u32x4 __attribute__((ext_vector_type(4)));
constexpr int BM = 256, BK = 64, HALF = 128, HTB = HALF * BK * 2  , STAGE_BYTES = 8 * HTB, NXCD = 8, WGM = 8;

__host__ __device__ __forceinline__ int lds_byte(int r, int c) { const int st = (r >> 4) * 2 + (c >> 5), rr = r & 15, cc = c & 31, ob = rr * 64 + cc * 2; return st * 1024 + (ob ^ (((ob >> 9) & 1) << 5)); }
__host__ __device__ __forceinline__ void stage_rc(int b, int& R, int& C) { const int st = b / 1024, sb = b % 1024, swz = sb ^ (((sb >> 9) & 1) << 5); R = (st >> 1) * 16 + swz / 64; C = (st & 1) * 32 + (swz % 64) / 2; }
__host__ __device__ __forceinline__ int perm32(int rho) { const int n = rho >> 4, i = rho & 15; return 8 * (i >> 2) + 4 * n + (i & 3); }

struct Unit { int pm, pn; };
struct Gemm { const bf16_t* A; const bf16_t* Bt; int M, N, K; };

struct StaticOrder {
    int nM, nN, nwg, G, c;
    __host__ __device__ void init(int M, int N, int G_, int c_) { nM = M / BM; nN = N / BM; nwg = nM * nN; G = G_; c = c_; }
    __host__ __device__ bool next(int i, Unit& u) const {
        const long L = (long)i * G + c; if (L >= nwg) return false;
        int wgid = (int)L; { const int q = nwg / NXCD, r = nwg % NXCD, xcd = wgid % NXCD, off = wgid / NXCD; wgid = (xcd < r ? xcd * (q + 1) : r * (q + 1) + (xcd - r) * q) + off; }
        const int nig = WGM * nN, gid = wgid / nig, fm = gid * WGM, gsz = (nM - fm) < WGM ? (nM - fm) : WGM;
        u.pm = fm + ((wgid % nig) % gsz); u.pn = (wgid % nig) / gsz; return true;
    }
    __device__ __forceinline__ void a_ready(const Unit&) const {}
    __device__ __forceinline__ void done(const Unit&) const {}
};
__device__ __forceinline__ unsigned cvt_pk_bf16(float lo, float hi) { unsigned r; asm volatile("v_cvt_pk_bf16_f32 %0, %1, %2" : "=v"(r) : "v"(lo), "v"(hi)); return r; }
__device__ __forceinline__ float dpp_shr1(float v) { return __builtin_bit_cast(float, __builtin_amdgcn_update_dpp(0, __builtin_bit_cast(int, v), 0x111, 0xf, 0xf, true)); }
__device__ __forceinline__ float dpp_shr2(float v) { return __builtin_bit_cast(float, __builtin_amdgcn_update_dpp(0, __builtin_bit_cast(int, v), 0x112, 0xf, 0xf, true)); }
__device__ __forceinline__ float dpp_shl15(float v) { return __builtin_bit_cast(float, __builtin_amdgcn_update_dpp(0, __builtin_bit_cast(int, v), 0x10F, 0xf, 0xf, true)); }
__device__ __forceinline__ float dpp_shl14(float v) { return __builtin_bit_cast(float, __builtin_amdgcn_update_dpp(0, __builtin_bit_cast(int, v), 0x10E, 0xf, 0xf, true)); }
__device__ __forceinline__ float gelu_tanh(float x) {
    const float z = 0.7978845608028654f * (x + 0.044715f * x * x * x);
    const float e = __builtin_amdgcn_exp2f(-2.8853900817779268f * z);
    return x * __builtin_amdgcn_rcpf(1.0f + e);
}
constexpr int TOKP = 32768;

struct EpiIn {
    static constexpr bool PERM = true, AFTER_DRAIN = false;
    bf16_t* P; const float* cosT; const float* sinT; const float* rs0;
    __device__ __forceinline__ void operator()(const f32x4 (&acc)[2][2][4][2], const Unit& u, int wr, int wc, int fr, int fq) const {
        asm volatile("" : "+v"(fr), "+v"(fq));
        const int row0 = u.pm * BM + wr * 64 + fr, col0 = u.pn * BM + wc * 32 + 8 * fq;
        if (u.pn < 4) {
            const float sc = (u.pn >= 2) ? 0.08838834764831845f : 1.0f;
            const int f0 = 16 * wc + 4 * fq;
#pragma unroll
            for (int ai = 0; ai < 2; ++ai)
#pragma unroll
                for (int m = 0; m < 4; ++m) {
                    const int r = row0 + ai * HALF + m * 16;
                    const int pos = r < TOKP ? (r & 4095) : 4096 + ((r - TOKP) & 15);
                    const float rsr = sc;
                    const f32x4 c4 = *(const f32x4*)(cosT + pos * 64 + f0) * rsr, s4 = *(const f32x4*)(sinT + pos * 64 + f0) * rsr;
                    bf16_t* rowp = P + (size_t)r * 3584 + col0;
#pragma unroll
                    for (int bj = 0; bj < 2; ++bj) {
                        const f32x4 x1 = acc[ai][bj][m][0], x2 = acc[ai][bj][m][1];
                        const f32x4 o1 = x1 * c4 - x2 * s4, o2 = x2 * c4 + x1 * s4;
                        u32x4 w; w.x = cvt_pk_bf16(o1[0], o1[1]); w.y = cvt_pk_bf16(o1[2], o1[3]); w.z = cvt_pk_bf16(o2[0], o2[1]); w.w = cvt_pk_bf16(o2[2], o2[3]);
                        *(u32x4*)(rowp + bj * HALF) = w;
                    }
                }
        } else if (u.pn >= 10) {
#pragma unroll
            for (int ai = 0; ai < 2; ++ai)
#pragma unroll
                for (int m = 0; m < 4; ++m) {
                    const int r = row0 + ai * HALF + m * 16;
                    const f32x4 v0 = acc[ai][0][m][0] * acc[ai][1][m][0], v1 = acc[ai][0][m][1] * acc[ai][1][m][1];
                    u32x4 w; w.x = cvt_pk_bf16(v0[0], v0[1]); w.y = cvt_pk_bf16(v0[2], v0[3]); w.z = cvt_pk_bf16(v1[0], v1[1]); w.w = cvt_pk_bf16(v1[2], v1[3]);
                    *(u32x4*)(P + (size_t)r * 3584 + 2560 + 128 * (u.pn - 10) + wc * 32 + 8 * fq) = w;
                }
        } else {
#pragma unroll
            for (int ai = 0; ai < 2; ++ai)
#pragma unroll
                for (int m = 0; m < 4; ++m) {
                    bf16_t* rowp = P + (size_t)(row0 + ai * HALF + m * 16) * 3584 + col0;
#pragma unroll
                    for (int bj = 0; bj < 2; ++bj) {
                        const f32x4 v0 = acc[ai][bj][m][0], v1 = acc[ai][bj][m][1];
                        u32x4 w; w.x = cvt_pk_bf16(v0[0], v0[1]); w.y = cvt_pk_bf16(v0[2], v0[3]); w.z = cvt_pk_bf16(v1[0], v1[1]); w.w = cvt_pk_bf16(v1[2], v1[3]);
                        *(u32x4*)(rowp + bj * HALF) = w;
                    }
                }
        }
    }
};

struct EpiY {
    static constexpr bool PERM = true, AFTER_DRAIN = false;
    bf16_t* Y; float* ssq;
    __device__ __forceinline__ void operator()(const f32x4 (&acc)[2][2][4][2], const Unit& u, int wr, int wc, int fr, int fq) const {
        asm volatile("" : "+v"(fr), "+v"(fq));
        const int row0 = u.pm * BM + wr * 64 + fr, col0 = u.pn * BM + wc * 32 + 8 * fq;
#pragma unroll
        for (int ai = 0; ai < 2; ++ai)
#pragma unroll
            for (int m = 0; m < 4; ++m) {
                const int r = row0 + ai * HALF + m * 16;
                bf16_t* rowp = Y + (size_t)r * 1024 + col0;
                float s = 0.f;
#pragma unroll
                for (int bj = 0; bj < 2; ++bj) {
                    const f32x4 v0 = acc[ai][bj][m][0], v1 = acc[ai][bj][m][1];
                    s += (v0[0] * v0[0] + v0[1] * v0[1]) + (v0[2] * v0[2] + v0[3] * v0[3]) + (v1[0] * v1[0] + v1[1] * v1[1]) + (v1[2] * v1[2] + v1[3] * v1[3]);
                    u32x4 w; w.x = cvt_pk_bf16(v0[0], v0[1]); w.y = cvt_pk_bf16(v0[2], v0[3]); w.z = cvt_pk_bf16(v1[0], v1[1]); w.w = cvt_pk_bf16(v1[2], v1[3]);
                    *(u32x4*)(rowp + bj * HALF) = w;
                }
                s += __shfl_xor(s, 16); s += __shfl_xor(s, 32);
                if (fq == 0) ssq[(size_t)r * 16 + u.pn * 4 + wc] = s;
            }
    }
};

struct EpiFfn {
    static constexpr bool PERM = true, AFTER_DRAIN = false;
    bf16_t* ACT; const float* cw; const float* cache; float* outp; float* outs; PG8_LAS float* halo; const float* rs2;
    __device__ __forceinline__ void operator()(const f32x4 (&acc)[2][2][4][2], const Unit& u, int wr, int wc, int fr, int fq) const {
        asm volatile("" : "+v"(fr), "+v"(fq));
        const int lc0 = wc * 32 + 8 * fq, ch0 = u.pn * 128 + lc0;
        const bool sample = false;
        const int par = u.pm & 1;
        f32x4 w0[2], w1[2], w2[2];
#pragma unroll
        for (int n = 0; n < 2; ++n) { w0[n] = *(const f32x4*)(cw + ch0 + 4 * n); w1[n] = *(const f32x4*)(cw + 4096 + ch0 + 4 * n); w2[n] = *(const f32x4*)(cw + 8192 + ch0 + 4 * n); }
        if (!sample && fr >= 14) {
#pragma unroll
            for (int ai = 0; ai < 2; ++ai) { PG8_LAS float* hp = halo + ((par * 4 + 2 * ai + wr) * 2 + (fr - 14)) * 128 + lc0;
                *(PG8_LAS f32x4*)hp = acc[ai][0][3][0]; *(PG8_LAS f32x4*)(hp + 4) = acc[ai][0][3][1]; }
        }
        asm volatile("s_waitcnt lgkmcnt(0)" ::: "memory"); __builtin_amdgcn_s_barrier(); asm volatile("" ::: "memory");
#pragma unroll
        for (int ai = 0; ai < 2; ++ai) {
            const int blk = 2 * ai + wr;
#pragma unroll
            for (int m = 0; m < 4; ++m) {
                f32x4 pv[2]; pv[0] = (f32x4){0.f, 0.f, 0.f, 0.f}; pv[1] = pv[0];
                const int sb = 8 * ai + 4 * wr + m;
                if (sample) {
                    if (fr >= 14 && sb < 8) { const float* cp = cache + (size_t)(sb * 2 + fr - 14) * 4096 + ch0; pv[0] = *(const f32x4*)cp; pv[1] = *(const f32x4*)(cp + 4); }
                } else if (m == 0) {
                    if (fr >= 14) {
                        const bool zero = (blk == 0) && ((u.pm & 15) == 0);
                        const int hb = (blk == 0) ? ((par ^ 1) * 4 + 3) : (par * 4 + blk - 1);
                        if (!zero) { const PG8_LAS float* hp = halo + (hb * 2 + fr - 14) * 128 + lc0; pv[0] = *(const PG8_LAS f32x4*)hp; pv[1] = *(const PG8_LAS f32x4*)(hp + 4); }
                    }
                } else { pv[0] = acc[ai][0][m - 1][0]; pv[1] = acc[ai][0][m - 1][1]; }
                const int r = u.pm * BM + ai * HALF + wr * 64 + m * 16 + fr;
                f32x4 a4[2];
#pragma unroll
                for (int n = 0; n < 2; ++n) {
                    const f32x4 cur = acc[ai][0][m][n], gt = acc[ai][1][m][n];
                    f32x4 p1, p2;
#pragma unroll
                    for (int e = 0; e < 4; ++e) { p1[e] = dpp_shr1(cur[e]) + dpp_shl15(pv[n][e]); p2[e] = dpp_shr2(cur[e]) + dpp_shl14(pv[n][e]); }
                    const f32x4 uc = w0[n] * p2 + w1[n] * p1 + w2[n] * cur;
                    const f32x4 zz = (uc * uc * 0.044715f + 1.0f) * uc * (-2.8853900817779268f * 0.7978845608028654f);
                    f32x4 rr;
#pragma unroll
                    for (int e = 0; e < 4; ++e) rr[e] = __builtin_amdgcn_rcpf(1.0f + __builtin_amdgcn_exp2f(zz[e]));
                    a4[n] = uc * rr * gt;
                }
                u32x4 w; w.x = cvt_pk_bf16(a4[0][0], a4[0][1]); w.y = cvt_pk_bf16(a4[0][2], a4[0][3]); w.z = cvt_pk_bf16(a4[1][0], a4[1][1]); w.w = cvt_pk_bf16(a4[1][2], a4[1][3]);
                *(u32x4*)(ACT + (size_t)r * 4096 + ch0) = w;
                if (sample) {
                    if (fr >= 14 && sb < 8) { float* op = outs + (size_t)(sb * 2 + fr - 14) * 4096 + ch0; *(f32x4*)op = acc[ai][0][m][0]; *(f32x4*)(op + 4) = acc[ai][0][m][1]; }
                } else if (m == 3 && blk == 3 && (u.pm & 15) == 15 && fr >= 14) {
                    float* op = outp + (size_t)((u.pm >> 4) * 2 + fr - 14) * 4096 + ch0; *(f32x4*)op = acc[ai][0][m][0]; *(f32x4*)(op + 4) = acc[ai][0][m][1];
                }
            }
        }
    }
};
struct WalkOrder {
    int G, c;
    __device__ __forceinline__ bool next(int i, Unit& u) const {
        int w = c, rem = i;
        while (w < 256) { const int len = 16;
            if (rem < len) { if (w < 256) { u.pm = (w >> 5) * 16 + rem; u.pn = w & 31; } else { u.pm = 128; u.pn = w - 256; } return true; }
            rem -= len; w += G; }
        return false;
    }
    __device__ __forceinline__ void a_ready(const Unit&) const {}
    __device__ __forceinline__ void done(const Unit&) const {}
};
template <class Epi, class Sched, bool ALIGN_EPI = false, bool SP2 = false>
__device__ __forceinline__ void gemm_phase(PG8_LAS unsigned char* lds, const Gemm g, const Sched& S, const Epi& E) {
    int tid_raw = threadIdx.x; asm volatile("" : "+v"(tid_raw));
    const int tid = tid_raw, wid = __builtin_amdgcn_readfirstlane(tid >> 6), lane = tid & 63, wr = wid >> 2, wc = wid & 3, fr = lane & 15, fq = lane >> 4;
    const int K = g.K, nt = K / BK;
    unsigned voffA[2], voffB[2];
#pragma unroll
    for (int i = 0; i < 2; ++i) { int R, C; stage_rc(tid * 16 + i * 8192, R, C); const int Rb = Epi::PERM ? ((R & ~31) + perm32(R & 31)) : R;
        voffA[i] = (unsigned)(R * K + C) * 2u; voffB[i] = (unsigned)(Rb * K + C) * 2u; }
    const size_t kstep = (size_t)(BK * 2);
    const size_t hstep = (size_t)HALF * K * 2;
    const size_t tstep = 2 * hstep;
    const unsigned ldsw = (unsigned)wid * 1024u;
    const int aoff = lds_byte(wr * 64 + fr, fq * 8), boff = lds_byte(wc * 32 + fr, fq * 8);
#define PG8_SA(b, h) (((b) * 2 + (h)) * HTB)
#define PG8_SB(b, h) ((4 + (b) * 2 + (h)) * HTB)
#define PG8_STAGE(bufoff, gbase, voff) do { _Pragma("unroll") for (int _i = 0; _i < 2; ++_i) \
        __builtin_amdgcn_global_load_lds((const unsigned*)((const char*)(gbase) + (voff)[_i]), (PG8_LAS unsigned*)(lds + (bufoff) + ldsw + _i * 8192), 16, 0, 0); } while (0)
#define PG8_LDA(dst, b, h) do { _Pragma("unroll") for (int m = 0; m < 4; ++m) _Pragma("unroll") for (int k = 0; k < 2; ++k) dst[m][k] = *(const PG8_LAS bf16x8*)(lds + PG8_SA(b, h) + aoff + m * 2048 + k * 1024); } while (0)
#define PG8_LDB(dst, b, h) do { _Pragma("unroll") for (int n = 0; n < 2; ++n) _Pragma("unroll") for (int k = 0; k < 2; ++k) dst[n][k] = *(const PG8_LAS bf16x8*)(lds + PG8_SB(b, h) + boff + n * 2048 + k * 1024); } while (0)
#define PG8_MMA(ai, bj, At, Bt) do { __builtin_amdgcn_s_setprio(1); _Pragma("unroll") for (int m = 0; m < 4; ++m) _Pragma("unroll") for (int n = 0; n < 2; ++n) _Pragma("unroll") for (int k = 0; k < 2; ++k) \
        acc[ai][bj][m][n] = __builtin_amdgcn_mfma_f32_16x16x32_bf16(Bt[n][k], At[m][k], acc[ai][bj][m][n], 0, 0, 0); __builtin_amdgcn_s_setprio(0); } while (0)
#define PG8_WAIT_V(n) asm volatile("s_waitcnt vmcnt(" #n ")" ::: "memory")
#define PG8_WAIT_L(n) asm volatile("s_waitcnt lgkmcnt(" #n ")" ::: "memory")
#define PG8_BAR __builtin_amdgcn_s_barrier()
#define PG8_SCHED __builtin_amdgcn_sched_barrier(0)
    Unit cur, nxt; int ui = 0;
    if (!S.next(0, cur)) return;
    f32x4 acc[2][2][4][2];
#pragma unroll
    for (int a = 0; a < 2; ++a)
#pragma unroll
        for (int b = 0; b < 2; ++b)
#pragma unroll
            for (int m = 0; m < 4; ++m)
#pragma unroll
                for (int n = 0; n < 2; ++n) acc[a][b][m][n] = (f32x4){0.f, 0.f, 0.f, 0.f};
    bf16x8 At[4][2], B0[2][2], B1[2][2];
    const char* cA = (const char*)g.A + (size_t)cur.pm * tstep; const char* cB = (const char*)g.Bt + (size_t)cur.pn * tstep;
    S.a_ready(cur);
    if constexpr (SP2) {
        PG8_STAGE(PG8_SB(0, 0), cB, voffB); PG8_STAGE(PG8_SB(0, 1), cB + hstep, voffB); PG8_STAGE(PG8_SA(0, 0), cA, voffA); PG8_STAGE(PG8_SA(0, 1), cA + hstep, voffA);
        if (wr == 1) PG8_BAR;
        PG8_WAIT_V(2); PG8_BAR;
        PG8_STAGE(PG8_SB(1, 0), cB + kstep, voffB); PG8_STAGE(PG8_SA(1, 0), cA + kstep, voffA); PG8_STAGE(PG8_SB(1, 1), cB + hstep + kstep, voffB);
        PG8_WAIT_V(6); PG8_BAR;
    } else {
        PG8_STAGE(PG8_SB(0, 0), cB, voffB); PG8_STAGE(PG8_SA(0, 0), cA, voffA); PG8_STAGE(PG8_SB(0, 1), cB + hstep, voffB); PG8_STAGE(PG8_SA(0, 1), cA + hstep, voffA);
        if (wr == 1) PG8_BAR;
        PG8_WAIT_V(4); PG8_BAR;
        PG8_STAGE(PG8_SB(1, 0), cB + kstep, voffB); PG8_STAGE(PG8_SA(1, 0), cA + kstep, voffA); PG8_STAGE(PG8_SB(1, 1), cB + hstep + kstep, voffB);
        PG8_WAIT_V(6); PG8_BAR;
    }
    for (;;) {
        const bool has_next = S.next(ui + 1, nxt);
        const char* nA = has_next ? (const char*)g.A + (size_t)nxt.pm * tstep : cA; const char* nB = has_next ? (const char*)g.Bt + (size_t)nxt.pn * tstep : cB;
        for (int t = 0; t < nt; t += 2) {
            const bool last = (t == nt - 2);
            const char* a1 = cA + (size_t)(t + 1) * kstep;
            const char* a2 = last ? nA : cA + (size_t)(t + 2) * kstep; const char* b2 = last ? nB : cB + (size_t)(t + 2) * kstep;
            const char* a3 = a2 + kstep; const char* b3 = b2 + kstep;
            if (last && has_next) S.a_ready(nxt);
            if constexpr (SP2) {
            PG8_LDB(B0, 0, 0); PG8_LDB(B1, 0, 1); PG8_SCHED; PG8_LDA(At, 0, 0); PG8_STAGE(PG8_SA(1, 1), a1 + hstep, voffA);
            PG8_WAIT_V(8); PG8_WAIT_L(0); PG8_BAR; PG8_MMA(0, 0, At, B0); PG8_MMA(0, 1, At, B1); PG8_BAR; PG8_SCHED;
            PG8_LDA(At, 0, 1); PG8_STAGE(PG8_SB(0, 0), b2, voffB); PG8_STAGE(PG8_SB(0, 1), b2 + hstep, voffB); PG8_STAGE(PG8_SA(0, 0), a2, voffA);
            PG8_WAIT_V(8); PG8_WAIT_L(0); PG8_BAR; PG8_MMA(1, 0, At, B0); PG8_MMA(1, 1, At, B1); PG8_BAR; PG8_SCHED;
            PG8_LDB(B0, 1, 0); PG8_LDB(B1, 1, 1); PG8_SCHED; PG8_LDA(At, 1, 0); PG8_STAGE(PG8_SA(0, 1), a2 + hstep, voffA);
            PG8_WAIT_V(8); PG8_WAIT_L(0); PG8_BAR; PG8_MMA(0, 0, At, B0); PG8_MMA(0, 1, At, B1); PG8_BAR; PG8_SCHED;
            PG8_LDA(At, 1, 1); PG8_STAGE(PG8_SB(1, 0), b3, voffB); PG8_STAGE(PG8_SB(1, 1), b3 + hstep, voffB); PG8_STAGE(PG8_SA(1, 0), a3, voffA);
            PG8_WAIT_V(8); PG8_WAIT_L(0); PG8_BAR; PG8_MMA(1, 0, At, B0); PG8_MMA(1, 1, At, B1); PG8_BAR; PG8_SCHED;
            } else {
            PG8_LDB(B0, 0, 0); PG8_SCHED; PG8_LDA(At, 0, 0); PG8_STAGE(PG8_SA(1, 1), a1 + hstep, voffA);
            PG8_WAIT_L(8); PG8_BAR; PG8_WAIT_L(0); PG8_MMA(0, 0, At, B0); PG8_BAR; PG8_SCHED;
            PG8_LDB(B1, 0, 1); PG8_STAGE(PG8_SB(0, 0), b2, voffB);
            PG8_BAR; PG8_WAIT_L(0); PG8_MMA(0, 1, At, B1); PG8_BAR;
            PG8_LDA(At, 0, 1); PG8_STAGE(PG8_SA(0, 0), a2, voffA);
            PG8_BAR; PG8_WAIT_L(0); PG8_MMA(1, 0, At, B0); PG8_BAR; PG8_SCHED;
            PG8_STAGE(PG8_SB(0, 1), b2 + hstep, voffB);
            PG8_WAIT_V(6); PG8_BAR; PG8_MMA(1, 1, At, B1); PG8_BAR;
            PG8_LDB(B0, 1, 0); PG8_SCHED; PG8_LDA(At, 1, 0); PG8_STAGE(PG8_SA(0, 1), a2 + hstep, voffA);
            PG8_WAIT_L(8); PG8_BAR; PG8_WAIT_L(0); PG8_MMA(0, 0, At, B0); PG8_BAR; PG8_SCHED;
            PG8_LDB(B1, 1, 1); PG8_STAGE(PG8_SB(1, 0), b3, voffB);
            PG8_BAR; PG8_WAIT_L(0); PG8_MMA(0, 1, At, B1); PG8_BAR;
            PG8_LDA(At, 1, 1); PG8_STAGE(PG8_SA(1, 0), a3, voffA);
            PG8_BAR; PG8_WAIT_L(0); PG8_MMA(1, 0, At, B0); PG8_BAR; PG8_SCHED;
            PG8_STAGE(PG8_SB(1, 1), b3 + hstep, voffB);
            PG8_WAIT_V(6); PG8_BAR; PG8_MMA(1, 1, At, B1); PG8_BAR;
            }
        }
        if constexpr (ALIGN_EPI) { if (wr == 0) PG8_BAR; }
        if constexpr (!Epi::AFTER_DRAIN) { E(acc, cur, wr, wc, fr, fq); S.done(cur); }
        if (!has_next) break;
#pragma unroll
        for (int a = 0; a < 2; ++a)
#pragma unroll
            for (int b = 0; b < 2; ++b)
#pragma unroll
                for (int m = 0; m < 4; ++m)
#pragma unroll
                    for (int n = 0; n < 2; ++n) acc[a][b][m][n] = (f32x4){0.f, 0.f, 0.f, 0.f};
        cur = nxt; cA = nA; cB = nB; ++ui;
        if constexpr (ALIGN_EPI) { if (wr == 1) PG8_BAR; }
    }
    PG8_WAIT_V(0);
    if constexpr (!ALIGN_EPI) { if (wr == 0) PG8_BAR; }
    PG8_BAR;
    if constexpr (Epi::AFTER_DRAIN) { E.fused(acc, cur, wr, wc, fr, fq, lds, wid, lane); S.done(cur); }
#undef PG8_SA
#undef PG8_SB
#undef PG8_STAGE
#undef PG8_LDA
#undef PG8_LDB
#undef PG8_MMA
#undef PG8_WAIT_V
#undef PG8_WAIT_L
#undef PG8_BAR
#undef PG8_SCHED
}
}

using pg8::bf16_t; using pg8::bf16x8; using pg8::f32x4; using pg8::u32x4;
#define LAS __attribute__((address_space(3)))
typedef unsigned u32x2 __attribute__((ext_vector_type(2)));
constexpr int DM = 1024, NIN = 3584, DFF = 4096;
constexpr int TOK_P = 32768, TOK = 32896, TOKPAD = 33024;
constexpr float EPS = 1e-6f;
constexpr size_t WS_WIN = 16384;
constexpr size_t WS_WOUT = WS_WIN + (size_t)NIN * DM * 2;
constexpr size_t WS_WFF1 = WS_WOUT + (size_t)DM * DM * 2;
constexpr size_t WS_WDN = WS_WFF1 + (size_t)2 * DFF * DM * 2;
constexpr size_t WS_COS = WS_WDN + (size_t)DM * DFF * 2;
constexpr size_t WS_SIN = WS_COS + (size_t)4112 * 64 * 4;
constexpr size_t WS_SSQ1 = WS_SIN + (size_t)4112 * 64 * 4;
constexpr size_t WS_SSQ2 = WS_SSQ1 + (size_t)TOKPAD * 16 * 4;
constexpr size_t WS_UG = WS_SSQ2 + (size_t)TOKPAD * 16 * 4;
constexpr size_t WS_PS = WS_UG + (size_t)256 * 32768;
constexpr size_t WS_YS = WS_PS + (size_t)128 * NIN * 4;
constexpr size_t WS_FS = WS_YS + (size_t)4 * 128 * DM * 4;
constexpr size_t WS_RA = WS_FS + (size_t)4 * 128 * DM * 4;
constexpr size_t WS_RB = WS_RA + (size_t)TOKPAD * DM * 2;
constexpr size_t WS_Y = WS_RB + (size_t)TOKPAD * DFF * 2;
constexpr size_t WS_RS2 = WS_Y + (size_t)TOKPAD * DM * 2;
constexpr size_t WS_RS0 = WS_RS2 + (size_t)TOK_P * 4;
constexpr size_t WS_XB = WS_RS0 + (size_t)TOK_P * 4;
constexpr size_t WS_END = WS_XB + (size_t)TOK_P * DM * 2;
constexpr size_t O_SRP = (size_t)TOK * DM, O_CCP = O_SRP + 524288, O_CFP = O_CCP + 8192, O_SRS = O_CFP + 65536, O_CCS = O_SRS + 524288, O_CFS = O_CCS + 8192;
constexpr int LDS_HALO = 131072, LDS_BARW = 131072 + 8192, LDS_BYTES = LDS_BARW + 16;

struct Params { const float* in[17]; float* out; unsigned char* ws; };

__device__ __forceinline__ float dppf(float v, const int ctrl_sel) {
    const int iv = __builtin_bit_cast(int, v); int r;
    switch (ctrl_sel) { case 1: r = __builtin_amdgcn_update_dpp(0, iv, 0x111, 0xf, 0xf, true); break; case 2: r = __builtin_amdgcn_update_dpp(0, iv, 0x112, 0xf, 0xf, true); break;
        case 4: r = __builtin_amdgcn_update_dpp(0, iv, 0x114, 0xf, 0xf, true); break; case 8: r = __builtin_amdgcn_update_dpp(0, iv, 0x118, 0xf, 0xf, true); break;
        case 15: r = __builtin_amdgcn_update_dpp(0, iv, 0x142, 0xa, 0xf, false); break; default: r = __builtin_amdgcn_update_dpp(0, iv, 0x143, 0xc, 0xf, false); break; }
    return __builtin_bit_cast(float, r);
}
__device__ __forceinline__ float wave_sum(float v) {
    v += dppf(v, 1); v += dppf(v, 2); v += dppf(v, 4); v += dppf(v, 8); v += dppf(v, 15); v += dppf(v, 31);
    return __builtin_bit_cast(float, __builtin_amdgcn_readlane(__builtin_bit_cast(int, v), 63));
}
__device__ __forceinline__ float bf2f(unsigned short b) { return __uint_as_float(((unsigned)b) << 16); }
__device__ __forceinline__ unsigned pk2(float a, float b) { return pg8::cvt_pk_bf16(a, b); }
__device__ __forceinline__ unsigned pk2s(float a, float b) { unsigned r; asm("v_cvt_pk_bf16_f32 %0, %1, %2" : "=v"(r) : "v"(a), "v"(b)); return r; }
__device__ __forceinline__ float silu_f(float g) { return g * __builtin_amdgcn_rcpf(1.0f + __builtin_amdgcn_exp2f(-1.4426950408889634f * g)); }
__device__ __forceinline__ int dmap(int P) { return ((P >> 2) & 1) * 64 + (P >> 3) * 4 + (P & 3); }
__device__ __forceinline__ int pmap(int d) { return ((d >> 4) & 3) * 32 + ((d >> 2) & 3) * 8 + ((d >> 6) & 1) * 4 + (d & 3); }

constexpr int RB = 6;
__device__ __forceinline__ f32x4 unpack_bf4(const u32x2 w) { f32x4 v; v[0] = __uint_as_float(w.x << 16); v[1] = __uint_as_float(w.x & 0xffff0000u); v[2] = __uint_as_float(w.y << 16); v[3] = __uint_as_float(w.y & 0xffff0000u); return v; }
__device__ __forceinline__ float sumsq4(const f32x4 a) { return (a[0] * a[0] + a[1] * a[1]) + (a[2] * a[2] + a[3] * a[3]); }
template <int MODE> __device__ __forceinline__ int rowmap(int c) {
    if (MODE == 0) { if (c < 1024) return (c & ~127) + pmap(c & 127);
        if (c >= 2560) { const int cc = (c - 2560) & 511, hcsel = (c >= 3072) ? 128 : 0; return 2560 + ((cc >> 7) << 8) + hcsel + (cc & 127); }
        return c; }
    if (MODE == 1) return c;
    if (MODE == 2) return ((c >> 7) << 8) + (c & 127);
    return ((c >> 7) << 8) + 128 + (c & 127);
}
template <int MODE, bool GAIN = false>
__device__ __forceinline__ void transpose_item(const float* W, int K, int N, bf16_t* WT, LAS float* scr, int item, int lane, const float* gain = nullptr) {
    const int nblk = N / 32, kb = item / nblk, nb = item % nblk, k0 = 64 * kb, n0 = 32 * nb;
#pragma unroll
    for (int i = 0; i < 32; ++i) { const int kk = 2 * i + (lane >> 5); scr[kk * 33 + (lane & 31)] = W[(size_t)(k0 + kk) * N + n0 + (lane & 31)]; }
    asm volatile("s_waitcnt lgkmcnt(0)" ::: "memory");
    const int c = lane & 7;
    f32x4 ga = (f32x4){1.f, 1.f, 1.f, 1.f}, gb = ga;
    if (GAIN) { ga = *(const f32x4*)(gain + k0 + 8 * c); gb = *(const f32x4*)(gain + k0 + 8 * c + 4); }
#pragma unroll
    for (int j = 0; j < 4; ++j) { const int n = (lane >> 3) + 8 * j; const LAS float* s = scr + (8 * c) * 33 + n;
        u32x4 o; o.x = pk2(s[0 * 33] * ga[0], s[1 * 33] * ga[1]); o.y = pk2(s[2 * 33] * ga[2], s[3 * 33] * ga[3]); o.z = pk2(s[4 * 33] * gb[0], s[5 * 33] * gb[1]); o.w = pk2(s[6 * 33] * gb[2], s[7 * 33] * gb[3]);
        *(u32x4*)(WT + (size_t)rowmap<MODE>(n0 + n) * K + k0 + 8 * c) = o; }
    asm volatile("s_waitcnt lgkmcnt(0)" ::: "memory");
}
__device__ __forceinline__ void phase0(const Params& p, LAS unsigned char* lds, int tid, int wid, int lane) {
    LAS float* scr = (LAS float*)(lds + wid * 8448);
    const int gw = blockIdx.x * 8 + wid, NGW = gridDim.x * 8;
    bf16_t* win = (bf16_t*)(p.ws + WS_WIN); bf16_t* wout = (bf16_t*)(p.ws + WS_WOUT); bf16_t* wff1 = (bf16_t*)(p.ws + WS_WFF1); bf16_t* wdn = (bf16_t*)(p.ws + WS_WDN);
    constexpr int I_IN = 16 * 112, I_OUT = 16 * 32, I_UP = 16 * 128, I_DN = 64 * 32, NITEMS = I_IN + I_OUT + 2 * I_UP + I_DN;
    for (int it = gw; it < NITEMS; it += NGW) {
        int r = it;
        if (r < I_IN) { transpose_item<0, true>(p.in[5], DM, NIN, win, scr, r, lane, p.in[9]); continue; } r -= I_IN;
        if (r < I_OUT) { transpose_item<1>(p.in[6], DM, DM, wout, scr, r, lane); continue; } r -= I_OUT;
        if (r < I_UP) { transpose_item<2, true>(p.in[13], DM, DFF, wff1, scr, r, lane, p.in[11]); continue; } r -= I_UP;
        if (r < I_UP) { transpose_item<3, true>(p.in[14], DM, DFF, wff1, scr, r, lane, p.in[11]); continue; } r -= I_UP;
        transpose_item<1>(p.in[16], DFF, DM, wdn, scr, r, lane);
    }
    float* cosT = (float*)(p.ws + WS_COS); float* sinT = (float*)(p.ws + WS_SIN);
    for (int idx = blockIdx.x * 512 + tid; idx < 4112 * 64; idx += gridDim.x * 512) {
        const int pos = idx >> 6, f = idx & 63;
        const float inv = exp2f(-(float)(2 * f) * (1.0f / 128.0f) * 13.287712379549449f);
        const float ang = (float)pos * inv;
        const double rev = (double)ang * 0.15915494309189535;
        const float fr = (float)(rev - floor(rev));
        cosT[idx] = __builtin_amdgcn_cosf(fr); sinT[idx] = __builtin_amdgcn_sinf(fr);
    }
    bf16_t* H = (bf16_t*)(p.ws + WS_RA); bf16_t* XB = (bf16_t*)(p.ws + WS_XB); float* RS0 = (float*)(p.ws + WS_RS0);
#pragma unroll 1
    for (int base = gw; base < TOK; base += RB * NGW) {
        f32x4 v[RB][4]; float s[RB];
#pragma unroll
        for (int k = 0; k < RB; ++k) { const int rr = min(base + k * NGW, TOK - 1);
            const float* xrow = rr < TOK_P ? p.in[0] + (size_t)rr * DM : p.in[1] + (size_t)(rr - TOK_P) * DM; s[k] = 0.f;
#pragma unroll
            for (int j = 0; j < 4; ++j) { v[k][j] = __builtin_nontemporal_load((const f32x4*)xrow + lane + 64 * j); s[k] += sumsq4(v[k][j]); } }
#pragma unroll
        for (int k = 0; k < RB; ++k) { const int r = base + k * NGW; const float rstd = rsqrtf(wave_sum(s[k]) * (1.0f / DM) + EPS);
            if (r < TOK_P) {
                if (lane == 0) RS0[r] = __builtin_amdgcn_rcpf(rstd);
#pragma unroll
                for (int j = 0; j < 4; ++j) { const f32x4 y = v[k][j] * rstd; *((u32x2*)(XB + (size_t)r * DM) + lane + 64 * j) = (u32x2){pk2(y[0], y[1]), pk2(y[2], y[3])}; }
            } else if (r < TOK) {
#pragma unroll
                for (int j = 0; j < 4; ++j) { const f32x4 y = v[k][j] * rstd; *((u32x2*)(H + (size_t)r * DM) + lane + 64 * j) = (u32x2){pk2(y[0], y[1]), pk2(y[2], y[3])}; } } }
    }
}

constexpr int QI_OFF = 0, KI_OFF = 17408, KT_OFF = 34816, VT_OFF = 53248, SI_OFF = 71680, ST_OFF = 80896, GI_OFF = 115712;
#define MFMA16(a, b, c) __builtin_amdgcn_mfma_f32_16x16x32_bf16((a), (b), (c), 0, 0, 0)
#define RET_ISSUE(S, nn) do { _Pragma("unroll") for (int i_ = 0; i_ < 2; ++i_) { \
        const bf16_t* rowp_ = P + (tok0 + (size_t)(nn) * 64 + 2 * (tid >> 4) + i_) * NIN + 128 * h + (tid & 15) * 8; \
        if (FULL) { rq[S][i_] = *(const u32x4*)rowp_; rg[S][i_] = *(const u32x4*)(rowp_ + 1536); } rk[S][i_] = *(const u32x4*)(rowp_ + 512); rv[S][i_] = *(const u32x4*)(rowp_ + 1024); } } while (0)
#define RET_STAGE_A(S) do { const int j_ = 2 * (tid >> 4), ch_ = tid & 15; \
        if (FULL) { _Pragma("unroll") for (int i_ = 0; i_ < 2; ++i_) { *(LAS u32x4*)(lds + QI_OFF + (j_ + i_) * 272 + ch_ * 16) = rq[S][i_]; *(LAS u32x4*)(lds + KI_OFF + (j_ + i_) * 272 + ch_ * 16) = rk[S][i_]; *(LAS u32x4*)(lds + GI_OFF + (j_ + i_) * 272 + ch_ * 16) = rg[S][i_]; } } \
        const float te0_ = __builtin_amdgcn_exp2f(l2g * (float)(63 - j_)), te1_ = __builtin_amdgcn_exp2f(l2g * (float)(62 - j_)); \
        const unsigned ka_[4] = {rk[S][0].x, rk[S][0].y, rk[S][0].z, rk[S][0].w}, kb_[4] = {rk[S][1].x, rk[S][1].y, rk[S][1].z, rk[S][1].w}; \
        const unsigned va_[4] = {rv[S][0].x, rv[S][0].y, rv[S][0].z, rv[S][0].w}, vb_[4] = {rv[S][1].x, rv[S][1].y, rv[S][1].z, rv[S][1].w}; \
        const int cofs_ = 16 * ((j_ >> 3) ^ (ch_ & 7)) + 2 * (j_ & 7); \
        _Pragma("unroll") for (int e2 = 0; e2 < 4; ++e2) { const int row_ = 8 * ch_ + 2 * e2; \
            *(LAS unsigned*)(lds + KT_OFF + row_ * 144 + cofs_) = pk2(__uint_as_float(ka_[e2] << 16) * te0_, __uint_as_float(kb_[e2] << 16) * te1_); \
            *(LAS unsigned*)(lds + KT_OFF + (row_ + 1) * 144 + cofs_) = pk2(__uint_as_float(ka_[e2] & 0xffff0000u) * te0_, __uint_as_float(kb_[e2] & 0xffff0000u) * te1_); \
            *(LAS unsigned*)(lds + VT_OFF + row_ * 144 + cofs_) = (va_[e2] & 0xffffu) | (vb_[e2] << 16); \
            *(LAS unsigned*)(lds + VT_OFF + (row_ + 1) * 144 + cofs_) = (va_[e2] >> 16) | (vb_[e2] & 0xffff0000u); } } while (0)
#define WG_BAR() do { asm volatile("s_waitcnt lgkmcnt(0)" ::: "memory"); __builtin_amdgcn_s_barrier(); asm volatile("" ::: "memory"); } while (0)
template <bool FULL>
__device__ __forceinline__ void ret_unit(const Params& p, LAS unsigned char* lds, int unit, int tid, int wid, int lane) {
    asm volatile("" : "+v"(tid), "+v"(lane));
    const int G = unit & 7, h = (unit >> 3) & 3, b = unit >> 5;
    const bf16_t* P = (const bf16_t*)(p.ws + WS_RB);
    bf16_t* MIX = (bf16_t*)(p.ws + WS_RA);
    float* UG = (float*)(p.ws + WS_UG);
    const size_t tok0 = (size_t)b * 4096 + (size_t)G * 512;
    const float l2g = log2f(1.0f - exp2f(-5.0f - (float)h));
    const float g64 = __builtin_amdgcn_exp2f(l2g * 64.0f);
    const bool is_state = wid >= 4; const int w4 = wid & 3;
    const int l15 = lane & 15, l4 = lane >> 4;
    const int vtL = l4 ^ (l15 >> 3);
    const int vtb0 = VT_OFF + l15 * 144 + 16 * vtL, vtb1 = VT_OFF + l15 * 144 + 16 * (vtL ^ 2);
#define VT_ADDR(nt, ks) ((((nt) & 1) ? vtb1 : vtb0) + (nt) * 2304 + 16 * (((4 * (ks)) ^ (2 * ((nt) & 3))) & 4))
    constexpr int PD = FULL ? 1 : 4;
    u32x4 rq[PD][2], rk[PD][2], rv[PD][2], rg[PD][2];
    if (is_state) {
        f32x4 st[2][8];
#pragma unroll
        for (int mt = 0; mt < 2; ++mt)
#pragma unroll
            for (int nt = 0; nt < 8; ++nt) st[mt][nt] = (f32x4){0.f, 0.f, 0.f, 0.f};
        if (FULL) {
#pragma unroll 1
            for (int Gp = 0; Gp < G; Gp += 2) {
                const float wa = __builtin_amdgcn_exp2f(l2g * 512.0f * (float)(G - 1 - Gp));
                const bool two = Gp + 1 < G;
                const float wb = two ? __builtin_amdgcn_exp2f(l2g * 512.0f * (float)(G - 2 - Gp)) : 0.f;
                const u32x2* sa = (const u32x2*)UG + ((size_t)((b * 4 + h) * 8 + Gp) * 4 + w4) * 1024 + lane;
                const u32x2* sb = two ? sa + 4 * 1024 : sa;
#pragma unroll
                for (int mt = 0; mt < 2; ++mt)
#pragma unroll
                    for (int nt = 0; nt < 8; ++nt) st[mt][nt] += unpack_bf4(sa[(mt * 8 + nt) * 64]) * wa + unpack_bf4(sb[(mt * 8 + nt) * 64]) * wb;
            }
        }
#pragma unroll
        for (int s = 0; s < PD; ++s) RET_ISSUE(s, s);
#pragma unroll 1
        for (int n0 = 0; n0 < 8; n0 += PD) {
#pragma unroll
          for (int s = 0; s < PD; ++s) { const int n = n0 + s;
            RET_STAGE_A(s);
            if (n + PD < 8) RET_ISSUE(s, n + PD);
            if (FULL) {
#pragma unroll
                for (int mt = 0; mt < 2; ++mt)
#pragma unroll
                    for (int nt = 0; nt < 8; ++nt) { const int e = 16 * nt + l15, dk0 = 32 * w4 + 16 * mt + 4 * l4;
                        *(LAS u32x2*)(lds + ST_OFF + e * 272 + dk0 * 2) = (u32x2){pk2(st[mt][nt][0], st[mt][nt][1]), pk2(st[mt][nt][2], st[mt][nt][3])}; }
            }
            WG_BAR();
            if (FULL) {
                bf16x8 ak[4];
#pragma unroll
                for (int ks = 0; ks < 4; ++ks) ak[ks] = *(const LAS bf16x8*)(lds + KI_OFF + (16 * w4 + l15) * 272 + (32 * ks + 8 * l4) * 2);
#pragma unroll
                for (int it = 0; it < 4; ++it) {
                    bf16x8 bq[4];
#pragma unroll
                    for (int ks = 0; ks < 4; ++ks) bq[ks] = *(const LAS bf16x8*)(lds + QI_OFF + (16 * it + l15) * 272 + (32 * ks + 8 * l4) * 2);
                    f32x4 sa = (f32x4){0.f, 0.f, 0.f, 0.f};
#pragma unroll
                    for (int ks = 0; ks < 4; ++ks) sa = MFMA16(ak[ks], bq[ks], sa);
                    const int i = 16 * it + l15, j0 = 16 * w4 + 4 * l4;
#pragma unroll
                    for (int r = 0; r < 4; ++r) { const int d = i - (j0 + r); sa[r] *= __builtin_amdgcn_exp2f(l2g * (float)(d < 0 ? -d : d)); }
                    *(LAS u32x2*)(lds + SI_OFF + i * 144 + j0 * 2) = (u32x2){pk2(sa[0], sa[1]), pk2(sa[2], sa[3])};
                }
            }
            WG_BAR();
#pragma unroll
            for (int mt = 0; mt < 2; ++mt)
#pragma unroll
                for (int nt = 0; nt < 8; ++nt) st[mt][nt] = st[mt][nt] * g64;
#pragma unroll
            for (int ks = 0; ks < 2; ++ks) {
                bf16x8 akt[2];
#pragma unroll
                for (int mt = 0; mt < 2; ++mt) { const int row = 32 * w4 + 16 * mt + l15; akt[mt] = *(const LAS bf16x8*)(lds + KT_OFF + row * 144 + 16 * ((4 * ks + l4) ^ ((row >> 3) & 7))); }
#pragma unroll
                for (int nh = 0; nh < 2; ++nh) {
                    bf16x8 bv[4];
#pragma unroll
                    for (int nt = 0; nt < 4; ++nt) bv[nt] = *(const LAS bf16x8*)(lds + VT_ADDR(4 * nh + nt, ks));
#pragma unroll
                    for (int nt = 0; nt < 4; ++nt)
#pragma unroll
                        for (int mt = 0; mt < 2; ++mt) st[mt][4 * nh + nt] = MFMA16(akt[mt], bv[nt], st[mt][4 * nh + nt]);
                }
            }
            WG_BAR();
          }
        }
        if (!FULL) {
            u32x2* dst = (u32x2*)UG + ((size_t)unit * 4 + w4) * 1024 + lane;
#pragma unroll
            for (int mt = 0; mt < 2; ++mt)
#pragma unroll
                for (int nt = 0; nt < 8; ++nt) dst[(mt * 8 + nt) * 64] = (u32x2){pk2(st[mt][nt][0], st[mt][nt][1]), pk2(st[mt][nt][2], st[mt][nt][3])};
        } else if (G == 7) {
            float* o = p.out + O_SRP + (size_t)(b * 4 + h) * 16384 + (64 * (l4 & 1) + 16 * w4 + 4 * (l4 >> 1)) * 128 + l15;
#pragma unroll
            for (int mt = 0; mt < 2; ++mt)
#pragma unroll
                for (int nt = 0; nt < 8; ++nt)
#pragma unroll
                    for (int r = 0; r < 4; ++r) o[(8 * mt + r) * 128 + 16 * nt] = st[mt][nt][r];
        }
    } else {
        float rwv[8];
#pragma unroll
        for (int nt = 0; nt < 8; ++nt) rwv[nt] = p.in[8][128 * h + 16 * nt + l15];
#pragma unroll
        for (int s = 0; s < PD; ++s) RET_ISSUE(s, s);
#pragma unroll 1
        for (int n0 = 0; n0 < 8; n0 += PD) {
#pragma unroll
          for (int s = 0; s < PD; ++s) { const int n = n0 + s;
            RET_STAGE_A(s);
            if (n + PD < 8) RET_ISSUE(s, n + PD);
            WG_BAR();
            f32x4 acc[8];
            if (FULL) {
                f32x4 fsv;
#pragma unroll
                for (int r = 0; r < 4; ++r) fsv[r] = __builtin_amdgcn_exp2f(l2g * (float)(16 * w4 + 4 * l4 + r + 1));
#pragma unroll
                for (int nt = 0; nt < 8; ++nt) acc[nt] = (f32x4){0.f, 0.f, 0.f, 0.f};
                bf16x8 aq[4];
#pragma unroll
                for (int ks = 0; ks < 4; ++ks) aq[ks] = *(const LAS bf16x8*)(lds + QI_OFF + (16 * w4 + l15) * 272 + (32 * ks + 8 * l4) * 2);
#pragma unroll
                for (int ks = 0; ks < 4; ++ks)
#pragma unroll
                    for (int nh = 0; nh < 2; ++nh) {
                        bf16x8 bs[4];
#pragma unroll
                        for (int nt = 0; nt < 4; ++nt) bs[nt] = *(const LAS bf16x8*)(lds + ST_OFF + (16 * (4 * nh + nt) + l15) * 272 + (32 * ks + 8 * l4) * 2);
#pragma unroll
                        for (int nt = 0; nt < 4; ++nt) acc[4 * nh + nt] = MFMA16(aq[ks], bs[nt], acc[4 * nh + nt]);
                    }
#pragma unroll
                for (int nt = 0; nt < 8; ++nt) acc[nt] = acc[nt] * fsv;
            }
            WG_BAR();
            if (FULL) {
                bf16x8 as_[2];
#pragma unroll
                for (int ks = 0; ks < 2; ++ks) as_[ks] = *(const LAS bf16x8*)(lds + SI_OFF + (16 * w4 + l15) * 144 + 16 * (4 * ks + l4));
#pragma unroll
                for (int ks = 0; ks < 2; ++ks)
#pragma unroll
                    for (int nh = 0; nh < 2; ++nh) {
                        bf16x8 bv[4];
#pragma unroll
                        for (int nt = 0; nt < 4; ++nt) bv[nt] = *(const LAS bf16x8*)(lds + VT_ADDR(4 * nh + nt, ks));
#pragma unroll
                        for (int nt = 0; nt < 4; ++nt) acc[4 * nh + nt] = MFMA16(as_[ks], bv[nt], acc[4 * nh + nt]);
                    }
                unsigned short gq[4][8];
#pragma unroll
                for (int r = 0; r < 4; ++r)
#pragma unroll
                    for (int nt = 0; nt < 8; ++nt) gq[r][nt] = *(const LAS unsigned short*)(lds + GI_OFF + (16 * w4 + 4 * l4 + r) * 272 + (16 * nt + l15) * 2);
                float rstd[4];
#pragma unroll
                for (int r = 0; r < 4; ++r) { float ss = 0.f;
#pragma unroll
                    for (int nt = 0; nt < 8; ++nt) ss += acc[nt][r] * acc[nt][r];
                    ss += dppf(ss, 1); ss += dppf(ss, 2); ss += dppf(ss, 4); ss += dppf(ss, 8);
                    ss = __shfl(ss, (lane & 48) | 15);
                    rstd[r] = rsqrtf(ss * (1.0f / 128.0f) + EPS); }
#pragma unroll
                for (int r = 0; r < 4; ++r)
#pragma unroll
                    for (int nt = 0; nt < 8; ++nt)
                        *(LAS unsigned short*)(lds + QI_OFF + (16 * w4 + 4 * l4 + r) * 272 + (16 * nt + l15) * 2) = (unsigned short)(pk2s(acc[nt][r] * rstd[r] * rwv[nt] * silu_f(bf2f(gq[r][nt])), 0.f) & 0xffffu);
#pragma unroll
                for (int q = 0; q < 4; ++q) { const int cidx = lane + 64 * q, row = 16 * w4 + (cidx >> 4), ch = cidx & 15;
                    const u32x4 v = *(const LAS u32x4*)(lds + QI_OFF + row * 272 + ch * 16);
                    *(u32x4*)(MIX + (tok0 + (size_t)n * 64 + row) * DM + 128 * h + ch * 8) = v; }
            }
            WG_BAR();
          }
        }
    }
#ifndef CONVREP
#define CONVREP 1
#endif
    if (FULL) for (int crep_ = 0; crep_ < CONVREP; ++crep_) {
        const int c0 = 128 * h + 8 * (tid & 15), run = tid >> 4, t0 = G * 512 + run * 16;
        const float* cwp = p.in[7];
        float w0[8], w1[8], w2[8], p1[8], p2[8];
#pragma unroll
        for (int e = 0; e < 8; ++e) { w0[e] = cwp[c0 + e]; w1[e] = cwp[512 + c0 + e]; w2[e] = cwp[1024 + c0 + e]; p1[e] = 0.f; p2[e] = 0.f; }
        if (t0 > 0) {
            const bf16_t* r2 = P + ((size_t)b * 4096 + t0 - 2) * NIN; const bf16_t* r1 = r2 + NIN;
            const u32x4 c2 = *(const u32x4*)(r2 + 2560 + c0), c1 = *(const u32x4*)(r1 + 2560 + c0);
            const unsigned c2w[4] = {c2.x, c2.y, c2.z, c2.w}, c1w[4] = {c1.x, c1.y, c1.z, c1.w};
#pragma unroll
            for (int e = 0; e < 4; ++e) {
                p2[2 * e] = __uint_as_float(c2w[e] << 16); p2[2 * e + 1] = __uint_as_float(c2w[e] & 0xffff0000u);
                p1[2 * e] = __uint_as_float(c1w[e] << 16); p1[2 * e + 1] = __uint_as_float(c1w[e] & 0xffff0000u); }
        }
#pragma unroll 8
        for (int t = 0; t < 16; ++t) {
            const size_t row = (size_t)b * 4096 + t0 + t;
            const bf16_t* rp = P + row * NIN;
            const u32x4 bb = *(const u32x4*)(rp + 2048 + c0), cc = *(const u32x4*)(rp + 2560 + c0);
            const unsigned bw[4] = {bb.x, bb.y, bb.z, bb.w}, cw4[4] = {cc.x, cc.y, cc.z, cc.w};
            float y[8];
#pragma unroll
            for (int e = 0; e < 4; ++e) {
                const float ca = __uint_as_float(cw4[e] << 16), cb = __uint_as_float(cw4[e] & 0xffff0000u);
                y[2 * e] = __uint_as_float(bw[e] << 16) * (w0[2 * e] * p2[2 * e] + w1[2 * e] * p1[2 * e] + w2[2 * e] * ca);
                y[2 * e + 1] = __uint_as_float(bw[e] & 0xffff0000u) * (w0[2 * e + 1] * p2[2 * e + 1] + w1[2 * e + 1] * p1[2 * e + 1] + w2[2 * e + 1] * cb);
                p2[2 * e] = p1[2 * e]; p2[2 * e + 1] = p1[2 * e + 1]; p1[2 * e] = ca; p1[2 * e + 1] = cb;
            }
            *(u32x4*)(MIX + row * DM + 512 + c0) = (u32x4){pk2(y[0], y[1]), pk2(y[2], y[3]), pk2(y[4], y[5]), pk2(y[6], y[7])};
        }
        if (G == 7 && run == 31) {
            float* o = p.out + O_CCP + (size_t)b * 1024 + c0;
#pragma unroll
            for (int e = 0; e < 8; ++e) { o[e] = p2[e]; o[512 + e] = p1[e]; }
        }
    }
#undef VT_ADDR
}

__device__ __forceinline__ float ch_at(const float* PS, const float* cache, int b, int t, int ch) {
    if (t < 0) return cache[(b * 2 + (t + 2)) * 512 + ch];
    const float* rp = PS + (size_t)(16 * b + t) * NIN;
    const int cc = 2560 + ((ch >> 7) << 8) + (ch & 127);
    return rp[cc] * rp[cc + 128];
}
__device__ __forceinline__ void sample_unit(const Params& p, LAS unsigned char* lds, int sup, int tid, int wid, int lane) {
    const int su = sup >> 2, part = sup & 3;
    const int b = su >> 2, h = su & 3, ts0 = TOK_P + 16 * b;
    const float* PS = (const float*)(p.ws + WS_PS);
    bf16_t* MIX = (bf16_t*)(p.ws + WS_RA);
    LAS float* qs = (LAS float*)lds; LAS float* ks = qs + 2048; LAS float* vs = qs + 4096; LAS float* Ssm = qs + 6144; LAS float* osm = qs + 6400;
    const float l2g = log2f(1.0f - exp2f(-5.0f - (float)h));
    const float* cosT = (const float*)(p.ws + WS_COS); const float* sinT = (const float*)(p.ws + WS_SIN);
    for (int idx = tid; idx < 2048; idx += 512) { const int i = idx >> 7, c = idx & 127, d = dmap(c);
        const float* rp = PS + (size_t)(16 * b + i) * NIN + 128 * h;
        const float cs = cosT[(4096 + i) * 64 + (d & 63)], sn = sinT[(4096 + i) * 64 + (d & 63)];
        const float xq = rp[c], xqp = rp[c ^ 4], xk = rp[512 + c], xkp = rp[512 + (c ^ 4)];
        qs[i * 128 + d] = d < 64 ? xq * cs - xqp * sn : xq * cs + xqp * sn;
        ks[i * 128 + d] = (d < 64 ? xk * cs - xkp * sn : xk * cs + xkp * sn) * 0.08838834764831845f;
        vs[i * 128 + c] = rp[1024 + c]; }
    const int e = tid & 127, sub = tid >> 7, irow = 4 * part + sub;
    LAS float* s0 = qs + 8704;
    { const float* s0g = p.in[2] + (size_t)su * 16384; f32x4 t8[8];
#pragma unroll
      for (int q = 0; q < 8; ++q) t8[q] = *((const f32x4*)s0g + tid + 512 * q);
#pragma unroll
      for (int q = 0; q < 8; ++q) *((LAS f32x4*)s0 + tid + 512 * q) = t8[q]; }
    __syncthreads();
    if (tid < 64) { const int i = 4 * part + (tid >> 4), j = tid & 15; float s = 0.f;
        for (int d = 0; d < 128; ++d) s += qs[i * 128 + d] * ks[j * 128 + d];
        const int dd = i - j; Ssm[i * 16 + j] = s * __builtin_amdgcn_exp2f(l2g * (float)(dd < 0 ? -dd : dd)); }
    float cr = 0.f;
#pragma unroll 8
    for (int d = 0; d < 128; ++d) cr += qs[irow * 128 + d] * s0[d * 128 + e];
    __syncthreads();
    { float o = 0.f;
      for (int j = 0; j < 16; ++j) o += Ssm[irow * 16 + j] * vs[j * 128 + e];
      osm[irow * 128 + e] = o + __builtin_amdgcn_exp2f(l2g * (float)(irow + 1)) * cr; }
    __syncthreads();
    if (wid < 4) { const int i = 4 * part + wid; const float v0 = osm[i * 128 + lane], v1 = osm[i * 128 + 64 + lane];
        const float rstd = rsqrtf(wave_sum(v0 * v0 + v1 * v1) * (1.0f / 128.0f) + EPS);
        const size_t token = (size_t)(ts0 + i);
        const float g0 = PS[(size_t)(16 * b + i) * NIN + 1536 + 128 * h + lane], g1 = PS[(size_t)(16 * b + i) * NIN + 1536 + 128 * h + 64 + lane];
        MIX[token * DM + 128 * h + lane] = (bf16_t)(pk2(v0 * rstd * p.in[8][128 * h + lane] * silu_f(g0), 0.f) & 0xffffu);
        MIX[token * DM + 128 * h + 64 + lane] = (bf16_t)(pk2(v1 * rstd * p.in[8][128 * h + 64 + lane] * silu_f(g1), 0.f) & 0xffffu); }
    const float g16 = __builtin_amdgcn_exp2f(l2g * 16.0f);
    float* outS = p.out + O_SRS + (size_t)su * 16384;
#pragma unroll 2
    for (int dd = 0; dd < 8; ++dd) { const int d = 32 * part + sub + 4 * dd; float a = g16 * s0[d * 128 + e];
        for (int j = 0; j < 16; ++j) a += __builtin_amdgcn_exp2f(l2g * (float)(15 - j)) * ks[j * 128 + d] * vs[j * 128 + e];
        outS[d * 128 + e] = a; }
    { const int ch = 128 * h + e; const float* cache = p.in[3]; const float* cwp = p.in[7];
      const float w0 = cwp[ch], w1 = cwp[512 + ch], w2 = cwp[1024 + ch];
      const int t = irow;
      const float c0 = ch_at(PS, cache, b, t - 2, ch), c1 = ch_at(PS, cache, b, t - 1, ch), c2 = ch_at(PS, cache, b, t, ch);
      const float y = PS[(size_t)(16 * b + t) * NIN + 2048 + ch] * (w0 * c0 + w1 * c1 + w2 * c2);
      MIX[(size_t)(ts0 + t) * DM + 512 + ch] = (bf16_t)(pk2(y, 0.f) & 0xffffu);
      if (t >= 14) p.out[O_CCS + (size_t)(b * 2 + t - 14) * 512 + ch] = c2; }
    __syncthreads();
}

constexpr int TG_B = 34816, TG_BUF = 34816 + 32 * 272;
template <int NB>
__device__ __forceinline__ void thin_gemm2(LAS unsigned char* lds, const bf16_t* A, int lda, const bf16_t* Bt, int ldb, int n0, int nbstride, int kbeg, int klen, f32x4 (&acc)[NB], int tid, int wid, int lane) {
    const int l15 = lane & 15, l4 = lane >> 4, nkb = klen >> 7;
    const bool hasb = tid < NB * 256;
    const bf16_t* ag = A + (size_t)(tid >> 4) * lda + kbeg + (tid & 15) * 8;
    const bf16_t* bg = Bt + (size_t)(n0 + (tid >> 8) * nbstride + ((tid >> 4) & 15)) * ldb + kbeg + (tid & 15) * 8;
    const int sto = (tid >> 4) * 272 + (tid & 15) * 16;
    const int fro = l15 * 272 + (8 * l4) * 2;
    u32x4 Xa[4], Ya[4], Xb = (u32x4){0u, 0u, 0u, 0u}, Yb = Xb;
#define TG_LOAD(R, kb) do { _Pragma("unroll") for (int i_ = 0; i_ < 4; ++i_) R##a[i_] = *(const u32x4*)(ag + (size_t)(32 * i_) * lda + (kb) * 128); if (hasb) R##b = *(const u32x4*)(bg + (kb) * 128); } while (0)
#define TG_STORE(R, buf) do { _Pragma("unroll") for (int i_ = 0; i_ < 4; ++i_) *(LAS u32x4*)(lds + (buf) * TG_BUF + sto + i_ * 32 * 272) = R##a[i_]; if (hasb) *(LAS u32x4*)(lds + (buf) * TG_BUF + TG_B + sto) = R##b; } while (0)
#define TG_COMP(buf) do { _Pragma("unroll") for (int ks = 0; ks < 4; ++ks) { const bf16x8 a_ = *(const LAS bf16x8*)(lds + (buf) * TG_BUF + 16 * wid * 272 + fro + ks * 64); \
        _Pragma("unroll") for (int nb = 0; nb < NB; ++nb) { const bf16x8 b_ = *(const LAS bf16x8*)(lds + (buf) * TG_BUF + TG_B + 16 * nb * 272 + fro + ks * 64); acc[nb] = MFMA16(a_, b_, acc[nb]); } } } while (0)
#pragma unroll
    for (int nb = 0; nb < NB; ++nb) acc[nb] = (f32x4){0.f, 0.f, 0.f, 0.f};
    TG_LOAD(X, 0); TG_LOAD(Y, 1);
    TG_STORE(X, 0); WG_BAR();
#pragma unroll 1
    for (int kb = 0; kb < nkb; kb += 2) {
        if (kb + 2 < nkb) TG_LOAD(X, kb + 2);
        TG_COMP(0);
        TG_STORE(Y, 1); WG_BAR();
        if (kb + 3 < nkb) TG_LOAD(Y, kb + 3);
        TG_COMP(1);
        if (kb + 2 < nkb) TG_STORE(X, 0);
        WG_BAR();
    }
#undef TG_LOAD
#undef TG_STORE
#undef TG_COMP
}
template <int NB>
__device__ __forceinline__ void thin_gemm(const bf16_t* A, int lda, const bf16_t* Bt, int ldb, int n0, int nbstride, int kbeg, int klen, f32x4 (&acc)[NB], int wid, int lane) {
    const int l15 = lane & 15, l4 = lane >> 4;
    const bf16_t* ap = A + (size_t)(16 * wid + l15) * lda + kbeg + 8 * l4;
    const bf16_t* bp = Bt + (size_t)(n0 + l15) * ldb + kbeg + 8 * l4;
#pragma unroll
    for (int nb = 0; nb < NB; ++nb) acc[nb] = (f32x4){0.f, 0.f, 0.f, 0.f};
#pragma unroll 1
    for (int s0 = 0; s0 < klen; s0 += 256) {
        bf16x8 a[8], b[NB][8];
#pragma unroll
        for (int s = 0; s < 8; ++s) { a[s] = *(const bf16x8*)(ap + s0 + 32 * s);
#pragma unroll
            for (int nb = 0; nb < NB; ++nb) b[nb][s] = *(const bf16x8*)(bp + (size_t)nb * nbstride * ldb + s0 + 32 * s); }
#pragma unroll
        for (int s = 0; s < 8; ++s)
#pragma unroll
            for (int nb = 0; nb < NB; ++nb) acc[nb] = MFMA16(a[s], b[nb][s], acc[nb]);
    }
}
__device__ __forceinline__ void thin_store(const f32x4& acc, float* out, int ldo, int col, int wid, int lane) {
#pragma unroll
    for (int r = 0; r < 4; ++r) out[(size_t)(16 * wid + 4 * (lane >> 4) + r) * ldo + col + (lane & 15)] = acc[r];
}
__device__ __forceinline__ void thin_ffn1(const Params& p, LAS unsigned char* lds, int c, int tid, int wid, int lane) {
    const int pn = c >> 3, j16 = c & 7, l15 = lane & 15, l4 = lane >> 4;
    f32x4 acc[2];
    thin_gemm2<2>(lds, (const bf16_t*)(p.ws + WS_Y) + (size_t)TOK_P * DM, DM, (const bf16_t*)(p.ws + WS_WFF1), DM, 256 * pn + 16 * j16, 128, 0, DM, acc, tid, wid, lane);
    const int ch = 128 * pn + 16 * j16 + l15, b = wid;
    const float* cw = p.in[15]; const float* cache = p.in[4] + (size_t)b * 2 * DFF + ch;
    const float w0 = cw[ch], w1 = cw[DFF + ch], w2 = cw[2 * DFF + ch];
    const f32x4 up = acc[0], gt = acc[1];
    float pm1 = __shfl_up(up[3], 16), pm2 = __shfl_up(up[2], 16);
    if (l4 == 0) { pm1 = cache[DFF]; pm2 = cache[0]; }
    float uc[4];
    uc[0] = w0 * pm2 + w1 * pm1 + w2 * up[0];
    uc[1] = w0 * pm1 + w1 * up[0] + w2 * up[1];
    uc[2] = w0 * up[0] + w1 * up[1] + w2 * up[2];
    uc[3] = w0 * up[1] + w1 * up[2] + w2 * up[3];
    bf16_t* ACT = (bf16_t*)(p.ws + WS_RB);
#pragma unroll
    for (int r = 0; r < 4; ++r) ACT[(size_t)(TOK_P + 16 * wid + 4 * l4 + r) * DFF + ch] = (bf16_t)(pk2(pg8::gelu_tanh(uc[r]) * gt[r], 0.f) & 0xffffu);
    if (l4 == 3) { float* o = p.out + O_CFS + (size_t)b * 2 * DFF + ch; o[0] = up[2]; o[DFF] = up[3]; }
}

__device__ __forceinline__ void phase4(const Params& p, int wid, int lane) {
    const int gw = blockIdx.x * 8 + wid, NGW = gridDim.x * 8;
    bf16_t* Y = (bf16_t*)(p.ws + WS_Y); const float* ssq = (const float*)(p.ws + WS_SSQ1); float* RS2 = (float*)(p.ws + WS_RS2); const bf16_t* XB = (const bf16_t*)(p.ws + WS_XB); const float* RS0 = (const float*)(p.ws + WS_RS0);
    const float* wpost = p.in[10];
    f32x4 wpo[4];
#pragma unroll
    for (int j = 0; j < 4; ++j) wpo[j] = *((const f32x4*)wpost + lane + 64 * j);
#pragma unroll 1
    for (int base = gw; base < TOK_P; base += RB * NGW) {
        f32x4 v[RB][4]; u32x2 yw[RB][4]; float sq[RB], i0[RB];
#pragma unroll
        for (int k = 0; k < RB; ++k) { const int rr = min(base + k * NGW, TOK_P - 1);
            sq[k] = lane < 16 ? ssq[(size_t)rr * 16 + lane] : 0.f; i0[k] = RS0[rr];
#pragma unroll
            for (int j = 0; j < 4; ++j) { v[k][j] = unpack_bf4(__builtin_nontemporal_load((const u32x2*)(XB + (size_t)rr * DM) + lane + 64 * j)); yw[k][j] = __builtin_nontemporal_load((const u32x2*)(Y + (size_t)rr * DM) + lane + 64 * j); } }
        float s2[RB];
#pragma unroll
        for (int k = 0; k < RB; ++k) { const float rstd1 = rsqrtf(wave_sum(sq[k]) * (1.0f / DM) + EPS); s2[k] = 0.f;
#pragma unroll
            for (int j = 0; j < 4; ++j) { v[k][j] = v[k][j] * i0[k] + (unpack_bf4(yw[k][j]) * rstd1) * wpo[j]; s2[k] += sumsq4(v[k][j]); } }
#pragma unroll
        for (int k = 0; k < RB; ++k) { const int r = base + k * NGW; const float rstd2 = rsqrtf(wave_sum(s2[k]) * (1.0f / DM) + EPS);
            if (r < TOK_P) {
                if (lane == 0) RS2[r] = __builtin_amdgcn_rcpf(rstd2);
#pragma unroll
                for (int j = 0; j < 4; ++j) { const f32x4 y = v[k][j] * rstd2; *((u32x2*)(Y + (size_t)r * DM) + lane + 64 * j) = (u32x2){pk2(y[0], y[1]), pk2(y[2], y[3])}; } } }
    }
    for (int r = TOK_P + gw; r < TOK; r += NGW) {
        const float* xrow = p.in[1] + (size_t)(r - TOK_P) * DM; const float* ys = (const float*)(p.ws + WS_YS) + (size_t)(r - TOK_P) * DM;
        f32x4 yv[4], v[4]; float s = 0.f, s2 = 0.f;
#pragma unroll
        for (int j = 0; j < 4; ++j) { f32x4 a = *((const f32x4*)ys + lane + 64 * j);
#pragma unroll
            for (int q = 1; q < 4; ++q) a += *((const f32x4*)(ys + (size_t)q * 128 * DM) + lane + 64 * j);
            yv[j] = a; s += sumsq4(a); }
        const float rstd1 = rsqrtf(wave_sum(s) * (1.0f / DM) + EPS);
#pragma unroll
        for (int j = 0; j < 4; ++j) { v[j] = *((const f32x4*)xrow + lane + 64 * j) + (yv[j] * rstd1) * wpo[j]; s2 += sumsq4(v[j]);
 }
        const float rstd2 = rsqrtf(wave_sum(s2) * (1.0f / DM) + EPS);
#pragma unroll
        for (int j = 0; j < 4; ++j) { const f32x4 y = v[j] * rstd2; *((u32x2*)(Y + (size_t)r * DM) + lane + 64 * j) = (u32x2){pk2(y[0], y[1]), pk2(y[2], y[3])}; }
    }
}
__device__ __forceinline__ void phase7(const Params& p, int wid, int lane) {
    const int gw = blockIdx.x * 8 + wid, NGW = gridDim.x * 8;
    const bf16_t* F = (const bf16_t*)(p.ws + WS_RA); const bf16_t* Y = (const bf16_t*)(p.ws + WS_Y);
    const float* ssq1 = (const float*)(p.ws + WS_SSQ1); const float* ssq2 = (const float*)(p.ws + WS_SSQ2);
    f32x4 wm[4], wf[4];
#pragma unroll
    for (int j = 0; j < 4; ++j) { wm[j] = *((const f32x4*)p.in[10] + lane + 64 * j); wf[j] = *((const f32x4*)p.in[12] + lane + 64 * j); }
    constexpr int RB7 = 6;
    const float* RS2p = (const float*)(p.ws + WS_RS2);
#pragma unroll 1
    for (int base = gw; base < TOK_P; base += RB7 * NGW) {
        u32x2 xw[RB7][4], fw[RB7][4]; float sq2[RB7], i2[RB7];
#pragma unroll
        for (int k = 0; k < RB7; ++k) { const int rr = min(base + k * NGW, TOK_P - 1);
            sq2[k] = lane < 16 ? ssq2[(size_t)rr * 16 + lane] : 0.f; i2[k] = RS2p[rr];
#pragma unroll
            for (int j = 0; j < 4; ++j) { xw[k][j] = __builtin_nontemporal_load((const u32x2*)(Y + (size_t)rr * DM) + lane + 64 * j); fw[k][j] = __builtin_nontemporal_load((const u32x2*)(F + (size_t)rr * DM) + lane + 64 * j); } }
#pragma unroll
        for (int k = 0; k < RB7; ++k) { const int r = base + k * NGW;
            const float rstd2 = rsqrtf(wave_sum(sq2[k]) * (1.0f / DM) + EPS);
            if (r < TOK_P) {
#pragma unroll
                for (int j = 0; j < 4; ++j) __builtin_nontemporal_store(unpack_bf4(xw[k][j]) * i2[k] + (unpack_bf4(fw[k][j]) * rstd2) * wf[j], (f32x4*)(p.out + (size_t)r * DM) + lane + 64 * j); } }
    }
    for (int r = TOK_P + gw; r < TOK; r += NGW) {
        const float* xrow = p.in[1] + (size_t)(r - TOK_P) * DM;
        const float* ys = (const float*)(p.ws + WS_YS) + (size_t)(r - TOK_P) * DM; const float* fs = (const float*)(p.ws + WS_FS) + (size_t)(r - TOK_P) * DM;
        f32x4 yv[4], fv[4]; float s1 = 0.f, s2 = 0.f;
#pragma unroll
        for (int j = 0; j < 4; ++j) { f32x4 a = *((const f32x4*)ys + lane + 64 * j), c = *((const f32x4*)fs + lane + 64 * j);
#pragma unroll
            for (int q = 1; q < 4; ++q) { a += *((const f32x4*)(ys + (size_t)q * 128 * DM) + lane + 64 * j); c += *((const f32x4*)(fs + (size_t)q * 128 * DM) + lane + 64 * j); }
            yv[j] = a; fv[j] = c; s1 += sumsq4(a); s2 += sumsq4(c); }
        const float rstd1 = rsqrtf(wave_sum(s1) * (1.0f / DM) + EPS), rstd2 = rsqrtf(wave_sum(s2) * (1.0f / DM) + EPS);
#pragma unroll
        for (int j = 0; j < 4; ++j) *((f32x4*)(p.out + (size_t)r * DM) + lane + 64 * j) = *((const f32x4*)xrow + lane + 64 * j) + (yv[j] * rstd1) * wm[j] + (fv[j] * rstd2) * wf[j];
    }
}


#define XB_TMO      128
#define XB_XCNT(j)  (256  + 64 * (j))
#define XB_XSUB(j)  (1280 + 64 * (j))
#define XB_XGEN(j)  (2304 + 64 * (j))
#define XB_TOP      3328
#define XB_TOPGEN   3392
#define XCD_BAR_WORDS 3456
#define XB_SPIN_CAP (1u << 18)

__device__ __forceinline__ unsigned xb_ld(unsigned* p)              { return __hip_atomic_load(p, __ATOMIC_RELAXED, __HIP_MEMORY_SCOPE_AGENT); }
__device__ __forceinline__ unsigned xb_add(unsigned* p, unsigned v) { return __hip_atomic_fetch_add(p, v, __ATOMIC_RELAXED, __HIP_MEMORY_SCOPE_AGENT); }
__device__ __forceinline__ unsigned xb_xcc_id() { return (unsigned)__builtin_amdgcn_s_getreg((3 << 11) | 20) & 0xFu; }
#define XB_SPIN(cond, bar) do { unsigned _sp = 0; while (cond) { __builtin_amdgcn_s_sleep(1); \
    if ((++_sp & 255u) == 0u) { if (xb_ld(&(bar)[XB_TMO])) break; if (_sp > XB_SPIN_CAP) { atomicAdd(&(bar)[XB_TMO], 1u); break; } } } } while (0)

struct XcdBarrier {
    unsigned* bar; unsigned x;
    volatile LAS unsigned* st;
};

__device__ __forceinline__ XcdBarrier xcd_barrier_post(unsigned* bar, volatile LAS unsigned* st) {
    XcdBarrier b; b.bar = bar; b.x = xb_xcc_id(); b.st = st;
    if (threadIdx.x == 0) (void)xb_add(&bar[XB_XCNT(b.x)], 1u);
    return b;
}
__device__ __forceinline__ void xcd_barrier_complete(unsigned* bar, unsigned x, unsigned& nloc, unsigned& nx) {
    const unsigned G = gridDim.x * gridDim.y * gridDim.z;
    unsigned sum, cnt, mine, sp = 0u;
    for (;;) {
        sum = 0u; cnt = 0u; mine = 0u;
#pragma unroll
        for (unsigned j = 0; j < 16; ++j) { const unsigned c = xb_ld(&bar[XB_XCNT(j)]); sum += c; cnt += (c > 0u) ? 1u : 0u; mine = (j == x) ? c : mine; }
        if (sum == G) break;
        __builtin_amdgcn_s_sleep(1);
        if ((++sp & 255u) == 0u) { if (xb_ld(&bar[XB_TMO])) break; if (sp > XB_SPIN_CAP) { atomicAdd(&bar[XB_TMO], 1u); break; } }
    }
    nloc = mine > 0u ? mine : 1u; nx = cnt > 0u ? cnt : 1u;
}

__device__ __forceinline__ void xcd_barrier(const XcdBarrier& b) {
    asm volatile("s_waitcnt vmcnt(0)" ::: "memory");
    __syncthreads();
    if (threadIdx.x == 0) {
        unsigned* bar = b.bar;
        __builtin_amdgcn_s_waitcnt(0);
        unsigned nloc = b.st[0], nx = b.st[1];
        if (nloc == 0u) { xcd_barrier_complete(bar, b.x, nloc, nx); b.st[0] = nloc; b.st[1] = nx; }
        const unsigned old = xb_add(&bar[XB_XSUB(b.x)], 1u);
        const unsigned gen = old / nloc;
        if (old + 1u == (gen + 1u) * nloc) {
            __builtin_amdgcn_fence(__ATOMIC_RELEASE, "agent");
            asm volatile("s_waitcnt vmcnt(0)" ::: "memory");
            const unsigned og = xb_add(&bar[XB_TOP], 1u);
            const unsigned tg = og / nx;
            if (og + 1u == (tg + 1u) * nx) xb_add(&bar[XB_TOPGEN], 1u);
            else XB_SPIN(xb_ld(&bar[XB_TOPGEN]) == tg, bar);
            __builtin_amdgcn_fence(__ATOMIC_ACQUIRE, "agent");
            xb_add(&bar[XB_XGEN(b.x)], 1u);
            asm volatile("s_waitcnt vmcnt(0)" ::: "memory");
        } else {
            XB_SPIN(xb_ld(&bar[XB_XGEN(b.x)]) == gen, bar);
            __builtin_amdgcn_fence(__ATOMIC_ACQUIRE, "agent");
            asm volatile("s_waitcnt vmcnt(0)" ::: "memory");
        }
    }
    __syncthreads();
}

#ifndef MK_LAUNCHES
#define MK_LAUNCHES 1
#endif
#ifndef REP0
#define REP0 1
#endif
#ifndef REP1
#define REP1 1
#endif
#ifndef REP2
#define REP2 1
#endif
#ifndef REP3
#define REP3 1
#endif
#ifndef REP4
#define REP4 1
#endif
#ifndef REP5
#define REP5 1
#endif
#ifndef REP6
#define REP6 1
#endif
#ifndef REP7
#define REP7 1
#endif
#define REPEAT(n) for (int rep_ = 0; rep_ < (n); ++rep_, ((rep_ < (n)) ? GRIDSYNC() : (void)0))
template <int PH_LO, int PH_HI>
__device__ __forceinline__ void run_phases(const Params& p, LAS unsigned char* lds) {
    int tid = threadIdx.x, lane = tid & 63; const int wid = __builtin_amdgcn_readfirstlane(tid >> 6);
    const int G = gridDim.x, c = blockIdx.x;
#define LAUNDER() asm volatile("" : "+v"(tid), "+v"(lane))
    XcdBarrier bar_;
    if (PH_HI - PH_LO > 1) {
        volatile LAS unsigned* stw = (volatile LAS unsigned*)(lds + LDS_BARW);
        if (threadIdx.x == 0) { stw[0] = 0u; stw[1] = 0u; }
        __syncthreads();
        bar_ = xcd_barrier_post((unsigned*)p.ws, stw);
        if (p.ws == nullptr) cg::this_grid().sync();
    }
#define GRIDSYNC() xcd_barrier(bar_)
#define SEAM(ph) do { if (PH_LO <= (ph) && (ph) + 1 < PH_HI) { GRIDSYNC(); } } while (0)
#ifdef XSYNC
    for (int xs_ = 0; xs_ < XSYNC; ++xs_) GRIDSYNC();
#endif
    if (PH_LO <= 0 && 0 < PH_HI) REPEAT(REP0) { LAUNDER(); phase0(p, lds, tid, wid, lane); }
    SEAM(0);
    if (PH_LO <= 1 && 1 < PH_HI) REPEAT(REP1) {
        for (int t = c; t < 224; t += G) { f32x4 acc[1]; thin_gemm2<1>(lds, (const bf16_t*)(p.ws + WS_RA) + (size_t)TOK_P * DM, DM, (const bf16_t*)(p.ws + WS_WIN), DM, 16 * t, 0, 0, DM, acc, tid, wid, lane);
            thin_store(acc[0], (float*)(p.ws + WS_PS), NIN, 16 * t, wid, lane); }
        pg8::Gemm g{(const bf16_t*)(p.ws + WS_XB), (const bf16_t*)(p.ws + WS_WIN), TOK_P, NIN, DM};
        pg8::StaticOrder S; S.init(TOK_P, NIN, G, c);
        pg8::EpiIn E{(bf16_t*)(p.ws + WS_RB), (const float*)(p.ws + WS_COS), (const float*)(p.ws + WS_SIN), (const float*)(p.ws + WS_RS0)};
        pg8::gemm_phase<pg8::EpiIn, pg8::StaticOrder, true, true>(lds, g, S, E);
    }
    SEAM(1);
    if (PH_LO <= 2 && 2 < PH_HI) REPEAT(REP2) {
#ifndef RUREP
#define RUREP 1
#endif
        for (int rrep_ = 0; rrep_ < RUREP; ++rrep_) for (int u = c; u < 256; u += G) ret_unit<false>(p, lds, u, tid, wid, lane);
        LAUNDER();
#ifndef SUREP
#define SUREP 1
#endif
        for (int srep_ = 0; srep_ < SUREP; ++srep_) for (int su = c; su < 128; su += G) sample_unit(p, lds, su, tid, wid, lane);
    }
    SEAM(2);
    if (PH_LO <= 3 && 3 < PH_HI) REPEAT(REP3) {
        for (int u = c; u < 256; u += G) ret_unit<true>(p, lds, u, tid, wid, lane);
    }
    SEAM(3);
    if (PH_LO <= 4 && 4 < PH_HI) REPEAT(REP4) {
        for (int t = c; t < 256; t += G) { f32x4 acc[1]; const int kq = t >> 6, nt = t & 63;
            thin_gemm2<1>(lds, (const bf16_t*)(p.ws + WS_RA) + (size_t)TOK_P * DM, DM, (const bf16_t*)(p.ws + WS_WOUT), DM, 16 * nt, 0, 256 * kq, 256, acc, tid, wid, lane);
            thin_store(acc[0], (float*)(p.ws + WS_YS) + (size_t)kq * 128 * DM, DM, 16 * nt, wid, lane); }
        pg8::Gemm g{(const bf16_t*)(p.ws + WS_RA), (const bf16_t*)(p.ws + WS_WOUT), TOK_P, DM, DM};
        pg8::StaticOrder S; S.init(TOK_P, DM, G, c);
        pg8::EpiY E{(bf16_t*)(p.ws + WS_Y), (float*)(p.ws + WS_SSQ1)};
        pg8::gemm_phase<pg8::EpiY, pg8::StaticOrder, true, true>(lds, g, S, E);
    }
    SEAM(4);
    if (PH_LO <= 5 && 5 < PH_HI) REPEAT(REP5) { LAUNDER(); phase4(p, wid, lane); }
    SEAM(5);
    if (PH_LO <= 6 && 6 < PH_HI) REPEAT(REP6) {
        for (int t = c; t < 256; t += G) thin_ffn1(p, lds, t, tid, wid, lane);
        pg8::Gemm g{(const bf16_t*)(p.ws + WS_Y), (const bf16_t*)(p.ws + WS_WFF1), TOK_P, 2 * DFF, DM};
        pg8::WalkOrder S{G, c};
        pg8::EpiFfn E{(bf16_t*)(p.ws + WS_RB), p.in[15], p.in[4], p.out + O_CFP, p.out + O_CFS, (LAS float*)(lds + LDS_HALO), (const float*)(p.ws + WS_RS2)};
        pg8::gemm_phase<pg8::EpiFfn, pg8::WalkOrder, true, true>(lds, g, S, E);
    }
    SEAM(6);
    if (PH_LO <= 7 && 7 < PH_HI) REPEAT(REP7) {
        for (int t = c; t < 256; t += G) { f32x4 acc[1]; const int kq = t >> 6, nt = t & 63;
            thin_gemm2<1>(lds, (const bf16_t*)(p.ws + WS_RB) + (size_t)TOK_P * DFF, DFF, (const bf16_t*)(p.ws + WS_WDN), DFF, 16 * nt, 0, 1024 * kq, 1024, acc, tid, wid, lane);
            thin_store(acc[0], (float*)(p.ws + WS_FS) + (size_t)kq * 128 * DM, DM, 16 * nt, wid, lane); }
        pg8::Gemm g{(const bf16_t*)(p.ws + WS_RB), (const bf16_t*)(p.ws + WS_WDN), TOK_P, DM, DFF};
        pg8::StaticOrder S; S.init(TOK_P, DM, G, c);
        pg8::EpiY E{(bf16_t*)(p.ws + WS_RA), (float*)(p.ws + WS_SSQ2)};
        pg8::gemm_phase<pg8::EpiY, pg8::StaticOrder, true, true>(lds, g, S, E);
    }
    SEAM(7);
#ifndef REP8
#define REP8 1
#endif
    if (PH_LO <= 8 && 8 < PH_HI) REPEAT(REP8) { LAUNDER(); phase7(p, wid, lane); }
#undef SEAM
}
constexpr int NPH = 9;
#if MK_LAUNCHES == 1
__global__ void __launch_bounds__(512, 2) fwd_kernel(Params p) {
    extern __shared__ __attribute__((aligned(16))) unsigned char smem[];
    run_phases<0, NPH>(p, (LAS unsigned char*)smem);
}
#else
template <int PH>
__global__ void __launch_bounds__(512, 2) fwd_phase(Params p) {
    extern __shared__ __attribute__((aligned(16))) unsigned char smem[];
    run_phases<PH, PH + 1>(p, (LAS unsigned char*)smem);
}
template <int PH> static void launch_phase(const Params& p, int grid, hipStream_t stream) {
    static bool attr = false;
    if (!attr) { (void)hipFuncSetAttribute((const void*)fwd_phase<PH>, hipFuncAttributeMaxDynamicSharedMemorySize, LDS_BYTES); attr = true; }
    hipLaunchKernelGGL(fwd_phase<PH>, dim3(grid), dim3(512), LDS_BYTES, stream, p);
}
#endif

extern "C" void kernel_launch(void* const* d_in, const int* in_sizes, int n_in, void* d_out, int out_size, void* d_ws, size_t ws_size, hipStream_t stream) {
    static int grid = 0;
    if (grid == 0) {
        if (n_in != 17 || ws_size < WS_END) { fprintf(stderr, "kernel_launch: expected 17 inputs and >= %zu bytes of workspace (got %d, %zu)\n", (size_t)WS_END, n_in, ws_size); grid = -1; return; }
        int dev = 0, cus = 0, per_cu = 0;
        (void)hipGetDevice(&dev); (void)hipDeviceGetAttribute(&cus, hipDeviceAttributeMultiprocessorCount, dev);
#if MK_LAUNCHES == 1
        if (hipFuncSetAttribute((const void*)fwd_kernel, hipFuncAttributeMaxDynamicSharedMemorySize, LDS_BYTES) != hipSuccess) { fprintf(stderr, "kernel_launch: hipFuncSetAttribute failed\n"); grid = -1; return; }
        if (hipOccupancyMaxActiveBlocksPerMultiprocessor(&per_cu, (const void*)fwd_kernel, 512, LDS_BYTES) != hipSuccess || per_cu < 1) { fprintf(stderr, "kernel_launch: occupancy query says %d\n", per_cu); per_cu = 1; }
        (void)hipGetLastError();
#endif
        grid = cus > 0 ? cus : 256;
    }
    if (grid < 0) return;
    Params p{};
    for (int i = 0; i < 17; ++i) p.in[i] = (const float*)d_in[i];
    p.out = (float*)d_out; p.ws = (unsigned char*)d_ws;
#if MK_LAUNCHES == 1
    if (hipMemsetAsync(d_ws, 0, 16384, stream) != hipSuccess) { fprintf(stderr, "kernel_launch: hipMemsetAsync failed\n"); return; }
    void* args[] = {&p};
    const hipError_t e = hipLaunchCooperativeKernel((const void*)fwd_kernel, dim3(grid), dim3(512), args, LDS_BYTES, stream);
    if (e != hipSuccess) fprintf(stderr, "kernel_launch: cooperative launch failed: %s (grid %d)\n", hipGetErrorString(e), grid);
#else
    launch_phase<0>(p, grid, stream); launch_phase<1>(p, grid, stream); launch_phase<2>(p, grid, stream); launch_phase<3>(p, grid, stream); launch_phase<4>(p, grid, stream);
    launch_phase<5>(p, grid, stream); launch_phase<6>(p, grid, stream); launch_phase<7>(p, grid, stream); launch_phase<8>(p, grid, stream);
#endif
}
```

```cpp
#include <hip/hip_runtime.h>
#include <hip/hip_cooperative_groups.h>
#include <cstdio>
#include <cstdint>
namespace cg = cooperative_groups;
namespace pg8 {
#define PG8_LAS __attribute__((address_space(3)))
typedef unsigned short bf16_t;
typedef short bf16x8 __attribute__((ext_vector_type(8)));
typedef float f32x4 __attribute__((ext_vector_type(4)));
typedef unsigned u32x4 __attribute__((ext_vector_type(4)));
constexpr int BM = 256, BK = 64, HALF = 128, HTB = HALF * BK * 2  , STAGE_BYTES = 8 * HTB, NXCD = 8, WGM = 8;

__host__ __device__ __forceinline__ int lds_byte(int r, int c) { const int st = (r >> 4) * 2 + (c >> 5), rr = r & 15, cc = c & 31, ob = rr * 64 + cc * 2; return st * 1024 + (ob ^ (((ob >> 9) & 1) << 5)); }
__host__ __device__ __forceinline__ void stage_rc(int b, int& R, int& C) { const int st = b / 1024, sb = b % 1024, swz = sb ^ (((sb >> 9) & 1) << 5); R = (st >> 1) * 16 + swz / 64; C = (st & 1) * 32 + (swz % 64) / 2; }
__host__ __device__ __forceinline__ int perm32(int rho) { const int n = rho >> 4, i = rho & 15; return 8 * (i >> 2) + 4 * n + (i & 3); }

struct Unit { int pm, pn; };
struct Gemm { const bf16_t* A; const bf16_t* Bt; int M, N, K; };

struct StaticOrder {
    int nM, nN, nwg, G, c;
    __host__ __device__ void init(int M, int N, int G_, int c_) { nM = M / BM; nN = N / BM; nwg = nM * nN; G = G_; c = c_; }
    __host__ __device__ bool next(int i, Unit& u) const {
        const long L = (long)i * G + c; if (L >= nwg) return false;
        int wgid = (int)L; { const int q = nwg / NXCD, r = nwg % NXCD, xcd = wgid % NXCD, off = wgid / NXCD; wgid = (xcd < r ? xcd * (q + 1) : r * (q + 1) + (xcd - r) * q) + off; }
        const int nig = WGM * nN, gid = wgid / nig, fm = gid * WGM, gsz = (nM - fm) < WGM ? (nM - fm) : WGM;
        u.pm = fm + ((wgid % nig) % gsz); u.pn = (wgid % nig) / gsz; return true;
    }
    __device__ __forceinline__ void a_ready(const Unit&) const {}
    __device__ __forceinline__ void done(const Unit&) const {}
};
__device__ __forceinline__ unsigned cvt_pk_bf16(float lo, float hi) { unsigned r; asm volatile("v_cvt_pk_bf16_f32 %0, %1, %2" : "=v"(r) : "v"(lo), "v"(hi)); return r; }
__device__ __forceinline__ float dpp_shr1(float v) { return __builtin_bit_cast(float, __builtin_amdgcn_update_dpp(0, __builtin_bit_cast(int, v), 0x111, 0xf, 0xf, true)); }
__device__ __forceinline__ float dpp_shr2(float v) { return __builtin_bit_cast(float, __builtin_amdgcn_update_dpp(0, __builtin_bit_cast(int, v), 0x112, 0xf, 0xf, true)); }
__device__ __forceinline__ float dpp_shl15(float v) { return __builtin_bit_cast(float, __builtin_amdgcn_update_dpp(0, __builtin_bit_cast(int, v), 0x10F, 0xf, 0xf, true)); }
__device__ __forceinline__ float dpp_shl14(float v) { return __builtin_bit_cast(float, __builtin_amdgcn_update_dpp(0, __builtin_bit_cast(int, v), 0x10E, 0xf, 0xf, true)); }
__device__ __forceinline__ float gelu_tanh(float x) {
    const float z = 0.7978845608028654f * (x + 0.044715f * x * x * x);
    const float e = __builtin_amdgcn_exp2f(-2.8853900817779268f * z);
    return x * __builtin_amdgcn_rcpf(1.0f + e);
}
constexpr int TOKP = 32768;

struct EpiIn {
    static constexpr bool PERM = true, AFTER_DRAIN = false;
    bf16_t* P; const float* cosT; const float* sinT; const float* rs0;
    __device__ __forceinline__ void operator()(const f32x4 (&acc)[2][2][4][2], const Unit& u, int wr, int wc, int fr, int fq) const {
        asm volatile("" : "+v"(fr), "+v"(fq));
        const int row0 = u.pm * BM + wr * 64 + fr, col0 = u.pn * BM + wc * 32 + 8 * fq;
        if (u.pn < 4) {
            const float sc = (u.pn >= 2) ? 0.08838834764831845f : 1.0f;
            const int f0 = 16 * wc + 4 * fq;
#pragma unroll
            for (int ai = 0; ai < 2; ++ai)
#pragma unroll
                for (int m = 0; m < 4; ++m) {
                    const int r = row0 + ai * HALF + m * 16;
                    const int pos = r < TOKP ? (r & 4095) : 4096 + ((r - TOKP) & 15);
                    const float rsr = sc;
                    const f32x4 c4 = *(const f32x4*)(cosT + pos * 64 + f0) * rsr, s4 = *(const f32x4*)(sinT + pos * 64 + f0) * rsr;
                    bf16_t* rowp = P + (size_t)r * 3584 + col0;
#pragma unroll
                    for (int bj = 0; bj < 2; ++bj) {
                        const f32x4 x1 = acc[ai][bj][m][0], x2 = acc[ai][bj][m][1];
                        const f32x4 o1 = x1 * c4 - x2 * s4, o2 = x2 * c4 + x1 * s4;
                        u32x4 w; w.x = cvt_pk_bf16(o1[0], o1[1]); w.y = cvt_pk_bf16(o1[2], o1[3]); w.z = cvt_pk_bf16(o2[0], o2[1]); w.w = cvt_pk_bf16(o2[2], o2[3]);
                        *(u32x4*)(rowp + bj * HALF) = w;
                    }
                }
        } else if (u.pn >= 10) {
#pragma unroll
            for (int ai = 0; ai < 2; ++ai)
#pragma unroll
                for (int m = 0; m < 4; ++m) {
                    const int r = row0 + ai * HALF + m * 16;
                    const f32x4 v0 = acc[ai][0][m][0] * acc[ai][1][m][0], v1 = acc[ai][0][m][1] * acc[ai][1][m][1];
                    u32x4 w; w.x = cvt_pk_bf16(v0[0], v0[1]); w.y = cvt_pk_bf16(v0[2], v0[3]); w.z = cvt_pk_bf16(v1[0], v1[1]); w.w = cvt_pk_bf16(v1[2], v1[3]);
                    *(u32x4*)(P + (size_t)r * 3584 + 2560 + 128 * (u.pn - 10) + wc * 32 + 8 * fq) = w;
                }
        } else {
#pragma unroll
            for (int ai = 0; ai < 2; ++ai)
#pragma unroll
                for (int m = 0; m < 4; ++m) {
                    bf16_t* rowp = P + (size_t)(row0 + ai * HALF + m * 16) * 3584 + col0;
#pragma unroll
                    for (int bj = 0; bj < 2; ++bj) {
                        const f32x4 v0 = acc[ai][bj][m][0], v1 = acc[ai][bj][m][1];
                        u32x4 w; w.x = cvt_pk_bf16(v0[0], v0[1]); w.y = cvt_pk_bf16(v0[2], v0[3]); w.z = cvt_pk_bf16(v1[0], v1[1]); w.w = cvt_pk_bf16(v1[2], v1[3]);
                        *(u32x4*)(rowp + bj * HALF) = w;
                    }
                }
        }
    }
};

struct EpiY {
    static constexpr bool PERM = true, AFTER_DRAIN = false;
    bf16_t* Y; float* ssq;
    __device__ __forceinline__ void operator()(const f32x4 (&acc)[2][2][4][2], const Unit& u, int wr, int wc, int fr, int fq) const {
        asm volatile("" : "+v"(fr), "+v"(fq));
        const int row0 = u.pm * BM + wr * 64 + fr, col0 = u.pn * BM + wc * 32 + 8 * fq;
#pragma unroll
        for (int ai = 0; ai < 2; ++ai)
#pragma unroll
            for (int m = 0; m < 4; ++m) {
                const int r = row0 + ai * HALF + m * 16;
                bf16_t* rowp = Y + (size_t)r * 1024 + col0;
#pragma unroll
                for (int bj = 0; bj < 2; ++bj) {
                    const f32x4 v0 = acc[ai][bj][m][0], v1 = acc[ai][bj][m][1];
                    u32x4 w; w.x = cvt_pk_bf16(v0[0], v0[1]); w.y = cvt_pk_bf16(v0[2], v0[3]); w.z = cvt_pk_bf16(v1[0], v1[1]); w.w = cvt_pk_bf16(v1[2], v1[3]);
                    *(u32x4*)(rowp + bj * HALF) = w;
                }
            }
    }
};

struct EpiFfn {
    static constexpr bool PERM = true, AFTER_DRAIN = false;
    bf16_t* ACT; const float* cw; const float* cache; float* outp; float* outs; PG8_LAS float* halo; const float* rs2;
    __device__ __forceinline__ void operator()(const f32x4 (&acc)[2][2][4][2], const Unit& u, int wr, int wc, int fr, int fq) const {
        asm volatile("" : "+v"(fr), "+v"(fq));
        const int lc0 = wc * 32 + 8 * fq, ch0 = u.pn * 128 + lc0;
        const bool sample = false;
        const int par = u.pm & 1;
        f32x4 w0[2], w1[2], w2[2];
#pragma unroll
        for (int n = 0; n < 2; ++n) { w0[n] = *(const f32x4*)(cw + ch0 + 4 * n); w1[n] = *(const f32x4*)(cw + 4096 + ch0 + 4 * n); w2[n] = *(const f32x4*)(cw + 8192 + ch0 + 4 * n); }
        if (!sample && fr >= 14) {
#pragma unroll
            for (int ai = 0; ai < 2; ++ai) { PG8_LAS float* hp = halo + ((par * 4 + 2 * ai + wr) * 2 + (fr - 14)) * 128 + lc0;
                *(PG8_LAS f32x4*)hp = acc[ai][0][3][0]; *(PG8_LAS f32x4*)(hp + 4) = acc[ai][0][3][1]; }
        }
        asm volatile("s_waitcnt lgkmcnt(0)" ::: "memory"); __builtin_amdgcn_s_barrier(); asm volatile("" ::: "memory");
#pragma unroll
        for (int ai = 0; ai < 2; ++ai) {
            const int blk = 2 * ai + wr;
#pragma unroll
            for (int m = 0; m < 4; ++m) {
                f32x4 pv[2]; pv[0] = (f32x4){0.f, 0.f, 0.f, 0.f}; pv[1] = pv[0];
                const int sb = 8 * ai + 4 * wr + m;
                if (sample) {
                    if (fr >= 14 && sb < 8) { const float* cp = cache + (size_t)(sb * 2 + fr - 14) * 4096 + ch0; pv[0] = *(const f32x4*)cp; pv[1] = *(const f32x4*)(cp + 4); }
                } else if (m == 0) {
                    if (fr >= 14) {
                        const bool zero = (blk == 0) && ((u.pm & 15) == 0);
                        const int hb = (blk == 0) ? ((par ^ 1) * 4 + 3) : (par * 4 + blk - 1);
                        if (!zero) { const PG8_LAS float* hp = halo + (hb * 2 + fr - 14) * 128 + lc0; pv[0] = *(const PG8_LAS f32x4*)hp; pv[1] = *(const PG8_LAS f32x4*)(hp + 4); }
                    }
                } else { pv[0] = acc[ai][0][m - 1][0]; pv[1] = acc[ai][0][m - 1][1]; }
                const int r = u.pm * BM + ai * HALF + wr * 64 + m * 16 + fr;
                f32x4 a4[2];
#pragma unroll
                for (int n = 0; n < 2; ++n) {
                    const f32x4 cur = acc[ai][0][m][n], gt = acc[ai][1][m][n];
                    f32x4 p1, p2;
#pragma unroll
                    for (int e = 0; e < 4; ++e) { p1[e] = dpp_shr1(cur[e]) + dpp_shl15(pv[n][e]); p2[e] = dpp_shr2(cur[e]) + dpp_shl14(pv[n][e]); }
                    const f32x4 uc = w0[n] * p2 + w1[n] * p1 + w2[n] * cur;
                    const f32x4 zz = (uc * uc * 0.044715f + 1.0f) * uc * (-2.8853900817779268f * 0.7978845608028654f);
                    f32x4 rr;
#pragma unroll
                    for (int e = 0; e < 4; ++e) rr[e] = __builtin_amdgcn_rcpf(1.0f + __builtin_amdgcn_exp2f(zz[e]));
                    a4[n] = uc * rr * gt;
                }
                u32x4 w; w.x = cvt_pk_bf16(a4[0][0], a4[0][1]); w.y = cvt_pk_bf16(a4[0][2], a4[0][3]); w.z = cvt_pk_bf16(a4[1][0], a4[1][1]); w.w = cvt_pk_bf16(a4[1][2], a4[1][3]);
                *(u32x4*)(ACT + (size_t)r * 4096 + ch0) = w;
                if (sample) {
                    if (fr >= 14 && sb < 8) { float* op = outs + (size_t)(sb * 2 + fr - 14) * 4096 + ch0; *(f32x4*)op = acc[ai][0][m][0]; *(f32x4*)(op + 4) = acc[ai][0][m][1]; }
                } else if (m == 3 && blk == 3 && (u.pm & 15) == 15 && fr >= 14) {
                    float* op = outp + (size_t)((u.pm >> 4) * 2 + fr - 14) * 4096 + ch0; *(f32x4*)op = acc[ai][0][m][0]; *(f32x4*)(op + 4) = acc[ai][0][m][1];
                }
            }
        }
    }
};
struct WalkOrder {
    int G, c;
    __device__ __forceinline__ bool next(int i, Unit& u) const {
        int w = c, rem = i;
        while (w < 256) { const int len = 16;
            if (rem < len) { if (w < 256) { u.pm = (w >> 5) * 16 + rem; u.pn = w & 31; } else { u.pm = 128; u.pn = w - 256; } return true; }
            rem -= len; w += G; }
        return false;
    }
    __device__ __forceinline__ void a_ready(const Unit&) const {}
    __device__ __forceinline__ void done(const Unit&) const {}
};
template <class Epi, class Sched, bool ALIGN_EPI = false, bool SP2 = false>
__device__ __forceinline__ void gemm_phase(PG8_LAS unsigned char* lds, const Gemm g, const Sched& S, const Epi& E) {
    int tid_raw = threadIdx.x; asm volatile("" : "+v"(tid_raw));
    const int tid = tid_raw, wid = __builtin_amdgcn_readfirstlane(tid >> 6), lane = tid & 63, wr = wid >> 2, wc = wid & 3, fr = lane & 15, fq = lane >> 4;
    const int K = g.K, nt = K / BK;
    unsigned voffA[2], voffB[2];
#pragma unroll
    for (int i = 0; i < 2; ++i) { int R, C; stage_rc(tid * 16 + i * 8192, R, C); const int Rb = Epi::PERM ? ((R & ~31) + perm32(R & 31)) : R;
        voffA[i] = (unsigned)(R * K + C) * 2u; voffB[i] = (unsigned)(Rb * K + C) * 2u; }
    const size_t kstep = (size_t)(BK * 2);
    const size_t hstep = (size_t)HALF * K * 2;
    const size_t tstep = 2 * hstep;
    const unsigned ldsw = (unsigned)wid * 1024u;
    const int aoff = lds_byte(wr * 64 + fr, fq * 8), boff = lds_byte(wc * 32 + fr, fq * 8);
#define PG8_SA(b, h) (((b) * 2 + (h)) * HTB)
#define PG8_SB(b, h) ((4 + (b) * 2 + (h)) * HTB)
#define PG8_STAGE(bufoff, gbase, voff) do { _Pragma("unroll") for (int _i = 0; _i < 2; ++_i) \
        __builtin_amdgcn_global_load_lds((const unsigned*)((const char*)(gbase) + (voff)[_i]), (PG8_LAS unsigned*)(lds + (bufoff) + ldsw + _i * 8192), 16, 0, 0); } while (0)
#define PG8_LDA(dst, b, h) do { _Pragma("unroll") for (int m = 0; m < 4; ++m) _Pragma("unroll") for (int k = 0; k < 2; ++k) dst[m][k] = *(const PG8_LAS bf16x8*)(lds + PG8_SA(b, h) + aoff + m * 2048 + k * 1024); } while (0)
#define PG8_LDB(dst, b, h) do { _Pragma("unroll") for (int n = 0; n < 2; ++n) _Pragma("unroll") for (int k = 0; k < 2; ++k) dst[n][k] = *(const PG8_LAS bf16x8*)(lds + PG8_SB(b, h) + boff + n * 2048 + k * 1024); } while (0)
#define PG8_MMA(ai, bj, At, Bt) do { __builtin_amdgcn_s_setprio(1); _Pragma("unroll") for (int m = 0; m < 4; ++m) _Pragma("unroll") for (int n = 0; n < 2; ++n) _Pragma("unroll") for (int k = 0; k < 2; ++k) \
        acc[ai][bj][m][n] = __builtin_amdgcn_mfma_f32_16x16x32_bf16(Bt[n][k], At[m][k], acc[ai][bj][m][n], 0, 0, 0); __builtin_amdgcn_s_setprio(0); } while (0)
#define PG8_WAIT_V(n) asm volatile("s_waitcnt vmcnt(" #n ")" ::: "memory")
#define PG8_WAIT_L(n) asm volatile("s_waitcnt lgkmcnt(" #n ")" ::: "memory")
#define PG8_BAR __builtin_amdgcn_s_barrier()
#define PG8_SCHED __builtin_amdgcn_sched_barrier(0)
    Unit cur, nxt; int ui = 0;
    if (!S.next(0, cur)) return;
    f32x4 acc[2][2][4][2];
#pragma unroll
    for (int a = 0; a < 2; ++a)
#pragma unroll
        for (int b = 0; b < 2; ++b)
#pragma unroll
            for (int m = 0; m < 4; ++m)
#pragma unroll
                for (int n = 0; n < 2; ++n) acc[a][b][m][n] = (f32x4){0.f, 0.f, 0.f, 0.f};
    bf16x8 At[4][2], B0[2][2], B1[2][2];
    const char* cA = (const char*)g.A + (size_t)cur.pm * tstep; const char* cB = (const char*)g.Bt + (size_t)cur.pn * tstep;
    S.a_ready(cur);
    if constexpr (SP2) {
        PG8_STAGE(PG8_SB(0, 0), cB, voffB); PG8_STAGE(PG8_SB(0, 1), cB + hstep, voffB); PG8_STAGE(PG8_SA(0, 0), cA, voffA); PG8_STAGE(PG8_SA(0, 1), cA + hstep, voffA);
        if (wr == 1) PG8_BAR;
        PG8_WAIT_V(2); PG8_BAR;
        PG8_STAGE(PG8_SB(1, 0), cB + kstep, voffB); PG8_STAGE(PG8_SA(1, 0), cA + kstep, voffA); PG8_STAGE(PG8_SB(1, 1), cB + hstep + kstep, voffB);
        PG8_WAIT_V(6); PG8_BAR;
    } else {
        PG8_STAGE(PG8_SB(0, 0), cB, voffB); PG8_STAGE(PG8_SA(0, 0), cA, voffA); PG8_STAGE(PG8_SB(0, 1), cB + hstep, voffB); PG8_STAGE(PG8_SA(0, 1), cA + hstep, voffA);
        if (wr == 1) PG8_BAR;
        PG8_WAIT_V(4); PG8_BAR;
        PG8_STAGE(PG8_SB(1, 0), cB + kstep, voffB); PG8_STAGE(PG8_SA(1, 0), cA + kstep, voffA); PG8_STAGE(PG8_SB(1, 1), cB + hstep + kstep, voffB);
        PG8_WAIT_V(6); PG8_BAR;
    }
    for (;;) {
        const bool has_next = S.next(ui + 1, nxt);
        const char* nA = has_next ? (const char*)g.A + (size_t)nxt.pm * tstep : cA; const char* nB = has_next ? (const char*)g.Bt + (size_t)nxt.pn * tstep : cB;
        for (int t = 0; t < nt; t += 2) {
            const bool last = (t == nt - 2);
            const char* a1 = cA + (size_t)(t + 1) * kstep;
            const char* a2 = last ? nA : cA + (size_t)(t + 2) * kstep; const char* b2 = last ? nB : cB + (size_t)(t + 2) * kstep;
            const char* a3 = a2 + kstep; const char* b3 = b2 + kstep;
            if (last && has_next) S.a_ready(nxt);
            if constexpr (SP2) {
            PG8_LDB(B0, 0, 0); PG8_LDB(B1, 0, 1); PG8_SCHED; PG8_LDA(At, 0, 0); PG8_STAGE(PG8_SA(1, 1), a1 + hstep, voffA);
            PG8_WAIT_V(8); PG8_WAIT_L(0); PG8_BAR; PG8_MMA(0, 0, At, B0); PG8_MMA(0, 1, At, B1); PG8_BAR; PG8_SCHED;
            PG8_LDA(At, 0, 1); PG8_STAGE(PG8_SB(0, 0), b2, voffB); PG8_STAGE(PG8_SB(0, 1), b2 + hstep, voffB); PG8_STAGE(PG8_SA(0, 0), a2, voffA);
            PG8_WAIT_V(8); PG8_WAIT_L(0); PG8_BAR; PG8_MMA(1, 0, At, B0); PG8_MMA(1, 1, At, B1); PG8_BAR; PG8_SCHED;
            PG8_LDB(B0, 1, 0); PG8_LDB(B1, 1, 1); PG8_SCHED; PG8_LDA(At, 1, 0); PG8_STAGE(PG8_SA(0, 1), a2 + hstep, voffA);
            PG8_WAIT_V(8); PG8_WAIT_L(0); PG8_BAR; PG8_MMA(0, 0, At, B0); PG8_MMA(0, 1, At, B1); PG8_BAR; PG8_SCHED;
            PG8_LDA(At, 1, 1); PG8_STAGE(PG8_SB(1, 0), b3, voffB); PG8_STAGE(PG8_SB(1, 1), b3 + hstep, voffB); PG8_STAGE(PG8_SA(1, 0), a3, voffA);
            PG8_WAIT_V(8); PG8_WAIT_L(0); PG8_BAR; PG8_MMA(1, 0, At, B0); PG8_MMA(1, 1, At, B1); PG8_BAR; PG8_SCHED;
            } else {
            PG8_LDB(B0, 0, 0); PG8_SCHED; PG8_LDA(At, 0, 0); PG8_STAGE(PG8_SA(1, 1), a1 + hstep, voffA);
            PG8_WAIT_L(8); PG8_BAR; PG8_WAIT_L(0); PG8_MMA(0, 0, At, B0); PG8_BAR; PG8_SCHED;
            PG8_LDB(B1, 0, 1); PG8_STAGE(PG8_SB(0, 0), b2, voffB);
            PG8_BAR; PG8_WAIT_L(0); PG8_MMA(0, 1, At, B1); PG8_BAR;
            PG8_LDA(At, 0, 1); PG8_STAGE(PG8_SA(0, 0), a2, voffA);
            PG8_BAR; PG8_WAIT_L(0); PG8_MMA(1, 0, At, B0); PG8_BAR; PG8_SCHED;
            PG8_STAGE(PG8_SB(0, 1), b2 + hstep, voffB);
            PG8_WAIT_V(6); PG8_BAR; PG8_MMA(1, 1, At, B1); PG8_BAR;
            PG8_LDB(B0, 1, 0); PG8_SCHED; PG8_LDA(At, 1, 0); PG8_STAGE(PG8_SA(0, 1), a2 + hstep, voffA);
            PG8_WAIT_L(8); PG8_BAR; PG8_WAIT_L(0); PG8_MMA(0, 0, At, B0); PG8_BAR; PG8_SCHED;
            PG8_LDB(B1, 1, 1); PG8_STAGE(PG8_SB(1, 0), b3, voffB);
            PG8_BAR; PG8_WAIT_L(0); PG8_MMA(0, 1, At, B1); PG8_BAR;
            PG8_LDA(At, 1, 1); PG8_STAGE(PG8_SA(1, 0), a3, voffA);
            PG8_BAR; PG8_WAIT_L(0); PG8_MMA(1, 0, At, B0); PG8_BAR; PG8_SCHED;
            PG8_STAGE(PG8_SB(1, 1), b3 + hstep, voffB);
            PG8_WAIT_V(6); PG8_BAR; PG8_MMA(1, 1, At, B1); PG8_BAR;
            }
        }
        if constexpr (ALIGN_EPI) { if (wr == 0) PG8_BAR; }
        if constexpr (!Epi::AFTER_DRAIN) { E(acc, cur, wr, wc, fr, fq); S.done(cur); }
        if (!has_next) break;
#pragma unroll
        for (int a = 0; a < 2; ++a)
#pragma unroll
            for (int b = 0; b < 2; ++b)
#pragma unroll
                for (int m = 0; m < 4; ++m)
#pragma unroll
                    for (int n = 0; n < 2; ++n) acc[a][b][m][n] = (f32x4){0.f, 0.f, 0.f, 0.f};
        cur = nxt; cA = nA; cB = nB; ++ui;
        if constexpr (ALIGN_EPI) { if (wr == 1) PG8_BAR; }
    }
    PG8_WAIT_V(0);
    if constexpr (!ALIGN_EPI) { if (wr == 0) PG8_BAR; }
    PG8_BAR;
    if constexpr (Epi::AFTER_DRAIN) { E.fused(acc, cur, wr, wc, fr, fq, lds, wid, lane); S.done(cur); }
#undef PG8_SA
#undef PG8_SB
#undef PG8_STAGE
#undef PG8_LDA
#undef PG8_LDB
#undef PG8_MMA
#undef PG8_WAIT_V
#undef PG8_WAIT_L
#undef PG8_BAR
#undef PG8_SCHED
}
}

using pg8::bf16_t; using pg8::bf16x8; using pg8::f32x4; using pg8::u32x4;
#define LAS __attribute__((address_space(3)))
typedef unsigned u32x2 __attribute__((ext_vector_type(2)));
constexpr int DM = 1024, NIN = 3584, DFF = 4096;
constexpr int TOK_P = 32768, TOK = 32896, TOKPAD = 33024;
constexpr float EPS = 1e-6f;
constexpr size_t WS_WIN = 16384;
constexpr size_t WS_WOUT = WS_WIN + (size_t)NIN * DM * 2;
constexpr size_t WS_WFF1 = WS_WOUT + (size_t)DM * DM * 2;
constexpr size_t WS_WDN = WS_WFF1 + (size_t)2 * DFF * DM * 2;
constexpr size_t WS_COS = WS_WDN + (size_t)DM * DFF * 2;
constexpr size_t WS_SIN = WS_COS + (size_t)4112 * 64 * 4;
constexpr size_t WS_SSQ1 = WS_SIN + (size_t)4112 * 64 * 4;
constexpr size_t WS_SSQ2 = WS_SSQ1 + (size_t)TOKPAD * 16 * 4;
constexpr size_t WS_UG = WS_SSQ2 + (size_t)TOKPAD * 16 * 4;
constexpr size_t WS_PS = WS_UG + (size_t)256 * 32768;
constexpr size_t WS_YS = WS_PS + (size_t)128 * NIN * 4;
constexpr size_t WS_FS = WS_YS + (size_t)4 * 128 * DM * 4;
constexpr size_t WS_RA = WS_FS + (size_t)4 * 128 * DM * 4;
constexpr size_t WS_RB = WS_RA + (size_t)TOKPAD * DM * 2;
constexpr size_t WS_Y = WS_RB + (size_t)TOKPAD * DFF * 2;
constexpr size_t WS_RS2 = WS_Y + (size_t)TOKPAD * DM * 2;
constexpr size_t WS_RS0 = WS_RS2 + (size_t)TOK_P * 4;
constexpr size_t WS_XB = WS_RS0 + (size_t)TOK_P * 4;
constexpr size_t WS_END = WS_XB + (size_t)TOK_P * DM * 2;
constexpr size_t O_SRP = (size_t)TOK * DM, O_CCP = O_SRP + 524288, O_CFP = O_CCP + 8192, O_SRS = O_CFP + 65536, O_CCS = O_SRS + 524288, O_CFS = O_CCS + 8192;
constexpr int LDS_HALO = 131072, LDS_BARW = 131072 + 8192, LDS_BYTES = LDS_BARW + 16;

struct Params { const float* in[17]; float* out; unsigned char* ws; };

__device__ __forceinline__ float dppf(float v, const int ctrl_sel) {
    const int iv = __builtin_bit_cast(int, v); int r;
    switch (ctrl_sel) { case 1: r = __builtin_amdgcn_update_dpp(0, iv, 0x111, 0xf, 0xf, true); break; case 2: r = __builtin_amdgcn_update_dpp(0, iv, 0x112, 0xf, 0xf, true); break;
        case 4: r = __builtin_amdgcn_update_dpp(0, iv, 0x114, 0xf, 0xf, true); break; case 8: r = __builtin_amdgcn_update_dpp(0, iv, 0x118, 0xf, 0xf, true); break;
        case 15: r = __builtin_amdgcn_update_dpp(0, iv, 0x142, 0xa, 0xf, false); break; default: r = __builtin_amdgcn_update_dpp(0, iv, 0x143, 0xc, 0xf, false); break; }
    return __builtin_bit_cast(float, r);
}
__device__ __forceinline__ float wave_sum(float v) {
    v += dppf(v, 1); v += dppf(v, 2); v += dppf(v, 4); v += dppf(v, 8); v += dppf(v, 15); v += dppf(v, 31);
    return __builtin_bit_cast(float, __builtin_amdgcn_readlane(__builtin_bit_cast(int, v), 63));
}
__device__ __forceinline__ float bf2f(unsigned short b) { return __uint_as_float(((unsigned)b) << 16); }
__device__ __forceinline__ unsigned pk2(float a, float b) { return pg8::cvt_pk_bf16(a, b); }
__device__ __forceinline__ unsigned pk2s(float a, float b) { unsigned r; asm("v_cvt_pk_bf16_f32 %0, %1, %2" : "=v"(r) : "v"(a), "v"(b)); return r; }
__device__ __forceinline__ float silu_f(float g) { return g * __builtin_amdgcn_rcpf(1.0f + __builtin_amdgcn_exp2f(-1.4426950408889634f * g)); }
__device__ __forceinline__ int dmap(int P) { return ((P >> 2) & 1) * 64 + (P >> 3) * 4 + (P & 3); }
__device__ __forceinline__ int pmap(int d) { return ((d >> 4) & 3) * 32 + ((d >> 2) & 3) * 8 + ((d >> 6) & 1) * 4 + (d & 3); }

constexpr int RB = 6;
__device__ __forceinline__ f32x4 unpack_bf4(const u32x2 w) { f32x4 v; v[0] = __uint_as_float(w.x << 16); v[1] = __uint_as_float(w.x & 0xffff0000u); v[2] = __uint_as_float(w.y << 16); v[3] = __uint_as_float(w.y & 0xffff0000u); return v; }
__device__ __forceinline__ float sumsq4(const f32x4 a) { return (a[0] * a[0] + a[1] * a[1]) + (a[2] * a[2] + a[3] * a[3]); }
template <int MODE> __device__ __forceinline__ int rowmap(int c) {
    if (MODE == 0) { if (c < 1024) return (c & ~127) + pmap(c & 127);
        if (c >= 2560) { const int cc = (c - 2560) & 511, hcsel = (c >= 3072) ? 128 : 0; return 2560 + ((cc >> 7) << 8) + hcsel + (cc & 127); }
        return c; }
    if (MODE == 1) return c;
    if (MODE == 2) return ((c >> 7) << 8) + (c & 127);
    return ((c >> 7) << 8) + 128 + (c & 127);
}
template <int MODE, bool GAIN = false>
__device__ __forceinline__ void transpose_item(const float* W, int K, int N, bf16_t* WT, LAS float* scr, int item, int lane, const float* gain = nullptr) {
    const int nblk = N / 32, kb = item / nblk, nb = item % nblk, k0 = 64 * kb, n0 = 32 * nb;
#pragma unroll
    for (int i = 0; i < 32; ++i) { const int kk = 2 * i + (lane >> 5); scr[kk * 33 + (lane & 31)] = W[(size_t)(k0 + kk) * N + n0 + (lane & 31)]; }
    asm volatile("s_waitcnt lgkmcnt(0)" ::: "memory");
    const int c = lane & 7;
    f32x4 ga = (f32x4){1.f, 1.f, 1.f, 1.f}, gb = ga;
    if (GAIN) { ga = *(const f32x4*)(gain + k0 + 8 * c); gb = *(const f32x4*)(gain + k0 + 8 * c + 4); }
#pragma unroll
    for (int j = 0; j < 4; ++j) { const int n = (lane >> 3) + 8 * j; const LAS float* s = scr + (8 * c) * 33 + n;
        u32x4 o; o.x = pk2(s[0 * 33] * ga[0], s[1 * 33] * ga[1]); o.y = pk2(s[2 * 33] * ga[2], s[3 * 33] * ga[3]); o.z = pk2(s[4 * 33] * gb[0], s[5 * 33] * gb[1]); o.w = pk2(s[6 * 33] * gb[2], s[7 * 33] * gb[3]);
        *(u32x4*)(WT + (size_t)rowmap<MODE>(n0 + n) * K + k0 + 8 * c) = o; }
    asm volatile("s_waitcnt lgkmcnt(0)" ::: "memory");
}
__device__ __forceinline__ void phase0(const Params& p, LAS unsigned char* lds, int tid, int wid, int lane) {
    LAS float* scr = (LAS float*)(lds + wid * 8448);
    const int gw = blockIdx.x * 8 + wid, NGW = gridDim.x * 8;
    bf16_t* win = (bf16_t*)(p.ws + WS_WIN); bf16_t* wout = (bf16_t*)(p.ws + WS_WOUT); bf16_t* wff1 = (bf16_t*)(p.ws + WS_WFF1); bf16_t* wdn = (bf16_t*)(p.ws + WS_WDN);
    constexpr int I_IN = 16 * 112, I_OUT = 16 * 32, I_UP = 16 * 128, I_DN = 64 * 32, NITEMS = I_IN + I_OUT + 2 * I_UP + I_DN;
    for (int it = gw; it < NITEMS; it += NGW) {
        int r = it;
        if (r < I_IN) { transpose_item<0, true>(p.in[5], DM, NIN, win, scr, r, lane, p.in[9]); continue; } r -= I_IN;
        if (r < I_OUT) { transpose_item<1>(p.in[6], DM, DM, wout, scr, r, lane); continue; } r -= I_OUT;
        if (r < I_UP) { transpose_item<2, true>(p.in[13], DM, DFF, wff1, scr, r, lane, p.in[11]); continue; } r -= I_UP;
        if (r < I_UP) { transpose_item<3, true>(p.in[14], DM, DFF, wff1, scr, r, lane, p.in[11]); continue; } r -= I_UP;
        transpose_item<1>(p.in[16], DFF, DM, wdn, scr, r, lane);
    }
    float* cosT = (float*)(p.ws + WS_COS); float* sinT = (float*)(p.ws + WS_SIN);
    for (int idx = blockIdx.x * 512 + tid; idx < 4112 * 64; idx += gridDim.x * 512) {
        const int pos = idx >> 6, f = idx & 63;
        const float inv = exp2f(-(float)(2 * f) * (1.0f / 128.0f) * 13.287712379549449f);
        const float ang = (float)pos * inv;
        const double rev = (double)ang * 0.15915494309189535;
        const float fr = (float)(rev - floor(rev));
        cosT[idx] = __builtin_amdgcn_cosf(fr); sinT[idx] = __builtin_amdgcn_sinf(fr);
    }
    bf16_t* H = (bf16_t*)(p.ws + WS_RA); bf16_t* XB = (bf16_t*)(p.ws + WS_XB); float* RS0 = (float*)(p.ws + WS_RS0);
#pragma unroll 1
    for (int base = gw; base < TOK; base += RB * NGW) {
        f32x4 v[RB][4]; float s[RB];
#pragma unroll
        for (int k = 0; k < RB; ++k) { const int rr = min(base + k * NGW, TOK - 1);
            const float* xrow = rr < TOK_P ? p.in[0] + (size_t)rr * DM : p.in[1] + (size_t)(rr - TOK_P) * DM; s[k] = 0.f;
#pragma unroll
            for (int j = 0; j < 4; ++j) { v[k][j] = __builtin_nontemporal_load((const f32x4*)xrow + lane + 64 * j); s[k] += sumsq4(v[k][j]); } }
#pragma unroll
        for (int k = 0; k < RB; ++k) { const int r = base + k * NGW; const float rstd = rsqrtf(wave_sum(s[k]) * (1.0f / DM) + EPS);
            if (r < TOK_P) {
                if (lane == 0) RS0[r] = __builtin_amdgcn_rcpf(rstd);
#pragma unroll
                for (int j = 0; j < 4; ++j) { const f32x4 y = v[k][j] * rstd; *((u32x2*)(XB + (size_t)r * DM) + lane + 64 * j) = (u32x2){pk2(y[0], y[1]), pk2(y[2], y[3])}; }
            } else if (r < TOK) {
#pragma unroll
                for (int j = 0; j < 4; ++j) { const f32x4 y = v[k][j] * rstd; *((u32x2*)(H + (size_t)r * DM) + lane + 64 * j) = (u32x2){pk2(y[0], y[1]), pk2(y[2], y[3])}; } } }
    }
}

constexpr int QI_OFF = 0, KI_OFF = 17408, KT_OFF = 34816, VT_OFF = 53248, SI_OFF = 71680, ST_OFF = 80896, GI_OFF = 115712;
#define MFMA16(a, b, c) __builtin_amdgcn_mfma_f32_16x16x32_bf16((a), (b), (c), 0, 0, 0)
#define RET_ISSUE(S, nn) do { _Pragma("unroll") for (int i_ = 0; i_ < 2; ++i_) { \
        const bf16_t* rowp_ = P + (tok0 + (size_t)(nn) * 64 + 2 * (tid >> 4) + i_) * NIN + 128 * h + (tid & 15) * 8; \
        if (FULL) { rq[S][i_] = *(const u32x4*)rowp_; rg[S][i_] = *(const u32x4*)(rowp_ + 1536); } rk[S][i_] = *(const u32x4*)(rowp_ + 512); rv[S][i_] = *(const u32x4*)(rowp_ + 1024); } } while (0)
#define RET_STAGE_A(S) do { const int j_ = 2 * (tid >> 4), ch_ = tid & 15; \
        if (FULL) { _Pragma("unroll") for (int i_ = 0; i_ < 2; ++i_) { *(LAS u32x4*)(lds + QI_OFF + (j_ + i_) * 272 + ch_ * 16) = rq[S][i_]; *(LAS u32x4*)(lds + KI_OFF + (j_ + i_) * 272 + ch_ * 16) = rk[S][i_]; *(LAS u32x4*)(lds + GI_OFF + (j_ + i_) * 272 + ch_ * 16) = rg[S][i_]; } } \
        const float te0_ = __builtin_amdgcn_exp2f(l2g * (float)(63 - j_)), te1_ = __builtin_amdgcn_exp2f(l2g * (float)(62 - j_)); \
        const unsigned ka_[4] = {rk[S][0].x, rk[S][0].y, rk[S][0].z, rk[S][0].w}, kb_[4] = {rk[S][1].x, rk[S][1].y, rk[S][1].z, rk[S][1].w}; \
        const unsigned va_[4] = {rv[S][0].x, rv[S][0].y, rv[S][0].z, rv[S][0].w}, vb_[4] = {rv[S][1].x, rv[S][1].y, rv[S][1].z, rv[S][1].w}; \
        const int cofs_ = 16 * ((j_ >> 3) ^ (ch_ & 7)) + 2 * (j_ & 7); \
        _Pragma("unroll") for (int e2 = 0; e2 < 4; ++e2) { const int row_ = 8 * ch_ + 2 * e2; \
            *(LAS unsigned*)(lds + KT_OFF + row_ * 144 + cofs_) = pk2(__uint_as_float(ka_[e2] << 16) * te0_, __uint_as_float(kb_[e2] << 16) * te1_); \
            *(LAS unsigned*)(lds + KT_OFF + (row_ + 1) * 144 + cofs_) = pk2(__uint_as_float(ka_[e2] & 0xffff0000u) * te0_, __uint_as_float(kb_[e2] & 0xffff0000u) * te1_); \
            *(LAS unsigned*)(lds + VT_OFF + row_ * 144 + cofs_) = (va_[e2] & 0xffffu) | (vb_[e2] << 16); \
            *(LAS unsigned*)(lds + VT_OFF + (row_ + 1) * 144 + cofs_) = (va_[e2] >> 16) | (vb_[e2] & 0xffff0000u); } } while (0)
#define WG_BAR() do { asm volatile("s_waitcnt lgkmcnt(0)" ::: "memory"); __builtin_amdgcn_s_barrier(); asm volatile("" ::: "memory"); } while (0)
template <bool FULL>
__device__ __forceinline__ void ret_unit(const Params& p, LAS unsigned char* lds, int unit, int tid, int wid, int lane) {
    asm volatile("" : "+v"(tid), "+v"(lane));
    const int G = unit & 7, h = (unit >> 3) & 3, b = unit >> 5;
    const bf16_t* P = (const bf16_t*)(p.ws + WS_RB);
    bf16_t* MIX = (bf16_t*)(p.ws + WS_RA);
    float* UG = (float*)(p.ws + WS_UG);
    const size_t tok0 = (size_t)b * 4096 + (size_t)G * 512;
    const float l2g = log2f(1.0f - exp2f(-5.0f - (float)h));
    const float g64 = __builtin_amdgcn_exp2f(l2g * 64.0f);
    const bool is_state = wid >= 4; const int w4 = wid & 3;
    const int l15 = lane & 15, l4 = lane >> 4;
    const int vtL = l4 ^ (l15 >> 3);
    const int vtb0 = VT_OFF + l15 * 144 + 16 * vtL, vtb1 = VT_OFF + l15 * 144 + 16 * (vtL ^ 2);
#define VT_ADDR(nt, ks) ((((nt) & 1) ? vtb1 : vtb0) + (nt) * 2304 + 16 * (((4 * (ks)) ^ (2 * ((nt) & 3))) & 4))
    constexpr int PD = FULL ? 1 : 4;
    u32x4 rq[PD][2], rk[PD][2], rv[PD][2], rg[PD][2];
    if (is_state) {
        f32x4 st[2][8];
#pragma unroll
        for (int mt = 0; mt < 2; ++mt)
#pragma unroll
            for (int nt = 0; nt < 8; ++nt) st[mt][nt] = (f32x4){0.f, 0.f, 0.f, 0.f};
        if (FULL) {
#pragma unroll 1
            for (int Gp = 0; Gp < G; Gp += 2) {
                const float wa = __builtin_amdgcn_exp2f(l2g * 512.0f * (float)(G - 1 - Gp));
                const bool two = Gp + 1 < G;
                const float wb = two ? __builtin_amdgcn_exp2f(l2g * 512.0f * (float)(G - 2 - Gp)) : 0.f;
                const u32x2* sa = (const u32x2*)UG + ((size_t)((b * 4 + h) * 8 + Gp) * 4 + w4) * 1024 + lane;
                const u32x2* sb = two ? sa + 4 * 1024 : sa;
#pragma unroll
                for (int mt = 0; mt < 2; ++mt)
#pragma unroll
                    for (int nt = 0; nt < 8; ++nt) st[mt][nt] += unpack_bf4(sa[(mt * 8 + nt) * 64]) * wa + unpack_bf4(sb[(mt * 8 + nt) * 64]) * wb;
            }
        }
#pragma unroll
        for (int s = 0; s < PD; ++s) RET_ISSUE(s, s);
#pragma unroll 1
        for (int n0 = 0; n0 < 8; n0 += PD) {
#pragma unroll
          for (int s = 0; s < PD; ++s) { const int n = n0 + s;
            RET_STAGE_A(s);
            if (n + PD < 8) RET_ISSUE(s, n + PD);
            if (FULL) {
#pragma unroll
                for (int mt = 0; mt < 2; ++mt)
#pragma unroll
                    for (int nt = 0; nt < 8; ++nt) { const int e = 16 * nt + l15, dk0 = 32 * w4 + 16 * mt + 4 * l4;
                        *(LAS u32x2*)(lds + ST_OFF + e * 272 + dk0 * 2) = (u32x2){pk2(st[mt][nt][0], st[mt][nt][1]), pk2(st[mt][nt][2], st[mt][nt][3])}; }
            }
            WG_BAR();
            if (FULL) {
                bf16x8 ak[4];
#pragma unroll
                for (int ks = 0; ks < 4; ++ks) ak[ks] = *(const LAS bf16x8*)(lds + KI_OFF + (16 * w4 + l15) * 272 + (32 * ks + 8 * l4) * 2);
#pragma unroll
                for (int it = 0; it < 4; ++it) {
                    bf16x8 bq[4];
#pragma unroll
                    for (int ks = 0; ks < 4; ++ks) bq[ks] = *(const LAS bf16x8*)(lds + QI_OFF + (16 * it + l15) * 272 + (32 * ks + 8 * l4) * 2);
                    f32x4 sa = (f32x4){0.f, 0.f, 0.f, 0.f};
#pragma unroll
                    for (int ks = 0; ks < 4; ++ks) sa = MFMA16(ak[ks], bq[ks], sa);
                    const int i = 16 * it + l15, j0 = 16 * w4 + 4 * l4;
#pragma unroll
                    for (int r = 0; r < 4; ++r) { const int d = i - (j0 + r); sa[r] *= __builtin_amdgcn_exp2f(l2g * (float)(d < 0 ? -d : d)); }
                    *(LAS u32x2*)(lds + SI_OFF + i * 144 + j0 * 2) = (u32x2){pk2(sa[0], sa[1]), pk2(sa[2], sa[3])};
                }
            }
            WG_BAR();
#pragma unroll
            for (int mt = 0; mt < 2; ++mt)
#pragma unroll
                for (int nt = 0; nt < 8; ++nt) st[mt][nt] = st[mt][nt] * g64;
#pragma unroll
            for (int ks = 0; ks < 2; ++ks) {
                bf16x8 akt[2];
#pragma unroll
                for (int mt = 0; mt < 2; ++mt) { const int row = 32 * w4 + 16 * mt + l15; akt[mt] = *(const LAS bf16x8*)(lds + KT_OFF + row * 144 + 16 * ((4 * ks + l4) ^ ((row >> 3) & 7))); }
#pragma unroll
                for (int nh = 0; nh < 2; ++nh) {
                    bf16x8 bv[4];
#pragma unroll
                    for (int nt = 0; nt < 4; ++nt) bv[nt] = *(const LAS bf16x8*)(lds + VT_ADDR(4 * nh + nt, ks));
#pragma unroll
                    for (int nt = 0; nt < 4; ++nt)
#pragma unroll
                        for (int mt = 0; mt < 2; ++mt) st[mt][4 * nh + nt] = MFMA16(akt[mt], bv[nt], st[mt][4 * nh + nt]);
                }
            }
            WG_BAR();
          }
        }
        if (!FULL) {
            u32x2* dst = (u32x2*)UG + ((size_t)unit * 4 + w4) * 1024 + lane;
#pragma unroll
            for (int mt = 0; mt < 2; ++mt)
#pragma unroll
                for (int nt = 0; nt < 8; ++nt) dst[(mt * 8 + nt) * 64] = (u32x2){pk2(st[mt][nt][0], st[mt][nt][1]), pk2(st[mt][nt][2], st[mt][nt][3])};
        } else if (G == 7) {
            float* o = p.out + O_SRP + (size_t)(b * 4 + h) * 16384 + (64 * (l4 & 1) + 16 * w4 + 4 * (l4 >> 1)) * 128 + l15;
#pragma unroll
            for (int mt = 0; mt < 2; ++mt)
#pragma unroll
                for (int nt = 0; nt < 8; ++nt)
#pragma unroll
                    for (int r = 0; r < 4; ++r) o[(8 * mt + r) * 128 + 16 * nt] = st[mt][nt][r];
        }
    } else {
        float rwv[8];
#pragma unroll
        for (int nt = 0; nt < 8; ++nt) rwv[nt] = p.in[8][128 * h + 16 * nt + l15];
#pragma unroll
        for (int s = 0; s < PD; ++s) RET_ISSUE(s, s);
#pragma unroll 1
        for (int n0 = 0; n0 < 8; n0 += PD) {
#pragma unroll
          for (int s = 0; s < PD; ++s) { const int n = n0 + s;
            RET_STAGE_A(s);
            if (n + PD < 8) RET_ISSUE(s, n + PD);
            WG_BAR();
            f32x4 acc[8];
            if (FULL) {
                f32x4 fsv;
#pragma unroll
                for (int r = 0; r < 4; ++r) fsv[r] = __builtin_amdgcn_exp2f(l2g * (float)(16 * w4 + 4 * l4 + r + 1));
#pragma unroll
                for (int nt = 0; nt < 8; ++nt) acc[nt] = (f32x4){0.f, 0.f, 0.f, 0.f};
                bf16x8 aq[4];
#pragma unroll
                for (int ks = 0; ks < 4; ++ks) aq[ks] = *(const LAS bf16x8*)(lds + QI_OFF + (16 * w4 + l15) * 272 + (32 * ks + 8 * l4) * 2);
#pragma unroll
                for (int ks = 0; ks < 4; ++ks)
#pragma unroll
                    for (int nh = 0; nh < 2; ++nh) {
                        bf16x8 bs[4];
#pragma unroll
                        for (int nt = 0; nt < 4; ++nt) bs[nt] = *(const LAS bf16x8*)(lds + ST_OFF + (16 * (4 * nh + nt) + l15) * 272 + (32 * ks + 8 * l4) * 2);
#pragma unroll
                        for (int nt = 0; nt < 4; ++nt) acc[4 * nh + nt] = MFMA16(aq[ks], bs[nt], acc[4 * nh + nt]);
                    }
#pragma unroll
                for (int nt = 0; nt < 8; ++nt) acc[nt] = acc[nt] * fsv;
            }
            WG_BAR();
            if (FULL) {
                bf16x8 as_[2];
#pragma unroll
                for (int ks = 0; ks < 2; ++ks) as_[ks] = *(const LAS bf16x8*)(lds + SI_OFF + (16 * w4 + l15) * 144 + 16 * (4 * ks + l4));
#pragma unroll
                for (int ks = 0; ks < 2; ++ks)
#pragma unroll
                    for (int nh = 0; nh < 2; ++nh) {
                        bf16x8 bv[4];
#pragma unroll
                        for (int nt = 0; nt < 4; ++nt) bv[nt] = *(const LAS bf16x8*)(lds + VT_ADDR(4 * nh + nt, ks));
#pragma unroll
                        for (int nt = 0; nt < 4; ++nt) acc[4 * nh + nt] = MFMA16(as_[ks], bv[nt], acc[4 * nh + nt]);
                    }
                unsigned short gq[4][8];
#pragma unroll
                for (int r = 0; r < 4; ++r)
#pragma unroll
                    for (int nt = 0; nt < 8; ++nt) gq[r][nt] = *(const LAS unsigned short*)(lds + GI_OFF + (16 * w4 + 4 * l4 + r) * 272 + (16 * nt + l15) * 2);
                float rstd[4];
#pragma unroll
                for (int r = 0; r < 4; ++r) { float ss = 0.f;
#pragma unroll
                    for (int nt = 0; nt < 8; ++nt) ss += acc[nt][r] * acc[nt][r];
                    ss += dppf(ss, 1); ss += dppf(ss, 2); ss += dppf(ss, 4); ss += dppf(ss, 8);
                    ss = __shfl(ss, (lane & 48) | 15);
                    rstd[r] = rsqrtf(ss * (1.0f / 128.0f) + EPS); }
#pragma unroll
                for (int r = 0; r < 4; ++r)
#pragma unroll
                    for (int nt = 0; nt < 8; ++nt)
                        *(LAS unsigned short*)(lds + QI_OFF + (16 * w4 + 4 * l4 + r) * 272 + (16 * nt + l15) * 2) = (unsigned short)(pk2s(acc[nt][r] * rstd[r] * rwv[nt] * silu_f(bf2f(gq[r][nt])), 0.f) & 0xffffu);
#pragma unroll
                for (int q = 0; q < 4; ++q) { const int cidx = lane + 64 * q, row = 16 * w4 + (cidx >> 4), ch = cidx & 15;
                    const u32x4 v = *(const LAS u32x4*)(lds + QI_OFF + row * 272 + ch * 16);
                    *(u32x4*)(MIX + (tok0 + (size_t)n * 64 + row) * DM + 128 * h + ch * 8) = v; }
            }
            WG_BAR();
          }
        }
    }
#ifndef CONVREP
#define CONVREP 1
#endif
    if (FULL) for (int crep_ = 0; crep_ < CONVREP; ++crep_) {
        const int c0 = 128 * h + 8 * (tid & 15), run = tid >> 4, t0 = G * 512 + run * 16;
        const float* cwp = p.in[7];
        float w0[8], w1[8], w2[8], p1[8], p2[8];
#pragma unroll
        for (int e = 0; e < 8; ++e) { w0[e] = cwp[c0 + e]; w1[e] = cwp[512 + c0 + e]; w2[e] = cwp[1024 + c0 + e]; p1[e] = 0.f; p2[e] = 0.f; }
        if (t0 > 0) {
            const bf16_t* r2 = P + ((size_t)b * 4096 + t0 - 2) * NIN; const bf16_t* r1 = r2 + NIN;
            const u32x4 c2 = *(const u32x4*)(r2 + 2560 + c0), c1 = *(const u32x4*)(r1 + 2560 + c0);
            const unsigned c2w[4] = {c2.x, c2.y, c2.z, c2.w}, c1w[4] = {c1.x, c1.y, c1.z, c1.w};
#pragma unroll
            for (int e = 0; e < 4; ++e) {
                p2[2 * e] = __uint_as_float(c2w[e] << 16); p2[2 * e + 1] = __uint_as_float(c2w[e] & 0xffff0000u);
                p1[2 * e] = __uint_as_float(c1w[e] << 16); p1[2 * e + 1] = __uint_as_float(c1w[e] & 0xffff0000u); }
        }
#pragma unroll 8
        for (int t = 0; t < 16; ++t) {
            const size_t row = (size_t)b * 4096 + t0 + t;
            const bf16_t* rp = P + row * NIN;
            const u32x4 bb = *(const u32x4*)(rp + 2048 + c0), cc = *(const u32x4*)(rp + 2560 + c0);
            const unsigned bw[4] = {bb.x, bb.y, bb.z, bb.w}, cw4[4] = {cc.x, cc.y, cc.z, cc.w};
            float y[8];
#pragma unroll
            for (int e = 0; e < 4; ++e) {
                const float ca = __uint_as_float(cw4[e] << 16), cb = __uint_as_float(cw4[e] & 0xffff0000u);
                y[2 * e] = __uint_as_float(bw[e] << 16) * (w0[2 * e] * p2[2 * e] + w1[2 * e] * p1[2 * e] + w2[2 * e] * ca);
                y[2 * e + 1] = __uint_as_float(bw[e] & 0xffff0000u) * (w0[2 * e + 1] * p2[2 * e + 1] + w1[2 * e + 1] * p1[2 * e + 1] + w2[2 * e + 1] * cb);
                p2[2 * e] = p1[2 * e]; p2[2 * e + 1] = p1[2 * e + 1]; p1[2 * e] = ca; p1[2 * e + 1] = cb;
            }
            *(u32x4*)(MIX + row * DM + 512 + c0) = (u32x4){pk2(y[0], y[1]), pk2(y[2], y[3]), pk2(y[4], y[5]), pk2(y[6], y[7])};
        }
        if (G == 7 && run == 31) {
            float* o = p.out + O_CCP + (size_t)b * 1024 + c0;
#pragma unroll
            for (int e = 0; e < 8; ++e) { o[e] = p2[e]; o[512 + e] = p1[e]; }
        }
    }
#undef VT_ADDR
}

__device__ __forceinline__ float ch_at(const float* PS, const float* cache, int b, int t, int ch) {
    if (t < 0) return cache[(b * 2 + (t + 2)) * 512 + ch];
    const float* rp = PS + (size_t)(16 * b + t) * NIN;
    const int cc = 2560 + ((ch >> 7) << 8) + (ch & 127);
    return rp[cc] * rp[cc + 128];
}
__device__ __forceinline__ void sample_unit(const Params& p, LAS unsigned char* lds, int sup, int tid, int wid, int lane) {
    const int su = sup >> 2, part = sup & 3;
    const int b = su >> 2, h = su & 3, ts0 = TOK_P + 16 * b;
    const float* PS = (const float*)(p.ws + WS_PS);
    bf16_t* MIX = (bf16_t*)(p.ws + WS_RA);
    LAS float* qs = (LAS float*)lds; LAS float* ks = qs + 2048; LAS float* vs = qs + 4096; LAS float* Ssm = qs + 6144; LAS float* osm = qs + 6400;
    const float l2g = log2f(1.0f - exp2f(-5.0f - (float)h));
    const float* cosT = (const float*)(p.ws + WS_COS); const float* sinT = (const float*)(p.ws + WS_SIN);
    for (int idx = tid; idx < 2048; idx += 512) { const int i = idx >> 7, c = idx & 127, d = dmap(c);
        const float* rp = PS + (size_t)(16 * b + i) * NIN + 128 * h;
        const float cs = cosT[(4096 + i) * 64 + (d & 63)], sn = sinT[(4096 + i) * 64 + (d & 63)];
        const float xq = rp[c], xqp = rp[c ^ 4], xk = rp[512 + c], xkp = rp[512 + (c ^ 4)];
        qs[i * 128 + d] = d < 64 ? xq * cs - xqp * sn : xq * cs + xqp * sn;
        ks[i * 128 + d] = (d < 64 ? xk * cs - xkp * sn : xk * cs + xkp * sn) * 0.08838834764831845f;
        vs[i * 128 + c] = rp[1024 + c]; }
    const int e = tid & 127, sub = tid >> 7, irow = 4 * part + sub;
    LAS float* s0 = qs + 8704;
    { const float* s0g = p.in[2] + (size_t)su * 16384; f32x4 t8[8];
#pragma unroll
      for (int q = 0; q < 8; ++q) t8[q] = *((const f32x4*)s0g + tid + 512 * q);
#pragma unroll
      for (int q = 0; q < 8; ++q) *((LAS f32x4*)s0 + tid + 512 * q) = t8[q]; }
    __syncthreads();
    if (tid < 64) { const int i = 4 * part + (tid >> 4), j = tid & 15; float s = 0.f;
        for (int d = 0; d < 128; ++d) s += qs[i * 128 + d] * ks[j * 128 + d];
        const int dd = i - j; Ssm[i * 16 + j] = s * __builtin_amdgcn_exp2f(l2g * (float)(dd < 0 ? -dd : dd)); }
    float cr = 0.f;
#pragma unroll 8
    for (int d = 0; d < 128; ++d) cr += qs[irow * 128 + d] * s0[d * 128 + e];
    __syncthreads();
    { float o = 0.f;
      for (int j = 0; j < 16; ++j) o += Ssm[irow * 16 + j] * vs[j * 128 + e];
      osm[irow * 128 + e] = o + __builtin_amdgcn_exp2f(l2g * (float)(irow + 1)) * cr; }
    __syncthreads();
    if (wid < 4) { const int i = 4 * part + wid; const float v0 = osm[i * 128 + lane], v1 = osm[i * 128 + 64 + lane];
        const float rstd = rsqrtf(wave_sum(v0 * v0 + v1 * v1) * (1.0f / 128.0f) + EPS);
        const size_t token = (size_t)(ts0 + i);
        const float g0 = PS[(size_t)(16 * b + i) * NIN + 1536 + 128 * h + lane], g1 = PS[(size_t)(16 * b + i) * NIN + 1536 + 128 * h + 64 + lane];
        MIX[token * DM + 128 * h + lane] = (bf16_t)(pk2(v0 * rstd * p.in[8][128 * h + lane] * silu_f(g0), 0.f) & 0xffffu);
        MIX[token * DM + 128 * h + 64 + lane] = (bf16_t)(pk2(v1 * rstd * p.in[8][128 * h + 64 + lane] * silu_f(g1), 0.f) & 0xffffu); }
    const float g16 = __builtin_amdgcn_exp2f(l2g * 16.0f);
    float* outS = p.out + O_SRS + (size_t)su * 16384;
#pragma unroll 2
    for (int dd = 0; dd < 8; ++dd) { const int d = 32 * part + sub + 4 * dd; float a = g16 * s0[d * 128 + e];
        for (int j = 0; j < 16; ++j) a += __builtin_amdgcn_exp2f(l2g * (float)(15 - j)) * ks[j * 128 + d] * vs[j * 128 + e];
        outS[d * 128 + e] = a; }
    { const int ch = 128 * h + e; const float* cache = p.in[3]; const float* cwp = p.in[7];
      const float w0 = cwp[ch], w1 = cwp[512 + ch], w2 = cwp[1024 + ch];
      const int t = irow;
      const float c0 = ch_at(PS, cache, b, t - 2, ch), c1 = ch_at(PS, cache, b, t - 1, ch), c2 = ch_at(PS, cache, b, t, ch);
      const float y = PS[(size_t)(16 * b + t) * NIN + 2048 + ch] * (w0 * c0 + w1 * c1 + w2 * c2);
      MIX[(size_t)(ts0 + t) * DM + 512 + ch] = (bf16_t)(pk2(y, 0.f) & 0xffffu);
      if (t >= 14) p.out[O_CCS + (size_t)(b * 2 + t - 14) * 512 + ch] = c2; }
    __syncthreads();
}

constexpr int TG_B = 34816, TG_BUF = 34816 + 32 * 272;
template <int NB>
__device__ __forceinline__ void thin_gemm2(LAS unsigned char* lds, const bf16_t* A, int lda, const bf16_t* Bt, int ldb, int n0, int nbstride, int kbeg, int klen, f32x4 (&acc)[NB], int tid, int wid, int lane) {
    const int l15 = lane & 15, l4 = lane >> 4, nkb = klen >> 7;
    const bool hasb = tid < NB * 256;
    const bf16_t* ag = A + (size_t)(tid >> 4) * lda + kbeg + (tid & 15) * 8;
    const bf16_t* bg = Bt + (size_t)(n0 + (tid >> 8) * nbstride + ((tid >> 4) & 15)) * ldb + kbeg + (tid & 15) * 8;
    const int sto = (tid >> 4) * 272 + (tid & 15) * 16;
    const int fro = l15 * 272 + (8 * l4) * 2;
    u32x4 Xa[4], Ya[4], Xb = (u32x4){0u, 0u, 0u, 0u}, Yb = Xb;
#define TG_LOAD(R, kb) do { _Pragma("unroll") for (int i_ = 0; i_ < 4; ++i_) R##a[i_] = *(const u32x4*)(ag + (size_t)(32 * i_) * lda + (kb) * 128); if (hasb) R##b = *(const u32x4*)(bg + (kb) * 128); } while (0)
#define TG_STORE(R, buf) do { _Pragma("unroll") for (int i_ = 0; i_ < 4; ++i_) *(LAS u32x4*)(lds + (buf) * TG_BUF + sto + i_ * 32 * 272) = R##a[i_]; if (hasb) *(LAS u32x4*)(lds + (buf) * TG_BUF + TG_B + sto) = R##b; } while (0)
#define TG_COMP(buf) do { _Pragma("unroll") for (int ks = 0; ks < 4; ++ks) { const bf16x8 a_ = *(const LAS bf16x8*)(lds + (buf) * TG_BUF + 16 * wid * 272 + fro + ks * 64); \
        _Pragma("unroll") for (int nb = 0; nb < NB; ++nb) { const bf16x8 b_ = *(const LAS bf16x8*)(lds + (buf) * TG_BUF + TG_B + 16 * nb * 272 + fro + ks * 64); acc[nb] = MFMA16(a_, b_, acc[nb]); } } } while (0)
#pragma unroll
    for (int nb = 0; nb < NB; ++nb) acc[nb] = (f32x4){0.f, 0.f, 0.f, 0.f};
    TG_LOAD(X, 0); TG_LOAD(Y, 1);
    TG_STORE(X, 0); WG_BAR();
#pragma unroll 1
    for (int kb = 0; kb < nkb; kb += 2) {
        if (kb + 2 < nkb) TG_LOAD(X, kb + 2);
        TG_COMP(0);
        TG_STORE(Y, 1); WG_BAR();
        if (kb + 3 < nkb) TG_LOAD(Y, kb + 3);
        TG_COMP(1);
        if (kb + 2 < nkb) TG_STORE(X, 0);
        WG_BAR();
    }
#undef TG_LOAD
#undef TG_STORE
#undef TG_COMP
}
template <int NB>
__device__ __forceinline__ void thin_gemm(const bf16_t* A, int lda, const bf16_t* Bt, int ldb, int n0, int nbstride, int kbeg, int klen, f32x4 (&acc)[NB], int wid, int lane) {
    const int l15 = lane & 15, l4 = lane >> 4;
    const bf16_t* ap = A + (size_t)(16 * wid + l15) * lda + kbeg + 8 * l4;
    const bf16_t* bp = Bt + (size_t)(n0 + l15) * ldb + kbeg + 8 * l4;
#pragma unroll
    for (int nb = 0; nb < NB; ++nb) acc[nb] = (f32x4){0.f, 0.f, 0.f, 0.f};
#pragma unroll 1
    for (int s0 = 0; s0 < klen; s0 += 256) {
        bf16x8 a[8], b[NB][8];
#pragma unroll
        for (int s = 0; s < 8; ++s) { a[s] = *(const bf16x8*)(ap + s0 + 32 * s);
#pragma unroll
            for (int nb = 0; nb < NB; ++nb) b[nb][s] = *(const bf16x8*)(bp + (size_t)nb * nbstride * ldb + s0 + 32 * s); }
#pragma unroll
        for (int s = 0; s < 8; ++s)
#pragma unroll
            for (int nb = 0; nb < NB; ++nb) acc[nb] = MFMA16(a[s], b[nb][s], acc[nb]);
    }
}
__device__ __forceinline__ void thin_store(const f32x4& acc, float* out, int ldo, int col, int wid, int lane) {
#pragma unroll
    for (int r = 0; r < 4; ++r) out[(size_t)(16 * wid + 4 * (lane >> 4) + r) * ldo + col + (lane & 15)] = acc[r];
}
__device__ __forceinline__ void thin_ffn1(const Params& p, LAS unsigned char* lds, int c, int tid, int wid, int lane) {
    const int pn = c >> 3, j16 = c & 7, l15 = lane & 15, l4 = lane >> 4;
    f32x4 acc[2];
    thin_gemm2<2>(lds, (const bf16_t*)(p.ws + WS_Y) + (size_t)TOK_P * DM, DM, (const bf16_t*)(p.ws + WS_WFF1), DM, 256 * pn + 16 * j16, 128, 0, DM, acc, tid, wid, lane);
    const int ch = 128 * pn + 16 * j16 + l15, b = wid;
    const float* cw = p.in[15]; const float* cache = p.in[4] + (size_t)b * 2 * DFF + ch;
    const float w0 = cw[ch], w1 = cw[DFF + ch], w2 = cw[2 * DFF + ch];
    const f32x4 up = acc[0], gt = acc[1];
    float pm1 = __shfl_up(up[3], 16), pm2 = __shfl_up(up[2], 16);
    if (l4 == 0) { pm1 = cache[DFF]; pm2 = cache[0]; }
    float uc[4];
    uc[0] = w0 * pm2 + w1 * pm1 + w2 * up[0];
    uc[1] = w0 * pm1 + w1 * up[0] + w2 * up[1];
    uc[2] = w0 * up[0] + w1 * up[1] + w2 * up[2];
    uc[3] = w0 * up[1] + w1 * up[2] + w2 * up[3];
    bf16_t* ACT = (bf16_t*)(p.ws + WS_RB);
#pragma unroll
    for (int r = 0; r < 4; ++r) ACT[(size_t)(TOK_P + 16 * wid + 4 * l4 + r) * DFF + ch] = (bf16_t)(pk2(pg8::gelu_tanh(uc[r]) * gt[r], 0.f) & 0xffffu);
    if (l4 == 3) { float* o = p.out + O_CFS + (size_t)b * 2 * DFF + ch; o[0] = up[2]; o[DFF] = up[3]; }
}

__device__ __forceinline__ void phase4(const Params& p, int wid, int lane) {
    const int gw = blockIdx.x * 8 + wid, NGW = gridDim.x * 8;
    bf16_t* Y = (bf16_t*)(p.ws + WS_Y); const float* ssq = (const float*)(p.ws + WS_SSQ1); float* RS2 = (float*)(p.ws + WS_RS2); const bf16_t* XB = (const bf16_t*)(p.ws + WS_XB); const float* RS0 = (const float*)(p.ws + WS_RS0);
    const float* wpost = p.in[10];
    f32x4 wpo[4];
#pragma unroll
    for (int j = 0; j < 4; ++j) wpo[j] = *((const f32x4*)wpost + lane + 64 * j);
#pragma unroll 1
    for (int base = gw; base < TOK_P; base += RB * NGW) {
        f32x4 v[RB][4]; u32x2 yw[RB][4]; float sq[RB], i0[RB];
#pragma unroll
        for (int k = 0; k < RB; ++k) { const int rr = min(base + k * NGW, TOK_P - 1);
            i0[k] = RS0[rr];
#pragma unroll
            for (int j = 0; j < 4; ++j) { v[k][j] = unpack_bf4(__builtin_nontemporal_load((const u32x2*)(XB + (size_t)rr * DM) + lane + 64 * j)); yw[k][j] = __builtin_nontemporal_load((const u32x2*)(Y + (size_t)rr * DM) + lane + 64 * j); } }
        float s2[RB];
#pragma unroll
        for (int k = 0; k < RB; ++k) { sq[k] = 0.f;
#pragma unroll
            for (int j = 0; j < 4; ++j) sq[k] += sumsq4(unpack_bf4(yw[k][j]));
            const float rstd1 = rsqrtf(wave_sum(sq[k]) * (1.0f / DM) + EPS); s2[k] = 0.f;
#pragma unroll
            for (int j = 0; j < 4; ++j) { v[k][j] = v[k][j] * i0[k] + (unpack_bf4(yw[k][j]) * rstd1) * wpo[j]; s2[k] += sumsq4(v[k][j]); } }
#pragma unroll
        for (int k = 0; k < RB; ++k) { const int r = base + k * NGW; const float rstd2 = rsqrtf(wave_sum(s2[k]) * (1.0f / DM) + EPS);
            if (r < TOK_P) {
                if (lane == 0) RS2[r] = __builtin_amdgcn_rcpf(rstd2);
#pragma unroll
                for (int j = 0; j < 4; ++j) { const f32x4 y = v[k][j] * rstd2; *((u32x2*)(Y + (size_t)r * DM) + lane + 64 * j) = (u32x2){pk2(y[0], y[1]), pk2(y[2], y[3])}; } } }
    }
    for (int r = TOK_P + gw; r < TOK; r += NGW) {
        const float* xrow = p.in[1] + (size_t)(r - TOK_P) * DM; const float* ys = (const float*)(p.ws + WS_YS) + (size_t)(r - TOK_P) * DM;
        f32x4 yv[4], v[4]; float s = 0.f, s2 = 0.f;
#pragma unroll
        for (int j = 0; j < 4; ++j) { f32x4 a = *((const f32x4*)ys + lane + 64 * j);
#pragma unroll
            for (int q = 1; q < 4; ++q) a += *((const f32x4*)(ys + (size_t)q * 128 * DM) + lane + 64 * j);
            yv[j] = a; s += sumsq4(a); }
        const float rstd1 = rsqrtf(wave_sum(s) * (1.0f / DM) + EPS);
#pragma unroll
        for (int j = 0; j < 4; ++j) { v[j] = *((const f32x4*)xrow + lane + 64 * j) + (yv[j] * rstd1) * wpo[j]; s2 += sumsq4(v[j]);
 }
        const float rstd2 = rsqrtf(wave_sum(s2) * (1.0f / DM) + EPS);
#pragma unroll
        for (int j = 0; j < 4; ++j) { const f32x4 y = v[j] * rstd2; *((u32x2*)(Y + (size_t)r * DM) + lane + 64 * j) = (u32x2){pk2(y[0], y[1]), pk2(y[2], y[3])}; }
    }
}
__device__ __forceinline__ void phase7(const Params& p, int wid, int lane) {
    const int gw = blockIdx.x * 8 + wid, NGW = gridDim.x * 8;
    const bf16_t* F = (const bf16_t*)(p.ws + WS_RA); const bf16_t* Y = (const bf16_t*)(p.ws + WS_Y);
    const float* ssq1 = (const float*)(p.ws + WS_SSQ1); const float* ssq2 = (const float*)(p.ws + WS_SSQ2);
    f32x4 wm[4], wf[4];
#pragma unroll
    for (int j = 0; j < 4; ++j) { wm[j] = *((const f32x4*)p.in[10] + lane + 64 * j); wf[j] = *((const f32x4*)p.in[12] + lane + 64 * j); }
    constexpr int RB7 = 6;
    const float* RS2p = (const float*)(p.ws + WS_RS2);
#pragma unroll 1
    for (int base = gw; base < TOK_P; base += RB7 * NGW) {
        u32x2 xw[RB7][4], fw[RB7][4]; float sq2[RB7], i2[RB7];
#pragma unroll
        for (int k = 0; k < RB7; ++k) { const int rr = min(base + k * NGW, TOK_P - 1);
            i2[k] = RS2p[rr];
#pragma unroll
            for (int j = 0; j < 4; ++j) { xw[k][j] = __builtin_nontemporal_load((const u32x2*)(Y + (size_t)rr * DM) + lane + 64 * j); fw[k][j] = __builtin_nontemporal_load((const u32x2*)(F + (size_t)rr * DM) + lane + 64 * j); } }
#pragma unroll
        for (int k = 0; k < RB7; ++k) { const int r = base + k * NGW; sq2[k] = 0.f;
#pragma unroll
            for (int j = 0; j < 4; ++j) sq2[k] += sumsq4(unpack_bf4(fw[k][j]));
            const float rstd2 = rsqrtf(wave_sum(sq2[k]) * (1.0f / DM) + EPS);
            if (r < TOK_P) {
#pragma unroll
                for (int j = 0; j < 4; ++j) __builtin_nontemporal_store(unpack_bf4(xw[k][j]) * i2[k] + (unpack_bf4(fw[k][j]) * rstd2) * wf[j], (f32x4*)(p.out + (size_t)r * DM) + lane + 64 * j); } }
    }
    for (int r = TOK_P + gw; r < TOK; r += NGW) {
        const float* xrow = p.in[1] + (size_t)(r - TOK_P) * DM;
        const float* ys = (const float*)(p.ws + WS_YS) + (size_t)(r - TOK_P) * DM; const float* fs = (const float*)(p.ws + WS_FS) + (size_t)(r - TOK_P) * DM;
        f32x4 yv[4], fv[4]; float s1 = 0.f, s2 = 0.f;
#pragma unroll
        for (int j = 0; j < 4; ++j) { f32x4 a = *((const f32x4*)ys + lane + 64 * j), c = *((const f32x4*)fs + lane + 64 * j);
#pragma unroll
            for (int q = 1; q < 4; ++q) { a += *((const f32x4*)(ys + (size_t)q * 128 * DM) + lane + 64 * j); c += *((const f32x4*)(fs + (size_t)q * 128 * DM) + lane + 64 * j); }
            yv[j] = a; fv[j] = c; s1 += sumsq4(a); s2 += sumsq4(c); }
        const float rstd1 = rsqrtf(wave_sum(s1) * (1.0f / DM) + EPS), rstd2 = rsqrtf(wave_sum(s2) * (1.0f / DM) + EPS);
#pragma unroll
        for (int j = 0; j < 4; ++j) *((f32x4*)(p.out + (size_t)r * DM) + lane + 64 * j) = *((const f32x4*)xrow + lane + 64 * j) + (yv[j] * rstd1) * wm[j] + (fv[j] * rstd2) * wf[j];
    }
}


#define XB_TMO      128
#define XB_XCNT(j)  (256  + 64 * (j))
#define XB_XSUB(j)  (1280 + 64 * (j))
#define XB_XGEN(j)  (2304 + 64 * (j))
#define XB_TOP      3328
#define XB_TOPGEN   3392
#define XCD_BAR_WORDS 3456
#define XB_SPIN_CAP (1u << 18)

__device__ __forceinline__ unsigned xb_ld(unsigned* p)              { return __hip_atomic_load(p, __ATOMIC_RELAXED, __HIP_MEMORY_SCOPE_AGENT); }
__device__ __forceinline__ unsigned xb_add(unsigned* p, unsigned v) { return __hip_atomic_fetch_add(p, v, __ATOMIC_RELAXED, __HIP_MEMORY_SCOPE_AGENT); }
__device__ __forceinline__ unsigned xb_xcc_id() { return (unsigned)__builtin_amdgcn_s_getreg((3 << 11) | 20) & 0xFu; }
#define XB_SPIN(cond, bar) do { unsigned _sp = 0; while (cond) { __builtin_amdgcn_s_sleep(1); \
    if ((++_sp & 255u) == 0u) { if (xb_ld(&(bar)[XB_TMO])) break; if (_sp > XB_SPIN_CAP) { atomicAdd(&(bar)[XB_TMO], 1u); break; } } } } while (0)

struct XcdBarrier {
    unsigned* bar; unsigned x;
    volatile LAS unsigned* st;
};

__device__ __forceinline__ XcdBarrier xcd_barrier_post(unsigned* bar, volatile LAS unsigned* st) {
    XcdBarrier b; b.bar = bar; b.x = xb_xcc_id(); b.st = st;
    if (threadIdx.x == 0) (void)xb_add(&bar[XB_XCNT(b.x)], 1u);
    return b;
}
__device__ __forceinline__ void xcd_barrier_complete(unsigned* bar, unsigned x, unsigned& nloc, unsigned& nx) {
    const unsigned G = gridDim.x * gridDim.y * gridDim.z;
    unsigned sum, cnt, mine, sp = 0u;
    for (;;) {
        sum = 0u; cnt = 0u; mine = 0u;
#pragma unroll
        for (unsigned j = 0; j < 16; ++j) { const unsigned c = xb_ld(&bar[XB_XCNT(j)]); sum += c; cnt += (c > 0u) ? 1u : 0u; mine = (j == x) ? c : mine; }
        if (sum == G) break;
        __builtin_amdgcn_s_sleep(1);
        if ((++sp & 255u) == 0u) { if (xb_ld(&bar[XB_TMO])) break; if (sp > XB_SPIN_CAP) { atomicAdd(&bar[XB_TMO], 1u); break; } }
    }
    nloc = mine > 0u ? mine : 1u; nx = cnt > 0u ? cnt : 1u;
}

__device__ __forceinline__ void xcd_barrier(const XcdBarrier& b) {
    asm volatile("s_waitcnt vmcnt(0)" ::: "memory");
    __syncthreads();
    if (threadIdx.x == 0) {
        unsigned* bar = b.bar;
        __builtin_amdgcn_s_waitcnt(0);
        unsigned nloc = b.st[0], nx = b.st[1];
        if (nloc == 0u) { xcd_barrier_complete(bar, b.x, nloc, nx); b.st[0] = nloc; b.st[1] = nx; }
        const unsigned old = xb_add(&bar[XB_XSUB(b.x)], 1u);
        const unsigned gen = old / nloc;
        if (old + 1u == (gen + 1u) * nloc) {
            __builtin_amdgcn_fence(__ATOMIC_RELEASE, "agent");
            asm volatile("s_waitcnt vmcnt(0)" ::: "memory");
            const unsigned og = xb_add(&bar[XB_TOP], 1u);
            const unsigned tg = og / nx;
            if (og + 1u == (tg + 1u) * nx) xb_add(&bar[XB_TOPGEN], 1u);
            else XB_SPIN(xb_ld(&bar[XB_TOPGEN]) == tg, bar);
            __builtin_amdgcn_fence(__ATOMIC_ACQUIRE, "agent");
            xb_add(&bar[XB_XGEN(b.x)], 1u);
            asm volatile("s_waitcnt vmcnt(0)" ::: "memory");
        } else {
            XB_SPIN(xb_ld(&bar[XB_XGEN(b.x)]) == gen, bar);
            __builtin_amdgcn_fence(__ATOMIC_ACQUIRE, "agent");
            asm volatile("s_waitcnt vmcnt(0)" ::: "memory");
        }
    }
    __syncthreads();
}

#ifndef MK_LAUNCHES
#define MK_LAUNCHES 1
#endif
#ifndef REP0
#define REP0 1
#endif
#ifndef REP1
#define REP1 1
#endif
#ifndef REP2
#define REP2 1
#endif
#ifndef REP3
#define REP3 1
#endif
#ifndef REP4
#define REP4 1
#endif
#ifndef REP5
#define REP5 1
#endif
#ifndef REP6
#define REP6 1
#endif
#ifndef REP7
#define REP7 1
#endif
#define REPEAT(n) for (int rep_ = 0; rep_ < (n); ++rep_, ((rep_ < (n)) ? GRIDSYNC() : (void)0))
template <int PH_LO, int PH_HI>
__device__ __forceinline__ void run_phases(const Params& p, LAS unsigned char* lds) {
    int tid = threadIdx.x, lane = tid & 63; const int wid = __builtin_amdgcn_readfirstlane(tid >> 6);
    const int G = gridDim.x, c = blockIdx.x;
#define LAUNDER() asm volatile("" : "+v"(tid), "+v"(lane))
    XcdBarrier bar_;
    if (PH_HI - PH_LO > 1) {
        volatile LAS unsigned* stw = (volatile LAS unsigned*)(lds + LDS_BARW);
        if (threadIdx.x == 0) { stw[0] = 0u; stw[1] = 0u; }
        __syncthreads();
        bar_ = xcd_barrier_post((unsigned*)p.ws, stw);
        if (p.ws == nullptr) cg::this_grid().sync();
    }
#define GRIDSYNC() xcd_barrier(bar_)
#define SEAM(ph) do { if (PH_LO <= (ph) && (ph) + 1 < PH_HI) { GRIDSYNC(); } } while (0)
#ifdef XSYNC
    for (int xs_ = 0; xs_ < XSYNC; ++xs_) GRIDSYNC();
#endif
    if (PH_LO <= 0 && 0 < PH_HI) REPEAT(REP0) { LAUNDER(); phase0(p, lds, tid, wid, lane); }
    SEAM(0);
    if (PH_LO <= 1 && 1 < PH_HI) REPEAT(REP1) {
        for (int t = c; t < 224; t += G) { f32x4 acc[1]; thin_gemm2<1>(lds, (const bf16_t*)(p.ws + WS_RA) + (size_t)TOK_P * DM, DM, (const bf16_t*)(p.ws + WS_WIN), DM, 16 * t, 0, 0, DM, acc, tid, wid, lane);
            thin_store(acc[0], (float*)(p.ws + WS_PS), NIN, 16 * t, wid, lane); }
        pg8::Gemm g{(const bf16_t*)(p.ws + WS_XB), (const bf16_t*)(p.ws + WS_WIN), TOK_P, NIN, DM};
        pg8::StaticOrder S; S.init(TOK_P, NIN, G, c);
        pg8::EpiIn E{(bf16_t*)(p.ws + WS_RB), (const float*)(p.ws + WS_COS), (const float*)(p.ws + WS_SIN), (const float*)(p.ws + WS_RS0)};
        pg8::gemm_phase<pg8::EpiIn, pg8::StaticOrder, true, true>(lds, g, S, E);
    }
    SEAM(1);
    if (PH_LO <= 2 && 2 < PH_HI) REPEAT(REP2) {
#ifndef RUREP
#define RUREP 1
#endif
        for (int rrep_ = 0; rrep_ < RUREP; ++rrep_) for (int u = c; u < 256; u += G) ret_unit<false>(p, lds, u, tid, wid, lane);
        LAUNDER();
#ifndef SUREP
#define SUREP 1
#endif
        for (int srep_ = 0; srep_ < SUREP; ++srep_) for (int su = c; su < 128; su += G) sample_unit(p, lds, su, tid, wid, lane);
    }
    SEAM(2);
    if (PH_LO <= 3 && 3 < PH_HI) REPEAT(REP3) {
        for (int u = c; u < 256; u += G) ret_unit<true>(p, lds, u, tid, wid, lane);
    }
    SEAM(3);
    if (PH_LO <= 4 && 4 < PH_HI) REPEAT(REP4) {
        for (int t = c; t < 256; t += G) { f32x4 acc[1]; const int kq = t >> 6, nt = t & 63;
            thin_gemm2<1>(lds, (const bf16_t*)(p.ws + WS_RA) + (size_t)TOK_P * DM, DM, (const bf16_t*)(p.ws + WS_WOUT), DM, 16 * nt, 0, 256 * kq, 256, acc, tid, wid, lane);
            thin_store(acc[0], (float*)(p.ws + WS_YS) + (size_t)kq * 128 * DM, DM, 16 * nt, wid, lane); }
        pg8::Gemm g{(const bf16_t*)(p.ws + WS_RA), (const bf16_t*)(p.ws + WS_WOUT), TOK_P, DM, DM};
        pg8::StaticOrder S; S.init(TOK_P, DM, G, c);
        pg8::EpiY E{(bf16_t*)(p.ws + WS_Y), (float*)(p.ws + WS_SSQ1)};
        pg8::gemm_phase<pg8::EpiY, pg8::StaticOrder, true, true>(lds, g, S, E);
    }
    SEAM(4);
    if (PH_LO <= 5 && 5 < PH_HI) REPEAT(REP5) { LAUNDER(); phase4(p, wid, lane); }
    SEAM(5);
    if (PH_LO <= 6 && 6 < PH_HI) REPEAT(REP6) {
        for (int t = c; t < 256; t += G) thin_ffn1(p, lds, t, tid, wid, lane);
        pg8::Gemm g{(const bf16_t*)(p.ws + WS_Y), (const bf16_t*)(p.ws + WS_WFF1), TOK_P, 2 * DFF, DM};
        pg8::WalkOrder S{G, c};
        pg8::EpiFfn E{(bf16_t*)(p.ws + WS_RB), p.in[15], p.in[4], p.out + O_CFP, p.out + O_CFS, (LAS float*)(lds + LDS_HALO), (const float*)(p.ws + WS_RS2)};
        pg8::gemm_phase<pg8::EpiFfn, pg8::WalkOrder, true, true>(lds, g, S, E);
    }
    SEAM(6);
    if (PH_LO <= 7 && 7 < PH_HI) REPEAT(REP7) {
        for (int t = c; t < 256; t += G) { f32x4 acc[1]; const int kq = t >> 6, nt = t & 63;
            thin_gemm2<1>(lds, (const bf16_t*)(p.ws + WS_RB) + (size_t)TOK_P * DFF, DFF, (const bf16_t*)(p.ws + WS_WDN), DFF, 16 * nt, 0, 1024 * kq, 1024, acc, tid, wid, lane);
            thin_store(acc[0], (float*)(p.ws + WS_FS) + (size_t)kq * 128 * DM, DM, 16 * nt, wid, lane); }
        pg8::Gemm g{(const bf16_t*)(p.ws + WS_RB), (const bf16_t*)(p.ws + WS_WDN), TOK_P, DM, DFF};
        pg8::StaticOrder S; S.init(TOK_P, DM, G, c);
        pg8::EpiY E{(bf16_t*)(p.ws + WS_RA), (float*)(p.ws + WS_SSQ2)};
        pg8::gemm_phase<pg8::EpiY, pg8::StaticOrder, true, true>(lds, g, S, E);
    }
    SEAM(7);
#ifndef REP8
#define REP8 1
#endif
    if (PH_LO <= 8 && 8 < PH_HI) REPEAT(REP8) { LAUNDER(); phase7(p, wid, lane); }
#undef SEAM
}
constexpr int NPH = 9;
#if MK_LAUNCHES == 1
__global__ void __launch_bounds__(512, 2) fwd_kernel(Params p) {
    extern __shared__ __attribute__((aligned(16))) unsigned char smem[];
    run_phases<0, NPH>(p, (LAS unsigned char*)smem);
}
#else
template <int PH>
__global__ void __launch_bounds__(512, 2) fwd_phase(Params p) {
    extern __shared__ __attribute__((aligned(16))) unsigned char smem[];
    run_phases<PH, PH + 1>(p, (LAS unsigned char*)smem);
}
template <int PH> static void launch_phase(const Params& p, int grid, hipStream_t stream) {
    static bool attr = false;
    if (!attr) { (void)hipFuncSetAttribute((const void*)fwd_phase<PH>, hipFuncAttributeMaxDynamicSharedMemorySize, LDS_BYTES); attr = true; }
    hipLaunchKernelGGL(fwd_phase<PH>, dim3(grid), dim3(512), LDS_BYTES, stream, p);
}
#endif

extern "C" void kernel_launch(void* const* d_in, const int* in_sizes, int n_in, void* d_out, int out_size, void* d_ws, size_t ws_size, hipStream_t stream) {
    static int grid = 0;
    if (grid == 0) {
        if (n_in != 17 || ws_size < WS_END) { fprintf(stderr, "kernel_launch: expected 17 inputs and >= %zu bytes of workspace (got %d, %zu)\n", (size_t)WS_END, n_in, ws_size); grid = -1; return; }
        int dev = 0, cus = 0, per_cu = 0;
        (void)hipGetDevice(&dev); (void)hipDeviceGetAttribute(&cus, hipDeviceAttributeMultiprocessorCount, dev);
#if MK_LAUNCHES == 1
        if (hipFuncSetAttribute((const void*)fwd_kernel, hipFuncAttributeMaxDynamicSharedMemorySize, LDS_BYTES) != hipSuccess) { fprintf(stderr, "kernel_launch: hipFuncSetAttribute failed\n"); grid = -1; return; }
        if (hipOccupancyMaxActiveBlocksPerMultiprocessor(&per_cu, (const void*)fwd_kernel, 512, LDS_BYTES) != hipSuccess || per_cu < 1) { fprintf(stderr, "kernel_launch: occupancy query says %d\n", per_cu); per_cu = 1; }
        (void)hipGetLastError();
#endif
        grid = cus > 0 ? cus : 256;
    }
    if (grid < 0) return;
    Params p{};
    for (int i = 0; i < 17; ++i) p.in[i] = (const float*)d_in[i];
    p.out = (float*)d_out; p.ws = (unsigned char*)d_ws;
#if MK_LAUNCHES == 1
    if (hipMemsetAsync(d_ws, 0, 16384, stream) != hipSuccess) { fprintf(stderr, "kernel_launch: hipMemsetAsync failed\n"); return; }
    void* args[] = {&p};
    const hipError_t e = hipLaunchCooperativeKernel((const void*)fwd_kernel, dim3(grid), dim3(512), args, LDS_BYTES, stream);
    if (e != hipSuccess) fprintf(stderr, "kernel_launch: cooperative launch failed: %s (grid %d)\n", hipGetErrorString(e), grid);
#else
    launch_phase<0>(p, grid, stream); launch_phase<1>(p, grid, stream); launch_phase<2>(p, grid, stream); launch_phase<3>(p, grid, stream); launch_phase<4>(p, grid, stream);
    launch_phase<5>(p, grid, stream); launch_phase<6>(p, grid, stream); launch_phase<7>(p, grid, stream); launch_phase<8>(p, grid, stream);
#endif
}
```

```cpp
#include <hip/hip_runtime.h>
#include <hip/hip_cooperative_groups.h>
#include <cstdio>
#include <cstdint>
namespace cg = cooperative_groups;
namespace pg8 {
#define PG8_LAS __attribute__((address_space(3)))
typedef unsigned short bf16_t;
typedef short bf16x8 __attribute__((ext_vector_type(8)));
typedef float f32x4 __attribute__((ext_vector_type(4)));
typedef unsigned u32x4 __attribute__((ext_vector_type(4)));
constexpr int BM = 256, BK = 64, HALF = 128, HTB = HALF * BK * 2  , STAGE_BYTES = 8 * HTB, NXCD = 8, WGM = 8;

__host__ __device__ __forceinline__ int lds_byte(int r, int c) { const int st = (r >> 4) * 2 + (c >> 5), rr = r & 15, cc = c & 31, ob = rr * 64 + cc * 2; return st * 1024 + (ob ^ (((ob >> 9) & 1) << 5)); }
__host__ __device__ __forceinline__ void stage_rc(int b, int& R, int& C) { const int st = b / 1024, sb = b % 1024, swz = sb ^ (((sb >> 9) & 1) << 5); R = (st >> 1) * 16 + swz / 64; C = (st & 1) * 32 + (swz % 64) / 2; }
__host__ __device__ __forceinline__ int perm32(int rho) { const int n = rho >> 4, i = rho & 15; return 8 * (i >> 2) + 4 * n + (i & 3); }

struct Unit { int pm, pn; };
struct Gemm { const bf16_t* A; const bf16_t* Bt; int M, N, K; };

struct StaticOrder {
    int nM, nN, nwg, G, c;
    __host__ __device__ void init(int M, int N, int G_, int c_) { nM = M / BM; nN = N / BM; nwg = nM * nN; G = G_; c = c_; }
    __host__ __device__ bool next(int i, Unit& u) const {
        const long L = (long)i * G + c; if (L >= nwg) return false;
        int wgid = (int)L; { const int q = nwg / NXCD, r = nwg % NXCD, xcd = wgid % NXCD, off = wgid / NXCD; wgid = (xcd < r ? xcd * (q + 1) : r * (q + 1) + (xcd - r) * q) + off; }
        const int nig = WGM * nN, gid = wgid / nig, fm = gid * WGM, gsz = (nM - fm) < WGM ? (nM - fm) : WGM;
        u.pm = fm + ((wgid % nig) % gsz); u.pn = (wgid % nig) / gsz; return true;
    }
    __device__ __forceinline__ void a_ready(const Unit&) const {}
    __device__ __forceinline__ void done(const Unit&) const {}
};
__device__ __forceinline__ unsigned cvt_pk_bf16(float lo, float hi) { unsigned r; asm volatile("v_cvt_pk_bf16_f32 %0, %1, %2" : "=v"(r) : "v"(lo), "v"(hi)); return r; }
__device__ __forceinline__ float dpp_shr1(float v) { return __builtin_bit_cast(float, __builtin_amdgcn_update_dpp(0, __builtin_bit_cast(int, v), 0x111, 0xf, 0xf, true)); }
__device__ __forceinline__ float dpp_shr2(float v) { return __builtin_bit_cast(float, __builtin_amdgcn_update_dpp(0, __builtin_bit_cast(int, v), 0x112, 0xf, 0xf, true)); }
__device__ __forceinline__ float dpp_shl15(float v) { return __builtin_bit_cast(float, __builtin_amdgcn_update_dpp(0, __builtin_bit_cast(int, v), 0x10F, 0xf, 0xf, true)); }
__device__ __forceinline__ float dpp_shl14(float v) { return __builtin_bit_cast(float, __builtin_amdgcn_update_dpp(0, __builtin_bit_cast(int, v), 0x10E, 0xf, 0xf, true)); }
__device__ __forceinline__ float gelu_tanh(float x) {
    const float z = 0.7978845608028654f * (x + 0.044715f * x * x * x);
    const float e = __builtin_amdgcn_exp2f(-2.8853900817779268f * z);
    return x * __builtin_amdgcn_rcpf(1.0f + e);
}
constexpr int TOKP = 32768;

struct EpiIn {
    static constexpr bool PERM = true, AFTER_DRAIN = false;
    bf16_t* P; const float* cosT; const float* sinT; const float* rs0;
    __device__ __forceinline__ void operator()(const f32x4 (&acc)[2][2][4][2], const Unit& u, int wr, int wc, int fr, int fq) const {
        asm volatile("" : "+v"(fr), "+v"(fq));
        const int row0 = u.pm * BM + wr * 64 + fr, col0 = u.pn * BM + wc * 32 + 8 * fq;
        if (u.pn < 4) {
            const float sc = (u.pn >= 2) ? 0.08838834764831845f : 1.0f;
            const int f0 = 16 * wc + 4 * fq;
#pragma unroll
            for (int ai = 0; ai < 2; ++ai)
#pragma unroll
                for (int m = 0; m < 4; ++m) {
                    const int r = row0 + ai * HALF + m * 16;
                    const int pos = r < TOKP ? (r & 4095) : 4096 + ((r - TOKP) & 15);
                    const float rsr = sc;
                    const f32x4 c4 = *(const f32x4*)(cosT + pos * 64 + f0) * rsr, s4 = *(const f32x4*)(sinT + pos * 64 + f0) * rsr;
                    bf16_t* rowp = P + (size_t)r * 3584 + col0;
#pragma unroll
                    for (int bj = 0; bj < 2; ++bj) {
                        const f32x4 x1 = acc[ai][bj][m][0], x2 = acc[ai][bj][m][1];
                        const f32x4 o1 = x1 * c4 - x2 * s4, o2 = x2 * c4 + x1 * s4;
                        u32x4 w; w.x = cvt_pk_bf16(o1[0], o1[1]); w.y = cvt_pk_bf16(o1[2], o1[3]); w.z = cvt_pk_bf16(o2[0], o2[1]); w.w = cvt_pk_bf16(o2[2], o2[3]);
                        *(u32x4*)(rowp + bj * HALF) = w;
                    }
                }
        } else if (u.pn >= 10) {
#pragma unroll
            for (int ai = 0; ai < 2; ++ai)
#pragma unroll
                for (int m = 0; m < 4; ++m) {
                    const int r = row0 + ai * HALF + m * 16;
                    const f32x4 v0 = acc[ai][0][m][0] * acc[ai][1][m][0], v1 = acc[ai][0][m][1] * acc[ai][1][m][1];
                    u32x4 w; w.x = cvt_pk_bf16(v0[0], v0[1]); w.y = cvt_pk_bf16(v0[2], v0[3]); w.z = cvt_pk_bf16(v1[0], v1[1]); w.w = cvt_pk_bf16(v1[2], v1[3]);
                    *(u32x4*)(P + (size_t)r * 3584 + 2560 + 128 * (u.pn - 10) + wc * 32 + 8 * fq) = w;
                }
        } else {
#pragma unroll
            for (int ai = 0; ai < 2; ++ai)
#pragma unroll
                for (int m = 0; m < 4; ++m) {
                    bf16_t* rowp = P + (size_t)(row0 + ai * HALF + m * 16) * 3584 + col0;
#pragma unroll
                    for (int bj = 0; bj < 2; ++bj) {
                        const f32x4 v0 = acc[ai][bj][m][0], v1 = acc[ai][bj][m][1];
                        u32x4 w; w.x = cvt_pk_bf16(v0[0], v0[1]); w.y = cvt_pk_bf16(v0[2], v0[3]); w.z = cvt_pk_bf16(v1[0], v1[1]); w.w = cvt_pk_bf16(v1[2], v1[3]);
                        *(u32x4*)(rowp + bj * HALF) = w;
                    }
                }
        }
    }
};

struct EpiY {
    static constexpr bool PERM = true, AFTER_DRAIN = false;
    bf16_t* Y; float* ssq;
    __device__ __forceinline__ void operator()(const f32x4 (&acc)[2][2][4][2], const Unit& u, int wr, int wc, int fr, int fq) const {
        asm volatile("" : "+v"(fr), "+v"(fq));
        const int row0 = u.pm * BM + wr * 64 + fr, col0 = u.pn * BM + wc * 32 + 8 * fq;
#pragma unroll
        for (int ai = 0; ai < 2; ++ai)
#pragma unroll
            for (int m = 0; m < 4; ++m) {
                const int r = row0 + ai * HALF + m * 16;
                bf16_t* rowp = Y + (size_t)r * 1024 + col0;
#pragma unroll
                for (int bj = 0; bj < 2; ++bj) {
                    const f32x4 v0 = acc[ai][bj][m][0], v1 = acc[ai][bj][m][1];
                    u32x4 w; w.x = cvt_pk_bf16(v0[0], v0[1]); w.y = cvt_pk_bf16(v0[2], v0[3]); w.z = cvt_pk_bf16(v1[0], v1[1]); w.w = cvt_pk_bf16(v1[2], v1[3]);
                    *(u32x4*)(rowp + bj * HALF) = w;
                }
            }
    }
};

struct EpiFfn {
    static constexpr bool PERM = true, AFTER_DRAIN = false;
    bf16_t* ACT; const float* cw; const float* cache; float* outp; float* outs; PG8_LAS float* halo; const float* rs2;
    __device__ __forceinline__ void operator()(const f32x4 (&acc)[2][2][4][2], const Unit& u, int wr, int wc, int fr, int fq) const {
        asm volatile("" : "+v"(fr), "+v"(fq));
        const int lc0 = wc * 32 + 8 * fq, ch0 = u.pn * 128 + lc0;
        const bool sample = false;
        const int par = u.pm & 1;
        f32x4 w0[2], w1[2], w2[2];
#pragma unroll
        for (int n = 0; n < 2; ++n) { w0[n] = *(const f32x4*)(cw + ch0 + 4 * n); w1[n] = *(const f32x4*)(cw + 4096 + ch0 + 4 * n); w2[n] = *(const f32x4*)(cw + 8192 + ch0 + 4 * n); }
        if (!sample && fr >= 14) {
#pragma unroll
            for (int ai = 0; ai < 2; ++ai) { PG8_LAS float* hp = halo + ((par * 4 + 2 * ai + wr) * 2 + (fr - 14)) * 128 + lc0;
                *(PG8_LAS f32x4*)hp = acc[ai][0][3][0]; *(PG8_LAS f32x4*)(hp + 4) = acc[ai][0][3][1]; }
        }
        asm volatile("s_waitcnt lgkmcnt(0)" ::: "memory"); __builtin_amdgcn_s_barrier(); asm volatile("" ::: "memory");
#pragma unroll
        for (int ai = 0; ai < 2; ++ai) {
            const int blk = 2 * ai + wr;
#pragma unroll
            for (int m = 0; m < 4; ++m) {
                f32x4 pv[2]; pv[0] = (f32x4){0.f, 0.f, 0.f, 0.f}; pv[1] = pv[0];
                const int sb = 8 * ai + 4 * wr + m;
                if (sample) {
                    if (fr >= 14 && sb < 8) { const float* cp = cache + (size_t)(sb * 2 + fr - 14) * 4096 + ch0; pv[0] = *(const f32x4*)cp; pv[1] = *(const f32x4*)(cp + 4); }
                } else if (m == 0) {
                    if (fr >= 14) {
                        const bool zero = (blk == 0) && ((u.pm & 15) == 0);
                        const int hb = (blk == 0) ? ((par ^ 1) * 4 + 3) : (par * 4 + blk - 1);
                        if (!zero) { const PG8_LAS float* hp = halo + (hb * 2 + fr - 14) * 128 + lc0; pv[0] = *(const PG8_LAS f32x4*)hp; pv[1] = *(const PG8_LAS f32x4*)(hp + 4); }
                    }
                } else { pv[0] = acc[ai][0][m - 1][0]; pv[1] = acc[ai][0][m - 1][1]; }
                const int r = u.pm * BM + ai * HALF + wr * 64 + m * 16 + fr;
                f32x4 a4[2];
#pragma unroll
                for (int n = 0; n < 2; ++n) {
                    const f32x4 cur = acc[ai][0][m][n], gt = acc[ai][1][m][n];
                    f32x4 p1, p2;
#pragma unroll
                    for (int e = 0; e < 4; ++e) { p1[e] = dpp_shr1(cur[e]) + dpp_shl15(pv[n][e]); p2[e] = dpp_shr2(cur[e]) + dpp_shl14(pv[n][e]); }
                    const f32x4 uc = w0[n] * p2 + w1[n] * p1 + w2[n] * cur;
                    const f32x4 zz = (uc * uc * 0.044715f + 1.0f) * uc * (-2.8853900817779268f * 0.7978845608028654f);
                    f32x4 rr;
#pragma unroll
                    for (int e = 0; e < 4; ++e) rr[e] = __builtin_amdgcn_rcpf(1.0f + __builtin_amdgcn_exp2f(zz[e]));
                    a4[n] = uc * rr * gt;
                }
                u32x4 w; w.x = cvt_pk_bf16(a4[0][0], a4[0][1]); w.y = cvt_pk_bf16(a4[0][2], a4[0][3]); w.z = cvt_pk_bf16(a4[1][0], a4[1][1]); w.w = cvt_pk_bf16(a4[1][2], a4[1][3]);
                *(u32x4*)(ACT + (size_t)r * 4096 + ch0) = w;
                if (sample) {
                    if (fr >= 14 && sb < 8) { float* op = outs + (size_t)(sb * 2 + fr - 14) * 4096 + ch0; *(f32x4*)op = acc[ai][0][m][0]; *(f32x4*)(op + 4) = acc[ai][0][m][1]; }
                } else if (m == 3 && blk == 3 && (u.pm & 15) == 15 && fr >= 14) {
                    float* op = outp + (size_t)((u.pm >> 4) * 2 + fr - 14) * 4096 + ch0; *(f32x4*)op = acc[ai][0][m][0]; *(f32x4*)(op + 4) = acc[ai][0][m][1];
                }
            }
        }
    }
};
struct WalkOrder {
    int G, c;
    __device__ __forceinline__ bool next(int i, Unit& u) const {
        int w = c, rem = i;
        while (w < 256) { const int len = 16;
            if (rem < len) { if (w < 256) { u.pm = (w >> 5) * 16 + rem; u.pn = w & 31; } else { u.pm = 128; u.pn = w - 256; } return true; }
            rem -= len; w += G; }
        return false;
    }
    __device__ __forceinline__ void a_ready(const Unit&) const {}
    __device__ __forceinline__ void done(const Unit&) const {}
};
template <class Epi, class Sched, bool ALIGN_EPI = false, bool SP2 = false>
__device__ __forceinline__ void gemm_phase(PG8_LAS unsigned char* lds, const Gemm g, const Sched& S, const Epi& E) {
    int tid_raw = threadIdx.x; asm volatile("" : "+v"(tid_raw));
    const int tid = tid_raw, wid = __builtin_amdgcn_readfirstlane(tid >> 6), lane = tid & 63, wr = wid >> 2, wc = wid & 3, fr = lane & 15, fq = lane >> 4;
    const int K = g.K, nt = K / BK;
    unsigned voffA[2], voffB[2];
#pragma unroll
    for (int i = 0; i < 2; ++i) { int R, C; stage_rc(tid * 16 + i * 8192, R, C); const int Rb = Epi::PERM ? ((R & ~31) + perm32(R & 31)) : R;
        voffA[i] = (unsigned)(R * K + C) * 2u; voffB[i] = (unsigned)(Rb * K + C) * 2u; }
    const size_t kstep = (size_t)(BK * 2);
    const size_t hstep = (size_t)HALF * K * 2;
    const size_t tstep = 2 * hstep;
    const unsigned ldsw = (unsigned)wid * 1024u;
    const int aoff = lds_byte(wr * 64 + fr, fq * 8), boff = lds_byte(wc * 32 + fr, fq * 8);
#define PG8_SA(b, h) (((b) * 2 + (h)) * HTB)
#define PG8_SB(b, h) ((4 + (b) * 2 + (h)) * HTB)
#define PG8_STAGE(bufoff, gbase, voff) do { _Pragma("unroll") for (int _i = 0; _i < 2; ++_i) \
        __builtin_amdgcn_global_load_lds((const unsigned*)((const char*)(gbase) + (voff)[_i]), (PG8_LAS unsigned*)(lds + (bufoff) + ldsw + _i * 8192), 16, 0, 0); } while (0)
#define PG8_LDA(dst, b, h) do { _Pragma("unroll") for (int m = 0; m < 4; ++m) _Pragma("unroll") for (int k = 0; k < 2; ++k) dst[m][k] = *(const PG8_LAS bf16x8*)(lds + PG8_SA(b, h) + aoff + m * 2048 + k * 1024); } while (0)
#define PG8_LDB(dst, b, h) do { _Pragma("unroll") for (int n = 0; n < 2; ++n) _Pragma("unroll") for (int k = 0; k < 2; ++k) dst[n][k] = *(const PG8_LAS bf16x8*)(lds + PG8_SB(b, h) + boff + n * 2048 + k * 1024); } while (0)
#define PG8_MMA(ai, bj, At, Bt) do { __builtin_amdgcn_s_setprio(1); _Pragma("unroll") for (int m = 0; m < 4; ++m) _Pragma("unroll") for (int n = 0; n < 2; ++n) _Pragma("unroll") for (int k = 0; k < 2; ++k) \
        acc[ai][bj][m][n] = __builtin_amdgcn_mfma_f32_16x16x32_bf16(Bt[n][k], At[m][k], acc[ai][bj][m][n], 0, 0, 0); __builtin_amdgcn_s_setprio(0); } while (0)
#define PG8_WAIT_V(n) asm volatile("s_waitcnt vmcnt(" #n ")" ::: "memory")
#define PG8_WAIT_L(n) asm volatile("s_waitcnt lgkmcnt(" #n ")" ::: "memory")
#define PG8_BAR __builtin_amdgcn_s_barrier()
#define PG8_SCHED __builtin_amdgcn_sched_barrier(0)
    Unit cur, nxt; int ui = 0;
    if (!S.next(0, cur)) return;
    f32x4 acc[2][2][4][2];
#pragma unroll
    for (int a = 0; a < 2; ++a)
#pragma unroll
        for (int b = 0; b < 2; ++b)
#pragma unroll
            for (int m = 0; m < 4; ++m)
#pragma unroll
                for (int n = 0; n < 2; ++n) acc[a][b][m][n] = (f32x4){0.f, 0.f, 0.f, 0.f};
    bf16x8 At[4][2], B0[2][2], B1[2][2];
    const char* cA = (const char*)g.A + (size_t)cur.pm * tstep; const char* cB = (const char*)g.Bt + (size_t)cur.pn * tstep;
    S.a_ready(cur);
    if constexpr (SP2) {
        PG8_STAGE(PG8_SB(0, 0), cB, voffB); PG8_STAGE(PG8_SB(0, 1), cB + hstep, voffB); PG8_STAGE(PG8_SA(0, 0), cA, voffA); PG8_STAGE(PG8_SA(0, 1), cA + hstep, voffA);
        if (wr == 1) PG8_BAR;
        PG8_WAIT_V(2); PG8_BAR;
        PG8_STAGE(PG8_SB(1, 0), cB + kstep, voffB); PG8_STAGE(PG8_SA(1, 0), cA + kstep, voffA); PG8_STAGE(PG8_SB(1, 1), cB + hstep + kstep, voffB);
        PG8_WAIT_V(6); PG8_BAR;
    } else {
        PG8_STAGE(PG8_SB(0, 0), cB, voffB); PG8_STAGE(PG8_SA(0, 0), cA, voffA); PG8_STAGE(PG8_SB(0, 1), cB + hstep, voffB); PG8_STAGE(PG8_SA(0, 1), cA + hstep, voffA);
        if (wr == 1) PG8_BAR;
        PG8_WAIT_V(4); PG8_BAR;
        PG8_STAGE(PG8_SB(1, 0), cB + kstep, voffB); PG8_STAGE(PG8_SA(1, 0), cA + kstep, voffA); PG8_STAGE(PG8_SB(1, 1), cB + hstep + kstep, voffB);
        PG8_WAIT_V(6); PG8_BAR;
    }
    for (;;) {
        const bool has_next = S.next(ui + 1, nxt);
        const char* nA = has_next ? (const char*)g.A + (size_t)nxt.pm * tstep : cA; const char* nB = has_next ? (const char*)g.Bt + (size_t)nxt.pn * tstep : cB;
        for (int t = 0; t < nt; t += 2) {
            const bool last = (t == nt - 2);
            const char* a1 = cA + (size_t)(t + 1) * kstep;
            const char* a2 = last ? nA : cA + (size_t)(t + 2) * kstep; const char* b2 = last ? nB : cB + (size_t)(t + 2) * kstep;
            const char* a3 = a2 + kstep; const char* b3 = b2 + kstep;
            if (last && has_next) S.a_ready(nxt);
            if constexpr (SP2) {
            PG8_LDB(B0, 0, 0); PG8_LDB(B1, 0, 1); PG8_SCHED; PG8_LDA(At, 0, 0); PG8_STAGE(PG8_SA(1, 1), a1 + hstep, voffA);
            PG8_WAIT_V(8); PG8_WAIT_L(0); PG8_BAR; PG8_MMA(0, 0, At, B0); PG8_MMA(0, 1, At, B1); PG8_BAR; PG8_SCHED;
            PG8_LDA(At, 0, 1); PG8_STAGE(PG8_SB(0, 0), b2, voffB); PG8_STAGE(PG8_SB(0, 1), b2 + hstep, voffB); PG8_STAGE(PG8_SA(0, 0), a2, voffA);
            PG8_WAIT_V(8); PG8_WAIT_L(0); PG8_BAR; PG8_MMA(1, 0, At, B0); PG8_MMA(1, 1, At, B1); PG8_BAR; PG8_SCHED;
            PG8_LDB(B0, 1, 0); PG8_LDB(B1, 1, 1); PG8_SCHED; PG8_LDA(At, 1, 0); PG8_STAGE(PG8_SA(0, 1), a2 + hstep, voffA);
            PG8_WAIT_V(8); PG8_WAIT_L(0); PG8_BAR; PG8_MMA(0, 0, At, B0); PG8_MMA(0, 1, At, B1); PG8_BAR; PG8_SCHED;
            PG8_LDA(At, 1, 1); PG8_STAGE(PG8_SB(1, 0), b3, voffB); PG8_STAGE(PG8_SB(1, 1), b3 + hstep, voffB); PG8_STAGE(PG8_SA(1, 0), a3, voffA);
            PG8_WAIT_V(8); PG8_WAIT_L(0); PG8_BAR; PG8_MMA(1, 0, At, B0); PG8_MMA(1, 1, At, B1); PG8_BAR; PG8_SCHED;
            } else {
            PG8_LDB(B0, 0, 0); PG8_SCHED; PG8_LDA(At, 0, 0); PG8_STAGE(PG8_SA(1, 1), a1 + hstep, voffA);
            PG8_WAIT_L(8); PG8_BAR; PG8_WAIT_L(0); PG8_MMA(0, 0, At, B0); PG8_BAR; PG8_SCHED;
            PG8_LDB(B1, 0, 1); PG8_STAGE(PG8_SB(0, 0), b2, voffB);
            PG8_BAR; PG8_WAIT_L(0); PG8_MMA(0, 1, At, B1); PG8_BAR;
            PG8_LDA(At, 0, 1); PG8_STAGE(PG8_SA(0, 0), a2, voffA);
            PG8_BAR; PG8_WAIT_L(0); PG8_MMA(1, 0, At, B0); PG8_BAR; PG8_SCHED;
            PG8_STAGE(PG8_SB(0, 1), b2 + hstep, voffB);
            PG8_WAIT_V(6); PG8_BAR; PG8_MMA(1, 1, At, B1); PG8_BAR;
            PG8_LDB(B0, 1, 0); PG8_SCHED; PG8_LDA(At, 1, 0); PG8_STAGE(PG8_SA(0, 1), a2 + hstep, voffA);
            PG8_WAIT_L(8); PG8_BAR; PG8_WAIT_L(0); PG8_MMA(0, 0, At, B0); PG8_BAR; PG8_SCHED;
            PG8_LDB(B1, 1, 1); PG8_STAGE(PG8_SB(1, 0), b3, voffB);
            PG8_BAR; PG8_WAIT_L(0); PG8_MMA(0, 1, At, B1); PG8_BAR;
            PG8_LDA(At, 1, 1); PG8_STAGE(PG8_SA(1, 0), a3, voffA);
            PG8_BAR; PG8_WAIT_L(0); PG8_MMA(1, 0, At, B0); PG8_BAR; PG8_SCHED;
            PG8_STAGE(PG8_SB(1, 1), b3 + hstep, voffB);
            PG8_WAIT_V(6); PG8_BAR; PG8_MMA(1, 1, At, B1); PG8_BAR;
            }
        }
        if constexpr (ALIGN_EPI) { if (wr == 0) PG8_BAR; }
        if constexpr (!Epi::AFTER_DRAIN) { E(acc, cur, wr, wc, fr, fq); S.done(cur); }
        if (!has_next) break;
#pragma unroll
        for (int a = 0; a < 2; ++a)
#pragma unroll
            for (int b = 0; b < 2; ++b)
#pragma unroll
                for (int m = 0; m < 4; ++m)
#pragma unroll
                    for (int n = 0; n < 2; ++n) acc[a][b][m][n] = (f32x4){0.f, 0.f, 0.f, 0.f};
        cur = nxt; cA = nA; cB = nB; ++ui;
        if constexpr (ALIGN_EPI) { if (wr == 1) PG8_BAR; }
    }
    PG8_WAIT_V(0);
    if constexpr (!ALIGN_EPI) { if (wr == 0) PG8_BAR; }
    PG8_BAR;
    if constexpr (Epi::AFTER_DRAIN) { E.fused(acc, cur, wr, wc, fr, fq, lds, wid, lane); S.done(cur); }
#undef PG8_SA
#undef PG8_SB
#undef PG8_STAGE
#undef PG8_LDA
#undef PG8_LDB
#undef PG8_MMA
#undef PG8_WAIT_V
#undef PG8_WAIT_L
#undef PG8_BAR
#undef PG8_SCHED
}
}

using pg8::bf16_t; using pg8::bf16x8; using pg8::f32x4; using pg8::u32x4;
#define LAS __attribute__((address_space(3)))
typedef unsigned u32x2 __attribute__((ext_vector_type(2)));
constexpr int DM = 1024, NIN = 3584, DFF = 4096;
constexpr int TOK_P = 32768, TOK = 32896, TOKPAD = 33024;
constexpr float EPS = 1e-6f;
constexpr size_t WS_WIN = 16384;
constexpr size_t WS_WOUT = WS_WIN + (size_t)NIN * DM * 2;
constexpr size_t WS_WFF1 = WS_WOUT + (size_t)DM * DM * 2;
constexpr size_t WS_WDN = WS_WFF1 + (size_t)2 * DFF * DM * 2;
constexpr size_t WS_COS = WS_WDN + (size_t)DM * DFF * 2;
constexpr size_t WS_SIN = WS_COS + (size_t)4112 * 64 * 4;
constexpr size_t WS_SSQ1 = WS_SIN + (size_t)4112 * 64 * 4;
constexpr size_t WS_SSQ2 = WS_SSQ1 + (size_t)TOKPAD * 16 * 4;
constexpr size_t WS_UG = WS_SSQ2 + (size_t)TOKPAD * 16 * 4;
constexpr size_t WS_PS = WS_UG + (size_t)256 * 32768;
constexpr size_t WS_YS = WS_PS + (size_t)128 * NIN * 4;
constexpr size_t WS_FS = WS_YS + (size_t)4 * 128 * DM * 4;
constexpr size_t WS_RA = WS_FS + (size_t)4 * 128 * DM * 4;
constexpr size_t WS_RB = WS_RA + (size_t)TOKPAD * DM * 2;
constexpr size_t WS_Y = WS_RB + (size_t)TOKPAD * DFF * 2;
constexpr size_t WS_RS2 = WS_Y + (size_t)TOKPAD * DM * 2;
constexpr size_t WS_RS0 = WS_RS2 + (size_t)TOK_P * 4;
constexpr size_t WS_XB = WS_RS0 + (size_t)TOK_P * 4;
constexpr size_t WS_END = WS_XB + (size_t)TOK_P * DM * 2;
constexpr size_t O_SRP = (size_t)TOK * DM, O_CCP = O_SRP + 524288, O_CFP = O_CCP + 8192, O_SRS = O_CFP + 65536, O_CCS = O_SRS + 524288, O_CFS = O_CCS + 8192;
constexpr int LDS_HALO = 131072, LDS_BARW = 131072 + 8192, LDS_BYTES = LDS_BARW + 16;

struct Params { const float* in[17]; float* out; unsigned char* ws; };

__device__ __forceinline__ float dppf(float v, const int ctrl_sel) {
    const int iv = __builtin_bit_cast(int, v); int r;
    switch (ctrl_sel) { case 1: r = __builtin_amdgcn_update_dpp(0, iv, 0x111, 0xf, 0xf, true); break; case 2: r = __builtin_amdgcn_update_dpp(0, iv, 0x112, 0xf, 0xf, true); break;
        case 4: r = __builtin_amdgcn_update_dpp(0, iv, 0x114, 0xf, 0xf, true); break; case 8: r = __builtin_amdgcn_update_dpp(0, iv, 0x118, 0xf, 0xf, true); break;
        case 15: r = __builtin_amdgcn_update_dpp(0, iv, 0x142, 0xa, 0xf, false); break; default: r = __builtin_amdgcn_update_dpp(0, iv, 0x143, 0xc, 0xf, false); break; }
    return __builtin_bit_cast(float, r);
}
__device__ __forceinline__ float wave_sum(float v) {
    v += dppf(v, 1); v += dppf(v, 2); v += dppf(v, 4); v += dppf(v, 8); v += dppf(v, 15); v += dppf(v, 31);
    return __builtin_bit_cast(float, __builtin_amdgcn_readlane(__builtin_bit_cast(int, v), 63));
}
__device__ __forceinline__ float bf2f(unsigned short b) { return __uint_as_float(((unsigned)b) << 16); }
__device__ __forceinline__ unsigned pk2(float a, float b) { return pg8::cvt_pk_bf16(a, b); }
__device__ __forceinline__ unsigned pk2s(float a, float b) { unsigned r; asm("v_cvt_pk_bf16_f32 %0, %1, %2" : "=v"(r) : "v"(a), "v"(b)); return r; }
__device__ __forceinline__ float silu_f(float g) { return g * __builtin_amdgcn_rcpf(1.0f + __builtin_amdgcn_exp2f(-1.4426950408889634f * g)); }
__device__ __forceinline__ int dmap(int P) { return ((P >> 2) & 1) * 64 + (P >> 3) * 4 + (P & 3); }
__device__ __forceinline__ int pmap(int d) { return ((d >> 4) & 3) * 32 + ((d >> 2) & 3) * 8 + ((d >> 6) & 1) * 4 + (d & 3); }

constexpr int RB = 6;
__device__ __forceinline__ f32x4 unpack_bf4(const u32x2 w) { f32x4 v; v[0] = __uint_as_float(w.x << 16); v[1] = __uint_as_float(w.x & 0xffff0000u); v[2] = __uint_as_float(w.y << 16); v[3] = __uint_as_float(w.y & 0xffff0000u); return v; }
__device__ __forceinline__ float sumsq4(const f32x4 a) { return (a[0] * a[0] + a[1] * a[1]) + (a[2] * a[2] + a[3] * a[3]); }
template <int MODE> __device__ __forceinline__ int rowmap(int c) {
    if (MODE == 0) { if (c < 1024) return (c & ~127) + pmap(c & 127);
        if (c >= 2560) { const int cc = (c - 2560) & 511, hcsel = (c >= 3072) ? 128 : 0; return 2560 + ((cc >> 7) << 8) + hcsel + (cc & 127); }
        return c; }
    if (MODE == 1) return c;
    if (MODE == 2) return ((c >> 7) << 8) + (c & 127);
    return ((c >> 7) << 8) + 128 + (c & 127);
}
template <int MODE, bool GAIN = false>
__device__ __forceinline__ void transpose_item(const float* W, int K, int N, bf16_t* WT, LAS float* scr, int item, int lane, const float* gain = nullptr) {
    const int nblk = N / 32, kb = item / nblk, nb = item % nblk, k0 = 64 * kb, n0 = 32 * nb;
#pragma unroll
    for (int i = 0; i < 32; ++i) { const int kk = 2 * i + (lane >> 5); scr[kk * 33 + (lane & 31)] = W[(size_t)(k0 + kk) * N + n0 + (lane & 31)]; }
    asm volatile("s_waitcnt lgkmcnt(0)" ::: "memory");
    const int c = lane & 7;
    f32x4 ga = (f32x4){1.f, 1.f, 1.f, 1.f}, gb = ga;
    if (GAIN) { ga = *(const f32x4*)(gain + k0 + 8 * c); gb = *(const f32x4*)(gain + k0 + 8 * c + 4); }
#pragma unroll
    for (int j = 0; j < 4; ++j) { const int n = (lane >> 3) + 8 * j; const LAS float* s = scr + (8 * c) * 33 + n;
        u32x4 o; o.x = pk2(s[0 * 33] * ga[0], s[1 * 33] * ga[1]); o.y = pk2(s[2 * 33] * ga[2], s[3 * 33] * ga[3]); o.z = pk2(s[4 * 33] * gb[0], s[5 * 33] * gb[1]); o.w = pk2(s[6 * 33] * gb[2], s[7 * 33] * gb[3]);
        *(u32x4*)(WT + (size_t)rowmap<MODE>(n0 + n) * K + k0 + 8 * c) = o; }
    asm volatile("s_waitcnt lgkmcnt(0)" ::: "memory");
}
__device__ __forceinline__ void phase0(const Params& p, LAS unsigned char* lds, int tid, int wid, int lane) {
    LAS float* scr = (LAS float*)(lds + wid * 8448);
    const int gw = blockIdx.x * 8 + wid, NGW = gridDim.x * 8;
    bf16_t* win = (bf16_t*)(p.ws + WS_WIN); bf16_t* wout = (bf16_t*)(p.ws + WS_WOUT); bf16_t* wff1 = (bf16_t*)(p.ws + WS_WFF1); bf16_t* wdn = (bf16_t*)(p.ws + WS_WDN);
    constexpr int I_IN = 16 * 112, I_OUT = 16 * 32, I_UP = 16 * 128, I_DN = 64 * 32, NITEMS = I_IN + I_OUT + 2 * I_UP + I_DN;
    for (int it = gw; it < NITEMS; it += NGW) {
        int r = it;
        if (r < I_IN) { transpose_item<0, true>(p.in[5], DM, NIN, win, scr, r, lane, p.in[9]); continue; } r -= I_IN;
        if (r < I_OUT) { transpose_item<1>(p.in[6], DM, DM, wout, scr, r, lane); continue; } r -= I_OUT;
        if (r < I_UP) { transpose_item<2, true>(p.in[13], DM, DFF, wff1, scr, r, lane, p.in[11]); continue; } r -= I_UP;
        if (r < I_UP) { transpose_item<3, true>(p.in[14], DM, DFF, wff1, scr, r, lane, p.in[11]); continue; } r -= I_UP;
        transpose_item<1>(p.in[16], DFF, DM, wdn, scr, r, lane);
    }
    float* cosT = (float*)(p.ws + WS_COS); float* sinT = (float*)(p.ws + WS_SIN);
    for (int idx = blockIdx.x * 512 + tid; idx < 4112 * 64; idx += gridDim.x * 512) {
        const int pos = idx >> 6, f = idx & 63;
        const float inv = exp2f(-(float)(2 * f) * (1.0f / 128.0f) * 13.287712379549449f);
        const float ang = (float)pos * inv;
        const double rev = (double)ang * 0.15915494309189535;
        const float fr = (float)(rev - floor(rev));
        cosT[idx] = __builtin_amdgcn_cosf(fr); sinT[idx] = __builtin_amdgcn_sinf(fr);
    }
    bf16_t* H = (bf16_t*)(p.ws + WS_RA); bf16_t* XB = (bf16_t*)(p.ws + WS_XB); float* RS0 = (float*)(p.ws + WS_RS0);
#pragma unroll 1
    for (int base = gw; base < TOK; base += RB * NGW) {
        f32x4 v[RB][4]; float s[RB];
#pragma unroll
        for (int k = 0; k < RB; ++k) { const int rr = min(base + k * NGW, TOK - 1);
            const float* xrow = rr < TOK_P ? p.in[0] + (size_t)rr * DM : p.in[1] + (size_t)(rr - TOK_P) * DM; s[k] = 0.f;
#pragma unroll
            for (int j = 0; j < 4; ++j) { v[k][j] = __builtin_nontemporal_load((const f32x4*)xrow + lane + 64 * j); s[k] += sumsq4(v[k][j]); } }
#pragma unroll
        for (int k = 0; k < RB; ++k) { const int r = base + k * NGW; const float rstd = rsqrtf(wave_sum(s[k]) * (1.0f / DM) + EPS);
            if (r < TOK_P) {
                if (lane == 0) RS0[r] = __builtin_amdgcn_rcpf(rstd);
#pragma unroll
                for (int j = 0; j < 4; ++j) { const f32x4 y = v[k][j] * rstd; *((u32x2*)(XB + (size_t)r * DM) + lane + 64 * j) = (u32x2){pk2(y[0], y[1]), pk2(y[2], y[3])}; }
            } else if (r < TOK) {
#pragma unroll
                for (int j = 0; j < 4; ++j) { const f32x4 y = v[k][j] * rstd; *((u32x2*)(H + (size_t)r * DM) + lane + 64 * j) = (u32x2){pk2(y[0], y[1]), pk2(y[2], y[3])}; } } }
    }
}

constexpr int QI_OFF = 0, KI_OFF = 17408, KT_OFF = 34816, VT_OFF = 53248, SI_OFF = 71680, ST_OFF = 80896, GI_OFF = 115712;
#define MFMA16(a, b, c) __builtin_amdgcn_mfma_f32_16x16x32_bf16((a), (b), (c), 0, 0, 0)
#define RET_ISSUE(S, nn) do { _Pragma("unroll") for (int i_ = 0; i_ < 2; ++i_) { \
        const bf16_t* rowp_ = P + (tok0 + (size_t)(nn) * 64 + 2 * (tid >> 4) + i_) * NIN + 128 * h + (tid & 15) * 8; \
        if (FULL) { rq[S][i_] = *(const u32x4*)rowp_; rg[S][i_] = *(const u32x4*)(rowp_ + 1536); } rk[S][i_] = *(const u32x4*)(rowp_ + 512); rv[S][i_] = *(const u32x4*)(rowp_ + 1024); } } while (0)
#define RET_STAGE_A(S) do { const int j_ = 2 * (tid >> 4), ch_ = tid & 15; \
        if (FULL) { _Pragma("unroll") for (int i_ = 0; i_ < 2; ++i_) { *(LAS u32x4*)(lds + QI_OFF + (j_ + i_) * 272 + ch_ * 16) = rq[S][i_]; *(LAS u32x4*)(lds + KI_OFF + (j_ + i_) * 272 + ch_ * 16) = rk[S][i_]; *(LAS u32x4*)(lds + GI_OFF + (j_ + i_) * 272 + ch_ * 16) = rg[S][i_]; } } \
        const float te0_ = __builtin_amdgcn_exp2f(l2g * (float)(63 - j_)), te1_ = __builtin_amdgcn_exp2f(l2g * (float)(62 - j_)); \
        const unsigned ka_[4] = {rk[S][0].x, rk[S][0].y, rk[S][0].z, rk[S][0].w}, kb_[4] = {rk[S][1].x, rk[S][1].y, rk[S][1].z, rk[S][1].w}; \
        const unsigned va_[4] = {rv[S][0].x, rv[S][0].y, rv[S][0].z, rv[S][0].w}, vb_[4] = {rv[S][1].x, rv[S][1].y, rv[S][1].z, rv[S][1].w}; \
        const int cofs_ = 16 * ((j_ >> 3) ^ (ch_ & 7)) + 2 * (j_ & 7); \
        _Pragma("unroll") for (int e2 = 0; e2 < 4; ++e2) { const int row_ = 8 * ch_ + 2 * e2; \
            *(LAS unsigned*)(lds + KT_OFF + row_ * 144 + cofs_) = pk2(__uint_as_float(ka_[e2] << 16) * te0_, __uint_as_float(kb_[e2] << 16) * te1_); \
            *(LAS unsigned*)(lds + KT_OFF + (row_ + 1) * 144 + cofs_) = pk2(__uint_as_float(ka_[e2] & 0xffff0000u) * te0_, __uint_as_float(kb_[e2] & 0xffff0000u) * te1_); \
            *(LAS unsigned*)(lds + VT_OFF + row_ * 144 + cofs_) = (va_[e2] & 0xffffu) | (vb_[e2] << 16); \
            *(LAS unsigned*)(lds + VT_OFF + (row_ + 1) * 144 + cofs_) = (va_[e2] >> 16) | (vb_[e2] & 0xffff0000u); } } while (0)
#define WG_BAR() do { asm volatile("s_waitcnt lgkmcnt(0)" ::: "memory"); __builtin_amdgcn_s_barrier(); asm volatile("" ::: "memory"); } while (0)
template <bool FULL>
__device__ __forceinline__ void ret_unit(const Params& p, LAS unsigned char* lds, int unit, int tid, int wid, int lane) {
    asm volatile("" : "+v"(tid), "+v"(lane));
    const int G = unit & 7, h = (unit >> 3) & 3, b = unit >> 5;
    const bf16_t* P = (const bf16_t*)(p.ws + WS_RB);
    bf16_t* MIX = (bf16_t*)(p.ws + WS_RA);
    float* UG = (float*)(p.ws + WS_UG);
    const size_t tok0 = (size_t)b * 4096 + (size_t)G * 512;
    const float l2g = log2f(1.0f - exp2f(-5.0f - (float)h));
    const float g64 = __builtin_amdgcn_exp2f(l2g * 64.0f);
    const bool is_state = wid >= 4; const int w4 = wid & 3;
    const int l15 = lane & 15, l4 = lane >> 4;
    const int vtL = l4 ^ (l15 >> 3);
    const int vtb0 = VT_OFF + l15 * 144 + 16 * vtL, vtb1 = VT_OFF + l15 * 144 + 16 * (vtL ^ 2);
#define VT_ADDR(nt, ks) ((((nt) & 1) ? vtb1 : vtb0) + (nt) * 2304 + 16 * (((4 * (ks)) ^ (2 * ((nt) & 3))) & 4))
    constexpr int PD = FULL ? 1 : 4;
    u32x4 rq[PD][2], rk[PD][2], rv[PD][2], rg[PD][2];
    if (is_state) {
        f32x4 st[2][8];
#pragma unroll
        for (int mt = 0; mt < 2; ++mt)
#pragma unroll
            for (int nt = 0; nt < 8; ++nt) st[mt][nt] = (f32x4){0.f, 0.f, 0.f, 0.f};
        if (FULL) {
#pragma unroll 1
            for (int Gp = 0; Gp < G; Gp += 2) {
                const float wa = __builtin_amdgcn_exp2f(l2g * 512.0f * (float)(G - 1 - Gp));
                const bool two = Gp + 1 < G;
                const float wb = two ? __builtin_amdgcn_exp2f(l2g * 512.0f * (float)(G - 2 - Gp)) : 0.f;
                const u32x2* sa = (const u32x2*)UG + ((size_t)((b * 4 + h) * 8 + Gp) * 4 + w4) * 1024 + lane;
                const u32x2* sb = two ? sa + 4 * 1024 : sa;
#pragma unroll
                for (int mt = 0; mt < 2; ++mt)
#pragma unroll
                    for (int nt = 0; nt < 8; ++nt) st[mt][nt] += unpack_bf4(sa[(mt * 8 + nt) * 64]) * wa + unpack_bf4(sb[(mt * 8 + nt) * 64]) * wb;
            }
        }
#pragma unroll
        for (int s = 0; s < PD; ++s) RET_ISSUE(s, s);
#pragma unroll 1
        for (int n0 = 0; n0 < 8; n0 += PD) {
#pragma unroll
          for (int s = 0; s < PD; ++s) { const int n = n0 + s;
            RET_STAGE_A(s);
            if (n + PD < 8) RET_ISSUE(s, n + PD);
            if (FULL) {
#pragma unroll
                for (int mt = 0; mt < 2; ++mt)
#pragma unroll
                    for (int nt = 0; nt < 8; ++nt) { const int e = 16 * nt + l15, dk0 = 32 * w4 + 16 * mt + 4 * l4;
                        *(LAS u32x2*)(lds + ST_OFF + e * 272 + dk0 * 2) = (u32x2){pk2(st[mt][nt][0], st[mt][nt][1]), pk2(st[mt][nt][2], st[mt][nt][3])}; }
            }
            WG_BAR();
            if (FULL) {
                bf16x8 ak[4];
#pragma unroll
                for (int ks = 0; ks < 4; ++ks) ak[ks] = *(const LAS bf16x8*)(lds + KI_OFF + (16 * w4 + l15) * 272 + (32 * ks + 8 * l4) * 2);
#pragma unroll
                for (int it = 0; it < 4; ++it) {
                    bf16x8 bq[4];
#pragma unroll
                    for (int ks = 0; ks < 4; ++ks) bq[ks] = *(const LAS bf16x8*)(lds + QI_OFF + (16 * it + l15) * 272 + (32 * ks + 8 * l4) * 2);
                    f32x4 sa = (f32x4){0.f, 0.f, 0.f, 0.f};
#pragma unroll
                    for (int ks = 0; ks < 4; ++ks) sa = MFMA16(ak[ks], bq[ks], sa);
                    const int i = 16 * it + l15, j0 = 16 * w4 + 4 * l4;
#pragma unroll
                    for (int r = 0; r < 4; ++r) { const int d = i - (j0 + r); sa[r] *= __builtin_amdgcn_exp2f(l2g * (float)(d < 0 ? -d : d)); }
                    *(LAS u32x2*)(lds + SI_OFF + i * 144 + j0 * 2) = (u32x2){pk2(sa[0], sa[1]), pk2(sa[2], sa[3])};
                }
            }
            WG_BAR();
#pragma unroll
            for (int mt = 0; mt < 2; ++mt)
#pragma unroll
                for (int nt = 0; nt < 8; ++nt) st[mt][nt] = st[mt][nt] * g64;
#pragma unroll
            for (int ks = 0; ks < 2; ++ks) {
                bf16x8 akt[2];
#pragma unroll
                for (int mt = 0; mt < 2; ++mt) { const int row = 32 * w4 + 16 * mt + l15; akt[mt] = *(const LAS bf16x8*)(lds + KT_OFF + row * 144 + 16 * ((4 * ks + l4) ^ ((row >> 3) & 7))); }
#pragma unroll
                for (int nh = 0; nh < 2; ++nh) {
                    bf16x8 bv[4];
#pragma unroll
                    for (int nt = 0; nt < 4; ++nt) bv[nt] = *(const LAS bf16x8*)(lds + VT_ADDR(4 * nh + nt, ks));
#pragma unroll
                    for (int nt = 0; nt < 4; ++nt)
#pragma unroll
                        for (int mt = 0; mt < 2; ++mt) st[mt][4 * nh + nt] = MFMA16(akt[mt], bv[nt], st[mt][4 * nh + nt]);
                }
            }
            WG_BAR();
          }
        }
        if (!FULL) {
            u32x2* dst = (u32x2*)UG + ((size_t)unit * 4 + w4) * 1024 + lane;
#pragma unroll
            for (int mt = 0; mt < 2; ++mt)
#pragma unroll
                for (int nt = 0; nt < 8; ++nt) dst[(mt * 8 + nt) * 64] = (u32x2){pk2(st[mt][nt][0], st[mt][nt][1]), pk2(st[mt][nt][2], st[mt][nt][3])};
        } else if (G == 7) {
            float* o = p.out + O_SRP + (size_t)(b * 4 + h) * 16384 + (64 * (l4 & 1) + 16 * w4 + 4 * (l4 >> 1)) * 128 + l15;
#pragma unroll
            for (int mt = 0; mt < 2; ++mt)
#pragma unroll
                for (int nt = 0; nt < 8; ++nt)
#pragma unroll
                    for (int r = 0; r < 4; ++r) o[(8 * mt + r) * 128 + 16 * nt] = st[mt][nt][r];
        }
    } else {
        float rwv[8];
#pragma unroll
        for (int nt = 0; nt < 8; ++nt) rwv[nt] = p.in[8][128 * h + 16 * nt + l15];
#pragma unroll
        for (int s = 0; s < PD; ++s) RET_ISSUE(s, s);
#pragma unroll 1
        for (int n0 = 0; n0 < 8; n0 += PD) {
#pragma unroll
          for (int s = 0; s < PD; ++s) { const int n = n0 + s;
            RET_STAGE_A(s);
            if (n + PD < 8) RET_ISSUE(s, n + PD);
            WG_BAR();
            f32x4 acc[8];
            if (FULL) {
                f32x4 fsv;
#pragma unroll
                for (int r = 0; r < 4; ++r) fsv[r] = __builtin_amdgcn_exp2f(l2g * (float)(16 * w4 + 4 * l4 + r + 1));
#pragma unroll
                for (int nt = 0; nt < 8; ++nt) acc[nt] = (f32x4){0.f, 0.f, 0.f, 0.f};
                bf16x8 aq[4];
#pragma unroll
                for (int ks = 0; ks < 4; ++ks) aq[ks] = *(const LAS bf16x8*)(lds + QI_OFF + (16 * w4 + l15) * 272 + (32 * ks + 8 * l4) * 2);
#pragma unroll
                for (int ks = 0; ks < 4; ++ks)
#pragma unroll
                    for (int nh = 0; nh < 2; ++nh) {
                        bf16x8 bs[4];
#pragma unroll
                        for (int nt = 0; nt < 4; ++nt) bs[nt] = *(const LAS bf16x8*)(lds + ST_OFF + (16 * (4 * nh + nt) + l15) * 272 + (32 * ks + 8 * l4) * 2);
#pragma unroll
                        for (int nt = 0; nt < 4; ++nt) acc[4 * nh + nt] = MFMA16(aq[ks], bs[nt], acc[4 * nh + nt]);
                    }
#pragma unroll
                for (int nt = 0; nt < 8; ++nt) acc[nt] = acc[nt] * fsv;
            }
            WG_BAR();
            if (FULL) {
                bf16x8 as_[2];
#pragma unroll
                for (int ks = 0; ks < 2; ++ks) as_[ks] = *(const LAS bf16x8*)(lds + SI_OFF + (16 * w4 + l15) * 144 + 16 * (4 * ks + l4));
#pragma unroll
                for (int ks = 0; ks < 2; ++ks)
#pragma unroll
                    for (int nh = 0; nh < 2; ++nh) {
                        bf16x8 bv[4];
#pragma unroll
                        for (int nt = 0; nt < 4; ++nt) bv[nt] = *(const LAS bf16x8*)(lds + VT_ADDR(4 * nh + nt, ks));
#pragma unroll
                        for (int nt = 0; nt < 4; ++nt) acc[4 * nh + nt] = MFMA16(as_[ks], bv[nt], acc[4 * nh + nt]);
                    }
                unsigned short gq[4][8];
#pragma unroll
                for (int r = 0; r < 4; ++r)
#pragma unroll
                    for (int nt = 0; nt < 8; ++nt) gq[r][nt] = *(const LAS unsigned short*)(lds + GI_OFF + (16 * w4 + 4 * l4 + r) * 272 + (16 * nt + l15) * 2);
                float rstd[4];
#pragma unroll
                for (int r = 0; r < 4; ++r) { float ss = 0.f;
#pragma unroll
                    for (int nt = 0; nt < 8; ++nt) ss += acc[nt][r] * acc[nt][r];
                    ss += dppf(ss, 1); ss += dppf(ss, 2); ss += dppf(ss, 4); ss += dppf(ss, 8);
                    ss = __shfl(ss, (lane & 48) | 15);
                    rstd[r] = rsqrtf(ss * (1.0f / 128.0f) + EPS); }
#pragma unroll
                for (int r = 0; r < 4; ++r)
#pragma unroll
                    for (int nt = 0; nt < 8; ++nt)
                        *(LAS unsigned short*)(lds + QI_OFF + (16 * w4 + 4 * l4 + r) * 272 + (16 * nt + l15) * 2) = (unsigned short)(pk2s(acc[nt][r] * rstd[r] * rwv[nt] * silu_f(bf2f(gq[r][nt])), 0.f) & 0xffffu);
#pragma unroll
                for (int q = 0; q < 4; ++q) { const int cidx = lane + 64 * q, row = 16 * w4 + (cidx >> 4), ch = cidx & 15;
                    const u32x4 v = *(const LAS u32x4*)(lds + QI_OFF + row * 272 + ch * 16);
                    *(u32x4*)(MIX + (tok0 + (size_t)n * 64 + row) * DM + 128 * h + ch * 8) = v; }
            }
            WG_BAR();
          }
        }
    }
#ifndef CONVREP
#define CONVREP 1
#endif
    if (FULL) for (int crep_ = 0; crep_ < CONVREP; ++crep_) {
        const int c0 = 128 * h + 8 * (tid & 15), run = tid >> 4, t0 = G * 512 + run * 16;
        const float* cwp = p.in[7];
        float w0[8], w1[8], w2[8], p1[8], p2[8];
#pragma unroll
        for (int e = 0; e < 8; ++e) { w0[e] = cwp[c0 + e]; w1[e] = cwp[512 + c0 + e]; w2[e] = cwp[1024 + c0 + e]; p1[e] = 0.f; p2[e] = 0.f; }
        if (t0 > 0) {
            const bf16_t* r2 = P + ((size_t)b * 4096 + t0 - 2) * NIN; const bf16_t* r1 = r2 + NIN;
            const u32x4 c2 = *(const u32x4*)(r2 + 2560 + c0), c1 = *(const u32x4*)(r1 + 2560 + c0);
            const unsigned c2w[4] = {c2.x, c2.y, c2.z, c2.w}, c1w[4] = {c1.x, c1.y, c1.z, c1.w};
#pragma unroll
            for (int e = 0; e < 4; ++e) {
                p2[2 * e] = __uint_as_float(c2w[e] << 16); p2[2 * e + 1] = __uint_as_float(c2w[e] & 0xffff0000u);
                p1[2 * e] = __uint_as_float(c1w[e] << 16); p1[2 * e + 1] = __uint_as_float(c1w[e] & 0xffff0000u); }
        }
#pragma unroll 8
        for (int t = 0; t < 16; ++t) {
            const size_t row = (size_t)b * 4096 + t0 + t;
            const bf16_t* rp = P + row * NIN;
            const u32x4 bb = *(const u32x4*)(rp + 2048 + c0), cc = *(const u32x4*)(rp + 2560 + c0);
            const unsigned bw[4] = {bb.x, bb.y, bb.z, bb.w}, cw4[4] = {cc.x, cc.y, cc.z, cc.w};
            float y[8];
#pragma unroll
            for (int e = 0; e < 4; ++e) {
                const float ca = __uint_as_float(cw4[e] << 16), cb = __uint_as_float(cw4[e] & 0xffff0000u);
                y[2 * e] = __uint_as_float(bw[e] << 16) * (w0[2 * e] * p2[2 * e] + w1[2 * e] * p1[2 * e] + w2[2 * e] * ca);
                y[2 * e + 1] = __uint_as_float(bw[e] & 0xffff0000u) * (w0[2 * e + 1] * p2[2 * e + 1] + w1[2 * e + 1] * p1[2 * e + 1] + w2[2 * e + 1] * cb);
                p2[2 * e] = p1[2 * e]; p2[2 * e + 1] = p1[2 * e + 1]; p1[2 * e] = ca; p1[2 * e + 1] = cb;
            }
            *(u32x4*)(MIX + row * DM + 512 + c0) = (u32x4){pk2(y[0], y[1]), pk2(y[2], y[3]), pk2(y[4], y[5]), pk2(y[6], y[7])};
        }
        if (G == 7 && run == 31) {
            float* o = p.out + O_CCP + (size_t)b * 1024 + c0;
#pragma unroll
            for (int e = 0; e < 8; ++e) { o[e] = p2[e]; o[512 + e] = p1[e]; }
        }
    }
#undef VT_ADDR
}

__device__ __forceinline__ float ch_at(const float* PS, const float* cache, int b, int t, int ch) {
    if (t < 0) return cache[(b * 2 + (t + 2)) * 512 + ch];
    const float* rp = PS + (size_t)(16 * b + t) * NIN;
    const int cc = 2560 + ((ch >> 7) << 8) + (ch & 127);
    return rp[cc] * rp[cc + 128];
}
__device__ __forceinline__ void sample_unit(const Params& p, LAS unsigned char* lds, int sup, int tid, int wid, int lane) {
    const int su = sup >> 2, part = sup & 3;
    const int b = su >> 2, h = su & 3, ts0 = TOK_P + 16 * b;
    const float* PS = (const float*)(p.ws + WS_PS);
    bf16_t* MIX = (bf16_t*)(p.ws + WS_RA);
    LAS float* qs = (LAS float*)lds; LAS float* ks = qs + 2048; LAS float* vs = qs + 4096; LAS float* Ssm = qs + 6144; LAS float* osm = qs + 6400;
    const float l2g = log2f(1.0f - exp2f(-5.0f - (float)h));
    const float* cosT = (const float*)(p.ws + WS_COS); const float* sinT = (const float*)(p.ws + WS_SIN);
    for (int idx = tid; idx < 2048; idx += 512) { const int i = idx >> 7, c = idx & 127, d = dmap(c);
        const float* rp = PS + (size_t)(16 * b + i) * NIN + 128 * h;
        const float cs = cosT[(4096 + i) * 64 + (d & 63)], sn = sinT[(4096 + i) * 64 + (d & 63)];
        const float xq = rp[c], xqp = rp[c ^ 4], xk = rp[512 + c], xkp = rp[512 + (c ^ 4)];
        qs[i * 128 + d] = d < 64 ? xq * cs - xqp * sn : xq * cs + xqp * sn;
        ks[i * 128 + d] = (d < 64 ? xk * cs - xkp * sn : xk * cs + xkp * sn) * 0.08838834764831845f;
        vs[i * 128 + c] = rp[1024 + c]; }
    const int e = tid & 127, sub = tid >> 7, irow = 4 * part + sub;
    LAS float* s0 = qs + 8704;
    { const float* s0g = p.in[2] + (size_t)su * 16384; f32x4 t8[8];
#pragma unroll
      for (int q = 0; q < 8; ++q) t8[q] = *((const f32x4*)s0g + tid + 512 * q);
#pragma unroll
      for (int q = 0; q < 8; ++q) *((LAS f32x4*)s0 + tid + 512 * q) = t8[q]; }
    __syncthreads();
    if (tid < 64) { const int i = 4 * part + (tid >> 4), j = tid & 15; float s = 0.f;
        for (int d = 0; d < 128; ++d) s += qs[i * 128 + d] * ks[j * 128 + d];
        const int dd = i - j; Ssm[i * 16 + j] = s * __builtin_amdgcn_exp2f(l2g * (float)(dd < 0 ? -dd : dd)); }
    float cr = 0.f;
#pragma unroll 8
    for (int d = 0; d < 128; ++d) cr += qs[irow * 128 + d] * s0[d * 128 + e];
    __syncthreads();
    { float o = 0.f;
      for (int j = 0; j < 16; ++j) o += Ssm[irow * 16 + j] * vs[j * 128 + e];
      osm[irow * 128 + e] = o + __builtin_amdgcn_exp2f(l2g * (float)(irow + 1)) * cr; }
    __syncthreads();
    if (wid < 4) { const int i = 4 * part + wid; const float v0 = osm[i * 128 + lane], v1 = osm[i * 128 + 64 + lane];
        const float rstd = rsqrtf(wave_sum(v0 * v0 + v1 * v1) * (1.0f / 128.0f) + EPS);
        const size_t token = (size_t)(ts0 + i);
        const float g0 = PS[(size_t)(16 * b + i) * NIN + 1536 + 128 * h + lane], g1 = PS[(size_t)(16 * b + i) * NIN + 1536 + 128 * h + 64 + lane];
        MIX[token * DM + 128 * h + lane] = (bf16_t)(pk2(v0 * rstd * p.in[8][128 * h + lane] * silu_f(g0), 0.f) & 0xffffu);
        MIX[token * DM + 128 * h + 64 + lane] = (bf16_t)(pk2(v1 * rstd * p.in[8][128 * h + 64 + lane] * silu_f(g1), 0.f) & 0xffffu); }
    const float g16 = __builtin_amdgcn_exp2f(l2g * 16.0f);
    float* outS = p.out + O_SRS + (size_t)su * 16384;
#pragma unroll 2
    for (int dd = 0; dd < 8; ++dd) { const int d = 32 * part + sub + 4 * dd; float a = g16 * s0[d * 128 + e];
        for (int j = 0; j < 16; ++j) a += __builtin_amdgcn_exp2f(l2g * (float)(15 - j)) * ks[j * 128 + d] * vs[j * 128 + e];
        outS[d * 128 + e] = a; }
    { const int ch = 128 * h + e; const float* cache = p.in[3]; const float* cwp = p.in[7];
      const float w0 = cwp[ch], w1 = cwp[512 + ch], w2 = cwp[1024 + ch];
      const int t = irow;
      const float c0 = ch_at(PS, cache, b, t - 2, ch), c1 = ch_at(PS, cache, b, t - 1, ch), c2 = ch_at(PS, cache, b, t, ch);
      const float y = PS[(size_t)(16 * b + t) * NIN + 2048 + ch] * (w0 * c0 + w1 * c1 + w2 * c2);
      MIX[(size_t)(ts0 + t) * DM + 512 + ch] = (bf16_t)(pk2(y, 0.f) & 0xffffu);
      if (t >= 14) p.out[O_CCS + (size_t)(b * 2 + t - 14) * 512 + ch] = c2; }
    __syncthreads();
}

constexpr int TG_B = 34816, TG_BUF = 34816 + 32 * 272;
template <int NB>
__device__ __forceinline__ void thin_gemm2(LAS unsigned char* lds, const bf16_t* A, int lda, const bf16_t* Bt, int ldb, int n0, int nbstride, int kbeg, int klen, f32x4 (&acc)[NB], int tid, int wid, int lane) {
    const int l15 = lane & 15, l4 = lane >> 4, nkb = klen >> 7;
    const bool hasb = tid < NB * 256;
    const bf16_t* ag = A + (size_t)(tid >> 4) * lda + kbeg + (tid & 15) * 8;
    const bf16_t* bg = Bt + (size_t)(n0 + (tid >> 8) * nbstride + ((tid >> 4) & 15)) * ldb + kbeg + (tid & 15) * 8;
    const int sto = (tid >> 4) * 272 + (tid & 15) * 16;
    const int fro = l15 * 272 + (8 * l4) * 2;
    u32x4 Xa[4], Ya[4], Xb = (u32x4){0u, 0u, 0u, 0u}, Yb = Xb;
#define TG_LOAD(R, kb) do { _Pragma("unroll") for (int i_ = 0; i_ < 4; ++i_) R##a[i_] = *(const u32x4*)(ag + (size_t)(32 * i_) * lda + (kb) * 128); if (hasb) R##b = *(const u32x4*)(bg + (kb) * 128); } while (0)
#define TG_STORE(R, buf) do { _Pragma("unroll") for (int i_ = 0; i_ < 4; ++i_) *(LAS u32x4*)(lds + (buf) * TG_BUF + sto + i_ * 32 * 272) = R##a[i_]; if (hasb) *(LAS u32x4*)(lds + (buf) * TG_BUF + TG_B + sto) = R##b; } while (0)
#define TG_COMP(buf) do { _Pragma("unroll") for (int ks = 0; ks < 4; ++ks) { const bf16x8 a_ = *(const LAS bf16x8*)(lds + (buf) * TG_BUF + 16 * wid * 272 + fro + ks * 64); \
        _Pragma("unroll") for (int nb = 0; nb < NB; ++nb) { const bf16x8 b_ = *(const LAS bf16x8*)(lds + (buf) * TG_BUF + TG_B + 16 * nb * 272 + fro + ks * 64); acc[nb] = MFMA16(a_, b_, acc[nb]); } } } while (0)
#pragma unroll
    for (int nb = 0; nb < NB; ++nb) acc[nb] = (f32x4){0.f, 0.f, 0.f, 0.f};
    TG_LOAD(X, 0); TG_LOAD(Y, 1);
    TG_STORE(X, 0); WG_BAR();
#pragma unroll 1
    for (int kb = 0; kb < nkb; kb += 2) {
        if (kb + 2 < nkb) TG_LOAD(X, kb + 2);
        TG_COMP(0);
        TG_STORE(Y, 1); WG_BAR();
        if (kb + 3 < nkb) TG_LOAD(Y, kb + 3);
        TG_COMP(1);
        if (kb + 2 < nkb) TG_STORE(X, 0);
        WG_BAR();
    }
#undef TG_LOAD
#undef TG_STORE
#undef TG_COMP
}
template <int NB>
__device__ __forceinline__ void thin_gemm(const bf16_t* A, int lda, const bf16_t* Bt, int ldb, int n0, int nbstride, int kbeg, int klen, f32x4 (&acc)[NB], int wid, int lane) {
    const int l15 = lane & 15, l4 = lane >> 4;
    const bf16_t* ap = A + (size_t)(16 * wid + l15) * lda + kbeg + 8 * l4;
    const bf16_t* bp = Bt + (size_t)(n0 + l15) * ldb + kbeg + 8 * l4;
#pragma unroll
    for (int nb = 0; nb < NB; ++nb) acc[nb] = (f32x4){0.f, 0.f, 0.f, 0.f};
#pragma unroll 1
    for (int s0 = 0; s0 < klen; s0 += 256) {
        bf16x8 a[8], b[NB][8];
#pragma unroll
        for (int s = 0; s < 8; ++s) { a[s] = *(const bf16x8*)(ap + s0 + 32 * s);
#pragma unroll
            for (int nb = 0; nb < NB; ++nb) b[nb][s] = *(const bf16x8*)(bp + (size_t)nb * nbstride * ldb + s0 + 32 * s); }
#pragma unroll
        for (int s = 0; s < 8; ++s)
#pragma unroll
            for (int nb = 0; nb < NB; ++nb) acc[nb] = MFMA16(a[s], b[nb][s], acc[nb]);
    }
}
__device__ __forceinline__ void thin_store(const f32x4& acc, float* out, int ldo, int col, int wid, int lane) {
#pragma unroll
    for (int r = 0; r < 4; ++r) out[(size_t)(16 * wid + 4 * (lane >> 4) + r) * ldo + col + (lane & 15)] = acc[r];
}
__device__ __forceinline__ void thin_ffn1(const Params& p, LAS unsigned char* lds, int c, int tid, int wid, int lane) {
    const int pn = c >> 3, j16 = c & 7, l15 = lane & 15, l4 = lane >> 4;
    f32x4 acc[2];
    thin_gemm2<2>(lds, (const bf16_t*)(p.ws + WS_Y) + (size_t)TOK_P * DM, DM, (const bf16_t*)(p.ws + WS_WFF1), DM, 256 * pn + 16 * j16, 128, 0, DM, acc, tid, wid, lane);
    const int ch = 128 * pn + 16 * j16 + l15, b = wid;
    const float* cw = p.in[15]; const float* cache = p.in[4] + (size_t)b * 2 * DFF + ch;
    const float w0 = cw[ch], w1 = cw[DFF + ch], w2 = cw[2 * DFF + ch];
    const f32x4 up = acc[0], gt = acc[1];
    float pm1 = __shfl_up(up[3], 16), pm2 = __shfl_up(up[2], 16);
    if (l4 == 0) { pm1 = cache[DFF]; pm2 = cache[0]; }
    float uc[4];
    uc[0] = w0 * pm2 + w1 * pm1 + w2 * up[0];
    uc[1] = w0 * pm1 + w1 * up[0] + w2 * up[1];
    uc[2] = w0 * up[0] + w1 * up[1] + w2 * up[2];
    uc[3] = w0 * up[1] + w1 * up[2] + w2 * up[3];
    bf16_t* ACT = (bf16_t*)(p.ws + WS_RB);
#pragma unroll
    for (int r = 0; r < 4; ++r) ACT[(size_t)(TOK_P + 16 * wid + 4 * l4 + r) * DFF + ch] = (bf16_t)(pk2(pg8::gelu_tanh(uc[r]) * gt[r], 0.f) & 0xffffu);
    if (l4 == 3) { float* o = p.out + O_CFS + (size_t)b * 2 * DFF + ch; o[0] = up[2]; o[DFF] = up[3]; }
}

__device__ __forceinline__ void phase4(const Params& p, int wid, int lane) {
    const int gw = blockIdx.x * 8 + wid, NGW = gridDim.x * 8;
    bf16_t* Y = (bf16_t*)(p.ws + WS_Y); const float* ssq = (const float*)(p.ws + WS_SSQ1); float* RS2 = (float*)(p.ws + WS_RS2); const bf16_t* XB = (const bf16_t*)(p.ws + WS_XB); const float* RS0 = (const float*)(p.ws + WS_RS0);
    const float* wpost = p.in[10];
    f32x4 wpo[4];
#pragma unroll
    for (int j = 0; j < 4; ++j) wpo[j] = *((const f32x4*)wpost + lane + 64 * j);
#pragma unroll 1
    for (int base = gw; base < TOK_P; base += RB * NGW) {
        f32x4 v[RB][4]; u32x2 yw[RB][4]; float sq[RB], i0[RB];
#pragma unroll
        for (int k = 0; k < RB; ++k) { const int rr = min(base + k * NGW, TOK_P - 1);
            i0[k] = RS0[rr];
#pragma unroll
            for (int j = 0; j < 4; ++j) { v[k][j] = unpack_bf4(__builtin_nontemporal_load((const u32x2*)(XB + (size_t)rr * DM) + lane + 64 * j)); yw[k][j] = __builtin_nontemporal_load((const u32x2*)(Y + (size_t)rr * DM) + lane + 64 * j); } }
        float s2[RB];
#pragma unroll
        for (int k = 0; k < RB; ++k) { sq[k] = 0.f;
#pragma unroll
            for (int j = 0; j < 4; ++j) sq[k] += sumsq4(unpack_bf4(yw[k][j]));
            const float rstd1 = rsqrtf(wave_sum(sq[k]) * (1.0f / DM) + EPS); s2[k] = 0.f;
#pragma unroll
            for (int j = 0; j < 4; ++j) { v[k][j] = v[k][j] * i0[k] + (unpack_bf4(yw[k][j]) * rstd1) * wpo[j]; s2[k] += sumsq4(v[k][j]); } }
#pragma unroll
        for (int k = 0; k < RB; ++k) { const int r = base + k * NGW; const float rstd2 = rsqrtf(wave_sum(s2[k]) * (1.0f / DM) + EPS);
            if (r < TOK_P) {
                if (lane == 0) RS2[r] = __builtin_amdgcn_rcpf(rstd2);
#pragma unroll
                for (int j = 0; j < 4; ++j) { const f32x4 y = v[k][j] * rstd2; *((u32x2*)(Y + (size_t)r * DM) + lane + 64 * j) = (u32x2){pk2(y[0], y[1]), pk2(y[2], y[3])}; } } }
    }
    for (int r = TOK_P + gw; r < TOK; r += NGW) {
        const float* xrow = p.in[1] + (size_t)(r - TOK_P) * DM; const float* ys = (const float*)(p.ws + WS_YS) + (size_t)(r - TOK_P) * DM;
        f32x4 yv[4], v[4]; float s = 0.f, s2 = 0.f;
#pragma unroll
        for (int j = 0; j < 4; ++j) { f32x4 a = *((const f32x4*)ys + lane + 64 * j);
#pragma unroll
            for (int q = 1; q < 4; ++q) a += *((const f32x4*)(ys + (size_t)q * 128 * DM) + lane + 64 * j);
            yv[j] = a; s += sumsq4(a); }
        const float rstd1 = rsqrtf(wave_sum(s) * (1.0f / DM) + EPS);
#pragma unroll
        for (int j = 0; j < 4; ++j) { v[j] = *((const f32x4*)xrow + lane + 64 * j) + (yv[j] * rstd1) * wpo[j]; s2 += sumsq4(v[j]);
 }
        const float rstd2 = rsqrtf(wave_sum(s2) * (1.0f / DM) + EPS);
#pragma unroll
        for (int j = 0; j < 4; ++j) { const f32x4 y = v[j] * rstd2; *((u32x2*)(Y + (size_t)r * DM) + lane + 64 * j) = (u32x2){pk2(y[0], y[1]), pk2(y[2], y[3])}; }
    }
}
__device__ __forceinline__ void phase7(const Params& p, int wid, int lane) {
    const int gw = blockIdx.x * 8 + wid, NGW = gridDim.x * 8;
    const bf16_t* F = (const bf16_t*)(p.ws + WS_RA); const bf16_t* Y = (const bf16_t*)(p.ws + WS_Y);
    const float* ssq1 = (const float*)(p.ws + WS_SSQ1); const float* ssq2 = (const float*)(p.ws + WS_SSQ2);
    f32x4 wm[4], wf[4];
#pragma unroll
    for (int j = 0; j < 4; ++j) { wm[j] = *((const f32x4*)p.in[10] + lane + 64 * j); wf[j] = *((const f32x4*)p.in[12] + lane + 64 * j); }
    constexpr int RB7 = 6;
    const float* RS2p = (const float*)(p.ws + WS_RS2);
#pragma unroll 1
    for (int base = gw; base < TOK_P; base += RB7 * NGW) {
        u32x2 xw[RB7][4], fw[RB7][4]; float sq2[RB7], i2[RB7];
#pragma unroll
        for (int k = 0; k < RB7; ++k) { const int rr = min(base + k * NGW, TOK_P - 1);
            i2[k] = RS2p[rr];
#pragma unroll
            for (int j = 0; j < 4; ++j) { xw[k][j] = __builtin_nontemporal_load((const u32x2*)(Y + (size_t)rr * DM) + lane + 64 * j); fw[k][j] = __builtin_nontemporal_load((const u32x2*)(F + (size_t)rr * DM) + lane + 64 * j); } }
#pragma unroll
        for (int k = 0; k < RB7; ++k) { const int r = base + k * NGW; sq2[k] = 0.f;
#pragma unroll
            for (int j = 0; j < 4; ++j) sq2[k] += sumsq4(unpack_bf4(fw[k][j]));
            const float rstd2 = rsqrtf(wave_sum(sq2[k]) * (1.0f / DM) + EPS);
            if (r < TOK_P) {
#pragma unroll
                for (int j = 0; j < 4; ++j) __builtin_nontemporal_store(unpack_bf4(xw[k][j]) * i2[k] + (unpack_bf4(fw[k][j]) * rstd2) * wf[j], (f32x4*)(p.out + (size_t)r * DM) + lane + 64 * j); } }
    }
    for (int r = TOK_P + gw; r < TOK; r += NGW) {
        const float* xrow = p.in[1] + (size_t)(r - TOK_P) * DM;
        const float* ys = (const float*)(p.ws + WS_YS) + (size_t)(r - TOK_P) * DM; const float* fs = (const float*)(p.ws + WS_FS) + (size_t)(r - TOK_P) * DM;
        f32x4 yv[4], fv[4]; float s1 = 0.f, s2 = 0.f;
#pragma unroll
        for (int j = 0; j < 4; ++j) { f32x4 a = *((const f32x4*)ys + lane + 64 * j), c = *((const f32x4*)fs + lane + 64 * j);
#pragma unroll
            for (int q = 1; q < 4; ++q) { a += *((const f32x4*)(ys + (size_t)q * 128 * DM) + lane + 64 * j); c += *((const f32x4*)(fs + (size_t)q * 128 * DM) + lane + 64 * j); }
            yv[j] = a; fv[j] = c; s1 += sumsq4(a); s2 += sumsq4(c); }
        const float rstd1 = rsqrtf(wave_sum(s1) * (1.0f / DM) + EPS), rstd2 = rsqrtf(wave_sum(s2) * (1.0f / DM) + EPS);
#pragma unroll
        for (int j = 0; j < 4; ++j) *((f32x4*)(p.out + (size_t)r * DM) + lane + 64 * j) = *((const f32x4*)xrow + lane + 64 * j) + (yv[j] * rstd1) * wm[j] + (fv[j] * rstd2) * wf[j];
    }
}


#define XB_TMO      128
#define XB_XCNT(j)  (256  + 64 * (j))
#define XB_XSUB(j)  (1280 + 64 * (j))
#define XB_XGEN(j)  (2304 + 64 * (j))
#define XB_TOP      3328
#define XB_TOPGEN   3392
#define XCD_BAR_WORDS 3456
#define XB_SPIN_CAP (1u << 18)

__device__ __forceinline__ unsigned xb_ld(unsigned* p)              { return __hip_atomic_load(p, __ATOMIC_RELAXED, __HIP_MEMORY_SCOPE_AGENT); }
__device__ __forceinline__ unsigned xb_add(unsigned* p, unsigned v) { return __hip_atomic_fetch_add(p, v, __ATOMIC_RELAXED, __HIP_MEMORY_SCOPE_AGENT); }
__device__ __forceinline__ unsigned xb_xcc_id() { return (unsigned)__builtin_amdgcn_s_getreg((3 << 11) | 20) & 0xFu; }
#define XB_SPIN(cond, bar) do { unsigned _sp = 0; while (cond) { __builtin_amdgcn_s_sleep(1); \
    if ((++_sp & 255u) == 0u) { if (xb_ld(&(bar)[XB_TMO])) break; if (_sp > XB_SPIN_CAP) { atomicAdd(&(bar)[XB_TMO], 1u); break; } } } } while (0)

struct XcdBarrier {
    unsigned* bar; unsigned x;
    volatile LAS unsigned* st;
};

__device__ __forceinline__ XcdBarrier xcd_barrier_post(unsigned* bar, volatile LAS unsigned* st) {
    XcdBarrier b; b.bar = bar; b.x = xb_xcc_id(); b.st = st;
    if (threadIdx.x == 0) (void)xb_add(&bar[XB_XCNT(b.x)], 1u);
    return b;
}
__device__ __forceinline__ void xcd_barrier_complete(unsigned* bar, unsigned x, unsigned& nloc, unsigned& nx) {
    const unsigned G = gridDim.x * gridDim.y * gridDim.z;
    unsigned sum, cnt, mine, sp = 0u;
    for (;;) {
        sum = 0u; cnt = 0u; mine = 0u;
#pragma unroll
        for (unsigned j = 0; j < 16; ++j) { const unsigned c = xb_ld(&bar[XB_XCNT(j)]); sum += c; cnt += (c > 0u) ? 1u : 0u; mine = (j == x) ? c : mine; }
        if (sum == G) break;
        __builtin_amdgcn_s_sleep(1);
        if ((++sp & 255u) == 0u) { if (xb_ld(&bar[XB_TMO])) break; if (sp > XB_SPIN_CAP) { atomicAdd(&bar[XB_TMO], 1u); break; } }
    }
    nloc = mine > 0u ? mine : 1u; nx = cnt > 0u ? cnt : 1u;
}

__device__ __forceinline__ void xcd_barrier(const XcdBarrier& b) {
    asm volatile("s_waitcnt vmcnt(0)" ::: "memory");
    __syncthreads();
    if (threadIdx.x == 0) {
        unsigned* bar = b.bar;
        __builtin_amdgcn_s_waitcnt(0);
        unsigned nloc = b.st[0], nx = b.st[1];
        if (nloc == 0u) { xcd_barrier_complete(bar, b.x, nloc, nx); b.st[0] = nloc; b.st[1] = nx; }
        const unsigned old = xb_add(&bar[XB_XSUB(b.x)], 1u);
        const unsigned gen = old / nloc;
        if (old + 1u == (gen + 1u) * nloc) {
            __builtin_amdgcn_fence(__ATOMIC_RELEASE, "agent");
            asm volatile("s_waitcnt vmcnt(0)" ::: "memory");
            const unsigned og = xb_add(&bar[XB_TOP], 1u);
            const unsigned tg = og / nx;
            if (og + 1u == (tg + 1u) * nx) xb_add(&bar[XB_TOPGEN], 1u);
            else XB_SPIN(xb_ld(&bar[XB_TOPGEN]) == tg, bar);
            __builtin_amdgcn_fence(__ATOMIC_ACQUIRE, "agent");
            xb_add(&bar[XB_XGEN(b.x)], 1u);
            asm volatile("s_waitcnt vmcnt(0)" ::: "memory");
        } else {
            XB_SPIN(xb_ld(&bar[XB_XGEN(b.x)]) == gen, bar);
            __builtin_amdgcn_fence(__ATOMIC_ACQUIRE, "agent");
            asm volatile("s_waitcnt vmcnt(0)" ::: "memory");
        }
    }
    __syncthreads();
}

#ifndef MK_LAUNCHES
#define MK_LAUNCHES 1
#endif
#ifndef REP0
#define REP0 1
#endif
#ifndef REP1
#define REP1 1
#endif
#ifndef REP2
#define REP2 1
#endif
#ifndef REP3
#define REP3 1
#endif
#ifndef REP4
#define REP4 1
#endif
#ifndef REP5
#define REP5 1
#endif
#ifndef REP6
#define REP6 1
#endif
#ifndef REP7
#define REP7 1
#endif
#define REPEAT(n) for (int rep_ = 0; rep_ < (n); ++rep_, ((rep_ < (n)) ? GRIDSYNC() : (void)0))
template <int PH_LO, int PH_HI>
__device__ __forceinline__ void run_phases(const Params& p, LAS unsigned char* lds) {
    int tid = threadIdx.x, lane = tid & 63; const int wid = __builtin_amdgcn_readfirstlane(tid >> 6);
    const int G = gridDim.x, c = blockIdx.x;
#define LAUNDER() asm volatile("" : "+v"(tid), "+v"(lane))
    XcdBarrier bar_;
    if (PH_HI - PH_LO > 1) {
        volatile LAS unsigned* stw = (volatile LAS unsigned*)(lds + LDS_BARW);
        if (threadIdx.x == 0) { stw[0] = 0u; stw[1] = 0u; }
        __syncthreads();
        bar_ = xcd_barrier_post((unsigned*)p.ws, stw);
        if (p.ws == nullptr) cg::this_grid().sync();
    }
#define GRIDSYNC() xcd_barrier(bar_)
#define SEAM(ph) do { if (PH_LO <= (ph) && (ph) + 1 < PH_HI) { GRIDSYNC(); } } while (0)
#ifdef XSYNC
    for (int xs_ = 0; xs_ < XSYNC; ++xs_) GRIDSYNC();
#endif
    if (PH_LO <= 0 && 0 < PH_HI) REPEAT(REP0) { LAUNDER(); phase0(p, lds, tid, wid, lane); }
    SEAM(0);
    if (PH_LO <= 1 && 1 < PH_HI) REPEAT(REP1) {
        for (int t = c; t < 224; t += G) { f32x4 acc[1]; thin_gemm2<1>(lds, (const bf16_t*)(p.ws + WS_RA) + (size_t)TOK_P * DM, DM, (const bf16_t*)(p.ws + WS_WIN), DM, 16 * t, 0, 0, DM, acc, tid, wid, lane);
            thin_store(acc[0], (float*)(p.ws + WS_PS), NIN, 16 * t, wid, lane); }
        pg8::Gemm g{(const bf16_t*)(p.ws + WS_XB), (const bf16_t*)(p.ws + WS_WIN), TOK_P, NIN, DM};
        pg8::StaticOrder S; S.init(TOK_P, NIN, G, c);
        pg8::EpiIn E{(bf16_t*)(p.ws + WS_RB), (const float*)(p.ws + WS_COS), (const float*)(p.ws + WS_SIN), (const float*)(p.ws + WS_RS0)};
        pg8::gemm_phase<pg8::EpiIn, pg8::StaticOrder, true, true>(lds, g, S, E);
    }
    SEAM(1);
    if (PH_LO <= 2 && 2 < PH_HI) REPEAT(REP2) {
#ifndef RUREP
#define RUREP 1
#endif
        for (int rrep_ = 0; rrep_ < RUREP; ++rrep_) for (int u = c; u < 256; u += G) ret_unit<false>(p, lds, u, tid, wid, lane);
        LAUNDER();
#ifndef SUREP
#define SUREP 1
#endif
        for (int srep_ = 0; srep_ < SUREP; ++srep_) for (int su = c; su < 128; su += G) sample_unit(p, lds, su, tid, wid, lane);
    }
    SEAM(2);
    if (PH_LO <= 3 && 3 < PH_HI) REPEAT(REP3) {
        for (int u = c; u < 256; u += G) ret_unit<true>(p, lds, u, tid, wid, lane);
    }
    SEAM(3);
    if (PH_LO <= 4 && 4 < PH_HI) REPEAT(REP4) {
        for (int t = c; t < 256; t += G) { f32x4 acc[1]; const int kq = t >> 6, nt = t & 63;
            thin_gemm2<1>(lds, (const bf16_t*)(p.ws + WS_RA) + (size_t)TOK_P * DM, DM, (const bf16_t*)(p.ws + WS_WOUT), DM, 16 * nt, 0, 256 * kq, 256, acc, tid, wid, lane);
            thin_store(acc[0], (float*)(p.ws + WS_YS) + (size_t)kq * 128 * DM, DM, 16 * nt, wid, lane); }
        pg8::Gemm g{(const bf16_t*)(p.ws + WS_RA), (const bf16_t*)(p.ws + WS_WOUT), TOK_P, DM, DM};
        pg8::StaticOrder S; S.init(TOK_P, DM, G, c);
        pg8::EpiY E{(bf16_t*)(p.ws + WS_Y), (float*)(p.ws + WS_SSQ1)};
        pg8::gemm_phase<pg8::EpiY, pg8::StaticOrder, false, true>(lds, g, S, E);
    }
    SEAM(4);
    if (PH_LO <= 5 && 5 < PH_HI) REPEAT(REP5) { LAUNDER(); phase4(p, wid, lane); }
    SEAM(5);
    if (PH_LO <= 6 && 6 < PH_HI) REPEAT(REP6) {
        for (int t = c; t < 256; t += G) thin_ffn1(p, lds, t, tid, wid, lane);
        pg8::Gemm g{(const bf16_t*)(p.ws + WS_Y), (const bf16_t*)(p.ws + WS_WFF1), TOK_P, 2 * DFF, DM};
        pg8::WalkOrder S{G, c};
        pg8::EpiFfn E{(bf16_t*)(p.ws + WS_RB), p.in[15], p.in[4], p.out + O_CFP, p.out + O_CFS, (LAS float*)(lds + LDS_HALO), (const float*)(p.ws + WS_RS2)};
        pg8::gemm_phase<pg8::EpiFfn, pg8::WalkOrder, true, true>(lds, g, S, E);
    }
    SEAM(6);
    if (PH_LO <= 7 && 7 < PH_HI) REPEAT(REP7) {
        for (int t = c; t < 256; t += G) { f32x4 acc[1]; const int kq = t >> 6, nt = t & 63;
            thin_gemm2<1>(lds, (const bf16_t*)(p.ws + WS_RB) + (size_t)TOK_P * DFF, DFF, (const bf16_t*)(p.ws + WS_WDN), DFF, 16 * nt, 0, 1024 * kq, 1024, acc, tid, wid, lane);
            thin_store(acc[0], (float*)(p.ws + WS_FS) + (size_t)kq * 128 * DM, DM, 16 * nt, wid, lane); }
        pg8::Gemm g{(const bf16_t*)(p.ws + WS_RB), (const bf16_t*)(p.ws + WS_WDN), TOK_P, DM, DFF};
        pg8::StaticOrder S; S.init(TOK_P, DM, G, c);
        pg8::EpiY E{(bf16_t*)(p.ws + WS_RA), (float*)(p.ws + WS_SSQ2)};
        pg8::gemm_phase<pg8::EpiY, pg8::StaticOrder, false, true>(lds, g, S, E);
    }
    SEAM(7);
#ifndef REP8
#define REP8 1
#endif
    if (PH_LO <= 8 && 8 < PH_HI) REPEAT(REP8) { LAUNDER(); phase7(p, wid, lane); }
#undef SEAM
}
constexpr int NPH = 9;
#if MK_LAUNCHES == 1
__global__ void __launch_bounds__(512, 2) fwd_kernel(Params p) {
    extern __shared__ __attribute__((aligned(16))) unsigned char smem[];
    run_phases<0, NPH>(p, (LAS unsigned char*)smem);
}
#else
template <int PH>
__global__ void __launch_bounds__(512, 2) fwd_phase(Params p) {
    extern __shared__ __attribute__((aligned(16))) unsigned char smem[];
    run_phases<PH, PH + 1>(p, (LAS unsigned char*)smem);
}
template <int PH> static void launch_phase(const Params& p, int grid, hipStream_t stream) {
    static bool attr = false;
    if (!attr) { (void)hipFuncSetAttribute((const void*)fwd_phase<PH>, hipFuncAttributeMaxDynamicSharedMemorySize, LDS_BYTES); attr = true; }
    hipLaunchKernelGGL(fwd_phase<PH>, dim3(grid), dim3(512), LDS_BYTES, stream, p);
}
#endif

extern "C" void kernel_launch(void* const* d_in, const int* in_sizes, int n_in, void* d_out, int out_size, void* d_ws, size_t ws_size, hipStream_t stream) {
    static int grid = 0;
    if (grid == 0) {
        if (n_in != 17 || ws_size < WS_END) { fprintf(stderr, "kernel_launch: expected 17 inputs and >= %zu bytes of workspace (got %d, %zu)\n", (size_t)WS_END, n_in, ws_size); grid = -1; return; }
        int dev = 0, cus = 0, per_cu = 0;
        (void)hipGetDevice(&dev); (void)hipDeviceGetAttribute(&cus, hipDeviceAttributeMultiprocessorCount, dev);
#if MK_LAUNCHES == 1
        if (hipFuncSetAttribute((const void*)fwd_kernel, hipFuncAttributeMaxDynamicSharedMemorySize, LDS_BYTES) != hipSuccess) { fprintf(stderr, "kernel_launch: hipFuncSetAttribute failed\n"); grid = -1; return; }
        if (hipOccupancyMaxActiveBlocksPerMultiprocessor(&per_cu, (const void*)fwd_kernel, 512, LDS_BYTES) != hipSuccess || per_cu < 1) { fprintf(stderr, "kernel_launch: occupancy query says %d\n", per_cu); per_cu = 1; }
        (void)hipGetLastError();
#endif
        grid = cus > 0 ? cus : 256;
    }
    if (grid < 0) return;
    Params p{};
    for (int i = 0; i < 17; ++i) p.in[i] = (const float*)d_in[i];
    p.out = (float*)d_out; p.ws = (unsigned char*)d_ws;
#if MK_LAUNCHES == 1
    if (hipMemsetAsync(d_ws, 0, 16384, stream) != hipSuccess) { fprintf(stderr, "kernel_launch: hipMemsetAsync failed\n"); return; }
    void* args[] = {&p};
    const hipError_t e = hipLaunchCooperativeKernel((const void*)fwd_kernel, dim3(grid), dim3(512), args, LDS_BYTES, stream);
    if (e != hipSuccess) fprintf(stderr, "kernel_launch: cooperative launch failed: %s (grid %d)\n", hipGetErrorString(e), grid);
#else
    launch_phase<0>(p, grid, stream); launch_phase<1>(p, grid, stream); launch_phase<2>(p, grid, stream); launch_phase<3>(p, grid, stream); launch_phase<4>(p, grid, stream);
    launch_phase<5>(p, grid, stream); launch_phase<6>(p, grid, stream); launch_phase<7>(p, grid, stream); launch_phase<8>(p, grid, stream);
#endif
}
```
